# Optimizing an MI355X kernel written in HIP

```python
import math
import jax
import jax.numpy as jnp
from jax import lax
import numpy as np

D_MODEL = 1024
BATCH = 4
SEQ = 4096
DEPTH = 1

N_META = 16
ROPE_THETA = 10000.0
EPS = 1e-6
A_HEAD_DIM = 64
A_HEADS = (D_MODEL // 2) // A_HEAD_DIM
A_WIDTH = A_HEADS * A_HEAD_DIM
KV_RANK = D_MODEL // 4
IDX_HEADS = 8
IDX_DIM = 64
INDEX_TOPK = 256
Q_BLOCK = 128
B_HEAD_DIM = 128
B_HEADS = (D_MODEL // 2) // B_HEAD_DIM
B_WIDTH = B_HEADS * B_HEAD_DIM
CONV_WIDTH = 4
CHUNK = 64
MIX_WIDTH = A_WIDTH + B_WIDTH
N_EXPERTS = 32
TOP_K = 4
D_FF = D_MODEL
SWIGLU_LIMIT = 7.0
SWIGLU_ALPHA = 1.702
MOE_BLOCK = 128
IN_SPLITS = (A_WIDTH, KV_RANK, IDX_HEADS * IDX_DIM, IDX_DIM, IDX_HEADS, 3 * B_WIDTH, B_WIDTH, B_HEADS, B_HEADS)
IN_COLS = A_WIDTH + KV_RANK + IDX_HEADS * IDX_DIM + IDX_DIM + IDX_HEADS + 4 * B_WIDTH + 2 * B_HEADS

kernel_name = "hybrid_dsa_gdn_moe_meta"


def rms_norm(x, w):
    xf = x.astype(jnp.float32)
    y = xf * lax.rsqrt(jnp.mean(xf * xf, axis=-1, keepdims=True) + EPS)
    return (y * w.astype(jnp.float32)).astype(x.dtype)


def l2_normalize(x):
    return x * lax.rsqrt(jnp.sum(x * x, axis=-1, keepdims=True) + EPS)


def rope_tables(n_pos, dim):
    inv_freq = ROPE_THETA ** (-jnp.arange(0, dim, 2, dtype=jnp.float32) / dim)
    ang = jnp.arange(n_pos, dtype=jnp.float32)[:, None] * inv_freq[None, :]
    return jnp.cos(ang), jnp.sin(ang)


def apply_rope(x, cos, sin):
    xf = x.astype(jnp.float32)
    x1, x2 = jnp.split(xf, 2, axis=-1)
    c = cos[:, None, :]
    s = sin[:, None, :]
    return jnp.concatenate([x1 * c - x2 * s, x2 * c + x1 * s], axis=-1).astype(x.dtype)


def sparse_index_attention(q, k, v, q_idx, k_idx, w_idx):
    B, T, H, hd = q.shape
    S = T - N_META
    scale = hd ** -0.5
    topk = min(INDEX_TOPK, S // 4)
    q_m, q_r = q[:, :N_META], q[:, N_META:]
    k_m, k_r = k[:, :N_META], k[:, N_META:]
    v_m, v_r = v[:, :N_META], v[:, N_META:]
    qi_r = q_idx[:, N_META:]
    ki_r = k_idx[:, N_META:]
    wi_r = w_idx[:, N_META:]
    causal_m = jnp.tril(jnp.ones((N_META, N_META), bool))
    s_mm = jnp.einsum('bqhd,bkhd->bhqk', q_m, k_m).astype(jnp.float32) * scale
    p_mm = jax.nn.softmax(jnp.where(causal_m, s_mm, -jnp.inf), axis=-1).astype(v.dtype)
    o_m = jnp.einsum('bhqk,bkhd->bqhd', p_mm, v_m)
    key_pos = jnp.arange(S)
    take = jax.vmap(lambda arr, idx: arr[idx])

    def query_block(j):
        start = j * Q_BLOCK
        qb = lax.dynamic_slice_in_dim(q_r, start, Q_BLOCK, axis=1)
        qib = lax.dynamic_slice_in_dim(qi_r, start, Q_BLOCK, axis=1)
        wb = lax.dynamic_slice_in_dim(wi_r, start, Q_BLOCK, axis=1)
        t_pos = start + jnp.arange(Q_BLOCK)
        rel = jax.nn.relu(jnp.einsum('bqhd,bsd->bqhs', qib, ki_r))
        iscore = jnp.einsum('bqhs,bqh->bqs', rel, wb).astype(jnp.float32)
        admissible = key_pos[None, :] <= t_pos[:, None]
        iscore = jnp.where(admissible[None], iscore, -jnp.inf)
        _, idx = lax.top_k(iscore, topk)
        valid = idx <= t_pos[None, :, None]
        kg = take(k_r, idx)
        vg = take(v_r, idx)
        s_sel = jnp.einsum('bqhd,bqkhd->bhqk', qb, kg).astype(jnp.float32) * scale
        s_sel = jnp.where(valid[:, None], s_sel, -jnp.inf)
        s_met = jnp.einsum('bqhd,bmhd->bhqm', qb, k_m).astype(jnp.float32) * scale
        p = jax.nn.softmax(jnp.concatenate([s_met, s_sel], axis=-1), axis=-1).astype(v.dtype)
        return (jnp.einsum('bhqm,bmhd->bqhd', p[..., :N_META], v_m)
                + jnp.einsum('bhqk,bqkhd->bqhd', p[..., N_META:], vg))

    o_r = lax.map(query_block, jnp.arange(S // Q_BLOCK))
    o_r = jnp.moveaxis(o_r, 0, 1).reshape(B, S, H, hd)
    return jnp.concatenate([o_m, o_r], axis=1)


def causal_depthwise_conv(x, w):
    C = x.shape[-1]
    return lax.conv_general_dilated(
        x, w[:, None, :].astype(x.dtype), window_strides=(1,),
        padding=((CONV_WIDTH - 1, 0),), dimension_numbers=('NWC', 'WIO', 'NWC'),
        feature_group_count=C)


def chunk_gated_delta_rule(q, k, v, g, beta):
    B, H, L, dk = q.shape
    dv = v.shape[-1]
    n = L // CHUNK
    q = q * dk ** -0.5
    k_beta = k * beta[..., None]
    v_beta = v * beta[..., None]

    def to_chunks(t):
        return t.reshape(B, H, n, CHUNK, t.shape[-1])

    q, k, k_beta, v_beta = to_chunks(q), to_chunks(k), to_chunks(k_beta), to_chunks(v_beta)
    g = jnp.cumsum(g.reshape(B, H, n, CHUNK), axis=-1)
    incl = jnp.tril(jnp.ones((CHUNK, CHUNK), bool))
    strict = jnp.tril(jnp.ones((CHUNK, CHUNK), bool), -1)
    decay = jnp.where(incl, jnp.exp(jnp.where(incl, g[..., :, None] - g[..., None, :], 0.0)), 0.0)
    a_mat = jnp.where(strict, jnp.einsum('bhncd,bhnsd->bhncs', k_beta, k) * decay, 0.0)
    eye = jnp.eye(CHUNK, dtype=jnp.float32)
    t_inv = lax.linalg.triangular_solve(a_mat + eye, jnp.broadcast_to(eye, a_mat.shape),
                                        left_side=True, lower=True, unit_diagonal=True)
    u = t_inv @ v_beta
    w = t_inv @ (k_beta * jnp.exp(g)[..., None])
    intra = jnp.where(incl, jnp.einsum('bhncd,bhnsd->bhncs', q, k) * decay, 0.0)

    def step(state, xs):
        q_c, k_c, u_c, w_c, g_c, intra_c = xs
        v_new = u_c - w_c @ state
        o_c = (q_c * jnp.exp(g_c)[..., None]) @ state + intra_c @ v_new
        g_last = g_c[..., -1:]
        state = state * jnp.exp(g_last)[..., None] + jnp.einsum(
            'bhcd,bhce->bhde', k_c * jnp.exp(g_last - g_c)[..., None], v_new)
        return state, o_c

    xs = tuple(jnp.moveaxis(t, 2, 0) for t in (q, k, u, w, g, intra))
    state0 = jnp.zeros((B, H, dk, dv), jnp.float32)
    _, o = lax.scan(step, state0, xs)
    return jnp.moveaxis(o, 0, 2).reshape(B, H, L, dv)


def gated_deltanet(qkv, z, beta_in, decay_in, conv_w, a_log, dt_bias, norm_w):
    B, T, _ = qkv.shape
    f32 = jnp.float32
    qkv = jax.nn.silu(causal_depthwise_conv(qkv, conv_w)).astype(f32)
    q, k, v = (t.reshape(B, T, B_HEADS, B_HEAD_DIM) for t in jnp.split(qkv, 3, axis=-1))
    q, k = l2_normalize(q), l2_normalize(k)
    beta = jax.nn.sigmoid(beta_in.astype(f32))
    g = -jnp.exp(a_log.astype(f32)) * jax.nn.softplus(decay_in.astype(f32) + dt_bias.astype(f32))
    n_pad = CHUNK - N_META

    def lead_pad(t):
        return jnp.pad(t, [(0, 0), (n_pad, 0)] + [(0, 0)] * (t.ndim - 2))

    q, k, v = (jnp.moveaxis(lead_pad(t), 1, 2) for t in (q, k, v))
    beta, g = (jnp.moveaxis(lead_pad(t), 1, 2) for t in (beta, g))
    o = chunk_gated_delta_rule(q, k, v, g, beta)
    o = jnp.moveaxis(o, 1, 2)[:, n_pad:]
    zf = z.astype(f32).reshape(B, T, B_HEADS, B_HEAD_DIM)
    o = rms_norm(o, norm_w) * jax.nn.silu(zf)
    return o.reshape(B, T, B_WIDTH).astype(z.dtype)


def moe_ffn(u, w_router, b_router, w_gate_up, b_gate_up, w_down, b_down):
    B, T, D = u.shape
    n_tok = B * T
    xt = u.reshape(n_tok, D)
    logits = (xt @ w_router + b_router).astype(jnp.float32)
    top_logit, top_e = lax.top_k(logits, TOP_K)
    gates = jax.nn.softmax(top_logit, axis=-1)
    n_assign = n_tok * TOP_K
    flat_e = top_e.reshape(-1)
    flat_tok = jnp.repeat(jnp.arange(n_tok, dtype=jnp.int32), TOP_K)
    flat_gate = gates.reshape(-1)
    order = jnp.argsort(flat_e)
    sorted_e = flat_e[order]
    counts = jnp.bincount(flat_e, length=N_EXPERTS)
    padded = (counts + MOE_BLOCK - 1) // MOE_BLOCK * MOE_BLOCK
    start = jnp.cumsum(counts) - counts
    pend = jnp.cumsum(padded)
    pstart = pend - padded
    dest = pstart[sorted_e] + jnp.arange(n_assign) - start[sorted_e]
    n_blocks = -(-(n_assign + N_EXPERTS * (MOE_BLOCK - 1)) // MOE_BLOCK)
    n_rows = n_blocks * MOE_BLOCK
    row_tok = jnp.full((n_rows,), n_tok, jnp.int32).at[dest].set(flat_tok[order])
    row_gate = jnp.zeros((n_rows,), jnp.float32).at[dest].set(flat_gate[order])
    block_e = jnp.minimum(jnp.searchsorted(pend, jnp.arange(n_blocks) * MOE_BLOCK, side='right'),
                          N_EXPERTS - 1)
    x_pad = jnp.concatenate([xt, jnp.zeros((1, D), xt.dtype)], axis=0)
    xb = x_pad[row_tok].reshape(n_blocks, MOE_BLOCK, D)

    def expert_block(args):
        xe, e = args
        gu = xe @ w_gate_up[e] + b_gate_up[e]
        gate = jnp.minimum(gu[:, 0::2], SWIGLU_LIMIT)
        up = jnp.clip(gu[:, 1::2], -SWIGLU_LIMIT, SWIGLU_LIMIT)
        glu = gate * jax.nn.sigmoid(gate * SWIGLU_ALPHA)
        return (glu * (up + 1.0)) @ w_down[e] + b_down[e]

    y = lax.map(expert_block, (xb, block_e)).reshape(n_rows, D)
    y = y * row_gate[:, None].astype(y.dtype)
    out = jnp.zeros((n_tok + 1, D), y.dtype).at[row_tok].add(y)[:n_tok]
    return out.reshape(B, T, D)


def hybrid_layer(h, norm_mix_w, w_in, q_norm_w, k_norm_w, kv_norm_w, w_kv_up, conv_w, a_log,
                 dt_bias, delta_norm_w, w_out, norm_ffn_w, w_router, b_router, w_gate_up,
                 b_gate_up, w_down, b_down):
    B, T, _ = h.shape
    u = rms_norm(h, norm_mix_w)
    points = np.cumsum(IN_SPLITS)[:-1].tolist()
    a_q, a_ckv, i_q, i_k, i_w, b_qkv, b_z, b_beta, b_a = jnp.split(u @ w_in, points, axis=-1)
    cos_a, sin_a = rope_tables(T, A_HEAD_DIM)
    cos_i, sin_i = rope_tables(T, IDX_DIM)
    q = apply_rope(rms_norm(a_q.reshape(B, T, A_HEADS, A_HEAD_DIM), q_norm_w), cos_a, sin_a)
    k, v = jnp.split(rms_norm(a_ckv, kv_norm_w) @ w_kv_up, 2, axis=-1)
    k = apply_rope(rms_norm(k.reshape(B, T, A_HEADS, A_HEAD_DIM), k_norm_w), cos_a, sin_a)
    v = v.reshape(B, T, A_HEADS, A_HEAD_DIM)
    q_idx = apply_rope(i_q.reshape(B, T, IDX_HEADS, IDX_DIM), cos_i, sin_i)
    k_idx = apply_rope(i_k[:, :, None, :], cos_i, sin_i)[:, :, 0]
    w_idx = i_w * (IDX_HEADS ** -0.5 * IDX_DIM ** -0.5)
    o_a = sparse_index_attention(q, k, v, q_idx, k_idx, w_idx).reshape(B, T, A_WIDTH)
    o_b = gated_deltanet(b_qkv, b_z, b_beta, b_a, conv_w, a_log, dt_bias, delta_norm_w)
    h = h + jnp.concatenate([o_a, o_b], axis=-1) @ w_out
    return h + moe_ffn(rms_norm(h, norm_ffn_w), w_router, b_router, w_gate_up, b_gate_up,
                       w_down, b_down)


def setup_inputs(seed: int = 0) -> dict:
    key = jax.random.key(seed)
    ks = jax.random.split(key, 20)
    f32 = jnp.float32

    def nrm(k, shape, scale):
        return jax.random.normal(k, shape, f32) * scale

    def gain(k, shape):
        return 1.0 + 0.02 * jax.random.normal(k, shape, f32)

    x = nrm(ks[0], (BATCH, SEQ, D_MODEL), 1.0)
    meta_tokens = nrm(ks[1], (N_META, D_MODEL), 1.0)
    norm_mix_w = gain(ks[2], (DEPTH, D_MODEL))
    w_in = nrm(ks[3], (DEPTH, D_MODEL, IN_COLS), D_MODEL ** -0.5)
    q_norm_w = gain(ks[4], (DEPTH, A_HEAD_DIM))
    k_norm_w = gain(ks[5], (DEPTH, A_HEAD_DIM))
    kv_norm_w = gain(ks[6], (DEPTH, KV_RANK))
    w_kv_up = nrm(ks[7], (DEPTH, KV_RANK, 2 * A_WIDTH), KV_RANK ** -0.5)
    conv_w = nrm(ks[8], (DEPTH, CONV_WIDTH, 3 * B_WIDTH), CONV_WIDTH ** -0.5)
    a_log = jnp.log(jax.random.uniform(ks[9], (DEPTH, B_HEADS), f32, 1.0, 16.0))
    dt = jnp.exp(jax.random.uniform(ks[10], (DEPTH, B_HEADS), f32, math.log(1e-3), math.log(0.1)))
    dt_bias = dt + jnp.log(-jnp.expm1(-dt))
    delta_norm_w = gain(ks[11], (DEPTH, B_HEAD_DIM))
    w_out = nrm(ks[12], (DEPTH, MIX_WIDTH, D_MODEL), MIX_WIDTH ** -0.5)
    norm_ffn_w = gain(ks[13], (DEPTH, D_MODEL))
    w_router = nrm(ks[14], (DEPTH, D_MODEL, N_EXPERTS), D_MODEL ** -0.5)
    b_router = nrm(ks[15], (DEPTH, N_EXPERTS), 0.01)
    w_gate_up = nrm(ks[16], (DEPTH, N_EXPERTS, D_MODEL, 2 * D_FF), D_MODEL ** -0.5)
    b_gate_up = nrm(ks[17], (DEPTH, N_EXPERTS, 2 * D_FF), 0.01)
    w_down = nrm(ks[18], (DEPTH, N_EXPERTS, D_FF, D_MODEL), D_FF ** -0.5)
    b_down = nrm(ks[19], (DEPTH, N_EXPERTS, D_MODEL), 0.01)
    return {"x": x, "meta_tokens": meta_tokens, "norm_mix_w": norm_mix_w, "w_in": w_in,
            "q_norm_w": q_norm_w, "k_norm_w": k_norm_w, "kv_norm_w": kv_norm_w,
            "w_kv_up": w_kv_up, "conv_w": conv_w, "a_log": a_log, "dt_bias": dt_bias,
            "delta_norm_w": delta_norm_w, "w_out": w_out, "norm_ffn_w": norm_ffn_w,
            "w_router": w_router, "b_router": b_router, "w_gate_up": w_gate_up,
            "b_gate_up": b_gate_up, "w_down": w_down, "b_down": b_down}


def reference(x, meta_tokens, norm_mix_w, w_in, q_norm_w, k_norm_w, kv_norm_w, w_kv_up, conv_w,
              a_log, dt_bias, delta_norm_w, w_out, norm_ffn_w, w_router, b_router, w_gate_up,
              b_gate_up, w_down, b_down):
    B = x.shape[0]
    meta = jnp.broadcast_to(meta_tokens.astype(x.dtype)[None], (B, N_META, x.shape[-1]))
    h = jnp.concatenate([meta, x], axis=1)
    for l in range(DEPTH):
        h = hybrid_layer(h, norm_mix_w[l], w_in[l], q_norm_w[l], k_norm_w[l], kv_norm_w[l],
                         w_kv_up[l], conv_w[l], a_log[l], dt_bias[l], delta_norm_w[l], w_out[l],
                         norm_ffn_w[l], w_router[l], b_router[l], w_gate_up[l], b_gate_up[l],
                         w_down[l], b_down[l])
    return h[:, N_META:]
```

```cpp
#include <hip/hip_runtime.h>
#include <stdint.h>

typedef __attribute__((ext_vector_type(8))) short bf16x8;
typedef __attribute__((ext_vector_type(4))) short s16x4;
typedef __attribute__((ext_vector_type(16))) float f32x16;
typedef __attribute__((ext_vector_type(4))) float f32x4;
typedef __bf16 bf2_t __attribute__((ext_vector_type(2)));
#define DI __device__ __forceinline__
#define MFMA32(a, b, c) __builtin_amdgcn_mfma_f32_32x32x16_bf16((a), (b), (c), 0, 0, 0)
#define MFMA16(a, b, c) __builtin_amdgcn_mfma_f32_16x16x32_bf16((a), (b), (c), 0, 0, 0)

constexpr int NB = 4, SEQ = 4096, NM = 16, T = 4112, NT = NB * T, NR = NB * SEQ, D = 1024, INC = 3408;
constexpr int C_AQ = 0, C_CKV = 512, C_IQ = 768, C_IK = 1280, C_IW = 1344, C_BQKV = 1352, C_BZ = 2888, C_BBETA = 3400, C_BA = 3404;
constexpr int NCH = 65, NCHT = NB * 4 * NCH;
constexpr int NEXP = 32, NASG = NR * 4;
constexpr int NTHREADS = 512, NWAVES = 8;

constexpr size_t al256(size_t x) { return (x + 255) & ~(size_t)255; }
constexpr size_t OFF_U = 0;
constexpr size_t OFF_P = OFF_U + al256((size_t)NT * 1024 * 2);
constexpr size_t OFF_ROPE = OFF_P + al256((size_t)NT * INC * 4);
constexpr size_t OFF_QB = OFF_ROPE + al256((size_t)T * 64 * 4);
constexpr size_t OFF_KB = OFF_QB + al256((size_t)NT * 512 * 2);
constexpr size_t OFF_VT = OFF_KB + al256((size_t)NT * 512 * 2);
constexpr size_t OFF_QI = OFF_VT + al256((size_t)NT * 512 * 2);
constexpr size_t OFF_KI = OFF_QI + al256((size_t)NT * 512 * 2);
constexpr size_t OFF_WI = OFF_KI + al256((size_t)NT * 64 * 2);
constexpr size_t OFF_CKV = OFF_WI + al256((size_t)NT * 8 * 4);
constexpr size_t OFF_KV = OFF_CKV + al256((size_t)NT * 256 * 2);
constexpr size_t OFF_MASK = OFF_KV + al256((size_t)NT * 1024 * 4);
constexpr size_t OFF_MIX = OFF_MASK + al256((size_t)NB * SEQ * 128 * 4);
constexpr size_t OFF_QD = OFF_MIX + al256((size_t)NT * 1024 * 2);
constexpr size_t OFF_KD = OFF_QD + al256((size_t)NT * 512 * 4);
constexpr size_t OFF_VD = OFF_KD + al256((size_t)NT * 512 * 4);
constexpr size_t OFF_BETA = OFF_VD + al256((size_t)NT * 512 * 4);
constexpr size_t OFF_G = OFF_BETA + al256((size_t)NT * 4 * 4);
constexpr size_t OFF_WN = OFF_G + al256((size_t)NT * 4 * 4);
constexpr size_t OFF_UU = OFF_WN + al256((size_t)NCHT * 64 * 128 * 2);
constexpr size_t OFF_QG = OFF_UU + al256((size_t)NCHT * 64 * 128 * 4);
constexpr size_t OFF_IN = OFF_QG + al256((size_t)NCHT * 64 * 128 * 2);
constexpr size_t OFF_KDT = OFF_IN + al256((size_t)NCHT * 64 * 64 * 2);
constexpr size_t OFF_DL = OFF_KDT + al256((size_t)NCHT * 64 * 128 * 2);
constexpr size_t OFF_OD = OFF_DL + al256((size_t)NCHT * 4);
constexpr size_t OFF_U2 = OFF_OD + al256((size_t)NT * 512 * 4);
constexpr size_t OFF_TOPE = OFF_U2 + al256((size_t)NR * 1024 * 2);
constexpr size_t OFF_GATEV = OFF_TOPE + al256((size_t)NR * 4 * 4);
constexpr size_t OFF_POS = OFF_GATEV + al256((size_t)NR * 4 * 4);
constexpr size_t OFF_SLOT = OFF_POS + al256((size_t)NR * 4 * 4);
constexpr size_t OFF_LTOK = OFF_SLOT + al256((size_t)NR * 4 * 4);
constexpr size_t OFF_LGATE = OFF_LTOK + al256((size_t)NASG * 4);
constexpr size_t OFF_Y = OFF_LGATE + al256((size_t)NASG * 4);
constexpr size_t OFF_CNT = OFF_Y + al256((size_t)NASG * 1024 * 2);
constexpr size_t WS_NEED = OFF_CNT + 4096;
constexpr size_t OFF_H1 = OFF_KV;
constexpr size_t OFF_HD = OFF_P;

struct Params {
  const float *x, *meta, *norm_mix_w, *w_in, *q_norm_w, *k_norm_w, *kv_norm_w, *w_kv_up, *conv_w, *a_log, *dt_bias,
      *delta_norm_w, *w_out, *norm_ffn_w, *w_router, *b_router, *w_gate_up, *b_gate_up, *w_down, *b_down;
  float* out;
  char* ws;
};

DI unsigned pk2(float a, float b) { bf2_t v; v[0] = (__bf16)a; v[1] = (__bf16)b; return __builtin_bit_cast(unsigned, v); }
DI unsigned short f2bf(float a) { return (unsigned short)(pk2(a, 0.f) & 0xffffu); }
DI float bf2f(unsigned short u) { return __uint_as_float(((unsigned)u) << 16); }
DI float wave_sum(float v) {
#pragma unroll
  for (int o = 32; o >= 1; o >>= 1) v += __shfl_xor(v, o);
  return v;
}
DI int crow(int reg, int h) { return (reg & 3) + 8 * (reg >> 2) + 4 * h; }
DI bf16x8 pack8(const f32x16& x, int s) {
  uint4 p;
  p.x = pk2(x[8 * s + 0], x[8 * s + 1]); p.y = pk2(x[8 * s + 2], x[8 * s + 3]);
  p.z = pk2(x[8 * s + 4], x[8 * s + 5]); p.w = pk2(x[8 * s + 6], x[8 * s + 7]);
  return __builtin_bit_cast(bf16x8, p);
}
DI bf16x8 ld8x2(const unsigned short* p0, const unsigned short* p1) {
  uint2 a = *(const uint2*)p0, b = *(const uint2*)p1;
  uint4 r = make_uint4(a.x, a.y, b.x, b.y);
  return __builtin_bit_cast(bf16x8, r);
}
DI bf16x8 ld16(const unsigned short* p) { uint4 r = *(const uint4*)p; return __builtin_bit_cast(bf16x8, r); }
DI const float* hrow(const Params& p, int tok) {
  int b = tok / T, t = tok - b * T;
  return (t < NM) ? (p.meta + (size_t)t * D) : (p.x + ((size_t)b * SEQ + (t - NM)) * D);
}

DI void phase_prep(const Params& p) {
  const int tid = threadIdx.x, lane = tid & 63, wave = tid >> 6;
  float* rope = (float*)(p.ws + OFF_ROPE);
  for (int idx = blockIdx.x * NTHREADS + tid; idx < T * 32; idx += gridDim.x * NTHREADS) {
    int t = idx >> 5, i = idx & 31;
    float inv = (float)pow(10000.0, -(double)i / 32.0);
    float ang = (float)t * inv;
    double ad = (double)ang;
    double n = rint(ad * 0.15915494309189535);
    float r = (float)(ad - n * 6.283185307179586);
    float sn, cs;
    sincosf(r, &sn, &cs);
    rope[t * 64 + i] = cs;
    rope[t * 64 + 32 + i] = sn;
  }
  unsigned short* U = (unsigned short*)(p.ws + OFF_U);
  for (int tok = blockIdx.x * NWAVES + wave; tok < NT; tok += gridDim.x * NWAVES) {
    const float* src = hrow(p, tok);
    float4 v[4];
    float ss = 0.f;
#pragma unroll
    for (int i = 0; i < 4; ++i) {
      v[i] = *(const float4*)(src + lane * 4 + 256 * i);
      ss += v[i].x * v[i].x + v[i].y * v[i].y + v[i].z * v[i].z + v[i].w * v[i].w;
    }
    ss = wave_sum(ss);
    float rstd = rsqrtf(ss * (1.f / 1024.f) + 1e-6f);
#pragma unroll
    for (int i = 0; i < 4; ++i) {
      float4 w = *(const float4*)(p.norm_mix_w + lane * 4 + 256 * i);
      uint2 o;
      o.x = pk2(v[i].x * rstd * w.x, v[i].y * rstd * w.y);
      o.y = pk2(v[i].z * rstd * w.z, v[i].w * rstd * w.w);
      *(uint2*)(U + (size_t)tok * 1024 + lane * 4 + 256 * i) = o;
    }
  }
}

constexpr int GA_STRIDE = 40;
constexpr int G_BM = 128, G_BN = 256, G_BK = 32;

template <int MODE>
DI void gemm_tile(const Params& p, char* smem, const unsigned short* Abase, int lda, int m0, int mend, const float* B, int ldb,
                  int n0, int N, int K, float* C, int ldc, int e, int slot0) {
  unsigned short* As = (unsigned short*)smem;
  unsigned short* Bs = As + G_BM * GA_STRIDE;
  const int tid = threadIdx.x, lane = tid & 63, wave = tid >> 6;
  const int wm = wave >> 2, wn = wave & 3, lr = lane & 31, lh = lane >> 5;
  const int arow = tid >> 2, akc = tid & 3;
  int am = m0 + arow;
  if (am > mend - 1) am = mend - 1;
  size_t arowoff;
  if (MODE == 1) arowoff = (size_t)(am + 16 * (am / SEQ + 1)) * lda;
  else if (MODE == 2) arowoff = (size_t)((const int*)(p.ws + OFF_LTOK))[am] * lda;
  else arowoff = (size_t)am * lda;
  const unsigned short* aptr = Abase + arowoff + akc * 8;
  const int nq = tid & 63, kg = tid >> 6;
  const int bn = n0 + nq * 4;
  const bool bvalid = bn < N;
  const float* bptr = B + (size_t)(kg * 4) * ldb + bn;

  f32x16 acc[2][2];
#pragma unroll
  for (int i = 0; i < 2; ++i)
#pragma unroll
    for (int j = 0; j < 2; ++j)
#pragma unroll
      for (int r = 0; r < 16; ++r) acc[i][j][r] = 0.f;

  uint4 areg;
  float4 breg[4];
  areg = *(const uint4*)aptr;
#pragma unroll
  for (int i = 0; i < 4; ++i) breg[i] = bvalid ? *(const float4*)(bptr + (size_t)i * ldb) : make_float4(0.f, 0.f, 0.f, 0.f);

  const int nk = K / G_BK;
  for (int kt = 0; kt < nk; ++kt) {
    __syncthreads();
    *(uint4*)(As + arow * GA_STRIDE + akc * 8) = areg;
    {
      uint2 w0, w1, w2, w3;
      w0.x = pk2(breg[0].x, breg[1].x); w0.y = pk2(breg[2].x, breg[3].x);
      w1.x = pk2(breg[0].y, breg[1].y); w1.y = pk2(breg[2].y, breg[3].y);
      w2.x = pk2(breg[0].z, breg[1].z); w2.y = pk2(breg[2].z, breg[3].z);
      w3.x = pk2(breg[0].w, breg[1].w); w3.y = pk2(breg[2].w, breg[3].w);
      *(uint2*)(Bs + (nq * 4 + 0) * GA_STRIDE + kg * 4) = w0;
      *(uint2*)(Bs + (nq * 4 + 1) * GA_STRIDE + kg * 4) = w1;
      *(uint2*)(Bs + (nq * 4 + 2) * GA_STRIDE + kg * 4) = w2;
      *(uint2*)(Bs + (nq * 4 + 3) * GA_STRIDE + kg * 4) = w3;
    }
    __syncthreads();
    if (kt + 1 < nk) {
      areg = *(const uint4*)(aptr + (size_t)(kt + 1) * G_BK);
#pragma unroll
      for (int i = 0; i < 4; ++i)
        breg[i] = bvalid ? *(const float4*)(bptr + (size_t)((kt + 1) * G_BK + i) * ldb) : make_float4(0.f, 0.f, 0.f, 0.f);
    }
#pragma unroll
    for (int ks = 0; ks < 2; ++ks) {
      bf16x8 af[2], bfr[2];
#pragma unroll
      for (int mt = 0; mt < 2; ++mt) af[mt] = ld16(As + (wm * 64 + mt * 32 + lr) * GA_STRIDE + ks * 16 + 8 * lh);
#pragma unroll
      for (int nt = 0; nt < 2; ++nt) {
        int brow = (MODE == 2) ? (wn * 64 + 2 * lr + nt) : (wn * 64 + nt * 32 + lr);
        bfr[nt] = ld16(Bs + brow * GA_STRIDE + ks * 16 + 8 * lh);
      }
#pragma unroll
      for (int mt = 0; mt < 2; ++mt)
#pragma unroll
        for (int nt = 0; nt < 2; ++nt) acc[mt][nt] = MFMA32(af[mt], bfr[nt], acc[mt][nt]);
    }
  }
  if (MODE == 0 || MODE == 1) {
#pragma unroll
    for (int mt = 0; mt < 2; ++mt)
#pragma unroll
      for (int nt = 0; nt < 2; ++nt) {
        int col = n0 + wn * 64 + nt * 32 + lr;
#pragma unroll
        for (int r = 0; r < 16; ++r) {
          int row = m0 + wm * 64 + mt * 32 + crow(r, lh);
          if (row < mend && col < N) {
            float v = acc[mt][nt][r];
            if (MODE == 1) v += p.x[(size_t)row * D + col];
            C[(size_t)row * ldc + col] = v;
          }
        }
      }
  } else if (MODE == 2) {
    unsigned short* HD = (unsigned short*)(p.ws + OFF_HD);
    const int f = (n0 + wn * 64) / 2 + lr;
    const float bg = p.b_gate_up[(size_t)e * 2048 + 2 * f], bu = p.b_gate_up[(size_t)e * 2048 + 2 * f + 1];
#pragma unroll
    for (int mt = 0; mt < 2; ++mt)
#pragma unroll
      for (int r = 0; r < 16; ++r) {
        int row = m0 + wm * 64 + mt * 32 + crow(r, lh);
        if (row < mend) {
          float g = fminf(acc[mt][0][r] + bg, 7.0f);
          float u = fminf(fmaxf(acc[mt][1][r] + bu, -7.0f), 7.0f);
          float glu = g / (1.f + __expf(-1.702f * g));
          HD[(size_t)row * 1024 + f] = f2bf(glu * (u + 1.f));
        }
      }
  } else {
    unsigned short* Y = (unsigned short*)(p.ws + OFF_Y);
    const float* lgate = (const float*)(p.ws + OFF_LGATE);
#pragma unroll
    for (int mt = 0; mt < 2; ++mt)
#pragma unroll
      for (int nt = 0; nt < 2; ++nt) {
        int col = n0 + wn * 64 + nt * 32 + lr;
        float bd = p.b_down[(size_t)e * 1024 + col];
#pragma unroll
        for (int r = 0; r < 16; ++r) {
          int row = m0 + wm * 64 + mt * 32 + crow(r, lh);
          if (row < mend) Y[(size_t)row * 1024 + col] = f2bf((acc[mt][nt][r] + bd) * lgate[row]);
        }
      }
  }
  (void)slot0;
}

DI void phase_gemm_inproj(const Params& p, char* smem) {
  const int mt = (NT + G_BM - 1) / G_BM, nt = (INC + G_BN - 1) / G_BN;
  for (int t = blockIdx.x; t < mt * nt; t += gridDim.x) {
    int tn = t / mt, tm = t - tn * mt;
    gemm_tile<0>(p, smem, (const unsigned short*)(p.ws + OFF_U), 1024, tm * G_BM, NT, p.w_in, INC, tn * G_BN, INC, 1024,
                 (float*)(p.ws + OFF_P), INC, 0, 0);
  }
}
DI void phase_gemm_kvup(const Params& p, char* smem) {
  const int mt = (NT + G_BM - 1) / G_BM, nt = 1024 / G_BN;
  for (int t = blockIdx.x; t < mt * nt; t += gridDim.x) {
    int tn = t / mt, tm = t - tn * mt;
    gemm_tile<0>(p, smem, (const unsigned short*)(p.ws + OFF_CKV), 256, tm * G_BM, NT, p.w_kv_up, 1024, tn * G_BN, 1024, 256,
                 (float*)(p.ws + OFF_KV), 1024, 0, 0);
  }
}
DI void phase_gemm_outproj(const Params& p, char* smem) {
  const int mt = NR / G_BM, nt = 1024 / G_BN;
  for (int t = blockIdx.x; t < mt * nt; t += gridDim.x) {
    int tn = t / mt, tm = t - tn * mt;
    gemm_tile<1>(p, smem, (const unsigned short*)(p.ws + OFF_MIX), 1024, tm * G_BM, NR, p.w_out, 1024, tn * G_BN, 1024, 1024,
                 (float*)(p.ws + OFF_H1), 1024, 0, 0);
  }
}
template <int MODE>
DI void phase_gemm_moe(const Params& p, char* smem) {
  const int* cnt = (const int*)(p.ws + OFF_CNT);
  constexpr int NTN = (MODE == 2) ? (2048 / G_BN) : (1024 / G_BN);
  int t = blockIdx.x;
  int tbase = 0, sbase = 0;
  for (int e = 0; e < NEXP; ++e) {
    int c = cnt[e];
    int mts = (c + G_BM - 1) / G_BM;
    int ntile_e = mts * NTN;
    while (t < tbase + ntile_e) {
      int lt = t - tbase;
      int tn = lt / mts, tm = lt - tn * mts;
      if (MODE == 2)
        gemm_tile<2>(p, smem, (const unsigned short*)(p.ws + OFF_U2), 1024, sbase + tm * G_BM, sbase + c,
                     p.w_gate_up + (size_t)e * 1024 * 2048, 2048, tn * G_BN, 2048, 1024, nullptr, 0, e, 0);
      else
        gemm_tile<3>(p, smem, (const unsigned short*)(p.ws + OFF_HD), 1024, sbase + tm * G_BM, sbase + c,
                     p.w_down + (size_t)e * 1024 * 1024, 1024, tn * G_BN, 1024, 1024, nullptr, 0, e, 0);
      t += gridDim.x;
    }
    tbase += ntile_e;
    sbase += c;
  }
}

DI float rope_apply(float v, float c, float s, int lane) {
  float o = __shfl_xor(v, 32);
  return (lane < 32) ? (v * c - o * s) : (v * c + o * s);
}
DI void phase_post1(const Params& p) {
  const int tid = threadIdx.x, lane = tid & 63, wave = tid >> 6;
  const float* P = (const float*)(p.ws + OFF_P);
  const float* rope = (const float*)(p.ws + OFF_ROPE);
  unsigned short* Qb = (unsigned short*)(p.ws + OFF_QB);
  unsigned short* QI = (unsigned short*)(p.ws + OFF_QI);
  unsigned short* KI = (unsigned short*)(p.ws + OFF_KI);
  unsigned short* CKV = (unsigned short*)(p.ws + OFF_CKV);
  float* WI = (float*)(p.ws + OFF_WI);
  float* Qd = (float*)(p.ws + OFF_QD);
  float* Kd = (float*)(p.ws + OFF_KD);
  float* Vd = (float*)(p.ws + OFF_VD);
  float* BETA = (float*)(p.ws + OFF_BETA);
  float* G = (float*)(p.ws + OFF_G);
  for (int tok = blockIdx.x * NWAVES + wave; tok < NT; tok += gridDim.x * NWAVES) {
    const int b = tok / T, t = tok - b * T;
    const float* row = P + (size_t)tok * INC;
    const float cs = rope[t * 64 + (lane & 31)], sn = rope[t * 64 + 32 + (lane & 31)];
    const float qw = p.q_norm_w[lane];
#pragma unroll
    for (int hh = 0; hh < 8; ++hh) {
      float v = row[C_AQ + hh * 64 + lane];
      float ss = wave_sum(v * v);
      v = v * rsqrtf(ss * (1.f / 64.f) + 1e-6f) * qw;
      v = rope_apply(v, cs, sn, lane);
      Qb[(size_t)tok * 512 + hh * 64 + lane] = f2bf(v);
    }
    {
      float4 v = *(const float4*)(row + C_CKV + lane * 4);
      float ss = wave_sum(v.x * v.x + v.y * v.y + v.z * v.z + v.w * v.w);
      float rstd = rsqrtf(ss * (1.f / 256.f) + 1e-6f);
      float4 w = *(const float4*)(p.kv_norm_w + lane * 4);
      uint2 o;
      o.x = pk2(v.x * rstd * w.x, v.y * rstd * w.y);
      o.y = pk2(v.z * rstd * w.z, v.w * rstd * w.w);
      *(uint2*)(CKV + (size_t)tok * 256 + lane * 4) = o;
    }
#pragma unroll
    for (int hh = 0; hh < 8; ++hh) {
      float v = row[C_IQ + hh * 64 + lane];
      v = rope_apply(v, cs, sn, lane);
      QI[(size_t)tok * 512 + hh * 64 + lane] = f2bf(v);
    }
    {
      float v = row[C_IK + lane];
      v = rope_apply(v, cs, sn, lane);
      KI[(size_t)tok * 64 + lane] = f2bf(v);
    }
    if (lane < 8) WI[(size_t)tok * 8 + lane] = row[C_IW + lane] * 0.04419417382415922f;
#pragma unroll
    for (int hd = 0; hd < 4; ++hd) {
      float cv[6];
#pragma unroll
      for (int i = 0; i < 6; ++i) {
        const int c = (i >> 1) * 512 + hd * 128 + (i & 1) * 64 + lane;
        float a = 0.f;
#pragma unroll
        for (int j = 0; j < 4; ++j) {
          int tt = t - 3 + j;
          if (tt >= 0) a += p.conv_w[j * 1536 + c] * row[(ptrdiff_t)(j - 3) * INC + C_BQKV + c];
        }
        cv[i] = a / (1.f + __expf(-a));
      }
      float ss = wave_sum(cv[0] * cv[0] + cv[1] * cv[1]);
      float r = rsqrtf(ss + 1e-6f);
      Qd[(size_t)tok * 512 + hd * 128 + lane] = cv[0] * r;
      Qd[(size_t)tok * 512 + hd * 128 + 64 + lane] = cv[1] * r;
      ss = wave_sum(cv[2] * cv[2] + cv[3] * cv[3]);
      r = rsqrtf(ss + 1e-6f);
      Kd[(size_t)tok * 512 + hd * 128 + lane] = cv[2] * r;
      Kd[(size_t)tok * 512 + hd * 128 + 64 + lane] = cv[3] * r;
      Vd[(size_t)tok * 512 + hd * 128 + lane] = cv[4];
      Vd[(size_t)tok * 512 + hd * 128 + 64 + lane] = cv[5];
      __builtin_amdgcn_sched_barrier(0);
    }
    if (lane < 4) {
      float bi = row[C_BBETA + lane];
      BETA[(size_t)tok * 4 + lane] = 1.f / (1.f + expf(-bi));
      float xx = row[C_BA + lane] + p.dt_bias[lane];
      float sp = fmaxf(xx, 0.f) + log1pf(expf(-fabsf(xx)));
      G[(size_t)tok * 4 + lane] = -expf(p.a_log[lane]) * sp;
    }
  }
}

DI void phase_post2(const Params& p) {
  const int tid = threadIdx.x, lane = tid & 63, wave = tid >> 6;
  const float* KV = (const float*)(p.ws + OFF_KV);
  const float* rope = (const float*)(p.ws + OFF_ROPE);
  unsigned short* Kb = (unsigned short*)(p.ws + OFF_KB);
  unsigned short* Vt = (unsigned short*)(p.ws + OFF_VT);
  for (int tok = blockIdx.x * NWAVES + wave; tok < NT; tok += gridDim.x * NWAVES) {
    const int b = tok / T, t = tok - b * T;
    const float* row = KV + (size_t)tok * 1024;
    const float cs = rope[t * 64 + (lane & 31)], sn = rope[t * 64 + 32 + (lane & 31)];
    const float kw = p.k_norm_w[lane];
#pragma unroll
    for (int hh = 0; hh < 8; ++hh) {
      float v = row[hh * 64 + lane];
      float ss = wave_sum(v * v);
      v = v * rsqrtf(ss * (1.f / 64.f) + 1e-6f) * kw;
      v = rope_apply(v, cs, sn, lane);
      Kb[(size_t)tok * 512 + hh * 64 + lane] = f2bf(v);
      float vv = row[512 + hh * 64 + lane];
      Vt[(((size_t)b * 8 + hh) * 64 + lane) * T + t] = f2bf(vv);
    }
  }
}

constexpr int KS_STRIDE = 129, AM_STRIDE = 65;
DI void phase_chunkprep(const Params& p, char* smem) {
  float* Ks = (float*)smem;
  float* Qs = Ks + 64 * KS_STRIDE;
  float* Am = Qs + 64 * KS_STRIDE;
  float* Tm = Am + 64 * AM_STRIDE;
  float* gc = Tm + 64 * AM_STRIDE;
  float* bet = gc + 64;
  float* gl = bet + 64;
  const int tid = threadIdx.x;
  const float* Qd = (const float*)(p.ws + OFF_QD);
  const float* Kd = (const float*)(p.ws + OFF_KD);
  const float* Vd = (const float*)(p.ws + OFF_VD);
  const float* BETA = (const float*)(p.ws + OFF_BETA);
  const float* G = (const float*)(p.ws + OFF_G);
  unsigned short* WN = (unsigned short*)(p.ws + OFF_WN);
  float* UU = (float*)(p.ws + OFF_UU);
  unsigned short* QG = (unsigned short*)(p.ws + OFF_QG);
  unsigned short* INm = (unsigned short*)(p.ws + OFF_IN);
  unsigned short* KDT = (unsigned short*)(p.ws + OFF_KDT);
  float* DL = (float*)(p.ws + OFF_DL);
  for (int ci = blockIdx.x; ci < NCHT; ci += gridDim.x) {
    const int bh = ci / NCH, c = ci - bh * NCH, b = bh >> 2, h = bh & 3;
    __syncthreads();
    for (int idx = tid; idx < 64 * 128; idx += NTHREADS) {
      int i = idx >> 7, d = idx & 127;
      int t = c * 64 + i - 48;
      float kv = 0.f, qv = 0.f;
      if (t >= 0) {
        size_t o = ((size_t)(b * T + t)) * 512 + h * 128 + d;
        kv = Kd[o];
        qv = Qd[o] * 0.08838834764831845f;
      }
      Ks[i * KS_STRIDE + d] = kv;
      Qs[i * KS_STRIDE + d] = qv;
    }
    if (tid < 64) {
      int t = c * 64 + tid - 48;
      float g = 0.f, be = 0.f;
      if (t >= 0) { g = G[(size_t)(b * T + t) * 4 + h]; be = BETA[(size_t)(b * T + t) * 4 + h]; }
      gl[tid] = g;
      bet[tid] = be;
    }
    __syncthreads();
    if (tid < 64) {
      float s = 0.f;
      for (int j = 0; j <= tid; ++j) s += gl[j];
      gc[tid] = s;
    }
    __syncthreads();
    {
      const int i = tid >> 3, jb = tid & 7;
      float akk[8], aqk[8];
#pragma unroll
      for (int jj = 0; jj < 8; ++jj) { akk[jj] = 0.f; aqk[jj] = 0.f; }
      for (int d = 0; d < 128; ++d) {
        float ki = Ks[i * KS_STRIDE + d], qi = Qs[i * KS_STRIDE + d];
#pragma unroll
        for (int jj = 0; jj < 8; ++jj) {
          float kj = Ks[(jb + 8 * jj) * KS_STRIDE + d];
          akk[jj] += ki * kj;
          aqk[jj] += qi * kj;
        }
      }
      const float gi = gc[i], bi = bet[i];
#pragma unroll
      for (int jj = 0; jj < 8; ++jj) {
        int j = jb + 8 * jj;
        float dec = (j <= i) ? __expf(gi - gc[j]) : 0.f;
        Am[i * AM_STRIDE + j] = (j < i) ? bi * akk[jj] * dec : 0.f;
        INm[(size_t)ci * 4096 + i * 64 + j] = f2bf((j <= i) ? aqk[jj] * dec : 0.f);
      }
    }
    __syncthreads();
    if (tid < 64) {
      const int cc = tid;
      for (int i = 0; i < 64; ++i) {
        float a = (i == cc) ? 1.f : 0.f;
        for (int j = 0; j < i; ++j) a -= Am[i * AM_STRIDE + j] * Tm[j * AM_STRIDE + cc];
        Tm[i * AM_STRIDE + cc] = a;
      }
    }
    __syncthreads();
    {
      const int e = tid & 127, rq = tid >> 7;
      float au[16], aw[16];
#pragma unroll
      for (int ii = 0; ii < 16; ++ii) { au[ii] = 0.f; aw[ii] = 0.f; }
      const int jmax = rq * 16 + 15;
      for (int j = 0; j <= jmax; ++j) {
        int t = c * 64 + j - 48;
        float bj = bet[j];
        float vb = (t >= 0) ? bj * Vd[((size_t)(b * T + t)) * 512 + h * 128 + e] : 0.f;
        float kb = bj * __expf(gc[j]) * Ks[j * KS_STRIDE + e];
#pragma unroll
        for (int ii = 0; ii < 16; ++ii) {
          float tij = Tm[(rq * 16 + ii) * AM_STRIDE + j];
          au[ii] += tij * vb;
          aw[ii] += tij * kb;
        }
      }
#pragma unroll
      for (int ii = 0; ii < 16; ++ii) {
        int i = rq * 16 + ii;
        UU[(size_t)ci * 8192 + i * 128 + e] = au[ii];
        WN[(size_t)ci * 8192 + i * 128 + e] = f2bf(-aw[ii]);
      }
    }
    const float glast = gc[63];
    for (int idx = tid; idx < 64 * 128; idx += NTHREADS) {
      int i = idx >> 7, d = idx & 127;
      QG[(size_t)ci * 8192 + i * 128 + d] = f2bf(Qs[i * KS_STRIDE + d] * __expf(gc[i]));
    }
    for (int idx = tid; idx < 64 * 128; idx += NTHREADS) {
      int i = idx & 63, d = idx >> 6;
      KDT[(size_t)ci * 8192 + d * 64 + i] = f2bf(Ks[i * KS_STRIDE + d] * __expf(glast - gc[i]));
    }
    if (tid == 0) DL[ci] = __expf(glast);
  }
}

DI unsigned ordkey(float f) {
  unsigned u = __float_as_uint(f);
  return (u & 0x80000000u) ? ~u : (u | 0x80000000u);
}
DI int half_sum(int v) {
#pragma unroll
  for (int o = 16; o >= 1; o >>= 1) v += __shfl_xor(v, o);
  return v;
}
DI void indexer_task(const Params& p, int b, int q0, int lane) {
  unsigned* MASK = (unsigned*)(p.ws + OFF_MASK);
  const int qsel = lane >> 5;
  const int tq = q0 + qsel;
  unsigned* mrow = MASK + ((size_t)b * SEQ + tq) * 128;
  if (q0 + 1 < 256) {
    for (int i = (lane & 31); i < 128; i += 32) {
      int rem = tq + 1 - 32 * i;
      unsigned w = (rem >= 32) ? 0xffffffffu : (rem > 0 ? ((1u << rem) - 1u) : 0u);
      mrow[i] = w;
    }
    return;
  }
  const unsigned short* QI = (const unsigned short*)(p.ws + OFF_QI);
  const unsigned short* KI = (const unsigned short*)(p.ws + OFF_KI);
  const float* WI = (const float*)(p.ws + OFF_WI);
  const int l15 = lane & 15, lg = lane >> 4;
  const size_t qtok = (size_t)b * T + NM + q0 + (l15 >> 3);
  const bf16x8 a0 = ld16(QI + qtok * 512 + (l15 & 7) * 64 + 8 * lg);
  const bf16x8 a1 = ld16(QI + qtok * 512 + (l15 & 7) * 64 + 32 + 8 * lg);
  float w[4];
  {
    const size_t wtok = (size_t)b * T + NM + q0 + (lg >> 1);
#pragma unroll
    for (int r = 0; r < 4; ++r) w[r] = WI[wtok * 8 + 4 * (lg & 1) + r];
  }
  const int npairs = (q0 + 2 + 31) >> 5;
  const unsigned short* kp = KI + ((size_t)b * T + NM) * 64 + (size_t)l15 * 64 + 8 * lg;
  unsigned u[128];
  int rem = tq - (lane & 31);
#pragma unroll
  for (int i = 0; i < 128; ++i) {
    unsigned uv = 0u;
    if (i < npairs) {
      float tot[2];
#pragma unroll
      for (int par = 0; par < 2; ++par) {
        const bf16x8 b0 = ld16(kp + par * 1024);
        const bf16x8 b1 = ld16(kp + par * 1024 + 32);
        f32x4 acc = {0.f, 0.f, 0.f, 0.f};
        acc = MFMA16(a0, b0, acc);
        acc = MFMA16(a1, b1, acc);
        float part = 0.f;
#pragma unroll
        for (int r = 0; r < 4; ++r) part += w[r] * fmaxf(acc[r], 0.f);
        tot[par] = part + __shfl_xor(part, 16);
      }
      const float sc = (lg & 1) ? tot[1] : tot[0];
      uv = (rem >= 0) ? ordkey(sc) : 0u;
    }
    u[i] = uv;
    kp += 2048;
    rem -= 32;
    asm volatile("" : "+v"(kp), "+v"(rem));
  }
  unsigned thr = 0u;
  for (int bit = 31; bit >= 0; --bit) {
    const unsigned cand = thr | (1u << bit);
    int cnt = 0;
#pragma unroll
    for (int i = 0; i < 128; ++i) cnt += (u[i] >= cand) ? 1 : 0;
    cnt = half_sum(cnt);
    if (cnt >= 256) thr = cand;
  }
  int cgt = 0;
#pragma unroll
  for (int i = 0; i < 128; ++i) cgt += (u[i] > thr) ? 1 : 0;
  cgt = half_sum(cgt);
  const int need = 256 - cgt;
  int base = 0;
  const unsigned lt_mask = (1u << (lane & 31)) - 1u;
#pragma unroll
  for (int i = 0; i < 128; ++i) {
    const bool eq = (u[i] == thr);
    const unsigned long long eb = __ballot(eq);
    const unsigned ehalf = qsel ? (unsigned)(eb >> 32) : (unsigned)eb;
    const int below = __popc(ehalf & lt_mask);
    const bool sel = (u[i] > thr) || (eq && (base + below < need));
    base += __popc(ehalf);
    const unsigned long long sb = __ballot(sel);
    const unsigned shalf = qsel ? (unsigned)(sb >> 32) : (unsigned)sb;
    if ((lane & 31) == 0) mrow[i] = shalf;
  }
}
DI void phase_indexer(const Params& p) {
  const int lane = threadIdx.x & 63, wave = threadIdx.x >> 6;
  const int ntask = NB * (SEQ / 2);
  for (int k = blockIdx.x * NWAVES + wave; k < ntask; k += gridDim.x * NWAVES) {
    const int b = k & 3, qp = (SEQ / 2 - 1) - (k >> 2);
    indexer_task(p, b, qp * 2, lane);
  }
}

DI void attn_task(const Params& p, int b, int hh, int qt, int lane) {
  const unsigned short* Qb = (const unsigned short*)(p.ws + OFF_QB);
  const unsigned short* Kb = (const unsigned short*)(p.ws + OFF_KB);
  const unsigned short* Vt = (const unsigned short*)(p.ws + OFF_VT);
  const unsigned* MASK = (const unsigned*)(p.ws + OFF_MASK);
  unsigned short* MIX = (unsigned short*)(p.ws + OFF_MIX);
  const int lr = lane & 31, lh = lane >> 5;
  const int tq = qt * 32 + lr;
  const size_t qtok = (size_t)b * T + NM + tq;
  bf16x8 qf[4];
#pragma unroll
  for (int ks = 0; ks < 4; ++ks) qf[ks] = ld16(Qb + qtok * 512 + hh * 64 + ks * 16 + 8 * lh);
  const unsigned* mrow = MASK + ((size_t)b * SEQ + tq) * 128;
  const unsigned short* vbase = Vt + ((size_t)b * 8 + hh) * 64 * T;
  f32x16 o[2];
#pragma unroll
  for (int i = 0; i < 2; ++i)
#pragma unroll
    for (int r = 0; r < 16; ++r) o[i][r] = 0.f;
  float m = -1e30f, lsum = 0.f;
  const float scale = 0.125f;
  for (int tile = -1; tile <= qt; ++tile) {
    const int base = (tile < 0) ? 0 : (NM + 32 * tile);
    const unsigned word = (tile < 0) ? 0x0000ffffu : mrow[tile];
    f32x16 s;
#pragma unroll
    for (int r = 0; r < 16; ++r) s[r] = 0.f;
    const size_t ktok = (size_t)b * T + base + lr;
#pragma unroll
    for (int ks = 0; ks < 4; ++ks) {
      bf16x8 kf = ld16(Kb + ktok * 512 + hh * 64 + ks * 16 + 8 * lh);
      s = MFMA32(kf, qf[ks], s);
    }
    float tmax = -1e30f;
#pragma unroll
    for (int r = 0; r < 16; ++r) {
      const bool valid = (word >> crow(r, lh)) & 1u;
      s[r] = valid ? s[r] * scale : -1e30f;
      tmax = fmaxf(tmax, s[r]);
    }
    tmax = fmaxf(tmax, __shfl_xor(tmax, 32));
    const float mnew = fmaxf(m, tmax);
    const float alpha = __expf(m - mnew);
    float psum = 0.f;
#pragma unroll
    for (int r = 0; r < 16; ++r) {
      const bool valid = (word >> crow(r, lh)) & 1u;
      const float pv = valid ? __expf(s[r] - mnew) : 0.f;
      s[r] = pv;
      psum += pv;
    }
    psum += __shfl_xor(psum, 32);
    lsum = lsum * alpha + psum;
    m = mnew;
#pragma unroll
    for (int i = 0; i < 2; ++i)
#pragma unroll
      for (int r = 0; r < 16; ++r) o[i][r] *= alpha;
#pragma unroll
    for (int ss = 0; ss < 2; ++ss) {
      const bf16x8 pf = pack8(s, ss);
#pragma unroll
      for (int dt = 0; dt < 2; ++dt) {
        const unsigned short* vp = vbase + (size_t)(dt * 32 + lr) * T + base + 16 * ss + 4 * lh;
        const bf16x8 vf = ld8x2(vp, vp + 8);
        o[dt] = MFMA32(vf, pf, o[dt]);
      }
    }
  }
  const float inv = 1.f / lsum;
#pragma unroll
  for (int dt = 0; dt < 2; ++dt)
#pragma unroll
    for (int r = 0; r < 16; ++r) MIX[qtok * 1024 + hh * 64 + dt * 32 + crow(r, lh)] = f2bf(o[dt][r] * inv);
}
DI void phase_attn(const Params& p) {
  const int lane = threadIdx.x & 63, wave = threadIdx.x >> 6;
  const int ntask = NB * 8 * 128;
  for (int k = blockIdx.x * NWAVES + wave; k < ntask; k += gridDim.x * NWAVES) {
    const int bh = k & 31, qt = 127 - (k >> 5);
    attn_task(p, bh >> 3, bh & 7, qt, lane);
  }
}

DI void scan_task(const Params& p, int b, int h, int sl, int lane) {
  const unsigned short* WN = (const unsigned short*)(p.ws + OFF_WN);
  const float* UU = (const float*)(p.ws + OFF_UU);
  const unsigned short* QG = (const unsigned short*)(p.ws + OFF_QG);
  const unsigned short* INm = (const unsigned short*)(p.ws + OFF_IN);
  const unsigned short* KDT = (const unsigned short*)(p.ws + OFF_KDT);
  const float* DL = (const float*)(p.ws + OFF_DL);
  float* OD = (float*)(p.ws + OFF_OD);
  const int lr = lane & 31, lh = lane >> 5, e0 = sl * 32;
  f32x16 S[4];
#pragma unroll
  for (int i = 0; i < 4; ++i)
#pragma unroll
    for (int r = 0; r < 16; ++r) S[i][r] = 0.f;
  for (int c = 0; c < NCH; ++c) {
    const size_t ci = (size_t)(b * 4 + h) * NCH + c;
    const unsigned short* wn = WN + ci * 8192;
    const unsigned short* qg = QG + ci * 8192;
    const unsigned short* in = INm + ci * 4096;
    const unsigned short* kdt = KDT + ci * 8192;
    const float* uu = UU + ci * 8192;
    bf16x8 sb[4][2];
#pragma unroll
    for (int mt = 0; mt < 4; ++mt)
#pragma unroll
      for (int s = 0; s < 2; ++s) sb[mt][s] = pack8(S[mt], s);
    f32x16 vn[2];
#pragma unroll
    for (int pt = 0; pt < 2; ++pt) {
#pragma unroll
      for (int r = 0; r < 16; ++r) vn[pt][r] = uu[(pt * 32 + crow(r, lh)) * 128 + e0 + lr];
#pragma unroll
      for (int mt = 0; mt < 4; ++mt)
#pragma unroll
        for (int s = 0; s < 2; ++s) {
          const unsigned short* ap = wn + (pt * 32 + lr) * 128 + mt * 32 + 16 * s + 4 * lh;
          vn[pt] = MFMA32(ld8x2(ap, ap + 8), sb[mt][s], vn[pt]);
        }
    }
    bf16x8 vb[2][2];
#pragma unroll
    for (int pt = 0; pt < 2; ++pt)
#pragma unroll
      for (int s = 0; s < 2; ++s) vb[pt][s] = pack8(vn[pt], s);
#pragma unroll
    for (int pt = 0; pt < 2; ++pt) {
      f32x16 o;
#pragma unroll
      for (int r = 0; r < 16; ++r) o[r] = 0.f;
#pragma unroll
      for (int mt = 0; mt < 4; ++mt)
#pragma unroll
        for (int s = 0; s < 2; ++s) {
          const unsigned short* ap = qg + (pt * 32 + lr) * 128 + mt * 32 + 16 * s + 4 * lh;
          o = MFMA32(ld8x2(ap, ap + 8), sb[mt][s], o);
        }
#pragma unroll
      for (int pt2 = 0; pt2 <= pt; ++pt2)
#pragma unroll
        for (int s = 0; s < 2; ++s) {
          const unsigned short* ap = in + (pt * 32 + lr) * 64 + pt2 * 32 + 16 * s + 4 * lh;
          o = MFMA32(ld8x2(ap, ap + 8), vb[pt2][s], o);
        }
#pragma unroll
      for (int r = 0; r < 16; ++r) {
        const int t = c * 64 + pt * 32 + crow(r, lh) - 48;
        if (t >= 0) OD[((size_t)(b * T + t)) * 512 + h * 128 + e0 + lr] = o[r];
      }
    }
    const float dl = DL[ci];
#pragma unroll
    for (int mt = 0; mt < 4; ++mt) {
#pragma unroll
      for (int r = 0; r < 16; ++r) S[mt][r] *= dl;
#pragma unroll
      for (int pt2 = 0; pt2 < 2; ++pt2)
#pragma unroll
        for (int s = 0; s < 2; ++s) {
          const unsigned short* ap = kdt + (mt * 32 + lr) * 64 + pt2 * 32 + 16 * s + 4 * lh;
          S[mt] = MFMA32(ld8x2(ap, ap + 8), vb[pt2][s], S[mt]);
        }
    }
  }
}
DI void phase_scan(const Params& p) {
  const int lane = threadIdx.x & 63, wave = threadIdx.x >> 6;
  if (wave != 0) return;
  for (int k = blockIdx.x; k < 64; k += gridDim.x) scan_task(p, k >> 4, (k >> 2) & 3, k & 3, lane);
}

DI void phase_gnorm(const Params& p) {
  const int tid = threadIdx.x, lane = tid & 63, wave = tid >> 6;
  const float* OD = (const float*)(p.ws + OFF_OD);
  const float* P = (const float*)(p.ws + OFF_P);
  unsigned short* MIX = (unsigned short*)(p.ws + OFF_MIX);
  for (int r = blockIdx.x * NWAVES + wave; r < NR; r += gridDim.x * NWAVES) {
    const int tok = r + 16 * (r / SEQ + 1);
#pragma unroll
    for (int hd = 0; hd < 4; ++hd) {
      float o0 = OD[(size_t)tok * 512 + hd * 128 + lane], o1 = OD[(size_t)tok * 512 + hd * 128 + 64 + lane];
      float ss = wave_sum(o0 * o0 + o1 * o1);
      float rstd = rsqrtf(ss * (1.f / 128.f) + 1e-6f);
      float z0 = P[(size_t)tok * INC + C_BZ + hd * 128 + lane], z1 = P[(size_t)tok * INC + C_BZ + hd * 128 + 64 + lane];
      float y0 = o0 * rstd * p.delta_norm_w[lane] * (z0 / (1.f + __expf(-z0)));
      float y1 = o1 * rstd * p.delta_norm_w[64 + lane] * (z1 / (1.f + __expf(-z1)));
      MIX[(size_t)tok * 1024 + 512 + hd * 128 + lane] = f2bf(y0);
      MIX[(size_t)tok * 1024 + 512 + hd * 128 + 64 + lane] = f2bf(y1);
    }
  }
}

DI void phase_router(const Params& p, char* smem) {
  const int tid = threadIdx.x, lane = tid & 63, wave = tid >> 6;
  float* us = (float*)smem + wave * 1024;
  const float* H1 = (const float*)(p.ws + OFF_H1);
  unsigned short* U2 = (unsigned short*)(p.ws + OFF_U2);
  int* TOPE = (int*)(p.ws + OFF_TOPE);
  float* GATEV = (float*)(p.ws + OFF_GATEV);
  int* POS = (int*)(p.ws + OFF_POS);
  int* CNT = (int*)(p.ws + OFF_CNT);
  for (int r = blockIdx.x * NWAVES + wave; r < NR; r += gridDim.x * NWAVES) {
    const float* src = H1 + (size_t)r * 1024;
    float4 v[4];
    float ss = 0.f;
#pragma unroll
    for (int i = 0; i < 4; ++i) {
      v[i] = *(const float4*)(src + lane * 4 + 256 * i);
      ss += v[i].x * v[i].x + v[i].y * v[i].y + v[i].z * v[i].z + v[i].w * v[i].w;
    }
    ss = wave_sum(ss);
    const float rstd = rsqrtf(ss * (1.f / 1024.f) + 1e-6f);
#pragma unroll
    for (int i = 0; i < 4; ++i) {
      float4 w = *(const float4*)(p.norm_ffn_w + lane * 4 + 256 * i);
      float4 u = make_float4(v[i].x * rstd * w.x, v[i].y * rstd * w.y, v[i].z * rstd * w.z, v[i].w * rstd * w.w);
      *(float4*)(us + lane * 4 + 256 * i) = u;
      uint2 o;
      o.x = pk2(u.x, u.y);
      o.y = pk2(u.z, u.w);
      *(uint2*)(U2 + (size_t)r * 1024 + lane * 4 + 256 * i) = o;
    }
    __builtin_amdgcn_s_waitcnt(0xc07f);
    __builtin_amdgcn_wave_barrier();
    const int e = lane & 31, half = lane >> 5;
    float acc = 0.f;
    for (int k = half * 512; k < half * 512 + 512; ++k) acc += us[k] * p.w_router[k * 32 + e];
    acc += __shfl_xor(acc, 32);
    float logit = acc + p.b_router[e];
    float tv[4];
    int te[4];
#pragma unroll
    for (int k = 0; k < 4; ++k) {
      float bv = logit;
      int bi = e;
#pragma unroll
      for (int o = 16; o >= 1; o >>= 1) {
        float ov = __shfl_xor(bv, o);
        int oi = __shfl_xor(bi, o);
        if (ov > bv || (ov == bv && oi < bi)) { bv = ov; bi = oi; }
      }
      tv[k] = bv;
      te[k] = bi;
      if (e == bi) logit = -3.0e38f;
    }
    float e1 = __expf(tv[1] - tv[0]), e2 = __expf(tv[2] - tv[0]), e3 = __expf(tv[3] - tv[0]);
    float inv = 1.f / (1.f + e1 + e2 + e3);
    if (lane < 4) {
      float gk = (lane == 0) ? inv : (lane == 1) ? e1 * inv : (lane == 2) ? e2 * inv : e3 * inv;
      int ek = (lane == 0) ? te[0] : (lane == 1) ? te[1] : (lane == 2) ? te[2] : te[3];
      TOPE[(size_t)r * 4 + lane] = ek;
      GATEV[(size_t)r * 4 + lane] = gk;
      POS[(size_t)r * 4 + lane] = atomicAdd(&CNT[ek], 1);
    }
    __builtin_amdgcn_wave_barrier();
  }
}
DI void phase_lists(const Params& p) {
  const int* CNT = (const int*)(p.ws + OFF_CNT);
  const int* TOPE = (const int*)(p.ws + OFF_TOPE);
  const float* GATEV = (const float*)(p.ws + OFF_GATEV);
  const int* POS = (const int*)(p.ws + OFF_POS);
  int* SLOT = (int*)(p.ws + OFF_SLOT);
  int* LTOK = (int*)(p.ws + OFF_LTOK);
  float* LGATE = (float*)(p.ws + OFF_LGATE);
  for (int a = blockIdx.x * NTHREADS + threadIdx.x; a < NASG; a += gridDim.x * NTHREADS) {
    const int e = TOPE[a];
    int off = 0;
    for (int j = 0; j < e; ++j) off += CNT[j];
    const int slot = off + POS[a];
    SLOT[a] = slot;
    LTOK[slot] = a >> 2;
    LGATE[slot] = GATEV[a];
  }
}
DI void phase_combine(const Params& p) {
  const float* H1 = (const float*)(p.ws + OFF_H1);
  const unsigned short* Y = (const unsigned short*)(p.ws + OFF_Y);
  const int* SLOT = (const int*)(p.ws + OFF_SLOT);
  for (int idx = blockIdx.x * NTHREADS + threadIdx.x; idx < NR * 256; idx += gridDim.x * NTHREADS) {
    const int r = idx >> 8, c4 = (idx & 255) * 4;
    float4 a = *(const float4*)(H1 + (size_t)r * 1024 + c4);
#pragma unroll
    for (int k = 0; k < 4; ++k) {
      const int slot = SLOT[r * 4 + k];
      uint2 y = *(const uint2*)(Y + (size_t)slot * 1024 + c4);
      a.x += bf2f((unsigned short)(y.x & 0xffffu));
      a.y += bf2f((unsigned short)(y.x >> 16));
      a.z += bf2f((unsigned short)(y.y & 0xffffu));
      a.w += bf2f((unsigned short)(y.y >> 16));
    }
    *(float4*)(p.out + (size_t)r * 1024 + c4) = a;
  }
}

constexpr int SMEM_BYTES = (64 * KS_STRIDE * 2 + 64 * AM_STRIDE * 2 + 192) * 4;

__global__ void __launch_bounds__(NTHREADS) mk0(Params p) {
  phase_prep(p);
}
__global__ void __launch_bounds__(NTHREADS) mk1(Params p) {
  __shared__ __attribute__((aligned(16))) char smem[SMEM_BYTES];
  phase_gemm_inproj(p, smem);
}
__global__ void __launch_bounds__(NTHREADS) mk2(Params p) {
  phase_post1(p);
}
__global__ void __launch_bounds__(NTHREADS) mk3(Params p) {
  __shared__ __attribute__((aligned(16))) char smem[SMEM_BYTES];
  phase_gemm_kvup(p, smem);
}
__global__ void __launch_bounds__(NTHREADS) mk4(Params p) {
  phase_post2(p);
}
__global__ void __launch_bounds__(NTHREADS) mk5(Params p) {
  __shared__ __attribute__((aligned(16))) char smem[SMEM_BYTES];
  phase_chunkprep(p, smem);
}
__global__ void __launch_bounds__(NTHREADS) mk6(Params p) {
  phase_indexer(p);
}
__global__ void __launch_bounds__(NTHREADS) mk7(Params p) {
  phase_attn(p);
}
__global__ void __launch_bounds__(NTHREADS) mk8(Params p) {
  phase_scan(p);
}
__global__ void __launch_bounds__(NTHREADS) mk9(Params p) {
  phase_gnorm(p);
}
__global__ void __launch_bounds__(NTHREADS) mk10(Params p) {
  __shared__ __attribute__((aligned(16))) char smem[SMEM_BYTES];
  phase_gemm_outproj(p, smem);
}
__global__ void __launch_bounds__(NTHREADS) mk11(Params p) {
  __shared__ __attribute__((aligned(16))) char smem[SMEM_BYTES];
  phase_router(p, smem);
}
__global__ void __launch_bounds__(NTHREADS) mk12(Params p) {
  phase_lists(p);
}
__global__ void __launch_bounds__(NTHREADS) mk13(Params p) {
  __shared__ __attribute__((aligned(16))) char smem[SMEM_BYTES];
  phase_gemm_moe<2>(p, smem);
}
__global__ void __launch_bounds__(NTHREADS) mk14(Params p) {
  __shared__ __attribute__((aligned(16))) char smem[SMEM_BYTES];
  phase_gemm_moe<3>(p, smem);
}
__global__ void __launch_bounds__(NTHREADS) mk15(Params p) {
  phase_combine(p);
}

extern "C" void kernel_launch(void* const* d_in, const int* in_sizes, int n_in, void* d_out, int out_size, void* d_ws,
                              size_t ws_size, hipStream_t stream) {
  (void)in_sizes; (void)n_in; (void)out_size;
  if (ws_size < WS_NEED) return;
  Params p{};
  p.x = (const float*)d_in[0]; p.meta = (const float*)d_in[1]; p.norm_mix_w = (const float*)d_in[2];
  p.w_in = (const float*)d_in[3]; p.q_norm_w = (const float*)d_in[4]; p.k_norm_w = (const float*)d_in[5];
  p.kv_norm_w = (const float*)d_in[6]; p.w_kv_up = (const float*)d_in[7]; p.conv_w = (const float*)d_in[8];
  p.a_log = (const float*)d_in[9]; p.dt_bias = (const float*)d_in[10]; p.delta_norm_w = (const float*)d_in[11];
  p.w_out = (const float*)d_in[12]; p.norm_ffn_w = (const float*)d_in[13]; p.w_router = (const float*)d_in[14];
  p.b_router = (const float*)d_in[15]; p.w_gate_up = (const float*)d_in[16]; p.b_gate_up = (const float*)d_in[17];
  p.w_down = (const float*)d_in[18]; p.b_down = (const float*)d_in[19];
  p.out = (float*)d_out;
  p.ws = (char*)d_ws;
  (void)hipMemsetAsync((char*)d_ws + OFF_CNT, 0, 4096, stream);
  mk0<<<dim3(256), dim3(NTHREADS), 0, stream>>>(p);
  mk1<<<dim3(256), dim3(NTHREADS), 0, stream>>>(p);
  mk2<<<dim3(256), dim3(NTHREADS), 0, stream>>>(p);
  mk3<<<dim3(256), dim3(NTHREADS), 0, stream>>>(p);
  mk4<<<dim3(256), dim3(NTHREADS), 0, stream>>>(p);
  mk5<<<dim3(256), dim3(NTHREADS), 0, stream>>>(p);
  mk6<<<dim3(256), dim3(NTHREADS), 0, stream>>>(p);
  mk7<<<dim3(256), dim3(NTHREADS), 0, stream>>>(p);
  mk8<<<dim3(256), dim3(NTHREADS), 0, stream>>>(p);
  mk9<<<dim3(256), dim3(NTHREADS), 0, stream>>>(p);
  mk10<<<dim3(256), dim3(NTHREADS), 0, stream>>>(p);
  mk11<<<dim3(256), dim3(NTHREADS), 0, stream>>>(p);
  mk12<<<dim3(256), dim3(NTHREADS), 0, stream>>>(p);
  mk13<<<dim3(256), dim3(NTHREADS), 0, stream>>>(p);
  mk14<<<dim3(256), dim3(NTHREADS), 0, stream>>>(p);
  mk15<<<dim3(256), dim3(NTHREADS), 0, stream>>>(p);
}
```

```cpp
#include <hip/hip_runtime.h>
#include <hip/hip_cooperative_groups.h>
#include <stdint.h>
#include <stdio.h>
namespace cg = cooperative_groups;

typedef __attribute__((ext_vector_type(8))) short bf16x8;
typedef __attribute__((ext_vector_type(4))) short s16x4;
typedef __attribute__((ext_vector_type(16))) float f32x16;
typedef __attribute__((ext_vector_type(4))) float f32x4;
typedef __bf16 bf2_t __attribute__((ext_vector_type(2)));
#define DI __device__ __forceinline__
#define MFMA32(a, b, c) __builtin_amdgcn_mfma_f32_32x32x16_bf16((a), (b), (c), 0, 0, 0)
#define MFMA16(a, b, c) __builtin_amdgcn_mfma_f32_16x16x32_bf16((a), (b), (c), 0, 0, 0)

constexpr int NB = 4, SEQ = 4096, NM = 16, T = 4112, NT = NB * T, NR = NB * SEQ, D = 1024, INC = 3408;
constexpr int C_AQ = 0, C_CKV = 512, C_IQ = 768, C_IK = 1280, C_IW = 1344, C_BQKV = 1352, C_BZ = 2888, C_BBETA = 3400, C_BA = 3404;
constexpr int NCH = 65, NCHT = NB * 4 * NCH;
constexpr int NEXP = 32, NASG = NR * 4;
constexpr int NTHREADS = 512, NWAVES = 8;

constexpr size_t al256(size_t x) { return (x + 255) & ~(size_t)255; }
constexpr size_t OFF_U = 0;
constexpr size_t OFF_P = OFF_U + al256((size_t)NT * 1024 * 2);
constexpr size_t OFF_ROPE = OFF_P + al256((size_t)NT * INC * 4);
constexpr size_t OFF_QB = OFF_ROPE + al256((size_t)T * 64 * 4);
constexpr size_t OFF_KB = OFF_QB + al256((size_t)NT * 512 * 2);
constexpr size_t OFF_VT = OFF_KB + al256((size_t)NT * 512 * 2);
constexpr size_t OFF_QI = OFF_VT + al256((size_t)NT * 512 * 2);
constexpr size_t OFF_KI = OFF_QI + al256((size_t)NT * 512 * 2);
constexpr size_t OFF_WI = OFF_KI + al256((size_t)NT * 64 * 2);
constexpr size_t OFF_CKV = OFF_WI + al256((size_t)NT * 8 * 4);
constexpr size_t OFF_KV = OFF_CKV + al256((size_t)NT * 256 * 2);
constexpr size_t OFF_MASK = OFF_KV + al256((size_t)NT * 1024 * 4);
constexpr size_t OFF_MIX = OFF_MASK + al256((size_t)NB * SEQ * 128 * 4);
constexpr size_t OFF_QD = OFF_MIX + al256((size_t)NT * 1024 * 2);
constexpr size_t OFF_KD = OFF_QD + al256((size_t)NT * 512 * 4);
constexpr size_t OFF_VD = OFF_KD + al256((size_t)NT * 512 * 4);
constexpr size_t OFF_BETA = OFF_VD + al256((size_t)NT * 512 * 4);
constexpr size_t OFF_G = OFF_BETA + al256((size_t)NT * 4 * 4);
constexpr size_t OFF_WN = OFF_G + al256((size_t)NT * 4 * 4);
constexpr size_t OFF_UU = OFF_WN + al256((size_t)NCHT * 64 * 128 * 2);
constexpr size_t OFF_QG = OFF_UU + al256((size_t)NCHT * 64 * 128 * 4);
constexpr size_t OFF_IN = OFF_QG + al256((size_t)NCHT * 64 * 128 * 2);
constexpr size_t OFF_KDT = OFF_IN + al256((size_t)NCHT * 64 * 64 * 2);
constexpr size_t OFF_DL = OFF_KDT + al256((size_t)NCHT * 64 * 128 * 2);
constexpr size_t OFF_OD = OFF_DL + al256((size_t)NCHT * 4);
constexpr size_t OFF_U2 = OFF_OD + al256((size_t)NT * 512 * 4);
constexpr size_t OFF_TOPE = OFF_U2 + al256((size_t)NR * 1024 * 2);
constexpr size_t OFF_GATEV = OFF_TOPE + al256((size_t)NR * 4 * 4);
constexpr size_t OFF_POS = OFF_GATEV + al256((size_t)NR * 4 * 4);
constexpr size_t OFF_SLOT = OFF_POS + al256((size_t)NR * 4 * 4);
constexpr size_t OFF_LTOK = OFF_SLOT + al256((size_t)NR * 4 * 4);
constexpr size_t OFF_LGATE = OFF_LTOK + al256((size_t)NASG * 4);
constexpr size_t OFF_Y = OFF_LGATE + al256((size_t)NASG * 4);
constexpr size_t OFF_CNT = OFF_Y + al256((size_t)NASG * 1024 * 2);
constexpr size_t WS_NEED = OFF_CNT + 4096;
constexpr size_t OFF_H1 = OFF_KV;
constexpr size_t OFF_HD = OFF_P;

struct Params {
  const float *x, *meta, *norm_mix_w, *w_in, *q_norm_w, *k_norm_w, *kv_norm_w, *w_kv_up, *conv_w, *a_log, *dt_bias,
      *delta_norm_w, *w_out, *norm_ffn_w, *w_router, *b_router, *w_gate_up, *b_gate_up, *w_down, *b_down;
  float* out;
  char* ws;
};

DI unsigned pk2(float a, float b) { bf2_t v; v[0] = (__bf16)a; v[1] = (__bf16)b; return __builtin_bit_cast(unsigned, v); }
DI unsigned short f2bf(float a) { return (unsigned short)(pk2(a, 0.f) & 0xffffu); }
DI float bf2f(unsigned short u) { return __uint_as_float(((unsigned)u) << 16); }
DI float wave_sum(float v) {
#pragma unroll
  for (int o = 32; o >= 1; o >>= 1) v += __shfl_xor(v, o);
  return v;
}
DI int otid() { int t = threadIdx.x; asm volatile("" : "+v"(t)); return t; }
DI int crow(int reg, int h) { return (reg & 3) + 8 * (reg >> 2) + 4 * h; }
DI bf16x8 pack8(const f32x16& x, int s) {
  uint4 p;
  p.x = pk2(x[8 * s + 0], x[8 * s + 1]); p.y = pk2(x[8 * s + 2], x[8 * s + 3]);
  p.z = pk2(x[8 * s + 4], x[8 * s + 5]); p.w = pk2(x[8 * s + 6], x[8 * s + 7]);
  return __builtin_bit_cast(bf16x8, p);
}
DI bf16x8 ld8x2(const unsigned short* p0, const unsigned short* p1) {
  uint2 a = *(const uint2*)p0, b = *(const uint2*)p1;
  uint4 r = make_uint4(a.x, a.y, b.x, b.y);
  return __builtin_bit_cast(bf16x8, r);
}
DI bf16x8 ld16(const unsigned short* p) { uint4 r = *(const uint4*)p; return __builtin_bit_cast(bf16x8, r); }
DI const float* hrow(const Params& p, int tok) {
  int b = tok / T, t = tok - b * T;
  return (t < NM) ? (p.meta + (size_t)t * D) : (p.x + ((size_t)b * SEQ + (t - NM)) * D);
}

DI void phase_prep(const Params& p) {
  const int tid = otid(), lane = tid & 63, wave = tid >> 6;
  float* rope = (float*)(p.ws + OFF_ROPE);
  for (int idx = blockIdx.x * NTHREADS + tid; idx < T * 32; idx += gridDim.x * NTHREADS) {
    int t = idx >> 5, i = idx & 31;
    float inv = (float)pow(10000.0, -(double)i / 32.0);
    float ang = (float)t * inv;
    double ad = (double)ang;
    double n = rint(ad * 0.15915494309189535);
    float r = (float)(ad - n * 6.283185307179586);
    float sn, cs;
    sincosf(r, &sn, &cs);
    rope[t * 64 + i] = cs;
    rope[t * 64 + 32 + i] = sn;
  }
  unsigned short* U = (unsigned short*)(p.ws + OFF_U);
  for (int tok = blockIdx.x * NWAVES + wave; tok < NT; tok += gridDim.x * NWAVES) {
    const float* src = hrow(p, tok);
    float4 v[4];
    float ss = 0.f;
#pragma unroll
    for (int i = 0; i < 4; ++i) {
      v[i] = *(const float4*)(src + lane * 4 + 256 * i);
      ss += v[i].x * v[i].x + v[i].y * v[i].y + v[i].z * v[i].z + v[i].w * v[i].w;
    }
    ss = wave_sum(ss);
    float rstd = rsqrtf(ss * (1.f / 1024.f) + 1e-6f);
#pragma unroll
    for (int i = 0; i < 4; ++i) {
      float4 w = *(const float4*)(p.norm_mix_w + lane * 4 + 256 * i);
      uint2 o;
      o.x = pk2(v[i].x * rstd * w.x, v[i].y * rstd * w.y);
      o.y = pk2(v[i].z * rstd * w.z, v[i].w * rstd * w.w);
      *(uint2*)(U + (size_t)tok * 1024 + lane * 4 + 256 * i) = o;
    }
  }
}

constexpr int GA_STRIDE = 40;
constexpr int G_BM = 128, G_BN = 256, G_BK = 32;

template <int MODE>
DI void gemm_tile(const Params& p, char* smem, const unsigned short* Abase, int lda, int m0, int mend, const float* B, int ldb,
                  int n0, int N, int K, float* C, int ldc, int e, int slot0) {
  unsigned short* As = (unsigned short*)smem;
  unsigned short* Bs = As + G_BM * GA_STRIDE;
  const int tid = otid(), lane = tid & 63, wave = tid >> 6;
  const int wm = wave >> 2, wn = wave & 3, lr = lane & 31, lh = lane >> 5;
  const int arow = tid >> 2, akc = tid & 3;
  int am = m0 + arow;
  if (am > mend - 1) am = mend - 1;
  size_t arowoff;
  if (MODE == 1) arowoff = (size_t)(am + 16 * (am / SEQ + 1)) * lda;
  else if (MODE == 2) arowoff = (size_t)((const int*)(p.ws + OFF_LTOK))[am] * lda;
  else arowoff = (size_t)am * lda;
  const unsigned short* aptr = Abase + arowoff + akc * 8;
  const int nq = tid & 63, kg = tid >> 6;
  const int bn = n0 + nq * 4;
  const bool bvalid = bn < N;
  const float* bptr = B + (size_t)(kg * 4) * ldb + bn;

  f32x16 acc[2][2];
#pragma unroll
  for (int i = 0; i < 2; ++i)
#pragma unroll
    for (int j = 0; j < 2; ++j)
#pragma unroll
      for (int r = 0; r < 16; ++r) acc[i][j][r] = 0.f;

  uint4 areg;
  float4 breg[4];
  areg = *(const uint4*)aptr;
#pragma unroll
  for (int i = 0; i < 4; ++i) breg[i] = bvalid ? *(const float4*)(bptr + (size_t)i * ldb) : make_float4(0.f, 0.f, 0.f, 0.f);

  const int nk = K / G_BK;
  for (int kt = 0; kt < nk; ++kt) {
    __syncthreads();
    *(uint4*)(As + arow * GA_STRIDE + akc * 8) = areg;
    {
      uint2 w0, w1, w2, w3;
      w0.x = pk2(breg[0].x, breg[1].x); w0.y = pk2(breg[2].x, breg[3].x);
      w1.x = pk2(breg[0].y, breg[1].y); w1.y = pk2(breg[2].y, breg[3].y);
      w2.x = pk2(breg[0].z, breg[1].z); w2.y = pk2(breg[2].z, breg[3].z);
      w3.x = pk2(breg[0].w, breg[1].w); w3.y = pk2(breg[2].w, breg[3].w);
      *(uint2*)(Bs + (nq * 4 + 0) * GA_STRIDE + kg * 4) = w0;
      *(uint2*)(Bs + (nq * 4 + 1) * GA_STRIDE + kg * 4) = w1;
      *(uint2*)(Bs + (nq * 4 + 2) * GA_STRIDE + kg * 4) = w2;
      *(uint2*)(Bs + (nq * 4 + 3) * GA_STRIDE + kg * 4) = w3;
    }
    __syncthreads();
    if (kt + 1 < nk) {
      areg = *(const uint4*)(aptr + (size_t)(kt + 1) * G_BK);
#pragma unroll
      for (int i = 0; i < 4; ++i)
        breg[i] = bvalid ? *(const float4*)(bptr + (size_t)((kt + 1) * G_BK + i) * ldb) : make_float4(0.f, 0.f, 0.f, 0.f);
    }
#pragma unroll
    for (int ks = 0; ks < 2; ++ks) {
      bf16x8 af[2], bfr[2];
#pragma unroll
      for (int mt = 0; mt < 2; ++mt) af[mt] = ld16(As + (wm * 64 + mt * 32 + lr) * GA_STRIDE + ks * 16 + 8 * lh);
#pragma unroll
      for (int nt = 0; nt < 2; ++nt) {
        int brow = (MODE == 2) ? (wn * 64 + 2 * lr + nt) : (wn * 64 + nt * 32 + lr);
        bfr[nt] = ld16(Bs + brow * GA_STRIDE + ks * 16 + 8 * lh);
      }
#pragma unroll
      for (int mt = 0; mt < 2; ++mt)
#pragma unroll
        for (int nt = 0; nt < 2; ++nt) acc[mt][nt] = MFMA32(af[mt], bfr[nt], acc[mt][nt]);
    }
  }
  if (MODE == 0 || MODE == 1) {
#pragma unroll
    for (int mt = 0; mt < 2; ++mt)
#pragma unroll
      for (int nt = 0; nt < 2; ++nt) {
        int col = n0 + wn * 64 + nt * 32 + lr;
#pragma unroll
        for (int r = 0; r < 16; ++r) {
          int row = m0 + wm * 64 + mt * 32 + crow(r, lh);
          if (row < mend && col < N) {
            float v = acc[mt][nt][r];
            if (MODE == 1) v += p.x[(size_t)row * D + col];
            C[(size_t)row * ldc + col] = v;
          }
        }
      }
  } else if (MODE == 2) {
    unsigned short* HD = (unsigned short*)(p.ws + OFF_HD);
    const int f = (n0 + wn * 64) / 2 + lr;
    const float bg = p.b_gate_up[(size_t)e * 2048 + 2 * f], bu = p.b_gate_up[(size_t)e * 2048 + 2 * f + 1];
#pragma unroll
    for (int mt = 0; mt < 2; ++mt)
#pragma unroll
      for (int r = 0; r < 16; ++r) {
        int row = m0 + wm * 64 + mt * 32 + crow(r, lh);
        if (row < mend) {
          float g = fminf(acc[mt][0][r] + bg, 7.0f);
          float u = fminf(fmaxf(acc[mt][1][r] + bu, -7.0f), 7.0f);
          float glu = g / (1.f + __expf(-1.702f * g));
          HD[(size_t)row * 1024 + f] = f2bf(glu * (u + 1.f));
        }
      }
  } else {
    unsigned short* Y = (unsigned short*)(p.ws + OFF_Y);
    const float* lgate = (const float*)(p.ws + OFF_LGATE);
#pragma unroll
    for (int mt = 0; mt < 2; ++mt)
#pragma unroll
      for (int nt = 0; nt < 2; ++nt) {
        int col = n0 + wn * 64 + nt * 32 + lr;
        float bd = p.b_down[(size_t)e * 1024 + col];
#pragma unroll
        for (int r = 0; r < 16; ++r) {
          int row = m0 + wm * 64 + mt * 32 + crow(r, lh);
          if (row < mend) Y[(size_t)row * 1024 + col] = f2bf((acc[mt][nt][r] + bd) * lgate[row]);
        }
      }
  }
  (void)slot0;
}

DI void phase_gemm_inproj(const Params& p, char* smem) {
  const int mt = (NT + G_BM - 1) / G_BM, nt = (INC + G_BN - 1) / G_BN;
  for (int t = blockIdx.x; t < mt * nt; t += gridDim.x) {
    int tn = t / mt, tm = t - tn * mt;
    gemm_tile<0>(p, smem, (const unsigned short*)(p.ws + OFF_U), 1024, tm * G_BM, NT, p.w_in, INC, tn * G_BN, INC, 1024,
                 (float*)(p.ws + OFF_P), INC, 0, 0);
  }
}
DI void phase_gemm_kvup(const Params& p, char* smem) {
  const int mt = (NT + G_BM - 1) / G_BM, nt = 1024 / G_BN;
  for (int t = blockIdx.x; t < mt * nt; t += gridDim.x) {
    int tn = t / mt, tm = t - tn * mt;
    gemm_tile<0>(p, smem, (const unsigned short*)(p.ws + OFF_CKV), 256, tm * G_BM, NT, p.w_kv_up, 1024, tn * G_BN, 1024, 256,
                 (float*)(p.ws + OFF_KV), 1024, 0, 0);
  }
}
DI void phase_gemm_outproj(const Params& p, char* smem) {
  const int mt = NR / G_BM, nt = 1024 / G_BN;
  for (int t = blockIdx.x; t < mt * nt; t += gridDim.x) {
    int tn = t / mt, tm = t - tn * mt;
    gemm_tile<1>(p, smem, (const unsigned short*)(p.ws + OFF_MIX), 1024, tm * G_BM, NR, p.w_out, 1024, tn * G_BN, 1024, 1024,
                 (float*)(p.ws + OFF_H1), 1024, 0, 0);
  }
}
template <int MODE>
DI void phase_gemm_moe(const Params& p, char* smem) {
  const int* cnt = (const int*)(p.ws + OFF_CNT);
  constexpr int NTN = (MODE == 2) ? (2048 / G_BN) : (1024 / G_BN);
  int t = blockIdx.x;
  int tbase = 0, sbase = 0;
  for (int e = 0; e < NEXP; ++e) {
    int c = cnt[e];
    int mts = (c + G_BM - 1) / G_BM;
    int ntile_e = mts * NTN;
    while (t < tbase + ntile_e) {
      int lt = t - tbase;
      int tn = lt / mts, tm = lt - tn * mts;
      if (MODE == 2)
        gemm_tile<2>(p, smem, (const unsigned short*)(p.ws + OFF_U2), 1024, sbase + tm * G_BM, sbase + c,
                     p.w_gate_up + (size_t)e * 1024 * 2048, 2048, tn * G_BN, 2048, 1024, nullptr, 0, e, 0);
      else
        gemm_tile<3>(p, smem, (const unsigned short*)(p.ws + OFF_HD), 1024, sbase + tm * G_BM, sbase + c,
                     p.w_down + (size_t)e * 1024 * 1024, 1024, tn * G_BN, 1024, 1024, nullptr, 0, e, 0);
      t += gridDim.x;
    }
    tbase += ntile_e;
    sbase += c;
  }
}

DI float rope_apply(float v, float c, float s, int lane) {
  float o = __shfl_xor(v, 32);
  return (lane < 32) ? (v * c - o * s) : (v * c + o * s);
}
DI void phase_post1(const Params& p) {
  const int tid = otid(), lane = tid & 63, wave = tid >> 6;
  const float* P = (const float*)(p.ws + OFF_P);
  const float* rope = (const float*)(p.ws + OFF_ROPE);
  unsigned short* Qb = (unsigned short*)(p.ws + OFF_QB);
  unsigned short* QI = (unsigned short*)(p.ws + OFF_QI);
  unsigned short* KI = (unsigned short*)(p.ws + OFF_KI);
  unsigned short* CKV = (unsigned short*)(p.ws + OFF_CKV);
  float* WI = (float*)(p.ws + OFF_WI);
  float* Qd = (float*)(p.ws + OFF_QD);
  float* Kd = (float*)(p.ws + OFF_KD);
  float* Vd = (float*)(p.ws + OFF_VD);
  float* BETA = (float*)(p.ws + OFF_BETA);
  float* G = (float*)(p.ws + OFF_G);
  for (int tok = blockIdx.x * NWAVES + wave; tok < NT; tok += gridDim.x * NWAVES) {
    const int b = tok / T, t = tok - b * T;
    const float* row = P + (size_t)tok * INC;
    const float cs = rope[t * 64 + (lane & 31)], sn = rope[t * 64 + 32 + (lane & 31)];
    const float qw = p.q_norm_w[lane];
#pragma unroll 2
    for (int hh = 0; hh < 8; ++hh) {
      float v = row[C_AQ + hh * 64 + lane];
      float ss = wave_sum(v * v);
      v = v * rsqrtf(ss * (1.f / 64.f) + 1e-6f) * qw;
      v = rope_apply(v, cs, sn, lane);
      Qb[(size_t)tok * 512 + hh * 64 + lane] = f2bf(v);
    }
    {
      float4 v = *(const float4*)(row + C_CKV + lane * 4);
      float ss = wave_sum(v.x * v.x + v.y * v.y + v.z * v.z + v.w * v.w);
      float rstd = rsqrtf(ss * (1.f / 256.f) + 1e-6f);
      float4 w = *(const float4*)(p.kv_norm_w + lane * 4);
      uint2 o;
      o.x = pk2(v.x * rstd * w.x, v.y * rstd * w.y);
      o.y = pk2(v.z * rstd * w.z, v.w * rstd * w.w);
      *(uint2*)(CKV + (size_t)tok * 256 + lane * 4) = o;
    }
#pragma unroll 2
    for (int hh = 0; hh < 8; ++hh) {
      float v = row[C_IQ + hh * 64 + lane];
      v = rope_apply(v, cs, sn, lane);
      QI[(size_t)tok * 512 + hh * 64 + lane] = f2bf(v);
    }
    {
      float v = row[C_IK + lane];
      v = rope_apply(v, cs, sn, lane);
      KI[(size_t)tok * 64 + lane] = f2bf(v);
    }
    if (lane < 8) WI[(size_t)tok * 8 + lane] = row[C_IW + lane] * 0.04419417382415922f;
#pragma unroll
    for (int hd = 0; hd < 4; ++hd) {
      float cv[6];
#pragma unroll
      for (int i = 0; i < 6; ++i) {
        const int c = (i >> 1) * 512 + hd * 128 + (i & 1) * 64 + lane;
        float a = 0.f;
#pragma unroll
        for (int j = 0; j < 4; ++j) {
          int tt = t - 3 + j;
          if (tt >= 0) a += p.conv_w[j * 1536 + c] * row[(ptrdiff_t)(j - 3) * INC + C_BQKV + c];
        }
        cv[i] = a / (1.f + __expf(-a));
      }
      float ss = wave_sum(cv[0] * cv[0] + cv[1] * cv[1]);
      float r = rsqrtf(ss + 1e-6f);
      Qd[(size_t)tok * 512 + hd * 128 + lane] = cv[0] * r;
      Qd[(size_t)tok * 512 + hd * 128 + 64 + lane] = cv[1] * r;
      ss = wave_sum(cv[2] * cv[2] + cv[3] * cv[3]);
      r = rsqrtf(ss + 1e-6f);
      Kd[(size_t)tok * 512 + hd * 128 + lane] = cv[2] * r;
      Kd[(size_t)tok * 512 + hd * 128 + 64 + lane] = cv[3] * r;
      Vd[(size_t)tok * 512 + hd * 128 + lane] = cv[4];
      Vd[(size_t)tok * 512 + hd * 128 + 64 + lane] = cv[5];
      __builtin_amdgcn_sched_barrier(0);
    }
    if (lane < 4) {
      float bi = row[C_BBETA + lane];
      BETA[(size_t)tok * 4 + lane] = 1.f / (1.f + expf(-bi));
      float xx = row[C_BA + lane] + p.dt_bias[lane];
      float sp = fmaxf(xx, 0.f) + log1pf(expf(-fabsf(xx)));
      G[(size_t)tok * 4 + lane] = -expf(p.a_log[lane]) * sp;
    }
  }
}

DI void phase_post2(const Params& p) {
  const int tid = otid(), lane = tid & 63, wave = tid >> 6;
  const float* KV = (const float*)(p.ws + OFF_KV);
  const float* rope = (const float*)(p.ws + OFF_ROPE);
  unsigned short* Kb = (unsigned short*)(p.ws + OFF_KB);
  unsigned short* Vt = (unsigned short*)(p.ws + OFF_VT);
  for (int tok = blockIdx.x * NWAVES + wave; tok < NT; tok += gridDim.x * NWAVES) {
    const int b = tok / T, t = tok - b * T;
    const float* row = KV + (size_t)tok * 1024;
    const float cs = rope[t * 64 + (lane & 31)], sn = rope[t * 64 + 32 + (lane & 31)];
    const float kw = p.k_norm_w[lane];
#pragma unroll
    for (int hh = 0; hh < 8; ++hh) {
      float v = row[hh * 64 + lane];
      float ss = wave_sum(v * v);
      v = v * rsqrtf(ss * (1.f / 64.f) + 1e-6f) * kw;
      v = rope_apply(v, cs, sn, lane);
      Kb[(size_t)tok * 512 + hh * 64 + lane] = f2bf(v);
      float vv = row[512 + hh * 64 + lane];
      Vt[(((size_t)b * 8 + hh) * 64 + lane) * T + t] = f2bf(vv);
    }
  }
}

constexpr int KS_STRIDE = 129, AM_STRIDE = 65;
DI void phase_chunkprep(const Params& p, char* smem) {
  float* Ks = (float*)smem;
  float* Qs = Ks + 64 * KS_STRIDE;
  float* Am = Qs + 64 * KS_STRIDE;
  float* Tm = Am + 64 * AM_STRIDE;
  float* gc = Tm + 64 * AM_STRIDE;
  float* bet = gc + 64;
  float* gl = bet + 64;
  const int tid = otid();
  const float* Qd = (const float*)(p.ws + OFF_QD);
  const float* Kd = (const float*)(p.ws + OFF_KD);
  const float* Vd = (const float*)(p.ws + OFF_VD);
  const float* BETA = (const float*)(p.ws + OFF_BETA);
  const float* G = (const float*)(p.ws + OFF_G);
  unsigned short* WN = (unsigned short*)(p.ws + OFF_WN);
  float* UU = (float*)(p.ws + OFF_UU);
  unsigned short* QG = (unsigned short*)(p.ws + OFF_QG);
  unsigned short* INm = (unsigned short*)(p.ws + OFF_IN);
  unsigned short* KDT = (unsigned short*)(p.ws + OFF_KDT);
  float* DL = (float*)(p.ws + OFF_DL);
  for (int ci = blockIdx.x; ci < NCHT; ci += gridDim.x) {
    const int bh = ci / NCH, c = ci - bh * NCH, b = bh >> 2, h = bh & 3;
    __syncthreads();
    for (int idx = tid; idx < 64 * 128; idx += NTHREADS) {
      int i = idx >> 7, d = idx & 127;
      int t = c * 64 + i - 48;
      float kv = 0.f, qv = 0.f;
      if (t >= 0) {
        size_t o = ((size_t)(b * T + t)) * 512 + h * 128 + d;
        kv = Kd[o];
        qv = Qd[o] * 0.08838834764831845f;
      }
      Ks[i * KS_STRIDE + d] = kv;
      Qs[i * KS_STRIDE + d] = qv;
    }
    if (tid < 64) {
      int t = c * 64 + tid - 48;
      float g = 0.f, be = 0.f;
      if (t >= 0) { g = G[(size_t)(b * T + t) * 4 + h]; be = BETA[(size_t)(b * T + t) * 4 + h]; }
      gl[tid] = g;
      bet[tid] = be;
    }
    __syncthreads();
    if (tid < 64) {
      float s = 0.f;
      for (int j = 0; j <= tid; ++j) s += gl[j];
      gc[tid] = s;
    }
    __syncthreads();
    {
      const int i = tid >> 3, jb = tid & 7;
      float akk[8], aqk[8];
#pragma unroll
      for (int jj = 0; jj < 8; ++jj) { akk[jj] = 0.f; aqk[jj] = 0.f; }
      for (int d = 0; d < 128; ++d) {
        float ki = Ks[i * KS_STRIDE + d], qi = Qs[i * KS_STRIDE + d];
#pragma unroll
        for (int jj = 0; jj < 8; ++jj) {
          float kj = Ks[(jb + 8 * jj) * KS_STRIDE + d];
          akk[jj] += ki * kj;
          aqk[jj] += qi * kj;
        }
      }
      const float gi = gc[i], bi = bet[i];
#pragma unroll
      for (int jj = 0; jj < 8; ++jj) {
        int j = jb + 8 * jj;
        float dec = (j <= i) ? __expf(gi - gc[j]) : 0.f;
        Am[i * AM_STRIDE + j] = (j < i) ? bi * akk[jj] * dec : 0.f;
        INm[(size_t)ci * 4096 + i * 64 + j] = f2bf((j <= i) ? aqk[jj] * dec : 0.f);
      }
    }
    __syncthreads();
    if (tid < 64) {
      const int cc = tid;
      for (int i = 0; i < 64; ++i) {
        float a = (i == cc) ? 1.f : 0.f;
        for (int j = 0; j < i; ++j) a -= Am[i * AM_STRIDE + j] * Tm[j * AM_STRIDE + cc];
        Tm[i * AM_STRIDE + cc] = a;
      }
    }
    __syncthreads();
    {
      const int e = tid & 127, rq = tid >> 7;
      float au[16], aw[16];
#pragma unroll
      for (int ii = 0; ii < 16; ++ii) { au[ii] = 0.f; aw[ii] = 0.f; }
      const int jmax = rq * 16 + 15;
      for (int j = 0; j <= jmax; ++j) {
        int t = c * 64 + j - 48;
        float bj = bet[j];
        float vb = (t >= 0) ? bj * Vd[((size_t)(b * T + t)) * 512 + h * 128 + e] : 0.f;
        float kb = bj * __expf(gc[j]) * Ks[j * KS_STRIDE + e];
#pragma unroll
        for (int ii = 0; ii < 16; ++ii) {
          float tij = Tm[(rq * 16 + ii) * AM_STRIDE + j];
          au[ii] += tij * vb;
          aw[ii] += tij * kb;
        }
      }
#pragma unroll
      for (int ii = 0; ii < 16; ++ii) {
        int i = rq * 16 + ii;
        UU[(size_t)ci * 8192 + i * 128 + e] = au[ii];
        WN[(size_t)ci * 8192 + i * 128 + e] = f2bf(-aw[ii]);
      }
    }
    const float glast = gc[63];
    for (int idx = tid; idx < 64 * 128; idx += NTHREADS) {
      int i = idx >> 7, d = idx & 127;
      QG[(size_t)ci * 8192 + i * 128 + d] = f2bf(Qs[i * KS_STRIDE + d] * __expf(gc[i]));
    }
    for (int idx = tid; idx < 64 * 128; idx += NTHREADS) {
      int i = idx & 63, d = idx >> 6;
      KDT[(size_t)ci * 8192 + d * 64 + i] = f2bf(Ks[i * KS_STRIDE + d] * __expf(glast - gc[i]));
    }
    if (tid == 0) DL[ci] = __expf(glast);
  }
}

DI unsigned ordkey(float f) {
  unsigned u = __float_as_uint(f);
  return (u & 0x80000000u) ? ~u : (u | 0x80000000u);
}
DI int half_sum(int v) {
#pragma unroll
  for (int o = 16; o >= 1; o >>= 1) v += __shfl_xor(v, o);
  return v;
}
DI void indexer_task(const Params& p, int b, int q0, int lane) {
  unsigned* MASK = (unsigned*)(p.ws + OFF_MASK);
  const int qsel = lane >> 5;
  const int tq = q0 + qsel;
  unsigned* mrow = MASK + ((size_t)b * SEQ + tq) * 128;
  if (q0 + 1 < 256) {
    for (int i = (lane & 31); i < 128; i += 32) {
      int rem = tq + 1 - 32 * i;
      unsigned w = (rem >= 32) ? 0xffffffffu : (rem > 0 ? ((1u << rem) - 1u) : 0u);
      mrow[i] = w;
    }
    return;
  }
  const unsigned short* QI = (const unsigned short*)(p.ws + OFF_QI);
  const unsigned short* KI = (const unsigned short*)(p.ws + OFF_KI);
  const float* WI = (const float*)(p.ws + OFF_WI);
  const int l15 = lane & 15, lg = lane >> 4;
  const size_t qtok = (size_t)b * T + NM + q0 + (l15 >> 3);
  const bf16x8 a0 = ld16(QI + qtok * 512 + (l15 & 7) * 64 + 8 * lg);
  const bf16x8 a1 = ld16(QI + qtok * 512 + (l15 & 7) * 64 + 32 + 8 * lg);
  float w[4];
  {
    const size_t wtok = (size_t)b * T + NM + q0 + (lg >> 1);
#pragma unroll
    for (int r = 0; r < 4; ++r) w[r] = WI[wtok * 8 + 4 * (lg & 1) + r];
  }
  const int npairs = (q0 + 2 + 31) >> 5;
  const unsigned short* kp = KI + ((size_t)b * T + NM) * 64 + (size_t)l15 * 64 + 8 * lg;
  unsigned u[128];
  int rem = tq - (lane & 31);
#pragma unroll
  for (int i = 0; i < 128; ++i) {
    unsigned uv = 0u;
    if (i < npairs) {
      float tot[2];
#pragma unroll
      for (int par = 0; par < 2; ++par) {
        const bf16x8 b0 = ld16(kp + par * 1024);
        const bf16x8 b1 = ld16(kp + par * 1024 + 32);
        f32x4 acc = {0.f, 0.f, 0.f, 0.f};
        acc = MFMA16(a0, b0, acc);
        acc = MFMA16(a1, b1, acc);
        float part = 0.f;
#pragma unroll
        for (int r = 0; r < 4; ++r) part += w[r] * fmaxf(acc[r], 0.f);
        tot[par] = part + __shfl_xor(part, 16);
      }
      const float sc = (lg & 1) ? tot[1] : tot[0];
      uv = (rem >= 0) ? ordkey(sc) : 0u;
    }
    u[i] = uv;
    kp += 2048;
    rem -= 32;
    asm volatile("" : "+v"(kp), "+v"(rem));
  }
  unsigned thr = 0u;
  for (int bit = 31; bit >= 0; --bit) {
    const unsigned cand = thr | (1u << bit);
    int cnt = 0;
#pragma unroll
    for (int i = 0; i < 128; ++i) cnt += (u[i] >= cand) ? 1 : 0;
    cnt = half_sum(cnt);
    if (cnt >= 256) thr = cand;
  }
  int cgt = 0;
#pragma unroll
  for (int i = 0; i < 128; ++i) cgt += (u[i] > thr) ? 1 : 0;
  cgt = half_sum(cgt);
  const int need = 256 - cgt;
  int base = 0;
  const unsigned lt_mask = (1u << (lane & 31)) - 1u;
#pragma unroll
  for (int i = 0; i < 128; ++i) {
    const bool eq = (u[i] == thr);
    const unsigned long long eb = __ballot(eq);
    const unsigned ehalf = qsel ? (unsigned)(eb >> 32) : (unsigned)eb;
    const int below = __popc(ehalf & lt_mask);
    const bool sel = (u[i] > thr) || (eq && (base + below < need));
    base += __popc(ehalf);
    const unsigned long long sb = __ballot(sel);
    const unsigned shalf = qsel ? (unsigned)(sb >> 32) : (unsigned)sb;
    if ((lane & 31) == 0) mrow[i] = shalf;
  }
}
DI void phase_indexer(const Params& p) {
  const int lane = otid() & 63, wave = otid() >> 6;
  const int ntask = NB * (SEQ / 2);
  for (int k = blockIdx.x * NWAVES + wave; k < ntask; k += gridDim.x * NWAVES) {
    const int b = k & 3, qp = (SEQ / 2 - 1) - (k >> 2);
    indexer_task(p, b, qp * 2, lane);
  }
}

DI void attn_task(const Params& p, int b, int hh, int qt, int lane) {
  const unsigned short* Qb = (const unsigned short*)(p.ws + OFF_QB);
  const unsigned short* Kb = (const unsigned short*)(p.ws + OFF_KB);
  const unsigned short* Vt = (const unsigned short*)(p.ws + OFF_VT);
  const unsigned* MASK = (const unsigned*)(p.ws + OFF_MASK);
  unsigned short* MIX = (unsigned short*)(p.ws + OFF_MIX);
  const int lr = lane & 31, lh = lane >> 5;
  const int tq = qt * 32 + lr;
  const size_t qtok = (size_t)b * T + NM + tq;
  bf16x8 qf[4];
#pragma unroll
  for (int ks = 0; ks < 4; ++ks) qf[ks] = ld16(Qb + qtok * 512 + hh * 64 + ks * 16 + 8 * lh);
  const unsigned* mrow = MASK + ((size_t)b * SEQ + tq) * 128;
  const unsigned short* vbase = Vt + ((size_t)b * 8 + hh) * 64 * T;
  f32x16 o[2];
#pragma unroll
  for (int i = 0; i < 2; ++i)
#pragma unroll
    for (int r = 0; r < 16; ++r) o[i][r] = 0.f;
  float m = -1e30f, lsum = 0.f;
  const float scale = 0.125f;
  for (int tile = -1; tile <= qt; ++tile) {
    const int base = (tile < 0) ? 0 : (NM + 32 * tile);
    const unsigned word = (tile < 0) ? 0x0000ffffu : mrow[tile];
    f32x16 s;
#pragma unroll
    for (int r = 0; r < 16; ++r) s[r] = 0.f;
    const size_t ktok = (size_t)b * T + base + lr;
#pragma unroll
    for (int ks = 0; ks < 4; ++ks) {
      bf16x8 kf = ld16(Kb + ktok * 512 + hh * 64 + ks * 16 + 8 * lh);
      s = MFMA32(kf, qf[ks], s);
    }
    float tmax = -1e30f;
#pragma unroll
    for (int r = 0; r < 16; ++r) {
      const bool valid = (word >> crow(r, lh)) & 1u;
      s[r] = valid ? s[r] * scale : -1e30f;
      tmax = fmaxf(tmax, s[r]);
    }
    tmax = fmaxf(tmax, __shfl_xor(tmax, 32));
    const float mnew = fmaxf(m, tmax);
    const float alpha = __expf(m - mnew);
    float psum = 0.f;
#pragma unroll
    for (int r = 0; r < 16; ++r) {
      const bool valid = (word >> crow(r, lh)) & 1u;
      const float pv = valid ? __expf(s[r] - mnew) : 0.f;
      s[r] = pv;
      psum += pv;
    }
    psum += __shfl_xor(psum, 32);
    lsum = lsum * alpha + psum;
    m = mnew;
#pragma unroll
    for (int i = 0; i < 2; ++i)
#pragma unroll
      for (int r = 0; r < 16; ++r) o[i][r] *= alpha;
#pragma unroll
    for (int ss = 0; ss < 2; ++ss) {
      const bf16x8 pf = pack8(s, ss);
#pragma unroll
      for (int dt = 0; dt < 2; ++dt) {
        const unsigned short* vp = vbase + (size_t)(dt * 32 + lr) * T + base + 16 * ss + 4 * lh;
        const bf16x8 vf = ld8x2(vp, vp + 8);
        o[dt] = MFMA32(vf, pf, o[dt]);
      }
    }
  }
  const float inv = 1.f / lsum;
#pragma unroll
  for (int dt = 0; dt < 2; ++dt)
#pragma unroll
    for (int r = 0; r < 16; ++r) MIX[qtok * 1024 + hh * 64 + dt * 32 + crow(r, lh)] = f2bf(o[dt][r] * inv);
}
DI void phase_attn(const Params& p) {
  const int lane = otid() & 63, wave = otid() >> 6;
  const int ntask = NB * 8 * 128;
  for (int k = blockIdx.x * NWAVES + wave; k < ntask; k += gridDim.x * NWAVES) {
    const int bh = k & 31, qt = 127 - (k >> 5);
    attn_task(p, bh >> 3, bh & 7, qt, lane);
  }
}

DI void scan_task(const Params& p, int b, int h, int sl, int lane) {
  const unsigned short* WN = (const unsigned short*)(p.ws + OFF_WN);
  const float* UU = (const float*)(p.ws + OFF_UU);
  const unsigned short* QG = (const unsigned short*)(p.ws + OFF_QG);
  const unsigned short* INm = (const unsigned short*)(p.ws + OFF_IN);
  const unsigned short* KDT = (const unsigned short*)(p.ws + OFF_KDT);
  const float* DL = (const float*)(p.ws + OFF_DL);
  float* OD = (float*)(p.ws + OFF_OD);
  const int lr = lane & 31, lh = lane >> 5, e0 = sl * 32;
  f32x16 S[4];
#pragma unroll
  for (int i = 0; i < 4; ++i)
#pragma unroll
    for (int r = 0; r < 16; ++r) S[i][r] = 0.f;
  for (int c = 0; c < NCH; ++c) {
    const size_t ci = (size_t)(b * 4 + h) * NCH + c;
    const unsigned short* wn = WN + ci * 8192;
    const unsigned short* qg = QG + ci * 8192;
    const unsigned short* in = INm + ci * 4096;
    const unsigned short* kdt = KDT + ci * 8192;
    const float* uu = UU + ci * 8192;
    f32x16 vn[2];
#pragma unroll
    for (int pt = 0; pt < 2; ++pt) {
#pragma unroll
      for (int r = 0; r < 16; ++r) vn[pt][r] = uu[(pt * 32 + crow(r, lh)) * 128 + e0 + lr];
#pragma unroll
      for (int mt = 0; mt < 4; ++mt)
#pragma unroll
        for (int s = 0; s < 2; ++s) {
          const unsigned short* ap = wn + (pt * 32 + lr) * 128 + mt * 32 + 16 * s + 4 * lh;
          vn[pt] = MFMA32(ld8x2(ap, ap + 8), pack8(S[mt], s), vn[pt]);
        }
    }
    bf16x8 vb[2][2];
#pragma unroll
    for (int pt = 0; pt < 2; ++pt)
#pragma unroll
      for (int s = 0; s < 2; ++s) vb[pt][s] = pack8(vn[pt], s);
#pragma unroll
    for (int pt = 0; pt < 2; ++pt) {
      f32x16 o;
#pragma unroll
      for (int r = 0; r < 16; ++r) o[r] = 0.f;
#pragma unroll
      for (int mt = 0; mt < 4; ++mt)
#pragma unroll
        for (int s = 0; s < 2; ++s) {
          const unsigned short* ap = qg + (pt * 32 + lr) * 128 + mt * 32 + 16 * s + 4 * lh;
          o = MFMA32(ld8x2(ap, ap + 8), pack8(S[mt], s), o);
        }
#pragma unroll
      for (int pt2 = 0; pt2 <= pt; ++pt2)
#pragma unroll
        for (int s = 0; s < 2; ++s) {
          const unsigned short* ap = in + (pt * 32 + lr) * 64 + pt2 * 32 + 16 * s + 4 * lh;
          o = MFMA32(ld8x2(ap, ap + 8), vb[pt2][s], o);
        }
#pragma unroll
      for (int r = 0; r < 16; ++r) {
        const int t = c * 64 + pt * 32 + crow(r, lh) - 48;
        if (t >= 0) OD[((size_t)(b * T + t)) * 512 + h * 128 + e0 + lr] = o[r];
      }
    }
    const float dl = DL[ci];
#pragma unroll
    for (int mt = 0; mt < 4; ++mt) {
#pragma unroll
      for (int r = 0; r < 16; ++r) S[mt][r] *= dl;
#pragma unroll
      for (int pt2 = 0; pt2 < 2; ++pt2)
#pragma unroll
        for (int s = 0; s < 2; ++s) {
          const unsigned short* ap = kdt + (mt * 32 + lr) * 64 + pt2 * 32 + 16 * s + 4 * lh;
          S[mt] = MFMA32(ld8x2(ap, ap + 8), vb[pt2][s], S[mt]);
        }
    }
  }
}
DI void phase_scan(const Params& p) {
  const int lane = otid() & 63, wave = otid() >> 6;
  if (wave == 0)
    for (int k = blockIdx.x; k < 64; k += gridDim.x) scan_task(p, k >> 4, (k >> 2) & 3, k & 3, lane);
}

DI void phase_gnorm(const Params& p) {
  const int tid = otid(), lane = tid & 63, wave = tid >> 6;
  const float* OD = (const float*)(p.ws + OFF_OD);
  const float* P = (const float*)(p.ws + OFF_P);
  unsigned short* MIX = (unsigned short*)(p.ws + OFF_MIX);
  for (int r = blockIdx.x * NWAVES + wave; r < NR; r += gridDim.x * NWAVES) {
    const int tok = r + 16 * (r / SEQ + 1);
#pragma unroll
    for (int hd = 0; hd < 4; ++hd) {
      float o0 = OD[(size_t)tok * 512 + hd * 128 + lane], o1 = OD[(size_t)tok * 512 + hd * 128 + 64 + lane];
      float ss = wave_sum(o0 * o0 + o1 * o1);
      float rstd = rsqrtf(ss * (1.f / 128.f) + 1e-6f);
      float z0 = P[(size_t)tok * INC + C_BZ + hd * 128 + lane], z1 = P[(size_t)tok * INC + C_BZ + hd * 128 + 64 + lane];
      float y0 = o0 * rstd * p.delta_norm_w[lane] * (z0 / (1.f + __expf(-z0)));
      float y1 = o1 * rstd * p.delta_norm_w[64 + lane] * (z1 / (1.f + __expf(-z1)));
      MIX[(size_t)tok * 1024 + 512 + hd * 128 + lane] = f2bf(y0);
      MIX[(size_t)tok * 1024 + 512 + hd * 128 + 64 + lane] = f2bf(y1);
    }
  }
}

DI void phase_router(const Params& p, char* smem) {
  const int tid = otid(), lane = tid & 63, wave = tid >> 6;
  float* us = (float*)smem + wave * 1024;
  const float* H1 = (const float*)(p.ws + OFF_H1);
  unsigned short* U2 = (unsigned short*)(p.ws + OFF_U2);
  int* TOPE = (int*)(p.ws + OFF_TOPE);
  float* GATEV = (float*)(p.ws + OFF_GATEV);
  int* POS = (int*)(p.ws + OFF_POS);
  int* CNT = (int*)(p.ws + OFF_CNT);
  for (int r = blockIdx.x * NWAVES + wave; r < NR; r += gridDim.x * NWAVES) {
    const float* src = H1 + (size_t)r * 1024;
    float4 v[4];
    float ss = 0.f;
#pragma unroll
    for (int i = 0; i < 4; ++i) {
      v[i] = *(const float4*)(src + lane * 4 + 256 * i);
      ss += v[i].x * v[i].x + v[i].y * v[i].y + v[i].z * v[i].z + v[i].w * v[i].w;
    }
    ss = wave_sum(ss);
    const float rstd = rsqrtf(ss * (1.f / 1024.f) + 1e-6f);
#pragma unroll
    for (int i = 0; i < 4; ++i) {
      float4 w = *(const float4*)(p.norm_ffn_w + lane * 4 + 256 * i);
      float4 u = make_float4(v[i].x * rstd * w.x, v[i].y * rstd * w.y, v[i].z * rstd * w.z, v[i].w * rstd * w.w);
      *(float4*)(us + lane * 4 + 256 * i) = u;
      uint2 o;
      o.x = pk2(u.x, u.y);
      o.y = pk2(u.z, u.w);
      *(uint2*)(U2 + (size_t)r * 1024 + lane * 4 + 256 * i) = o;
    }
    __builtin_amdgcn_s_waitcnt(0xc07f);
    __builtin_amdgcn_wave_barrier();
    const int e = lane & 31, half = lane >> 5;
    float acc = 0.f;
    for (int k = half * 512; k < half * 512 + 512; ++k) acc += us[k] * p.w_router[k * 32 + e];
    acc += __shfl_xor(acc, 32);
    float logit = acc + p.b_router[e];
    float tv[4];
    int te[4];
#pragma unroll
    for (int k = 0; k < 4; ++k) {
      float bv = logit;
      int bi = e;
#pragma unroll
      for (int o = 16; o >= 1; o >>= 1) {
        float ov = __shfl_xor(bv, o);
        int oi = __shfl_xor(bi, o);
        if (ov > bv || (ov == bv && oi < bi)) { bv = ov; bi = oi; }
      }
      tv[k] = bv;
      te[k] = bi;
      if (e == bi) logit = -3.0e38f;
    }
    float e1 = __expf(tv[1] - tv[0]), e2 = __expf(tv[2] - tv[0]), e3 = __expf(tv[3] - tv[0]);
    float inv = 1.f / (1.f + e1 + e2 + e3);
    if (lane < 4) {
      float gk = (lane == 0) ? inv : (lane == 1) ? e1 * inv : (lane == 2) ? e2 * inv : e3 * inv;
      int ek = (lane == 0) ? te[0] : (lane == 1) ? te[1] : (lane == 2) ? te[2] : te[3];
      TOPE[(size_t)r * 4 + lane] = ek;
      GATEV[(size_t)r * 4 + lane] = gk;
      POS[(size_t)r * 4 + lane] = atomicAdd(&CNT[ek], 1);
    }
    __builtin_amdgcn_wave_barrier();
  }
}
DI void phase_lists(const Params& p) {
  const int* CNT = (const int*)(p.ws + OFF_CNT);
  const int* TOPE = (const int*)(p.ws + OFF_TOPE);
  const float* GATEV = (const float*)(p.ws + OFF_GATEV);
  const int* POS = (const int*)(p.ws + OFF_POS);
  int* SLOT = (int*)(p.ws + OFF_SLOT);
  int* LTOK = (int*)(p.ws + OFF_LTOK);
  float* LGATE = (float*)(p.ws + OFF_LGATE);
  for (int a = blockIdx.x * NTHREADS + otid(); a < NASG; a += gridDim.x * NTHREADS) {
    const int e = TOPE[a];
    int off = 0;
    for (int j = 0; j < e; ++j) off += CNT[j];
    const int slot = off + POS[a];
    SLOT[a] = slot;
    LTOK[slot] = a >> 2;
    LGATE[slot] = GATEV[a];
  }
}
DI void phase_combine(const Params& p) {
  const float* H1 = (const float*)(p.ws + OFF_H1);
  const unsigned short* Y = (const unsigned short*)(p.ws + OFF_Y);
  const int* SLOT = (const int*)(p.ws + OFF_SLOT);
  for (int idx = blockIdx.x * NTHREADS + otid(); idx < NR * 256; idx += gridDim.x * NTHREADS) {
    const int r = idx >> 8, c4 = (idx & 255) * 4;
    float4 a = *(const float4*)(H1 + (size_t)r * 1024 + c4);
#pragma unroll
    for (int k = 0; k < 4; ++k) {
      const int slot = SLOT[r * 4 + k];
      uint2 y = *(const uint2*)(Y + (size_t)slot * 1024 + c4);
      a.x += bf2f((unsigned short)(y.x & 0xffffu));
      a.y += bf2f((unsigned short)(y.x >> 16));
      a.z += bf2f((unsigned short)(y.y & 0xffffu));
      a.w += bf2f((unsigned short)(y.y >> 16));
    }
    *(float4*)(p.out + (size_t)r * 1024 + c4) = a;
  }
}

constexpr int SMEM_BYTES = (64 * KS_STRIDE * 2 + 64 * AM_STRIDE * 2 + 192) * 4;

__global__ void __launch_bounds__(NTHREADS) mk(Params p) {
  __shared__ __attribute__((aligned(16))) char smem[SMEM_BYTES];
  cg::grid_group grid = cg::this_grid();
  phase_prep(p);
  grid.sync();
  phase_gemm_inproj(p, smem);
  grid.sync();
  phase_post1(p);
  grid.sync();
  phase_gemm_kvup(p, smem);
  phase_chunkprep(p, smem);
  grid.sync();
  phase_post2(p);
  phase_indexer(p);
  grid.sync();
  phase_scan(p);
  phase_attn(p);
  grid.sync();
  phase_gnorm(p);
  grid.sync();
  phase_gemm_outproj(p, smem);
  grid.sync();
  phase_router(p, smem);
  grid.sync();
  phase_lists(p);
  grid.sync();
  phase_gemm_moe<2>(p, smem);
  grid.sync();
  phase_gemm_moe<3>(p, smem);
  grid.sync();
  phase_combine(p);
}

extern "C" void kernel_launch(void* const* d_in, const int* in_sizes, int n_in, void* d_out, int out_size, void* d_ws,
                              size_t ws_size, hipStream_t stream) {
  (void)in_sizes; (void)n_in; (void)out_size;
  if (ws_size < WS_NEED) return;
  Params p{};
  p.x = (const float*)d_in[0]; p.meta = (const float*)d_in[1]; p.norm_mix_w = (const float*)d_in[2];
  p.w_in = (const float*)d_in[3]; p.q_norm_w = (const float*)d_in[4]; p.k_norm_w = (const float*)d_in[5];
  p.kv_norm_w = (const float*)d_in[6]; p.w_kv_up = (const float*)d_in[7]; p.conv_w = (const float*)d_in[8];
  p.a_log = (const float*)d_in[9]; p.dt_bias = (const float*)d_in[10]; p.delta_norm_w = (const float*)d_in[11];
  p.w_out = (const float*)d_in[12]; p.norm_ffn_w = (const float*)d_in[13]; p.w_router = (const float*)d_in[14];
  p.b_router = (const float*)d_in[15]; p.w_gate_up = (const float*)d_in[16]; p.b_gate_up = (const float*)d_in[17];
  p.w_down = (const float*)d_in[18]; p.b_down = (const float*)d_in[19];
  p.out = (float*)d_out;
  p.ws = (char*)d_ws;
  (void)hipMemsetAsync((char*)d_ws + OFF_CNT, 0, 4096, stream);
  static int grid_blocks = 0;
  if (!grid_blocks) {
    int dev = 0, cus = 0, per_cu = 0;
    (void)hipGetDevice(&dev);
    (void)hipDeviceGetAttribute(&cus, hipDeviceAttributeMultiprocessorCount, dev);
    (void)hipOccupancyMaxActiveBlocksPerMultiprocessor(&per_cu, mk, NTHREADS, 0);
    if (per_cu > 1) per_cu = 1;
    grid_blocks = cus * per_cu;
  }
  void* args[] = {&p};
  hipError_t e = hipLaunchCooperativeKernel((void*)mk, dim3(grid_blocks), dim3(NTHREADS), args, 0, stream);
  if (e != hipSuccess) fprintf(stderr, "cooperative launch failed: %s (grid %d)\n", hipGetErrorString(e), grid_blocks);
}
```

```cpp
#include <hip/hip_runtime.h>
#include <stdint.h>
#include <stdio.h>


typedef __attribute__((ext_vector_type(8))) short bf16x8;
typedef __attribute__((ext_vector_type(4))) short s16x4;
typedef __attribute__((ext_vector_type(16))) float f32x16;
typedef __attribute__((ext_vector_type(4))) float f32x4;
typedef __bf16 bf2_t __attribute__((ext_vector_type(2)));
#define DI __device__ __forceinline__
#define MFMA32(a, b, c) __builtin_amdgcn_mfma_f32_32x32x16_bf16((a), (b), (c), 0, 0, 0)
#define MFMA16(a, b, c) __builtin_amdgcn_mfma_f32_16x16x32_bf16((a), (b), (c), 0, 0, 0)

constexpr int NB = 4, SEQ = 4096, NM = 16, T = 4112, NT = NB * T, NR = NB * SEQ, D = 1024, INC = 3408;
constexpr int C_AQ = 0, C_CKV = 512, C_IQ = 768, C_IK = 1280, C_IW = 1344, C_BQKV = 1352, C_BZ = 2888, C_BBETA = 3400, C_BA = 3404;
constexpr int NCH = 65, NCHT = NB * 4 * NCH;
constexpr int NEXP = 32, NASG = NR * 4;
constexpr int NTHREADS = 512, NWAVES = 8;

constexpr size_t al256(size_t x) { return (x + 255) & ~(size_t)255; }
constexpr size_t OFF_U = 0;
constexpr int NTP = 16640;
constexpr size_t OFF_P = OFF_U + al256((size_t)NTP * 1024 * 2);
constexpr size_t OFF_ROPE = OFF_P + al256((size_t)NT * INC * 4);
constexpr size_t OFF_QB = OFF_ROPE + al256((size_t)T * 64 * 4);
constexpr size_t OFF_KB = OFF_QB + al256((size_t)NT * 512 * 2);
constexpr size_t OFF_VT = OFF_KB + al256((size_t)NT * 512 * 2);
constexpr size_t OFF_QI = OFF_VT + al256((size_t)NT * 512 * 2);
constexpr size_t OFF_KI = OFF_QI + al256((size_t)NT * 512 * 2);
constexpr size_t OFF_WI = OFF_KI + al256((size_t)NT * 64 * 2);
constexpr size_t OFF_CKV = OFF_WI + al256((size_t)NT * 8 * 4);
constexpr size_t OFF_KV = OFF_CKV + al256((size_t)NTP * 256 * 2);
constexpr size_t OFF_MASK = OFF_KV + al256((size_t)NT * 1024 * 4);
constexpr size_t OFF_MIX = OFF_MASK + al256((size_t)NB * SEQ * 128 * 4);
constexpr size_t OFF_QD = OFF_MIX + al256((size_t)NT * 1024 * 2);
constexpr size_t OFF_KD = OFF_QD + al256((size_t)NT * 512 * 4);
constexpr size_t OFF_VD = OFF_KD + al256((size_t)NT * 512 * 4);
constexpr size_t OFF_BETA = OFF_VD + al256((size_t)NT * 512 * 4);
constexpr size_t OFF_G = OFF_BETA + al256((size_t)NT * 4 * 4);
constexpr size_t OFF_WN = OFF_G + al256((size_t)NT * 4 * 4);
constexpr size_t OFF_UU = OFF_WN + al256((size_t)NCHT * 64 * 128 * 2);
constexpr size_t OFF_QG = OFF_UU + al256((size_t)NCHT * 64 * 128 * 4);
constexpr size_t OFF_IN = OFF_QG + al256((size_t)NCHT * 64 * 128 * 2);
constexpr size_t OFF_KDT = OFF_IN + al256((size_t)NCHT * 64 * 64 * 2);
constexpr size_t OFF_DL = OFF_KDT + al256((size_t)NCHT * 64 * 128 * 2);
constexpr size_t OFF_OD = OFF_DL + al256((size_t)NCHT * 4);
constexpr size_t OFF_U2 = OFF_OD + al256((size_t)NT * 512 * 4);
constexpr size_t OFF_TOPE = OFF_U2 + al256((size_t)NR * 1024 * 2);
constexpr size_t OFF_GATEV = OFF_TOPE + al256((size_t)NR * 4 * 4);
constexpr size_t OFF_POS = OFF_GATEV + al256((size_t)NR * 4 * 4);
constexpr size_t OFF_SLOT = OFF_POS + al256((size_t)NR * 4 * 4);
constexpr size_t OFF_LTOK = OFF_SLOT + al256((size_t)NR * 4 * 4);
constexpr size_t OFF_LGATE = OFF_LTOK + al256((size_t)NASG * 4);
constexpr size_t OFF_WTIN = OFF_LGATE + al256((size_t)NASG * 4);
constexpr size_t OFF_WTKV = OFF_WTIN + al256((size_t)3584 * 1024 * 2);
constexpr size_t OFF_WTOUT = OFF_WTKV + al256((size_t)1024 * 256 * 2);
constexpr size_t OFF_WTGU = OFF_WTOUT + al256((size_t)1024 * 1024 * 2);
constexpr size_t OFF_WTDN = OFF_WTGU + al256((size_t)32 * 2048 * 1024 * 2);
constexpr size_t OFF_CNT = OFF_WTDN + al256((size_t)32 * 1024 * 1024 * 2);
constexpr size_t OFF_Y = OFF_QD;
static_assert(OFF_U2 - OFF_QD >= (size_t)NASG * 1024 * 2, "Y alias does not fit");
static_assert((size_t)(NASG + 256) * 1024 * 2 <= (size_t)NT * INC * 4, "HD alias does not fit");
constexpr size_t OFF_BAR = OFF_CNT + 4096;
constexpr size_t WS_NEED = OFF_BAR + 16384;
constexpr size_t OFF_H1 = OFF_KV;
constexpr size_t OFF_HD = OFF_P;

struct Params {
  const float *x, *meta, *norm_mix_w, *w_in, *q_norm_w, *k_norm_w, *kv_norm_w, *w_kv_up, *conv_w, *a_log, *dt_bias,
      *delta_norm_w, *w_out, *norm_ffn_w, *w_router, *b_router, *w_gate_up, *b_gate_up, *w_down, *b_down;
  float* out;
  char* ws;
  int wv;
  int pad0;
};

DI unsigned pk2(float a, float b) { bf2_t v; v[0] = (__bf16)a; v[1] = (__bf16)b; return __builtin_bit_cast(unsigned, v); }
DI unsigned short f2bf(float a) { return (unsigned short)(pk2(a, 0.f) & 0xffffu); }
DI float bf2f(unsigned short u) { return __uint_as_float(((unsigned)u) << 16); }
DI float wave_sum(float v) {
#pragma unroll
  for (int o = 32; o >= 1; o >>= 1) v += __shfl_xor(v, o);
  return v;
}
DI int otid(const Params& p) {
  int l;
  asm volatile("v_mbcnt_lo_u32_b32 %0, -1, 0\n\tv_mbcnt_hi_u32_b32 %0, -1, %0" : "=v"(l));
  return (p.wv << 6) | l;
}
DI int crow(int reg, int h) { return (reg & 3) + 8 * (reg >> 2) + 4 * h; }
DI bf16x8 pack8(const f32x16& x, int s) {
  uint4 p;
  p.x = pk2(x[8 * s + 0], x[8 * s + 1]); p.y = pk2(x[8 * s + 2], x[8 * s + 3]);
  p.z = pk2(x[8 * s + 4], x[8 * s + 5]); p.w = pk2(x[8 * s + 6], x[8 * s + 7]);
  return __builtin_bit_cast(bf16x8, p);
}
DI bf16x8 ld8x2(const unsigned short* p0, const unsigned short* p1) {
  uint2 a = *(const uint2*)p0, b = *(const uint2*)p1;
  uint4 r = make_uint4(a.x, a.y, b.x, b.y);
  return __builtin_bit_cast(bf16x8, r);
}
DI bf16x8 ld16(const unsigned short* p) { uint4 r = *(const uint4*)p; return __builtin_bit_cast(bf16x8, r); }
DI const float* hrow(const Params& p, int tok) {
  int b = tok / T, t = tok - b * T;
  return (t < NM) ? (p.meta + (size_t)t * D) : (p.x + ((size_t)b * SEQ + (t - NM)) * D);
}

DI void phase_prep(const Params& p) {
  const int tid = otid(p), lane = tid & 63, wave = tid >> 6;
  float* rope = (float*)(p.ws + OFF_ROPE);
  for (int idx = blockIdx.x * NTHREADS + tid; idx < T * 32; idx += gridDim.x * NTHREADS) {
    int t = idx >> 5, i = idx & 31;
    float inv = (float)pow(10000.0, -(double)i / 32.0);
    float ang = (float)t * inv;
    double ad = (double)ang;
    double n = rint(ad * 0.15915494309189535);
    float r = (float)(ad - n * 6.283185307179586);
    float sn, cs;
    sincosf(r, &sn, &cs);
    rope[t * 64 + i] = cs;
    rope[t * 64 + 32 + i] = sn;
  }
  unsigned short* U = (unsigned short*)(p.ws + OFF_U);
  for (int tok = blockIdx.x * NWAVES + wave; tok < NT; tok += gridDim.x * NWAVES) {
    const float* src = hrow(p, tok);
    float4 v[4];
    float ss = 0.f;
#pragma unroll
    for (int i = 0; i < 4; ++i) {
      v[i] = *(const float4*)(src + lane * 4 + 256 * i);
      ss += v[i].x * v[i].x + v[i].y * v[i].y + v[i].z * v[i].z + v[i].w * v[i].w;
    }
    ss = wave_sum(ss);
    float rstd = rsqrtf(ss * (1.f / 1024.f) + 1e-6f);
#pragma unroll
    for (int i = 0; i < 4; ++i) {
      float4 w = *(const float4*)(p.norm_mix_w + lane * 4 + 256 * i);
      uint2 o;
      o.x = pk2(v[i].x * rstd * w.x, v[i].y * rstd * w.y);
      o.y = pk2(v[i].z * rstd * w.z, v[i].w * rstd * w.w);
      *(uint2*)(U + (size_t)tok * 1024 + lane * 4 + 256 * i) = o;
    }
  }
}

DI void wconv_tile(const float* src, unsigned short* dst, int K, int N, int k0, int n0, char* smem, int tid) {
  unsigned short* ts = (unsigned short*)smem;
  __syncthreads();
#pragma unroll
  for (int it = 0; it < 2; ++it) {
    const int k = (tid >> 4) + 32 * it, n4 = (tid & 15) * 4;
    float4 v = make_float4(0.f, 0.f, 0.f, 0.f);
    if (n0 + n4 < N) v = *(const float4*)(src + (size_t)(k0 + k) * N + n0 + n4);
    ts[(n4 + 0) * 72 + k] = f2bf(v.x);
    ts[(n4 + 1) * 72 + k] = f2bf(v.y);
    ts[(n4 + 2) * 72 + k] = f2bf(v.z);
    ts[(n4 + 3) * 72 + k] = f2bf(v.w);
  }
  __syncthreads();
  const int n = tid >> 3, k8 = (tid & 7) * 8;
  const uint4 o = *(const uint4*)(ts + n * 72 + k8);
  *(uint4*)(dst + (size_t)(n0 + n) * K + k0 + k8) = o;
}
constexpr int WC_IN = 16 * 56, WC_KV = 4 * 16, WC_OUT = 16 * 16, WC_GU = 32 * 16 * 32, WC_DN = 32 * 16 * 16;
constexpr int WC_SMALL = WC_IN + WC_KV + WC_OUT, WC_ALL = WC_SMALL + WC_GU + WC_DN;
DI void wconv_task(const Params& p, int t, char* smem) {
  const int tid = otid(p);
  if (t < WC_IN) {
    wconv_tile(p.w_in, (unsigned short*)(p.ws + OFF_WTIN), 1024, INC, (t / 56) * 64, (t % 56) * 64, smem, tid);
  } else if (t < WC_IN + WC_KV) {
    t -= WC_IN;
    wconv_tile(p.w_kv_up, (unsigned short*)(p.ws + OFF_WTKV), 256, 1024, (t / 16) * 64, (t % 16) * 64, smem, tid);
  } else if (t < WC_SMALL) {
    t -= WC_IN + WC_KV;
    wconv_tile(p.w_out, (unsigned short*)(p.ws + OFF_WTOUT), 1024, 1024, (t / 16) * 64, (t % 16) * 64, smem, tid);
  } else if (t < WC_SMALL + WC_GU) {
    t -= WC_SMALL;
    const int e = t / 512, r = t % 512;
    wconv_tile(p.w_gate_up + (size_t)e * 1024 * 2048, (unsigned short*)(p.ws + OFF_WTGU) + (size_t)e * 2048 * 1024, 1024, 2048,
               (r / 32) * 64, (r % 32) * 64, smem, tid);
  } else {
    t -= WC_SMALL + WC_GU;
    const int e = t / 256, r = t % 256;
    wconv_tile(p.w_down + (size_t)e * 1024 * 1024, (unsigned short*)(p.ws + OFF_WTDN) + (size_t)e * 1024 * 1024, 1024, 1024,
               (r / 16) * 64, (r % 16) * 64, smem, tid);
  }
}
DI void phase_wconv(const Params& p, char* smem, int t0, int t1) {
  for (int t = t0 + blockIdx.x; t < t1; t += gridDim.x) wconv_task(p, t, smem);
}

#define LAS __attribute__((address_space(3)))
namespace g8 {
constexpr int BM = 256, BK = 64, HALF = 128, HTB = HALF * BK * 2, STAGE_BYTES = 8 * HTB, NXCD = 8, WGM = 8;
constexpr int TAB_OFF = STAGE_BYTES;
constexpr int MAXU = 24;
DI int lds_byte(int r, int c) { const int st = (r >> 4) * 2 + (c >> 5), rr = r & 15, cc = c & 31, ob = rr * 64 + cc * 2; return st * 1024 + (ob ^ (((ob >> 9) & 1) << 5)); }
DI void stage_rc(int b, int& R, int& C) { const int st = b / 1024, sb = b % 1024, swz = sb ^ (((sb >> 9) & 1) << 5); R = (st >> 1) * 16 + swz / 64; C = (st & 1) * 32 + (swz % 64) / 2; }
DI int perm32(int rho) { const int n = rho >> 4, i = rho & 15; return 8 * (i >> 2) + 4 * n + (i & 3); }
DI int xcd_remap(int L, int nwg) { const int q = nwg / NXCD, r = nwg % NXCD, xcd = L % NXCD, off = L / NXCD; return (xcd < r ? xcd * (q + 1) : r * (q + 1) + (xcd - r) * q) + off; }
struct UnitT { int valid, arow, mend, pn, e, orow; };

template <int MODE> DI int n_units(const Params& p) {
  if (MODE == 0) return 65 * 14;
  if (MODE == 1) return 65 * 4;
  if (MODE == 2) return 64 * 4;
  const int* cnt = (const int*)(p.ws + OFF_CNT);
  int n = 0;
  for (int e = 0; e < NEXP; ++e) n += ((cnt[e] + 255) >> 8) * (MODE == 3 ? 8 : 4);
  return n;
}
template <int MODE> DI void unit_of(const Params& p, int L, int nwg, UnitT& u) {
  u.valid = 0; u.arow = 0; u.mend = 0; u.pn = 0; u.e = 0; u.orow = 0;
  if (L >= nwg) return;
  const int wgid = xcd_remap(L, nwg);
  u.valid = 1;
  if (MODE <= 2) {
    const int nM = (MODE == 2) ? 64 : 65, nN = (MODE == 0) ? 14 : 4;
    const int nig = WGM * nN, gid = wgid / nig, fm = gid * WGM, gsz = (nM - fm) < WGM ? (nM - fm) : WGM;
    const int pm = fm + ((wgid % nig) % gsz);
    u.pn = (wgid % nig) / gsz;
    u.orow = pm * 256;
    u.arow = (MODE == 2) ? (pm * 256 + 16 * (pm / 16 + 1)) : pm * 256;
    u.mend = (MODE == 2) ? NR : NT;
  } else {
    const int* cnt = (const int*)(p.ws + OFF_CNT);
    constexpr int NTN = (MODE == 3) ? 8 : 4;
    int id = wgid, sbase = 0;
    for (int e = 0; e < NEXP; ++e) {
      const int c = cnt[e], mts = (c + 255) >> 8, ne = mts * NTN;
      if (id < ne) {
        const int tn = id / mts, tm = id - tn * mts;
        u.e = e; u.pn = tn; u.arow = sbase + tm * 256; u.orow = u.arow; u.mend = sbase + c;
        return;
      }
      id -= ne;
      sbase += c;
    }
    u.valid = 0;
  }
}
DI float swiglu(float g, float u) {
  g = fminf(g, 7.0f);
  u = fminf(fmaxf(u, -7.0f), 7.0f);
  return g / (1.f + __expf(-1.702f * g)) * (u + 1.f);
}
template <int MODE>
DI void epilogue(const Params& p, const f32x4 (&acc)[2][2][4][2], const UnitT& u, int wr, int wc, int fr, int fq) {
  constexpr bool PERM = (MODE >= 3);
  const int row0 = u.orow + wr * 64 + fr;
  const int col0 = u.pn * 256 + wc * 32 + (PERM ? 8 * fq : 4 * fq);
  if (MODE == 0 || MODE == 1 || MODE == 2) {
    float* C = (float*)(p.ws + (MODE == 0 ? OFF_P : MODE == 1 ? OFF_KV : OFF_H1));
    const int ldc = (MODE == 0) ? INC : 1024;
#pragma unroll
    for (int ai = 0; ai < 2; ++ai)
#pragma unroll
      for (int m = 0; m < 4; ++m) {
        const int row = row0 + ai * 128 + m * 16;
        if (row < u.mend) {
#pragma unroll
          for (int bj = 0; bj < 2; ++bj)
#pragma unroll
            for (int n = 0; n < 2; ++n) {
              const int col = col0 + bj * 128 + n * 16;
              if (MODE != 0 || col < INC) {
                f32x4 v = acc[ai][bj][m][n];
                if (MODE == 2) v += *(const f32x4*)(p.x + (size_t)row * D + col);
                *(f32x4*)(C + (size_t)row * ldc + col) = v;
              }
            }
        }
      }
  } else if (MODE == 3) {
    unsigned short* HD = (unsigned short*)(p.ws + OFF_HD);
    f32x4 bv[2][2];
#pragma unroll
    for (int bj = 0; bj < 2; ++bj)
#pragma unroll
      for (int n = 0; n < 2; ++n) bv[bj][n] = *(const f32x4*)(p.b_gate_up + (size_t)u.e * 2048 + col0 + bj * 128 + 4 * n);
#pragma unroll
    for (int ai = 0; ai < 2; ++ai)
#pragma unroll
      for (int m = 0; m < 4; ++m) {
        const int row = row0 + ai * 128 + m * 16;
        if (row < u.mend) {
#pragma unroll
          for (int bj = 0; bj < 2; ++bj) {
            const f32x4 v0 = acc[ai][bj][m][0] + bv[bj][0], v1 = acc[ai][bj][m][1] + bv[bj][1];
            uint2 o;
            o.x = pk2(swiglu(v0[0], v0[1]), swiglu(v0[2], v0[3]));
            o.y = pk2(swiglu(v1[0], v1[1]), swiglu(v1[2], v1[3]));
            *(uint2*)(HD + (size_t)row * 1024 + (col0 + bj * 128) / 2) = o;
          }
        }
      }
  } else {
    unsigned short* Y = (unsigned short*)(p.ws + OFF_Y);
    const float* lgate = (const float*)(p.ws + OFF_LGATE);
    f32x4 bv[2][2];
#pragma unroll
    for (int bj = 0; bj < 2; ++bj)
#pragma unroll
      for (int n = 0; n < 2; ++n) bv[bj][n] = *(const f32x4*)(p.b_down + (size_t)u.e * 1024 + col0 + bj * 128 + 4 * n);
#pragma unroll
    for (int ai = 0; ai < 2; ++ai)
#pragma unroll
      for (int m = 0; m < 4; ++m) {
        const int row = row0 + ai * 128 + m * 16;
        if (row < u.mend) {
          const float gt = lgate[row];
#pragma unroll
          for (int bj = 0; bj < 2; ++bj) {
            const f32x4 v0 = (acc[ai][bj][m][0] + bv[bj][0]) * gt, v1 = (acc[ai][bj][m][1] + bv[bj][1]) * gt;
            uint4 o;
            o.x = pk2(v0[0], v0[1]); o.y = pk2(v0[2], v0[3]); o.z = pk2(v1[0], v1[1]); o.w = pk2(v1[2], v1[3]);
            *(uint4*)(Y + (size_t)row * 1024 + col0 + bj * 128) = o;
          }
        }
      }
  }
}

template <int MODE>
DI void gemm_phase(const Params& p, char* smem) {
  constexpr bool PERM = (MODE >= 3);
  constexpr int K = (MODE == 1) ? 256 : 1024, nt = K / BK;
  LAS unsigned char* lds = (LAS unsigned char*)smem;
  LAS int* tab = (LAS int*)(lds + TAB_OFF);
  const int tid = otid(p), wid = __builtin_amdgcn_readfirstlane(tid >> 6), lane = tid & 63, wr = wid >> 2, wc = wid & 3, fr = lane & 15, fq = lane >> 4;
  __syncthreads();
  {
    const int nwg = n_units<MODE>(p);
    for (int ti = 0; ti < MAXU; ++ti) {
      UnitT u;
      unit_of<MODE>(p, ti * (int)gridDim.x + (int)blockIdx.x, nwg, u);
      if (tid == 0) { tab[ti * 8 + 0] = u.valid; tab[ti * 8 + 1] = u.arow; tab[ti * 8 + 2] = u.mend; tab[ti * 8 + 3] = u.pn; tab[ti * 8 + 4] = u.e; tab[ti * 8 + 5] = u.orow; }
    }
  }
  __syncthreads();
#define G8_GETU(i, u) do { const int _i = (i); (u).valid = (_i < MAXU) ? __builtin_amdgcn_readfirstlane(tab[_i * 8 + 0]) : 0; (u).arow = __builtin_amdgcn_readfirstlane(tab[(_i < MAXU ? _i : 0) * 8 + 1]); \
    (u).mend = __builtin_amdgcn_readfirstlane(tab[(_i < MAXU ? _i : 0) * 8 + 2]); (u).pn = __builtin_amdgcn_readfirstlane(tab[(_i < MAXU ? _i : 0) * 8 + 3]); \
    (u).e = __builtin_amdgcn_readfirstlane(tab[(_i < MAXU ? _i : 0) * 8 + 4]); (u).orow = __builtin_amdgcn_readfirstlane(tab[(_i < MAXU ? _i : 0) * 8 + 5]); } while (0)
  UnitT cur, nxt;
  G8_GETU(0, cur);
  if (!cur.valid) return;
  const char* Abase = (const char*)(p.ws + (MODE == 0 ? OFF_U : MODE == 1 ? OFF_CKV : MODE == 2 ? OFF_MIX : MODE == 3 ? OFF_U2 : OFF_HD));
  const char* Bbase = (const char*)(p.ws + (MODE == 0 ? OFF_WTIN : MODE == 1 ? OFF_WTKV : MODE == 2 ? OFF_WTOUT : MODE == 3 ? OFF_WTGU : OFF_WTDN));
  constexpr size_t BEXP = (MODE == 3) ? (size_t)2048 * 1024 * 2 : (MODE == 4) ? (size_t)1024 * 1024 * 2 : 0;
  int Rr[2], Cc[2];
  unsigned voffB[2];
#pragma unroll
  for (int i = 0; i < 2; ++i) {
    stage_rc(tid * 16 + i * 8192, Rr[i], Cc[i]);
    const int Rb = PERM ? ((Rr[i] & ~31) + perm32(Rr[i] & 31)) : Rr[i];
    voffB[i] = (unsigned)(Rb * K + Cc[i]) * 2u;
  }
  unsigned voffA[2][2];
  const int* ltok = (const int*)(p.ws + OFF_LTOK);
#define G8_VOFFA(dst, un) do { _Pragma("unroll") for (int _h = 0; _h < 2; ++_h) _Pragma("unroll") for (int _i = 0; _i < 2; ++_i) { \
      if (MODE == 3) { int _s = (un).arow + _h * 128 + Rr[_i]; _s = _s < NASG ? _s : NASG - 1; dst[_h][_i] = (unsigned)(ltok[_s] * K + Cc[_i]) * 2u; } \
      else dst[_h][_i] = (unsigned)((_h * 128 + Rr[_i]) * K + Cc[_i]) * 2u; } } while (0)
  const size_t kstep = (size_t)(BK * 2);
  const size_t hstep = (size_t)HALF * K * 2;
  const size_t tstep = 2 * hstep;
  const unsigned ldsw = (unsigned)wid * 1024u;
  const int aoff = lds_byte(wr * 64 + fr, fq * 8), boff = lds_byte(wc * 32 + fr, fq * 8);
#define G8_SA(b, h) (((b) * 2 + (h)) * HTB)
#define G8_SB(b, h) ((4 + (b) * 2 + (h)) * HTB)
#define G8_STAGE(bufoff, gbase, voff) do { _Pragma("unroll") for (int _i = 0; _i < 2; ++_i) \
    __builtin_amdgcn_global_load_lds((const unsigned*)((const char*)(gbase) + (voff)[_i]), (LAS unsigned*)(lds + (bufoff) + ldsw + _i * 8192), 16, 0, 0); } while (0)
#define G8_LDA(dst, b, h) do { _Pragma("unroll") for (int m = 0; m < 4; ++m) _Pragma("unroll") for (int k = 0; k < 2; ++k) dst[m][k] = *(const LAS bf16x8*)(lds + G8_SA(b, h) + aoff + m * 2048 + k * 1024); } while (0)
#define G8_LDB(dst, b, h) do { _Pragma("unroll") for (int n = 0; n < 2; ++n) _Pragma("unroll") for (int k = 0; k < 2; ++k) dst[n][k] = *(const LAS bf16x8*)(lds + G8_SB(b, h) + boff + n * 2048 + k * 1024); } while (0)
#define G8_MMA(ai, bj, At, Bt) do { __builtin_amdgcn_s_setprio(1); _Pragma("unroll") for (int m = 0; m < 4; ++m) _Pragma("unroll") for (int n = 0; n < 2; ++n) _Pragma("unroll") for (int k = 0; k < 2; ++k) \
    acc[ai][bj][m][n] = __builtin_amdgcn_mfma_f32_16x16x32_bf16(Bt[n][k], At[m][k], acc[ai][bj][m][n], 0, 0, 0); __builtin_amdgcn_s_setprio(0); } while (0)
#define G8_WAIT_V(n) asm volatile("s_waitcnt vmcnt(" #n ")" ::: "memory")
#define G8_WAIT_L(n) asm volatile("s_waitcnt lgkmcnt(" #n ")" ::: "memory")
#define G8_BAR __builtin_amdgcn_s_barrier()
#define G8_SCHED __builtin_amdgcn_sched_barrier(0)
  int ui = 0;
  f32x4 acc[2][2][4][2];
#pragma unroll
  for (int a = 0; a < 2; ++a)
#pragma unroll
    for (int b = 0; b < 2; ++b)
#pragma unroll
      for (int m = 0; m < 4; ++m)
#pragma unroll
        for (int n = 0; n < 2; ++n) acc[a][b][m][n] = (f32x4){0.f, 0.f, 0.f, 0.f};
  bf16x8 At[4][2], B0[2][2], B1[2][2];
  G8_VOFFA(voffA, cur);
  if (MODE == 3) asm volatile("s_waitcnt vmcnt(0)" ::: "memory");
  const char* cA = (MODE == 3) ? Abase : Abase + (size_t)cur.arow * K * 2;
  const char* cB = Bbase + (size_t)cur.e * BEXP + (size_t)cur.pn * tstep;
  G8_STAGE(G8_SB(0, 0), cB, voffB); G8_STAGE(G8_SA(0, 0), cA, voffA[0]); G8_STAGE(G8_SB(0, 1), cB + hstep, voffB); G8_STAGE(G8_SA(0, 1), cA, voffA[1]);
  if (wr == 1) G8_BAR;
  G8_WAIT_V(4); G8_BAR;
  G8_STAGE(G8_SB(1, 0), cB + kstep, voffB); G8_STAGE(G8_SA(1, 0), cA + kstep, voffA[0]); G8_STAGE(G8_SB(1, 1), cB + hstep + kstep, voffB);
  G8_WAIT_V(6); G8_BAR;
  for (;;) {
    G8_GETU(ui + 1, nxt);
    const bool has_next = nxt.valid != 0;
    const char* nA = has_next ? ((MODE == 3) ? Abase : Abase + (size_t)nxt.arow * K * 2) : cA;
    const char* nB = has_next ? Bbase + (size_t)nxt.e * BEXP + (size_t)nxt.pn * tstep : cB;
#pragma unroll 1
    for (int t = 0; t < nt; t += 2) {
      const bool last = (t == nt - 2);
      const char* a1 = cA + (size_t)(t + 1) * kstep;
      const char* a2 = last ? nA : cA + (size_t)(t + 2) * kstep;
      const char* b2 = last ? nB : cB + (size_t)(t + 2) * kstep;
      const char* a3 = a2 + kstep;
      const char* b3 = b2 + kstep;
      G8_LDB(B0, 0, 0); G8_SCHED; G8_LDA(At, 0, 0); G8_STAGE(G8_SA(1, 1), a1, voffA[1]);
      if (MODE == 3) {
        if (last && has_next) {
          G8_VOFFA(voffA, nxt);
          asm volatile("s_waitcnt vmcnt(0)" ::: "memory");
        }
      }
      G8_WAIT_L(8); G8_BAR; G8_WAIT_L(0); G8_MMA(0, 0, At, B0); G8_BAR; G8_SCHED;
      G8_LDB(B1, 0, 1); G8_STAGE(G8_SB(0, 0), b2, voffB);
      G8_BAR; G8_WAIT_L(0); G8_MMA(0, 1, At, B1); G8_BAR;
      G8_LDA(At, 0, 1); G8_STAGE(G8_SA(0, 0), a2, voffA[0]);
      G8_BAR; G8_WAIT_L(0); G8_MMA(1, 0, At, B0); G8_BAR; G8_SCHED;
      G8_STAGE(G8_SB(0, 1), b2 + hstep, voffB);
      G8_WAIT_V(6); G8_BAR; G8_MMA(1, 1, At, B1); G8_BAR;
      G8_LDB(B0, 1, 0); G8_SCHED; G8_LDA(At, 1, 0); G8_STAGE(G8_SA(0, 1), a2, voffA[1]);
      G8_WAIT_L(8); G8_BAR; G8_WAIT_L(0); G8_MMA(0, 0, At, B0); G8_BAR; G8_SCHED;
      G8_LDB(B1, 1, 1); G8_STAGE(G8_SB(1, 0), b3, voffB);
      G8_BAR; G8_WAIT_L(0); G8_MMA(0, 1, At, B1); G8_BAR;
      G8_LDA(At, 1, 1); G8_STAGE(G8_SA(1, 0), a3, voffA[0]);
      G8_BAR; G8_WAIT_L(0); G8_MMA(1, 0, At, B0); G8_BAR; G8_SCHED;
      G8_STAGE(G8_SB(1, 1), b3 + hstep, voffB);
      G8_WAIT_V(6); G8_BAR; G8_MMA(1, 1, At, B1); G8_BAR;
    }
    epilogue<MODE>(p, acc, cur, wr, wc, fr, fq);
    if (!has_next) break;
#pragma unroll
    for (int a = 0; a < 2; ++a)
#pragma unroll
      for (int b = 0; b < 2; ++b)
#pragma unroll
        for (int m = 0; m < 4; ++m)
#pragma unroll
          for (int n = 0; n < 2; ++n) acc[a][b][m][n] = (f32x4){0.f, 0.f, 0.f, 0.f};
    cur = nxt; cA = nA; cB = nB; ++ui;
  }
  G8_WAIT_V(0);
  if (wr == 0) G8_BAR;
  G8_BAR;
#undef G8_GETU
#undef G8_VOFFA
#undef G8_SA
#undef G8_SB
#undef G8_STAGE
#undef G8_LDA
#undef G8_LDB
#undef G8_MMA
#undef G8_WAIT_V
#undef G8_WAIT_L
#undef G8_BAR
#undef G8_SCHED
}
}

DI float rope_apply(float v, float c, float s, int lane) {
  float o = __shfl_xor(v, 32);
  return (lane < 32) ? (v * c - o * s) : (v * c + o * s);
}
DI void phase_post1(const Params& p) {
  const int tid = otid(p), lane = tid & 63, wave = tid >> 6;
  const float* P = (const float*)(p.ws + OFF_P);
  const float* rope = (const float*)(p.ws + OFF_ROPE);
  unsigned short* Qb = (unsigned short*)(p.ws + OFF_QB);
  unsigned short* QI = (unsigned short*)(p.ws + OFF_QI);
  unsigned short* KI = (unsigned short*)(p.ws + OFF_KI);
  unsigned short* CKV = (unsigned short*)(p.ws + OFF_CKV);
  float* WI = (float*)(p.ws + OFF_WI);
  float* Qd = (float*)(p.ws + OFF_QD);
  float* Kd = (float*)(p.ws + OFF_KD);
  float* Vd = (float*)(p.ws + OFF_VD);
  float* BETA = (float*)(p.ws + OFF_BETA);
  float* G = (float*)(p.ws + OFF_G);
  for (int tok = blockIdx.x * NWAVES + wave; tok < NT; tok += gridDim.x * NWAVES) {
    const int b = tok / T, t = tok - b * T;
    const float* row = P + (size_t)tok * INC;
    const float cs = rope[t * 64 + (lane & 31)], sn = rope[t * 64 + 32 + (lane & 31)];
    const float qw = p.q_norm_w[lane];
#pragma unroll 2
    for (int hh = 0; hh < 8; ++hh) {
      float v = row[C_AQ + hh * 64 + lane];
      float ss = wave_sum(v * v);
      v = v * rsqrtf(ss * (1.f / 64.f) + 1e-6f) * qw;
      v = rope_apply(v, cs, sn, lane);
      Qb[(size_t)tok * 512 + hh * 64 + lane] = f2bf(v);
    }
    {
      float4 v = *(const float4*)(row + C_CKV + lane * 4);
      float ss = wave_sum(v.x * v.x + v.y * v.y + v.z * v.z + v.w * v.w);
      float rstd = rsqrtf(ss * (1.f / 256.f) + 1e-6f);
      float4 w = *(const float4*)(p.kv_norm_w + lane * 4);
      uint2 o;
      o.x = pk2(v.x * rstd * w.x, v.y * rstd * w.y);
      o.y = pk2(v.z * rstd * w.z, v.w * rstd * w.w);
      *(uint2*)(CKV + (size_t)tok * 256 + lane * 4) = o;
    }
#pragma unroll 2
    for (int hh = 0; hh < 8; ++hh) {
      float v = row[C_IQ + hh * 64 + lane];
      v = rope_apply(v, cs, sn, lane);
      QI[(size_t)tok * 512 + hh * 64 + lane] = f2bf(v);
    }
    {
      float v = row[C_IK + lane];
      v = rope_apply(v, cs, sn, lane);
      KI[(size_t)tok * 64 + lane] = f2bf(v);
    }
    if (lane < 8) WI[(size_t)tok * 8 + lane] = row[C_IW + lane] * 0.04419417382415922f;
#pragma unroll
    for (int hd = 0; hd < 4; ++hd) {
      float cv[6];
#pragma unroll
      for (int i = 0; i < 6; ++i) {
        const int c = (i >> 1) * 512 + hd * 128 + (i & 1) * 64 + lane;
        float a = 0.f;
#pragma unroll
        for (int j = 0; j < 4; ++j) {
          int tt = t - 3 + j;
          if (tt >= 0) a += p.conv_w[j * 1536 + c] * row[(ptrdiff_t)(j - 3) * INC + C_BQKV + c];
        }
        cv[i] = a / (1.f + __expf(-a));
      }
      float ss = wave_sum(cv[0] * cv[0] + cv[1] * cv[1]);
      float r = rsqrtf(ss + 1e-6f);
      Qd[(size_t)tok * 512 + hd * 128 + lane] = cv[0] * r;
      Qd[(size_t)tok * 512 + hd * 128 + 64 + lane] = cv[1] * r;
      ss = wave_sum(cv[2] * cv[2] + cv[3] * cv[3]);
      r = rsqrtf(ss + 1e-6f);
      Kd[(size_t)tok * 512 + hd * 128 + lane] = cv[2] * r;
      Kd[(size_t)tok * 512 + hd * 128 + 64 + lane] = cv[3] * r;
      Vd[(size_t)tok * 512 + hd * 128 + lane] = cv[4];
      Vd[(size_t)tok * 512 + hd * 128 + 64 + lane] = cv[5];
      __builtin_amdgcn_sched_barrier(0);
    }
    if (lane < 4) {
      float bi = row[C_BBETA + lane];
      BETA[(size_t)tok * 4 + lane] = 1.f / (1.f + expf(-bi));
      float xx = row[C_BA + lane] + p.dt_bias[lane];
      float sp = fmaxf(xx, 0.f) + log1pf(expf(-fabsf(xx)));
      G[(size_t)tok * 4 + lane] = -expf(p.a_log[lane]) * sp;
    }
  }
}

DI void phase_post2(const Params& p) {
  const int tid = otid(p), lane = tid & 63, wave = tid >> 6;
  const float* KV = (const float*)(p.ws + OFF_KV);
  const float* rope = (const float*)(p.ws + OFF_ROPE);
  unsigned short* Kb = (unsigned short*)(p.ws + OFF_KB);
  unsigned short* Vt = (unsigned short*)(p.ws + OFF_VT);
  for (int tok = blockIdx.x * NWAVES + wave; tok < NT; tok += gridDim.x * NWAVES) {
    const int b = tok / T, t = tok - b * T;
    const float* row = KV + (size_t)tok * 1024;
    const float cs = rope[t * 64 + (lane & 31)], sn = rope[t * 64 + 32 + (lane & 31)];
    const float kw = p.k_norm_w[lane];
#pragma unroll
    for (int hh = 0; hh < 8; ++hh) {
      float v = row[hh * 64 + lane];
      float ss = wave_sum(v * v);
      v = v * rsqrtf(ss * (1.f / 64.f) + 1e-6f) * kw;
      v = rope_apply(v, cs, sn, lane);
      Kb[(size_t)tok * 512 + hh * 64 + lane] = f2bf(v);
      float vv = row[512 + hh * 64 + lane];
      Vt[(((size_t)b * 8 + hh) * 64 + lane) * T + t] = f2bf(vv);
    }
  }
}

constexpr int KS_STRIDE = 129, AM_STRIDE = 65;
DI void phase_chunkprep(const Params& p, char* smem) {
  float* Ks = (float*)smem;
  float* Qs = Ks + 64 * KS_STRIDE;
  float* Am = Qs + 64 * KS_STRIDE;
  float* Tm = Am + 64 * AM_STRIDE;
  float* gc = Tm + 64 * AM_STRIDE;
  float* bet = gc + 64;
  float* gl = bet + 64;
  const int tid = otid(p);
  const float* Qd = (const float*)(p.ws + OFF_QD);
  const float* Kd = (const float*)(p.ws + OFF_KD);
  const float* Vd = (const float*)(p.ws + OFF_VD);
  const float* BETA = (const float*)(p.ws + OFF_BETA);
  const float* G = (const float*)(p.ws + OFF_G);
  unsigned short* WN = (unsigned short*)(p.ws + OFF_WN);
  float* UU = (float*)(p.ws + OFF_UU);
  unsigned short* QG = (unsigned short*)(p.ws + OFF_QG);
  unsigned short* INm = (unsigned short*)(p.ws + OFF_IN);
  unsigned short* KDT = (unsigned short*)(p.ws + OFF_KDT);
  float* DL = (float*)(p.ws + OFF_DL);
  for (int ci = blockIdx.x; ci < NCHT; ci += gridDim.x) {
    const int bh = ci / NCH, c = ci - bh * NCH, b = bh >> 2, h = bh & 3;
    __syncthreads();
    for (int idx = tid; idx < 64 * 128; idx += NTHREADS) {
      int i = idx >> 7, d = idx & 127;
      int t = c * 64 + i - 48;
      float kv = 0.f, qv = 0.f;
      if (t >= 0) {
        size_t o = ((size_t)(b * T + t)) * 512 + h * 128 + d;
        kv = Kd[o];
        qv = Qd[o] * 0.08838834764831845f;
      }
      Ks[i * KS_STRIDE + d] = kv;
      Qs[i * KS_STRIDE + d] = qv;
    }
    if (tid < 64) {
      int t = c * 64 + tid - 48;
      float g = 0.f, be = 0.f;
      if (t >= 0) { g = G[(size_t)(b * T + t) * 4 + h]; be = BETA[(size_t)(b * T + t) * 4 + h]; }
      gl[tid] = g;
      bet[tid] = be;
    }
    __syncthreads();
    if (tid < 64) {
      float s = 0.f;
      for (int j = 0; j <= tid; ++j) s += gl[j];
      gc[tid] = s;
    }
    __syncthreads();
    {
      const int i = tid >> 3, jb = tid & 7;
      float akk[8], aqk[8];
#pragma unroll
      for (int jj = 0; jj < 8; ++jj) { akk[jj] = 0.f; aqk[jj] = 0.f; }
      for (int d = 0; d < 128; ++d) {
        float ki = Ks[i * KS_STRIDE + d], qi = Qs[i * KS_STRIDE + d];
#pragma unroll
        for (int jj = 0; jj < 8; ++jj) {
          float kj = Ks[(jb + 8 * jj) * KS_STRIDE + d];
          akk[jj] += ki * kj;
          aqk[jj] += qi * kj;
        }
      }
      const float gi = gc[i], bi = bet[i];
#pragma unroll
      for (int jj = 0; jj < 8; ++jj) {
        int j = jb + 8 * jj;
        float dec = (j <= i) ? __expf(gi - gc[j]) : 0.f;
        Am[i * AM_STRIDE + j] = (j < i) ? bi * akk[jj] * dec : 0.f;
        INm[(size_t)ci * 4096 + i * 64 + j] = f2bf((j <= i) ? aqk[jj] * dec : 0.f);
      }
    }
    __syncthreads();
    if (tid < 64) {
      const int cc = tid;
      for (int i = 0; i < 64; ++i) {
        float a = (i == cc) ? 1.f : 0.f;
        for (int j = 0; j < i; ++j) a -= Am[i * AM_STRIDE + j] * Tm[j * AM_STRIDE + cc];
        Tm[i * AM_STRIDE + cc] = a;
      }
    }
    __syncthreads();
    {
      const int e = tid & 127, rq = tid >> 7;
      float au[16], aw[16];
#pragma unroll
      for (int ii = 0; ii < 16; ++ii) { au[ii] = 0.f; aw[ii] = 0.f; }
      const int jmax = rq * 16 + 15;
      for (int j = 0; j <= jmax; ++j) {
        int t = c * 64 + j - 48;
        float bj = bet[j];
        float vb = (t >= 0) ? bj * Vd[((size_t)(b * T + t)) * 512 + h * 128 + e] : 0.f;
        float kb = bj * __expf(gc[j]) * Ks[j * KS_STRIDE + e];
#pragma unroll
        for (int ii = 0; ii < 16; ++ii) {
          float tij = Tm[(rq * 16 + ii) * AM_STRIDE + j];
          au[ii] += tij * vb;
          aw[ii] += tij * kb;
        }
      }
#pragma unroll
      for (int ii = 0; ii < 16; ++ii) {
        int i = rq * 16 + ii;
        UU[(size_t)ci * 8192 + i * 128 + e] = au[ii];
        WN[(size_t)ci * 8192 + i * 128 + e] = f2bf(-aw[ii]);
      }
    }
    const float glast = gc[63];
    for (int idx = tid; idx < 64 * 128; idx += NTHREADS) {
      int i = idx >> 7, d = idx & 127;
      QG[(size_t)ci * 8192 + i * 128 + d] = f2bf(Qs[i * KS_STRIDE + d] * __expf(gc[i]));
    }
    for (int idx = tid; idx < 64 * 128; idx += NTHREADS) {
      int i = idx & 63, d = idx >> 6;
      KDT[(size_t)ci * 8192 + d * 64 + i] = f2bf(Ks[i * KS_STRIDE + d] * __expf(glast - gc[i]));
    }
    if (tid == 0) DL[ci] = __expf(glast);
  }
}

DI unsigned ordkey(float f) {
  unsigned u = __float_as_uint(f);
  return (u & 0x80000000u) ? ~u : (u | 0x80000000u);
}
DI int half_sum(int v) {
#pragma unroll
  for (int o = 16; o >= 1; o >>= 1) v += __shfl_xor(v, o);
  return v;
}
DI void indexer_task(const Params& p, int b, int q0, int lane) {
  unsigned* MASK = (unsigned*)(p.ws + OFF_MASK);
  const int qsel = lane >> 5;
  const int tq = q0 + qsel;
  unsigned* mrow = MASK + ((size_t)b * SEQ + tq) * 128;
  if (q0 + 1 < 256) {
    for (int i = (lane & 31); i < 128; i += 32) {
      int rem = tq + 1 - 32 * i;
      unsigned w = (rem >= 32) ? 0xffffffffu : (rem > 0 ? ((1u << rem) - 1u) : 0u);
      mrow[i] = w;
    }
    return;
  }
  const unsigned short* QI = (const unsigned short*)(p.ws + OFF_QI);
  const unsigned short* KI = (const unsigned short*)(p.ws + OFF_KI);
  const float* WI = (const float*)(p.ws + OFF_WI);
  const int l15 = lane & 15, lg = lane >> 4;
  const size_t qtok = (size_t)b * T + NM + q0 + (l15 >> 3);
  const bf16x8 a0 = ld16(QI + qtok * 512 + (l15 & 7) * 64 + 8 * lg);
  const bf16x8 a1 = ld16(QI + qtok * 512 + (l15 & 7) * 64 + 32 + 8 * lg);
  float w[4];
  {
    const size_t wtok = (size_t)b * T + NM + q0 + (lg >> 1);
#pragma unroll
    for (int r = 0; r < 4; ++r) w[r] = WI[wtok * 8 + 4 * (lg & 1) + r];
  }
  const int npairs = (q0 + 2 + 31) >> 5;
  const unsigned short* kp = KI + ((size_t)b * T + NM) * 64 + (size_t)l15 * 64 + 8 * lg;
  unsigned u[128];
  int rem = tq - (lane & 31);
#pragma unroll
  for (int i = 0; i < 128; ++i) {
    unsigned uv = 0u;
    if (i < npairs) {
      float tot[2];
#pragma unroll
      for (int par = 0; par < 2; ++par) {
        const bf16x8 b0 = ld16(kp + par * 1024);
        const bf16x8 b1 = ld16(kp + par * 1024 + 32);
        f32x4 acc = {0.f, 0.f, 0.f, 0.f};
        acc = MFMA16(a0, b0, acc);
        acc = MFMA16(a1, b1, acc);
        float part = 0.f;
#pragma unroll
        for (int r = 0; r < 4; ++r) part += w[r] * fmaxf(acc[r], 0.f);
        tot[par] = part + __shfl_xor(part, 16);
      }
      const float sc = (lg & 1) ? tot[1] : tot[0];
      uv = (rem >= 0) ? ordkey(sc) : 0u;
    }
    u[i] = uv;
    kp += 2048;
    rem -= 32;
    asm volatile("" : "+v"(kp), "+v"(rem));
  }
  unsigned thr = 0u;
  for (int bit = 31; bit >= 0; --bit) {
    const unsigned cand = thr | (1u << bit);
    int cnt = 0;
#pragma unroll
    for (int i = 0; i < 128; ++i) cnt += (u[i] >= cand) ? 1 : 0;
    cnt = half_sum(cnt);
    if (cnt >= 256) thr = cand;
  }
  int cgt = 0;
#pragma unroll
  for (int i = 0; i < 128; ++i) cgt += (u[i] > thr) ? 1 : 0;
  cgt = half_sum(cgt);
  const int need = 256 - cgt;
  int base = 0;
  const unsigned lt_mask = (1u << (lane & 31)) - 1u;
#pragma unroll
  for (int i = 0; i < 128; ++i) {
    const bool eq = (u[i] == thr);
    const unsigned long long eb = __ballot(eq);
    const unsigned ehalf = qsel ? (unsigned)(eb >> 32) : (unsigned)eb;
    const int below = __popc(ehalf & lt_mask);
    const bool sel = (u[i] > thr) || (eq && (base + below < need));
    base += __popc(ehalf);
    const unsigned long long sb = __ballot(sel);
    const unsigned shalf = qsel ? (unsigned)(sb >> 32) : (unsigned)sb;
    if ((lane & 31) == 0) mrow[i] = shalf;
  }
}
DI void phase_indexer(const Params& p) {
  const int lane = otid(p) & 63, wave = otid(p) >> 6;
  const int ntask = NB * (SEQ / 2);
  for (int k = blockIdx.x * NWAVES + wave; k < ntask; k += gridDim.x * NWAVES) {
    const int b = k & 3, qp = (SEQ / 2 - 1) - (k >> 2);
    indexer_task(p, b, qp * 2, lane);
  }
}

DI void attn_task(const Params& p, int b, int hh, int qt, int lane) {
  const unsigned short* Qb = (const unsigned short*)(p.ws + OFF_QB);
  const unsigned short* Kb = (const unsigned short*)(p.ws + OFF_KB);
  const unsigned short* Vt = (const unsigned short*)(p.ws + OFF_VT);
  const unsigned* MASK = (const unsigned*)(p.ws + OFF_MASK);
  unsigned short* MIX = (unsigned short*)(p.ws + OFF_MIX);
  const int lr = lane & 31, lh = lane >> 5;
  const int tq = qt * 32 + lr;
  const size_t qtok = (size_t)b * T + NM + tq;
  bf16x8 qf[4];
#pragma unroll
  for (int ks = 0; ks < 4; ++ks) qf[ks] = ld16(Qb + qtok * 512 + hh * 64 + ks * 16 + 8 * lh);
  const unsigned* mrow = MASK + ((size_t)b * SEQ + tq) * 128;
  const unsigned short* vbase = Vt + ((size_t)b * 8 + hh) * 64 * T;
  f32x16 o[2];
#pragma unroll
  for (int i = 0; i < 2; ++i)
#pragma unroll
    for (int r = 0; r < 16; ++r) o[i][r] = 0.f;
  float m = -1e30f, lsum = 0.f;
  const float scale = 0.125f;
  for (int tile = -1; tile <= qt; ++tile) {
    const int base = (tile < 0) ? 0 : (NM + 32 * tile);
    const unsigned word = (tile < 0) ? 0x0000ffffu : mrow[tile];
    f32x16 s;
#pragma unroll
    for (int r = 0; r < 16; ++r) s[r] = 0.f;
    const size_t ktok = (size_t)b * T + base + lr;
#pragma unroll
    for (int ks = 0; ks < 4; ++ks) {
      bf16x8 kf = ld16(Kb + ktok * 512 + hh * 64 + ks * 16 + 8 * lh);
      s = MFMA32(kf, qf[ks], s);
    }
    float tmax = -1e30f;
#pragma unroll
    for (int r = 0; r < 16; ++r) {
      const bool valid = (word >> crow(r, lh)) & 1u;
      s[r] = valid ? s[r] * scale : -1e30f;
      tmax = fmaxf(tmax, s[r]);
    }
    tmax = fmaxf(tmax, __shfl_xor(tmax, 32));
    const float mnew = fmaxf(m, tmax);
    const float alpha = __expf(m - mnew);
    float psum = 0.f;
#pragma unroll
    for (int r = 0; r < 16; ++r) {
      const bool valid = (word >> crow(r, lh)) & 1u;
      const float pv = valid ? __expf(s[r] - mnew) : 0.f;
      s[r] = pv;
      psum += pv;
    }
    psum += __shfl_xor(psum, 32);
    lsum = lsum * alpha + psum;
    m = mnew;
#pragma unroll
    for (int i = 0; i < 2; ++i)
#pragma unroll
      for (int r = 0; r < 16; ++r) o[i][r] *= alpha;
#pragma unroll
    for (int ss = 0; ss < 2; ++ss) {
      const bf16x8 pf = pack8(s, ss);
#pragma unroll
      for (int dt = 0; dt < 2; ++dt) {
        const unsigned short* vp = vbase + (size_t)(dt * 32 + lr) * T + base + 16 * ss + 4 * lh;
        const bf16x8 vf = ld8x2(vp, vp + 8);
        o[dt] = MFMA32(vf, pf, o[dt]);
      }
    }
  }
  const float inv = 1.f / lsum;
#pragma unroll
  for (int dt = 0; dt < 2; ++dt)
#pragma unroll
    for (int r = 0; r < 16; ++r) MIX[qtok * 1024 + hh * 64 + dt * 32 + crow(r, lh)] = f2bf(o[dt][r] * inv);
}
DI void phase_attn(const Params& p) {
  const int lane = otid(p) & 63, wave = otid(p) >> 6;
  const int ntask = NB * 8 * 128;
  for (int k = blockIdx.x * NWAVES + wave; k < ntask; k += gridDim.x * NWAVES) {
    const int bh = k & 31, qt = 127 - (k >> 5);
    attn_task(p, bh >> 3, bh & 7, qt, lane);
  }
}

DI void scan_task(const Params& p, int b, int h, int sl, int lane) {
  const unsigned short* WN = (const unsigned short*)(p.ws + OFF_WN);
  const float* UU = (const float*)(p.ws + OFF_UU);
  const unsigned short* QG = (const unsigned short*)(p.ws + OFF_QG);
  const unsigned short* INm = (const unsigned short*)(p.ws + OFF_IN);
  const unsigned short* KDT = (const unsigned short*)(p.ws + OFF_KDT);
  const float* DL = (const float*)(p.ws + OFF_DL);
  float* OD = (float*)(p.ws + OFF_OD);
  const int lr = lane & 31, lh = lane >> 5, e0 = sl * 32;
  f32x16 S[4];
#pragma unroll
  for (int i = 0; i < 4; ++i)
#pragma unroll
    for (int r = 0; r < 16; ++r) S[i][r] = 0.f;
  for (int c = 0; c < NCH; ++c) {
    const size_t ci = (size_t)(b * 4 + h) * NCH + c;
    const unsigned short* wn = WN + ci * 8192;
    const unsigned short* qg = QG + ci * 8192;
    const unsigned short* in = INm + ci * 4096;
    const unsigned short* kdt = KDT + ci * 8192;
    const float* uu = UU + ci * 8192;
    f32x16 vn[2];
#pragma unroll
    for (int pt = 0; pt < 2; ++pt) {
#pragma unroll
      for (int r = 0; r < 16; ++r) vn[pt][r] = uu[(pt * 32 + crow(r, lh)) * 128 + e0 + lr];
#pragma unroll
      for (int mt = 0; mt < 4; ++mt)
#pragma unroll
        for (int s = 0; s < 2; ++s) {
          const unsigned short* ap = wn + (pt * 32 + lr) * 128 + mt * 32 + 16 * s + 4 * lh;
          vn[pt] = MFMA32(ld8x2(ap, ap + 8), pack8(S[mt], s), vn[pt]);
        }
    }
    bf16x8 vb[2][2];
#pragma unroll
    for (int pt = 0; pt < 2; ++pt)
#pragma unroll
      for (int s = 0; s < 2; ++s) vb[pt][s] = pack8(vn[pt], s);
#pragma unroll
    for (int pt = 0; pt < 2; ++pt) {
      f32x16 o;
#pragma unroll
      for (int r = 0; r < 16; ++r) o[r] = 0.f;
#pragma unroll
      for (int mt = 0; mt < 4; ++mt)
#pragma unroll
        for (int s = 0; s < 2; ++s) {
          const unsigned short* ap = qg + (pt * 32 + lr) * 128 + mt * 32 + 16 * s + 4 * lh;
          o = MFMA32(ld8x2(ap, ap + 8), pack8(S[mt], s), o);
        }
#pragma unroll
      for (int pt2 = 0; pt2 <= pt; ++pt2)
#pragma unroll
        for (int s = 0; s < 2; ++s) {
          const unsigned short* ap = in + (pt * 32 + lr) * 64 + pt2 * 32 + 16 * s + 4 * lh;
          o = MFMA32(ld8x2(ap, ap + 8), vb[pt2][s], o);
        }
#pragma unroll
      for (int r = 0; r < 16; ++r) {
        const int t = c * 64 + pt * 32 + crow(r, lh) - 48;
        if (t >= 0) OD[((size_t)(b * T + t)) * 512 + h * 128 + e0 + lr] = o[r];
      }
    }
    const float dl = DL[ci];
#pragma unroll
    for (int mt = 0; mt < 4; ++mt) {
#pragma unroll
      for (int r = 0; r < 16; ++r) S[mt][r] *= dl;
#pragma unroll
      for (int pt2 = 0; pt2 < 2; ++pt2)
#pragma unroll
        for (int s = 0; s < 2; ++s) {
          const unsigned short* ap = kdt + (mt * 32 + lr) * 64 + pt2 * 32 + 16 * s + 4 * lh;
          S[mt] = MFMA32(ld8x2(ap, ap + 8), vb[pt2][s], S[mt]);
        }
    }
  }
}
DI void phase_scan(const Params& p) {
  const int lane = otid(p) & 63, wave = otid(p) >> 6;
  if (wave == 0)
    for (int k = blockIdx.x; k < 64; k += gridDim.x) scan_task(p, k >> 4, (k >> 2) & 3, k & 3, lane);
}

DI void phase_gnorm(const Params& p) {
  const int tid = otid(p), lane = tid & 63, wave = tid >> 6;
  const float* OD = (const float*)(p.ws + OFF_OD);
  const float* P = (const float*)(p.ws + OFF_P);
  unsigned short* MIX = (unsigned short*)(p.ws + OFF_MIX);
  for (int r = blockIdx.x * NWAVES + wave; r < NR; r += gridDim.x * NWAVES) {
    const int tok = r + 16 * (r / SEQ + 1);
#pragma unroll
    for (int hd = 0; hd < 4; ++hd) {
      float o0 = OD[(size_t)tok * 512 + hd * 128 + lane], o1 = OD[(size_t)tok * 512 + hd * 128 + 64 + lane];
      float ss = wave_sum(o0 * o0 + o1 * o1);
      float rstd = rsqrtf(ss * (1.f / 128.f) + 1e-6f);
      float z0 = P[(size_t)tok * INC + C_BZ + hd * 128 + lane], z1 = P[(size_t)tok * INC + C_BZ + hd * 128 + 64 + lane];
      float y0 = o0 * rstd * p.delta_norm_w[lane] * (z0 / (1.f + __expf(-z0)));
      float y1 = o1 * rstd * p.delta_norm_w[64 + lane] * (z1 / (1.f + __expf(-z1)));
      MIX[(size_t)tok * 1024 + 512 + hd * 128 + lane] = f2bf(y0);
      MIX[(size_t)tok * 1024 + 512 + hd * 128 + 64 + lane] = f2bf(y1);
    }
  }
}

DI void phase_router(const Params& p, char* smem) {
  const int tid = otid(p), lane = tid & 63, wave = tid >> 6;
  float* us = (float*)smem + wave * 1024;
  const float* H1 = (const float*)(p.ws + OFF_H1);
  unsigned short* U2 = (unsigned short*)(p.ws + OFF_U2);
  int* TOPE = (int*)(p.ws + OFF_TOPE);
  float* GATEV = (float*)(p.ws + OFF_GATEV);
  int* POS = (int*)(p.ws + OFF_POS);
  int* CNT = (int*)(p.ws + OFF_CNT);
  for (int r = blockIdx.x * NWAVES + wave; r < NR; r += gridDim.x * NWAVES) {
    const float* src = H1 + (size_t)r * 1024;
    float4 v[4];
    float ss = 0.f;
#pragma unroll
    for (int i = 0; i < 4; ++i) {
      v[i] = *(const float4*)(src + lane * 4 + 256 * i);
      ss += v[i].x * v[i].x + v[i].y * v[i].y + v[i].z * v[i].z + v[i].w * v[i].w;
    }
    ss = wave_sum(ss);
    const float rstd = rsqrtf(ss * (1.f / 1024.f) + 1e-6f);
#pragma unroll
    for (int i = 0; i < 4; ++i) {
      float4 w = *(const float4*)(p.norm_ffn_w + lane * 4 + 256 * i);
      float4 u = make_float4(v[i].x * rstd * w.x, v[i].y * rstd * w.y, v[i].z * rstd * w.z, v[i].w * rstd * w.w);
      *(float4*)(us + lane * 4 + 256 * i) = u;
      uint2 o;
      o.x = pk2(u.x, u.y);
      o.y = pk2(u.z, u.w);
      *(uint2*)(U2 + (size_t)r * 1024 + lane * 4 + 256 * i) = o;
    }
    __builtin_amdgcn_s_waitcnt(0xc07f);
    __builtin_amdgcn_wave_barrier();
    const int e = lane & 31, half = lane >> 5;
    float acc = 0.f;
    for (int k = half * 512; k < half * 512 + 512; ++k) acc += us[k] * p.w_router[k * 32 + e];
    acc += __shfl_xor(acc, 32);
    float logit = acc + p.b_router[e];
    float tv[4];
    int te[4];
#pragma unroll
    for (int k = 0; k < 4; ++k) {
      float bv = logit;
      int bi = e;
#pragma unroll
      for (int o = 16; o >= 1; o >>= 1) {
        float ov = __shfl_xor(bv, o);
        int oi = __shfl_xor(bi, o);
        if (ov > bv || (ov == bv && oi < bi)) { bv = ov; bi = oi; }
      }
      tv[k] = bv;
      te[k] = bi;
      if (e == bi) logit = -3.0e38f;
    }
    float e1 = __expf(tv[1] - tv[0]), e2 = __expf(tv[2] - tv[0]), e3 = __expf(tv[3] - tv[0]);
    float inv = 1.f / (1.f + e1 + e2 + e3);
    if (lane < 4) {
      float gk = (lane == 0) ? inv : (lane == 1) ? e1 * inv : (lane == 2) ? e2 * inv : e3 * inv;
      int ek = (lane == 0) ? te[0] : (lane == 1) ? te[1] : (lane == 2) ? te[2] : te[3];
      TOPE[(size_t)r * 4 + lane] = ek;
      GATEV[(size_t)r * 4 + lane] = gk;
      POS[(size_t)r * 4 + lane] = atomicAdd(&CNT[ek], 1);
    }
    __builtin_amdgcn_wave_barrier();
  }
}
DI void phase_lists(const Params& p) {
  const int* CNT = (const int*)(p.ws + OFF_CNT);
  const int* TOPE = (const int*)(p.ws + OFF_TOPE);
  const float* GATEV = (const float*)(p.ws + OFF_GATEV);
  const int* POS = (const int*)(p.ws + OFF_POS);
  int* SLOT = (int*)(p.ws + OFF_SLOT);
  int* LTOK = (int*)(p.ws + OFF_LTOK);
  float* LGATE = (float*)(p.ws + OFF_LGATE);
  for (int a = blockIdx.x * NTHREADS + otid(p); a < NASG; a += gridDim.x * NTHREADS) {
    const int e = TOPE[a];
    int off = 0;
    for (int j = 0; j < e; ++j) off += CNT[j];
    const int slot = off + POS[a];
    SLOT[a] = slot;
    LTOK[slot] = a >> 2;
    LGATE[slot] = GATEV[a];
  }
}
DI void phase_combine(const Params& p) {
  const float* H1 = (const float*)(p.ws + OFF_H1);
  const unsigned short* Y = (const unsigned short*)(p.ws + OFF_Y);
  const int* SLOT = (const int*)(p.ws + OFF_SLOT);
  for (int idx = blockIdx.x * NTHREADS + otid(p); idx < NR * 256; idx += gridDim.x * NTHREADS) {
    const int r = idx >> 8, c4 = (idx & 255) * 4;
    float4 a = *(const float4*)(H1 + (size_t)r * 1024 + c4);
#pragma unroll
    for (int k = 0; k < 4; ++k) {
      const int slot = SLOT[r * 4 + k];
      uint2 y = *(const uint2*)(Y + (size_t)slot * 1024 + c4);
      a.x += bf2f((unsigned short)(y.x & 0xffffu));
      a.y += bf2f((unsigned short)(y.x >> 16));
      a.z += bf2f((unsigned short)(y.y & 0xffffu));
      a.w += bf2f((unsigned short)(y.y >> 16));
    }
    *(float4*)(p.out + (size_t)r * 1024 + c4) = a;
  }
}


#define XB_TMO      128
#define XB_XCNT(j)  (256  + 64 * (j))
#define XB_XSUB(j)  (1280 + 64 * (j))
#define XB_XGEN(j)  (2304 + 64 * (j))
#define XB_TOP      3328
#define XB_TOPGEN   3392
#define XB_SPIN_CAP (1u << 22)
DI unsigned xb_ld(unsigned* p) { return __hip_atomic_load(p, __ATOMIC_RELAXED, __HIP_MEMORY_SCOPE_AGENT); }
DI unsigned xb_add(unsigned* p, unsigned v) { return __hip_atomic_fetch_add(p, v, __ATOMIC_RELAXED, __HIP_MEMORY_SCOPE_AGENT); }
DI unsigned xb_xcc_id() { return (unsigned)__builtin_amdgcn_s_getreg((3 << 11) | 20) & 0xFu; }
#define XB_SPIN(cond, bar) do { unsigned _sp = 0; while (cond) { __builtin_amdgcn_s_sleep(1); \
    if ((++_sp & 255u) == 0u) { if (xb_ld(&(bar)[XB_TMO])) break; if (_sp > XB_SPIN_CAP) { atomicAdd(&(bar)[XB_TMO], 1u); break; } } } } while (0)
struct XcdBarrier { unsigned* bar; unsigned x; volatile LAS unsigned* st; bool leader; };
DI void xcd_barrier_complete(unsigned* bar, unsigned x, unsigned& nloc, unsigned& nx) {
  const unsigned G = gridDim.x * gridDim.y * gridDim.z;
  unsigned sum, cnt, mine, sp = 0u;
  for (;;) {
    sum = 0u; cnt = 0u; mine = 0u;
#pragma unroll
    for (unsigned j = 0; j < 16; ++j) { const unsigned c = xb_ld(&bar[XB_XCNT(j)]); sum += c; cnt += (c > 0u) ? 1u : 0u; mine = (j == x) ? c : mine; }
    if (sum == G) break;
    __builtin_amdgcn_s_sleep(1);
    if ((++sp & 255u) == 0u) { if (xb_ld(&bar[XB_TMO])) break; if (sp > XB_SPIN_CAP) { atomicAdd(&bar[XB_TMO], 1u); break; } }
  }
  nloc = mine > 0u ? mine : 1u; nx = cnt > 0u ? cnt : 1u;
}
DI void xcd_barrier(const XcdBarrier& b) {
  asm volatile("s_waitcnt vmcnt(0)" ::: "memory");
  __syncthreads();
  if (b.leader) {
    unsigned* bar = b.bar;
    __builtin_amdgcn_s_waitcnt(0);
    unsigned nloc = b.st[0], nx = b.st[1];
    if (nloc == 0u) { xcd_barrier_complete(bar, b.x, nloc, nx); b.st[0] = nloc; b.st[1] = nx; }
    const unsigned old = xb_add(&bar[XB_XSUB(b.x)], 1u);
    const unsigned gen = old / nloc;
    if (old + 1u == (gen + 1u) * nloc) {
      __builtin_amdgcn_fence(__ATOMIC_RELEASE, "agent");
      asm volatile("s_waitcnt vmcnt(0)" ::: "memory");
      const unsigned og = xb_add(&bar[XB_TOP], 1u);
      const unsigned tg = og / nx;
      if (og + 1u == (tg + 1u) * nx) xb_add(&bar[XB_TOPGEN], 1u);
      else XB_SPIN(xb_ld(&bar[XB_TOPGEN]) == tg, bar);
      __builtin_amdgcn_fence(__ATOMIC_ACQUIRE, "agent");
      xb_add(&bar[XB_XGEN(b.x)], 1u);
      asm volatile("s_waitcnt vmcnt(0)" ::: "memory");
    } else {
      XB_SPIN(xb_ld(&bar[XB_XGEN(b.x)]) == gen, bar);
      __builtin_amdgcn_fence(__ATOMIC_ACQUIRE, "agent");
      asm volatile("s_waitcnt vmcnt(0)" ::: "memory");
    }
  }
  __syncthreads();
}

constexpr int SMEM_BYTES = g8::STAGE_BYTES + 1024;

__global__ void __launch_bounds__(NTHREADS) mk(Params p0) {
  __shared__ __attribute__((aligned(16))) char smem[SMEM_BYTES];
  Params p = p0;
  p.wv = __builtin_amdgcn_readfirstlane((int)(threadIdx.x >> 6));
  XcdBarrier xb;
  {
    volatile LAS unsigned* st = (volatile LAS unsigned*)((LAS unsigned char*)smem + g8::STAGE_BYTES + 768);
    if (threadIdx.x == 0) { st[0] = 0u; st[1] = 0u; }
    __syncthreads();
    xb.bar = (unsigned*)(p.ws + OFF_BAR); xb.x = xb_xcc_id(); xb.st = st; xb.leader = (threadIdx.x == 0);
    if (xb.leader) (void)xb_add(&xb.bar[XB_XCNT(xb.x)], 1u);
  }
  phase_prep(p);
  phase_wconv(p, smem, 0, WC_ALL);
  xcd_barrier(xb);
  g8::gemm_phase<0>(p, smem);
  xcd_barrier(xb);
  phase_post1(p);
  xcd_barrier(xb);
  g8::gemm_phase<1>(p, smem);
  phase_chunkprep(p, smem);
  xcd_barrier(xb);
  phase_post2(p);
  phase_indexer(p);
  xcd_barrier(xb);
  phase_scan(p);
  phase_attn(p);
  xcd_barrier(xb);
  phase_gnorm(p);
  xcd_barrier(xb);
  g8::gemm_phase<2>(p, smem);
  xcd_barrier(xb);
  phase_router(p, smem);
  xcd_barrier(xb);
  phase_lists(p);
  xcd_barrier(xb);
  g8::gemm_phase<3>(p, smem);
  xcd_barrier(xb);
  g8::gemm_phase<4>(p, smem);
  xcd_barrier(xb);
  phase_combine(p);
}

extern "C" void kernel_launch(void* const* d_in, const int* in_sizes, int n_in, void* d_out, int out_size, void* d_ws,
                              size_t ws_size, hipStream_t stream) {
  (void)in_sizes; (void)n_in; (void)out_size;
  if (ws_size < WS_NEED) return;
  Params p{};
  p.x = (const float*)d_in[0]; p.meta = (const float*)d_in[1]; p.norm_mix_w = (const float*)d_in[2];
  p.w_in = (const float*)d_in[3]; p.q_norm_w = (const float*)d_in[4]; p.k_norm_w = (const float*)d_in[5];
  p.kv_norm_w = (const float*)d_in[6]; p.w_kv_up = (const float*)d_in[7]; p.conv_w = (const float*)d_in[8];
  p.a_log = (const float*)d_in[9]; p.dt_bias = (const float*)d_in[10]; p.delta_norm_w = (const float*)d_in[11];
  p.w_out = (const float*)d_in[12]; p.norm_ffn_w = (const float*)d_in[13]; p.w_router = (const float*)d_in[14];
  p.b_router = (const float*)d_in[15]; p.w_gate_up = (const float*)d_in[16]; p.b_gate_up = (const float*)d_in[17];
  p.w_down = (const float*)d_in[18]; p.b_down = (const float*)d_in[19];
  p.out = (float*)d_out;
  p.ws = (char*)d_ws;
  (void)hipMemsetAsync((char*)d_ws + OFF_CNT, 0, 4096 + 16384, stream);
  static int grid_blocks = 0;
  if (!grid_blocks) {
    int dev = 0, cus = 0, per_cu = 0;
    (void)hipGetDevice(&dev);
    (void)hipDeviceGetAttribute(&cus, hipDeviceAttributeMultiprocessorCount, dev);
    (void)hipOccupancyMaxActiveBlocksPerMultiprocessor(&per_cu, mk, NTHREADS, 0);
    if (per_cu > 1) per_cu = 1;
    grid_blocks = cus * per_cu;
  }
  void* args[] = {&p};
  hipError_t e = hipLaunchCooperativeKernel((void*)mk, dim3(grid_blocks), dim3(NTHREADS), args, 0, stream);
  if (e != hipSuccess) fprintf(stderr, "cooperative launch failed: %s (grid %d)\n", hipGetErrorString(e), grid_blocks);
}
```

```cpp
#include <hip/hip_runtime.h>
#include <stdint.h>
#include <stdio.h>


typedef __attribute__((ext_vector_type(8))) short bf16x8;
typedef __attribute__((ext_vector_type(4))) short s16x4;
typedef __attribute__((ext_vector_type(16))) float f32x16;
typedef __attribute__((ext_vector_type(4))) float f32x4;
typedef __bf16 bf2_t __attribute__((ext_vector_type(2)));
#define DI __device__ __forceinline__
#define MFMA32(a, b, c) __builtin_amdgcn_mfma_f32_32x32x16_bf16((a), (b), (c), 0, 0, 0)
#define MFMA16(a, b, c) __builtin_amdgcn_mfma_f32_16x16x32_bf16((a), (b), (c), 0, 0, 0)

constexpr int NB = 4, SEQ = 4096, NM = 16, T = 4112, NT = NB * T, NR = NB * SEQ, D = 1024, INC = 3408;
constexpr int C_AQ = 0, C_CKV = 512, C_IQ = 768, C_IK = 1280, C_IW = 1344, C_BQKV = 1352, C_BZ = 2888, C_BBETA = 3400, C_BA = 3404;
constexpr int NCH = 65, NCHT = NB * 4 * NCH;
constexpr int NEXP = 32, NASG = NR * 4;
constexpr int NTHREADS = 512, NWAVES = 8;

constexpr size_t al256(size_t x) { return (x + 255) & ~(size_t)255; }
constexpr size_t OFF_U = 0;
constexpr int NTP = 16640;
constexpr size_t OFF_P = OFF_U + al256((size_t)NTP * 1024 * 2);
constexpr size_t OFF_ROPE = OFF_P + al256((size_t)NT * INC * 4);
constexpr size_t OFF_QB = OFF_ROPE + al256((size_t)T * 64 * 4);
constexpr size_t OFF_KB = OFF_QB + al256((size_t)NT * 512 * 2);
constexpr size_t OFF_VT = OFF_KB + al256((size_t)NT * 512 * 2);
constexpr size_t OFF_QI = OFF_VT + al256((size_t)NT * 512 * 2);
constexpr size_t OFF_KI = OFF_QI + al256((size_t)NT * 512 * 2);
constexpr size_t OFF_WI = OFF_KI + al256((size_t)NT * 64 * 2);
constexpr size_t OFF_CKV = OFF_WI + al256((size_t)NT * 8 * 4);
constexpr size_t OFF_KV = OFF_CKV + al256((size_t)NTP * 256 * 2);
constexpr size_t OFF_MASK = OFF_KV + al256((size_t)NT * 1024 * 4);
constexpr size_t OFF_MIX = OFF_MASK + al256((size_t)NB * SEQ * 128 * 4);
constexpr size_t OFF_QD = OFF_MIX + al256((size_t)NT * 1024 * 2);
constexpr size_t OFF_KD = OFF_QD + al256((size_t)NT * 512 * 4);
constexpr size_t OFF_VD = OFF_KD + al256((size_t)NT * 512 * 4);
constexpr size_t OFF_BETA = OFF_VD + al256((size_t)NT * 512 * 4);
constexpr size_t OFF_G = OFF_BETA + al256((size_t)NT * 4 * 4);
constexpr int CHB_ELEMS = 30720, CH_QG = 8448, CH_KDT = 16896, CH_IN = 25600;
constexpr size_t OFF_WN = OFF_G + al256((size_t)NT * 4 * 4);
constexpr size_t OFF_UU = OFF_WN + al256((size_t)NCHT * CHB_ELEMS * 2);
constexpr size_t OFF_DL = OFF_UU + al256((size_t)NCHT * 64 * 128 * 4);
constexpr size_t OFF_OD = OFF_DL + al256((size_t)NCHT * 4);
constexpr size_t OFF_U2 = OFF_OD + al256((size_t)NT * 512 * 4);
constexpr size_t OFF_TOPE = OFF_U2 + al256((size_t)NR * 1024 * 2);
constexpr size_t OFF_GATEV = OFF_TOPE + al256((size_t)NR * 4 * 4);
constexpr size_t OFF_POS = OFF_GATEV + al256((size_t)NR * 4 * 4);
constexpr size_t OFF_SLOT = OFF_POS + al256((size_t)NR * 4 * 4);
constexpr size_t OFF_LTOK = OFF_SLOT + al256((size_t)NR * 4 * 4);
constexpr size_t OFF_LGATE = OFF_LTOK + al256((size_t)NASG * 4);
constexpr size_t OFF_WTIN = OFF_LGATE + al256((size_t)NASG * 4);
constexpr size_t OFF_WTKV = OFF_WTIN + al256((size_t)3584 * 1024 * 2);
constexpr size_t OFF_WTOUT = OFF_WTKV + al256((size_t)1024 * 256 * 2);
constexpr size_t OFF_WTGU = OFF_WTOUT + al256((size_t)1024 * 1024 * 2);
constexpr size_t OFF_WTDN = OFF_WTGU + al256((size_t)32 * 2048 * 1024 * 2);
constexpr size_t OFF_CNT = OFF_WTDN + al256((size_t)32 * 1024 * 1024 * 2);
constexpr size_t OFF_Y = OFF_QD;
static_assert(OFF_U2 - OFF_QD >= (size_t)NASG * 1024 * 2, "Y alias does not fit");
static_assert((size_t)(NASG + 256) * 1024 * 2 <= (size_t)NT * INC * 4, "HD alias does not fit");
constexpr size_t OFF_WRS = OFF_CNT + 4096;
constexpr size_t OFF_BAR = OFF_WRS + 131072;
constexpr size_t WS_NEED = OFF_BAR + 16384;
constexpr size_t OFF_H1 = OFF_KV;
constexpr size_t OFF_HD = OFF_P;

struct Params {
  const float *x, *meta, *norm_mix_w, *w_in, *q_norm_w, *k_norm_w, *kv_norm_w, *w_kv_up, *conv_w, *a_log, *dt_bias,
      *delta_norm_w, *w_out, *norm_ffn_w, *w_router, *b_router, *w_gate_up, *b_gate_up, *w_down, *b_down;
  float* out;
  char* ws;
  int wv;
  int pad0;
};

DI unsigned pk2(float a, float b) { bf2_t v; v[0] = (__bf16)a; v[1] = (__bf16)b; return __builtin_bit_cast(unsigned, v); }
DI unsigned short f2bf(float a) { return (unsigned short)(pk2(a, 0.f) & 0xffffu); }
DI float bf2f(unsigned short u) { return __uint_as_float(((unsigned)u) << 16); }
template <int CTRL> DI float dppf(float v) { return __builtin_bit_cast(float, __builtin_amdgcn_update_dpp(0, __builtin_bit_cast(int, v), CTRL, 0xf, 0xf, false)); }
template <int CTRL> DI int dppi(int v) { return __builtin_amdgcn_update_dpp(0, v, CTRL, 0xf, 0xf, false); }
DI float rlf(float v, int l) { return __builtin_bit_cast(float, __builtin_amdgcn_readlane(__builtin_bit_cast(int, v), l)); }
DI float wave_sum(float v) {
  v += dppf<0xB1>(v); v += dppf<0x4E>(v); v += dppf<0x141>(v); v += dppf<0x140>(v);
  return (rlf(v, 0) + rlf(v, 16)) + (rlf(v, 32) + rlf(v, 48));
}
DI float xor32f(float v, int lane) {
  auto r = __builtin_amdgcn_permlane32_swap(__builtin_bit_cast(unsigned, v), __builtin_bit_cast(unsigned, v), false, false);
  return __builtin_bit_cast(float, (lane < 32) ? r[1] : r[0]);
}
DI float xor16f(float v, int lane) {
  auto r = __builtin_amdgcn_permlane16_swap(__builtin_bit_cast(unsigned, v), __builtin_bit_cast(unsigned, v), false, false);
  return __builtin_bit_cast(float, (lane & 16) ? r[0] : r[1]);
}
DI int otid(const Params& p) {
  int l;
  asm volatile("v_mbcnt_lo_u32_b32 %0, -1, 0\n\tv_mbcnt_hi_u32_b32 %0, -1, %0" : "=v"(l));
  return (p.wv << 6) | l;
}
DI int swzA(int row, int col) { return row * 132 + col; }
DI int swzB(int row, int col) { return row * 68 + col; }
DI int crow(int reg, int h) { return (reg & 3) + 8 * (reg >> 2) + 4 * h; }
DI bf16x8 pack8(const f32x16& x, int s) {
  uint4 p;
  p.x = pk2(x[8 * s + 0], x[8 * s + 1]); p.y = pk2(x[8 * s + 2], x[8 * s + 3]);
  p.z = pk2(x[8 * s + 4], x[8 * s + 5]); p.w = pk2(x[8 * s + 6], x[8 * s + 7]);
  return __builtin_bit_cast(bf16x8, p);
}
DI bf16x8 ld8x2(const unsigned short* p0, const unsigned short* p1) {
  uint2 a = *(const uint2*)p0, b = *(const uint2*)p1;
  uint4 r = make_uint4(a.x, a.y, b.x, b.y);
  return __builtin_bit_cast(bf16x8, r);
}
DI bf16x8 ld16(const unsigned short* p) { uint4 r = *(const uint4*)p; return __builtin_bit_cast(bf16x8, r); }
DI const float* hrow(const Params& p, int tok) {
  int b = tok / T, t = tok - b * T;
  return (t < NM) ? (p.meta + (size_t)t * D) : (p.x + ((size_t)b * SEQ + (t - NM)) * D);
}

DI void phase_prep(const Params& p) {
  const int tid = otid(p), lane = tid & 63, wave = tid >> 6;
  float* rope = (float*)(p.ws + OFF_ROPE);
  for (int idx = blockIdx.x * NTHREADS + tid; idx < T * 32; idx += gridDim.x * NTHREADS) {
    int t = idx >> 5, i = idx & 31;
    float inv = (float)pow(10000.0, -(double)i / 32.0);
    float ang = (float)t * inv;
    double ad = (double)ang;
    double n = rint(ad * 0.15915494309189535);
    float r = (float)(ad - n * 6.283185307179586);
    float sn, cs;
    sincosf(r, &sn, &cs);
    rope[t * 64 + i] = cs;
    rope[t * 64 + 32 + i] = sn;
  }
  float* wrs = (float*)(p.ws + OFF_WRS);
  for (int idx = blockIdx.x * NTHREADS + tid; idx < 1024 * 32; idx += gridDim.x * NTHREADS) wrs[idx] = p.norm_ffn_w[idx >> 5] * p.w_router[idx];
  unsigned short* U = (unsigned short*)(p.ws + OFF_U);
  for (int tok = blockIdx.x * NWAVES + wave; tok < NT; tok += gridDim.x * NWAVES) {
    const float* src = hrow(p, tok);
    float4 v[4];
    float ss = 0.f;
#pragma unroll
    for (int i = 0; i < 4; ++i) {
      v[i] = *(const float4*)(src + lane * 4 + 256 * i);
      ss += v[i].x * v[i].x + v[i].y * v[i].y + v[i].z * v[i].z + v[i].w * v[i].w;
    }
    ss = wave_sum(ss);
    float rstd = rsqrtf(ss * (1.f / 1024.f) + 1e-6f);
#pragma unroll
    for (int i = 0; i < 4; ++i) {
      float4 w = *(const float4*)(p.norm_mix_w + lane * 4 + 256 * i);
      uint2 o;
      o.x = pk2(v[i].x * rstd * w.x, v[i].y * rstd * w.y);
      o.y = pk2(v[i].z * rstd * w.z, v[i].w * rstd * w.w);
      *(uint2*)(U + (size_t)tok * 1024 + lane * 4 + 256 * i) = o;
    }
  }
}

DI void wconv_tile(const float* src, unsigned short* dst, int K, int N, int k0, int n0, char* smem, int tid) {
  unsigned short* ts = (unsigned short*)smem;
  __syncthreads();
#pragma unroll
  for (int it = 0; it < 2; ++it) {
    const int k = (tid >> 4) + 32 * it, n4 = (tid & 15) * 4;
    float4 v = make_float4(0.f, 0.f, 0.f, 0.f);
    if (n0 + n4 < N) v = *(const float4*)(src + (size_t)(k0 + k) * N + n0 + n4);
    ts[(n4 + 0) * 72 + k] = f2bf(v.x);
    ts[(n4 + 1) * 72 + k] = f2bf(v.y);
    ts[(n4 + 2) * 72 + k] = f2bf(v.z);
    ts[(n4 + 3) * 72 + k] = f2bf(v.w);
  }
  __syncthreads();
  const int n = tid >> 3, k8 = (tid & 7) * 8;
  const uint4 o = *(const uint4*)(ts + n * 72 + k8);
  *(uint4*)(dst + (size_t)(n0 + n) * K + k0 + k8) = o;
}
constexpr int WC_IN = 16 * 56, WC_KV = 4 * 16, WC_OUT = 16 * 16, WC_GU = 32 * 16 * 32, WC_DN = 32 * 16 * 16;
constexpr int WC_SMALL = WC_IN + WC_KV + WC_OUT, WC_ALL = WC_SMALL + WC_GU + WC_DN;
DI void wconv_task(const Params& p, int t, char* smem) {
  const int tid = otid(p);
  if (t < WC_IN) {
    wconv_tile(p.w_in, (unsigned short*)(p.ws + OFF_WTIN), 1024, INC, (t / 56) * 64, (t % 56) * 64, smem, tid);
  } else if (t < WC_IN + WC_KV) {
    t -= WC_IN;
    wconv_tile(p.w_kv_up, (unsigned short*)(p.ws + OFF_WTKV), 256, 1024, (t / 16) * 64, (t % 16) * 64, smem, tid);
  } else if (t < WC_SMALL) {
    t -= WC_IN + WC_KV;
    wconv_tile(p.w_out, (unsigned short*)(p.ws + OFF_WTOUT), 1024, 1024, (t / 16) * 64, (t % 16) * 64, smem, tid);
  } else if (t < WC_SMALL + WC_GU) {
    t -= WC_SMALL;
    const int e = t / 512, r = t % 512;
    wconv_tile(p.w_gate_up + (size_t)e * 1024 * 2048, (unsigned short*)(p.ws + OFF_WTGU) + (size_t)e * 2048 * 1024, 1024, 2048,
               (r / 32) * 64, (r % 32) * 64, smem, tid);
  } else {
    t -= WC_SMALL + WC_GU;
    const int e = t / 256, r = t % 256;
    wconv_tile(p.w_down + (size_t)e * 1024 * 1024, (unsigned short*)(p.ws + OFF_WTDN) + (size_t)e * 1024 * 1024, 1024, 1024,
               (r / 16) * 64, (r % 16) * 64, smem, tid);
  }
}
DI void phase_wconv(const Params& p, char* smem, int t0, int t1) {
  for (int t = t0 + blockIdx.x; t < t1; t += gridDim.x) wconv_task(p, t, smem);
}

#define LAS __attribute__((address_space(3)))
namespace g8 {
constexpr int BM = 256, BK = 64, HALF = 128, HTB = HALF * BK * 2, STAGE_BYTES = 8 * HTB, NXCD = 8, WGM = 8;
constexpr int TAB_OFF = STAGE_BYTES;
constexpr int MAXU = 24;
DI int lds_byte(int r, int c) { const int st = (r >> 4) * 2 + (c >> 5), rr = r & 15, cc = c & 31, ob = rr * 64 + cc * 2; return st * 1024 + (ob ^ (((ob >> 9) & 1) << 5)); }
DI void stage_rc(int b, int& R, int& C) { const int st = b / 1024, sb = b % 1024, swz = sb ^ (((sb >> 9) & 1) << 5); R = (st >> 1) * 16 + swz / 64; C = (st & 1) * 32 + (swz % 64) / 2; }
DI int perm32(int rho) { const int n = rho >> 4, i = rho & 15; return 8 * (i >> 2) + 4 * n + (i & 3); }
DI int xcd_remap(int L, int nwg) { const int q = nwg / NXCD, r = nwg % NXCD, xcd = L % NXCD, off = L / NXCD; return (xcd < r ? xcd * (q + 1) : r * (q + 1) + (xcd - r) * q) + off; }
struct UnitT { int valid, arow, mend, pn, e, orow; };

template <int MODE> DI int n_units(const Params& p) {
  if (MODE == 0) return 65 * 14;
  if (MODE == 1) return 65 * 4;
  if (MODE == 2) return 64 * 4;
  const int* cnt = (const int*)(p.ws + OFF_CNT);
  int n = 0;
  for (int e = 0; e < NEXP; ++e) n += ((cnt[e] + 255) >> 8) * (MODE == 3 ? 8 : 4);
  return n;
}
template <int MODE> DI void unit_of(const Params& p, int L, int nwg, UnitT& u) {
  u.valid = 0; u.arow = 0; u.mend = 0; u.pn = 0; u.e = 0; u.orow = 0;
  if (L >= nwg) return;
  const int wgid = xcd_remap(L, nwg);
  u.valid = 1;
  if (MODE <= 2) {
    const int nM = (MODE == 2) ? 64 : 65, nN = (MODE == 0) ? 14 : 4;
    const int nig = WGM * nN, gid = wgid / nig, fm = gid * WGM, gsz = (nM - fm) < WGM ? (nM - fm) : WGM;
    const int pm = fm + ((wgid % nig) % gsz);
    u.pn = (wgid % nig) / gsz;
    u.orow = pm * 256;
    u.arow = (MODE == 2) ? (pm * 256 + 16 * (pm / 16 + 1)) : pm * 256;
    u.mend = (MODE == 2) ? NR : NT;
  } else {
    const int* cnt = (const int*)(p.ws + OFF_CNT);
    constexpr int NTN = (MODE == 3) ? 8 : 4;
    int id = wgid, sbase = 0;
    for (int e = 0; e < NEXP; ++e) {
      const int c = cnt[e], mts = (c + 255) >> 8, ne = mts * NTN;
      if (id < ne) {
        const int tn = id / mts, tm = id - tn * mts;
        u.e = e; u.pn = tn; u.arow = sbase + tm * 256; u.orow = u.arow; u.mend = sbase + c;
        return;
      }
      id -= ne;
      sbase += c;
    }
    u.valid = 0;
  }
}
DI float swiglu(float g, float u) {
  g = fminf(g, 7.0f);
  u = fminf(fmaxf(u, -7.0f), 7.0f);
  return g / (1.f + __expf(-1.702f * g)) * (u + 1.f);
}
template <int MODE>
DI void epilogue(const Params& p, const f32x4 (&acc)[2][2][4][2], const UnitT& u, int wr, int wc, int fr, int fq) {
  constexpr bool PERM = (MODE >= 3);
  const int row0 = u.orow + wr * 64 + fr;
  const int col0 = u.pn * 256 + wc * 32 + (PERM ? 8 * fq : 4 * fq);
  if (MODE == 0 || MODE == 1 || MODE == 2) {
    float* C = (float*)(p.ws + (MODE == 0 ? OFF_P : MODE == 1 ? OFF_KV : OFF_H1));
    const int ldc = (MODE == 0) ? INC : 1024;
#pragma unroll
    for (int ai = 0; ai < 2; ++ai)
#pragma unroll
      for (int m = 0; m < 4; ++m) {
        const int row = row0 + ai * 128 + m * 16;
        if (row < u.mend) {
#pragma unroll
          for (int bj = 0; bj < 2; ++bj)
#pragma unroll
            for (int n = 0; n < 2; ++n) {
              const int col = col0 + bj * 128 + n * 16;
              if (MODE != 0 || col < INC) {
                f32x4 v = acc[ai][bj][m][n];
                if (MODE == 2) v += *(const f32x4*)(p.x + (size_t)row * D + col);
                *(f32x4*)(C + (size_t)row * ldc + col) = v;
              }
            }
        }
      }
  } else if (MODE == 3) {
    unsigned short* HD = (unsigned short*)(p.ws + OFF_HD);
    f32x4 bv[2][2];
#pragma unroll
    for (int bj = 0; bj < 2; ++bj)
#pragma unroll
      for (int n = 0; n < 2; ++n) bv[bj][n] = *(const f32x4*)(p.b_gate_up + (size_t)u.e * 2048 + col0 + bj * 128 + 4 * n);
#pragma unroll
    for (int ai = 0; ai < 2; ++ai)
#pragma unroll
      for (int m = 0; m < 4; ++m) {
        const int row = row0 + ai * 128 + m * 16;
        if (row < u.mend) {
#pragma unroll
          for (int bj = 0; bj < 2; ++bj) {
            const f32x4 v0 = acc[ai][bj][m][0] + bv[bj][0], v1 = acc[ai][bj][m][1] + bv[bj][1];
            uint2 o;
            o.x = pk2(swiglu(v0[0], v0[1]), swiglu(v0[2], v0[3]));
            o.y = pk2(swiglu(v1[0], v1[1]), swiglu(v1[2], v1[3]));
            *(uint2*)(HD + (size_t)row * 1024 + (col0 + bj * 128) / 2) = o;
          }
        }
      }
  } else {
    unsigned short* Y = (unsigned short*)(p.ws + OFF_Y);
    const float* lgate = (const float*)(p.ws + OFF_LGATE);
    f32x4 bv[2][2];
#pragma unroll
    for (int bj = 0; bj < 2; ++bj)
#pragma unroll
      for (int n = 0; n < 2; ++n) bv[bj][n] = *(const f32x4*)(p.b_down + (size_t)u.e * 1024 + col0 + bj * 128 + 4 * n);
#pragma unroll
    for (int ai = 0; ai < 2; ++ai)
#pragma unroll
      for (int m = 0; m < 4; ++m) {
        const int row = row0 + ai * 128 + m * 16;
        if (row < u.mend) {
          const float gt = lgate[row];
#pragma unroll
          for (int bj = 0; bj < 2; ++bj) {
            const f32x4 v0 = (acc[ai][bj][m][0] + bv[bj][0]) * gt, v1 = (acc[ai][bj][m][1] + bv[bj][1]) * gt;
            uint4 o;
            o.x = pk2(v0[0], v0[1]); o.y = pk2(v0[2], v0[3]); o.z = pk2(v1[0], v1[1]); o.w = pk2(v1[2], v1[3]);
            *(uint4*)(Y + (size_t)row * 1024 + col0 + bj * 128) = o;
          }
        }
      }
  }
}

template <int MODE>
DI void gemm_phase(const Params& p, char* smem) {
  constexpr bool PERM = (MODE >= 3);
  constexpr int K = (MODE == 1) ? 256 : 1024, nt = K / BK;
  LAS unsigned char* lds = (LAS unsigned char*)smem;
  LAS int* tab = (LAS int*)(lds + TAB_OFF);
  const int tid = otid(p), wid = __builtin_amdgcn_readfirstlane(tid >> 6), lane = tid & 63, wr = wid >> 2, wc = wid & 3, fr = lane & 15, fq = lane >> 4;
  __syncthreads();
  {
    const int nwg = n_units<MODE>(p);
    for (int ti = 0; ti < MAXU; ++ti) {
      UnitT u;
      unit_of<MODE>(p, ti * (int)gridDim.x + (int)blockIdx.x, nwg, u);
      if (tid == 0) { tab[ti * 8 + 0] = u.valid; tab[ti * 8 + 1] = u.arow; tab[ti * 8 + 2] = u.mend; tab[ti * 8 + 3] = u.pn; tab[ti * 8 + 4] = u.e; tab[ti * 8 + 5] = u.orow; }
    }
  }
  __syncthreads();
#define G8_GETU(i, u) do { const int _i = (i); (u).valid = (_i < MAXU) ? __builtin_amdgcn_readfirstlane(tab[_i * 8 + 0]) : 0; (u).arow = __builtin_amdgcn_readfirstlane(tab[(_i < MAXU ? _i : 0) * 8 + 1]); \
    (u).mend = __builtin_amdgcn_readfirstlane(tab[(_i < MAXU ? _i : 0) * 8 + 2]); (u).pn = __builtin_amdgcn_readfirstlane(tab[(_i < MAXU ? _i : 0) * 8 + 3]); \
    (u).e = __builtin_amdgcn_readfirstlane(tab[(_i < MAXU ? _i : 0) * 8 + 4]); (u).orow = __builtin_amdgcn_readfirstlane(tab[(_i < MAXU ? _i : 0) * 8 + 5]); } while (0)
  UnitT cur, nxt;
  G8_GETU(0, cur);
  if (!cur.valid) return;
  const char* Abase = (const char*)(p.ws + (MODE == 0 ? OFF_U : MODE == 1 ? OFF_CKV : MODE == 2 ? OFF_MIX : MODE == 3 ? OFF_U2 : OFF_HD));
  const char* Bbase = (const char*)(p.ws + (MODE == 0 ? OFF_WTIN : MODE == 1 ? OFF_WTKV : MODE == 2 ? OFF_WTOUT : MODE == 3 ? OFF_WTGU : OFF_WTDN));
  constexpr size_t BEXP = (MODE == 3) ? (size_t)2048 * 1024 * 2 : (MODE == 4) ? (size_t)1024 * 1024 * 2 : 0;
  int Rr[2], Cc[2];
  unsigned voffB[2];
#pragma unroll
  for (int i = 0; i < 2; ++i) {
    stage_rc(tid * 16 + i * 8192, Rr[i], Cc[i]);
    const int Rb = PERM ? ((Rr[i] & ~31) + perm32(Rr[i] & 31)) : Rr[i];
    voffB[i] = (unsigned)(Rb * K + Cc[i]) * 2u;
  }
  unsigned voffA[2][2];
  const int* ltok = (const int*)(p.ws + OFF_LTOK);
#define G8_VOFFA(dst, un) do { _Pragma("unroll") for (int _h = 0; _h < 2; ++_h) _Pragma("unroll") for (int _i = 0; _i < 2; ++_i) { \
      if (MODE == 3) { int _s = (un).arow + _h * 128 + Rr[_i]; _s = _s < NASG ? _s : NASG - 1; dst[_h][_i] = (unsigned)(ltok[_s] * K + Cc[_i]) * 2u; } \
      else dst[_h][_i] = (unsigned)((_h * 128 + Rr[_i]) * K + Cc[_i]) * 2u; } } while (0)
  const size_t kstep = (size_t)(BK * 2);
  const size_t hstep = (size_t)HALF * K * 2;
  const size_t tstep = 2 * hstep;
  const unsigned ldsw = (unsigned)wid * 1024u;
  const int aoff = lds_byte(wr * 64 + fr, fq * 8), boff = lds_byte(wc * 32 + fr, fq * 8);
#define G8_SA(b, h) (((b) * 2 + (h)) * HTB)
#define G8_SB(b, h) ((4 + (b) * 2 + (h)) * HTB)
#define G8_STAGE(bufoff, gbase, voff) do { _Pragma("unroll") for (int _i = 0; _i < 2; ++_i) \
    __builtin_amdgcn_global_load_lds((const unsigned*)((const char*)(gbase) + (voff)[_i]), (LAS unsigned*)(lds + (bufoff) + ldsw + _i * 8192), 16, 0, 0); } while (0)
#define G8_LDA(dst, b, h) do { _Pragma("unroll") for (int m = 0; m < 4; ++m) _Pragma("unroll") for (int k = 0; k < 2; ++k) dst[m][k] = *(const LAS bf16x8*)(lds + G8_SA(b, h) + aoff + m * 2048 + k * 1024); } while (0)
#define G8_LDB(dst, b, h) do { _Pragma("unroll") for (int n = 0; n < 2; ++n) _Pragma("unroll") for (int k = 0; k < 2; ++k) dst[n][k] = *(const LAS bf16x8*)(lds + G8_SB(b, h) + boff + n * 2048 + k * 1024); } while (0)
#define G8_MMA(ai, bj, At, Bt) do { __builtin_amdgcn_s_setprio(1); _Pragma("unroll") for (int m = 0; m < 4; ++m) _Pragma("unroll") for (int n = 0; n < 2; ++n) _Pragma("unroll") for (int k = 0; k < 2; ++k) \
    acc[ai][bj][m][n] = __builtin_amdgcn_mfma_f32_16x16x32_bf16(Bt[n][k], At[m][k], acc[ai][bj][m][n], 0, 0, 0); __builtin_amdgcn_s_setprio(0); } while (0)
#define G8_WAIT_V(n) asm volatile("s_waitcnt vmcnt(" #n ")" ::: "memory")
#define G8_WAIT_L(n) asm volatile("s_waitcnt lgkmcnt(" #n ")" ::: "memory")
#define G8_BAR __builtin_amdgcn_s_barrier()
#define G8_SCHED __builtin_amdgcn_sched_barrier(0)
  int ui = 0;
  f32x4 acc[2][2][4][2];
#pragma unroll
  for (int a = 0; a < 2; ++a)
#pragma unroll
    for (int b = 0; b < 2; ++b)
#pragma unroll
      for (int m = 0; m < 4; ++m)
#pragma unroll
        for (int n = 0; n < 2; ++n) acc[a][b][m][n] = (f32x4){0.f, 0.f, 0.f, 0.f};
  bf16x8 At[4][2], B0[2][2], B1[2][2];
  G8_VOFFA(voffA, cur);
  if (MODE == 3) asm volatile("s_waitcnt vmcnt(0)" ::: "memory");
  const char* cA = (MODE == 3) ? Abase : Abase + (size_t)cur.arow * K * 2;
  const char* cB = Bbase + (size_t)cur.e * BEXP + (size_t)cur.pn * tstep;
  G8_STAGE(G8_SB(0, 0), cB, voffB); G8_STAGE(G8_SA(0, 0), cA, voffA[0]); G8_STAGE(G8_SB(0, 1), cB + hstep, voffB); G8_STAGE(G8_SA(0, 1), cA, voffA[1]);
  if (wr == 1) G8_BAR;
  G8_WAIT_V(4); G8_BAR;
  G8_STAGE(G8_SB(1, 0), cB + kstep, voffB); G8_STAGE(G8_SA(1, 0), cA + kstep, voffA[0]); G8_STAGE(G8_SB(1, 1), cB + hstep + kstep, voffB);
  G8_WAIT_V(6); G8_BAR;
  for (;;) {
    G8_GETU(ui + 1, nxt);
    const bool has_next = nxt.valid != 0;
    const char* nA = has_next ? ((MODE == 3) ? Abase : Abase + (size_t)nxt.arow * K * 2) : cA;
    const char* nB = has_next ? Bbase + (size_t)nxt.e * BEXP + (size_t)nxt.pn * tstep : cB;
#pragma unroll 1
    for (int t = 0; t < nt; t += 2) {
      const bool last = (t == nt - 2);
      const char* a1 = cA + (size_t)(t + 1) * kstep;
      const char* a2 = last ? nA : cA + (size_t)(t + 2) * kstep;
      const char* b2 = last ? nB : cB + (size_t)(t + 2) * kstep;
      const char* a3 = a2 + kstep;
      const char* b3 = b2 + kstep;
      G8_LDB(B0, 0, 0); G8_SCHED; G8_LDA(At, 0, 0); G8_STAGE(G8_SA(1, 1), a1, voffA[1]);
      if (MODE == 3) {
        if (last && has_next) {
          G8_VOFFA(voffA, nxt);
          asm volatile("s_waitcnt vmcnt(0)" ::: "memory");
        }
      }
      G8_WAIT_L(8); G8_BAR; G8_WAIT_L(0); G8_MMA(0, 0, At, B0); G8_BAR; G8_SCHED;
      G8_LDB(B1, 0, 1); G8_STAGE(G8_SB(0, 0), b2, voffB);
      G8_BAR; G8_WAIT_L(0); G8_MMA(0, 1, At, B1); G8_BAR;
      G8_LDA(At, 0, 1); G8_STAGE(G8_SA(0, 0), a2, voffA[0]);
      G8_BAR; G8_WAIT_L(0); G8_MMA(1, 0, At, B0); G8_BAR; G8_SCHED;
      G8_STAGE(G8_SB(0, 1), b2 + hstep, voffB);
      G8_WAIT_V(6); G8_BAR; G8_MMA(1, 1, At, B1); G8_BAR;
      G8_LDB(B0, 1, 0); G8_SCHED; G8_LDA(At, 1, 0); G8_STAGE(G8_SA(0, 1), a2, voffA[1]);
      G8_WAIT_L(8); G8_BAR; G8_WAIT_L(0); G8_MMA(0, 0, At, B0); G8_BAR; G8_SCHED;
      G8_LDB(B1, 1, 1); G8_STAGE(G8_SB(1, 0), b3, voffB);
      G8_BAR; G8_WAIT_L(0); G8_MMA(0, 1, At, B1); G8_BAR;
      G8_LDA(At, 1, 1); G8_STAGE(G8_SA(1, 0), a3, voffA[0]);
      G8_BAR; G8_WAIT_L(0); G8_MMA(1, 0, At, B0); G8_BAR; G8_SCHED;
      G8_STAGE(G8_SB(1, 1), b3 + hstep, voffB);
      G8_WAIT_V(6); G8_BAR; G8_MMA(1, 1, At, B1); G8_BAR;
    }
    epilogue<MODE>(p, acc, cur, wr, wc, fr, fq);
    if (!has_next) break;
#pragma unroll
    for (int a = 0; a < 2; ++a)
#pragma unroll
      for (int b = 0; b < 2; ++b)
#pragma unroll
        for (int m = 0; m < 4; ++m)
#pragma unroll
          for (int n = 0; n < 2; ++n) acc[a][b][m][n] = (f32x4){0.f, 0.f, 0.f, 0.f};
    cur = nxt; cA = nA; cB = nB; ++ui;
  }
  G8_WAIT_V(0);
  if (wr == 0) G8_BAR;
  G8_BAR;
#undef G8_GETU
#undef G8_VOFFA
#undef G8_SA
#undef G8_SB
#undef G8_STAGE
#undef G8_LDA
#undef G8_LDB
#undef G8_MMA
#undef G8_WAIT_V
#undef G8_WAIT_L
#undef G8_BAR
#undef G8_SCHED
}
}

DI float rope_apply(float v, float c, float s, int lane) {
  float o = xor32f(v, lane);
  return (lane < 32) ? (v * c - o * s) : (v * c + o * s);
}
DI void phase_post1(const Params& p) {
  const int tid = otid(p), lane = tid & 63, wave = tid >> 6;
  const float* P = (const float*)(p.ws + OFF_P);
  const float* rope = (const float*)(p.ws + OFF_ROPE);
  unsigned short* Qb = (unsigned short*)(p.ws + OFF_QB);
  unsigned short* QI = (unsigned short*)(p.ws + OFF_QI);
  unsigned short* KI = (unsigned short*)(p.ws + OFF_KI);
  unsigned short* CKV = (unsigned short*)(p.ws + OFF_CKV);
  float* WI = (float*)(p.ws + OFF_WI);
  float* Qd = (float*)(p.ws + OFF_QD);
  float* Kd = (float*)(p.ws + OFF_KD);
  float* Vd = (float*)(p.ws + OFF_VD);
  float* BETA = (float*)(p.ws + OFF_BETA);
  float* G = (float*)(p.ws + OFF_G);
  for (int tok = blockIdx.x * NWAVES + wave; tok < NT; tok += gridDim.x * NWAVES) {
    const int b = tok / T, t = tok - b * T;
    const float* row = P + (size_t)tok * INC;
    const float cs = rope[t * 64 + (lane & 31)], sn = rope[t * 64 + 32 + (lane & 31)];
    const float qw = p.q_norm_w[lane];
#pragma unroll 2
    for (int hh = 0; hh < 8; ++hh) {
      float v = row[C_AQ + hh * 64 + lane];
      float ss = wave_sum(v * v);
      v = v * rsqrtf(ss * (1.f / 64.f) + 1e-6f) * qw;
      v = rope_apply(v, cs, sn, lane);
      Qb[(size_t)tok * 512 + hh * 64 + lane] = f2bf(v);
    }
    {
      float4 v = *(const float4*)(row + C_CKV + lane * 4);
      float ss = wave_sum(v.x * v.x + v.y * v.y + v.z * v.z + v.w * v.w);
      float rstd = rsqrtf(ss * (1.f / 256.f) + 1e-6f);
      float4 w = *(const float4*)(p.kv_norm_w + lane * 4);
      uint2 o;
      o.x = pk2(v.x * rstd * w.x, v.y * rstd * w.y);
      o.y = pk2(v.z * rstd * w.z, v.w * rstd * w.w);
      *(uint2*)(CKV + (size_t)tok * 256 + lane * 4) = o;
    }
#pragma unroll 2
    for (int hh = 0; hh < 8; ++hh) {
      float v = row[C_IQ + hh * 64 + lane];
      v = rope_apply(v, cs, sn, lane);
      QI[(size_t)tok * 512 + hh * 64 + lane] = f2bf(v);
    }
    {
      float v = row[C_IK + lane];
      v = rope_apply(v, cs, sn, lane);
      KI[(size_t)tok * 64 + lane] = f2bf(v);
    }
    if (lane < 8) WI[(size_t)tok * 8 + lane] = row[C_IW + lane] * 0.04419417382415922f;
#pragma unroll
    for (int hd = 0; hd < 4; ++hd) {
      float cv[6];
#pragma unroll
      for (int i = 0; i < 6; ++i) {
        const int c = (i >> 1) * 512 + hd * 128 + (i & 1) * 64 + lane;
        float a = 0.f;
#pragma unroll
        for (int j = 0; j < 4; ++j) {
          int tt = t - 3 + j;
          if (tt >= 0) a += p.conv_w[j * 1536 + c] * row[(ptrdiff_t)(j - 3) * INC + C_BQKV + c];
        }
        cv[i] = a / (1.f + __expf(-a));
      }
      float ss = wave_sum(cv[0] * cv[0] + cv[1] * cv[1]);
      float r = rsqrtf(ss + 1e-6f);
      Qd[(size_t)tok * 512 + hd * 128 + lane] = cv[0] * r;
      Qd[(size_t)tok * 512 + hd * 128 + 64 + lane] = cv[1] * r;
      ss = wave_sum(cv[2] * cv[2] + cv[3] * cv[3]);
      r = rsqrtf(ss + 1e-6f);
      Kd[(size_t)tok * 512 + hd * 128 + lane] = cv[2] * r;
      Kd[(size_t)tok * 512 + hd * 128 + 64 + lane] = cv[3] * r;
      Vd[(size_t)tok * 512 + hd * 128 + lane] = cv[4];
      Vd[(size_t)tok * 512 + hd * 128 + 64 + lane] = cv[5];
      __builtin_amdgcn_sched_barrier(0);
    }
    if (lane < 4) {
      float bi = row[C_BBETA + lane];
      BETA[(size_t)tok * 4 + lane] = 1.f / (1.f + expf(-bi));
      float xx = row[C_BA + lane] + p.dt_bias[lane];
      float sp = fmaxf(xx, 0.f) + log1pf(expf(-fabsf(xx)));
      G[(size_t)tok * 4 + lane] = -expf(p.a_log[lane]) * sp;
    }
  }
}

DI void phase_post2(const Params& p) {
  const int tid = otid(p), lane = tid & 63, wave = tid >> 6;
  const float* KV = (const float*)(p.ws + OFF_KV);
  const float* rope = (const float*)(p.ws + OFF_ROPE);
  unsigned short* Kb = (unsigned short*)(p.ws + OFF_KB);
  unsigned short* Vt = (unsigned short*)(p.ws + OFF_VT);
  for (int tok = blockIdx.x * NWAVES + wave; tok < NT; tok += gridDim.x * NWAVES) {
    const int b = tok / T, t = tok - b * T;
    const float* row = KV + (size_t)tok * 1024;
    const float cs = rope[t * 64 + (lane & 31)], sn = rope[t * 64 + 32 + (lane & 31)];
    const float kw = p.k_norm_w[lane];
#pragma unroll
    for (int hh = 0; hh < 8; ++hh) {
      float v = row[hh * 64 + lane];
      float ss = wave_sum(v * v);
      v = v * rsqrtf(ss * (1.f / 64.f) + 1e-6f) * kw;
      v = rope_apply(v, cs, sn, lane);
      Kb[(size_t)tok * 512 + hh * 64 + lane] = f2bf(v);
      float vv = row[512 + hh * 64 + lane];
      Vt[(((size_t)b * 8 + hh) * 64 + lane) * T + t] = f2bf(vv);
    }
  }
}

constexpr int KS_STRIDE = 129, AM_STRIDE = 65;
DI void phase_chunkprep(const Params& p, char* smem) {
  float* Ks = (float*)smem;
  float* Qs = Ks + 64 * KS_STRIDE;
  float* Am = Qs + 64 * KS_STRIDE;
  float* Tm = Am + 64 * AM_STRIDE;
  float* gc = Tm + 64 * AM_STRIDE;
  float* bet = gc + 64;
  float* gl = bet + 64;
  const int tid = otid(p);
  const float* Qd = (const float*)(p.ws + OFF_QD);
  const float* Kd = (const float*)(p.ws + OFF_KD);
  const float* Vd = (const float*)(p.ws + OFF_VD);
  const float* BETA = (const float*)(p.ws + OFF_BETA);
  const float* G = (const float*)(p.ws + OFF_G);
  unsigned short* CHB = (unsigned short*)(p.ws + OFF_WN);
  float* UU = (float*)(p.ws + OFF_UU);
  float* DL = (float*)(p.ws + OFF_DL);
  for (int ci = blockIdx.x; ci < NCHT; ci += gridDim.x) {
    unsigned short* chb = CHB + (size_t)ci * CHB_ELEMS;
    const int bh = ci / NCH, c = ci - bh * NCH, b = bh >> 2, h = bh & 3;
    __syncthreads();
    for (int idx = tid; idx < 64 * 128; idx += NTHREADS) {
      int i = idx >> 7, d = idx & 127;
      int t = c * 64 + i - 48;
      float kv = 0.f, qv = 0.f;
      if (t >= 0) {
        size_t o = ((size_t)(b * T + t)) * 512 + h * 128 + d;
        kv = Kd[o];
        qv = Qd[o] * 0.08838834764831845f;
      }
      Ks[i * KS_STRIDE + d] = kv;
      Qs[i * KS_STRIDE + d] = qv;
    }
    if (tid < 64) {
      int t = c * 64 + tid - 48;
      float g = 0.f, be = 0.f;
      if (t >= 0) { g = G[(size_t)(b * T + t) * 4 + h]; be = BETA[(size_t)(b * T + t) * 4 + h]; }
      gl[tid] = g;
      bet[tid] = be;
    }
    __syncthreads();
    if (tid < 64) {
      float s = 0.f;
      for (int j = 0; j <= tid; ++j) s += gl[j];
      gc[tid] = s;
    }
    __syncthreads();
    {
      const int i = tid >> 3, jb = tid & 7;
      float akk[8], aqk[8];
#pragma unroll
      for (int jj = 0; jj < 8; ++jj) { akk[jj] = 0.f; aqk[jj] = 0.f; }
      for (int d = 0; d < 128; ++d) {
        float ki = Ks[i * KS_STRIDE + d], qi = Qs[i * KS_STRIDE + d];
#pragma unroll
        for (int jj = 0; jj < 8; ++jj) {
          float kj = Ks[(jb + 8 * jj) * KS_STRIDE + d];
          akk[jj] += ki * kj;
          aqk[jj] += qi * kj;
        }
      }
      const float gi = gc[i], bi = bet[i];
#pragma unroll
      for (int jj = 0; jj < 8; ++jj) {
        int j = jb + 8 * jj;
        float dec = (j <= i) ? __expf(gi - gc[j]) : 0.f;
        Am[i * AM_STRIDE + j] = (j < i) ? bi * akk[jj] * dec : 0.f;
        chb[CH_IN + swzB(i, j)] = f2bf((j <= i) ? aqk[jj] * dec : 0.f);
      }
    }
    __syncthreads();
    {
      float* Mt = gl + 64;
      for (int idx = tid; idx < 64 * 64; idx += NTHREADS) Tm[(idx >> 6) * AM_STRIDE + (idx & 63)] = 0.f;
      __syncthreads();
      if (tid < 64) {
        const int bb = tid >> 4, cc = tid & 15, o = 16 * bb;
        float x[16];
#pragma unroll
        for (int i = 0; i < 16; ++i) {
          float a = (i == cc) ? 1.f : 0.f;
#pragma unroll
          for (int j = 0; j < 16; ++j)
            if (j < i) a -= Am[(o + i) * AM_STRIDE + o + j] * x[j];
          x[i] = a;
          Tm[(o + i) * AM_STRIDE + o + cc] = a;
        }
      }
      __syncthreads();
      {
        const int B = tid >> 8, i = (tid >> 4) & 15, j = tid & 15, o = 32 * B;
        float m = 0.f;
#pragma unroll
        for (int k = 0; k < 16; ++k) m += Am[(o + 16 + i) * AM_STRIDE + o + k] * Tm[(o + k) * AM_STRIDE + o + j];
        Mt[(B * 16 + i) * 33 + j] = m;
        __syncthreads();
        float t = 0.f;
#pragma unroll
        for (int k = 0; k < 16; ++k) t += Tm[(o + 16 + i) * AM_STRIDE + o + 16 + k] * Mt[(B * 16 + k) * 33 + j];
        __syncthreads();
        Tm[(o + 16 + i) * AM_STRIDE + o + j] = -t;
      }
      __syncthreads();
      {
        const int i = tid >> 4, j0 = (tid & 15) * 2;
        float m0 = 0.f, m1 = 0.f;
        for (int k = 0; k < 32; ++k) {
          const float a = Am[(32 + i) * AM_STRIDE + k];
          m0 += a * Tm[k * AM_STRIDE + j0];
          m1 += a * Tm[k * AM_STRIDE + j0 + 1];
        }
        Mt[i * 33 + j0] = m0;
        Mt[i * 33 + j0 + 1] = m1;
        __syncthreads();
        float t0 = 0.f, t1 = 0.f;
        for (int k = 0; k < 32; ++k) {
          const float a = Tm[(32 + i) * AM_STRIDE + 32 + k];
          t0 += a * Mt[k * 33 + j0];
          t1 += a * Mt[k * 33 + j0 + 1];
        }
        __syncthreads();
        Tm[(32 + i) * AM_STRIDE + j0] = -t0;
        Tm[(32 + i) * AM_STRIDE + j0 + 1] = -t1;
      }
    }
    __syncthreads();
    {
      const int e = tid & 127, rq = tid >> 7;
      float au[16], aw[16];
#pragma unroll
      for (int ii = 0; ii < 16; ++ii) { au[ii] = 0.f; aw[ii] = 0.f; }
      const int jmax = rq * 16 + 15;
      for (int j = 0; j <= jmax; ++j) {
        int t = c * 64 + j - 48;
        float bj = bet[j];
        float vb = (t >= 0) ? bj * Vd[((size_t)(b * T + t)) * 512 + h * 128 + e] : 0.f;
        float kb = bj * __expf(gc[j]) * Ks[j * KS_STRIDE + e];
#pragma unroll
        for (int ii = 0; ii < 16; ++ii) {
          float tij = Tm[(rq * 16 + ii) * AM_STRIDE + j];
          au[ii] += tij * vb;
          aw[ii] += tij * kb;
        }
      }
#pragma unroll
      for (int ii = 0; ii < 16; ++ii) {
        int i = rq * 16 + ii;
        {
          const int ri = i & 31, hh = (ri >> 2) & 1, reg = (ri & 3) + 4 * (ri >> 3);
          UU[(size_t)ci * 8192 + ((((e >> 5) * 2 + (i >> 5)) * 2 + hh) * 32 + (e & 31)) * 16 + reg] = au[ii];
        }
        chb[swzA(i, e)] = f2bf(-aw[ii]);
      }
    }
    const float glast = gc[63];
    for (int idx = tid; idx < 64 * 128; idx += NTHREADS) {
      int i = idx >> 7, d = idx & 127;
      chb[CH_QG + swzA(i, d)] = f2bf(Qs[i * KS_STRIDE + d] * __expf(gc[i]));
    }
    for (int idx = tid; idx < 64 * 128; idx += NTHREADS) {
      int i = idx & 63, d = idx >> 6;
      chb[CH_KDT + swzB(d, i)] = f2bf(Ks[i * KS_STRIDE + d] * __expf(glast - gc[i]));
    }
    if (tid == 0) DL[ci] = __expf(glast);
  }
}

DI unsigned ordkey(float f) {
  unsigned u = __float_as_uint(f);
  return (u & 0x80000000u) ? ~u : (u | 0x80000000u);
}
DI int half_sum(int v) {
  v += dppi<0xB1>(v); v += dppi<0x4E>(v); v += dppi<0x141>(v); v += dppi<0x140>(v);
  const int lo = __builtin_amdgcn_readlane(v, 0) + __builtin_amdgcn_readlane(v, 16);
  const int hi = __builtin_amdgcn_readlane(v, 32) + __builtin_amdgcn_readlane(v, 48);
  return (__builtin_amdgcn_mbcnt_hi(~0u, __builtin_amdgcn_mbcnt_lo(~0u, 0u)) < 32u) ? lo : hi;
}
DI void indexer_task(const Params& p, int b, int q0, int lane) {
  unsigned* MASK = (unsigned*)(p.ws + OFF_MASK);
  const int qsel = lane >> 5;
  const int tq = q0 + qsel;
  unsigned* mrow = MASK + ((size_t)b * SEQ + tq) * 128;
  if (q0 + 1 < 256) {
    for (int i = (lane & 31); i < 128; i += 32) {
      int rem = tq + 1 - 32 * i;
      unsigned w = (rem >= 32) ? 0xffffffffu : (rem > 0 ? ((1u << rem) - 1u) : 0u);
      mrow[i] = w;
    }
    return;
  }
  const unsigned short* QI = (const unsigned short*)(p.ws + OFF_QI);
  const unsigned short* KI = (const unsigned short*)(p.ws + OFF_KI);
  const float* WI = (const float*)(p.ws + OFF_WI);
  const int l15 = lane & 15, lg = lane >> 4;
  const size_t qtok = (size_t)b * T + NM + q0 + (l15 >> 3);
  const bf16x8 a0 = ld16(QI + qtok * 512 + (l15 & 7) * 64 + 8 * lg);
  const bf16x8 a1 = ld16(QI + qtok * 512 + (l15 & 7) * 64 + 32 + 8 * lg);
  float w[4];
  {
    const size_t wtok = (size_t)b * T + NM + q0 + (lg >> 1);
#pragma unroll
    for (int r = 0; r < 4; ++r) w[r] = WI[wtok * 8 + 4 * (lg & 1) + r];
  }
  const int npairs = (q0 + 2 + 31) >> 5;
  const unsigned short* kp = KI + ((size_t)b * T + NM) * 64 + (size_t)l15 * 64 + 8 * lg;
  unsigned u[128];
  int rem = tq - (lane & 31);
#pragma unroll
  for (int i = 0; i < 128; ++i) {
    unsigned uv = 0u;
    if (i < npairs) {
      float tot[2];
#pragma unroll
      for (int par = 0; par < 2; ++par) {
        const bf16x8 b0 = ld16(kp + par * 1024);
        const bf16x8 b1 = ld16(kp + par * 1024 + 32);
        f32x4 acc = {0.f, 0.f, 0.f, 0.f};
        acc = MFMA16(a0, b0, acc);
        acc = MFMA16(a1, b1, acc);
        float part = 0.f;
#pragma unroll
        for (int r = 0; r < 4; ++r) part += w[r] * fmaxf(acc[r], 0.f);
        tot[par] = part + xor16f(part, lane);
      }
      const float sc = (lg & 1) ? tot[1] : tot[0];
      uv = (rem >= 0) ? ordkey(sc) : 0u;
    }
    u[i] = uv;
    kp += 2048;
    rem -= 32;
    asm volatile("" : "+v"(kp), "+v"(rem));
  }
  unsigned thr = 0u;
  for (int bit = 31; bit >= 0; --bit) {
    const unsigned cand = thr | (1u << bit);
    int cnt = 0;
#pragma unroll
    for (int i = 0; i < 128; ++i) cnt += (u[i] >= cand) ? 1 : 0;
    cnt = half_sum(cnt);
    if (cnt >= 256) thr = cand;
  }
  int cgt = 0;
#pragma unroll
  for (int i = 0; i < 128; ++i) cgt += (u[i] > thr) ? 1 : 0;
  cgt = half_sum(cgt);
  const int need = 256 - cgt;
  int base = 0;
  const unsigned lt_mask = (1u << (lane & 31)) - 1u;
#pragma unroll
  for (int i = 0; i < 128; ++i) {
    const bool eq = (u[i] == thr);
    const unsigned long long eb = __ballot(eq);
    const unsigned ehalf = qsel ? (unsigned)(eb >> 32) : (unsigned)eb;
    const int below = __popc(ehalf & lt_mask);
    const bool sel = (u[i] > thr) || (eq && (base + below < need));
    base += __popc(ehalf);
    const unsigned long long sb = __ballot(sel);
    const unsigned shalf = qsel ? (unsigned)(sb >> 32) : (unsigned)sb;
    if ((lane & 31) == 0) mrow[i] = shalf;
  }
}
DI void phase_indexer(const Params& p) {
  const int lane = otid(p) & 63, wave = otid(p) >> 6;
  const int ntask = NB * (SEQ / 2);
  for (int k = blockIdx.x * NWAVES + wave; k < ntask; k += gridDim.x * NWAVES) {
    const int b = k & 3, qp = (SEQ / 2 - 1) - (k >> 2);
    indexer_task(p, b, qp * 2, lane);
  }
}

DI void attn_task(const Params& p, int b, int hh, int qt, int lane) {
  const unsigned short* Qb = (const unsigned short*)(p.ws + OFF_QB);
  const unsigned short* Kb = (const unsigned short*)(p.ws + OFF_KB);
  const unsigned short* Vt = (const unsigned short*)(p.ws + OFF_VT);
  const unsigned* MASK = (const unsigned*)(p.ws + OFF_MASK);
  unsigned short* MIX = (unsigned short*)(p.ws + OFF_MIX);
  const int lr = lane & 31, lh = lane >> 5;
  const int tq = qt * 32 + lr;
  const size_t qtok = (size_t)b * T + NM + tq;
  bf16x8 qf[4];
#pragma unroll
  for (int ks = 0; ks < 4; ++ks) qf[ks] = ld16(Qb + qtok * 512 + hh * 64 + ks * 16 + 8 * lh);
  const unsigned* mrow = MASK + ((size_t)b * SEQ + tq) * 128;
  const unsigned short* vbase = Vt + ((size_t)b * 8 + hh) * 64 * T;
  f32x16 o[2];
#pragma unroll
  for (int i = 0; i < 2; ++i)
#pragma unroll
    for (int r = 0; r < 16; ++r) o[i][r] = 0.f;
  float m = -1e30f, lsum = 0.f;
  const float scale = 0.125f;
  for (int tile = -1; tile <= qt; ++tile) {
    const int base = (tile < 0) ? 0 : (NM + 32 * tile);
    const unsigned word = (tile < 0) ? 0x0000ffffu : mrow[tile];
    f32x16 s;
#pragma unroll
    for (int r = 0; r < 16; ++r) s[r] = 0.f;
    const size_t ktok = (size_t)b * T + base + lr;
#pragma unroll
    for (int ks = 0; ks < 4; ++ks) {
      bf16x8 kf = ld16(Kb + ktok * 512 + hh * 64 + ks * 16 + 8 * lh);
      s = MFMA32(kf, qf[ks], s);
    }
    float tmax = -1e30f;
#pragma unroll
    for (int r = 0; r < 16; ++r) {
      const bool valid = (word >> crow(r, lh)) & 1u;
      s[r] = valid ? s[r] * scale : -1e30f;
      tmax = fmaxf(tmax, s[r]);
    }
    tmax = fmaxf(tmax, xor32f(tmax, lane));
    const float mnew = fmaxf(m, tmax);
    const float alpha = __expf(m - mnew);
    float psum = 0.f;
#pragma unroll
    for (int r = 0; r < 16; ++r) {
      const bool valid = (word >> crow(r, lh)) & 1u;
      const float pv = valid ? __expf(s[r] - mnew) : 0.f;
      s[r] = pv;
      psum += pv;
    }
    psum += xor32f(psum, lane);
    lsum = lsum * alpha + psum;
    m = mnew;
#pragma unroll
    for (int i = 0; i < 2; ++i)
#pragma unroll
      for (int r = 0; r < 16; ++r) o[i][r] *= alpha;
#pragma unroll
    for (int ss = 0; ss < 2; ++ss) {
      const bf16x8 pf = pack8(s, ss);
#pragma unroll
      for (int dt = 0; dt < 2; ++dt) {
        const unsigned short* vp = vbase + (size_t)(dt * 32 + lr) * T + base + 16 * ss + 4 * lh;
        const bf16x8 vf = ld8x2(vp, vp + 8);
        o[dt] = MFMA32(vf, pf, o[dt]);
      }
    }
  }
  const float inv = 1.f / lsum;
#pragma unroll
  for (int dt = 0; dt < 2; ++dt)
#pragma unroll
    for (int r = 0; r < 16; ++r) MIX[qtok * 1024 + hh * 64 + dt * 32 + crow(r, lh)] = f2bf(o[dt][r] * inv);
}
DI void attn_worker(const Params& p, int lane) {
  unsigned* ctr = (unsigned*)(p.ws + OFF_BAR + 15872);
  const int ntask = NB * 8 * 128;
  for (;;) {
    int k = 0;
    if (lane == 0) k = (int)__hip_atomic_fetch_add(ctr, 1u, __ATOMIC_RELAXED, __HIP_MEMORY_SCOPE_AGENT);
    k = __builtin_amdgcn_readfirstlane(k);
    if (k >= ntask) break;
    const int bh = k & 31, qt = 127 - (k >> 5);
    attn_task(p, bh >> 3, bh & 7, qt, lane);
  }
}

DI bf16x8 lds8x2(const LAS unsigned short* p0, const LAS unsigned short* p1) {
  typedef unsigned u32x2_t __attribute__((ext_vector_type(2)));
  typedef unsigned u32x4_t __attribute__((ext_vector_type(4)));
  const u32x2_t a = *(const LAS u32x2_t*)p0, b = *(const LAS u32x2_t*)p1;
  const u32x4_t r = {a[0], a[1], b[0], b[1]};
  return __builtin_bit_cast(bf16x8, r);
}
DI void scan_block(const Params& p, char* smem, int bh) {
  const int tid = otid(p), lane = tid & 63, wave = __builtin_amdgcn_readfirstlane(tid >> 6);
  const int b = bh >> 2, h = bh & 3;
  LAS unsigned char* lds = (LAS unsigned char*)smem;
  const unsigned short* CHB = (const unsigned short*)(p.ws + OFF_WN) + (size_t)bh * NCH * CHB_ELEMS;
  const float* UU = (const float*)(p.ws + OFF_UU) + (size_t)bh * NCH * 8192;
  const float* DL = (const float*)(p.ws + OFF_DL) + (size_t)bh * NCH;
  float* OD = (float*)(p.ws + OFF_OD);
  constexpr int CHB_BYTES = CHB_ELEMS * 2;
  __syncthreads();
  if (wave >= 4) {
    const int w4 = wave - 4;
    for (int c = 0; c <= NCH; ++c) {
      if (c < NCH) {
        const char* src = (const char*)(CHB + (size_t)c * CHB_ELEMS) + (size_t)(w4 * 15) * 1024 + lane * 16;
        const unsigned dst = (unsigned)((c & 1) * CHB_BYTES + (w4 * 15) * 1024);
#pragma unroll
        for (int j = 0; j < 15; ++j)
          __builtin_amdgcn_global_load_lds((const unsigned*)(src + j * 1024), (LAS unsigned*)(lds + dst + j * 1024), 16, 0, 0);
      }
      asm volatile("s_waitcnt vmcnt(0)" ::: "memory");
      __builtin_amdgcn_s_barrier();
    }
  } else {
    const int sl = wave, lr = lane & 31, lh = lane >> 5, e0 = sl * 32;
    f32x16 S[4];
#pragma unroll
    for (int i = 0; i < 4; ++i)
#pragma unroll
      for (int r = 0; r < 16; ++r) S[i][r] = 0.f;
    f32x16 un[2];
    const float* up0 = UU + ((size_t)(sl * 2) * 2 + lh) * 512 + lr * 16;
#pragma unroll
    for (int pt = 0; pt < 2; ++pt)
#pragma unroll
      for (int q = 0; q < 4; ++q) {
        const float4 v = *(const float4*)(up0 + pt * 1024 + q * 4);
        un[pt][4 * q] = v.x; un[pt][4 * q + 1] = v.y; un[pt][4 * q + 2] = v.z; un[pt][4 * q + 3] = v.w;
      }
    const int oA = lr * 132 + 4 * lh;
    const int oB = lr * 68 + 4 * lh;
    __builtin_amdgcn_s_barrier();
    for (int c = 0; c < NCH; ++c) {
      const LAS unsigned short* cb = (const LAS unsigned short*)(lds + (c & 1) * CHB_BYTES);
      f32x16 vn[2];
      vn[0] = un[0];
      vn[1] = un[1];
#pragma unroll
      for (int pt = 0; pt < 2; ++pt) {
#pragma unroll
        for (int mt = 0; mt < 4; ++mt)
#pragma unroll
          for (int s2 = 0; s2 < 2; ++s2) {
            const LAS unsigned short* ap = cb + oA + pt * 32 * 132 + mt * 32 + 16 * s2;
            vn[pt] = MFMA32(lds8x2(ap, ap + 8), pack8(S[mt], s2), vn[pt]);
          }
      }
      bf16x8 vb[2][2];
#pragma unroll
      for (int pt = 0; pt < 2; ++pt)
#pragma unroll
        for (int s2 = 0; s2 < 2; ++s2) vb[pt][s2] = pack8(vn[pt], s2);
#pragma unroll
      for (int pt = 0; pt < 2; ++pt) {
        f32x16 o;
#pragma unroll
        for (int r = 0; r < 16; ++r) o[r] = 0.f;
#pragma unroll
        for (int mt = 0; mt < 4; ++mt)
#pragma unroll
          for (int s2 = 0; s2 < 2; ++s2) {
            const LAS unsigned short* ap = cb + CH_QG + oA + pt * 32 * 132 + mt * 32 + 16 * s2;
            o = MFMA32(lds8x2(ap, ap + 8), pack8(S[mt], s2), o);
          }
#pragma unroll
        for (int pt2 = 0; pt2 <= pt; ++pt2)
#pragma unroll
          for (int s2 = 0; s2 < 2; ++s2) {
            const LAS unsigned short* ap = cb + CH_IN + oB + pt * 32 * 68 + pt2 * 32 + 16 * s2;
            o = MFMA32(lds8x2(ap, ap + 8), vb[pt2][s2], o);
          }
#pragma unroll
        for (int r = 0; r < 16; ++r) {
          const int t = c * 64 + pt * 32 + crow(r, lh) - 48;
          if (t >= 0) OD[((size_t)(b * T + t)) * 512 + h * 128 + e0 + lr] = o[r];
        }
      }
      if (c + 1 < NCH) {
        const float* up = up0 + (size_t)(c + 1) * 8192;
#pragma unroll
        for (int pt = 0; pt < 2; ++pt)
#pragma unroll
          for (int q = 0; q < 4; ++q) {
            const float4 v = *(const float4*)(up + pt * 1024 + q * 4);
            un[pt][4 * q] = v.x; un[pt][4 * q + 1] = v.y; un[pt][4 * q + 2] = v.z; un[pt][4 * q + 3] = v.w;
          }
      }
      const float dl = DL[c];
#pragma unroll
      for (int mt = 0; mt < 4; ++mt) {
#pragma unroll
        for (int r = 0; r < 16; ++r) S[mt][r] *= dl;
#pragma unroll
        for (int pt2 = 0; pt2 < 2; ++pt2)
#pragma unroll
          for (int s2 = 0; s2 < 2; ++s2) {
            const LAS unsigned short* ap = cb + CH_KDT + oB + mt * 32 * 68 + pt2 * 32 + 16 * s2;
            S[mt] = MFMA32(lds8x2(ap, ap + 8), vb[pt2][s2], S[mt]);
          }
      }
      asm volatile("s_waitcnt lgkmcnt(0)" ::: "memory");
      __builtin_amdgcn_s_barrier();
    }
  }
  __syncthreads();
}
DI void phase_scan_attn(const Params& p, char* smem) {
  const int lane = otid(p) & 63;
  if (blockIdx.x < 16) scan_block(p, smem, blockIdx.x);
  attn_worker(p, lane);
}

DI void phase_gnorm(const Params& p) {
  const int tid = otid(p), lane = tid & 63, wave = tid >> 6;
  const float* OD = (const float*)(p.ws + OFF_OD);
  const float* P = (const float*)(p.ws + OFF_P);
  unsigned short* MIX = (unsigned short*)(p.ws + OFF_MIX);
  for (int r = blockIdx.x * NWAVES + wave; r < NR; r += gridDim.x * NWAVES) {
    const int tok = r + 16 * (r / SEQ + 1);
#pragma unroll
    for (int hd = 0; hd < 4; ++hd) {
      float o0 = OD[(size_t)tok * 512 + hd * 128 + lane], o1 = OD[(size_t)tok * 512 + hd * 128 + 64 + lane];
      float ss = wave_sum(o0 * o0 + o1 * o1);
      float rstd = rsqrtf(ss * (1.f / 128.f) + 1e-6f);
      float z0 = P[(size_t)tok * INC + C_BZ + hd * 128 + lane], z1 = P[(size_t)tok * INC + C_BZ + hd * 128 + 64 + lane];
      float y0 = o0 * rstd * p.delta_norm_w[lane] * (z0 / (1.f + __expf(-z0)));
      float y1 = o1 * rstd * p.delta_norm_w[64 + lane] * (z1 / (1.f + __expf(-z1)));
      MIX[(size_t)tok * 1024 + 512 + hd * 128 + lane] = f2bf(y0);
      MIX[(size_t)tok * 1024 + 512 + hd * 128 + 64 + lane] = f2bf(y1);
    }
  }
}

DI void phase_router(const Params& p, char* smem) {
  const int tid = otid(p), lane = tid & 63, wave = tid >> 6;
  float* lg = (float*)smem + wave * (32 * 33);
  const float* H1 = (const float*)(p.ws + OFF_H1);
  const float* wrs = (const float*)(p.ws + OFF_WRS);
  unsigned short* U2 = (unsigned short*)(p.ws + OFF_U2);
  int* TOPE = (int*)(p.ws + OFF_TOPE);
  float* GATEV = (float*)(p.ws + OFF_GATEV);
  int* POS = (int*)(p.ws + OFF_POS);
  int* CNT = (int*)(p.ws + OFF_CNT);
  const int lr = lane & 31, lh = lane >> 5;
  for (int task = blockIdx.x * NWAVES + wave; task < NR / 32; task += gridDim.x * NWAVES) {
    const int r0 = task * 32;
    float myrstd = 0.f;
    for (int tt = 0; tt < 32; ++tt) {
      const float* src = H1 + (size_t)(r0 + tt) * 1024;
      float4 v[4];
      float ss = 0.f;
#pragma unroll
      for (int i = 0; i < 4; ++i) {
        v[i] = *(const float4*)(src + lane * 4 + 256 * i);
        ss += v[i].x * v[i].x + v[i].y * v[i].y + v[i].z * v[i].z + v[i].w * v[i].w;
      }
      ss = wave_sum(ss);
      const float rstd = rsqrtf(ss * (1.f / 1024.f) + 1e-6f);
      myrstd = (lr == tt) ? rstd : myrstd;
#pragma unroll
      for (int i = 0; i < 4; ++i) {
        float4 w = *(const float4*)(p.norm_ffn_w + lane * 4 + 256 * i);
        uint2 o;
        o.x = pk2(v[i].x * rstd * w.x, v[i].y * rstd * w.y);
        o.y = pk2(v[i].z * rstd * w.z, v[i].w * rstd * w.w);
        *(uint2*)(U2 + (size_t)(r0 + tt) * 1024 + lane * 4 + 256 * i) = o;
      }
    }
    f32x16 acc;
#pragma unroll
    for (int i = 0; i < 16; ++i) acc[i] = 0.f;
    const float* arow = H1 + (size_t)(r0 + lr) * 1024;
    const float* bcol = wrs + lh * 32 + lr;
#pragma unroll 4
    for (int k0 = 0; k0 < 1024; k0 += 4) {
      const float4 a4 = *(const float4*)(arow + k0);
      const float b0 = bcol[(size_t)k0 * 32], b1 = bcol[(size_t)(k0 + 2) * 32];
      acc = __builtin_amdgcn_mfma_f32_32x32x2f32(lh ? a4.y : a4.x, b0, acc, 0, 0, 0);
      acc = __builtin_amdgcn_mfma_f32_32x32x2f32(lh ? a4.w : a4.z, b1, acc, 0, 0, 0);
    }
#pragma unroll
    for (int r = 0; r < 16; ++r) lg[crow(r, lh) * 33 + lr] = acc[r];
    __builtin_amdgcn_s_waitcnt(0xc07f);
    __builtin_amdgcn_wave_barrier();
    if (lane < 32) {
      float lv[32];
#pragma unroll
      for (int e = 0; e < 32; ++e) lv[e] = lg[lane * 33 + e] * myrstd + p.b_router[e];
      float tv[4];
      int te[4];
#pragma unroll
      for (int k = 0; k < 4; ++k) {
        float bv = lv[0];
        int bi = 0;
#pragma unroll
        for (int e = 1; e < 32; ++e)
          if (lv[e] > bv) { bv = lv[e]; bi = e; }
        tv[k] = bv;
        te[k] = bi;
#pragma unroll
        for (int e = 0; e < 32; ++e)
          if (e == bi) lv[e] = -3.0e38f;
      }
      const float e1 = __expf(tv[1] - tv[0]), e2 = __expf(tv[2] - tv[0]), e3 = __expf(tv[3] - tv[0]);
      const float inv = 1.f / (1.f + e1 + e2 + e3);
      const size_t rr = (size_t)(r0 + lane) * 4;
      TOPE[rr + 0] = te[0]; TOPE[rr + 1] = te[1]; TOPE[rr + 2] = te[2]; TOPE[rr + 3] = te[3];
      GATEV[rr + 0] = inv; GATEV[rr + 1] = e1 * inv; GATEV[rr + 2] = e2 * inv; GATEV[rr + 3] = e3 * inv;
      POS[rr + 0] = atomicAdd(&CNT[te[0]], 1);
      POS[rr + 1] = atomicAdd(&CNT[te[1]], 1);
      POS[rr + 2] = atomicAdd(&CNT[te[2]], 1);
      POS[rr + 3] = atomicAdd(&CNT[te[3]], 1);
    }
    __builtin_amdgcn_wave_barrier();
  }
}
DI void phase_lists(const Params& p) {
  const int* CNT = (const int*)(p.ws + OFF_CNT);
  const int* TOPE = (const int*)(p.ws + OFF_TOPE);
  const float* GATEV = (const float*)(p.ws + OFF_GATEV);
  const int* POS = (const int*)(p.ws + OFF_POS);
  int* SLOT = (int*)(p.ws + OFF_SLOT);
  int* LTOK = (int*)(p.ws + OFF_LTOK);
  float* LGATE = (float*)(p.ws + OFF_LGATE);
  for (int a = blockIdx.x * NTHREADS + otid(p); a < NASG; a += gridDim.x * NTHREADS) {
    const int e = TOPE[a];
    int off = 0;
    for (int j = 0; j < e; ++j) off += CNT[j];
    const int slot = off + POS[a];
    SLOT[a] = slot;
    LTOK[slot] = a >> 2;
    LGATE[slot] = GATEV[a];
  }
}
DI void phase_combine(const Params& p) {
  const float* H1 = (const float*)(p.ws + OFF_H1);
  const unsigned short* Y = (const unsigned short*)(p.ws + OFF_Y);
  const int* SLOT = (const int*)(p.ws + OFF_SLOT);
  for (int idx = blockIdx.x * NTHREADS + otid(p); idx < NR * 256; idx += gridDim.x * NTHREADS) {
    const int r = idx >> 8, c4 = (idx & 255) * 4;
    float4 a = *(const float4*)(H1 + (size_t)r * 1024 + c4);
#pragma unroll
    for (int k = 0; k < 4; ++k) {
      const int slot = SLOT[r * 4 + k];
      uint2 y = *(const uint2*)(Y + (size_t)slot * 1024 + c4);
      a.x += bf2f((unsigned short)(y.x & 0xffffu));
      a.y += bf2f((unsigned short)(y.x >> 16));
      a.z += bf2f((unsigned short)(y.y & 0xffffu));
      a.w += bf2f((unsigned short)(y.y >> 16));
    }
    *(float4*)(p.out + (size_t)r * 1024 + c4) = a;
  }
}


#define XB_TMO      128
#define XB_XCNT(j)  (256  + 64 * (j))
#define XB_XSUB(j)  (1280 + 64 * (j))
#define XB_XGEN(j)  (2304 + 64 * (j))
#define XB_TOP      3328
#define XB_TOPGEN   3392
#define XB_SPIN_CAP (1u << 22)
DI unsigned xb_ld(unsigned* p) { return __hip_atomic_load(p, __ATOMIC_RELAXED, __HIP_MEMORY_SCOPE_AGENT); }
DI unsigned xb_add(unsigned* p, unsigned v) { return __hip_atomic_fetch_add(p, v, __ATOMIC_RELAXED, __HIP_MEMORY_SCOPE_AGENT); }
DI unsigned xb_xcc_id() { return (unsigned)__builtin_amdgcn_s_getreg((3 << 11) | 20) & 0xFu; }
#define XB_SPIN(cond, bar) do { unsigned _sp = 0; while (cond) { __builtin_amdgcn_s_sleep(1); \
    if ((++_sp & 255u) == 0u) { if (xb_ld(&(bar)[XB_TMO])) break; if (_sp > XB_SPIN_CAP) { atomicAdd(&(bar)[XB_TMO], 1u); break; } } } } while (0)
struct XcdBarrier { unsigned* bar; unsigned x; volatile LAS unsigned* st; bool leader; };
DI void xcd_barrier_complete(unsigned* bar, unsigned x, unsigned& nloc, unsigned& nx) {
  const unsigned G = gridDim.x * gridDim.y * gridDim.z;
  unsigned sum, cnt, mine, sp = 0u;
  for (;;) {
    sum = 0u; cnt = 0u; mine = 0u;
#pragma unroll
    for (unsigned j = 0; j < 16; ++j) { const unsigned c = xb_ld(&bar[XB_XCNT(j)]); sum += c; cnt += (c > 0u) ? 1u : 0u; mine = (j == x) ? c : mine; }
    if (sum == G) break;
    __builtin_amdgcn_s_sleep(1);
    if ((++sp & 255u) == 0u) { if (xb_ld(&bar[XB_TMO])) break; if (sp > XB_SPIN_CAP) { atomicAdd(&bar[XB_TMO], 1u); break; } }
  }
  nloc = mine > 0u ? mine : 1u; nx = cnt > 0u ? cnt : 1u;
}
DI void xcd_barrier(const XcdBarrier& b) {
  asm volatile("s_waitcnt vmcnt(0)" ::: "memory");
  __syncthreads();
  if (b.leader) {
    unsigned* bar = b.bar;
    __builtin_amdgcn_s_waitcnt(0);
    unsigned nloc = b.st[0], nx = b.st[1];
    if (nloc == 0u) { xcd_barrier_complete(bar, b.x, nloc, nx); b.st[0] = nloc; b.st[1] = nx; }
    const unsigned old = xb_add(&bar[XB_XSUB(b.x)], 1u);
    const unsigned gen = old / nloc;
    if (old + 1u == (gen + 1u) * nloc) {
      __builtin_amdgcn_fence(__ATOMIC_RELEASE, "agent");
      asm volatile("s_waitcnt vmcnt(0)" ::: "memory");
      const unsigned og = xb_add(&bar[XB_TOP], 1u);
      const unsigned tg = og / nx;
      if (og + 1u == (tg + 1u) * nx) xb_add(&bar[XB_TOPGEN], 1u);
      else XB_SPIN(xb_ld(&bar[XB_TOPGEN]) == tg, bar);
      __builtin_amdgcn_fence(__ATOMIC_ACQUIRE, "agent");
      xb_add(&bar[XB_XGEN(b.x)], 1u);
      asm volatile("s_waitcnt vmcnt(0)" ::: "memory");
    } else {
      XB_SPIN(xb_ld(&bar[XB_XGEN(b.x)]) == gen, bar);
      __builtin_amdgcn_fence(__ATOMIC_ACQUIRE, "agent");
      asm volatile("s_waitcnt vmcnt(0)" ::: "memory");
    }
  }
  __syncthreads();
}

constexpr int SMEM_BYTES = g8::STAGE_BYTES + 1024;

__global__ void __launch_bounds__(NTHREADS) mk(Params p0) {
  __shared__ __attribute__((aligned(16))) char smem[SMEM_BYTES];
  Params p = p0;
  p.wv = __builtin_amdgcn_readfirstlane((int)(threadIdx.x >> 6));
  XcdBarrier xb;
  {
    volatile LAS unsigned* st = (volatile LAS unsigned*)((LAS unsigned char*)smem + g8::STAGE_BYTES + 768);
    if (threadIdx.x == 0) { st[0] = 0u; st[1] = 0u; }
    __syncthreads();
    xb.bar = (unsigned*)(p.ws + OFF_BAR); xb.x = xb_xcc_id(); xb.st = st; xb.leader = (threadIdx.x == 0);
    if (xb.leader) (void)xb_add(&xb.bar[XB_XCNT(xb.x)], 1u);
  }
  phase_prep(p);
  phase_wconv(p, smem, 0, WC_ALL);
  xcd_barrier(xb);
  g8::gemm_phase<0>(p, smem);
  xcd_barrier(xb);
  phase_post1(p);
  xcd_barrier(xb);
  g8::gemm_phase<1>(p, smem);
  phase_chunkprep(p, smem);
  xcd_barrier(xb);
  phase_post2(p);
  phase_indexer(p);
  xcd_barrier(xb);
  phase_scan_attn(p, smem);
  xcd_barrier(xb);
  phase_gnorm(p);
  xcd_barrier(xb);
  g8::gemm_phase<2>(p, smem);
  xcd_barrier(xb);
  phase_router(p, smem);
  xcd_barrier(xb);
  phase_lists(p);
  xcd_barrier(xb);
  g8::gemm_phase<3>(p, smem);
  xcd_barrier(xb);
  g8::gemm_phase<4>(p, smem);
  xcd_barrier(xb);
  phase_combine(p);
}

extern "C" void kernel_launch(void* const* d_in, const int* in_sizes, int n_in, void* d_out, int out_size, void* d_ws,
                              size_t ws_size, hipStream_t stream) {
  (void)in_sizes; (void)n_in; (void)out_size;
  if (ws_size < WS_NEED) return;
  Params p{};
  p.x = (const float*)d_in[0]; p.meta = (const float*)d_in[1]; p.norm_mix_w = (const float*)d_in[2];
  p.w_in = (const float*)d_in[3]; p.q_norm_w = (const float*)d_in[4]; p.k_norm_w = (const float*)d_in[5];
  p.kv_norm_w = (const float*)d_in[6]; p.w_kv_up = (const float*)d_in[7]; p.conv_w = (const float*)d_in[8];
  p.a_log = (const float*)d_in[9]; p.dt_bias = (const float*)d_in[10]; p.delta_norm_w = (const float*)d_in[11];
  p.w_out = (const float*)d_in[12]; p.norm_ffn_w = (const float*)d_in[13]; p.w_router = (const float*)d_in[14];
  p.b_router = (const float*)d_in[15]; p.w_gate_up = (const float*)d_in[16]; p.b_gate_up = (const float*)d_in[17];
  p.w_down = (const float*)d_in[18]; p.b_down = (const float*)d_in[19];
  p.out = (float*)d_out;
  p.ws = (char*)d_ws;
  (void)hipMemsetAsync((char*)d_ws + OFF_CNT, 0, 4096, stream);
  (void)hipMemsetAsync((char*)d_ws + OFF_BAR, 0, 16384, stream);
  static int grid_blocks = 0;
  if (!grid_blocks) {
    int dev = 0, cus = 0, per_cu = 0;
    (void)hipGetDevice(&dev);
    (void)hipDeviceGetAttribute(&cus, hipDeviceAttributeMultiprocessorCount, dev);
    (void)hipOccupancyMaxActiveBlocksPerMultiprocessor(&per_cu, mk, NTHREADS, 0);
    if (per_cu > 1) per_cu = 1;
    grid_blocks = cus * per_cu;
  }
  void* args[] = {&p};
  hipError_t e = hipLaunchCooperativeKernel((void*)mk, dim3(grid_blocks), dim3(NTHREADS), args, 0, stream);
  if (e != hipSuccess) fprintf(stderr, "cooperative launch failed: %s (grid %d)\n", hipGetErrorString(e), grid_blocks);
}
```

```cpp
#include <hip/hip_runtime.h>
#include <stdint.h>
#include <stdio.h>


typedef __attribute__((ext_vector_type(8))) short bf16x8;
typedef __attribute__((ext_vector_type(4))) short s16x4;
typedef __attribute__((ext_vector_type(16))) float f32x16;
typedef __attribute__((ext_vector_type(4))) float f32x4;
typedef __bf16 bf2_t __attribute__((ext_vector_type(2)));
#define DI __device__ __forceinline__
#define MFMA32(a, b, c) __builtin_amdgcn_mfma_f32_32x32x16_bf16((a), (b), (c), 0, 0, 0)
#define MFMA16(a, b, c) __builtin_amdgcn_mfma_f32_16x16x32_bf16((a), (b), (c), 0, 0, 0)

constexpr int NB = 4, SEQ = 4096, NM = 16, T = 4112, NT = NB * T, NR = NB * SEQ, D = 1024, INC = 3408;
constexpr int C_AQ = 0, C_CKV = 512, C_IQ = 768, C_IK = 1280, C_IW = 1344, C_BQKV = 1352, C_BZ = 2888, C_BBETA = 3400, C_BA = 3404;
constexpr int NCH = 65, NCHT = NB * 4 * NCH;
constexpr int NEXP = 32, NASG = NR * 4;
constexpr int NTHREADS = 512, NWAVES = 8;

constexpr size_t al256(size_t x) { return (x + 255) & ~(size_t)255; }
constexpr size_t OFF_U = 0;
constexpr int NTP = 16640;
constexpr size_t OFF_P = OFF_U + al256((size_t)NTP * 1024 * 2);
constexpr size_t OFF_ROPE = OFF_P + al256((size_t)NT * INC * 4);
constexpr size_t OFF_QB = OFF_ROPE + al256((size_t)T * 64 * 4);
constexpr size_t OFF_KB = OFF_QB + al256((size_t)NT * 512 * 2);
constexpr size_t OFF_VT = OFF_KB + al256((size_t)NT * 512 * 2);
constexpr size_t OFF_QI = OFF_VT + al256((size_t)NT * 512 * 2);
constexpr size_t OFF_KI = OFF_QI + al256((size_t)NT * 512 * 2);
constexpr size_t OFF_WI = OFF_KI + al256((size_t)NT * 64 * 2);
constexpr size_t OFF_CKV = OFF_WI + al256((size_t)NT * 8 * 4);
constexpr size_t OFF_KV = OFF_CKV + al256((size_t)NTP * 256 * 2);
constexpr size_t OFF_MASK = OFF_KV + al256((size_t)NT * 1024 * 4);
constexpr size_t OFF_MIX = OFF_MASK + al256((size_t)NB * SEQ * 128 * 4);
constexpr size_t OFF_QD = OFF_MIX + al256((size_t)NT * 1024 * 2);
constexpr size_t OFF_KD = OFF_QD + al256((size_t)NT * 512 * 4);
constexpr size_t OFF_VD = OFF_KD + al256((size_t)NT * 512 * 4);
constexpr size_t OFF_BETA = OFF_VD + al256((size_t)NT * 512 * 4);
constexpr size_t OFF_G = OFF_BETA + al256((size_t)NT * 4 * 4);
constexpr int CHB_ELEMS = 30720, CH_QG = 8448, CH_KDT = 16896, CH_IN = 25600;
constexpr size_t OFF_WN = OFF_G + al256((size_t)NT * 4 * 4);
constexpr size_t OFF_UU = OFF_WN + al256((size_t)NCHT * CHB_ELEMS * 2);
constexpr size_t OFF_DL = OFF_UU + al256((size_t)NCHT * 64 * 128 * 4);
constexpr size_t OFF_OD = OFF_DL + al256((size_t)NCHT * 4);
constexpr size_t OFF_U2 = OFF_OD + al256((size_t)NT * 512 * 4);
constexpr size_t OFF_TOPE = OFF_U2 + al256((size_t)NR * 1024 * 2);
constexpr size_t OFF_GATEV = OFF_TOPE + al256((size_t)NR * 4 * 4);
constexpr size_t OFF_POS = OFF_GATEV + al256((size_t)NR * 4 * 4);
constexpr size_t OFF_SLOT = OFF_POS + al256((size_t)NR * 4 * 4);
constexpr size_t OFF_LTOK = OFF_SLOT + al256((size_t)NR * 4 * 4);
constexpr size_t OFF_LGATE = OFF_LTOK + al256((size_t)NASG * 4);
constexpr size_t OFF_WTIN = OFF_LGATE + al256((size_t)NASG * 4);
constexpr size_t OFF_WTKV = OFF_WTIN + al256((size_t)3584 * 1024 * 2);
constexpr size_t OFF_WTOUT = OFF_WTKV + al256((size_t)1024 * 256 * 2);
constexpr size_t OFF_WTGU = OFF_WTOUT + al256((size_t)1024 * 1024 * 2);
constexpr size_t OFF_WTDN = OFF_WTGU + al256((size_t)32 * 2048 * 1024 * 2);
constexpr size_t OFF_CNT = OFF_WTDN + al256((size_t)32 * 1024 * 1024 * 2);
constexpr size_t OFF_Y = OFF_QD;
static_assert(OFF_U2 - OFF_QD >= (size_t)NASG * 1024 * 2, "Y alias does not fit");
static_assert((size_t)(NASG + 256) * 1024 * 2 <= (size_t)NT * INC * 4, "HD alias does not fit");
constexpr size_t OFF_WRS = OFF_CNT + 4096;
constexpr size_t OFF_SST = OFF_WRS + 131072;
constexpr size_t OFF_BAR = OFF_SST + (size_t)16 * 4 * 64 * 64 * 4;
constexpr size_t WS_NEED = OFF_BAR + 16384;
constexpr size_t OFF_H1 = OFF_KV;
constexpr size_t OFF_HD = OFF_P;

struct Params {
  const float *x, *meta, *norm_mix_w, *w_in, *q_norm_w, *k_norm_w, *kv_norm_w, *w_kv_up, *conv_w, *a_log, *dt_bias,
      *delta_norm_w, *w_out, *norm_ffn_w, *w_router, *b_router, *w_gate_up, *b_gate_up, *w_down, *b_down;
  float* out;
  char* ws;
  int wv;
  int pad0;
};

DI unsigned pk2(float a, float b) { bf2_t v; v[0] = (__bf16)a; v[1] = (__bf16)b; return __builtin_bit_cast(unsigned, v); }
DI unsigned short f2bf(float a) { return (unsigned short)(pk2(a, 0.f) & 0xffffu); }
DI float bf2f(unsigned short u) { return __uint_as_float(((unsigned)u) << 16); }
template <int CTRL> DI float dppf(float v) { return __builtin_bit_cast(float, __builtin_amdgcn_update_dpp(0, __builtin_bit_cast(int, v), CTRL, 0xf, 0xf, false)); }
template <int CTRL> DI int dppi(int v) { return __builtin_amdgcn_update_dpp(0, v, CTRL, 0xf, 0xf, false); }
DI float rlf(float v, int l) { return __builtin_bit_cast(float, __builtin_amdgcn_readlane(__builtin_bit_cast(int, v), l)); }
DI float wave_sum(float v) {
  v += dppf<0xB1>(v); v += dppf<0x4E>(v); v += dppf<0x141>(v); v += dppf<0x140>(v);
  return (rlf(v, 0) + rlf(v, 16)) + (rlf(v, 32) + rlf(v, 48));
}
DI float xor32f(float v, int lane) {
  auto r = __builtin_amdgcn_permlane32_swap(__builtin_bit_cast(unsigned, v), __builtin_bit_cast(unsigned, v), false, false);
  return __builtin_bit_cast(float, (lane < 32) ? r[1] : r[0]);
}
DI float xor16f(float v, int lane) {
  auto r = __builtin_amdgcn_permlane16_swap(__builtin_bit_cast(unsigned, v), __builtin_bit_cast(unsigned, v), false, false);
  return __builtin_bit_cast(float, (lane & 16) ? r[0] : r[1]);
}
DI int otid(const Params& p) {
  int l;
  asm volatile("v_mbcnt_lo_u32_b32 %0, -1, 0\n\tv_mbcnt_hi_u32_b32 %0, -1, %0" : "=v"(l));
  return (p.wv << 6) | l;
}
DI int swzA(int row, int col) { return row * 132 + col; }
DI int swzB(int row, int col) { return row * 68 + col; }
DI int crow(int reg, int h) { return (reg & 3) + 8 * (reg >> 2) + 4 * h; }
DI bf16x8 pack8(const f32x16& x, int s) {
  uint4 p;
  p.x = pk2(x[8 * s + 0], x[8 * s + 1]); p.y = pk2(x[8 * s + 2], x[8 * s + 3]);
  p.z = pk2(x[8 * s + 4], x[8 * s + 5]); p.w = pk2(x[8 * s + 6], x[8 * s + 7]);
  return __builtin_bit_cast(bf16x8, p);
}
DI bf16x8 ld8x2(const unsigned short* p0, const unsigned short* p1) {
  uint2 a = *(const uint2*)p0, b = *(const uint2*)p1;
  uint4 r = make_uint4(a.x, a.y, b.x, b.y);
  return __builtin_bit_cast(bf16x8, r);
}
DI bf16x8 ld16(const unsigned short* p) { uint4 r = *(const uint4*)p; return __builtin_bit_cast(bf16x8, r); }
DI const float* hrow(const Params& p, int tok) {
  int b = tok / T, t = tok - b * T;
  return (t < NM) ? (p.meta + (size_t)t * D) : (p.x + ((size_t)b * SEQ + (t - NM)) * D);
}

DI void phase_prep(const Params& p) {
  const int tid = otid(p), lane = tid & 63, wave = tid >> 6;
  float* rope = (float*)(p.ws + OFF_ROPE);
  for (int idx = blockIdx.x * NTHREADS + tid; idx < T * 32; idx += gridDim.x * NTHREADS) {
    int t = idx >> 5, i = idx & 31;
    float inv = (float)pow(10000.0, -(double)i / 32.0);
    float ang = (float)t * inv;
    double ad = (double)ang;
    double n = rint(ad * 0.15915494309189535);
    float r = (float)(ad - n * 6.283185307179586);
    float sn, cs;
    sincosf(r, &sn, &cs);
    rope[t * 64 + i] = cs;
    rope[t * 64 + 32 + i] = sn;
  }
  float* wrs = (float*)(p.ws + OFF_WRS);
  for (int idx = blockIdx.x * NTHREADS + tid; idx < 1024 * 32; idx += gridDim.x * NTHREADS) wrs[idx] = p.norm_ffn_w[idx >> 5] * p.w_router[idx];
  unsigned short* U = (unsigned short*)(p.ws + OFF_U);
  for (int tok = blockIdx.x * NWAVES + wave; tok < NT; tok += gridDim.x * NWAVES) {
    const float* src = hrow(p, tok);
    float4 v[4];
    float ss = 0.f;
#pragma unroll
    for (int i = 0; i < 4; ++i) {
      v[i] = *(const float4*)(src + lane * 4 + 256 * i);
      ss += v[i].x * v[i].x + v[i].y * v[i].y + v[i].z * v[i].z + v[i].w * v[i].w;
    }
    ss = wave_sum(ss);
    float rstd = rsqrtf(ss * (1.f / 1024.f) + 1e-6f);
#pragma unroll
    for (int i = 0; i < 4; ++i) {
      float4 w = *(const float4*)(p.norm_mix_w + lane * 4 + 256 * i);
      uint2 o;
      o.x = pk2(v[i].x * rstd * w.x, v[i].y * rstd * w.y);
      o.y = pk2(v[i].z * rstd * w.z, v[i].w * rstd * w.w);
      *(uint2*)(U + (size_t)tok * 1024 + lane * 4 + 256 * i) = o;
    }
  }
}

DI void wconv_task2(const float* src, unsigned short* dst, int K, int N, int k0, int n0, int tid) {
  const int kg = tid >> 6, n = n0 + (tid & 63) * 4, k = k0 + kg * 8;
  float4 v[8];
#pragma unroll
  for (int i = 0; i < 8; ++i) {
    v[i] = make_float4(0.f, 0.f, 0.f, 0.f);
    if (n < N) v[i] = *(const float4*)(src + (size_t)(k + i) * N + n);
  }
  uint4 o;
  o.x = pk2(v[0].x, v[1].x); o.y = pk2(v[2].x, v[3].x); o.z = pk2(v[4].x, v[5].x); o.w = pk2(v[6].x, v[7].x);
  *(uint4*)(dst + (size_t)(n + 0) * K + k) = o;
  o.x = pk2(v[0].y, v[1].y); o.y = pk2(v[2].y, v[3].y); o.z = pk2(v[4].y, v[5].y); o.w = pk2(v[6].y, v[7].y);
  *(uint4*)(dst + (size_t)(n + 1) * K + k) = o;
  o.x = pk2(v[0].z, v[1].z); o.y = pk2(v[2].z, v[3].z); o.z = pk2(v[4].z, v[5].z); o.w = pk2(v[6].z, v[7].z);
  *(uint4*)(dst + (size_t)(n + 2) * K + k) = o;
  o.x = pk2(v[0].w, v[1].w); o.y = pk2(v[2].w, v[3].w); o.z = pk2(v[4].w, v[5].w); o.w = pk2(v[6].w, v[7].w);
  *(uint4*)(dst + (size_t)(n + 3) * K + k) = o;
}
constexpr int WC_IN = 16 * 14, WC_KV = 4 * 4, WC_OUT = 16 * 4, WC_GU = 32 * 128, WC_DN = 32 * 64;
constexpr int WC_SMALL = WC_IN + WC_KV + WC_OUT, WC_ALL = WC_SMALL + WC_GU + WC_DN;
DI void wconv_task(const Params& p, int t, int tid) {
  if (t < WC_IN) {
    wconv_task2(p.w_in, (unsigned short*)(p.ws + OFF_WTIN), 1024, INC, (t / 14) * 64, (t % 14) * 256, tid);
  } else if (t < WC_IN + WC_KV) {
    t -= WC_IN;
    wconv_task2(p.w_kv_up, (unsigned short*)(p.ws + OFF_WTKV), 256, 1024, (t >> 2) * 64, (t & 3) * 256, tid);
  } else if (t < WC_SMALL) {
    t -= WC_IN + WC_KV;
    wconv_task2(p.w_out, (unsigned short*)(p.ws + OFF_WTOUT), 1024, 1024, (t >> 2) * 64, (t & 3) * 256, tid);
  } else if (t < WC_SMALL + WC_GU) {
    t -= WC_SMALL;
    const int e = t >> 7, r = t & 127;
    wconv_task2(p.w_gate_up + (size_t)e * 1024 * 2048, (unsigned short*)(p.ws + OFF_WTGU) + (size_t)e * 2048 * 1024, 1024, 2048,
                (r >> 3) * 64, (r & 7) * 256, tid);
  } else {
    t -= WC_SMALL + WC_GU;
    const int e = t >> 6, r = t & 63;
    wconv_task2(p.w_down + (size_t)e * 1024 * 1024, (unsigned short*)(p.ws + OFF_WTDN) + (size_t)e * 1024 * 1024, 1024, 1024,
                (r >> 2) * 64, (r & 3) * 256, tid);
  }
}
DI void phase_wconv(const Params& p, int t0, int t1) {
  const int tid = otid(p);
  for (int t = t0 + blockIdx.x; t < t1; t += gridDim.x) wconv_task(p, t, tid);
}

#define LAS __attribute__((address_space(3)))
namespace g8 {
constexpr int BM = 256, BK = 64, HALF = 128, HTB = HALF * BK * 2, STAGE_BYTES = 8 * HTB, NXCD = 8, WGM = 8;
constexpr int TAB_OFF = STAGE_BYTES;
constexpr int MAXU = 24;
DI int lds_byte(int r, int c) { const int st = (r >> 4) * 2 + (c >> 5), rr = r & 15, cc = c & 31, ob = rr * 64 + cc * 2; return st * 1024 + (ob ^ (((ob >> 9) & 1) << 5)); }
DI void stage_rc(int b, int& R, int& C) { const int st = b / 1024, sb = b % 1024, swz = sb ^ (((sb >> 9) & 1) << 5); R = (st >> 1) * 16 + swz / 64; C = (st & 1) * 32 + (swz % 64) / 2; }
DI int perm32(int rho) { const int n = rho >> 4, i = rho & 15; return 8 * (i >> 2) + 4 * n + (i & 3); }
DI int xcd_remap(int L, int nwg) { const int q = nwg / NXCD, r = nwg % NXCD, xcd = L % NXCD, off = L / NXCD; return (xcd < r ? xcd * (q + 1) : r * (q + 1) + (xcd - r) * q) + off; }
struct UnitT { int valid, arow, mend, pn, e, orow; };

template <int MODE> DI int n_units(const Params& p) {
  if (MODE == 0) return 65 * 14;
  if (MODE == 1) return 65 * 4;
  if (MODE == 2) return 64 * 4;
  const int* cnt = (const int*)(p.ws + OFF_CNT);
  int n = 0;
  for (int e = 0; e < NEXP; ++e) n += ((cnt[e] + 255) >> 8) * (MODE == 3 ? 8 : 4);
  return n;
}
template <int MODE> DI void unit_of(const Params& p, int L, int nwg, UnitT& u) {
  u.valid = 0; u.arow = 0; u.mend = 0; u.pn = 0; u.e = 0; u.orow = 0;
  if (L >= nwg) return;
  const int wgid = xcd_remap(L, nwg);
  u.valid = 1;
  if (MODE <= 2) {
    const int nM = (MODE == 2) ? 64 : 65, nN = (MODE == 0) ? 14 : 4;
    const int nig = WGM * nN, gid = wgid / nig, fm = gid * WGM, gsz = (nM - fm) < WGM ? (nM - fm) : WGM;
    const int pm = fm + ((wgid % nig) % gsz);
    u.pn = (wgid % nig) / gsz;
    u.orow = pm * 256;
    u.arow = (MODE == 2) ? (pm * 256 + 16 * (pm / 16 + 1)) : pm * 256;
    u.mend = (MODE == 2) ? NR : NT;
  } else {
    const int* cnt = (const int*)(p.ws + OFF_CNT);
    constexpr int NTN = (MODE == 3) ? 8 : 4;
    int id = wgid, sbase = 0;
    for (int e = 0; e < NEXP; ++e) {
      const int c = cnt[e], mts = (c + 255) >> 8, ne = mts * NTN;
      if (id < ne) {
        const int tn = id / mts, tm = id - tn * mts;
        u.e = e; u.pn = tn; u.arow = sbase + tm * 256; u.orow = u.arow; u.mend = sbase + c;
        return;
      }
      id -= ne;
      sbase += c;
    }
    u.valid = 0;
  }
}
DI float swiglu(float g, float u) {
  g = fminf(g, 7.0f);
  u = fminf(fmaxf(u, -7.0f), 7.0f);
  return g / (1.f + __expf(-1.702f * g)) * (u + 1.f);
}
template <int MODE>
DI void epilogue(const Params& p, const f32x4 (&acc)[2][2][4][2], const UnitT& u, int wr, int wc, int fr, int fq) {
  constexpr bool PERM = (MODE >= 3);
  const int row0 = u.orow + wr * 64 + fr;
  const int col0 = u.pn * 256 + wc * 32 + (PERM ? 8 * fq : 4 * fq);
  if (MODE == 0 || MODE == 1 || MODE == 2) {
    float* C = (float*)(p.ws + (MODE == 0 ? OFF_P : MODE == 1 ? OFF_KV : OFF_H1));
    const int ldc = (MODE == 0) ? INC : 1024;
#pragma unroll
    for (int ai = 0; ai < 2; ++ai)
#pragma unroll
      for (int m = 0; m < 4; ++m) {
        const int row = row0 + ai * 128 + m * 16;
        if (row < u.mend) {
#pragma unroll
          for (int bj = 0; bj < 2; ++bj)
#pragma unroll
            for (int n = 0; n < 2; ++n) {
              const int col = col0 + bj * 128 + n * 16;
              if (MODE != 0 || col < INC) {
                f32x4 v = acc[ai][bj][m][n];
                if (MODE == 2) v += *(const f32x4*)(p.x + (size_t)row * D + col);
                *(f32x4*)(C + (size_t)row * ldc + col) = v;
              }
            }
        }
      }
  } else if (MODE == 3) {
    unsigned short* HD = (unsigned short*)(p.ws + OFF_HD);
    f32x4 bv[2][2];
#pragma unroll
    for (int bj = 0; bj < 2; ++bj)
#pragma unroll
      for (int n = 0; n < 2; ++n) bv[bj][n] = *(const f32x4*)(p.b_gate_up + (size_t)u.e * 2048 + col0 + bj * 128 + 4 * n);
#pragma unroll
    for (int ai = 0; ai < 2; ++ai)
#pragma unroll
      for (int m = 0; m < 4; ++m) {
        const int row = row0 + ai * 128 + m * 16;
        if (row < u.mend) {
#pragma unroll
          for (int bj = 0; bj < 2; ++bj) {
            const f32x4 v0 = acc[ai][bj][m][0] + bv[bj][0], v1 = acc[ai][bj][m][1] + bv[bj][1];
            uint2 o;
            o.x = pk2(swiglu(v0[0], v0[1]), swiglu(v0[2], v0[3]));
            o.y = pk2(swiglu(v1[0], v1[1]), swiglu(v1[2], v1[3]));
            *(uint2*)(HD + (size_t)row * 1024 + (col0 + bj * 128) / 2) = o;
          }
        }
      }
  } else {
    unsigned short* Y = (unsigned short*)(p.ws + OFF_Y);
    const float* lgate = (const float*)(p.ws + OFF_LGATE);
    f32x4 bv[2][2];
#pragma unroll
    for (int bj = 0; bj < 2; ++bj)
#pragma unroll
      for (int n = 0; n < 2; ++n) bv[bj][n] = *(const f32x4*)(p.b_down + (size_t)u.e * 1024 + col0 + bj * 128 + 4 * n);
#pragma unroll
    for (int ai = 0; ai < 2; ++ai)
#pragma unroll
      for (int m = 0; m < 4; ++m) {
        const int row = row0 + ai * 128 + m * 16;
        if (row < u.mend) {
          const float gt = lgate[row];
#pragma unroll
          for (int bj = 0; bj < 2; ++bj) {
            const f32x4 v0 = (acc[ai][bj][m][0] + bv[bj][0]) * gt, v1 = (acc[ai][bj][m][1] + bv[bj][1]) * gt;
            uint4 o;
            o.x = pk2(v0[0], v0[1]); o.y = pk2(v0[2], v0[3]); o.z = pk2(v1[0], v1[1]); o.w = pk2(v1[2], v1[3]);
            *(uint4*)(Y + (size_t)row * 1024 + col0 + bj * 128) = o;
          }
        }
      }
  }
}

template <int MODE>
DI void gemm_phase(const Params& p, char* smem) {
  constexpr bool PERM = (MODE >= 3);
  constexpr int K = (MODE == 1) ? 256 : 1024, nt = K / BK;
  LAS unsigned char* lds = (LAS unsigned char*)smem;
  LAS int* tab = (LAS int*)(lds + TAB_OFF);
  const int tid = otid(p), wid = __builtin_amdgcn_readfirstlane(tid >> 6), lane = tid & 63, wr = wid >> 2, wc = wid & 3, fr = lane & 15, fq = lane >> 4;
  __syncthreads();
  {
    const int nwg = n_units<MODE>(p);
    for (int ti = 0; ti < MAXU; ++ti) {
      UnitT u;
      unit_of<MODE>(p, ti * (int)gridDim.x + (int)blockIdx.x, nwg, u);
      if (tid == 0) { tab[ti * 8 + 0] = u.valid; tab[ti * 8 + 1] = u.arow; tab[ti * 8 + 2] = u.mend; tab[ti * 8 + 3] = u.pn; tab[ti * 8 + 4] = u.e; tab[ti * 8 + 5] = u.orow; }
    }
  }
  __syncthreads();
#define G8_GETU(i, u) do { const int _i = (i); (u).valid = (_i < MAXU) ? __builtin_amdgcn_readfirstlane(tab[_i * 8 + 0]) : 0; (u).arow = __builtin_amdgcn_readfirstlane(tab[(_i < MAXU ? _i : 0) * 8 + 1]); \
    (u).mend = __builtin_amdgcn_readfirstlane(tab[(_i < MAXU ? _i : 0) * 8 + 2]); (u).pn = __builtin_amdgcn_readfirstlane(tab[(_i < MAXU ? _i : 0) * 8 + 3]); \
    (u).e = __builtin_amdgcn_readfirstlane(tab[(_i < MAXU ? _i : 0) * 8 + 4]); (u).orow = __builtin_amdgcn_readfirstlane(tab[(_i < MAXU ? _i : 0) * 8 + 5]); } while (0)
  UnitT cur, nxt;
  G8_GETU(0, cur);
  if (!cur.valid) return;
  const char* Abase = (const char*)(p.ws + (MODE == 0 ? OFF_U : MODE == 1 ? OFF_CKV : MODE == 2 ? OFF_MIX : MODE == 3 ? OFF_U2 : OFF_HD));
  const char* Bbase = (const char*)(p.ws + (MODE == 0 ? OFF_WTIN : MODE == 1 ? OFF_WTKV : MODE == 2 ? OFF_WTOUT : MODE == 3 ? OFF_WTGU : OFF_WTDN));
  constexpr size_t BEXP = (MODE == 3) ? (size_t)2048 * 1024 * 2 : (MODE == 4) ? (size_t)1024 * 1024 * 2 : 0;
  int Rr[2], Cc[2];
  unsigned voffB[2];
#pragma unroll
  for (int i = 0; i < 2; ++i) {
    stage_rc(tid * 16 + i * 8192, Rr[i], Cc[i]);
    const int Rb = PERM ? ((Rr[i] & ~31) + perm32(Rr[i] & 31)) : Rr[i];
    voffB[i] = (unsigned)(Rb * K + Cc[i]) * 2u;
  }
  unsigned voffA[2][2];
  const int* ltok = (const int*)(p.ws + OFF_LTOK);
#define G8_VOFFA(dst, un) do { _Pragma("unroll") for (int _h = 0; _h < 2; ++_h) _Pragma("unroll") for (int _i = 0; _i < 2; ++_i) { \
      if (MODE == 3) { int _s = (un).arow + _h * 128 + Rr[_i]; _s = _s < NASG ? _s : NASG - 1; dst[_h][_i] = (unsigned)(ltok[_s] * K + Cc[_i]) * 2u; } \
      else dst[_h][_i] = (unsigned)((_h * 128 + Rr[_i]) * K + Cc[_i]) * 2u; } } while (0)
  const size_t kstep = (size_t)(BK * 2);
  const size_t hstep = (size_t)HALF * K * 2;
  const size_t tstep = 2 * hstep;
  const unsigned ldsw = (unsigned)wid * 1024u;
  const int aoff = lds_byte(wr * 64 + fr, fq * 8), boff = lds_byte(wc * 32 + fr, fq * 8);
#define G8_SA(b, h) (((b) * 2 + (h)) * HTB)
#define G8_SB(b, h) ((4 + (b) * 2 + (h)) * HTB)
#define G8_STAGE(bufoff, gbase, voff) do { _Pragma("unroll") for (int _i = 0; _i < 2; ++_i) \
    __builtin_amdgcn_global_load_lds((const unsigned*)((const char*)(gbase) + (voff)[_i]), (LAS unsigned*)(lds + (bufoff) + ldsw + _i * 8192), 16, 0, 0); } while (0)
#define G8_LDA(dst, b, h) do { _Pragma("unroll") for (int m = 0; m < 4; ++m) _Pragma("unroll") for (int k = 0; k < 2; ++k) dst[m][k] = *(const LAS bf16x8*)(lds + G8_SA(b, h) + aoff + m * 2048 + k * 1024); } while (0)
#define G8_LDB(dst, b, h) do { _Pragma("unroll") for (int n = 0; n < 2; ++n) _Pragma("unroll") for (int k = 0; k < 2; ++k) dst[n][k] = *(const LAS bf16x8*)(lds + G8_SB(b, h) + boff + n * 2048 + k * 1024); } while (0)
#define G8_MMA(ai, bj, At, Bt) do { __builtin_amdgcn_s_setprio(1); _Pragma("unroll") for (int m = 0; m < 4; ++m) _Pragma("unroll") for (int n = 0; n < 2; ++n) _Pragma("unroll") for (int k = 0; k < 2; ++k) \
    acc[ai][bj][m][n] = __builtin_amdgcn_mfma_f32_16x16x32_bf16(Bt[n][k], At[m][k], acc[ai][bj][m][n], 0, 0, 0); __builtin_amdgcn_s_setprio(0); } while (0)
#define G8_WAIT_V(n) asm volatile("s_waitcnt vmcnt(" #n ")" ::: "memory")
#define G8_WAIT_L(n) asm volatile("s_waitcnt lgkmcnt(" #n ")" ::: "memory")
#define G8_BAR __builtin_amdgcn_s_barrier()
#define G8_SCHED __builtin_amdgcn_sched_barrier(0)
  int ui = 0;
  f32x4 acc[2][2][4][2];
#pragma unroll
  for (int a = 0; a < 2; ++a)
#pragma unroll
    for (int b = 0; b < 2; ++b)
#pragma unroll
      for (int m = 0; m < 4; ++m)
#pragma unroll
        for (int n = 0; n < 2; ++n) acc[a][b][m][n] = (f32x4){0.f, 0.f, 0.f, 0.f};
  bf16x8 At[4][2], B0[2][2], B1[2][2];
  G8_VOFFA(voffA, cur);
  if (MODE == 3) asm volatile("s_waitcnt vmcnt(0)" ::: "memory");
  const char* cA = (MODE == 3) ? Abase : Abase + (size_t)cur.arow * K * 2;
  const char* cB = Bbase + (size_t)cur.e * BEXP + (size_t)cur.pn * tstep;
  G8_STAGE(G8_SB(0, 0), cB, voffB); G8_STAGE(G8_SA(0, 0), cA, voffA[0]); G8_STAGE(G8_SB(0, 1), cB + hstep, voffB); G8_STAGE(G8_SA(0, 1), cA, voffA[1]);
  if (wr == 1) G8_BAR;
  G8_WAIT_V(4); G8_BAR;
  G8_STAGE(G8_SB(1, 0), cB + kstep, voffB); G8_STAGE(G8_SA(1, 0), cA + kstep, voffA[0]); G8_STAGE(G8_SB(1, 1), cB + hstep + kstep, voffB);
  G8_WAIT_V(6); G8_BAR;
  for (;;) {
    G8_GETU(ui + 1, nxt);
    const bool has_next = nxt.valid != 0;
    const char* nA = has_next ? ((MODE == 3) ? Abase : Abase + (size_t)nxt.arow * K * 2) : cA;
    const char* nB = has_next ? Bbase + (size_t)nxt.e * BEXP + (size_t)nxt.pn * tstep : cB;
#pragma unroll 1
    for (int t = 0; t < nt; t += 2) {
      const bool last = (t == nt - 2);
      const char* a1 = cA + (size_t)(t + 1) * kstep;
      const char* a2 = last ? nA : cA + (size_t)(t + 2) * kstep;
      const char* b2 = last ? nB : cB + (size_t)(t + 2) * kstep;
      const char* a3 = a2 + kstep;
      const char* b3 = b2 + kstep;
      G8_LDB(B0, 0, 0); G8_SCHED; G8_LDA(At, 0, 0); G8_STAGE(G8_SA(1, 1), a1, voffA[1]);
      if (MODE == 3) {
        if (last && has_next) {
          G8_VOFFA(voffA, nxt);
          asm volatile("s_waitcnt vmcnt(0)" ::: "memory");
        }
      }
      G8_WAIT_L(8); G8_BAR; G8_WAIT_L(0); G8_MMA(0, 0, At, B0); G8_BAR; G8_SCHED;
      G8_LDB(B1, 0, 1); G8_STAGE(G8_SB(0, 0), b2, voffB);
      G8_BAR; G8_WAIT_L(0); G8_MMA(0, 1, At, B1); G8_BAR;
      G8_LDA(At, 0, 1); G8_STAGE(G8_SA(0, 0), a2, voffA[0]);
      G8_BAR; G8_WAIT_L(0); G8_MMA(1, 0, At, B0); G8_BAR; G8_SCHED;
      G8_STAGE(G8_SB(0, 1), b2 + hstep, voffB);
      G8_WAIT_V(6); G8_BAR; G8_MMA(1, 1, At, B1); G8_BAR;
      G8_LDB(B0, 1, 0); G8_SCHED; G8_LDA(At, 1, 0); G8_STAGE(G8_SA(0, 1), a2, voffA[1]);
      G8_WAIT_L(8); G8_BAR; G8_WAIT_L(0); G8_MMA(0, 0, At, B0); G8_BAR; G8_SCHED;
      G8_LDB(B1, 1, 1); G8_STAGE(G8_SB(1, 0), b3, voffB);
      G8_BAR; G8_WAIT_L(0); G8_MMA(0, 1, At, B1); G8_BAR;
      G8_LDA(At, 1, 1); G8_STAGE(G8_SA(1, 0), a3, voffA[0]);
      G8_BAR; G8_WAIT_L(0); G8_MMA(1, 0, At, B0); G8_BAR; G8_SCHED;
      G8_STAGE(G8_SB(1, 1), b3 + hstep, voffB);
      G8_WAIT_V(6); G8_BAR; G8_MMA(1, 1, At, B1); G8_BAR;
    }
    epilogue<MODE>(p, acc, cur, wr, wc, fr, fq);
    if (!has_next) break;
#pragma unroll
    for (int a = 0; a < 2; ++a)
#pragma unroll
      for (int b = 0; b < 2; ++b)
#pragma unroll
        for (int m = 0; m < 4; ++m)
#pragma unroll
          for (int n = 0; n < 2; ++n) acc[a][b][m][n] = (f32x4){0.f, 0.f, 0.f, 0.f};
    cur = nxt; cA = nA; cB = nB; ++ui;
  }
  G8_WAIT_V(0);
  if (wr == 0) G8_BAR;
  G8_BAR;
#undef G8_GETU
#undef G8_VOFFA
#undef G8_SA
#undef G8_SB
#undef G8_STAGE
#undef G8_LDA
#undef G8_LDB
#undef G8_MMA
#undef G8_WAIT_V
#undef G8_WAIT_L
#undef G8_BAR
#undef G8_SCHED
}
}

DI float rope_apply(float v, float c, float s, int lane) {
  float o = xor32f(v, lane);
  return (lane < 32) ? (v * c - o * s) : (v * c + o * s);
}
DI void phase_post1(const Params& p, char* smem) {
  const int tid = otid(p), lane = tid & 63, wave = tid >> 6;
  const float* P = (const float*)(p.ws + OFF_P);
  const float* rope = (const float*)(p.ws + OFF_ROPE);
  unsigned short* Qb = (unsigned short*)(p.ws + OFF_QB);
  unsigned short* QI = (unsigned short*)(p.ws + OFF_QI);
  unsigned short* KI = (unsigned short*)(p.ws + OFF_KI);
  unsigned short* CKV = (unsigned short*)(p.ws + OFF_CKV);
  float* WI = (float*)(p.ws + OFF_WI);
  float* Qd = (float*)(p.ws + OFF_QD);
  float* Kd = (float*)(p.ws + OFF_KD);
  float* Vd = (float*)(p.ws + OFF_VD);
  float* BETA = (float*)(p.ws + OFF_BETA);
  float* G = (float*)(p.ws + OFF_G);
  float* cw = (float*)smem;
  __syncthreads();
  for (int idx = tid; idx < 4 * 1536; idx += NTHREADS) cw[idx] = p.conv_w[idx];
  __syncthreads();
  const float qw = p.q_norm_w[lane];
  const float4 kvw = *(const float4*)(p.kv_norm_w + lane * 4);
  for (int g = blockIdx.x * NWAVES + wave; g < NT / 8; g += gridDim.x * NWAVES) {
    const int tok0 = g * 8, b = tok0 / T, t0 = tok0 - b * T;
#pragma unroll 1
    for (int tt = 0; tt < 8; ++tt) {
      const int tok = tok0 + tt, t = t0 + tt;
      const float* row = P + (size_t)tok * INC;
      float qv[8], iv[8];
#pragma unroll
      for (int hh = 0; hh < 8; ++hh) { qv[hh] = row[C_AQ + hh * 64 + lane]; iv[hh] = row[C_IQ + hh * 64 + lane]; }
      const float4 ckv = *(const float4*)(row + C_CKV + lane * 4);
      const float ikv = row[C_IK + lane];
      const float tailv = row[(lane < 8) ? (C_IW + lane) : (C_BBETA + ((lane - 8) & 7))];
      const float cs = rope[t * 64 + (lane & 31)], sn = rope[t * 64 + 32 + (lane & 31)];
      unsigned short* qb = Qb + (size_t)tok * 512 + lane;
      unsigned short* qi = QI + (size_t)tok * 512 + lane;
#pragma unroll
      for (int hh = 0; hh < 8; ++hh) {
        float v = qv[hh];
        const float ss = wave_sum(v * v);
        v = v * rsqrtf(ss * (1.f / 64.f) + 1e-6f) * qw;
        qb[hh * 64] = f2bf(rope_apply(v, cs, sn, lane));
        qi[hh * 64] = f2bf(rope_apply(iv[hh], cs, sn, lane));
      }
      {
        const float ss = wave_sum(ckv.x * ckv.x + ckv.y * ckv.y + ckv.z * ckv.z + ckv.w * ckv.w);
        const float rstd = rsqrtf(ss * (1.f / 256.f) + 1e-6f);
        uint2 o;
        o.x = pk2(ckv.x * rstd * kvw.x, ckv.y * rstd * kvw.y);
        o.y = pk2(ckv.z * rstd * kvw.z, ckv.w * rstd * kvw.w);
        *(uint2*)(CKV + (size_t)tok * 256 + lane * 4) = o;
      }
      KI[(size_t)tok * 64 + lane] = f2bf(rope_apply(ikv, cs, sn, lane));
      if (lane < 8) WI[(size_t)tok * 8 + lane] = tailv * 0.04419417382415922f;
      if (lane >= 8 && lane < 12) BETA[(size_t)tok * 4 + (lane - 8)] = 1.f / (1.f + expf(-tailv));
      if (lane >= 12 && lane < 16) {
        const float xx = tailv + p.dt_bias[lane - 12];
        const float sp = fmaxf(xx, 0.f) + log1pf(expf(-fabsf(xx)));
        G[(size_t)tok * 4 + (lane - 12)] = -expf(p.a_log[lane - 12]) * sp;
      }
    }
    float x0[24], x1[24], x2[24];
    {
      const float* base = P + (size_t)tok0 * INC + C_BQKV + lane;
#pragma unroll
      for (int i = 0; i < 24; ++i) {
        x0[i] = (t0 >= 3) ? base[64 * i - 3 * (ptrdiff_t)INC] : 0.f;
        x1[i] = (t0 >= 2) ? base[64 * i - 2 * (ptrdiff_t)INC] : 0.f;
        x2[i] = (t0 >= 1) ? base[64 * i - 1 * (ptrdiff_t)INC] : 0.f;
      }
    }
#pragma unroll 1
    for (int tt = 0; tt < 8; ++tt) {
      const int tok = tok0 + tt;
      const float* xr = P + (size_t)tok * INC + C_BQKV + lane;
      float x3[24];
#pragma unroll
      for (int i = 0; i < 24; ++i) x3[i] = xr[64 * i];
      int cl = lane;
      asm volatile("" : "+v"(cl));
      float* qd = Qd + (size_t)tok * 512 + lane;
      float* kd = Kd + (size_t)tok * 512 + lane;
      float* vd = Vd + (size_t)tok * 512 + lane;
#pragma unroll
      for (int hd = 0; hd < 4; ++hd) {
        float cv[6];
#pragma unroll
        for (int q = 0; q < 6; ++q) {
          const int i = (q >> 1) * 8 + 2 * hd + (q & 1);
          const int c = cl + 64 * i;
          const float a = cw[c] * x0[i] + cw[1536 + c] * x1[i] + cw[2 * 1536 + c] * x2[i] + cw[3 * 1536 + c] * x3[i];
          cv[q] = a / (1.f + __expf(-a));
          x0[i] = x1[i]; x1[i] = x2[i]; x2[i] = x3[i];
        }
        float ss = wave_sum(cv[0] * cv[0] + cv[1] * cv[1]);
        float r = rsqrtf(ss + 1e-6f);
        qd[hd * 128] = cv[0] * r;
        qd[hd * 128 + 64] = cv[1] * r;
        ss = wave_sum(cv[2] * cv[2] + cv[3] * cv[3]);
        r = rsqrtf(ss + 1e-6f);
        kd[hd * 128] = cv[2] * r;
        kd[hd * 128 + 64] = cv[3] * r;
        vd[hd * 128] = cv[4];
        vd[hd * 128 + 64] = cv[5];
      }
    }
  }
}

DI void phase_post2(const Params& p, char* smem) {
  (void)smem;
  const int tid = otid(p), lane = tid & 63, wave = tid >> 6;
  const float* KV = (const float*)(p.ws + OFF_KV);
  const float* rope = (const float*)(p.ws + OFF_ROPE);
  unsigned short* Kb = (unsigned short*)(p.ws + OFF_KB);
  unsigned short* Vb = (unsigned short*)(p.ws + OFF_VT);
  const float kw = p.k_norm_w[lane];
  for (int tok = blockIdx.x * NWAVES + wave; tok < NT; tok += gridDim.x * NWAVES) {
    const int b = tok / T, t = tok - b * T;
    const float* row = KV + (size_t)tok * 1024;
    float kv[8], vv[8];
#pragma unroll
    for (int hh = 0; hh < 8; ++hh) { kv[hh] = row[hh * 64 + lane]; vv[hh] = row[512 + hh * 64 + lane]; }
    const float cs = rope[t * 64 + (lane & 31)], sn = rope[t * 64 + 32 + (lane & 31)];
    unsigned short* kb = Kb + (size_t)tok * 512 + lane;
    unsigned short* vb = Vb + (size_t)tok * 512 + lane;
#pragma unroll
    for (int hh = 0; hh < 8; ++hh) {
      float v = kv[hh];
      const float ss = wave_sum(v * v);
      v = v * rsqrtf(ss * (1.f / 64.f) + 1e-6f) * kw;
      kb[hh * 64] = f2bf(rope_apply(v, cs, sn, lane));
      vb[hh * 64] = f2bf(vv[hh]);
    }
  }
}

constexpr int KS_STRIDE = 129, AM_STRIDE = 65;
DI void phase_chunkprep(const Params& p, char* smem) {
  float* Ks = (float*)smem;
  float* Qs = Ks + 64 * KS_STRIDE;
  float* Am = Qs + 64 * KS_STRIDE;
  float* Tm = Am + 64 * AM_STRIDE;
  float* gc = Tm + 64 * AM_STRIDE;
  float* bet = gc + 64;
  float* gl = bet + 64;
  const int tid = otid(p);
  const float* Qd = (const float*)(p.ws + OFF_QD);
  const float* Kd = (const float*)(p.ws + OFF_KD);
  const float* Vd = (const float*)(p.ws + OFF_VD);
  const float* BETA = (const float*)(p.ws + OFF_BETA);
  const float* G = (const float*)(p.ws + OFF_G);
  unsigned short* CHB = (unsigned short*)(p.ws + OFF_WN);
  float* UU = (float*)(p.ws + OFF_UU);
  float* DL = (float*)(p.ws + OFF_DL);
  for (int ci = blockIdx.x; ci < NCHT; ci += gridDim.x) {
    unsigned short* chb = CHB + (size_t)ci * CHB_ELEMS;
    const int bh = ci / NCH, c = ci - bh * NCH, b = bh >> 2, h = bh & 3;
    __syncthreads();
    for (int idx = tid; idx < 64 * 128; idx += NTHREADS) {
      int i = idx >> 7, d = idx & 127;
      int t = c * 64 + i - 48;
      float kv = 0.f, qv = 0.f;
      if (t >= 0) {
        size_t o = ((size_t)(b * T + t)) * 512 + h * 128 + d;
        kv = Kd[o];
        qv = Qd[o] * 0.08838834764831845f;
      }
      Ks[i * KS_STRIDE + d] = kv;
      Qs[i * KS_STRIDE + d] = qv;
    }
    if (tid < 64) {
      int t = c * 64 + tid - 48;
      float g = 0.f, be = 0.f;
      if (t >= 0) { g = G[(size_t)(b * T + t) * 4 + h]; be = BETA[(size_t)(b * T + t) * 4 + h]; }
      gl[tid] = g;
      bet[tid] = be;
    }
    __syncthreads();
    if (tid < 64) {
      float s = 0.f;
      for (int j = 0; j <= tid; ++j) s += gl[j];
      gc[tid] = s;
    }
    __syncthreads();
    {
      const int i = tid >> 3, jb = tid & 7;
      float akk[8], aqk[8];
#pragma unroll
      for (int jj = 0; jj < 8; ++jj) { akk[jj] = 0.f; aqk[jj] = 0.f; }
      for (int d = 0; d < 128; ++d) {
        float ki = Ks[i * KS_STRIDE + d], qi = Qs[i * KS_STRIDE + d];
#pragma unroll
        for (int jj = 0; jj < 8; ++jj) {
          float kj = Ks[(jb + 8 * jj) * KS_STRIDE + d];
          akk[jj] += ki * kj;
          aqk[jj] += qi * kj;
        }
      }
      const float gi = gc[i], bi = bet[i];
#pragma unroll
      for (int jj = 0; jj < 8; ++jj) {
        int j = jb + 8 * jj;
        float dec = (j <= i) ? __expf(gi - gc[j]) : 0.f;
        Am[i * AM_STRIDE + j] = (j < i) ? bi * akk[jj] * dec : 0.f;
        chb[CH_IN + swzB(i, j)] = f2bf((j <= i) ? aqk[jj] * dec : 0.f);
      }
    }
    __syncthreads();
    {
      float* Mt = gl + 64;
      for (int idx = tid; idx < 64 * 64; idx += NTHREADS) Tm[(idx >> 6) * AM_STRIDE + (idx & 63)] = 0.f;
      __syncthreads();
      if (tid < 64) {
        const int bb = tid >> 4, cc = tid & 15, o = 16 * bb;
        float x[16];
#pragma unroll
        for (int i = 0; i < 16; ++i) {
          float a = (i == cc) ? 1.f : 0.f;
#pragma unroll
          for (int j = 0; j < 16; ++j)
            if (j < i) a -= Am[(o + i) * AM_STRIDE + o + j] * x[j];
          x[i] = a;
          Tm[(o + i) * AM_STRIDE + o + cc] = a;
        }
      }
      __syncthreads();
      {
        const int B = tid >> 8, i = (tid >> 4) & 15, j = tid & 15, o = 32 * B;
        float m = 0.f;
#pragma unroll
        for (int k = 0; k < 16; ++k) m += Am[(o + 16 + i) * AM_STRIDE + o + k] * Tm[(o + k) * AM_STRIDE + o + j];
        Mt[(B * 16 + i) * 33 + j] = m;
        __syncthreads();
        float t = 0.f;
#pragma unroll
        for (int k = 0; k < 16; ++k) t += Tm[(o + 16 + i) * AM_STRIDE + o + 16 + k] * Mt[(B * 16 + k) * 33 + j];
        __syncthreads();
        Tm[(o + 16 + i) * AM_STRIDE + o + j] = -t;
      }
      __syncthreads();
      {
        const int i = tid >> 4, j0 = (tid & 15) * 2;
        float m0 = 0.f, m1 = 0.f;
        for (int k = 0; k < 32; ++k) {
          const float a = Am[(32 + i) * AM_STRIDE + k];
          m0 += a * Tm[k * AM_STRIDE + j0];
          m1 += a * Tm[k * AM_STRIDE + j0 + 1];
        }
        Mt[i * 33 + j0] = m0;
        Mt[i * 33 + j0 + 1] = m1;
        __syncthreads();
        float t0 = 0.f, t1 = 0.f;
        for (int k = 0; k < 32; ++k) {
          const float a = Tm[(32 + i) * AM_STRIDE + 32 + k];
          t0 += a * Mt[k * 33 + j0];
          t1 += a * Mt[k * 33 + j0 + 1];
        }
        __syncthreads();
        Tm[(32 + i) * AM_STRIDE + j0] = -t0;
        Tm[(32 + i) * AM_STRIDE + j0 + 1] = -t1;
      }
    }
    __syncthreads();
    {
      const int e = tid & 127, rq = tid >> 7;
      float au[16], aw[16];
#pragma unroll
      for (int ii = 0; ii < 16; ++ii) { au[ii] = 0.f; aw[ii] = 0.f; }
      const int jmax = rq * 16 + 15;
      for (int j = 0; j <= jmax; ++j) {
        int t = c * 64 + j - 48;
        float bj = bet[j];
        float vb = (t >= 0) ? bj * Vd[((size_t)(b * T + t)) * 512 + h * 128 + e] : 0.f;
        float kb = bj * __expf(gc[j]) * Ks[j * KS_STRIDE + e];
#pragma unroll
        for (int ii = 0; ii < 16; ++ii) {
          float tij = Tm[(rq * 16 + ii) * AM_STRIDE + j];
          au[ii] += tij * vb;
          aw[ii] += tij * kb;
        }
      }
#pragma unroll
      for (int ii = 0; ii < 16; ++ii) {
        int i = rq * 16 + ii;
        {
          const int ri = i & 31, hh = (ri >> 2) & 1, reg = (ri & 3) + 4 * (ri >> 3);
          UU[(size_t)ci * 8192 + ((((e >> 5) * 2 + (i >> 5)) * 2 + hh) * 32 + (e & 31)) * 16 + reg] = au[ii];
        }
        chb[swzA(i, e)] = f2bf(-aw[ii]);
      }
    }
    const float glast = gc[63];
    for (int idx = tid; idx < 64 * 128; idx += NTHREADS) {
      int i = idx >> 7, d = idx & 127;
      chb[CH_QG + swzA(i, d)] = f2bf(Qs[i * KS_STRIDE + d] * __expf(gc[i]));
    }
    for (int idx = tid; idx < 64 * 128; idx += NTHREADS) {
      int i = idx & 63, d = idx >> 6;
      chb[CH_KDT + swzB(d, i)] = f2bf(Ks[i * KS_STRIDE + d] * __expf(glast - gc[i]));
    }
    if (tid == 0) DL[ci] = __expf(glast);
  }
}

DI unsigned ordkey(float f) {
  unsigned u = __float_as_uint(f);
  return (u & 0x80000000u) ? ~u : (u | 0x80000000u);
}
DI int half_sum(int v) {
  v += dppi<0xB1>(v); v += dppi<0x4E>(v); v += dppi<0x141>(v); v += dppi<0x140>(v);
  const int lo = __builtin_amdgcn_readlane(v, 0) + __builtin_amdgcn_readlane(v, 16);
  const int hi = __builtin_amdgcn_readlane(v, 32) + __builtin_amdgcn_readlane(v, 48);
  return (__builtin_amdgcn_mbcnt_hi(~0u, __builtin_amdgcn_mbcnt_lo(~0u, 0u)) < 32u) ? lo : hi;
}
DI void indexer_task(const Params& p, int b, int q0, int lane) {
  unsigned* MASK = (unsigned*)(p.ws + OFF_MASK);
  const int qsel = lane >> 5;
  const int tq = q0 + qsel;
  unsigned* mrow = MASK + ((size_t)b * SEQ + tq) * 128;
  if (q0 + 1 < 256) {
    for (int i = (lane & 31); i < 128; i += 32) {
      int rem = tq + 1 - 32 * i;
      unsigned w = (rem >= 32) ? 0xffffffffu : (rem > 0 ? ((1u << rem) - 1u) : 0u);
      mrow[i] = w;
    }
    return;
  }
  const unsigned short* QI = (const unsigned short*)(p.ws + OFF_QI);
  const unsigned short* KI = (const unsigned short*)(p.ws + OFF_KI);
  const float* WI = (const float*)(p.ws + OFF_WI);
  const int l15 = lane & 15, lg = lane >> 4;
  const size_t qtok = (size_t)b * T + NM + q0 + (l15 >> 3);
  const bf16x8 a0 = ld16(QI + qtok * 512 + (l15 & 7) * 64 + 8 * lg);
  const bf16x8 a1 = ld16(QI + qtok * 512 + (l15 & 7) * 64 + 32 + 8 * lg);
  float w[4];
  {
    const size_t wtok = (size_t)b * T + NM + q0 + (lg >> 1);
#pragma unroll
    for (int r = 0; r < 4; ++r) w[r] = WI[wtok * 8 + 4 * (lg & 1) + r];
  }
  const int npairs = (q0 + 2 + 31) >> 5;
  const unsigned short* kp = KI + ((size_t)b * T + NM) * 64 + (size_t)l15 * 64 + 8 * lg;
  unsigned u[128];
  int rem = tq - (lane & 31);
  bf16x8 n0 = ld16(kp), n1 = ld16(kp + 32), n2 = ld16(kp + 1024), n3 = ld16(kp + 1024 + 32);
#pragma unroll
  for (int i = 0; i < 128; ++i) {
    unsigned uv = 0u;
    kp += 2048;
    asm volatile("" : "+v"(kp));
    if (i < npairs) {
      const bf16x8 c0 = n0, c1 = n1, c2 = n2, c3 = n3;
      if (i + 1 < npairs) { n0 = ld16(kp); n1 = ld16(kp + 32); n2 = ld16(kp + 1024); n3 = ld16(kp + 1024 + 32); }
      float tot[2];
      {
        f32x4 acc = {0.f, 0.f, 0.f, 0.f};
        acc = MFMA16(a0, c0, acc);
        acc = MFMA16(a1, c1, acc);
        float part = 0.f;
#pragma unroll
        for (int r = 0; r < 4; ++r) part += w[r] * fmaxf(acc[r], 0.f);
        tot[0] = part + xor16f(part, lane);
      }
      {
        f32x4 acc = {0.f, 0.f, 0.f, 0.f};
        acc = MFMA16(a0, c2, acc);
        acc = MFMA16(a1, c3, acc);
        float part = 0.f;
#pragma unroll
        for (int r = 0; r < 4; ++r) part += w[r] * fmaxf(acc[r], 0.f);
        tot[1] = part + xor16f(part, lane);
      }
      const float sc = (lg & 1) ? tot[1] : tot[0];
      uv = (rem >= 0) ? ordkey(sc) : 0u;
    }
    u[i] = uv;
    rem -= 32;
    asm volatile("" : "+v"(rem));
  }
  const int nblk = (npairs + 15) >> 4;
  unsigned thr = 0u;
  bool done = false;
  for (int bit = 31; bit >= 0; --bit) {
    const unsigned cand = thr | (1u << bit);
    int cnt = 0;
#pragma unroll
    for (int blk = 0; blk < 8; ++blk) {
      if (blk < nblk) {
#pragma unroll
        for (int j = 0; j < 16; ++j) cnt += (u[blk * 16 + j] >= cand) ? 1 : 0;
      }
    }
    cnt = half_sum(cnt);
    if (!done && cnt >= 256) thr = cand;
    done = done || (cnt == 256);
    if (__all(done)) break;
  }
  int cgt = 0;
#pragma unroll
  for (int blk = 0; blk < 8; ++blk) {
    if (blk < nblk) {
#pragma unroll
      for (int j = 0; j < 16; ++j) cgt += (u[blk * 16 + j] > thr) ? 1 : 0;
    }
  }
  cgt = half_sum(cgt);
  const int need = 256 - cgt;
  int base = 0;
  const unsigned lt_mask = (1u << (lane & 31)) - 1u;
#pragma unroll
  for (int blk = 0; blk < 8; ++blk) {
    if (blk < nblk) {
#pragma unroll
      for (int j = 0; j < 16; ++j) {
        const int i = blk * 16 + j;
        const bool eq = (u[i] == thr);
        const unsigned long long eb = __ballot(eq);
        const unsigned ehalf = qsel ? (unsigned)(eb >> 32) : (unsigned)eb;
        const int below = __popc(ehalf & lt_mask);
        const bool sel = (u[i] > thr) || (eq && (base + below < need));
        base += __popc(ehalf);
        const unsigned long long sb = __ballot(sel);
        const unsigned shalf = qsel ? (unsigned)(sb >> 32) : (unsigned)sb;
        if ((lane & 31) == 0) mrow[i] = shalf;
      }
    }
  }
}
DI void phase_indexer(const Params& p, char* smem) {
  const int tid = otid(p), lane = tid & 63, wave = tid >> 6;
  unsigned* ctr = (unsigned*)(p.ws + OFF_BAR + 15872 + 64);
  volatile LAS int* slot = (volatile LAS int*)((LAS unsigned char*)smem + g8::STAGE_BYTES + 800);
  const int ngroup = NB * (SEQ / 16);
  for (;;) {
    __syncthreads();
    if (tid == 0) *slot = (int)__hip_atomic_fetch_add(ctr, 1u, __ATOMIC_RELAXED, __HIP_MEMORY_SCOPE_AGENT);
    __syncthreads();
    const int g = __builtin_amdgcn_readfirstlane(*slot);
    if (g >= ngroup) break;
    const int b = g & 3, q8 = (SEQ / 16 - 1) - (g >> 2);
    indexer_task(p, b, (q8 * 8 + wave) * 2, lane);
  }
}

constexpr int AT_KROW = 72, AT_VROW = 96;
constexpr int AT_KBYTES = 32 * AT_KROW * 2, AT_STAGE = AT_KBYTES + 32 * AT_VROW * 2;
typedef short s16x4v __attribute__((ext_vector_type(4)));
typedef unsigned u32x4v __attribute__((ext_vector_type(4)));
DI void attn_block(const Params& p, char* smem, int b, int hh, int G) {
  const unsigned short* Qb = (const unsigned short*)(p.ws + OFF_QB);
  const unsigned short* Kb = (const unsigned short*)(p.ws + OFF_KB);
  const unsigned short* Vb = (const unsigned short*)(p.ws + OFF_VT);
  const unsigned* MASK = (const unsigned*)(p.ws + OFF_MASK);
  unsigned short* MIX = (unsigned short*)(p.ws + OFF_MIX);
  LAS unsigned char* lds = (LAS unsigned char*)smem;
  const int tid = otid(p), lane = tid & 63, wave = __builtin_amdgcn_readfirstlane(tid >> 6);
  const int lr = lane & 31, lh = lane >> 5;
  const int qt = 8 * G + wave;
  const int tq = qt * 32 + lr;
  const size_t qtok = (size_t)b * T + NM + tq;
  bf16x8 qf[4];
#pragma unroll
  for (int ks = 0; ks < 4; ++ks) qf[ks] = ld16(Qb + qtok * 512 + hh * 64 + ks * 16 + 8 * lh);
  const unsigned* mrow = MASK + ((size_t)b * SEQ + tq) * 128;
  const int which = tid >> 8, srow = (tid >> 3) & 31, sch = tid & 7;
  const unsigned short* gsrc = (which ? Vb : Kb) + ((size_t)b * T + srow) * 512 + hh * 64 + sch * 8;
  const unsigned sdst = which ? (unsigned)(AT_KBYTES + srow * (AT_VROW * 2) + sch * 16) : (unsigned)(srow * (AT_KROW * 2) + sch * 16);
  const int ntile = 8 * G + 9;
  const unsigned koff = (unsigned)(lr * (AT_KROW * 2) + 16 * lh);
  const unsigned voff = (unsigned)(AT_KBYTES + (4 * lh + ((lane & 15) >> 2)) * (AT_VROW * 2) + (16 * ((lane >> 4) & 1) + 4 * (lane & 3)) * 2);
  __syncthreads();
  {
    const u32x4v st0 = *(const u32x4v*)gsrc;
    *(LAS u32x4v*)(lds + sdst) = st0;
  }
  f32x16 o[2];
#pragma unroll
  for (int i = 0; i < 2; ++i)
#pragma unroll
    for (int r = 0; r < 16; ++r) o[i][r] = 0.f;
  float m = -1e30f, lsum = 0.f;
  const float scale = 0.125f;
  unsigned wnext = mrow[0];
  __syncthreads();
  for (int it = 0; it < ntile; ++it) {
    const int kt = it - 1;
    const bool has_next = it + 1 < ntile;
    u32x4v stg = {0u, 0u, 0u, 0u};
    if (has_next) stg = *(const u32x4v*)(gsrc + (size_t)(NM + 32 * (kt + 1)) * 512);
    if (kt <= qt) {
      const unsigned word = (kt < 0) ? 0x0000ffffu : wnext;
      if (kt >= 0 && kt < qt) wnext = mrow[kt + 1];
      const LAS unsigned char* sb = lds + (it & 1) * AT_STAGE;
      f32x16 s;
#pragma unroll
      for (int r = 0; r < 16; ++r) s[r] = 0.f;
#pragma unroll
      for (int ks = 0; ks < 4; ++ks) {
        const bf16x8 kf = *(const LAS bf16x8*)(sb + koff + ks * 32);
        s = MFMA32(kf, qf[ks], s);
      }
      float tmax = -1e30f;
#pragma unroll
      for (int r = 0; r < 16; ++r) {
        const bool valid = (word >> crow(r, lh)) & 1u;
        s[r] = valid ? s[r] * scale : -1e30f;
        tmax = fmaxf(tmax, s[r]);
      }
      tmax = fmaxf(tmax, xor32f(tmax, lane));
      const float mnew = fmaxf(m, tmax);
      const float alpha = __expf(m - mnew);
      float psum = 0.f;
#pragma unroll
      for (int r = 0; r < 16; ++r) {
        const bool valid = (word >> crow(r, lh)) & 1u;
        const float pv = valid ? __expf(s[r] - mnew) : 0.f;
        s[r] = pv;
        psum += pv;
      }
      psum += xor32f(psum, lane);
      lsum = lsum * alpha + psum;
      m = mnew;
#pragma unroll
      for (int i = 0; i < 2; ++i)
#pragma unroll
        for (int r = 0; r < 16; ++r) o[i][r] *= alpha;
#pragma unroll
      for (int ss = 0; ss < 2; ++ss) {
        const bf16x8 pf = pack8(s, ss);
#pragma unroll
        for (int dt = 0; dt < 2; ++dt) {
          const LAS unsigned char* vp = sb + voff + (16 * ss) * (AT_VROW * 2) + dt * 64;
          const s16x4v lo = __builtin_amdgcn_ds_read_tr16_b64_v4i16((LAS s16x4v*)vp);
          const s16x4v hi = __builtin_amdgcn_ds_read_tr16_b64_v4i16((LAS s16x4v*)(vp + 8 * (AT_VROW * 2)));
          const bf16x8 vf = __builtin_shufflevector(lo, hi, 0, 1, 2, 3, 4, 5, 6, 7);
          o[dt] = MFMA32(vf, pf, o[dt]);
        }
      }
    }
    if (has_next) *(LAS u32x4v*)(lds + ((it + 1) & 1) * AT_STAGE + sdst) = stg;
    __syncthreads();
  }
  const float inv = 1.f / lsum;
#pragma unroll
  for (int dt = 0; dt < 2; ++dt)
#pragma unroll
    for (int r = 0; r < 16; ++r) MIX[qtok * 1024 + hh * 64 + dt * 32 + crow(r, lh)] = f2bf(o[dt][r] * inv);
}
DI void attn_worker(const Params& p, char* smem) {
  unsigned* ctr = (unsigned*)(p.ws + OFF_BAR + 15872);
  volatile LAS int* slot = (volatile LAS int*)((LAS unsigned char*)smem + g8::STAGE_BYTES + 800);
  const int tid = otid(p);
  for (;;) {
    __syncthreads();
    if (tid == 0) *slot = (int)__hip_atomic_fetch_add(ctr, 1u, __ATOMIC_RELAXED, __HIP_MEMORY_SCOPE_AGENT);
    __syncthreads();
    const int k = __builtin_amdgcn_readfirstlane(*slot);
    if (k >= NB * 8 * 16) break;
    const int bh = k & 31, G = 15 - (k >> 5);
    attn_block(p, smem, bh >> 3, bh & 7, G);
  }
}

DI bf16x8 lds8x2(const LAS unsigned short* p0, const LAS unsigned short* p1) {
  typedef unsigned u32x2_t __attribute__((ext_vector_type(2)));
  typedef unsigned u32x4_t __attribute__((ext_vector_type(4)));
  const u32x2_t a = *(const LAS u32x2_t*)p0, b = *(const LAS u32x2_t*)p1;
  const u32x4_t r = {a[0], a[1], b[0], b[1]};
  return __builtin_bit_cast(bf16x8, r);
}
DI void scan_block(const Params& p, char* smem, int bh, const int c0, const int c1) {
  const int tid = otid(p), lane = tid & 63, wave = __builtin_amdgcn_readfirstlane(tid >> 6);
  const int b = bh >> 2, h = bh & 3;
  LAS unsigned char* lds = (LAS unsigned char*)smem;
  const unsigned short* CHB = (const unsigned short*)(p.ws + OFF_WN) + (size_t)bh * NCH * CHB_ELEMS;
  const float* UU = (const float*)(p.ws + OFF_UU) + (size_t)bh * NCH * 8192;
  const float* DL = (const float*)(p.ws + OFF_DL) + (size_t)bh * NCH;
  float* OD = (float*)(p.ws + OFF_OD);
  constexpr int CHB_BYTES = CHB_ELEMS * 2;
  __syncthreads();
  if (wave >= 4) {
    const int w4 = wave - 4;
    for (int c = c0; c <= c1; ++c) {
      if (c < c1) {
        const char* src = (const char*)(CHB + (size_t)c * CHB_ELEMS) + (size_t)(w4 * 15) * 1024 + lane * 16;
        const unsigned dst = (unsigned)((c & 1) * CHB_BYTES + (w4 * 15) * 1024);
#pragma unroll
        for (int j = 0; j < 15; ++j)
          __builtin_amdgcn_global_load_lds((const unsigned*)(src + j * 1024), (LAS unsigned*)(lds + dst + j * 1024), 16, 0, 0);
      }
      asm volatile("s_waitcnt vmcnt(0)" ::: "memory");
      __builtin_amdgcn_s_barrier();
    }
  } else {
    const int sl = wave, lr = lane & 31, lh = lane >> 5, e0 = sl * 32;
    f32x16 S[4];
    float* sst = (float*)(p.ws + OFF_SST) + ((size_t)(bh * 4 + sl) * 64 + lane) * 64;
#pragma unroll
    for (int i = 0; i < 4; ++i)
#pragma unroll
      for (int q = 0; q < 4; ++q) {
        float4 v = make_float4(0.f, 0.f, 0.f, 0.f);
        if (c0 > 0) v = *(const float4*)(sst + i * 16 + q * 4);
        S[i][4 * q] = v.x; S[i][4 * q + 1] = v.y; S[i][4 * q + 2] = v.z; S[i][4 * q + 3] = v.w;
      }
    f32x16 un[2];
    const float* up0 = UU + (size_t)c0 * 8192 + ((size_t)(sl * 2) * 2 + lh) * 512 + lr * 16;
#pragma unroll
    for (int pt = 0; pt < 2; ++pt)
#pragma unroll
      for (int q = 0; q < 4; ++q) {
        const float4 v = *(const float4*)(up0 + pt * 1024 + q * 4);
        un[pt][4 * q] = v.x; un[pt][4 * q + 1] = v.y; un[pt][4 * q + 2] = v.z; un[pt][4 * q + 3] = v.w;
      }
    const int oA = lr * 132 + 4 * lh;
    const int oB = lr * 68 + 4 * lh;
    __builtin_amdgcn_s_barrier();
    for (int c = c0; c < c1; ++c) {
      const LAS unsigned short* cb = (const LAS unsigned short*)(lds + (c & 1) * CHB_BYTES);
      f32x16 vn[2];
      vn[0] = un[0];
      vn[1] = un[1];
#pragma unroll
      for (int pt = 0; pt < 2; ++pt) {
#pragma unroll
        for (int mt = 0; mt < 4; ++mt)
#pragma unroll
          for (int s2 = 0; s2 < 2; ++s2) {
            const LAS unsigned short* ap = cb + oA + pt * 32 * 132 + mt * 32 + 16 * s2;
            vn[pt] = MFMA32(lds8x2(ap, ap + 8), pack8(S[mt], s2), vn[pt]);
          }
      }
      bf16x8 vb[2][2];
#pragma unroll
      for (int pt = 0; pt < 2; ++pt)
#pragma unroll
        for (int s2 = 0; s2 < 2; ++s2) vb[pt][s2] = pack8(vn[pt], s2);
#pragma unroll
      for (int pt = 0; pt < 2; ++pt) {
        f32x16 o;
#pragma unroll
        for (int r = 0; r < 16; ++r) o[r] = 0.f;
#pragma unroll
        for (int mt = 0; mt < 4; ++mt)
#pragma unroll
          for (int s2 = 0; s2 < 2; ++s2) {
            const LAS unsigned short* ap = cb + CH_QG + oA + pt * 32 * 132 + mt * 32 + 16 * s2;
            o = MFMA32(lds8x2(ap, ap + 8), pack8(S[mt], s2), o);
          }
#pragma unroll
        for (int pt2 = 0; pt2 <= pt; ++pt2)
#pragma unroll
          for (int s2 = 0; s2 < 2; ++s2) {
            const LAS unsigned short* ap = cb + CH_IN + oB + pt * 32 * 68 + pt2 * 32 + 16 * s2;
            o = MFMA32(lds8x2(ap, ap + 8), vb[pt2][s2], o);
          }
#pragma unroll
        for (int r = 0; r < 16; ++r) {
          const int t = c * 64 + pt * 32 + crow(r, lh) - 48;
          if (t >= 0) OD[((size_t)(b * T + t)) * 512 + h * 128 + e0 + lr] = o[r];
        }
      }
      if (c + 1 < c1) {
        const float* up = up0 + (size_t)(c + 1 - c0) * 8192;
#pragma unroll
        for (int pt = 0; pt < 2; ++pt)
#pragma unroll
          for (int q = 0; q < 4; ++q) {
            const float4 v = *(const float4*)(up + pt * 1024 + q * 4);
            un[pt][4 * q] = v.x; un[pt][4 * q + 1] = v.y; un[pt][4 * q + 2] = v.z; un[pt][4 * q + 3] = v.w;
          }
      }
      const float dl = DL[c];
#pragma unroll
      for (int mt = 0; mt < 4; ++mt) {
#pragma unroll
        for (int r = 0; r < 16; ++r) S[mt][r] *= dl;
#pragma unroll
        for (int pt2 = 0; pt2 < 2; ++pt2)
#pragma unroll
          for (int s2 = 0; s2 < 2; ++s2) {
            const LAS unsigned short* ap = cb + CH_KDT + oB + mt * 32 * 68 + pt2 * 32 + 16 * s2;
            S[mt] = MFMA32(lds8x2(ap, ap + 8), vb[pt2][s2], S[mt]);
          }
      }
      asm volatile("s_waitcnt lgkmcnt(0)" ::: "memory");
      __builtin_amdgcn_s_barrier();
    }
    if (c1 < NCH) {
#pragma unroll
      for (int i = 0; i < 4; ++i)
#pragma unroll
        for (int q = 0; q < 4; ++q) *(float4*)(sst + i * 16 + q * 4) = make_float4(S[i][4 * q], S[i][4 * q + 1], S[i][4 * q + 2], S[i][4 * q + 3]);
    }
  }
  __syncthreads();
}
DI void phase_scan_attn(const Params& p, char* smem) {
  if (blockIdx.x < 16) scan_block(p, smem, blockIdx.x, 33, NCH);
  attn_worker(p, smem);
}

DI void phase_gnorm(const Params& p) {
  const int tid = otid(p), lane = tid & 63, wave = tid >> 6;
  const float* OD = (const float*)(p.ws + OFF_OD);
  const float* P = (const float*)(p.ws + OFF_P);
  unsigned short* MIX = (unsigned short*)(p.ws + OFF_MIX);
  for (int r = blockIdx.x * NWAVES + wave; r < NR; r += gridDim.x * NWAVES) {
    const int tok = r + 16 * (r / SEQ + 1);
#pragma unroll
    for (int hd = 0; hd < 4; ++hd) {
      float o0 = OD[(size_t)tok * 512 + hd * 128 + lane], o1 = OD[(size_t)tok * 512 + hd * 128 + 64 + lane];
      float ss = wave_sum(o0 * o0 + o1 * o1);
      float rstd = rsqrtf(ss * (1.f / 128.f) + 1e-6f);
      float z0 = P[(size_t)tok * INC + C_BZ + hd * 128 + lane], z1 = P[(size_t)tok * INC + C_BZ + hd * 128 + 64 + lane];
      float y0 = o0 * rstd * p.delta_norm_w[lane] * (z0 / (1.f + __expf(-z0)));
      float y1 = o1 * rstd * p.delta_norm_w[64 + lane] * (z1 / (1.f + __expf(-z1)));
      MIX[(size_t)tok * 1024 + 512 + hd * 128 + lane] = f2bf(y0);
      MIX[(size_t)tok * 1024 + 512 + hd * 128 + 64 + lane] = f2bf(y1);
    }
  }
}

DI void phase_router(const Params& p, char* smem) {
  const int tid = otid(p), lane = tid & 63, wave = tid >> 6;
  float* part = (float*)smem;
  float* rstds = part + 8 * 32 * 33;
  const float* H1 = (const float*)(p.ws + OFF_H1);
  const float* wrs = (const float*)(p.ws + OFF_WRS);
  unsigned short* U2 = (unsigned short*)(p.ws + OFF_U2);
  int* TOPE = (int*)(p.ws + OFF_TOPE);
  float* GATEV = (float*)(p.ws + OFF_GATEV);
  int* POS = (int*)(p.ws + OFF_POS);
  int* CNT = (int*)(p.ws + OFF_CNT);
  const int lr = lane & 31, lh = lane >> 5;
  float4 nw[4];
#pragma unroll
  for (int i = 0; i < 4; ++i) nw[i] = *(const float4*)(p.norm_ffn_w + lane * 4 + 256 * i);
  for (int task = blockIdx.x; task < NR / 32; task += gridDim.x) {
    const int r0 = task * 32;
    __syncthreads();
#pragma unroll
    for (int tt = 0; tt < 4; ++tt) {
      const int r = r0 + wave * 4 + tt;
      const float* src = H1 + (size_t)r * 1024;
      float4 v[4];
      float ss = 0.f;
#pragma unroll
      for (int i = 0; i < 4; ++i) {
        v[i] = *(const float4*)(src + lane * 4 + 256 * i);
        ss += v[i].x * v[i].x + v[i].y * v[i].y + v[i].z * v[i].z + v[i].w * v[i].w;
      }
      ss = wave_sum(ss);
      const float rstd = rsqrtf(ss * (1.f / 1024.f) + 1e-6f);
      if (lane == 0) rstds[wave * 4 + tt] = rstd;
#pragma unroll
      for (int i = 0; i < 4; ++i) {
        uint2 o;
        o.x = pk2(v[i].x * rstd * nw[i].x, v[i].y * rstd * nw[i].y);
        o.y = pk2(v[i].z * rstd * nw[i].z, v[i].w * rstd * nw[i].w);
        *(uint2*)(U2 + (size_t)r * 1024 + lane * 4 + 256 * i) = o;
      }
    }
    f32x16 acc;
#pragma unroll
    for (int i = 0; i < 16; ++i) acc[i] = 0.f;
    const float* arow = H1 + (size_t)(r0 + lr) * 1024 + wave * 128;
    const float* bcol = wrs + (size_t)(wave * 128 + lh) * 32 + lr;
#pragma unroll 8
    for (int k0 = 0; k0 < 128; k0 += 4) {
      const float4 a4 = *(const float4*)(arow + k0);
      const float b0 = bcol[(size_t)k0 * 32], b1 = bcol[(size_t)(k0 + 2) * 32];
      acc = __builtin_amdgcn_mfma_f32_32x32x2f32(lh ? a4.y : a4.x, b0, acc, 0, 0, 0);
      acc = __builtin_amdgcn_mfma_f32_32x32x2f32(lh ? a4.w : a4.z, b1, acc, 0, 0, 0);
    }
#pragma unroll
    for (int r = 0; r < 16; ++r) part[(wave * 32 + crow(r, lh)) * 33 + lr] = acc[r];
    __syncthreads();
    if (tid < 32) {
      const float myrstd = rstds[tid];
      float lv[32];
#pragma unroll
      for (int e = 0; e < 32; ++e) {
        float a = 0.f;
#pragma unroll
        for (int w = 0; w < 8; ++w) a += part[(w * 32 + tid) * 33 + e];
        lv[e] = a * myrstd + p.b_router[e];
      }
      float tv[4];
      int te[4];
#pragma unroll
      for (int k = 0; k < 4; ++k) {
        float bv = lv[0];
        int bi = 0;
#pragma unroll
        for (int e = 1; e < 32; ++e)
          if (lv[e] > bv) { bv = lv[e]; bi = e; }
        tv[k] = bv;
        te[k] = bi;
#pragma unroll
        for (int e = 0; e < 32; ++e)
          if (e == bi) lv[e] = -3.0e38f;
      }
      const float e1 = __expf(tv[1] - tv[0]), e2 = __expf(tv[2] - tv[0]), e3 = __expf(tv[3] - tv[0]);
      const float inv = 1.f / (1.f + e1 + e2 + e3);
      const size_t rr = (size_t)(r0 + tid) * 4;
      TOPE[rr + 0] = te[0]; TOPE[rr + 1] = te[1]; TOPE[rr + 2] = te[2]; TOPE[rr + 3] = te[3];
      GATEV[rr + 0] = inv; GATEV[rr + 1] = e1 * inv; GATEV[rr + 2] = e2 * inv; GATEV[rr + 3] = e3 * inv;
      POS[rr + 0] = atomicAdd(&CNT[te[0]], 1);
      POS[rr + 1] = atomicAdd(&CNT[te[1]], 1);
      POS[rr + 2] = atomicAdd(&CNT[te[2]], 1);
      POS[rr + 3] = atomicAdd(&CNT[te[3]], 1);
    }
  }
}
DI void phase_lists(const Params& p) {
  const int* CNT = (const int*)(p.ws + OFF_CNT);
  const int* TOPE = (const int*)(p.ws + OFF_TOPE);
  const float* GATEV = (const float*)(p.ws + OFF_GATEV);
  const int* POS = (const int*)(p.ws + OFF_POS);
  int* SLOT = (int*)(p.ws + OFF_SLOT);
  int* LTOK = (int*)(p.ws + OFF_LTOK);
  float* LGATE = (float*)(p.ws + OFF_LGATE);
  for (int a = blockIdx.x * NTHREADS + otid(p); a < NASG; a += gridDim.x * NTHREADS) {
    const int e = TOPE[a];
    int off = 0;
    for (int j = 0; j < e; ++j) off += CNT[j];
    const int slot = off + POS[a];
    SLOT[a] = slot;
    LTOK[slot] = a >> 2;
    LGATE[slot] = GATEV[a];
  }
}
DI void phase_combine(const Params& p) {
  const float* H1 = (const float*)(p.ws + OFF_H1);
  const unsigned short* Y = (const unsigned short*)(p.ws + OFF_Y);
  const int* SLOT = (const int*)(p.ws + OFF_SLOT);
  for (int idx = blockIdx.x * NTHREADS + otid(p); idx < NR * 256; idx += gridDim.x * NTHREADS) {
    const int r = idx >> 8, c4 = (idx & 255) * 4;
    float4 a = *(const float4*)(H1 + (size_t)r * 1024 + c4);
#pragma unroll
    for (int k = 0; k < 4; ++k) {
      const int slot = SLOT[r * 4 + k];
      uint2 y = *(const uint2*)(Y + (size_t)slot * 1024 + c4);
      a.x += bf2f((unsigned short)(y.x & 0xffffu));
      a.y += bf2f((unsigned short)(y.x >> 16));
      a.z += bf2f((unsigned short)(y.y & 0xffffu));
      a.w += bf2f((unsigned short)(y.y >> 16));
    }
    *(float4*)(p.out + (size_t)r * 1024 + c4) = a;
  }
}


#define XB_TMO      128
#define XB_XCNT(j)  (256  + 64 * (j))
#define XB_XSUB(j)  (1280 + 64 * (j))
#define XB_XGEN(j)  (2304 + 64 * (j))
#define XB_TOP      3328
#define XB_TOPGEN   3392
#define XB_SPIN_CAP (1u << 22)
DI unsigned xb_ld(unsigned* p) { return __hip_atomic_load(p, __ATOMIC_RELAXED, __HIP_MEMORY_SCOPE_AGENT); }
DI unsigned xb_add(unsigned* p, unsigned v) { return __hip_atomic_fetch_add(p, v, __ATOMIC_RELAXED, __HIP_MEMORY_SCOPE_AGENT); }
DI unsigned xb_xcc_id() { return (unsigned)__builtin_amdgcn_s_getreg((3 << 11) | 20) & 0xFu; }
#define XB_SPIN(cond, bar) do { unsigned _sp = 0; while (cond) { __builtin_amdgcn_s_sleep(1); \
    if ((++_sp & 255u) == 0u) { if (xb_ld(&(bar)[XB_TMO])) break; if (_sp > XB_SPIN_CAP) { atomicAdd(&(bar)[XB_TMO], 1u); break; } } } } while (0)
struct XcdBarrier { unsigned* bar; unsigned x; volatile LAS unsigned* st; bool leader; };
DI void xcd_barrier_complete(unsigned* bar, unsigned x, unsigned& nloc, unsigned& nx) {
  const unsigned G = gridDim.x * gridDim.y * gridDim.z;
  unsigned sum, cnt, mine, sp = 0u;
  for (;;) {
    sum = 0u; cnt = 0u; mine = 0u;
#pragma unroll
    for (unsigned j = 0; j < 16; ++j) { const unsigned c = xb_ld(&bar[XB_XCNT(j)]); sum += c; cnt += (c > 0u) ? 1u : 0u; mine = (j == x) ? c : mine; }
    if (sum == G) break;
    __builtin_amdgcn_s_sleep(1);
    if ((++sp & 255u) == 0u) { if (xb_ld(&bar[XB_TMO])) break; if (sp > XB_SPIN_CAP) { atomicAdd(&bar[XB_TMO], 1u); break; } }
  }
  nloc = mine > 0u ? mine : 1u; nx = cnt > 0u ? cnt : 1u;
}
DI void xcd_barrier(const XcdBarrier& b) {
  asm volatile("s_waitcnt vmcnt(0)" ::: "memory");
  __syncthreads();
  if (b.leader) {
    unsigned* bar = b.bar;
    __builtin_amdgcn_s_waitcnt(0);
    unsigned nloc = b.st[0], nx = b.st[1];
    if (nloc == 0u) { xcd_barrier_complete(bar, b.x, nloc, nx); b.st[0] = nloc; b.st[1] = nx; }
    const unsigned old = xb_add(&bar[XB_XSUB(b.x)], 1u);
    const unsigned gen = old / nloc;
    if (old + 1u == (gen + 1u) * nloc) {
      __builtin_amdgcn_fence(__ATOMIC_RELEASE, "agent");
      asm volatile("s_waitcnt vmcnt(0)" ::: "memory");
      const unsigned og = xb_add(&bar[XB_TOP], 1u);
      const unsigned tg = og / nx;
      if (og + 1u == (tg + 1u) * nx) xb_add(&bar[XB_TOPGEN], 1u);
      else XB_SPIN(xb_ld(&bar[XB_TOPGEN]) == tg, bar);
      __builtin_amdgcn_fence(__ATOMIC_ACQUIRE, "agent");
      xb_add(&bar[XB_XGEN(b.x)], 1u);
      asm volatile("s_waitcnt vmcnt(0)" ::: "memory");
    } else {
      XB_SPIN(xb_ld(&bar[XB_XGEN(b.x)]) == gen, bar);
      __builtin_amdgcn_fence(__ATOMIC_ACQUIRE, "agent");
      asm volatile("s_waitcnt vmcnt(0)" ::: "memory");
    }
  }
  __syncthreads();
}

constexpr int SMEM_BYTES = g8::STAGE_BYTES + 1024;

__global__ void __launch_bounds__(NTHREADS) mk(Params p0) {
  __shared__ __attribute__((aligned(16))) char smem[SMEM_BYTES];
  Params p = p0;
  p.wv = __builtin_amdgcn_readfirstlane((int)(threadIdx.x >> 6));
  XcdBarrier xb;
  {
    volatile LAS unsigned* st = (volatile LAS unsigned*)((LAS unsigned char*)smem + g8::STAGE_BYTES + 768);
    if (threadIdx.x == 0) { st[0] = 0u; st[1] = 0u; }
    __syncthreads();
    xb.bar = (unsigned*)(p.ws + OFF_BAR); xb.x = xb_xcc_id(); xb.st = st; xb.leader = (threadIdx.x == 0);
    if (xb.leader) (void)xb_add(&xb.bar[XB_XCNT(xb.x)], 1u);
  }
  phase_prep(p);
  phase_wconv(p, 0, WC_ALL);
  xcd_barrier(xb);
  g8::gemm_phase<0>(p, smem);
  xcd_barrier(xb);
  phase_post1(p, smem);
  xcd_barrier(xb);
  g8::gemm_phase<1>(p, smem);
  phase_chunkprep(p, smem);
  xcd_barrier(xb);
  if (blockIdx.x < 16) scan_block(p, smem, blockIdx.x, 0, 33);
  phase_post2(p, smem);
  phase_indexer(p, smem);
  xcd_barrier(xb);
  phase_scan_attn(p, smem);
  xcd_barrier(xb);
  phase_gnorm(p);
  xcd_barrier(xb);
  g8::gemm_phase<2>(p, smem);
  xcd_barrier(xb);
  phase_router(p, smem);
  xcd_barrier(xb);
  phase_lists(p);
  xcd_barrier(xb);
  g8::gemm_phase<3>(p, smem);
  xcd_barrier(xb);
  g8::gemm_phase<4>(p, smem);
  xcd_barrier(xb);
  phase_combine(p);
}

extern "C" void kernel_launch(void* const* d_in, const int* in_sizes, int n_in, void* d_out, int out_size, void* d_ws,
                              size_t ws_size, hipStream_t stream) {
  (void)in_sizes; (void)n_in; (void)out_size;
  if (ws_size < WS_NEED) return;
  Params p{};
  p.x = (const float*)d_in[0]; p.meta = (const float*)d_in[1]; p.norm_mix_w = (const float*)d_in[2];
  p.w_in = (const float*)d_in[3]; p.q_norm_w = (const float*)d_in[4]; p.k_norm_w = (const float*)d_in[5];
  p.kv_norm_w = (const float*)d_in[6]; p.w_kv_up = (const float*)d_in[7]; p.conv_w = (const float*)d_in[8];
  p.a_log = (const float*)d_in[9]; p.dt_bias = (const float*)d_in[10]; p.delta_norm_w = (const float*)d_in[11];
  p.w_out = (const float*)d_in[12]; p.norm_ffn_w = (const float*)d_in[13]; p.w_router = (const float*)d_in[14];
  p.b_router = (const float*)d_in[15]; p.w_gate_up = (const float*)d_in[16]; p.b_gate_up = (const float*)d_in[17];
  p.w_down = (const float*)d_in[18]; p.b_down = (const float*)d_in[19];
  p.out = (float*)d_out;
  p.ws = (char*)d_ws;
  (void)hipMemsetAsync((char*)d_ws + OFF_CNT, 0, 4096, stream);
  (void)hipMemsetAsync((char*)d_ws + OFF_BAR, 0, 16384, stream);
  static int grid_blocks = 0;
  if (!grid_blocks) {
    int dev = 0, cus = 0, per_cu = 0;
    (void)hipGetDevice(&dev);
    (void)hipDeviceGetAttribute(&cus, hipDeviceAttributeMultiprocessorCount, dev);
    (void)hipOccupancyMaxActiveBlocksPerMultiprocessor(&per_cu, mk, NTHREADS, 0);
    if (per_cu > 1) per_cu = 1;
    grid_blocks = cus * per_cu;
  }
  void* args[] = {&p};
  hipError_t e = hipLaunchCooperativeKernel((void*)mk, dim3(grid_blocks), dim3(NTHREADS), args, 0, stream);
  if (e != hipSuccess) fprintf(stderr, "cooperative launch failed: %s (grid %d)\n", hipGetErrorString(e), grid_blocks);
}
```

```cpp
#include <hip/hip_runtime.h>
#include <stdint.h>
#include <stdio.h>


typedef __attribute__((ext_vector_type(8))) short bf16x8;
typedef __attribute__((ext_vector_type(4))) short s16x4;
typedef __attribute__((ext_vector_type(16))) float f32x16;
typedef __attribute__((ext_vector_type(4))) float f32x4;
typedef __bf16 bf2_t __attribute__((ext_vector_type(2)));
#define DI __device__ __forceinline__
#define MFMA32(a, b, c) __builtin_amdgcn_mfma_f32_32x32x16_bf16((a), (b), (c), 0, 0, 0)
#define MFMA16(a, b, c) __builtin_amdgcn_mfma_f32_16x16x32_bf16((a), (b), (c), 0, 0, 0)

constexpr int NB = 4, SEQ = 4096, NM = 16, T = 4112, NT = NB * T, NR = NB * SEQ, D = 1024, INC = 3408;
constexpr int C_AQ = 0, C_CKV = 512, C_IQ = 768, C_IK = 1280, C_IW = 1344, C_BQKV = 1352, C_BZ = 2888, C_BBETA = 3400, C_BA = 3404;
constexpr int NCH = 65, NCHT = NB * 4 * NCH;
constexpr int NEXP = 32, NASG = NR * 4;
constexpr int CNTS = 32;
constexpr int NTHREADS = 512, NWAVES = 8;

constexpr size_t al256(size_t x) { return (x + 255) & ~(size_t)255; }
constexpr size_t OFF_U = 0;
constexpr int NTP = 16640;
constexpr size_t OFF_P = OFF_U + al256((size_t)NTP * 1024 * 2);
constexpr size_t OFF_ROPE = OFF_P + al256((size_t)NT * INC * 4);
constexpr size_t OFF_QB = OFF_ROPE + al256((size_t)T * 64 * 4);
constexpr size_t OFF_KB = OFF_QB + al256((size_t)NT * 512 * 2);
constexpr size_t OFF_VT = OFF_KB + al256((size_t)NT * 512 * 2);
constexpr size_t OFF_QI = OFF_VT + al256((size_t)NT * 512 * 2);
constexpr size_t OFF_KI = OFF_QI + al256((size_t)NT * 512 * 2);
constexpr size_t OFF_WI = OFF_KI + al256((size_t)NT * 64 * 2);
constexpr size_t OFF_CKV = OFF_WI + al256((size_t)NT * 8 * 4);
constexpr size_t OFF_KV = OFF_CKV + al256((size_t)NTP * 256 * 2);
constexpr size_t OFF_MASK = OFF_KV + al256((size_t)NT * 1024 * 4);
constexpr size_t OFF_MIX = OFF_MASK + al256((size_t)NB * SEQ * 128 * 4);
constexpr size_t OFF_QD = OFF_MIX + al256((size_t)NT * 1024 * 2);
constexpr size_t OFF_KD = OFF_QD + al256((size_t)NT * 512 * 4);
constexpr size_t OFF_VD = OFF_KD + al256((size_t)NT * 512 * 4);
constexpr size_t OFF_BETA = OFF_VD + al256((size_t)NT * 512 * 4);
constexpr size_t OFF_G = OFF_BETA + al256((size_t)NT * 4 * 4);
constexpr int CHB_ELEMS = 30720, CH_QG = 8448, CH_KDT = 16896, CH_IN = 25600;
constexpr size_t OFF_WN = OFF_G + al256((size_t)NT * 4 * 4);
constexpr size_t OFF_UU = OFF_WN + al256((size_t)NCHT * CHB_ELEMS * 2);
constexpr size_t OFF_DL = OFF_UU + al256((size_t)NCHT * 64 * 128 * 4);
constexpr size_t OFF_OD = OFF_DL + al256((size_t)NCHT * 4);
constexpr size_t OFF_U2 = OFF_OD + al256((size_t)NT * 512 * 4);
constexpr size_t OFF_TOPE = OFF_U2 + al256((size_t)NR * 1024 * 2);
constexpr size_t OFF_GATEV = OFF_TOPE + al256((size_t)NR * 4 * 4);
constexpr size_t OFF_POS = OFF_GATEV + al256((size_t)NR * 4 * 4);
constexpr size_t OFF_SLOT = OFF_POS + al256((size_t)NR * 4 * 4);
constexpr size_t OFF_LTOK = OFF_SLOT + al256((size_t)NR * 4 * 4);
constexpr size_t OFF_LGATE = OFF_LTOK + al256((size_t)NASG * 4);
constexpr size_t OFF_WTIN = OFF_LGATE + al256((size_t)NASG * 4);
constexpr size_t OFF_WTKV = OFF_WTIN + al256((size_t)3584 * 1024 * 2);
constexpr size_t OFF_WTOUT = OFF_WTKV + al256((size_t)1024 * 256 * 2);
constexpr size_t OFF_WTGU = OFF_WTOUT + al256((size_t)1024 * 1024 * 2);
constexpr size_t OFF_WTDN = OFF_WTGU + al256((size_t)32 * 2048 * 1024 * 2);
constexpr size_t OFF_CNT = OFF_WTDN + al256((size_t)32 * 1024 * 1024 * 2);
constexpr size_t OFF_Y = OFF_QD;
static_assert(OFF_U2 - OFF_QD >= (size_t)NASG * 1024 * 2, "Y alias does not fit");
static_assert((size_t)(NASG + 256) * 1024 * 2 <= (size_t)NT * INC * 4, "HD alias does not fit");
constexpr size_t OFF_WRS = OFF_CNT + 4096;
constexpr size_t OFF_SST = OFF_WRS + 131072;
constexpr size_t OFF_BAR = OFF_SST + (size_t)16 * 4 * 64 * 64 * 4;
constexpr size_t WS_NEED = OFF_BAR + 16384;
constexpr size_t OFF_H1 = OFF_KV;
constexpr size_t OFF_HD = OFF_P;

struct Params {
  const float *x, *meta, *norm_mix_w, *w_in, *q_norm_w, *k_norm_w, *kv_norm_w, *w_kv_up, *conv_w, *a_log, *dt_bias,
      *delta_norm_w, *w_out, *norm_ffn_w, *w_router, *b_router, *w_gate_up, *b_gate_up, *w_down, *b_down;
  float* out;
  char* ws;
  int wv;
  int pad0;
};

#define LAS __attribute__((address_space(3)))
constexpr int STAGE_LDS_BYTES = 131072;
DI unsigned pk2(float a, float b) { bf2_t v; v[0] = (__bf16)a; v[1] = (__bf16)b; return __builtin_bit_cast(unsigned, v); }
DI unsigned short f2bf(float a) { return (unsigned short)(pk2(a, 0.f) & 0xffffu); }
DI float bf2f(unsigned short u) { return __uint_as_float(((unsigned)u) << 16); }
template <int CTRL> DI float dppf(float v) { return __builtin_bit_cast(float, __builtin_amdgcn_update_dpp(0, __builtin_bit_cast(int, v), CTRL, 0xf, 0xf, false)); }
template <int CTRL> DI int dppi(int v) { return __builtin_amdgcn_update_dpp(0, v, CTRL, 0xf, 0xf, false); }
DI float rlf(float v, int l) { return __builtin_bit_cast(float, __builtin_amdgcn_readlane(__builtin_bit_cast(int, v), l)); }
DI float wave_sum(float v) {
  v += dppf<0xB1>(v); v += dppf<0x4E>(v); v += dppf<0x141>(v); v += dppf<0x140>(v);
  return (rlf(v, 0) + rlf(v, 16)) + (rlf(v, 32) + rlf(v, 48));
}
DI float xor32f(float v, int lane) {
  auto r = __builtin_amdgcn_permlane32_swap(__builtin_bit_cast(unsigned, v), __builtin_bit_cast(unsigned, v), false, false);
  return __builtin_bit_cast(float, (lane < 32) ? r[1] : r[0]);
}
DI float xor16f(float v, int lane) {
  auto r = __builtin_amdgcn_permlane16_swap(__builtin_bit_cast(unsigned, v), __builtin_bit_cast(unsigned, v), false, false);
  return __builtin_bit_cast(float, (lane & 16) ? r[0] : r[1]);
}
DI int otid(const Params& p) {
  int l;
  asm volatile("v_mbcnt_lo_u32_b32 %0, -1, 0\n\tv_mbcnt_hi_u32_b32 %0, -1, %0" : "=v"(l));
  return (p.wv << 6) | l;
}
DI int swzA(int row, int col) { return row * 132 + col; }
DI int swzB(int row, int col) { return row * 68 + col; }
DI int crow(int reg, int h) { return (reg & 3) + 8 * (reg >> 2) + 4 * h; }
DI bf16x8 pack8(const f32x16& x, int s) {
  uint4 p;
  p.x = pk2(x[8 * s + 0], x[8 * s + 1]); p.y = pk2(x[8 * s + 2], x[8 * s + 3]);
  p.z = pk2(x[8 * s + 4], x[8 * s + 5]); p.w = pk2(x[8 * s + 6], x[8 * s + 7]);
  return __builtin_bit_cast(bf16x8, p);
}
DI bf16x8 ld8x2(const unsigned short* p0, const unsigned short* p1) {
  uint2 a = *(const uint2*)p0, b = *(const uint2*)p1;
  uint4 r = make_uint4(a.x, a.y, b.x, b.y);
  return __builtin_bit_cast(bf16x8, r);
}
DI bf16x8 ld16(const unsigned short* p) { uint4 r = *(const uint4*)p; return __builtin_bit_cast(bf16x8, r); }
DI const float* hrow(const Params& p, int tok) {
  int b = tok / T, t = tok - b * T;
  return (t < NM) ? (p.meta + (size_t)t * D) : (p.x + ((size_t)b * SEQ + (t - NM)) * D);
}

DI void phase_prep(const Params& p) {
  const int tid = otid(p), lane = tid & 63, wave = tid >> 6;
  float* rope = (float*)(p.ws + OFF_ROPE);
  for (int idx = blockIdx.x * NTHREADS + tid; idx < T * 32; idx += gridDim.x * NTHREADS) {
    int t = idx >> 5, i = idx & 31;
    float inv = (float)pow(10000.0, -(double)i / 32.0);
    float ang = (float)t * inv;
    double ad = (double)ang;
    double n = rint(ad * 0.15915494309189535);
    float r = (float)(ad - n * 6.283185307179586);
    float sn, cs;
    sincosf(r, &sn, &cs);
    rope[t * 64 + i] = cs;
    rope[t * 64 + 32 + i] = sn;
  }
  float* wrs = (float*)(p.ws + OFF_WRS);
  for (int idx = blockIdx.x * NTHREADS + tid; idx < 1024 * 32; idx += gridDim.x * NTHREADS) wrs[idx] = p.norm_ffn_w[idx >> 5] * p.w_router[idx];
  unsigned short* U = (unsigned short*)(p.ws + OFF_U);
  for (int tok = blockIdx.x * NWAVES + wave; tok < NT; tok += gridDim.x * NWAVES) {
    const float* src = hrow(p, tok);
    float4 v[4];
    float ss = 0.f;
#pragma unroll
    for (int i = 0; i < 4; ++i) {
      v[i] = *(const float4*)(src + lane * 4 + 256 * i);
      ss += v[i].x * v[i].x + v[i].y * v[i].y + v[i].z * v[i].z + v[i].w * v[i].w;
    }
    ss = wave_sum(ss);
    float rstd = rsqrtf(ss * (1.f / 1024.f) + 1e-6f);
#pragma unroll
    for (int i = 0; i < 4; ++i) {
      float4 w = *(const float4*)(p.norm_mix_w + lane * 4 + 256 * i);
      uint2 o;
      o.x = pk2(v[i].x * rstd * w.x, v[i].y * rstd * w.y);
      o.y = pk2(v[i].z * rstd * w.z, v[i].w * rstd * w.w);
      *(uint2*)(U + (size_t)tok * 1024 + lane * 4 + 256 * i) = o;
    }
  }
}

DI void wconv_task2(const float* src, unsigned short* dst, int K, int N, int k0, int n0, int tid) {
  const int kg = tid >> 6, n = n0 + (tid & 63) * 4, k = k0 + kg * 8;
  float4 v[8];
#pragma unroll
  for (int i = 0; i < 8; ++i) {
    v[i] = make_float4(0.f, 0.f, 0.f, 0.f);
    if (n < N) v[i] = *(const float4*)(src + (size_t)(k + i) * N + n);
  }
  uint4 o;
  o.x = pk2(v[0].x, v[1].x); o.y = pk2(v[2].x, v[3].x); o.z = pk2(v[4].x, v[5].x); o.w = pk2(v[6].x, v[7].x);
  *(uint4*)(dst + (size_t)(n + 0) * K + k) = o;
  o.x = pk2(v[0].y, v[1].y); o.y = pk2(v[2].y, v[3].y); o.z = pk2(v[4].y, v[5].y); o.w = pk2(v[6].y, v[7].y);
  *(uint4*)(dst + (size_t)(n + 1) * K + k) = o;
  o.x = pk2(v[0].z, v[1].z); o.y = pk2(v[2].z, v[3].z); o.z = pk2(v[4].z, v[5].z); o.w = pk2(v[6].z, v[7].z);
  *(uint4*)(dst + (size_t)(n + 2) * K + k) = o;
  o.x = pk2(v[0].w, v[1].w); o.y = pk2(v[2].w, v[3].w); o.z = pk2(v[4].w, v[5].w); o.w = pk2(v[6].w, v[7].w);
  *(uint4*)(dst + (size_t)(n + 3) * K + k) = o;
}
constexpr int WC_IN = 16 * 14, WC_KV = 4 * 4, WC_OUT = 16 * 4, WC_GU = 32 * 128, WC_DN = 32 * 64;
constexpr int WC_SMALL = WC_IN + WC_KV + WC_OUT, WC_ALL = WC_SMALL + WC_GU + WC_DN;
DI void wconv_task(const Params& p, int t, int tid) {
  if (t < WC_IN) {
    wconv_task2(p.w_in, (unsigned short*)(p.ws + OFF_WTIN), 1024, INC, (t / 14) * 64, (t % 14) * 256, tid);
  } else if (t < WC_IN + WC_KV) {
    t -= WC_IN;
    wconv_task2(p.w_kv_up, (unsigned short*)(p.ws + OFF_WTKV), 256, 1024, (t >> 2) * 64, (t & 3) * 256, tid);
  } else if (t < WC_SMALL) {
    t -= WC_IN + WC_KV;
    wconv_task2(p.w_out, (unsigned short*)(p.ws + OFF_WTOUT), 1024, 1024, (t >> 2) * 64, (t & 3) * 256, tid);
  } else if (t < WC_SMALL + WC_GU) {
    t -= WC_SMALL;
    const int e = t >> 7, r = t & 127;
    wconv_task2(p.w_gate_up + (size_t)e * 1024 * 2048, (unsigned short*)(p.ws + OFF_WTGU) + (size_t)e * 2048 * 1024, 1024, 2048,
                (r >> 3) * 64, (r & 7) * 256, tid);
  } else {
    t -= WC_SMALL + WC_GU;
    const int e = t >> 6, r = t & 63;
    wconv_task2(p.w_down + (size_t)e * 1024 * 1024, (unsigned short*)(p.ws + OFF_WTDN) + (size_t)e * 1024 * 1024, 1024, 1024,
                (r >> 2) * 64, (r & 3) * 256, tid);
  }
}
DI void wconv_fill(const Params& p, char* smem, int site, bool drain) {
  unsigned* q = (unsigned*)(p.ws + OFF_BAR + 15872 + 128);
  volatile LAS int* slot = (volatile LAS int*)((LAS unsigned char*)smem + STAGE_LDS_BYTES + 832);
  const int tid = otid(p);
  __syncthreads();
  if (tid == 0 && !drain) (void)__hip_atomic_fetch_add(&q[16 + site], 1u, __ATOMIC_RELAXED, __HIP_MEMORY_SCOPE_AGENT);
  for (;;) {
    __syncthreads();
    if (tid == 0) {
      int t = -1;
      const bool all_done = !drain && __hip_atomic_load(&q[16 + site], __ATOMIC_RELAXED, __HIP_MEMORY_SCOPE_AGENT) >= gridDim.x;
      if (!all_done) t = WC_SMALL + (int)__hip_atomic_fetch_add(&q[0], 1u, __ATOMIC_RELAXED, __HIP_MEMORY_SCOPE_AGENT);
      *slot = t;
    }
    __syncthreads();
    const int t = __builtin_amdgcn_readfirstlane(*slot);
    if (t < 0 || t >= WC_ALL) break;
    wconv_task(p, t, tid);
  }
}
DI void phase_wconv(const Params& p, int t0, int t1) {
  const int tid = otid(p);
  for (int t = t0 + blockIdx.x; t < t1; t += gridDim.x) wconv_task(p, t, tid);
}

namespace g8 {
constexpr int BM = 256, BK = 64, HALF = 128, HTB = HALF * BK * 2, STAGE_BYTES = 8 * HTB, NXCD = 8, WGM = 8;
constexpr int TAB_OFF = STAGE_BYTES;
constexpr int MAXU = 24;
DI int lds_byte(int r, int c) { const int st = (r >> 4) * 2 + (c >> 5), rr = r & 15, cc = c & 31, ob = rr * 64 + cc * 2; return st * 1024 + (ob ^ (((ob >> 9) & 1) << 5)); }
DI void stage_rc(int b, int& R, int& C) { const int st = b / 1024, sb = b % 1024, swz = sb ^ (((sb >> 9) & 1) << 5); R = (st >> 1) * 16 + swz / 64; C = (st & 1) * 32 + (swz % 64) / 2; }
DI int perm32(int rho) { const int n = rho >> 4, i = rho & 15; return 8 * (i >> 2) + 4 * n + (i & 3); }
DI int xcd_remap(int L, int nwg) { const int q = nwg / NXCD, r = nwg % NXCD, xcd = L % NXCD, off = L / NXCD; return (xcd < r ? xcd * (q + 1) : r * (q + 1) + (xcd - r) * q) + off; }
struct UnitT { int valid, arow, mend, pn, e, orow; };

template <int MODE> DI int n_units(const Params& p) {
  if (MODE == 0) return 65 * 14;
  if (MODE == 1) return 65 * 4;
  if (MODE == 2) return 64 * 4;
  const int* cnt = (const int*)(p.ws + OFF_CNT);
  int n = 0;
  for (int e = 0; e < NEXP; ++e) n += ((cnt[e * CNTS] + 255) >> 8) * (MODE == 3 ? 8 : 4);
  return n;
}
template <int MODE> DI void unit_of(const Params& p, int L, int nwg, UnitT& u) {
  u.valid = 0; u.arow = 0; u.mend = 0; u.pn = 0; u.e = 0; u.orow = 0;
  if (L >= nwg) return;
  const int wgid = xcd_remap(L, nwg);
  u.valid = 1;
  if (MODE <= 2) {
    const int nM = (MODE == 2) ? 64 : 65, nN = (MODE == 0) ? 14 : 4;
    const int nig = WGM * nN, gid = wgid / nig, fm = gid * WGM, gsz = (nM - fm) < WGM ? (nM - fm) : WGM;
    const int pm = fm + ((wgid % nig) % gsz);
    u.pn = (wgid % nig) / gsz;
    u.orow = pm * 256;
    u.arow = (MODE == 2) ? (pm * 256 + 16 * (pm / 16 + 1)) : pm * 256;
    u.mend = (MODE == 2) ? NR : NT;
  } else {
    const int* cnt = (const int*)(p.ws + OFF_CNT);
    constexpr int NTN = (MODE == 3) ? 8 : 4;
    int id = wgid, sbase = 0;
    for (int e = 0; e < NEXP; ++e) {
      const int c = cnt[e * CNTS], mts = (c + 255) >> 8, ne = mts * NTN;
      if (id < ne) {
        const int tn = id / mts, tm = id - tn * mts;
        u.e = e; u.pn = tn; u.arow = sbase + tm * 256; u.orow = u.arow; u.mend = sbase + c;
        return;
      }
      id -= ne;
      sbase += c;
    }
    u.valid = 0;
  }
}
DI float swiglu(float g, float u) {
  g = fminf(g, 7.0f);
  u = fminf(fmaxf(u, -7.0f), 7.0f);
  return g / (1.f + __expf(-1.702f * g)) * (u + 1.f);
}
template <int MODE>
DI void epilogue(const Params& p, const f32x4 (&acc)[2][2][4][2], const UnitT& u, int wr, int wc, int fr, int fq) {
  constexpr bool PERM = (MODE >= 3);
  const int row0 = u.orow + wr * 64 + fr;
  const int col0 = u.pn * 256 + wc * 32 + (PERM ? 8 * fq : 4 * fq);
  if (MODE == 0 || MODE == 1 || MODE == 2) {
    float* C = (float*)(p.ws + (MODE == 0 ? OFF_P : MODE == 1 ? OFF_KV : OFF_H1));
    const int ldc = (MODE == 0) ? INC : 1024;
#pragma unroll
    for (int ai = 0; ai < 2; ++ai)
#pragma unroll
      for (int m = 0; m < 4; ++m) {
        const int row = row0 + ai * 128 + m * 16;
        if (row < u.mend) {
#pragma unroll
          for (int bj = 0; bj < 2; ++bj)
#pragma unroll
            for (int n = 0; n < 2; ++n) {
              const int col = col0 + bj * 128 + n * 16;
              if (MODE != 0 || col < INC) {
                f32x4 v = acc[ai][bj][m][n];
                if (MODE == 2) v += *(const f32x4*)(p.x + (size_t)row * D + col);
                *(f32x4*)(C + (size_t)row * ldc + col) = v;
              }
            }
        }
      }
  } else if (MODE == 3) {
    unsigned short* HD = (unsigned short*)(p.ws + OFF_HD);
    f32x4 bv[2][2];
#pragma unroll
    for (int bj = 0; bj < 2; ++bj)
#pragma unroll
      for (int n = 0; n < 2; ++n) bv[bj][n] = *(const f32x4*)(p.b_gate_up + (size_t)u.e * 2048 + col0 + bj * 128 + 4 * n);
#pragma unroll
    for (int ai = 0; ai < 2; ++ai)
#pragma unroll
      for (int m = 0; m < 4; ++m) {
        const int row = row0 + ai * 128 + m * 16;
        if (row < u.mend) {
#pragma unroll
          for (int bj = 0; bj < 2; ++bj) {
            const f32x4 v0 = acc[ai][bj][m][0] + bv[bj][0], v1 = acc[ai][bj][m][1] + bv[bj][1];
            uint2 o;
            o.x = pk2(swiglu(v0[0], v0[1]), swiglu(v0[2], v0[3]));
            o.y = pk2(swiglu(v1[0], v1[1]), swiglu(v1[2], v1[3]));
            *(uint2*)(HD + (size_t)row * 1024 + (col0 + bj * 128) / 2) = o;
          }
        }
      }
  } else {
    unsigned short* Y = (unsigned short*)(p.ws + OFF_Y);
    const float* lgate = (const float*)(p.ws + OFF_LGATE);
    f32x4 bv[2][2];
#pragma unroll
    for (int bj = 0; bj < 2; ++bj)
#pragma unroll
      for (int n = 0; n < 2; ++n) bv[bj][n] = *(const f32x4*)(p.b_down + (size_t)u.e * 1024 + col0 + bj * 128 + 4 * n);
#pragma unroll
    for (int ai = 0; ai < 2; ++ai)
#pragma unroll
      for (int m = 0; m < 4; ++m) {
        const int row = row0 + ai * 128 + m * 16;
        if (row < u.mend) {
          const float gt = lgate[row];
#pragma unroll
          for (int bj = 0; bj < 2; ++bj) {
            const f32x4 v0 = (acc[ai][bj][m][0] + bv[bj][0]) * gt, v1 = (acc[ai][bj][m][1] + bv[bj][1]) * gt;
            uint4 o;
            o.x = pk2(v0[0], v0[1]); o.y = pk2(v0[2], v0[3]); o.z = pk2(v1[0], v1[1]); o.w = pk2(v1[2], v1[3]);
            *(uint4*)(Y + (size_t)row * 1024 + col0 + bj * 128) = o;
          }
        }
      }
  }
}

template <int MODE>
DI void gemm_phase(const Params& p, char* smem) {
  constexpr bool PERM = (MODE >= 3);
  constexpr int K = (MODE == 1) ? 256 : 1024, nt = K / BK;
  LAS unsigned char* lds = (LAS unsigned char*)smem;
  LAS int* tab = (LAS int*)(lds + TAB_OFF);
  const int tid = otid(p), wid = __builtin_amdgcn_readfirstlane(tid >> 6), lane = tid & 63, wr = wid >> 2, wc = wid & 3, fr = lane & 15, fq = lane >> 4;
  __syncthreads();
  {
    const int nwg = n_units<MODE>(p);
    for (int ti = 0; ti < MAXU; ++ti) {
      UnitT u;
      unit_of<MODE>(p, ti * (int)gridDim.x + (int)blockIdx.x, nwg, u);
      if (tid == 0) { tab[ti * 8 + 0] = u.valid; tab[ti * 8 + 1] = u.arow; tab[ti * 8 + 2] = u.mend; tab[ti * 8 + 3] = u.pn; tab[ti * 8 + 4] = u.e; tab[ti * 8 + 5] = u.orow; }
    }
  }
  __syncthreads();
#define G8_GETU(i, u) do { const int _i = (i); (u).valid = (_i < MAXU) ? __builtin_amdgcn_readfirstlane(tab[_i * 8 + 0]) : 0; (u).arow = __builtin_amdgcn_readfirstlane(tab[(_i < MAXU ? _i : 0) * 8 + 1]); \
    (u).mend = __builtin_amdgcn_readfirstlane(tab[(_i < MAXU ? _i : 0) * 8 + 2]); (u).pn = __builtin_amdgcn_readfirstlane(tab[(_i < MAXU ? _i : 0) * 8 + 3]); \
    (u).e = __builtin_amdgcn_readfirstlane(tab[(_i < MAXU ? _i : 0) * 8 + 4]); (u).orow = __builtin_amdgcn_readfirstlane(tab[(_i < MAXU ? _i : 0) * 8 + 5]); } while (0)
  UnitT cur, nxt;
  G8_GETU(0, cur);
  if (!cur.valid) return;
  const char* Abase = (const char*)(p.ws + (MODE == 0 ? OFF_U : MODE == 1 ? OFF_CKV : MODE == 2 ? OFF_MIX : MODE == 3 ? OFF_U2 : OFF_HD));
  const char* Bbase = (const char*)(p.ws + (MODE == 0 ? OFF_WTIN : MODE == 1 ? OFF_WTKV : MODE == 2 ? OFF_WTOUT : MODE == 3 ? OFF_WTGU : OFF_WTDN));
  constexpr size_t BEXP = (MODE == 3) ? (size_t)2048 * 1024 * 2 : (MODE == 4) ? (size_t)1024 * 1024 * 2 : 0;
  int Rr[2], Cc[2];
  unsigned voffB[2];
#pragma unroll
  for (int i = 0; i < 2; ++i) {
    stage_rc(tid * 16 + i * 8192, Rr[i], Cc[i]);
    const int Rb = PERM ? ((Rr[i] & ~31) + perm32(Rr[i] & 31)) : Rr[i];
    voffB[i] = (unsigned)(Rb * K + Cc[i]) * 2u;
  }
  unsigned voffA[2][2];
  const int* ltok = (const int*)(p.ws + OFF_LTOK);
#define G8_VOFFA(dst, un) do { _Pragma("unroll") for (int _h = 0; _h < 2; ++_h) _Pragma("unroll") for (int _i = 0; _i < 2; ++_i) { \
      if (MODE == 3) { int _s = (un).arow + _h * 128 + Rr[_i]; _s = _s < NASG ? _s : NASG - 1; dst[_h][_i] = (unsigned)(ltok[_s] * K + Cc[_i]) * 2u; } \
      else dst[_h][_i] = (unsigned)((_h * 128 + Rr[_i]) * K + Cc[_i]) * 2u; } } while (0)
  const size_t kstep = (size_t)(BK * 2);
  const size_t hstep = (size_t)HALF * K * 2;
  const size_t tstep = 2 * hstep;
  const unsigned ldsw = (unsigned)wid * 1024u;
  const int aoff = lds_byte(wr * 64 + fr, fq * 8), boff = lds_byte(wc * 32 + fr, fq * 8);
#define G8_SA(b, h) (((b) * 2 + (h)) * HTB)
#define G8_SB(b, h) ((4 + (b) * 2 + (h)) * HTB)
#define G8_STAGE(bufoff, gbase, voff) do { _Pragma("unroll") for (int _i = 0; _i < 2; ++_i) \
    __builtin_amdgcn_global_load_lds((const unsigned*)((const char*)(gbase) + (voff)[_i]), (LAS unsigned*)(lds + (bufoff) + ldsw + _i * 8192), 16, 0, 0); } while (0)
#define G8_LDA(dst, b, h) do { _Pragma("unroll") for (int m = 0; m < 4; ++m) _Pragma("unroll") for (int k = 0; k < 2; ++k) dst[m][k] = *(const LAS bf16x8*)(lds + G8_SA(b, h) + aoff + m * 2048 + k * 1024); } while (0)
#define G8_LDB(dst, b, h) do { _Pragma("unroll") for (int n = 0; n < 2; ++n) _Pragma("unroll") for (int k = 0; k < 2; ++k) dst[n][k] = *(const LAS bf16x8*)(lds + G8_SB(b, h) + boff + n * 2048 + k * 1024); } while (0)
#define G8_MMA(ai, bj, At, Bt) do { __builtin_amdgcn_s_setprio(1); _Pragma("unroll") for (int m = 0; m < 4; ++m) _Pragma("unroll") for (int n = 0; n < 2; ++n) _Pragma("unroll") for (int k = 0; k < 2; ++k) \
    acc[ai][bj][m][n] = __builtin_amdgcn_mfma_f32_16x16x32_bf16(Bt[n][k], At[m][k], acc[ai][bj][m][n], 0, 0, 0); __builtin_amdgcn_s_setprio(0); } while (0)
#define G8_WAIT_V(n) asm volatile("s_waitcnt vmcnt(" #n ")" ::: "memory")
#define G8_WAIT_L(n) asm volatile("s_waitcnt lgkmcnt(" #n ")" ::: "memory")
#define G8_BAR __builtin_amdgcn_s_barrier()
#define G8_SCHED __builtin_amdgcn_sched_barrier(0)
  int ui = 0;
  f32x4 acc[2][2][4][2];
#pragma unroll
  for (int a = 0; a < 2; ++a)
#pragma unroll
    for (int b = 0; b < 2; ++b)
#pragma unroll
      for (int m = 0; m < 4; ++m)
#pragma unroll
        for (int n = 0; n < 2; ++n) acc[a][b][m][n] = (f32x4){0.f, 0.f, 0.f, 0.f};
  bf16x8 At[4][2], B0[2][2], B1[2][2];
  G8_VOFFA(voffA, cur);
  if (MODE == 3) asm volatile("s_waitcnt vmcnt(0)" ::: "memory");
  const char* cA = (MODE == 3) ? Abase : Abase + (size_t)cur.arow * K * 2;
  const char* cB = Bbase + (size_t)cur.e * BEXP + (size_t)cur.pn * tstep;
  G8_STAGE(G8_SB(0, 0), cB, voffB); G8_STAGE(G8_SA(0, 0), cA, voffA[0]); G8_STAGE(G8_SB(0, 1), cB + hstep, voffB); G8_STAGE(G8_SA(0, 1), cA, voffA[1]);
  if (wr == 1) G8_BAR;
  G8_WAIT_V(4); G8_BAR;
  G8_STAGE(G8_SB(1, 0), cB + kstep, voffB); G8_STAGE(G8_SA(1, 0), cA + kstep, voffA[0]); G8_STAGE(G8_SB(1, 1), cB + hstep + kstep, voffB);
  G8_WAIT_V(6); G8_BAR;
  for (;;) {
    G8_GETU(ui + 1, nxt);
    const bool has_next = nxt.valid != 0;
    const char* nA = has_next ? ((MODE == 3) ? Abase : Abase + (size_t)nxt.arow * K * 2) : cA;
    const char* nB = has_next ? Bbase + (size_t)nxt.e * BEXP + (size_t)nxt.pn * tstep : cB;
#pragma unroll 1
    for (int t = 0; t < nt; t += 2) {
      const bool last = (t == nt - 2);
      const char* a1 = cA + (size_t)(t + 1) * kstep;
      const char* a2 = last ? nA : cA + (size_t)(t + 2) * kstep;
      const char* b2 = last ? nB : cB + (size_t)(t + 2) * kstep;
      const char* a3 = a2 + kstep;
      const char* b3 = b2 + kstep;
      G8_LDB(B0, 0, 0); G8_SCHED; G8_LDA(At, 0, 0); G8_STAGE(G8_SA(1, 1), a1, voffA[1]);
      if (MODE == 3) {
        if (last && has_next) {
          G8_VOFFA(voffA, nxt);
          asm volatile("s_waitcnt vmcnt(0)" ::: "memory");
        }
      }
      G8_WAIT_L(8); G8_BAR; G8_WAIT_L(0); G8_MMA(0, 0, At, B0); G8_BAR; G8_SCHED;
      G8_LDB(B1, 0, 1); G8_STAGE(G8_SB(0, 0), b2, voffB);
      G8_BAR; G8_WAIT_L(0); G8_MMA(0, 1, At, B1); G8_BAR;
      G8_LDA(At, 0, 1); G8_STAGE(G8_SA(0, 0), a2, voffA[0]);
      G8_BAR; G8_WAIT_L(0); G8_MMA(1, 0, At, B0); G8_BAR; G8_SCHED;
      G8_STAGE(G8_SB(0, 1), b2 + hstep, voffB);
      G8_WAIT_V(6); G8_BAR; G8_MMA(1, 1, At, B1); G8_BAR;
      G8_LDB(B0, 1, 0); G8_SCHED; G8_LDA(At, 1, 0); G8_STAGE(G8_SA(0, 1), a2, voffA[1]);
      G8_WAIT_L(8); G8_BAR; G8_WAIT_L(0); G8_MMA(0, 0, At, B0); G8_BAR; G8_SCHED;
      G8_LDB(B1, 1, 1); G8_STAGE(G8_SB(1, 0), b3, voffB);
      G8_BAR; G8_WAIT_L(0); G8_MMA(0, 1, At, B1); G8_BAR;
      G8_LDA(At, 1, 1); G8_STAGE(G8_SA(1, 0), a3, voffA[0]);
      G8_BAR; G8_WAIT_L(0); G8_MMA(1, 0, At, B0); G8_BAR; G8_SCHED;
      G8_STAGE(G8_SB(1, 1), b3 + hstep, voffB);
      G8_WAIT_V(6); G8_BAR; G8_MMA(1, 1, At, B1); G8_BAR;
    }
    epilogue<MODE>(p, acc, cur, wr, wc, fr, fq);
    if (!has_next) break;
#pragma unroll
    for (int a = 0; a < 2; ++a)
#pragma unroll
      for (int b = 0; b < 2; ++b)
#pragma unroll
        for (int m = 0; m < 4; ++m)
#pragma unroll
          for (int n = 0; n < 2; ++n) acc[a][b][m][n] = (f32x4){0.f, 0.f, 0.f, 0.f};
    cur = nxt; cA = nA; cB = nB; ++ui;
  }
  G8_WAIT_V(0);
  if (wr == 0) G8_BAR;
  G8_BAR;
#undef G8_GETU
#undef G8_VOFFA
#undef G8_SA
#undef G8_SB
#undef G8_STAGE
#undef G8_LDA
#undef G8_LDB
#undef G8_MMA
#undef G8_WAIT_V
#undef G8_WAIT_L
#undef G8_BAR
#undef G8_SCHED
}
}

DI float rope_apply(float v, float c, float s, int lane) {
  float o = xor32f(v, lane);
  return (lane < 32) ? (v * c - o * s) : (v * c + o * s);
}
DI void phase_post1(const Params& p, char* smem) {
  const int tid = otid(p), lane = tid & 63, wave = tid >> 6;
  const float* P = (const float*)(p.ws + OFF_P);
  const float* rope = (const float*)(p.ws + OFF_ROPE);
  unsigned short* Qb = (unsigned short*)(p.ws + OFF_QB);
  unsigned short* QI = (unsigned short*)(p.ws + OFF_QI);
  unsigned short* KI = (unsigned short*)(p.ws + OFF_KI);
  unsigned short* CKV = (unsigned short*)(p.ws + OFF_CKV);
  float* WI = (float*)(p.ws + OFF_WI);
  float* Qd = (float*)(p.ws + OFF_QD);
  float* Kd = (float*)(p.ws + OFF_KD);
  float* Vd = (float*)(p.ws + OFF_VD);
  float* BETA = (float*)(p.ws + OFF_BETA);
  float* G = (float*)(p.ws + OFF_G);
  float* cw = (float*)smem;
  __syncthreads();
  for (int idx = tid; idx < 4 * 1536; idx += NTHREADS) cw[idx] = p.conv_w[idx];
  __syncthreads();
  const float qw = p.q_norm_w[lane];
  const float4 kvw = *(const float4*)(p.kv_norm_w + lane * 4);
  constexpr int PG = 4;
  for (int g = blockIdx.x * NWAVES + wave; g < NT / PG; g += gridDim.x * NWAVES) {
    const int tok0 = g * PG, b = tok0 / T, t0 = tok0 - b * T;
#pragma unroll 1
    for (int tt = 0; tt < PG; ++tt) {
      const int tok = tok0 + tt, t = t0 + tt;
      const float* row = P + (size_t)tok * INC;
      float qv[8], iv[8];
#pragma unroll
      for (int hh = 0; hh < 8; ++hh) { qv[hh] = row[C_AQ + hh * 64 + lane]; iv[hh] = row[C_IQ + hh * 64 + lane]; }
      const float4 ckv = *(const float4*)(row + C_CKV + lane * 4);
      const float ikv = row[C_IK + lane];
      const float tailv = row[(lane < 8) ? (C_IW + lane) : (C_BBETA + ((lane - 8) & 7))];
      const float cs = rope[t * 64 + (lane & 31)], sn = rope[t * 64 + 32 + (lane & 31)];
      unsigned short* qb = Qb + (size_t)tok * 512 + lane;
      unsigned short* qi = QI + (size_t)tok * 512 + lane;
#pragma unroll
      for (int hh = 0; hh < 8; ++hh) {
        float v = qv[hh];
        const float ss = wave_sum(v * v);
        v = v * rsqrtf(ss * (1.f / 64.f) + 1e-6f) * qw;
        qb[hh * 64] = f2bf(rope_apply(v, cs, sn, lane));
        qi[hh * 64] = f2bf(rope_apply(iv[hh], cs, sn, lane));
      }
      {
        const float ss = wave_sum(ckv.x * ckv.x + ckv.y * ckv.y + ckv.z * ckv.z + ckv.w * ckv.w);
        const float rstd = rsqrtf(ss * (1.f / 256.f) + 1e-6f);
        uint2 o;
        o.x = pk2(ckv.x * rstd * kvw.x, ckv.y * rstd * kvw.y);
        o.y = pk2(ckv.z * rstd * kvw.z, ckv.w * rstd * kvw.w);
        *(uint2*)(CKV + (size_t)tok * 256 + lane * 4) = o;
      }
      KI[(size_t)tok * 64 + lane] = f2bf(rope_apply(ikv, cs, sn, lane));
      if (lane < 8) WI[(size_t)tok * 8 + lane] = tailv * 0.04419417382415922f;
      if (lane >= 8 && lane < 12) BETA[(size_t)tok * 4 + (lane - 8)] = 1.f / (1.f + expf(-tailv));
      if (lane >= 12 && lane < 16) {
        const float xx = tailv + p.dt_bias[lane - 12];
        const float sp = fmaxf(xx, 0.f) + log1pf(expf(-fabsf(xx)));
        G[(size_t)tok * 4 + (lane - 12)] = -expf(p.a_log[lane - 12]) * sp;
      }
    }
    float x0[24], x1[24], x2[24];
    {
      const float* base = P + (size_t)tok0 * INC + C_BQKV + lane;
#pragma unroll
      for (int i = 0; i < 24; ++i) {
        x0[i] = (t0 >= 3) ? base[64 * i - 3 * (ptrdiff_t)INC] : 0.f;
        x1[i] = (t0 >= 2) ? base[64 * i - 2 * (ptrdiff_t)INC] : 0.f;
        x2[i] = (t0 >= 1) ? base[64 * i - 1 * (ptrdiff_t)INC] : 0.f;
      }
    }
#pragma unroll 1
    for (int tt = 0; tt < PG; ++tt) {
      const int tok = tok0 + tt;
      const float* xr = P + (size_t)tok * INC + C_BQKV + lane;
      float x3[24];
#pragma unroll
      for (int i = 0; i < 24; ++i) x3[i] = xr[64 * i];
      int cl = lane;
      asm volatile("" : "+v"(cl));
      float* qd = Qd + (size_t)tok * 512 + lane;
      float* kd = Kd + (size_t)tok * 512 + lane;
      float* vd = Vd + (size_t)tok * 512 + lane;
#pragma unroll
      for (int hd = 0; hd < 4; ++hd) {
        float cv[6];
#pragma unroll
        for (int q = 0; q < 6; ++q) {
          const int i = (q >> 1) * 8 + 2 * hd + (q & 1);
          const int c = cl + 64 * i;
          const float a = cw[c] * x0[i] + cw[1536 + c] * x1[i] + cw[2 * 1536 + c] * x2[i] + cw[3 * 1536 + c] * x3[i];
          cv[q] = a / (1.f + __expf(-a));
          x0[i] = x1[i]; x1[i] = x2[i]; x2[i] = x3[i];
        }
        float ss = wave_sum(cv[0] * cv[0] + cv[1] * cv[1]);
        float r = rsqrtf(ss + 1e-6f);
        qd[hd * 128] = cv[0] * r;
        qd[hd * 128 + 64] = cv[1] * r;
        ss = wave_sum(cv[2] * cv[2] + cv[3] * cv[3]);
        r = rsqrtf(ss + 1e-6f);
        kd[hd * 128] = cv[2] * r;
        kd[hd * 128 + 64] = cv[3] * r;
        vd[hd * 128] = cv[4];
        vd[hd * 128 + 64] = cv[5];
      }
    }
  }
}

DI void phase_post2(const Params& p, char* smem) {
  (void)smem;
  const int tid = otid(p), lane = tid & 63, wave = tid >> 6;
  const float* KV = (const float*)(p.ws + OFF_KV);
  const float* rope = (const float*)(p.ws + OFF_ROPE);
  unsigned short* Kb = (unsigned short*)(p.ws + OFF_KB);
  unsigned short* Vb = (unsigned short*)(p.ws + OFF_VT);
  const float kw = p.k_norm_w[lane];
  for (int tok = blockIdx.x * NWAVES + wave; tok < NT; tok += gridDim.x * NWAVES) {
    const int b = tok / T, t = tok - b * T;
    const float* row = KV + (size_t)tok * 1024;
    float kv[8], vv[8];
#pragma unroll
    for (int hh = 0; hh < 8; ++hh) { kv[hh] = row[hh * 64 + lane]; vv[hh] = row[512 + hh * 64 + lane]; }
    const float cs = rope[t * 64 + (lane & 31)], sn = rope[t * 64 + 32 + (lane & 31)];
    unsigned short* kb = Kb + (size_t)tok * 512 + lane;
    unsigned short* vb = Vb + (size_t)tok * 512 + lane;
#pragma unroll
    for (int hh = 0; hh < 8; ++hh) {
      float v = kv[hh];
      const float ss = wave_sum(v * v);
      v = v * rsqrtf(ss * (1.f / 64.f) + 1e-6f) * kw;
      kb[hh * 64] = f2bf(rope_apply(v, cs, sn, lane));
      vb[hh * 64] = f2bf(vv[hh]);
    }
  }
}

constexpr int KS_STRIDE = 129, AM_STRIDE = 65;
DI void phase_chunkprep(const Params& p, char* smem) {
  float* Ks = (float*)smem;
  float* Qs = Ks + 64 * KS_STRIDE;
  float* Am = Qs + 64 * KS_STRIDE;
  float* Tm = Am + 64 * AM_STRIDE;
  float* gc = Tm + 64 * AM_STRIDE;
  float* bet = gc + 64;
  float* gl = bet + 64;
  unsigned short* T16 = (unsigned short*)(gl + 64);
  float* Mt = (float*)T16;
  unsigned short* VbT = T16 + 64 * 72;
  unsigned short* KbT = (unsigned short*)Qs;
  static_assert((64 * KS_STRIDE * 2 + 64 * AM_STRIDE * 2 + 192) * 4 + (64 * 72 + 128 * 72) * 2 <= 131072, "chunk prep LDS");
  const int tid = otid(p), lane = tid & 63, wave = tid >> 6;
  const float* Qd = (const float*)(p.ws + OFF_QD);
  const float* Kd = (const float*)(p.ws + OFF_KD);
  const float* Vd = (const float*)(p.ws + OFF_VD);
  const float* BETA = (const float*)(p.ws + OFF_BETA);
  const float* G = (const float*)(p.ws + OFF_G);
  unsigned short* CHB = (unsigned short*)(p.ws + OFF_WN);
  float* UU = (float*)(p.ws + OFF_UU);
  float* DL = (float*)(p.ws + OFF_DL);
  for (int ci = blockIdx.x; ci < NCHT; ci += gridDim.x) {
    unsigned short* chb = CHB + (size_t)ci * CHB_ELEMS;
    const int bh = ci / NCH, c = ci - bh * NCH, b = bh >> 2, h = bh & 3;
    __syncthreads();
    if (tid < 64) {
      int t = c * 64 + tid - 48;
      float g = 0.f, be = 0.f;
      if (t >= 0) { g = G[(size_t)(b * T + t) * 4 + h]; be = BETA[(size_t)(b * T + t) * 4 + h]; }
      gl[tid] = g;
      bet[tid] = be;
    }
    float vreg[16];
#pragma unroll
    for (int it = 0; it < 16; ++it) {
      const int idx = tid + it * NTHREADS, i = idx >> 7, d = idx & 127;
      const int t = c * 64 + i - 48;
      float kv = 0.f, qv = 0.f, vv = 0.f;
      if (t >= 0) {
        const size_t o = ((size_t)(b * T + t)) * 512 + h * 128 + d;
        kv = Kd[o];
        qv = Qd[o] * 0.08838834764831845f;
        vv = Vd[o];
      }
      Ks[i * KS_STRIDE + d] = kv;
      Qs[i * KS_STRIDE + d] = qv;
      vreg[it] = vv;
    }
    __syncthreads();
    if (tid < 64) {
      float s2 = 0.f;
      for (int j = 0; j <= tid; ++j) s2 += gl[j];
      gc[tid] = s2;
    }
    __syncthreads();
    {
      const int i = tid >> 3, jb = tid & 7;
      float akk[8], aqk[8];
#pragma unroll
      for (int jj = 0; jj < 8; ++jj) { akk[jj] = 0.f; aqk[jj] = 0.f; }
      for (int d = 0; d < 128; ++d) {
        float ki = Ks[i * KS_STRIDE + d], qi = Qs[i * KS_STRIDE + d];
#pragma unroll
        for (int jj = 0; jj < 8; ++jj) {
          float kj = Ks[(jb + 8 * jj) * KS_STRIDE + d];
          akk[jj] += ki * kj;
          aqk[jj] += qi * kj;
        }
      }
      const float gi = gc[i], bi = bet[i];
#pragma unroll
      for (int jj = 0; jj < 8; ++jj) {
        int j = jb + 8 * jj;
        float dec = (j <= i) ? __expf(gi - gc[j]) : 0.f;
        Am[i * AM_STRIDE + j] = (j < i) ? bi * akk[jj] * dec : 0.f;
        chb[CH_IN + swzB(i, j)] = f2bf((j <= i) ? aqk[jj] * dec : 0.f);
      }
    }
    for (int idx = tid; idx < 64 * 128; idx += NTHREADS) {
      int i = idx >> 7, d = idx & 127;
      chb[CH_QG + swzA(i, d)] = f2bf(Qs[i * KS_STRIDE + d] * __expf(gc[i]));
    }
    __syncthreads();
#pragma unroll
    for (int it = 0; it < 16; ++it) {
      const int idx = tid + it * NTHREADS, i = idx >> 7, d = idx & 127;
      const float bi = bet[i];
      VbT[d * 72 + i] = f2bf(bi * vreg[it]);
      KbT[d * 72 + i] = f2bf(bi * __expf(gc[i]) * Ks[i * KS_STRIDE + d]);
    }
    {
      for (int idx = tid; idx < 64 * 64; idx += NTHREADS) Tm[(idx >> 6) * AM_STRIDE + (idx & 63)] = 0.f;
      __syncthreads();
      if (tid < 64) {
        const int bb = tid >> 4, cc = tid & 15, o = 16 * bb;
        float x[16];
#pragma unroll
        for (int i = 0; i < 16; ++i) {
          float a = (i == cc) ? 1.f : 0.f;
#pragma unroll
          for (int j = 0; j < 16; ++j)
            if (j < i) a -= Am[(o + i) * AM_STRIDE + o + j] * x[j];
          x[i] = a;
          Tm[(o + i) * AM_STRIDE + o + cc] = a;
        }
      }
      __syncthreads();
      {
        const int B = tid >> 8, i = (tid >> 4) & 15, j = tid & 15, o = 32 * B;
        float m = 0.f;
#pragma unroll
        for (int k = 0; k < 16; ++k) m += Am[(o + 16 + i) * AM_STRIDE + o + k] * Tm[(o + k) * AM_STRIDE + o + j];
        Mt[(B * 16 + i) * 33 + j] = m;
        __syncthreads();
        float t = 0.f;
#pragma unroll
        for (int k = 0; k < 16; ++k) t += Tm[(o + 16 + i) * AM_STRIDE + o + 16 + k] * Mt[(B * 16 + k) * 33 + j];
        __syncthreads();
        Tm[(o + 16 + i) * AM_STRIDE + o + j] = -t;
      }
      __syncthreads();
      {
        const int i = tid >> 4, j0 = (tid & 15) * 2;
        float m0 = 0.f, m1 = 0.f;
        for (int k = 0; k < 32; ++k) {
          const float a = Am[(32 + i) * AM_STRIDE + k];
          m0 += a * Tm[k * AM_STRIDE + j0];
          m1 += a * Tm[k * AM_STRIDE + j0 + 1];
        }
        Mt[i * 33 + j0] = m0;
        Mt[i * 33 + j0 + 1] = m1;
        __syncthreads();
        float t0 = 0.f, t1 = 0.f;
        for (int k = 0; k < 32; ++k) {
          const float a = Tm[(32 + i) * AM_STRIDE + 32 + k];
          t0 += a * Mt[k * 33 + j0];
          t1 += a * Mt[k * 33 + j0 + 1];
        }
        __syncthreads();
        Tm[(32 + i) * AM_STRIDE + j0] = -t0;
        Tm[(32 + i) * AM_STRIDE + j0 + 1] = -t1;
      }
    }
    __syncthreads();
    for (int idx = tid; idx < 64 * 64; idx += NTHREADS) T16[(idx >> 6) * 72 + (idx & 63)] = f2bf(Tm[(idx >> 6) * AM_STRIDE + (idx & 63)]);
    __syncthreads();
    {
      const int mat = wave >> 2, nt = wave & 3, lr = lane & 31, lh = lane >> 5;
      const unsigned short* Bt = mat ? KbT : VbT;
#pragma unroll
      for (int mt = 0; mt < 2; ++mt) {
        f32x16 acc;
#pragma unroll
        for (int r = 0; r < 16; ++r) acc[r] = 0.f;
#pragma unroll
        for (int ks = 0; ks < 4; ++ks) {
          const bf16x8 af = ld16(T16 + (mt * 32 + lr) * 72 + ks * 16 + 8 * lh);
          const bf16x8 bfr = ld16(Bt + (nt * 32 + lr) * 72 + ks * 16 + 8 * lh);
          acc = MFMA32(af, bfr, acc);
        }
        if (mat == 0) {
          float* up = UU + (size_t)ci * 8192 + (((nt * 2 + mt) * 2 + lh) * 32 + lr) * 16;
#pragma unroll
          for (int q = 0; q < 4; ++q) *(float4*)(up + 4 * q) = make_float4(acc[4 * q], acc[4 * q + 1], acc[4 * q + 2], acc[4 * q + 3]);
        } else {
#pragma unroll
          for (int r = 0; r < 16; ++r) chb[swzA(mt * 32 + crow(r, lh), nt * 32 + lr)] = f2bf(-acc[r]);
        }
      }
    }
    const float glast = gc[63];
    for (int idx = tid; idx < 64 * 128; idx += NTHREADS) {
      int i = idx & 63, d = idx >> 6;
      chb[CH_KDT + swzB(d, i)] = f2bf(Ks[i * KS_STRIDE + d] * __expf(glast - gc[i]));
    }
    if (tid == 0) DL[ci] = __expf(glast);
  }
}

DI unsigned ordkey(float f) {
  unsigned u = __float_as_uint(f);
  return (u & 0x80000000u) ? ~u : (u | 0x80000000u);
}
DI int half_sum(int v) {
  v += dppi<0xB1>(v); v += dppi<0x4E>(v); v += dppi<0x141>(v); v += dppi<0x140>(v);
  const int lo = __builtin_amdgcn_readlane(v, 0) + __builtin_amdgcn_readlane(v, 16);
  const int hi = __builtin_amdgcn_readlane(v, 32) + __builtin_amdgcn_readlane(v, 48);
  return (__builtin_amdgcn_mbcnt_hi(~0u, __builtin_amdgcn_mbcnt_lo(~0u, 0u)) < 32u) ? lo : hi;
}
DI void indexer_task(const Params& p, int b, int q0, int lane) {
  unsigned* MASK = (unsigned*)(p.ws + OFF_MASK);
  const int qsel = lane >> 5;
  const int tq = q0 + qsel;
  unsigned* mrow = MASK + ((size_t)b * SEQ + tq) * 128;
  if (q0 + 1 < 256) {
    for (int i = (lane & 31); i < 128; i += 32) {
      int rem = tq + 1 - 32 * i;
      unsigned w = (rem >= 32) ? 0xffffffffu : (rem > 0 ? ((1u << rem) - 1u) : 0u);
      mrow[i] = w;
    }
    return;
  }
  const unsigned short* QI = (const unsigned short*)(p.ws + OFF_QI);
  const unsigned short* KI = (const unsigned short*)(p.ws + OFF_KI);
  const float* WI = (const float*)(p.ws + OFF_WI);
  const int l15 = lane & 15, lg = lane >> 4;
  const size_t qtok = (size_t)b * T + NM + q0 + (l15 >> 3);
  const bf16x8 a0 = ld16(QI + qtok * 512 + (l15 & 7) * 64 + 8 * lg);
  const bf16x8 a1 = ld16(QI + qtok * 512 + (l15 & 7) * 64 + 32 + 8 * lg);
  float w[4];
  {
    const size_t wtok = (size_t)b * T + NM + q0 + (lg >> 1);
#pragma unroll
    for (int r = 0; r < 4; ++r) w[r] = WI[wtok * 8 + 4 * (lg & 1) + r];
  }
  const int npairs = (q0 + 2 + 31) >> 5;
  const unsigned short* kp = KI + ((size_t)b * T + NM) * 64 + (size_t)l15 * 64 + 8 * lg;
  unsigned u[128];
  int rem = tq - (lane & 31);
  bf16x8 n0 = ld16(kp), n1 = ld16(kp + 32), n2 = ld16(kp + 1024), n3 = ld16(kp + 1024 + 32);
#pragma unroll
  for (int i = 0; i < 128; ++i) {
    unsigned uv = 0u;
    kp += 2048;
    asm volatile("" : "+v"(kp));
    if (i < npairs) {
      const bf16x8 c0 = n0, c1 = n1, c2 = n2, c3 = n3;
      if (i + 1 < npairs) { n0 = ld16(kp); n1 = ld16(kp + 32); n2 = ld16(kp + 1024); n3 = ld16(kp + 1024 + 32); }
      float tot[2];
      {
        f32x4 acc = {0.f, 0.f, 0.f, 0.f};
        acc = MFMA16(a0, c0, acc);
        acc = MFMA16(a1, c1, acc);
        float part = 0.f;
#pragma unroll
        for (int r = 0; r < 4; ++r) part += w[r] * fmaxf(acc[r], 0.f);
        tot[0] = part + xor16f(part, lane);
      }
      {
        f32x4 acc = {0.f, 0.f, 0.f, 0.f};
        acc = MFMA16(a0, c2, acc);
        acc = MFMA16(a1, c3, acc);
        float part = 0.f;
#pragma unroll
        for (int r = 0; r < 4; ++r) part += w[r] * fmaxf(acc[r], 0.f);
        tot[1] = part + xor16f(part, lane);
      }
      const float sc = (lg & 1) ? tot[1] : tot[0];
      uv = (rem >= 0) ? ordkey(sc) : 0u;
    }
    u[i] = uv;
    rem -= 32;
    asm volatile("" : "+v"(rem));
  }
  const int nblk = (npairs + 15) >> 4;
  unsigned thr = 0u;
  bool done = false;
  for (int bit = 31; bit >= 0; --bit) {
    const unsigned cand = thr | (1u << bit);
    int cnt = 0;
#pragma unroll
    for (int blk = 0; blk < 8; ++blk) {
      if (blk < nblk) {
#pragma unroll
        for (int j = 0; j < 16; ++j) cnt += (u[blk * 16 + j] >= cand) ? 1 : 0;
      }
    }
    cnt = half_sum(cnt);
    if (!done && cnt >= 256) thr = cand;
    done = done || (cnt == 256);
    if (__all(done)) break;
  }
  int cgt = 0;
#pragma unroll
  for (int blk = 0; blk < 8; ++blk) {
    if (blk < nblk) {
#pragma unroll
      for (int j = 0; j < 16; ++j) cgt += (u[blk * 16 + j] > thr) ? 1 : 0;
    }
  }
  cgt = half_sum(cgt);
  const int need = 256 - cgt;
  int base = 0;
  const unsigned lt_mask = (1u << (lane & 31)) - 1u;
#pragma unroll
  for (int blk = 0; blk < 8; ++blk) {
    if (blk < nblk) {
#pragma unroll
      for (int j = 0; j < 16; ++j) {
        const int i = blk * 16 + j;
        const bool eq = (u[i] == thr);
        const unsigned long long eb = __ballot(eq);
        const unsigned ehalf = qsel ? (unsigned)(eb >> 32) : (unsigned)eb;
        const int below = __popc(ehalf & lt_mask);
        const bool sel = (u[i] > thr) || (eq && (base + below < need));
        base += __popc(ehalf);
        const unsigned long long sb = __ballot(sel);
        const unsigned shalf = qsel ? (unsigned)(sb >> 32) : (unsigned)sb;
        if ((lane & 31) == 0) mrow[i] = shalf;
      }
    }
  }
}
DI void phase_indexer(const Params& p, char* smem) {
  const int tid = otid(p), lane = tid & 63, wave = tid >> 6;
  unsigned* ctr = (unsigned*)(p.ws + OFF_BAR + 15872 + 64);
  volatile LAS int* slot = (volatile LAS int*)((LAS unsigned char*)smem + g8::STAGE_BYTES + 800);
  const int ngroup = NB * (SEQ / 16);
  for (;;) {
    __syncthreads();
    if (tid == 0) *slot = (int)__hip_atomic_fetch_add(ctr, 1u, __ATOMIC_RELAXED, __HIP_MEMORY_SCOPE_AGENT);
    __syncthreads();
    const int g = __builtin_amdgcn_readfirstlane(*slot);
    if (g >= ngroup) break;
    const int b = g & 3, q8 = (SEQ / 16 - 1) - (g >> 2);
    indexer_task(p, b, (q8 * 8 + wave) * 2, lane);
  }
}

constexpr int AT_KROW = 72, AT_VROW = 96;
constexpr int AT_KBYTES = 32 * AT_KROW * 2, AT_STAGE = AT_KBYTES + 32 * AT_VROW * 2;
typedef short s16x4v __attribute__((ext_vector_type(4)));
typedef unsigned u32x4v __attribute__((ext_vector_type(4)));
DI void attn_block(const Params& p, char* smem, int b, int hh, int G) {
  const unsigned short* Qb = (const unsigned short*)(p.ws + OFF_QB);
  const unsigned short* Kb = (const unsigned short*)(p.ws + OFF_KB);
  const unsigned short* Vb = (const unsigned short*)(p.ws + OFF_VT);
  const unsigned* MASK = (const unsigned*)(p.ws + OFF_MASK);
  unsigned short* MIX = (unsigned short*)(p.ws + OFF_MIX);
  LAS unsigned char* lds = (LAS unsigned char*)smem;
  const int tid = otid(p), lane = tid & 63, wave = __builtin_amdgcn_readfirstlane(tid >> 6);
  const int lr = lane & 31, lh = lane >> 5;
  const int qt = 8 * G + wave;
  const int tq = qt * 32 + lr;
  const size_t qtok = (size_t)b * T + NM + tq;
  bf16x8 qf[4];
#pragma unroll
  for (int ks = 0; ks < 4; ++ks) qf[ks] = ld16(Qb + qtok * 512 + hh * 64 + ks * 16 + 8 * lh);
  const unsigned* mrow = MASK + ((size_t)b * SEQ + tq) * 128;
  const int which = tid >> 8, srow = (tid >> 3) & 31, sch = tid & 7;
  const unsigned short* gsrc = (which ? Vb : Kb) + ((size_t)b * T + srow) * 512 + hh * 64 + sch * 8;
  const unsigned sdst = which ? (unsigned)(AT_KBYTES + srow * (AT_VROW * 2) + sch * 16) : (unsigned)(srow * (AT_KROW * 2) + sch * 16);
  const int ntile = 8 * G + 9;
  const unsigned koff = (unsigned)(lr * (AT_KROW * 2) + 16 * lh);
  const unsigned voff = (unsigned)(AT_KBYTES + (4 * lh + ((lane & 15) >> 2)) * (AT_VROW * 2) + (16 * ((lane >> 4) & 1) + 4 * (lane & 3)) * 2);
  __syncthreads();
  {
    const u32x4v st0 = *(const u32x4v*)gsrc;
    *(LAS u32x4v*)(lds + sdst) = st0;
  }
  f32x16 o[2];
#pragma unroll
  for (int i = 0; i < 2; ++i)
#pragma unroll
    for (int r = 0; r < 16; ++r) o[i][r] = 0.f;
  float m = -1e30f, lsum = 0.f;
  const float scale = 0.125f;
  unsigned wnext = mrow[0];
  __syncthreads();
  for (int it = 0; it < ntile; ++it) {
    const int kt = it - 1;
    const bool has_next = it + 1 < ntile;
    u32x4v stg = {0u, 0u, 0u, 0u};
    if (has_next) stg = *(const u32x4v*)(gsrc + (size_t)(NM + 32 * (kt + 1)) * 512);
    if (kt <= qt) {
      const unsigned word = (kt < 0) ? 0x0000ffffu : wnext;
      if (kt >= 0 && kt < qt) wnext = mrow[kt + 1];
      const LAS unsigned char* sb = lds + (it & 1) * AT_STAGE;
      f32x16 s;
#pragma unroll
      for (int r = 0; r < 16; ++r) s[r] = 0.f;
#pragma unroll
      for (int ks = 0; ks < 4; ++ks) {
        const bf16x8 kf = *(const LAS bf16x8*)(sb + koff + ks * 32);
        s = MFMA32(kf, qf[ks], s);
      }
      float tmax = -1e30f;
#pragma unroll
      for (int r = 0; r < 16; ++r) {
        const bool valid = (word >> crow(r, lh)) & 1u;
        s[r] = valid ? s[r] * scale : -1e30f;
        tmax = fmaxf(tmax, s[r]);
      }
      tmax = fmaxf(tmax, xor32f(tmax, lane));
      const float mnew = fmaxf(m, tmax);
      const float alpha = __expf(m - mnew);
      float psum = 0.f;
#pragma unroll
      for (int r = 0; r < 16; ++r) {
        const bool valid = (word >> crow(r, lh)) & 1u;
        const float pv = valid ? __expf(s[r] - mnew) : 0.f;
        s[r] = pv;
        psum += pv;
      }
      psum += xor32f(psum, lane);
      lsum = lsum * alpha + psum;
      m = mnew;
#pragma unroll
      for (int i = 0; i < 2; ++i)
#pragma unroll
        for (int r = 0; r < 16; ++r) o[i][r] *= alpha;
#pragma unroll
      for (int ss = 0; ss < 2; ++ss) {
        const bf16x8 pf = pack8(s, ss);
#pragma unroll
        for (int dt = 0; dt < 2; ++dt) {
          const LAS unsigned char* vp = sb + voff + (16 * ss) * (AT_VROW * 2) + dt * 64;
          const s16x4v lo = __builtin_amdgcn_ds_read_tr16_b64_v4i16((LAS s16x4v*)vp);
          const s16x4v hi = __builtin_amdgcn_ds_read_tr16_b64_v4i16((LAS s16x4v*)(vp + 8 * (AT_VROW * 2)));
          const bf16x8 vf = __builtin_shufflevector(lo, hi, 0, 1, 2, 3, 4, 5, 6, 7);
          o[dt] = MFMA32(vf, pf, o[dt]);
        }
      }
    }
    if (has_next) *(LAS u32x4v*)(lds + ((it + 1) & 1) * AT_STAGE + sdst) = stg;
    __syncthreads();
  }
  const float inv = 1.f / lsum;
#pragma unroll
  for (int dt = 0; dt < 2; ++dt)
#pragma unroll
    for (int r = 0; r < 16; ++r) MIX[qtok * 1024 + hh * 64 + dt * 32 + crow(r, lh)] = f2bf(o[dt][r] * inv);
}
DI void attn_worker(const Params& p, char* smem) {
  unsigned* ctr = (unsigned*)(p.ws + OFF_BAR + 15872);
  volatile LAS int* slot = (volatile LAS int*)((LAS unsigned char*)smem + g8::STAGE_BYTES + 800);
  const int tid = otid(p);
  for (;;) {
    __syncthreads();
    if (tid == 0) *slot = (int)__hip_atomic_fetch_add(ctr, 1u, __ATOMIC_RELAXED, __HIP_MEMORY_SCOPE_AGENT);
    __syncthreads();
    const int k = __builtin_amdgcn_readfirstlane(*slot);
    if (k >= NB * 8 * 16) break;
    const int bh = k & 31, G = 15 - (k >> 5);
    attn_block(p, smem, bh >> 3, bh & 7, G);
  }
}

DI bf16x8 lds8x2(const LAS unsigned short* p0, const LAS unsigned short* p1) {
  typedef unsigned u32x2_t __attribute__((ext_vector_type(2)));
  typedef unsigned u32x4_t __attribute__((ext_vector_type(4)));
  const u32x2_t a = *(const LAS u32x2_t*)p0, b = *(const LAS u32x2_t*)p1;
  const u32x4_t r = {a[0], a[1], b[0], b[1]};
  return __builtin_bit_cast(bf16x8, r);
}
DI void scan_block(const Params& p, char* smem, int bh, const int c0, const int c1) {
  const int tid = otid(p), lane = tid & 63, wave = __builtin_amdgcn_readfirstlane(tid >> 6);
  const int b = bh >> 2, h = bh & 3;
  LAS unsigned char* lds = (LAS unsigned char*)smem;
  const unsigned short* CHB = (const unsigned short*)(p.ws + OFF_WN) + (size_t)bh * NCH * CHB_ELEMS;
  const float* UU = (const float*)(p.ws + OFF_UU) + (size_t)bh * NCH * 8192;
  const float* DL = (const float*)(p.ws + OFF_DL) + (size_t)bh * NCH;
  float* OD = (float*)(p.ws + OFF_OD);
  constexpr int CHB_BYTES = CHB_ELEMS * 2;
  __syncthreads();
  if (wave >= 4) {
    const int w4 = wave - 4;
    for (int c = c0; c <= c1; ++c) {
      if (c < c1) {
        const char* src = (const char*)(CHB + (size_t)c * CHB_ELEMS) + (size_t)(w4 * 15) * 1024 + lane * 16;
        const unsigned dst = (unsigned)((c & 1) * CHB_BYTES + (w4 * 15) * 1024);
#pragma unroll
        for (int j = 0; j < 15; ++j)
          __builtin_amdgcn_global_load_lds((const unsigned*)(src + j * 1024), (LAS unsigned*)(lds + dst + j * 1024), 16, 0, 0);
      }
      asm volatile("s_waitcnt vmcnt(0)" ::: "memory");
      __builtin_amdgcn_s_barrier();
    }
  } else {
    const int sl = wave, lr = lane & 31, lh = lane >> 5, e0 = sl * 32;
    f32x16 S[4];
    float* sst = (float*)(p.ws + OFF_SST) + ((size_t)(bh * 4 + sl) * 64 + lane) * 64;
#pragma unroll
    for (int i = 0; i < 4; ++i)
#pragma unroll
      for (int q = 0; q < 4; ++q) {
        float4 v = make_float4(0.f, 0.f, 0.f, 0.f);
        if (c0 > 0) v = *(const float4*)(sst + i * 16 + q * 4);
        S[i][4 * q] = v.x; S[i][4 * q + 1] = v.y; S[i][4 * q + 2] = v.z; S[i][4 * q + 3] = v.w;
      }
    f32x16 un[2];
    const float* up0 = UU + (size_t)c0 * 8192 + ((size_t)(sl * 2) * 2 + lh) * 512 + lr * 16;
#pragma unroll
    for (int pt = 0; pt < 2; ++pt)
#pragma unroll
      for (int q = 0; q < 4; ++q) {
        const float4 v = *(const float4*)(up0 + pt * 1024 + q * 4);
        un[pt][4 * q] = v.x; un[pt][4 * q + 1] = v.y; un[pt][4 * q + 2] = v.z; un[pt][4 * q + 3] = v.w;
      }
    const int oA = lr * 132 + 4 * lh;
    const int oB = lr * 68 + 4 * lh;
    __builtin_amdgcn_s_barrier();
    for (int c = c0; c < c1; ++c) {
      const LAS unsigned short* cb = (const LAS unsigned short*)(lds + (c & 1) * CHB_BYTES);
      f32x16 vn[2];
      vn[0] = un[0];
      vn[1] = un[1];
#pragma unroll
      for (int pt = 0; pt < 2; ++pt) {
#pragma unroll
        for (int mt = 0; mt < 4; ++mt)
#pragma unroll
          for (int s2 = 0; s2 < 2; ++s2) {
            const LAS unsigned short* ap = cb + oA + pt * 32 * 132 + mt * 32 + 16 * s2;
            vn[pt] = MFMA32(lds8x2(ap, ap + 8), pack8(S[mt], s2), vn[pt]);
          }
      }
      bf16x8 vb[2][2];
#pragma unroll
      for (int pt = 0; pt < 2; ++pt)
#pragma unroll
        for (int s2 = 0; s2 < 2; ++s2) vb[pt][s2] = pack8(vn[pt], s2);
#pragma unroll
      for (int pt = 0; pt < 2; ++pt) {
        f32x16 o;
#pragma unroll
        for (int r = 0; r < 16; ++r) o[r] = 0.f;
#pragma unroll
        for (int mt = 0; mt < 4; ++mt)
#pragma unroll
          for (int s2 = 0; s2 < 2; ++s2) {
            const LAS unsigned short* ap = cb + CH_QG + oA + pt * 32 * 132 + mt * 32 + 16 * s2;
            o = MFMA32(lds8x2(ap, ap + 8), pack8(S[mt], s2), o);
          }
#pragma unroll
        for (int pt2 = 0; pt2 <= pt; ++pt2)
#pragma unroll
          for (int s2 = 0; s2 < 2; ++s2) {
            const LAS unsigned short* ap = cb + CH_IN + oB + pt * 32 * 68 + pt2 * 32 + 16 * s2;
            o = MFMA32(lds8x2(ap, ap + 8), vb[pt2][s2], o);
          }
#pragma unroll
        for (int r = 0; r < 16; ++r) {
          const int t = c * 64 + pt * 32 + crow(r, lh) - 48;
          if (t >= 0) OD[((size_t)(b * T + t)) * 512 + h * 128 + e0 + lr] = o[r];
        }
      }
      if (c + 1 < c1) {
        const float* up = up0 + (size_t)(c + 1 - c0) * 8192;
#pragma unroll
        for (int pt = 0; pt < 2; ++pt)
#pragma unroll
          for (int q = 0; q < 4; ++q) {
            const float4 v = *(const float4*)(up + pt * 1024 + q * 4);
            un[pt][4 * q] = v.x; un[pt][4 * q + 1] = v.y; un[pt][4 * q + 2] = v.z; un[pt][4 * q + 3] = v.w;
          }
      }
      const float dl = DL[c];
#pragma unroll
      for (int mt = 0; mt < 4; ++mt) {
#pragma unroll
        for (int r = 0; r < 16; ++r) S[mt][r] *= dl;
#pragma unroll
        for (int pt2 = 0; pt2 < 2; ++pt2)
#pragma unroll
          for (int s2 = 0; s2 < 2; ++s2) {
            const LAS unsigned short* ap = cb + CH_KDT + oB + mt * 32 * 68 + pt2 * 32 + 16 * s2;
            S[mt] = MFMA32(lds8x2(ap, ap + 8), vb[pt2][s2], S[mt]);
          }
      }
      asm volatile("s_waitcnt lgkmcnt(0)" ::: "memory");
      __builtin_amdgcn_s_barrier();
    }
    if (c1 < NCH) {
#pragma unroll
      for (int i = 0; i < 4; ++i)
#pragma unroll
        for (int q = 0; q < 4; ++q) *(float4*)(sst + i * 16 + q * 4) = make_float4(S[i][4 * q], S[i][4 * q + 1], S[i][4 * q + 2], S[i][4 * q + 3]);
    }
  }
  __syncthreads();
}
DI void phase_scan_attn(const Params& p, char* smem) {
  if (blockIdx.x < 16) scan_block(p, smem, blockIdx.x, 33, NCH);
  attn_worker(p, smem);
}

DI void phase_gnorm(const Params& p) {
  const int tid = otid(p), lane = tid & 63, wave = tid >> 6;
  const float* OD = (const float*)(p.ws + OFF_OD);
  const float* P = (const float*)(p.ws + OFF_P);
  unsigned short* MIX = (unsigned short*)(p.ws + OFF_MIX);
  for (int r = blockIdx.x * NWAVES + wave; r < NR; r += gridDim.x * NWAVES) {
    const int tok = r + 16 * (r / SEQ + 1);
#pragma unroll
    for (int hd = 0; hd < 4; ++hd) {
      float o0 = OD[(size_t)tok * 512 + hd * 128 + lane], o1 = OD[(size_t)tok * 512 + hd * 128 + 64 + lane];
      float ss = wave_sum(o0 * o0 + o1 * o1);
      float rstd = rsqrtf(ss * (1.f / 128.f) + 1e-6f);
      float z0 = P[(size_t)tok * INC + C_BZ + hd * 128 + lane], z1 = P[(size_t)tok * INC + C_BZ + hd * 128 + 64 + lane];
      float y0 = o0 * rstd * p.delta_norm_w[lane] * (z0 / (1.f + __expf(-z0)));
      float y1 = o1 * rstd * p.delta_norm_w[64 + lane] * (z1 / (1.f + __expf(-z1)));
      MIX[(size_t)tok * 1024 + 512 + hd * 128 + lane] = f2bf(y0);
      MIX[(size_t)tok * 1024 + 512 + hd * 128 + 64 + lane] = f2bf(y1);
    }
  }
}

DI void phase_router(const Params& p, char* smem) {
  const int tid = otid(p), lane = tid & 63, wave = tid >> 6;
  float* part = (float*)smem;
  float* rstds = part + 8 * 32 * 33;
  int* lhist = (int*)(rstds + 32);
  int* lbase = lhist + 32;
  const float* H1 = (const float*)(p.ws + OFF_H1);
  const float* wrs = (const float*)(p.ws + OFF_WRS);
  unsigned short* U2 = (unsigned short*)(p.ws + OFF_U2);
  int* TOPE = (int*)(p.ws + OFF_TOPE);
  float* GATEV = (float*)(p.ws + OFF_GATEV);
  int* POS = (int*)(p.ws + OFF_POS);
  int* CNT = (int*)(p.ws + OFF_CNT);
  const int lr = lane & 31, lh = lane >> 5;
  float4 nw[4];
#pragma unroll
  for (int i = 0; i < 4; ++i) nw[i] = *(const float4*)(p.norm_ffn_w + lane * 4 + 256 * i);
  for (int task = blockIdx.x; task < NR / 32; task += gridDim.x) {
    const int r0 = task * 32;
    __syncthreads();
    if (tid < 32) lhist[tid] = 0;
    int lp0 = 0, lp1 = 0, lp2 = 0, lp3 = 0, xe0 = 0, xe1 = 0, xe2 = 0, xe3 = 0;
#pragma unroll
    for (int tt = 0; tt < 4; ++tt) {
      const int r = r0 + wave * 4 + tt;
      const float* src = H1 + (size_t)r * 1024;
      float4 v[4];
      float ss = 0.f;
#pragma unroll
      for (int i = 0; i < 4; ++i) {
        v[i] = *(const float4*)(src + lane * 4 + 256 * i);
        ss += v[i].x * v[i].x + v[i].y * v[i].y + v[i].z * v[i].z + v[i].w * v[i].w;
      }
      ss = wave_sum(ss);
      const float rstd = rsqrtf(ss * (1.f / 1024.f) + 1e-6f);
      if (lane == 0) rstds[wave * 4 + tt] = rstd;
#pragma unroll
      for (int i = 0; i < 4; ++i) {
        uint2 o;
        o.x = pk2(v[i].x * rstd * nw[i].x, v[i].y * rstd * nw[i].y);
        o.y = pk2(v[i].z * rstd * nw[i].z, v[i].w * rstd * nw[i].w);
        *(uint2*)(U2 + (size_t)r * 1024 + lane * 4 + 256 * i) = o;
      }
    }
    f32x16 acc;
#pragma unroll
    for (int i = 0; i < 16; ++i) acc[i] = 0.f;
    const float* arow = H1 + (size_t)(r0 + lr) * 1024 + wave * 128;
    const float* bcol = wrs + (size_t)(wave * 128 + lh) * 32 + lr;
#pragma unroll 8
    for (int k0 = 0; k0 < 128; k0 += 4) {
      const float4 a4 = *(const float4*)(arow + k0);
      const float b0 = bcol[(size_t)k0 * 32], b1 = bcol[(size_t)(k0 + 2) * 32];
      acc = __builtin_amdgcn_mfma_f32_32x32x2f32(lh ? a4.y : a4.x, b0, acc, 0, 0, 0);
      acc = __builtin_amdgcn_mfma_f32_32x32x2f32(lh ? a4.w : a4.z, b1, acc, 0, 0, 0);
    }
#pragma unroll
    for (int r = 0; r < 16; ++r) part[(wave * 32 + crow(r, lh)) * 33 + lr] = acc[r];
    __syncthreads();
    if (tid < 32) {
      const float myrstd = rstds[tid];
      float lv[32];
#pragma unroll
      for (int e = 0; e < 32; ++e) {
        float a = 0.f;
#pragma unroll
        for (int w = 0; w < 8; ++w) a += part[(w * 32 + tid) * 33 + e];
        lv[e] = a * myrstd + p.b_router[e];
      }
      float tv[4];
      int te[4];
#pragma unroll
      for (int k = 0; k < 4; ++k) {
        float bv = lv[0];
        int bi = 0;
#pragma unroll
        for (int e = 1; e < 32; ++e)
          if (lv[e] > bv) { bv = lv[e]; bi = e; }
        tv[k] = bv;
        te[k] = bi;
#pragma unroll
        for (int e = 0; e < 32; ++e)
          if (e == bi) lv[e] = -3.0e38f;
      }
      const float e1 = __expf(tv[1] - tv[0]), e2 = __expf(tv[2] - tv[0]), e3 = __expf(tv[3] - tv[0]);
      const float inv = 1.f / (1.f + e1 + e2 + e3);
      const size_t rr = (size_t)(r0 + tid) * 4;
      TOPE[rr + 0] = te[0]; TOPE[rr + 1] = te[1]; TOPE[rr + 2] = te[2]; TOPE[rr + 3] = te[3];
      GATEV[rr + 0] = inv; GATEV[rr + 1] = e1 * inv; GATEV[rr + 2] = e2 * inv; GATEV[rr + 3] = e3 * inv;
      lp0 = atomicAdd(&lhist[te[0]], 1); lp1 = atomicAdd(&lhist[te[1]], 1); lp2 = atomicAdd(&lhist[te[2]], 1); lp3 = atomicAdd(&lhist[te[3]], 1);
      xe0 = te[0]; xe1 = te[1]; xe2 = te[2]; xe3 = te[3];
    }
    __syncthreads();
    if (tid < 32) {
      const int c = lhist[tid];
      lbase[tid] = (c > 0) ? atomicAdd(&CNT[tid * CNTS], c) : 0;
    }
    __syncthreads();
    if (tid < 32) {
      const size_t rr = (size_t)(r0 + tid) * 4;
      POS[rr + 0] = lbase[xe0] + lp0; POS[rr + 1] = lbase[xe1] + lp1; POS[rr + 2] = lbase[xe2] + lp2; POS[rr + 3] = lbase[xe3] + lp3;
    }
  }
}
DI void phase_lists(const Params& p) {
  const int* CNT = (const int*)(p.ws + OFF_CNT);
  const int* TOPE = (const int*)(p.ws + OFF_TOPE);
  const float* GATEV = (const float*)(p.ws + OFF_GATEV);
  const int* POS = (const int*)(p.ws + OFF_POS);
  int* SLOT = (int*)(p.ws + OFF_SLOT);
  int* LTOK = (int*)(p.ws + OFF_LTOK);
  float* LGATE = (float*)(p.ws + OFF_LGATE);
  for (int a = blockIdx.x * NTHREADS + otid(p); a < NASG; a += gridDim.x * NTHREADS) {
    const int e = TOPE[a];
    int off = 0;
    for (int j = 0; j < e; ++j) off += CNT[j * CNTS];
    const int slot = off + POS[a];
    SLOT[a] = slot;
    LTOK[slot] = a >> 2;
    LGATE[slot] = GATEV[a];
  }
}
DI void phase_combine(const Params& p) {
  const float* H1 = (const float*)(p.ws + OFF_H1);
  const unsigned short* Y = (const unsigned short*)(p.ws + OFF_Y);
  const int* SLOT = (const int*)(p.ws + OFF_SLOT);
  for (int idx = blockIdx.x * NTHREADS + otid(p); idx < NR * 256; idx += gridDim.x * NTHREADS) {
    const int r = idx >> 8, c4 = (idx & 255) * 4;
    float4 a = *(const float4*)(H1 + (size_t)r * 1024 + c4);
#pragma unroll
    for (int k = 0; k < 4; ++k) {
      const int slot = SLOT[r * 4 + k];
      uint2 y = *(const uint2*)(Y + (size_t)slot * 1024 + c4);
      a.x += bf2f((unsigned short)(y.x & 0xffffu));
      a.y += bf2f((unsigned short)(y.x >> 16));
      a.z += bf2f((unsigned short)(y.y & 0xffffu));
      a.w += bf2f((unsigned short)(y.y >> 16));
    }
    *(float4*)(p.out + (size_t)r * 1024 + c4) = a;
  }
}


#define XB_TMO      128
#define XB_XCNT(j)  (256  + 64 * (j))
#define XB_XSUB(j)  (1280 + 64 * (j))
#define XB_XGEN(j)  (2304 + 64 * (j))
#define XB_TOP      3328
#define XB_TOPGEN   3392
#define XB_SPIN_CAP (1u << 22)
DI unsigned xb_ld(unsigned* p) { return __hip_atomic_load(p, __ATOMIC_RELAXED, __HIP_MEMORY_SCOPE_AGENT); }
DI unsigned xb_add(unsigned* p, unsigned v) { return __hip_atomic_fetch_add(p, v, __ATOMIC_RELAXED, __HIP_MEMORY_SCOPE_AGENT); }
DI unsigned xb_xcc_id() { return (unsigned)__builtin_amdgcn_s_getreg((3 << 11) | 20) & 0xFu; }
#define XB_SPIN(cond, bar) do { unsigned _sp = 0; while (cond) { __builtin_amdgcn_s_sleep(1); \
    if ((++_sp & 255u) == 0u) { if (xb_ld(&(bar)[XB_TMO])) break; if (_sp > XB_SPIN_CAP) { atomicAdd(&(bar)[XB_TMO], 1u); break; } } } } while (0)
struct XcdBarrier { unsigned* bar; unsigned x; volatile LAS unsigned* st; bool leader; };
DI void xcd_barrier_complete(unsigned* bar, unsigned x, unsigned& nloc, unsigned& nx) {
  const unsigned G = gridDim.x * gridDim.y * gridDim.z;
  unsigned sum, cnt, mine, sp = 0u;
  for (;;) {
    sum = 0u; cnt = 0u; mine = 0u;
#pragma unroll
    for (unsigned j = 0; j < 16; ++j) { const unsigned c = xb_ld(&bar[XB_XCNT(j)]); sum += c; cnt += (c > 0u) ? 1u : 0u; mine = (j == x) ? c : mine; }
    if (sum == G) break;
    __builtin_amdgcn_s_sleep(1);
    if ((++sp & 255u) == 0u) { if (xb_ld(&bar[XB_TMO])) break; if (sp > XB_SPIN_CAP) { atomicAdd(&bar[XB_TMO], 1u); break; } }
  }
  nloc = mine > 0u ? mine : 1u; nx = cnt > 0u ? cnt : 1u;
}
DI void xcd_barrier(const XcdBarrier& b) {
  asm volatile("s_waitcnt vmcnt(0)" ::: "memory");
  __syncthreads();
  if (b.leader) {
    unsigned* bar = b.bar;
    __builtin_amdgcn_s_waitcnt(0);
    unsigned nloc = b.st[0], nx = b.st[1];
    if (nloc == 0u) { xcd_barrier_complete(bar, b.x, nloc, nx); b.st[0] = nloc; b.st[1] = nx; }
    const unsigned old = xb_add(&bar[XB_XSUB(b.x)], 1u);
    const unsigned gen = old / nloc;
    if (old + 1u == (gen + 1u) * nloc) {
      __builtin_amdgcn_fence(__ATOMIC_RELEASE, "agent");
      asm volatile("s_waitcnt vmcnt(0)" ::: "memory");
      const unsigned og = xb_add(&bar[XB_TOP], 1u);
      const unsigned tg = og / nx;
      if (og + 1u == (tg + 1u) * nx) xb_add(&bar[XB_TOPGEN], 1u);
      else XB_SPIN(xb_ld(&bar[XB_TOPGEN]) == tg, bar);
      __builtin_amdgcn_fence(__ATOMIC_ACQUIRE, "agent");
      xb_add(&bar[XB_XGEN(b.x)], 1u);
      asm volatile("s_waitcnt vmcnt(0)" ::: "memory");
    } else {
      XB_SPIN(xb_ld(&bar[XB_XGEN(b.x)]) == gen, bar);
      __builtin_amdgcn_fence(__ATOMIC_ACQUIRE, "agent");
      asm volatile("s_waitcnt vmcnt(0)" ::: "memory");
    }
  }
  __syncthreads();
}

constexpr int SMEM_BYTES = g8::STAGE_BYTES + 1024;

__global__ void __launch_bounds__(NTHREADS) mk(Params p0) {
  __shared__ __attribute__((aligned(16))) char smem[SMEM_BYTES];
  Params p = p0;
  p.wv = __builtin_amdgcn_readfirstlane((int)(threadIdx.x >> 6));
  XcdBarrier xb;
  {
    volatile LAS unsigned* st = (volatile LAS unsigned*)((LAS unsigned char*)smem + g8::STAGE_BYTES + 768);
    if (threadIdx.x == 0) { st[0] = 0u; st[1] = 0u; }
    __syncthreads();
    xb.bar = (unsigned*)(p.ws + OFF_BAR); xb.x = xb_xcc_id(); xb.st = st; xb.leader = (threadIdx.x == 0);
    if (xb.leader) (void)xb_add(&xb.bar[XB_XCNT(xb.x)], 1u);
  }
  phase_prep(p);
  phase_wconv(p, 0, WC_SMALL);
  xcd_barrier(xb);
  g8::gemm_phase<0>(p, smem);
  wconv_fill(p, smem, 0, false);
  xcd_barrier(xb);
  phase_post1(p, smem);
  xcd_barrier(xb);
  g8::gemm_phase<1>(p, smem);
  phase_chunkprep(p, smem);
  wconv_fill(p, smem, 1, false);
  xcd_barrier(xb);
  if (blockIdx.x < 16) scan_block(p, smem, blockIdx.x, 0, 33);
  phase_post2(p, smem);
  phase_indexer(p, smem);
  wconv_fill(p, smem, 2, false);
  xcd_barrier(xb);
  phase_scan_attn(p, smem);
  wconv_fill(p, smem, 3, false);
  xcd_barrier(xb);
  phase_gnorm(p);
  xcd_barrier(xb);
  g8::gemm_phase<2>(p, smem);
  xcd_barrier(xb);
  phase_router(p, smem);
  xcd_barrier(xb);
  phase_lists(p);
  wconv_fill(p, smem, 4, true);
  xcd_barrier(xb);
  g8::gemm_phase<3>(p, smem);
  xcd_barrier(xb);
  g8::gemm_phase<4>(p, smem);
  xcd_barrier(xb);
  phase_combine(p);
}

extern "C" void kernel_launch(void* const* d_in, const int* in_sizes, int n_in, void* d_out, int out_size, void* d_ws,
                              size_t ws_size, hipStream_t stream) {
  (void)in_sizes; (void)n_in; (void)out_size;
  if (ws_size < WS_NEED) return;
  Params p{};
  p.x = (const float*)d_in[0]; p.meta = (const float*)d_in[1]; p.norm_mix_w = (const float*)d_in[2];
  p.w_in = (const float*)d_in[3]; p.q_norm_w = (const float*)d_in[4]; p.k_norm_w = (const float*)d_in[5];
  p.kv_norm_w = (const float*)d_in[6]; p.w_kv_up = (const float*)d_in[7]; p.conv_w = (const float*)d_in[8];
  p.a_log = (const float*)d_in[9]; p.dt_bias = (const float*)d_in[10]; p.delta_norm_w = (const float*)d_in[11];
  p.w_out = (const float*)d_in[12]; p.norm_ffn_w = (const float*)d_in[13]; p.w_router = (const float*)d_in[14];
  p.b_router = (const float*)d_in[15]; p.w_gate_up = (const float*)d_in[16]; p.b_gate_up = (const float*)d_in[17];
  p.w_down = (const float*)d_in[18]; p.b_down = (const float*)d_in[19];
  p.out = (float*)d_out;
  p.ws = (char*)d_ws;
  (void)hipMemsetAsync((char*)d_ws + OFF_CNT, 0, 4096, stream);
  (void)hipMemsetAsync((char*)d_ws + OFF_BAR, 0, 16384, stream);
  static int grid_blocks = 0;
  if (!grid_blocks) {
    int dev = 0, cus = 0, per_cu = 0;
    (void)hipGetDevice(&dev);
    (void)hipDeviceGetAttribute(&cus, hipDeviceAttributeMultiprocessorCount, dev);
    (void)hipOccupancyMaxActiveBlocksPerMultiprocessor(&per_cu, mk, NTHREADS, 0);
    if (per_cu > 1) per_cu = 1;
    grid_blocks = cus * per_cu;
  }
  void* args[] = {&p};
  hipError_t e = hipLaunchCooperativeKernel((void*)mk, dim3(grid_blocks), dim3(NTHREADS), args, 0, stream);
  if (e != hipSuccess) fprintf(stderr, "cooperative launch failed: %s (grid %d)\n", hipGetErrorString(e), grid_blocks);
}
```

```cpp
#include <hip/hip_runtime.h>
#include <stdint.h>
#include <stdio.h>


typedef __attribute__((ext_vector_type(8))) short bf16x8;
typedef __attribute__((ext_vector_type(4))) short s16x4;
typedef __attribute__((ext_vector_type(16))) float f32x16;
typedef __attribute__((ext_vector_type(4))) float f32x4;
typedef __bf16 bf2_t __attribute__((ext_vector_type(2)));
#define DI __device__ __forceinline__
#define MFMA32(a, b, c) __builtin_amdgcn_mfma_f32_32x32x16_bf16((a), (b), (c), 0, 0, 0)
#define MFMA16(a, b, c) __builtin_amdgcn_mfma_f32_16x16x32_bf16((a), (b), (c), 0, 0, 0)

constexpr int NB = 4, SEQ = 4096, NM = 16, T = 4112, NT = NB * T, NR = NB * SEQ, D = 1024, INC = 3408;
constexpr int C_AQ = 0, C_CKV = 512, C_IQ = 768, C_IK = 1280, C_IW = 1344, C_BQKV = 1352, C_BZ = 2888, C_BBETA = 3400, C_BA = 3404;
constexpr int NCH = 65, NCHT = NB * 4 * NCH;
constexpr int NEXP = 32, NASG = NR * 4;
constexpr int CNTS = 32;
constexpr int NTHREADS = 512, NWAVES = 8;

constexpr size_t al256(size_t x) { return (x + 255) & ~(size_t)255; }
constexpr size_t OFF_U = 0;
constexpr int NTP = 16640;
constexpr size_t OFF_P = OFF_U + al256((size_t)NTP * 1024 * 2);
constexpr size_t OFF_ROPE = OFF_P + al256((size_t)NT * INC * 4);
constexpr size_t OFF_QB = OFF_ROPE + al256((size_t)T * 64 * 4);
constexpr size_t OFF_KB = OFF_QB + al256((size_t)NT * 512 * 2);
constexpr size_t OFF_VT = OFF_KB + al256((size_t)NT * 512 * 2);
constexpr size_t OFF_QI = OFF_VT + al256((size_t)NT * 512 * 2);
constexpr size_t OFF_KI = OFF_QI + al256((size_t)NT * 512 * 2);
constexpr size_t OFF_WI = OFF_KI + al256((size_t)NT * 64 * 2);
constexpr size_t OFF_CKV = OFF_WI + al256((size_t)NT * 8 * 4);
constexpr size_t OFF_KV = OFF_CKV + al256((size_t)NTP * 256 * 2);
constexpr size_t OFF_MASK = OFF_KV + al256((size_t)NT * 1024 * 4);
constexpr size_t OFF_MIX = OFF_MASK + al256((size_t)NB * SEQ * 128 * 4);
constexpr size_t OFF_QD = OFF_MIX + al256((size_t)NT * 1024 * 2);
constexpr size_t OFF_KD = OFF_QD + al256((size_t)NT * 512 * 4);
constexpr size_t OFF_VD = OFF_KD + al256((size_t)NT * 512 * 4);
constexpr size_t OFF_BETA = OFF_VD + al256((size_t)NT * 512 * 4);
constexpr size_t OFF_G = OFF_BETA + al256((size_t)NT * 4 * 4);
constexpr int CHB_ELEMS = 30720, CH_QG = 8448, CH_KDT = 16896, CH_IN = 25600;
constexpr size_t OFF_WN = OFF_G + al256((size_t)NT * 4 * 4);
constexpr size_t OFF_UU = OFF_WN + al256((size_t)NCHT * CHB_ELEMS * 2);
constexpr size_t OFF_DL = OFF_UU + al256((size_t)NCHT * 64 * 128 * 4);
constexpr size_t OFF_OD = OFF_DL + al256((size_t)NCHT * 4);
constexpr size_t OFF_U2 = OFF_OD + al256((size_t)NT * 512 * 4);
constexpr size_t OFF_TOPE = OFF_U2 + al256((size_t)NR * 1024 * 2);
constexpr size_t OFF_GATEV = OFF_TOPE + al256((size_t)NR * 4 * 4);
constexpr size_t OFF_POS = OFF_GATEV + al256((size_t)NR * 4 * 4);
constexpr size_t OFF_SLOT = OFF_POS + al256((size_t)NR * 4 * 4);
constexpr size_t OFF_LTOK = OFF_SLOT + al256((size_t)NR * 4 * 4);
constexpr size_t OFF_LGATE = OFF_LTOK + al256((size_t)NASG * 4);
constexpr size_t OFF_WTIN = OFF_LGATE + al256((size_t)NASG * 4);
constexpr size_t OFF_WTKV = OFF_WTIN + al256((size_t)3584 * 1024 * 2);
constexpr size_t OFF_WTOUT = OFF_WTKV + al256((size_t)1024 * 256 * 2);
constexpr size_t OFF_WTGU = OFF_WTOUT + al256((size_t)1024 * 1024 * 2);
constexpr size_t OFF_WTDN = OFF_WTGU + al256((size_t)32 * 2048 * 1024 * 2);
constexpr size_t OFF_CNT = OFF_WTDN + al256((size_t)32 * 1024 * 1024 * 2);
constexpr size_t OFF_Y = OFF_QD;
static_assert(OFF_U2 - OFF_QD >= (size_t)NASG * 1024 * 2, "Y alias does not fit");
static_assert((size_t)(NASG + 256) * 1024 * 2 <= (size_t)NT * INC * 4, "HD alias does not fit");
constexpr size_t OFF_WRS = OFF_CNT + 4096;
constexpr size_t OFF_SST = OFF_WRS + 131072;
constexpr size_t OFF_BAR = OFF_SST + (size_t)16 * 4 * 64 * 64 * 4;
constexpr size_t WS_NEED = OFF_BAR + 16384;
constexpr size_t OFF_H1 = OFF_KV;
constexpr size_t OFF_HD = OFF_P;

struct Params {
  const float *x, *meta, *norm_mix_w, *w_in, *q_norm_w, *k_norm_w, *kv_norm_w, *w_kv_up, *conv_w, *a_log, *dt_bias,
      *delta_norm_w, *w_out, *norm_ffn_w, *w_router, *b_router, *w_gate_up, *b_gate_up, *w_down, *b_down;
  float* out;
  char* ws;
  int wv;
  int pad0;
};

#define LAS __attribute__((address_space(3)))
constexpr int STAGE_LDS_BYTES = 131072;
DI unsigned pk2(float a, float b) { bf2_t v; v[0] = (__bf16)a; v[1] = (__bf16)b; return __builtin_bit_cast(unsigned, v); }
DI unsigned short f2bf(float a) { return (unsigned short)(pk2(a, 0.f) & 0xffffu); }
DI float bf2f(unsigned short u) { return __uint_as_float(((unsigned)u) << 16); }
template <int CTRL> DI float dppf(float v) { return __builtin_bit_cast(float, __builtin_amdgcn_update_dpp(0, __builtin_bit_cast(int, v), CTRL, 0xf, 0xf, false)); }
template <int CTRL> DI int dppi(int v) { return __builtin_amdgcn_update_dpp(0, v, CTRL, 0xf, 0xf, false); }
DI float rlf(float v, int l) { return __builtin_bit_cast(float, __builtin_amdgcn_readlane(__builtin_bit_cast(int, v), l)); }
DI float wave_sum(float v) {
  v += dppf<0xB1>(v); v += dppf<0x4E>(v); v += dppf<0x141>(v); v += dppf<0x140>(v);
  return (rlf(v, 0) + rlf(v, 16)) + (rlf(v, 32) + rlf(v, 48));
}
DI float xor32f(float v, int lane) {
  auto r = __builtin_amdgcn_permlane32_swap(__builtin_bit_cast(unsigned, v), __builtin_bit_cast(unsigned, v), false, false);
  return __builtin_bit_cast(float, (lane < 32) ? r[1] : r[0]);
}
DI float xor16f(float v, int lane) {
  auto r = __builtin_amdgcn_permlane16_swap(__builtin_bit_cast(unsigned, v), __builtin_bit_cast(unsigned, v), false, false);
  return __builtin_bit_cast(float, (lane & 16) ? r[0] : r[1]);
}
DI int otid(const Params& p) {
  int l;
  asm volatile("v_mbcnt_lo_u32_b32 %0, -1, 0\n\tv_mbcnt_hi_u32_b32 %0, -1, %0" : "=v"(l));
  return (p.wv << 6) | l;
}
DI int swzA(int row, int col) { return row * 132 + col; }
DI int swzB(int row, int col) { return row * 68 + col; }
DI int crow(int reg, int h) { return (reg & 3) + 8 * (reg >> 2) + 4 * h; }
DI bf16x8 pack8(const f32x16& x, int s) {
  uint4 p;
  p.x = pk2(x[8 * s + 0], x[8 * s + 1]); p.y = pk2(x[8 * s + 2], x[8 * s + 3]);
  p.z = pk2(x[8 * s + 4], x[8 * s + 5]); p.w = pk2(x[8 * s + 6], x[8 * s + 7]);
  return __builtin_bit_cast(bf16x8, p);
}
DI bf16x8 ld8x2(const unsigned short* p0, const unsigned short* p1) {
  uint2 a = *(const uint2*)p0, b = *(const uint2*)p1;
  uint4 r = make_uint4(a.x, a.y, b.x, b.y);
  return __builtin_bit_cast(bf16x8, r);
}
DI bf16x8 ld16(const unsigned short* p) { uint4 r = *(const uint4*)p; return __builtin_bit_cast(bf16x8, r); }
DI const float* hrow(const Params& p, int tok) {
  int b = tok / T, t = tok - b * T;
  return (t < NM) ? (p.meta + (size_t)t * D) : (p.x + ((size_t)b * SEQ + (t - NM)) * D);
}

DI void phase_prep(const Params& p) {
  const int tid = otid(p), lane = tid & 63, wave = tid >> 6;
  float* rope = (float*)(p.ws + OFF_ROPE);
  for (int idx = blockIdx.x * NTHREADS + tid; idx < T * 32; idx += gridDim.x * NTHREADS) {
    int t = idx >> 5, i = idx & 31;
    float inv = (float)pow(10000.0, -(double)i / 32.0);
    float ang = (float)t * inv;
    double ad = (double)ang;
    double n = rint(ad * 0.15915494309189535);
    float r = (float)(ad - n * 6.283185307179586);
    float sn, cs;
    sincosf(r, &sn, &cs);
    rope[t * 64 + i] = cs;
    rope[t * 64 + 32 + i] = sn;
  }
  float* wrs = (float*)(p.ws + OFF_WRS);
  for (int idx = blockIdx.x * NTHREADS + tid; idx < 1024 * 32; idx += gridDim.x * NTHREADS) wrs[idx] = p.norm_ffn_w[idx >> 5] * p.w_router[idx];
  unsigned short* U = (unsigned short*)(p.ws + OFF_U);
  for (int tok = blockIdx.x * NWAVES + wave; tok < NT; tok += gridDim.x * NWAVES) {
    const float* src = hrow(p, tok);
    float4 v[4];
    float ss = 0.f;
#pragma unroll
    for (int i = 0; i < 4; ++i) {
      v[i] = *(const float4*)(src + lane * 4 + 256 * i);
      ss += v[i].x * v[i].x + v[i].y * v[i].y + v[i].z * v[i].z + v[i].w * v[i].w;
    }
    ss = wave_sum(ss);
    float rstd = rsqrtf(ss * (1.f / 1024.f) + 1e-6f);
#pragma unroll
    for (int i = 0; i < 4; ++i) {
      float4 w = *(const float4*)(p.norm_mix_w + lane * 4 + 256 * i);
      uint2 o;
      o.x = pk2(v[i].x * rstd * w.x, v[i].y * rstd * w.y);
      o.y = pk2(v[i].z * rstd * w.z, v[i].w * rstd * w.w);
      *(uint2*)(U + (size_t)tok * 1024 + lane * 4 + 256 * i) = o;
    }
  }
}

DI void wconv_task2(const float* src, unsigned short* dst, int K, int N, int k0, int n0, int tid) {
  const int kg = tid >> 6, n = n0 + (tid & 63) * 4, k = k0 + kg * 8;
  float4 v[8];
#pragma unroll
  for (int i = 0; i < 8; ++i) {
    v[i] = make_float4(0.f, 0.f, 0.f, 0.f);
    if (n < N) v[i] = *(const float4*)(src + (size_t)(k + i) * N + n);
  }
  uint4 o;
  o.x = pk2(v[0].x, v[1].x); o.y = pk2(v[2].x, v[3].x); o.z = pk2(v[4].x, v[5].x); o.w = pk2(v[6].x, v[7].x);
  *(uint4*)(dst + (size_t)(n + 0) * K + k) = o;
  o.x = pk2(v[0].y, v[1].y); o.y = pk2(v[2].y, v[3].y); o.z = pk2(v[4].y, v[5].y); o.w = pk2(v[6].y, v[7].y);
  *(uint4*)(dst + (size_t)(n + 1) * K + k) = o;
  o.x = pk2(v[0].z, v[1].z); o.y = pk2(v[2].z, v[3].z); o.z = pk2(v[4].z, v[5].z); o.w = pk2(v[6].z, v[7].z);
  *(uint4*)(dst + (size_t)(n + 2) * K + k) = o;
  o.x = pk2(v[0].w, v[1].w); o.y = pk2(v[2].w, v[3].w); o.z = pk2(v[4].w, v[5].w); o.w = pk2(v[6].w, v[7].w);
  *(uint4*)(dst + (size_t)(n + 3) * K + k) = o;
}
constexpr int WC_IN = 16 * 14, WC_KV = 4 * 4, WC_OUT = 16 * 4, WC_GU = 32 * 128, WC_DN = 32 * 64;
constexpr int WC_SMALL = WC_IN + WC_KV + WC_OUT, WC_ALL = WC_SMALL + WC_GU + WC_DN;
DI void wconv_task(const Params& p, int t, int tid) {
  if (t < WC_IN) {
    wconv_task2(p.w_in, (unsigned short*)(p.ws + OFF_WTIN), 1024, INC, (t / 14) * 64, (t % 14) * 256, tid);
  } else if (t < WC_IN + WC_KV) {
    t -= WC_IN;
    wconv_task2(p.w_kv_up, (unsigned short*)(p.ws + OFF_WTKV), 256, 1024, (t >> 2) * 64, (t & 3) * 256, tid);
  } else if (t < WC_SMALL) {
    t -= WC_IN + WC_KV;
    wconv_task2(p.w_out, (unsigned short*)(p.ws + OFF_WTOUT), 1024, 1024, (t >> 2) * 64, (t & 3) * 256, tid);
  } else if (t < WC_SMALL + WC_GU) {
    t -= WC_SMALL;
    const int e = t >> 7, r = t & 127;
    wconv_task2(p.w_gate_up + (size_t)e * 1024 * 2048, (unsigned short*)(p.ws + OFF_WTGU) + (size_t)e * 2048 * 1024, 1024, 2048,
                (r >> 3) * 64, (r & 7) * 256, tid);
  } else {
    t -= WC_SMALL + WC_GU;
    const int e = t >> 6, r = t & 63;
    wconv_task2(p.w_down + (size_t)e * 1024 * 1024, (unsigned short*)(p.ws + OFF_WTDN) + (size_t)e * 1024 * 1024, 1024, 1024,
                (r >> 2) * 64, (r & 3) * 256, tid);
  }
}
DI void wconv_fill(const Params& p, char* smem, int site, bool drain) {
  unsigned* q = (unsigned*)(p.ws + OFF_BAR + 15872 + 128);
  volatile LAS int* slot = (volatile LAS int*)((LAS unsigned char*)smem + STAGE_LDS_BYTES + 832);
  const int tid = otid(p);
  __syncthreads();
  if (tid == 0 && !drain) (void)__hip_atomic_fetch_add(&q[16 + site], 1u, __ATOMIC_RELAXED, __HIP_MEMORY_SCOPE_AGENT);
  for (;;) {
    __syncthreads();
    if (tid == 0) {
      int t = -1;
      const bool all_done = !drain && __hip_atomic_load(&q[16 + site], __ATOMIC_RELAXED, __HIP_MEMORY_SCOPE_AGENT) >= gridDim.x;
      if (!all_done) t = WC_SMALL + (int)__hip_atomic_fetch_add(&q[0], 1u, __ATOMIC_RELAXED, __HIP_MEMORY_SCOPE_AGENT);
      *slot = t;
    }
    __syncthreads();
    const int t = __builtin_amdgcn_readfirstlane(*slot);
    if (t < 0 || t >= WC_ALL) break;
    wconv_task(p, t, tid);
  }
}
DI void phase_wconv(const Params& p, int t0, int t1) {
  const int tid = otid(p);
  for (int t = t0 + blockIdx.x; t < t1; t += gridDim.x) wconv_task(p, t, tid);
}

namespace g8 {
constexpr int BM = 256, BK = 64, HALF = 128, HTB = HALF * BK * 2, STAGE_BYTES = 8 * HTB, NXCD = 8, WGM = 8;
constexpr int TAB_OFF = STAGE_BYTES;
constexpr int MAXU = 24;
DI int lds_byte(int r, int c) { const int st = (r >> 4) * 2 + (c >> 5), rr = r & 15, cc = c & 31, ob = rr * 64 + cc * 2; return st * 1024 + (ob ^ (((ob >> 9) & 1) << 5)); }
DI void stage_rc(int b, int& R, int& C) { const int st = b / 1024, sb = b % 1024, swz = sb ^ (((sb >> 9) & 1) << 5); R = (st >> 1) * 16 + swz / 64; C = (st & 1) * 32 + (swz % 64) / 2; }
DI int perm32(int rho) { const int n = rho >> 4, i = rho & 15; return 8 * (i >> 2) + 4 * n + (i & 3); }
DI int xcd_remap(int L, int nwg) { const int q = nwg / NXCD, r = nwg % NXCD, xcd = L % NXCD, off = L / NXCD; return (xcd < r ? xcd * (q + 1) : r * (q + 1) + (xcd - r) * q) + off; }
struct UnitT { int valid, arow, mend, pn, e, orow; };

template <int MODE> DI int n_units(const Params& p) {
  if (MODE == 0) return 65 * 14;
  if (MODE == 1) return 65 * 4;
  if (MODE == 2) return 64 * 4;
  const int* cnt = (const int*)(p.ws + OFF_CNT);
  int n = 0;
  for (int e = 0; e < NEXP; ++e) n += ((cnt[e * CNTS] + 255) >> 8) * (MODE == 3 ? 8 : 4);
  return n;
}
template <int MODE> DI void unit_of(const Params& p, int L, int nwg, UnitT& u) {
  u.valid = 0; u.arow = 0; u.mend = 0; u.pn = 0; u.e = 0; u.orow = 0;
  if (L >= nwg) return;
  const int wgid = xcd_remap(L, nwg);
  u.valid = 1;
  if (MODE <= 2) {
    const int nM = (MODE == 2) ? 64 : 65, nN = (MODE == 0) ? 14 : 4;
    const int nig = WGM * nN, gid = wgid / nig, fm = gid * WGM, gsz = (nM - fm) < WGM ? (nM - fm) : WGM;
    const int pm = fm + ((wgid % nig) % gsz);
    u.pn = (wgid % nig) / gsz;
    u.orow = pm * 256;
    u.arow = (MODE == 2) ? (pm * 256 + 16 * (pm / 16 + 1)) : pm * 256;
    u.mend = (MODE == 2) ? NR : NT;
  } else {
    const int* cnt = (const int*)(p.ws + OFF_CNT);
    constexpr int NTN = (MODE == 3) ? 8 : 4;
    int id = wgid, sbase = 0;
    for (int e = 0; e < NEXP; ++e) {
      const int c = cnt[e * CNTS], mts = (c + 255) >> 8, ne = mts * NTN;
      if (id < ne) {
        const int tn = id / mts, tm = id - tn * mts;
        u.e = e; u.pn = tn; u.arow = sbase + tm * 256; u.orow = u.arow; u.mend = sbase + c;
        return;
      }
      id -= ne;
      sbase += c;
    }
    u.valid = 0;
  }
}
DI float swiglu(float g, float u) {
  g = fminf(g, 7.0f);
  u = fminf(fmaxf(u, -7.0f), 7.0f);
  return g / (1.f + __expf(-1.702f * g)) * (u + 1.f);
}
template <int MODE>
DI void epilogue(const Params& p, const f32x4 (&acc)[2][2][4][2], const UnitT& u, int wr, int wc, int fr, int fq) {
  constexpr bool PERM = (MODE >= 3);
  const int row0 = u.orow + wr * 64 + fr;
  const int col0 = u.pn * 256 + wc * 32 + (PERM ? 8 * fq : 4 * fq);
  if (MODE == 0 || MODE == 1 || MODE == 2) {
    float* C = (float*)(p.ws + (MODE == 0 ? OFF_P : MODE == 1 ? OFF_KV : OFF_H1));
    const int ldc = (MODE == 0) ? INC : 1024;
#pragma unroll
    for (int ai = 0; ai < 2; ++ai)
#pragma unroll
      for (int m = 0; m < 4; ++m) {
        const int row = row0 + ai * 128 + m * 16;
        if (row < u.mend) {
#pragma unroll
          for (int bj = 0; bj < 2; ++bj)
#pragma unroll
            for (int n = 0; n < 2; ++n) {
              const int col = col0 + bj * 128 + n * 16;
              if (MODE != 0 || col < INC) {
                f32x4 v = acc[ai][bj][m][n];
                if (MODE == 2) v += *(const f32x4*)(p.x + (size_t)row * D + col);
                *(f32x4*)(C + (size_t)row * ldc + col) = v;
              }
            }
        }
      }
  } else if (MODE == 3) {
    unsigned short* HD = (unsigned short*)(p.ws + OFF_HD);
    f32x4 bv[2][2];
#pragma unroll
    for (int bj = 0; bj < 2; ++bj)
#pragma unroll
      for (int n = 0; n < 2; ++n) bv[bj][n] = *(const f32x4*)(p.b_gate_up + (size_t)u.e * 2048 + col0 + bj * 128 + 4 * n);
#pragma unroll
    for (int ai = 0; ai < 2; ++ai)
#pragma unroll
      for (int m = 0; m < 4; ++m) {
        const int row = row0 + ai * 128 + m * 16;
        if (row < u.mend) {
#pragma unroll
          for (int bj = 0; bj < 2; ++bj) {
            const f32x4 v0 = acc[ai][bj][m][0] + bv[bj][0], v1 = acc[ai][bj][m][1] + bv[bj][1];
            uint2 o;
            o.x = pk2(swiglu(v0[0], v0[1]), swiglu(v0[2], v0[3]));
            o.y = pk2(swiglu(v1[0], v1[1]), swiglu(v1[2], v1[3]));
            *(uint2*)(HD + (size_t)row * 1024 + (col0 + bj * 128) / 2) = o;
          }
        }
      }
  } else {
    unsigned short* Y = (unsigned short*)(p.ws + OFF_Y);
    const float* lgate = (const float*)(p.ws + OFF_LGATE);
    f32x4 bv[2][2];
#pragma unroll
    for (int bj = 0; bj < 2; ++bj)
#pragma unroll
      for (int n = 0; n < 2; ++n) bv[bj][n] = *(const f32x4*)(p.b_down + (size_t)u.e * 1024 + col0 + bj * 128 + 4 * n);
#pragma unroll
    for (int ai = 0; ai < 2; ++ai)
#pragma unroll
      for (int m = 0; m < 4; ++m) {
        const int row = row0 + ai * 128 + m * 16;
        if (row < u.mend) {
          const float gt = lgate[row];
#pragma unroll
          for (int bj = 0; bj < 2; ++bj) {
            const f32x4 v0 = (acc[ai][bj][m][0] + bv[bj][0]) * gt, v1 = (acc[ai][bj][m][1] + bv[bj][1]) * gt;
            uint4 o;
            o.x = pk2(v0[0], v0[1]); o.y = pk2(v0[2], v0[3]); o.z = pk2(v1[0], v1[1]); o.w = pk2(v1[2], v1[3]);
            *(uint4*)(Y + (size_t)row * 1024 + col0 + bj * 128) = o;
          }
        }
      }
  }
}

template <int MODE>
DI void gemm_phase(const Params& p, char* smem) {
  constexpr bool PERM = (MODE >= 3);
  constexpr int K = (MODE == 1) ? 256 : 1024, nt = K / BK;
  LAS unsigned char* lds = (LAS unsigned char*)smem;
  LAS int* tab = (LAS int*)(lds + TAB_OFF);
  const int tid = otid(p), wid = __builtin_amdgcn_readfirstlane(tid >> 6), lane = tid & 63, wr = wid >> 2, wc = wid & 3, fr = lane & 15, fq = lane >> 4;
  __syncthreads();
  {
    const int nwg = n_units<MODE>(p);
    for (int ti = 0; ti < MAXU; ++ti) {
      UnitT u;
      unit_of<MODE>(p, ti * (int)gridDim.x + (int)blockIdx.x, nwg, u);
      if (tid == 0) { tab[ti * 8 + 0] = u.valid; tab[ti * 8 + 1] = u.arow; tab[ti * 8 + 2] = u.mend; tab[ti * 8 + 3] = u.pn; tab[ti * 8 + 4] = u.e; tab[ti * 8 + 5] = u.orow; }
    }
  }
  __syncthreads();
#define G8_GETU(i, u) do { const int _i = (i); (u).valid = (_i < MAXU) ? __builtin_amdgcn_readfirstlane(tab[_i * 8 + 0]) : 0; (u).arow = __builtin_amdgcn_readfirstlane(tab[(_i < MAXU ? _i : 0) * 8 + 1]); \
    (u).mend = __builtin_amdgcn_readfirstlane(tab[(_i < MAXU ? _i : 0) * 8 + 2]); (u).pn = __builtin_amdgcn_readfirstlane(tab[(_i < MAXU ? _i : 0) * 8 + 3]); \
    (u).e = __builtin_amdgcn_readfirstlane(tab[(_i < MAXU ? _i : 0) * 8 + 4]); (u).orow = __builtin_amdgcn_readfirstlane(tab[(_i < MAXU ? _i : 0) * 8 + 5]); } while (0)
  UnitT cur, nxt;
  G8_GETU(0, cur);
  if (!cur.valid) return;
  const char* Abase = (const char*)(p.ws + (MODE == 0 ? OFF_U : MODE == 1 ? OFF_CKV : MODE == 2 ? OFF_MIX : MODE == 3 ? OFF_U2 : OFF_HD));
  const char* Bbase = (const char*)(p.ws + (MODE == 0 ? OFF_WTIN : MODE == 1 ? OFF_WTKV : MODE == 2 ? OFF_WTOUT : MODE == 3 ? OFF_WTGU : OFF_WTDN));
  constexpr size_t BEXP = (MODE == 3) ? (size_t)2048 * 1024 * 2 : (MODE == 4) ? (size_t)1024 * 1024 * 2 : 0;
  int Rr[2], Cc[2];
  unsigned voffB[2];
#pragma unroll
  for (int i = 0; i < 2; ++i) {
    stage_rc(tid * 16 + i * 8192, Rr[i], Cc[i]);
    const int Rb = PERM ? ((Rr[i] & ~31) + perm32(Rr[i] & 31)) : Rr[i];
    voffB[i] = (unsigned)(Rb * K + Cc[i]) * 2u;
  }
  unsigned voffA[2][2];
  const int* ltok = (const int*)(p.ws + OFF_LTOK);
#define G8_VOFFA(dst, un) do { _Pragma("unroll") for (int _h = 0; _h < 2; ++_h) _Pragma("unroll") for (int _i = 0; _i < 2; ++_i) { \
      if (MODE == 3) { int _s = (un).arow + _h * 128 + Rr[_i]; _s = _s < NASG ? _s : NASG - 1; dst[_h][_i] = (unsigned)(ltok[_s] * K + Cc[_i]) * 2u; } \
      else dst[_h][_i] = (unsigned)((_h * 128 + Rr[_i]) * K + Cc[_i]) * 2u; } } while (0)
  const size_t kstep = (size_t)(BK * 2);
  const size_t hstep = (size_t)HALF * K * 2;
  const size_t tstep = 2 * hstep;
  const unsigned ldsw = (unsigned)wid * 1024u;
  const int aoff = lds_byte(wr * 64 + fr, fq * 8), boff = lds_byte(wc * 32 + fr, fq * 8);
#define G8_SA(b, h) (((b) * 2 + (h)) * HTB)
#define G8_SB(b, h) ((4 + (b) * 2 + (h)) * HTB)
#define G8_STAGE(bufoff, gbase, voff) do { _Pragma("unroll") for (int _i = 0; _i < 2; ++_i) \
    __builtin_amdgcn_global_load_lds((const unsigned*)((const char*)(gbase) + (voff)[_i]), (LAS unsigned*)(lds + (bufoff) + ldsw + _i * 8192), 16, 0, 0); } while (0)
#define G8_LDA(dst, b, h) do { _Pragma("unroll") for (int m = 0; m < 4; ++m) _Pragma("unroll") for (int k = 0; k < 2; ++k) dst[m][k] = *(const LAS bf16x8*)(lds + G8_SA(b, h) + aoff + m * 2048 + k * 1024); } while (0)
#define G8_LDB(dst, b, h) do { _Pragma("unroll") for (int n = 0; n < 2; ++n) _Pragma("unroll") for (int k = 0; k < 2; ++k) dst[n][k] = *(const LAS bf16x8*)(lds + G8_SB(b, h) + boff + n * 2048 + k * 1024); } while (0)
#define G8_MMA(ai, bj, At, Bt) do { __builtin_amdgcn_s_setprio(1); _Pragma("unroll") for (int m = 0; m < 4; ++m) _Pragma("unroll") for (int n = 0; n < 2; ++n) _Pragma("unroll") for (int k = 0; k < 2; ++k) \
    acc[ai][bj][m][n] = __builtin_amdgcn_mfma_f32_16x16x32_bf16(Bt[n][k], At[m][k], acc[ai][bj][m][n], 0, 0, 0); __builtin_amdgcn_s_setprio(0); } while (0)
#define G8_WAIT_V(n) asm volatile("s_waitcnt vmcnt(" #n ")" ::: "memory")
#define G8_WAIT_L(n) asm volatile("s_waitcnt lgkmcnt(" #n ")" ::: "memory")
#define G8_BAR __builtin_amdgcn_s_barrier()
#define G8_SCHED __builtin_amdgcn_sched_barrier(0)
  int ui = 0;
  f32x4 acc[2][2][4][2];
#pragma unroll
  for (int a = 0; a < 2; ++a)
#pragma unroll
    for (int b = 0; b < 2; ++b)
#pragma unroll
      for (int m = 0; m < 4; ++m)
#pragma unroll
        for (int n = 0; n < 2; ++n) acc[a][b][m][n] = (f32x4){0.f, 0.f, 0.f, 0.f};
  bf16x8 At[4][2], B0[2][2], B1[2][2];
  G8_VOFFA(voffA, cur);
  if (MODE == 3) asm volatile("s_waitcnt vmcnt(0)" ::: "memory");
  const char* cA = (MODE == 3) ? Abase : Abase + (size_t)cur.arow * K * 2;
  const char* cB = Bbase + (size_t)cur.e * BEXP + (size_t)cur.pn * tstep;
  G8_STAGE(G8_SB(0, 0), cB, voffB); G8_STAGE(G8_SA(0, 0), cA, voffA[0]); G8_STAGE(G8_SB(0, 1), cB + hstep, voffB); G8_STAGE(G8_SA(0, 1), cA, voffA[1]);
  if (wr == 1) G8_BAR;
  G8_WAIT_V(4); G8_BAR;
  G8_STAGE(G8_SB(1, 0), cB + kstep, voffB); G8_STAGE(G8_SA(1, 0), cA + kstep, voffA[0]); G8_STAGE(G8_SB(1, 1), cB + hstep + kstep, voffB);
  G8_WAIT_V(6); G8_BAR;
  for (;;) {
    G8_GETU(ui + 1, nxt);
    const bool has_next = nxt.valid != 0;
    const char* nA = has_next ? ((MODE == 3) ? Abase : Abase + (size_t)nxt.arow * K * 2) : cA;
    const char* nB = has_next ? Bbase + (size_t)nxt.e * BEXP + (size_t)nxt.pn * tstep : cB;
#pragma unroll 1
    for (int t = 0; t < nt; t += 2) {
      const bool last = (t == nt - 2);
      const char* a1 = cA + (size_t)(t + 1) * kstep;
      const char* a2 = last ? nA : cA + (size_t)(t + 2) * kstep;
      const char* b2 = last ? nB : cB + (size_t)(t + 2) * kstep;
      const char* a3 = a2 + kstep;
      const char* b3 = b2 + kstep;
      G8_LDB(B0, 0, 0); G8_SCHED; G8_LDA(At, 0, 0); G8_STAGE(G8_SA(1, 1), a1, voffA[1]);
      if (MODE == 3) {
        if (last && has_next) {
          G8_VOFFA(voffA, nxt);
          asm volatile("s_waitcnt vmcnt(0)" ::: "memory");
        }
      }
      G8_WAIT_L(8); G8_BAR; G8_WAIT_L(0); G8_MMA(0, 0, At, B0); G8_BAR; G8_SCHED;
      G8_LDB(B1, 0, 1); G8_STAGE(G8_SB(0, 0), b2, voffB);
      G8_BAR; G8_WAIT_L(0); G8_MMA(0, 1, At, B1); G8_BAR;
      G8_LDA(At, 0, 1); G8_STAGE(G8_SA(0, 0), a2, voffA[0]);
      G8_BAR; G8_WAIT_L(0); G8_MMA(1, 0, At, B0); G8_BAR; G8_SCHED;
      G8_STAGE(G8_SB(0, 1), b2 + hstep, voffB);
      G8_WAIT_V(6); G8_BAR; G8_MMA(1, 1, At, B1); G8_BAR;
      G8_LDB(B0, 1, 0); G8_SCHED; G8_LDA(At, 1, 0); G8_STAGE(G8_SA(0, 1), a2, voffA[1]);
      G8_WAIT_L(8); G8_BAR; G8_WAIT_L(0); G8_MMA(0, 0, At, B0); G8_BAR; G8_SCHED;
      G8_LDB(B1, 1, 1); G8_STAGE(G8_SB(1, 0), b3, voffB);
      G8_BAR; G8_WAIT_L(0); G8_MMA(0, 1, At, B1); G8_BAR;
      G8_LDA(At, 1, 1); G8_STAGE(G8_SA(1, 0), a3, voffA[0]);
      G8_BAR; G8_WAIT_L(0); G8_MMA(1, 0, At, B0); G8_BAR; G8_SCHED;
      G8_STAGE(G8_SB(1, 1), b3 + hstep, voffB);
      G8_WAIT_V(6); G8_BAR; G8_MMA(1, 1, At, B1); G8_BAR;
    }
    epilogue<MODE>(p, acc, cur, wr, wc, fr, fq);
    if (!has_next) break;
#pragma unroll
    for (int a = 0; a < 2; ++a)
#pragma unroll
      for (int b = 0; b < 2; ++b)
#pragma unroll
        for (int m = 0; m < 4; ++m)
#pragma unroll
          for (int n = 0; n < 2; ++n) acc[a][b][m][n] = (f32x4){0.f, 0.f, 0.f, 0.f};
    cur = nxt; cA = nA; cB = nB; ++ui;
  }
  G8_WAIT_V(0);
  if (wr == 0) G8_BAR;
  G8_BAR;
#undef G8_GETU
#undef G8_VOFFA
#undef G8_SA
#undef G8_SB
#undef G8_STAGE
#undef G8_LDA
#undef G8_LDB
#undef G8_MMA
#undef G8_WAIT_V
#undef G8_WAIT_L
#undef G8_BAR
#undef G8_SCHED
}
}

DI float rope_apply(float v, float c, float s, int lane) {
  float o = xor32f(v, lane);
  return (lane < 32) ? (v * c - o * s) : (v * c + o * s);
}
DI void phase_post1(const Params& p, char* smem) {
  const int tid = otid(p), lane = tid & 63, wave = tid >> 6;
  const float* P = (const float*)(p.ws + OFF_P);
  const float* rope = (const float*)(p.ws + OFF_ROPE);
  unsigned short* Qb = (unsigned short*)(p.ws + OFF_QB);
  unsigned short* QI = (unsigned short*)(p.ws + OFF_QI);
  unsigned short* KI = (unsigned short*)(p.ws + OFF_KI);
  unsigned short* CKV = (unsigned short*)(p.ws + OFF_CKV);
  float* WI = (float*)(p.ws + OFF_WI);
  float* Qd = (float*)(p.ws + OFF_QD);
  float* Kd = (float*)(p.ws + OFF_KD);
  float* Vd = (float*)(p.ws + OFF_VD);
  float* BETA = (float*)(p.ws + OFF_BETA);
  float* G = (float*)(p.ws + OFF_G);
  float* cw = (float*)smem;
  __syncthreads();
  for (int idx = tid; idx < 4 * 1536; idx += NTHREADS) cw[idx] = p.conv_w[idx];
  __syncthreads();
  const float qw = p.q_norm_w[lane];
  const float4 kvw = *(const float4*)(p.kv_norm_w + lane * 4);
  constexpr int PG = 4;
  for (int g = blockIdx.x * NWAVES + wave; g < NT / PG; g += gridDim.x * NWAVES) {
    const int tok0 = g * PG, b = tok0 / T, t0 = tok0 - b * T;
    const int tailc = (lane < 8) ? (C_IW + lane) : (C_BBETA + ((lane - 8) & 7));
    float nqv[8], niv[8];
    float4 nckv;
    float nikv, ntail;
    {
      const float* row = P + (size_t)tok0 * INC;
#pragma unroll
      for (int hh = 0; hh < 8; ++hh) { nqv[hh] = row[C_AQ + hh * 64 + lane]; niv[hh] = row[C_IQ + hh * 64 + lane]; }
      nckv = *(const float4*)(row + C_CKV + lane * 4);
      nikv = row[C_IK + lane];
      ntail = row[tailc];
    }
#pragma unroll 1
    for (int tt = 0; tt < PG; ++tt) {
      const int tok = tok0 + tt, t = t0 + tt;
      float qv[8], iv[8];
#pragma unroll
      for (int hh = 0; hh < 8; ++hh) { qv[hh] = nqv[hh]; iv[hh] = niv[hh]; }
      const float4 ckv = nckv;
      const float ikv = nikv, tailv = ntail;
      if (tt + 1 < PG) {
        const float* row = P + (size_t)(tok + 1) * INC;
#pragma unroll
        for (int hh = 0; hh < 8; ++hh) { nqv[hh] = row[C_AQ + hh * 64 + lane]; niv[hh] = row[C_IQ + hh * 64 + lane]; }
        nckv = *(const float4*)(row + C_CKV + lane * 4);
        nikv = row[C_IK + lane];
        ntail = row[tailc];
      }
      const float cs = rope[t * 64 + (lane & 31)], sn = rope[t * 64 + 32 + (lane & 31)];
      unsigned short* qb = Qb + (size_t)tok * 512 + lane;
      unsigned short* qi = QI + (size_t)tok * 512 + lane;
#pragma unroll
      for (int hh = 0; hh < 8; ++hh) {
        float v = qv[hh];
        const float ss = wave_sum(v * v);
        v = v * rsqrtf(ss * (1.f / 64.f) + 1e-6f) * qw;
        qb[hh * 64] = f2bf(rope_apply(v, cs, sn, lane));
        qi[hh * 64] = f2bf(rope_apply(iv[hh], cs, sn, lane));
      }
      {
        const float ss = wave_sum(ckv.x * ckv.x + ckv.y * ckv.y + ckv.z * ckv.z + ckv.w * ckv.w);
        const float rstd = rsqrtf(ss * (1.f / 256.f) + 1e-6f);
        uint2 o;
        o.x = pk2(ckv.x * rstd * kvw.x, ckv.y * rstd * kvw.y);
        o.y = pk2(ckv.z * rstd * kvw.z, ckv.w * rstd * kvw.w);
        *(uint2*)(CKV + (size_t)tok * 256 + lane * 4) = o;
      }
      KI[(size_t)tok * 64 + lane] = f2bf(rope_apply(ikv, cs, sn, lane));
      if (lane < 8) WI[(size_t)tok * 8 + lane] = tailv * 0.04419417382415922f;
      if (lane >= 8 && lane < 12) BETA[(size_t)tok * 4 + (lane - 8)] = 1.f / (1.f + expf(-tailv));
      if (lane >= 12 && lane < 16) {
        const float xx = tailv + p.dt_bias[lane - 12];
        const float sp = fmaxf(xx, 0.f) + log1pf(expf(-fabsf(xx)));
        G[(size_t)tok * 4 + (lane - 12)] = -expf(p.a_log[lane - 12]) * sp;
      }
    }
    float x0[24], x1[24], x2[24];
    {
      const float* base = P + (size_t)tok0 * INC + C_BQKV + lane;
#pragma unroll
      for (int i = 0; i < 24; ++i) {
        x0[i] = (t0 >= 3) ? base[64 * i - 3 * (ptrdiff_t)INC] : 0.f;
        x1[i] = (t0 >= 2) ? base[64 * i - 2 * (ptrdiff_t)INC] : 0.f;
        x2[i] = (t0 >= 1) ? base[64 * i - 1 * (ptrdiff_t)INC] : 0.f;
      }
    }
    float xn[24];
    {
      const float* xr = P + (size_t)tok0 * INC + C_BQKV + lane;
#pragma unroll
      for (int i = 0; i < 24; ++i) xn[i] = xr[64 * i];
    }
#pragma unroll 1
    for (int tt = 0; tt < PG; ++tt) {
      const int tok = tok0 + tt;
      float x3[24];
#pragma unroll
      for (int i = 0; i < 24; ++i) x3[i] = xn[i];
      if (tt + 1 < PG) {
        const float* xr = P + (size_t)(tok + 1) * INC + C_BQKV + lane;
#pragma unroll
        for (int i = 0; i < 24; ++i) xn[i] = xr[64 * i];
      }
      int cl = lane;
      asm volatile("" : "+v"(cl));
      float* qd = Qd + (size_t)tok * 512 + lane;
      float* kd = Kd + (size_t)tok * 512 + lane;
      float* vd = Vd + (size_t)tok * 512 + lane;
#pragma unroll
      for (int hd = 0; hd < 4; ++hd) {
        float cv[6];
#pragma unroll
        for (int q = 0; q < 6; ++q) {
          const int i = (q >> 1) * 8 + 2 * hd + (q & 1);
          const int c = cl + 64 * i;
          const float a = cw[c] * x0[i] + cw[1536 + c] * x1[i] + cw[2 * 1536 + c] * x2[i] + cw[3 * 1536 + c] * x3[i];
          cv[q] = a / (1.f + __expf(-a));
          x0[i] = x1[i]; x1[i] = x2[i]; x2[i] = x3[i];
        }
        float ss = wave_sum(cv[0] * cv[0] + cv[1] * cv[1]);
        float r = rsqrtf(ss + 1e-6f);
        qd[hd * 128] = cv[0] * r;
        qd[hd * 128 + 64] = cv[1] * r;
        ss = wave_sum(cv[2] * cv[2] + cv[3] * cv[3]);
        r = rsqrtf(ss + 1e-6f);
        kd[hd * 128] = cv[2] * r;
        kd[hd * 128 + 64] = cv[3] * r;
        vd[hd * 128] = cv[4];
        vd[hd * 128 + 64] = cv[5];
      }
    }
  }
}

DI void phase_post2(const Params& p, char* smem) {
  (void)smem;
  const int tid = otid(p), lane = tid & 63, wave = tid >> 6;
  const float* KV = (const float*)(p.ws + OFF_KV);
  const float* rope = (const float*)(p.ws + OFF_ROPE);
  unsigned short* Kb = (unsigned short*)(p.ws + OFF_KB);
  unsigned short* Vb = (unsigned short*)(p.ws + OFF_VT);
  const float kw = p.k_norm_w[lane];
  for (int tok = blockIdx.x * NWAVES + wave; tok < NT; tok += gridDim.x * NWAVES) {
    const int b = tok / T, t = tok - b * T;
    const float* row = KV + (size_t)tok * 1024;
    float kv[8], vv[8];
#pragma unroll
    for (int hh = 0; hh < 8; ++hh) { kv[hh] = row[hh * 64 + lane]; vv[hh] = row[512 + hh * 64 + lane]; }
    const float cs = rope[t * 64 + (lane & 31)], sn = rope[t * 64 + 32 + (lane & 31)];
    unsigned short* kb = Kb + (size_t)tok * 512 + lane;
    unsigned short* vb = Vb + (size_t)tok * 512 + lane;
#pragma unroll
    for (int hh = 0; hh < 8; ++hh) {
      float v = kv[hh];
      const float ss = wave_sum(v * v);
      v = v * rsqrtf(ss * (1.f / 64.f) + 1e-6f) * kw;
      kb[hh * 64] = f2bf(rope_apply(v, cs, sn, lane));
      vb[hh * 64] = f2bf(vv[hh]);
    }
  }
}

constexpr int KS_STRIDE = 129, AM_STRIDE = 65;
DI void phase_chunkprep(const Params& p, char* smem) {
  float* Ks = (float*)smem;
  float* Qs = Ks + 64 * KS_STRIDE;
  float* Am = Qs + 64 * KS_STRIDE;
  float* Tm = Am + 64 * AM_STRIDE;
  float* gc = Tm + 64 * AM_STRIDE;
  float* bet = gc + 64;
  float* gl = bet + 64;
  unsigned short* T16 = (unsigned short*)(gl + 64);
  float* Mt = (float*)T16;
  unsigned short* VbT = T16 + 64 * 72;
  unsigned short* KbT = (unsigned short*)Qs;
  static_assert((64 * KS_STRIDE * 2 + 64 * AM_STRIDE * 2 + 192) * 4 + (64 * 72 + 128 * 72) * 2 <= 131072, "chunk prep LDS");
  const int tid = otid(p), lane = tid & 63, wave = tid >> 6;
  const float* Qd = (const float*)(p.ws + OFF_QD);
  const float* Kd = (const float*)(p.ws + OFF_KD);
  const float* Vd = (const float*)(p.ws + OFF_VD);
  const float* BETA = (const float*)(p.ws + OFF_BETA);
  const float* G = (const float*)(p.ws + OFF_G);
  unsigned short* CHB = (unsigned short*)(p.ws + OFF_WN);
  float* UU = (float*)(p.ws + OFF_UU);
  float* DL = (float*)(p.ws + OFF_DL);
  for (int ci = blockIdx.x; ci < NCHT; ci += gridDim.x) {
    unsigned short* chb = CHB + (size_t)ci * CHB_ELEMS;
    const int bh = ci / NCH, c = ci - bh * NCH, b = bh >> 2, h = bh & 3;
    __syncthreads();
    if (tid < 64) {
      int t = c * 64 + tid - 48;
      float g = 0.f, be = 0.f;
      if (t >= 0) { g = G[(size_t)(b * T + t) * 4 + h]; be = BETA[(size_t)(b * T + t) * 4 + h]; }
      gl[tid] = g;
      bet[tid] = be;
    }
    float vreg[16];
#pragma unroll
    for (int it = 0; it < 16; ++it) {
      const int idx = tid + it * NTHREADS, i = idx >> 7, d = idx & 127;
      const int t = c * 64 + i - 48;
      float kv = 0.f, qv = 0.f, vv = 0.f;
      if (t >= 0) {
        const size_t o = ((size_t)(b * T + t)) * 512 + h * 128 + d;
        kv = Kd[o];
        qv = Qd[o] * 0.08838834764831845f;
        vv = Vd[o];
      }
      Ks[i * KS_STRIDE + d] = kv;
      Qs[i * KS_STRIDE + d] = qv;
      vreg[it] = vv;
    }
    __syncthreads();
    if (tid < 64) {
      float s2 = 0.f;
      for (int j = 0; j <= tid; ++j) s2 += gl[j];
      gc[tid] = s2;
    }
    __syncthreads();
    {
      const int i = tid >> 3, jb = tid & 7;
      float akk[8], aqk[8];
#pragma unroll
      for (int jj = 0; jj < 8; ++jj) { akk[jj] = 0.f; aqk[jj] = 0.f; }
      for (int d = 0; d < 128; ++d) {
        float ki = Ks[i * KS_STRIDE + d], qi = Qs[i * KS_STRIDE + d];
#pragma unroll
        for (int jj = 0; jj < 8; ++jj) {
          float kj = Ks[(jb + 8 * jj) * KS_STRIDE + d];
          akk[jj] += ki * kj;
          aqk[jj] += qi * kj;
        }
      }
      const float gi = gc[i], bi = bet[i];
#pragma unroll
      for (int jj = 0; jj < 8; ++jj) {
        int j = jb + 8 * jj;
        float dec = (j <= i) ? __expf(gi - gc[j]) : 0.f;
        Am[i * AM_STRIDE + j] = (j < i) ? bi * akk[jj] * dec : 0.f;
        chb[CH_IN + swzB(i, j)] = f2bf((j <= i) ? aqk[jj] * dec : 0.f);
      }
    }
    for (int idx = tid; idx < 64 * 128; idx += NTHREADS) {
      int i = idx >> 7, d = idx & 127;
      chb[CH_QG + swzA(i, d)] = f2bf(Qs[i * KS_STRIDE + d] * __expf(gc[i]));
    }
    __syncthreads();
#pragma unroll
    for (int it = 0; it < 16; ++it) {
      const int idx = tid + it * NTHREADS, i = idx >> 7, d = idx & 127;
      const float bi = bet[i];
      VbT[d * 72 + i] = f2bf(bi * vreg[it]);
      KbT[d * 72 + i] = f2bf(bi * __expf(gc[i]) * Ks[i * KS_STRIDE + d]);
    }
    {
      for (int idx = tid; idx < 64 * 64; idx += NTHREADS) Tm[(idx >> 6) * AM_STRIDE + (idx & 63)] = 0.f;
      __syncthreads();
      if (tid < 64) {
        const int bb = tid >> 4, cc = tid & 15, o = 16 * bb;
        float x[16];
#pragma unroll
        for (int i = 0; i < 16; ++i) {
          float a = (i == cc) ? 1.f : 0.f;
#pragma unroll
          for (int j = 0; j < 16; ++j)
            if (j < i) a -= Am[(o + i) * AM_STRIDE + o + j] * x[j];
          x[i] = a;
          Tm[(o + i) * AM_STRIDE + o + cc] = a;
        }
      }
      __syncthreads();
      {
        const int B = tid >> 8, i = (tid >> 4) & 15, j = tid & 15, o = 32 * B;
        float m = 0.f;
#pragma unroll
        for (int k = 0; k < 16; ++k) m += Am[(o + 16 + i) * AM_STRIDE + o + k] * Tm[(o + k) * AM_STRIDE + o + j];
        Mt[(B * 16 + i) * 33 + j] = m;
        __syncthreads();
        float t = 0.f;
#pragma unroll
        for (int k = 0; k < 16; ++k) t += Tm[(o + 16 + i) * AM_STRIDE + o + 16 + k] * Mt[(B * 16 + k) * 33 + j];
        __syncthreads();
        Tm[(o + 16 + i) * AM_STRIDE + o + j] = -t;
      }
      __syncthreads();
      {
        const int i = tid >> 4, j0 = (tid & 15) * 2;
        float m0 = 0.f, m1 = 0.f;
        for (int k = 0; k < 32; ++k) {
          const float a = Am[(32 + i) * AM_STRIDE + k];
          m0 += a * Tm[k * AM_STRIDE + j0];
          m1 += a * Tm[k * AM_STRIDE + j0 + 1];
        }
        Mt[i * 33 + j0] = m0;
        Mt[i * 33 + j0 + 1] = m1;
        __syncthreads();
        float t0 = 0.f, t1 = 0.f;
        for (int k = 0; k < 32; ++k) {
          const float a = Tm[(32 + i) * AM_STRIDE + 32 + k];
          t0 += a * Mt[k * 33 + j0];
          t1 += a * Mt[k * 33 + j0 + 1];
        }
        __syncthreads();
        Tm[(32 + i) * AM_STRIDE + j0] = -t0;
        Tm[(32 + i) * AM_STRIDE + j0 + 1] = -t1;
      }
    }
    __syncthreads();
    for (int idx = tid; idx < 64 * 64; idx += NTHREADS) T16[(idx >> 6) * 72 + (idx & 63)] = f2bf(Tm[(idx >> 6) * AM_STRIDE + (idx & 63)]);
    __syncthreads();
    {
      const int mat = wave >> 2, nt = wave & 3, lr = lane & 31, lh = lane >> 5;
      const unsigned short* Bt = mat ? KbT : VbT;
#pragma unroll
      for (int mt = 0; mt < 2; ++mt) {
        f32x16 acc;
#pragma unroll
        for (int r = 0; r < 16; ++r) acc[r] = 0.f;
#pragma unroll
        for (int ks = 0; ks < 4; ++ks) {
          const bf16x8 af = ld16(T16 + (mt * 32 + lr) * 72 + ks * 16 + 8 * lh);
          const bf16x8 bfr = ld16(Bt + (nt * 32 + lr) * 72 + ks * 16 + 8 * lh);
          acc = MFMA32(af, bfr, acc);
        }
        if (mat == 0) {
          float* up = UU + (size_t)ci * 8192 + (((nt * 2 + mt) * 2 + lh) * 32 + lr) * 16;
#pragma unroll
          for (int q = 0; q < 4; ++q) *(float4*)(up + 4 * q) = make_float4(acc[4 * q], acc[4 * q + 1], acc[4 * q + 2], acc[4 * q + 3]);
        } else {
#pragma unroll
          for (int r = 0; r < 16; ++r) chb[swzA(mt * 32 + crow(r, lh), nt * 32 + lr)] = f2bf(-acc[r]);
        }
      }
    }
    const float glast = gc[63];
    for (int idx = tid; idx < 64 * 128; idx += NTHREADS) {
      int i = idx & 63, d = idx >> 6;
      chb[CH_KDT + swzB(d, i)] = f2bf(Ks[i * KS_STRIDE + d] * __expf(glast - gc[i]));
    }
    if (tid == 0) DL[ci] = __expf(glast);
  }
}

DI float relu_fma(float w, float x, float acc) {
  const int xi = __builtin_bit_cast(int, x);
  const float m = __builtin_bit_cast(float, xi > 0 ? xi : 0);
  return __builtin_fmaf(w, m, acc);
}
DI unsigned ordkey(float f) {
  unsigned u = __float_as_uint(f);
  return (u & 0x80000000u) ? ~u : (u | 0x80000000u);
}
DI int half_sum(int v) {
  v += dppi<0xB1>(v); v += dppi<0x4E>(v); v += dppi<0x141>(v); v += dppi<0x140>(v);
  const int lo = __builtin_amdgcn_readlane(v, 0) + __builtin_amdgcn_readlane(v, 16);
  const int hi = __builtin_amdgcn_readlane(v, 32) + __builtin_amdgcn_readlane(v, 48);
  return (__builtin_amdgcn_mbcnt_hi(~0u, __builtin_amdgcn_mbcnt_lo(~0u, 0u)) < 32u) ? lo : hi;
}
DI int cnt4_ge(int cnt, unsigned a, unsigned b, unsigned c, unsigned d, unsigned cand) {
  unsigned long long m0, m1, m2, m3;
  asm("v_cmp_ge_u32_e64 %1, %5, %9\n\tv_cmp_ge_u32_e64 %2, %6, %9\n\tv_cmp_ge_u32_e64 %3, %7, %9\n\tv_cmp_ge_u32_e64 %4, %8, %9\n\t"
      "v_addc_co_u32_e64 %0, %1, %0, 0, %1\n\tv_addc_co_u32_e64 %0, %2, %0, 0, %2\n\tv_addc_co_u32_e64 %0, %3, %0, 0, %3\n\tv_addc_co_u32_e64 %0, %4, %0, 0, %4"
      : "+v"(cnt), "=&s"(m0), "=&s"(m1), "=&s"(m2), "=&s"(m3)
      : "v"(a), "v"(b), "v"(c), "v"(d), "v"(cand));
  return cnt;
}
DI int cnt4_gt(int cnt, unsigned a, unsigned b, unsigned c, unsigned d, unsigned cand) {
  unsigned long long m0, m1, m2, m3;
  asm("v_cmp_gt_u32_e64 %1, %5, %9\n\tv_cmp_gt_u32_e64 %2, %6, %9\n\tv_cmp_gt_u32_e64 %3, %7, %9\n\tv_cmp_gt_u32_e64 %4, %8, %9\n\t"
      "v_addc_co_u32_e64 %0, %1, %0, 0, %1\n\tv_addc_co_u32_e64 %0, %2, %0, 0, %2\n\tv_addc_co_u32_e64 %0, %3, %0, 0, %3\n\tv_addc_co_u32_e64 %0, %4, %0, 0, %4"
      : "+v"(cnt), "=&s"(m0), "=&s"(m1), "=&s"(m2), "=&s"(m3)
      : "v"(a), "v"(b), "v"(c), "v"(d), "v"(cand));
  return cnt;
}
DI void indexer_task(const Params& p, int b, int q0, int lane) {
  unsigned* MASK = (unsigned*)(p.ws + OFF_MASK);
  const int qsel = lane >> 5;
  const int tq = q0 + qsel;
  unsigned* mrow = MASK + ((size_t)b * SEQ + tq) * 128;
  if (q0 + 1 < 256) {
    for (int i = (lane & 31); i < 128; i += 32) {
      int rem = tq + 1 - 32 * i;
      unsigned w = (rem >= 32) ? 0xffffffffu : (rem > 0 ? ((1u << rem) - 1u) : 0u);
      mrow[i] = w;
    }
    return;
  }
  const unsigned short* QI = (const unsigned short*)(p.ws + OFF_QI);
  const unsigned short* KI = (const unsigned short*)(p.ws + OFF_KI);
  const float* WI = (const float*)(p.ws + OFF_WI);
  const int l15 = lane & 15, lg = lane >> 4;
  const size_t qtok = (size_t)b * T + NM + q0 + (l15 >> 3);
  const bf16x8 a0 = ld16(QI + qtok * 512 + (l15 & 7) * 64 + 8 * lg);
  const bf16x8 a1 = ld16(QI + qtok * 512 + (l15 & 7) * 64 + 32 + 8 * lg);
  float w[4];
  {
    const size_t wtok = (size_t)b * T + NM + q0 + (lg >> 1);
#pragma unroll
    for (int r = 0; r < 4; ++r) w[r] = WI[wtok * 8 + 4 * (lg & 1) + r];
  }
  const int npairs = (q0 + 2 + 31) >> 5;
  const unsigned short* kp = KI + ((size_t)b * T + NM) * 64 + (size_t)l15 * 64 + 8 * lg;
  unsigned u[128];
  int rem = tq - (lane & 31);
  bf16x8 n0 = ld16(kp), n1 = ld16(kp + 32), n2 = ld16(kp + 1024), n3 = ld16(kp + 1024 + 32);
#pragma unroll
  for (int i = 0; i < 128; ++i) {
    unsigned uv = 0u;
    kp += 2048;
    asm volatile("" : "+v"(kp));
    if (i < npairs) {
      const bf16x8 c0 = n0, c1 = n1, c2 = n2, c3 = n3;
      if (i + 1 < npairs) { n0 = ld16(kp); n1 = ld16(kp + 32); n2 = ld16(kp + 1024); n3 = ld16(kp + 1024 + 32); }
      float tot[2];
      {
        f32x4 acc = {0.f, 0.f, 0.f, 0.f};
        acc = MFMA16(a0, c0, acc);
        acc = MFMA16(a1, c1, acc);
        float part = 0.f;
#pragma unroll
        for (int r = 0; r < 4; ++r) part = relu_fma(w[r], acc[r], part);
        tot[0] = part + xor16f(part, lane);
      }
      {
        f32x4 acc = {0.f, 0.f, 0.f, 0.f};
        acc = MFMA16(a0, c2, acc);
        acc = MFMA16(a1, c3, acc);
        float part = 0.f;
#pragma unroll
        for (int r = 0; r < 4; ++r) part = relu_fma(w[r], acc[r], part);
        tot[1] = part + xor16f(part, lane);
      }
      const float sc = (lg & 1) ? tot[1] : tot[0];
      uv = (rem >= 0) ? ordkey(sc) : 0u;
    }
    u[i] = uv;
    rem -= 32;
    asm volatile("" : "+v"(rem));
  }
  const int nblk = (npairs + 15) >> 4;
  unsigned thr = 0u;
  bool done = false;
  for (int bit = 31; bit >= 0; --bit) {
    const unsigned cand = thr | (1u << bit);
    int cnt = 0;
#pragma unroll
    for (int blk = 0; blk < 8; ++blk) {
      if (blk < nblk) {
#pragma unroll
        for (int j = 0; j < 16; j += 4) cnt = cnt4_ge(cnt, u[blk * 16 + j], u[blk * 16 + j + 1], u[blk * 16 + j + 2], u[blk * 16 + j + 3], cand);
      }
    }
    cnt = half_sum(cnt);
    if (!done && cnt >= 256) thr = cand;
    done = done || (cnt == 256);
    if (__all(done)) break;
  }
  int cgt = 0;
#pragma unroll
  for (int blk = 0; blk < 8; ++blk) {
    if (blk < nblk) {
#pragma unroll
      for (int j = 0; j < 16; j += 4) cgt = cnt4_gt(cgt, u[blk * 16 + j], u[blk * 16 + j + 1], u[blk * 16 + j + 2], u[blk * 16 + j + 3], thr);
    }
  }
  cgt = half_sum(cgt);
  const int need = 256 - cgt;
  int base = 0;
  const unsigned lt_mask = (1u << (lane & 31)) - 1u;
#pragma unroll
  for (int blk = 0; blk < 8; ++blk) {
    if (blk < nblk) {
#pragma unroll
      for (int j = 0; j < 16; ++j) {
        const int i = blk * 16 + j;
        const bool eq = (u[i] == thr);
        const unsigned long long eb = __ballot(eq);
        const unsigned ehalf = qsel ? (unsigned)(eb >> 32) : (unsigned)eb;
        const int below = __popc(ehalf & lt_mask);
        const bool sel = (u[i] > thr) || (eq && (base + below < need));
        base += __popc(ehalf);
        const unsigned long long sb = __ballot(sel);
        const unsigned shalf = qsel ? (unsigned)(sb >> 32) : (unsigned)sb;
        if ((lane & 31) == 0) mrow[i] = shalf;
      }
    }
  }
}
DI void phase_indexer(const Params& p, char* smem) {
  const int tid = otid(p), lane = tid & 63, wave = tid >> 6;
  unsigned* ctr = (unsigned*)(p.ws + OFF_BAR + 15872 + 64);
  volatile LAS int* slot = (volatile LAS int*)((LAS unsigned char*)smem + g8::STAGE_BYTES + 800);
  const int ngroup = NB * (SEQ / 16);
  for (;;) {
    __syncthreads();
    if (tid == 0) *slot = (int)__hip_atomic_fetch_add(ctr, 1u, __ATOMIC_RELAXED, __HIP_MEMORY_SCOPE_AGENT);
    __syncthreads();
    const int g = __builtin_amdgcn_readfirstlane(*slot);
    if (g >= ngroup) break;
    const int b = g & 3, q8 = (SEQ / 16 - 1) - (g >> 2);
    indexer_task(p, b, (q8 * 8 + wave) * 2, lane);
  }
}

constexpr int AT_KROW = 72, AT_VROW = 96;
constexpr int AT_KBYTES = 32 * AT_KROW * 2, AT_STAGE = AT_KBYTES + 32 * AT_VROW * 2;
typedef short s16x4v __attribute__((ext_vector_type(4)));
typedef unsigned u32x4v __attribute__((ext_vector_type(4)));
DI void attn_block(const Params& p, char* smem, int b, int hh, int G) {
  const unsigned short* Qb = (const unsigned short*)(p.ws + OFF_QB);
  const unsigned short* Kb = (const unsigned short*)(p.ws + OFF_KB);
  const unsigned short* Vb = (const unsigned short*)(p.ws + OFF_VT);
  const unsigned* MASK = (const unsigned*)(p.ws + OFF_MASK);
  unsigned short* MIX = (unsigned short*)(p.ws + OFF_MIX);
  LAS unsigned char* lds = (LAS unsigned char*)smem;
  const int tid = otid(p), lane = tid & 63, wave = __builtin_amdgcn_readfirstlane(tid >> 6);
  const int lr = lane & 31, lh = lane >> 5;
  const int qt = 8 * G + wave;
  const int tq = qt * 32 + lr;
  const size_t qtok = (size_t)b * T + NM + tq;
  bf16x8 qf[4];
#pragma unroll
  for (int ks = 0; ks < 4; ++ks) qf[ks] = ld16(Qb + qtok * 512 + hh * 64 + ks * 16 + 8 * lh);
  const unsigned* mrow = MASK + ((size_t)b * SEQ + tq) * 128;
  const int which = tid >> 8, srow = (tid >> 3) & 31, sch = tid & 7;
  const unsigned short* gsrc = (which ? Vb : Kb) + ((size_t)b * T + srow) * 512 + hh * 64 + sch * 8;
  const unsigned sdst = which ? (unsigned)(AT_KBYTES + srow * (AT_VROW * 2) + sch * 16) : (unsigned)(srow * (AT_KROW * 2) + sch * 16);
  const int ntile = 8 * G + 9;
  const unsigned koff = (unsigned)(lr * (AT_KROW * 2) + 16 * lh);
  const unsigned voff = (unsigned)(AT_KBYTES + (4 * lh + ((lane & 15) >> 2)) * (AT_VROW * 2) + (16 * ((lane >> 4) & 1) + 4 * (lane & 3)) * 2);
  __syncthreads();
  {
    const u32x4v st0 = *(const u32x4v*)gsrc;
    *(LAS u32x4v*)(lds + sdst) = st0;
  }
  f32x16 o[2];
#pragma unroll
  for (int i = 0; i < 2; ++i)
#pragma unroll
    for (int r = 0; r < 16; ++r) o[i][r] = 0.f;
  float m = -1e30f, lsum = 0.f;
  const float scale = 0.125f;
  unsigned wnext = mrow[0];
  __syncthreads();
  for (int it = 0; it < ntile; ++it) {
    const int kt = it - 1;
    const bool has_next = it + 1 < ntile;
    u32x4v stg = {0u, 0u, 0u, 0u};
    if (has_next) stg = *(const u32x4v*)(gsrc + (size_t)(NM + 32 * (kt + 1)) * 512);
    if (kt <= qt) {
      const unsigned word = (kt < 0) ? 0x0000ffffu : wnext;
      if (kt >= 0 && kt < qt) wnext = mrow[kt + 1];
      const LAS unsigned char* sb = lds + (it & 1) * AT_STAGE;
      f32x16 s;
#pragma unroll
      for (int r = 0; r < 16; ++r) s[r] = 0.f;
#pragma unroll
      for (int ks = 0; ks < 4; ++ks) {
        const bf16x8 kf = *(const LAS bf16x8*)(sb + koff + ks * 32);
        s = MFMA32(kf, qf[ks], s);
      }
      float tmax = -1e30f;
#pragma unroll
      for (int r = 0; r < 16; ++r) {
        const bool valid = (word >> crow(r, lh)) & 1u;
        s[r] = valid ? s[r] * scale : -1e30f;
        tmax = fmaxf(tmax, s[r]);
      }
      tmax = fmaxf(tmax, xor32f(tmax, lane));
      const float mnew = fmaxf(m, tmax);
      const float alpha = __expf(m - mnew);
      float psum = 0.f;
#pragma unroll
      for (int r = 0; r < 16; ++r) {
        const bool valid = (word >> crow(r, lh)) & 1u;
        const float pv = valid ? __expf(s[r] - mnew) : 0.f;
        s[r] = pv;
        psum += pv;
      }
      psum += xor32f(psum, lane);
      lsum = lsum * alpha + psum;
      m = mnew;
#pragma unroll
      for (int i = 0; i < 2; ++i)
#pragma unroll
        for (int r = 0; r < 16; ++r) o[i][r] *= alpha;
#pragma unroll
      for (int ss = 0; ss < 2; ++ss) {
        const bf16x8 pf = pack8(s, ss);
#pragma unroll
        for (int dt = 0; dt < 2; ++dt) {
          const LAS unsigned char* vp = sb + voff + (16 * ss) * (AT_VROW * 2) + dt * 64;
          const s16x4v lo = __builtin_amdgcn_ds_read_tr16_b64_v4i16((LAS s16x4v*)vp);
          const s16x4v hi = __builtin_amdgcn_ds_read_tr16_b64_v4i16((LAS s16x4v*)(vp + 8 * (AT_VROW * 2)));
          const bf16x8 vf = __builtin_shufflevector(lo, hi, 0, 1, 2, 3, 4, 5, 6, 7);
          o[dt] = MFMA32(vf, pf, o[dt]);
        }
      }
    }
    if (has_next) *(LAS u32x4v*)(lds + ((it + 1) & 1) * AT_STAGE + sdst) = stg;
    __syncthreads();
  }
  const float inv = 1.f / lsum;
#pragma unroll
  for (int dt = 0; dt < 2; ++dt)
#pragma unroll
    for (int r = 0; r < 16; ++r) MIX[qtok * 1024 + hh * 64 + dt * 32 + crow(r, lh)] = f2bf(o[dt][r] * inv);
}
DI void attn_worker(const Params& p, char* smem) {
  unsigned* ctr = (unsigned*)(p.ws + OFF_BAR + 15872);
  volatile LAS int* slot = (volatile LAS int*)((LAS unsigned char*)smem + g8::STAGE_BYTES + 800);
  const int tid = otid(p);
  for (;;) {
    __syncthreads();
    if (tid == 0) *slot = (int)__hip_atomic_fetch_add(ctr, 1u, __ATOMIC_RELAXED, __HIP_MEMORY_SCOPE_AGENT);
    __syncthreads();
    const int k = __builtin_amdgcn_readfirstlane(*slot);
    if (k >= NB * 8 * 16) break;
    const int bh = k & 31, G = 15 - (k >> 5);
    attn_block(p, smem, bh >> 3, bh & 7, G);
  }
}

DI bf16x8 lds8x2(const LAS unsigned short* p0, const LAS unsigned short* p1) {
  typedef unsigned u32x2_t __attribute__((ext_vector_type(2)));
  typedef unsigned u32x4_t __attribute__((ext_vector_type(4)));
  const u32x2_t a = *(const LAS u32x2_t*)p0, b = *(const LAS u32x2_t*)p1;
  const u32x4_t r = {a[0], a[1], b[0], b[1]};
  return __builtin_bit_cast(bf16x8, r);
}
DI void scan_block(const Params& p, char* smem, int bh, const int c0, const int c1) {
  const int tid = otid(p), lane = tid & 63, wave = __builtin_amdgcn_readfirstlane(tid >> 6);
  const int b = bh >> 2, h = bh & 3;
  LAS unsigned char* lds = (LAS unsigned char*)smem;
  const unsigned short* CHB = (const unsigned short*)(p.ws + OFF_WN) + (size_t)bh * NCH * CHB_ELEMS;
  const float* UU = (const float*)(p.ws + OFF_UU) + (size_t)bh * NCH * 8192;
  const float* DL = (const float*)(p.ws + OFF_DL) + (size_t)bh * NCH;
  float* OD = (float*)(p.ws + OFF_OD);
  constexpr int CHB_BYTES = CHB_ELEMS * 2;
  __syncthreads();
  if (wave >= 4) {
    const int w4 = wave - 4;
    for (int c = c0; c <= c1; ++c) {
      if (c < c1) {
        const char* src = (const char*)(CHB + (size_t)c * CHB_ELEMS) + (size_t)(w4 * 15) * 1024 + lane * 16;
        const unsigned dst = (unsigned)((c & 1) * CHB_BYTES + (w4 * 15) * 1024);
#pragma unroll
        for (int j = 0; j < 15; ++j)
          __builtin_amdgcn_global_load_lds((const unsigned*)(src + j * 1024), (LAS unsigned*)(lds + dst + j * 1024), 16, 0, 0);
      }
      asm volatile("s_waitcnt vmcnt(0)" ::: "memory");
      __builtin_amdgcn_s_barrier();
    }
  } else {
    const int sl = wave, lr = lane & 31, lh = lane >> 5, e0 = sl * 32;
    f32x16 S[4];
    float* sst = (float*)(p.ws + OFF_SST) + ((size_t)(bh * 4 + sl) * 64 + lane) * 64;
#pragma unroll
    for (int i = 0; i < 4; ++i)
#pragma unroll
      for (int q = 0; q < 4; ++q) {
        float4 v = make_float4(0.f, 0.f, 0.f, 0.f);
        if (c0 > 0) v = *(const float4*)(sst + i * 16 + q * 4);
        S[i][4 * q] = v.x; S[i][4 * q + 1] = v.y; S[i][4 * q + 2] = v.z; S[i][4 * q + 3] = v.w;
      }
    f32x16 un[2];
    const float* up0 = UU + (size_t)c0 * 8192 + ((size_t)(sl * 2) * 2 + lh) * 512 + lr * 16;
#pragma unroll
    for (int pt = 0; pt < 2; ++pt)
#pragma unroll
      for (int q = 0; q < 4; ++q) {
        const float4 v = *(const float4*)(up0 + pt * 1024 + q * 4);
        un[pt][4 * q] = v.x; un[pt][4 * q + 1] = v.y; un[pt][4 * q + 2] = v.z; un[pt][4 * q + 3] = v.w;
      }
    const int oA = lr * 132 + 4 * lh;
    const int oB = lr * 68 + 4 * lh;
    __builtin_amdgcn_s_barrier();
    for (int c = c0; c < c1; ++c) {
      const LAS unsigned short* cb = (const LAS unsigned short*)(lds + (c & 1) * CHB_BYTES);
      f32x16 vn[2];
      vn[0] = un[0];
      vn[1] = un[1];
#pragma unroll
      for (int pt = 0; pt < 2; ++pt) {
#pragma unroll
        for (int mt = 0; mt < 4; ++mt)
#pragma unroll
          for (int s2 = 0; s2 < 2; ++s2) {
            const LAS unsigned short* ap = cb + oA + pt * 32 * 132 + mt * 32 + 16 * s2;
            vn[pt] = MFMA32(lds8x2(ap, ap + 8), pack8(S[mt], s2), vn[pt]);
          }
      }
      bf16x8 vb[2][2];
#pragma unroll
      for (int pt = 0; pt < 2; ++pt)
#pragma unroll
        for (int s2 = 0; s2 < 2; ++s2) vb[pt][s2] = pack8(vn[pt], s2);
#pragma unroll
      for (int pt = 0; pt < 2; ++pt) {
        f32x16 o;
#pragma unroll
        for (int r = 0; r < 16; ++r) o[r] = 0.f;
#pragma unroll
        for (int mt = 0; mt < 4; ++mt)
#pragma unroll
          for (int s2 = 0; s2 < 2; ++s2) {
            const LAS unsigned short* ap = cb + CH_QG + oA + pt * 32 * 132 + mt * 32 + 16 * s2;
            o = MFMA32(lds8x2(ap, ap + 8), pack8(S[mt], s2), o);
          }
#pragma unroll
        for (int pt2 = 0; pt2 <= pt; ++pt2)
#pragma unroll
          for (int s2 = 0; s2 < 2; ++s2) {
            const LAS unsigned short* ap = cb + CH_IN + oB + pt * 32 * 68 + pt2 * 32 + 16 * s2;
            o = MFMA32(lds8x2(ap, ap + 8), vb[pt2][s2], o);
          }
#pragma unroll
        for (int r = 0; r < 16; ++r) {
          const int t = c * 64 + pt * 32 + crow(r, lh) - 48;
          if (t >= 0) OD[((size_t)(b * T + t)) * 512 + h * 128 + e0 + lr] = o[r];
        }
      }
      if (c + 1 < c1) {
        const float* up = up0 + (size_t)(c + 1 - c0) * 8192;
#pragma unroll
        for (int pt = 0; pt < 2; ++pt)
#pragma unroll
          for (int q = 0; q < 4; ++q) {
            const float4 v = *(const float4*)(up + pt * 1024 + q * 4);
            un[pt][4 * q] = v.x; un[pt][4 * q + 1] = v.y; un[pt][4 * q + 2] = v.z; un[pt][4 * q + 3] = v.w;
          }
      }
      const float dl = DL[c];
#pragma unroll
      for (int mt = 0; mt < 4; ++mt) {
#pragma unroll
        for (int r = 0; r < 16; ++r) S[mt][r] *= dl;
#pragma unroll
        for (int pt2 = 0; pt2 < 2; ++pt2)
#pragma unroll
          for (int s2 = 0; s2 < 2; ++s2) {
            const LAS unsigned short* ap = cb + CH_KDT + oB + mt * 32 * 68 + pt2 * 32 + 16 * s2;
            S[mt] = MFMA32(lds8x2(ap, ap + 8), vb[pt2][s2], S[mt]);
          }
      }
      asm volatile("s_waitcnt lgkmcnt(0)" ::: "memory");
      __builtin_amdgcn_s_barrier();
    }
    if (c1 < NCH) {
#pragma unroll
      for (int i = 0; i < 4; ++i)
#pragma unroll
        for (int q = 0; q < 4; ++q) *(float4*)(sst + i * 16 + q * 4) = make_float4(S[i][4 * q], S[i][4 * q + 1], S[i][4 * q + 2], S[i][4 * q + 3]);
    }
  }
  __syncthreads();
}
DI void phase_scan_attn(const Params& p, char* smem) {
  attn_worker(p, smem);
}

DI void phase_gnorm(const Params& p) {
  const int tid = otid(p), lane = tid & 63, wave = tid >> 6;
  const float* OD = (const float*)(p.ws + OFF_OD);
  const float* P = (const float*)(p.ws + OFF_P);
  unsigned short* MIX = (unsigned short*)(p.ws + OFF_MIX);
  for (int r = blockIdx.x * NWAVES + wave; r < NR; r += gridDim.x * NWAVES) {
    const int tok = r + 16 * (r / SEQ + 1);
#pragma unroll
    for (int hd = 0; hd < 4; ++hd) {
      float o0 = OD[(size_t)tok * 512 + hd * 128 + lane], o1 = OD[(size_t)tok * 512 + hd * 128 + 64 + lane];
      float ss = wave_sum(o0 * o0 + o1 * o1);
      float rstd = rsqrtf(ss * (1.f / 128.f) + 1e-6f);
      float z0 = P[(size_t)tok * INC + C_BZ + hd * 128 + lane], z1 = P[(size_t)tok * INC + C_BZ + hd * 128 + 64 + lane];
      float y0 = o0 * rstd * p.delta_norm_w[lane] * (z0 / (1.f + __expf(-z0)));
      float y1 = o1 * rstd * p.delta_norm_w[64 + lane] * (z1 / (1.f + __expf(-z1)));
      MIX[(size_t)tok * 1024 + 512 + hd * 128 + lane] = f2bf(y0);
      MIX[(size_t)tok * 1024 + 512 + hd * 128 + 64 + lane] = f2bf(y1);
    }
  }
}

DI void phase_router(const Params& p, char* smem) {
  const int tid = otid(p), lane = tid & 63, wave = tid >> 6;
  float* part = (float*)smem;
  float* rstds = part + 8 * 32 * 33;
  int* lhist = (int*)(rstds + 32);
  int* lbase = lhist + 32;
  const float* H1 = (const float*)(p.ws + OFF_H1);
  const float* wrs = (const float*)(p.ws + OFF_WRS);
  unsigned short* U2 = (unsigned short*)(p.ws + OFF_U2);
  int* TOPE = (int*)(p.ws + OFF_TOPE);
  float* GATEV = (float*)(p.ws + OFF_GATEV);
  int* POS = (int*)(p.ws + OFF_POS);
  int* CNT = (int*)(p.ws + OFF_CNT);
  const int lr = lane & 31, lh = lane >> 5;
  float4 nw[4];
#pragma unroll
  for (int i = 0; i < 4; ++i) nw[i] = *(const float4*)(p.norm_ffn_w + lane * 4 + 256 * i);
  for (int task = blockIdx.x; task < NR / 32; task += gridDim.x) {
    const int r0 = task * 32;
    __syncthreads();
    if (tid < 32) lhist[tid] = 0;
    int lp0 = 0, lp1 = 0, lp2 = 0, lp3 = 0, xe0 = 0, xe1 = 0, xe2 = 0, xe3 = 0;
#pragma unroll
    for (int tt = 0; tt < 4; ++tt) {
      const int r = r0 + wave * 4 + tt;
      const float* src = H1 + (size_t)r * 1024;
      float4 v[4];
      float ss = 0.f;
#pragma unroll
      for (int i = 0; i < 4; ++i) {
        v[i] = *(const float4*)(src + lane * 4 + 256 * i);
        ss += v[i].x * v[i].x + v[i].y * v[i].y + v[i].z * v[i].z + v[i].w * v[i].w;
      }
      ss = wave_sum(ss);
      const float rstd = rsqrtf(ss * (1.f / 1024.f) + 1e-6f);
      if (lane == 0) rstds[wave * 4 + tt] = rstd;
#pragma unroll
      for (int i = 0; i < 4; ++i) {
        uint2 o;
        o.x = pk2(v[i].x * rstd * nw[i].x, v[i].y * rstd * nw[i].y);
        o.y = pk2(v[i].z * rstd * nw[i].z, v[i].w * rstd * nw[i].w);
        *(uint2*)(U2 + (size_t)r * 1024 + lane * 4 + 256 * i) = o;
      }
    }
    f32x16 acc;
#pragma unroll
    for (int i = 0; i < 16; ++i) acc[i] = 0.f;
    const float* arow = H1 + (size_t)(r0 + lr) * 1024 + wave * 128;
    const float* bcol = wrs + (size_t)(wave * 128 + lh) * 32 + lr;
#pragma unroll 8
    for (int k0 = 0; k0 < 128; k0 += 4) {
      const float4 a4 = *(const float4*)(arow + k0);
      const float b0 = bcol[(size_t)k0 * 32], b1 = bcol[(size_t)(k0 + 2) * 32];
      acc = __builtin_amdgcn_mfma_f32_32x32x2f32(lh ? a4.y : a4.x, b0, acc, 0, 0, 0);
      acc = __builtin_amdgcn_mfma_f32_32x32x2f32(lh ? a4.w : a4.z, b1, acc, 0, 0, 0);
    }
#pragma unroll
    for (int r = 0; r < 16; ++r) part[(wave * 32 + crow(r, lh)) * 33 + lr] = acc[r];
    __syncthreads();
    if (tid < 32) {
      const float myrstd = rstds[tid];
      float lv[32];
#pragma unroll
      for (int e = 0; e < 32; ++e) {
        float a = 0.f;
#pragma unroll
        for (int w = 0; w < 8; ++w) a += part[(w * 32 + tid) * 33 + e];
        lv[e] = a * myrstd + p.b_router[e];
      }
      float tv[4];
      int te[4];
#pragma unroll
      for (int k = 0; k < 4; ++k) {
        float bv = lv[0];
        int bi = 0;
#pragma unroll
        for (int e = 1; e < 32; ++e)
          if (lv[e] > bv) { bv = lv[e]; bi = e; }
        tv[k] = bv;
        te[k] = bi;
#pragma unroll
        for (int e = 0; e < 32; ++e)
          if (e == bi) lv[e] = -3.0e38f;
      }
      const float e1 = __expf(tv[1] - tv[0]), e2 = __expf(tv[2] - tv[0]), e3 = __expf(tv[3] - tv[0]);
      const float inv = 1.f / (1.f + e1 + e2 + e3);
      const size_t rr = (size_t)(r0 + tid) * 4;
      TOPE[rr + 0] = te[0]; TOPE[rr + 1] = te[1]; TOPE[rr + 2] = te[2]; TOPE[rr + 3] = te[3];
      GATEV[rr + 0] = inv; GATEV[rr + 1] = e1 * inv; GATEV[rr + 2] = e2 * inv; GATEV[rr + 3] = e3 * inv;
      lp0 = atomicAdd(&lhist[te[0]], 1); lp1 = atomicAdd(&lhist[te[1]], 1); lp2 = atomicAdd(&lhist[te[2]], 1); lp3 = atomicAdd(&lhist[te[3]], 1);
      xe0 = te[0]; xe1 = te[1]; xe2 = te[2]; xe3 = te[3];
    }
    __syncthreads();
    if (tid < 32) {
      const int c = lhist[tid];
      lbase[tid] = (c > 0) ? atomicAdd(&CNT[tid * CNTS], c) : 0;
    }
    __syncthreads();
    if (tid < 32) {
      const size_t rr = (size_t)(r0 + tid) * 4;
      POS[rr + 0] = lbase[xe0] + lp0; POS[rr + 1] = lbase[xe1] + lp1; POS[rr + 2] = lbase[xe2] + lp2; POS[rr + 3] = lbase[xe3] + lp3;
    }
  }
}
DI void phase_lists(const Params& p) {
  const int* CNT = (const int*)(p.ws + OFF_CNT);
  const int* TOPE = (const int*)(p.ws + OFF_TOPE);
  const float* GATEV = (const float*)(p.ws + OFF_GATEV);
  const int* POS = (const int*)(p.ws + OFF_POS);
  int* SLOT = (int*)(p.ws + OFF_SLOT);
  int* LTOK = (int*)(p.ws + OFF_LTOK);
  float* LGATE = (float*)(p.ws + OFF_LGATE);
  for (int a = blockIdx.x * NTHREADS + otid(p); a < NASG; a += gridDim.x * NTHREADS) {
    const int e = TOPE[a];
    int off = 0;
    for (int j = 0; j < e; ++j) off += CNT[j * CNTS];
    const int slot = off + POS[a];
    SLOT[a] = slot;
    LTOK[slot] = a >> 2;
    LGATE[slot] = GATEV[a];
  }
}
DI void phase_combine(const Params& p) {
  const float* H1 = (const float*)(p.ws + OFF_H1);
  const unsigned short* Y = (const unsigned short*)(p.ws + OFF_Y);
  const int* SLOT = (const int*)(p.ws + OFF_SLOT);
  for (int idx = blockIdx.x * NTHREADS + otid(p); idx < NR * 256; idx += gridDim.x * NTHREADS) {
    const int r = idx >> 8, c4 = (idx & 255) * 4;
    float4 a = *(const float4*)(H1 + (size_t)r * 1024 + c4);
#pragma unroll
    for (int k = 0; k < 4; ++k) {
      const int slot = SLOT[r * 4 + k];
      uint2 y = *(const uint2*)(Y + (size_t)slot * 1024 + c4);
      a.x += bf2f((unsigned short)(y.x & 0xffffu));
      a.y += bf2f((unsigned short)(y.x >> 16));
      a.z += bf2f((unsigned short)(y.y & 0xffffu));
      a.w += bf2f((unsigned short)(y.y >> 16));
    }
    *(float4*)(p.out + (size_t)r * 1024 + c4) = a;
  }
}


#define XB_TMO      128
#define XB_XCNT(j)  (256  + 64 * (j))
#define XB_XSUB(j)  (1280 + 64 * (j))
#define XB_XGEN(j)  (2304 + 64 * (j))
#define XB_TOP      3328
#define XB_TOPGEN   3392
#define XB_SPIN_CAP (1u << 22)
DI unsigned xb_ld(unsigned* p) { return __hip_atomic_load(p, __ATOMIC_RELAXED, __HIP_MEMORY_SCOPE_AGENT); }
DI unsigned xb_add(unsigned* p, unsigned v) { return __hip_atomic_fetch_add(p, v, __ATOMIC_RELAXED, __HIP_MEMORY_SCOPE_AGENT); }
DI unsigned xb_xcc_id() { return (unsigned)__builtin_amdgcn_s_getreg((3 << 11) | 20) & 0xFu; }
#define XB_SPIN(cond, bar) do { unsigned _sp = 0; while (cond) { __builtin_amdgcn_s_sleep(1); \
    if ((++_sp & 255u) == 0u) { if (xb_ld(&(bar)[XB_TMO])) break; if (_sp > XB_SPIN_CAP) { atomicAdd(&(bar)[XB_TMO], 1u); break; } } } } while (0)
struct XcdBarrier { unsigned* bar; unsigned x; volatile LAS unsigned* st; bool leader; };
DI void xcd_barrier_complete(unsigned* bar, unsigned x, unsigned& nloc, unsigned& nx) {
  const unsigned G = gridDim.x * gridDim.y * gridDim.z;
  unsigned sum, cnt, mine, sp = 0u;
  for (;;) {
    sum = 0u; cnt = 0u; mine = 0u;
#pragma unroll
    for (unsigned j = 0; j < 16; ++j) { const unsigned c = xb_ld(&bar[XB_XCNT(j)]); sum += c; cnt += (c > 0u) ? 1u : 0u; mine = (j == x) ? c : mine; }
    if (sum == G) break;
    __builtin_amdgcn_s_sleep(1);
    if ((++sp & 255u) == 0u) { if (xb_ld(&bar[XB_TMO])) break; if (sp > XB_SPIN_CAP) { atomicAdd(&bar[XB_TMO], 1u); break; } }
  }
  nloc = mine > 0u ? mine : 1u; nx = cnt > 0u ? cnt : 1u;
}
DI void xcd_barrier(const XcdBarrier& b) {
  asm volatile("s_waitcnt vmcnt(0)" ::: "memory");
  __syncthreads();
  if (b.leader) {
    unsigned* bar = b.bar;
    __builtin_amdgcn_s_waitcnt(0);
    unsigned nloc = b.st[0], nx = b.st[1];
    if (nloc == 0u) { xcd_barrier_complete(bar, b.x, nloc, nx); b.st[0] = nloc; b.st[1] = nx; }
    const unsigned old = xb_add(&bar[XB_XSUB(b.x)], 1u);
    const unsigned gen = old / nloc;
    if (old + 1u == (gen + 1u) * nloc) {
      __builtin_amdgcn_fence(__ATOMIC_RELEASE, "agent");
      asm volatile("s_waitcnt vmcnt(0)" ::: "memory");
      const unsigned og = xb_add(&bar[XB_TOP], 1u);
      const unsigned tg = og / nx;
      if (og + 1u == (tg + 1u) * nx) xb_add(&bar[XB_TOPGEN], 1u);
      else XB_SPIN(xb_ld(&bar[XB_TOPGEN]) == tg, bar);
      __builtin_amdgcn_fence(__ATOMIC_ACQUIRE, "agent");
      xb_add(&bar[XB_XGEN(b.x)], 1u);
      asm volatile("s_waitcnt vmcnt(0)" ::: "memory");
    } else {
      XB_SPIN(xb_ld(&bar[XB_XGEN(b.x)]) == gen, bar);
      __builtin_amdgcn_fence(__ATOMIC_ACQUIRE, "agent");
      asm volatile("s_waitcnt vmcnt(0)" ::: "memory");
    }
  }
  __syncthreads();
}

constexpr int SMEM_BYTES = g8::STAGE_BYTES + 1024;

__global__ void __launch_bounds__(NTHREADS) mk(Params p0) {
  __shared__ __attribute__((aligned(16))) char smem[SMEM_BYTES];
  Params p = p0;
  p.wv = __builtin_amdgcn_readfirstlane((int)(threadIdx.x >> 6));
  XcdBarrier xb;
  {
    volatile LAS unsigned* st = (volatile LAS unsigned*)((LAS unsigned char*)smem + g8::STAGE_BYTES + 768);
    if (threadIdx.x == 0) { st[0] = 0u; st[1] = 0u; }
    __syncthreads();
    xb.bar = (unsigned*)(p.ws + OFF_BAR); xb.x = xb_xcc_id(); xb.st = st; xb.leader = (threadIdx.x == 0);
    if (xb.leader) (void)xb_add(&xb.bar[XB_XCNT(xb.x)], 1u);
  }
  phase_prep(p);
  phase_wconv(p, 0, WC_SMALL);
  xcd_barrier(xb);
  g8::gemm_phase<0>(p, smem);
  wconv_fill(p, smem, 0, false);
  xcd_barrier(xb);
  phase_post1(p, smem);
  xcd_barrier(xb);
  g8::gemm_phase<1>(p, smem);
  phase_chunkprep(p, smem);
  wconv_fill(p, smem, 1, false);
  xcd_barrier(xb);
  if (blockIdx.x < 16) scan_block(p, smem, blockIdx.x, 0, NCH);
  phase_post2(p, smem);
  phase_indexer(p, smem);
  wconv_fill(p, smem, 2, false);
  xcd_barrier(xb);
  phase_scan_attn(p, smem);
  wconv_fill(p, smem, 3, false);
  xcd_barrier(xb);
  phase_gnorm(p);
  xcd_barrier(xb);
  g8::gemm_phase<2>(p, smem);
  xcd_barrier(xb);
  phase_router(p, smem);
  xcd_barrier(xb);
  phase_lists(p);
  wconv_fill(p, smem, 4, true);
  xcd_barrier(xb);
  g8::gemm_phase<3>(p, smem);
  xcd_barrier(xb);
  g8::gemm_phase<4>(p, smem);
  xcd_barrier(xb);
  phase_combine(p);
}

extern "C" void kernel_launch(void* const* d_in, const int* in_sizes, int n_in, void* d_out, int out_size, void* d_ws,
                              size_t ws_size, hipStream_t stream) {
  (void)in_sizes; (void)n_in; (void)out_size;
  if (ws_size < WS_NEED) return;
  Params p{};
  p.x = (const float*)d_in[0]; p.meta = (const float*)d_in[1]; p.norm_mix_w = (const float*)d_in[2];
  p.w_in = (const float*)d_in[3]; p.q_norm_w = (const float*)d_in[4]; p.k_norm_w = (const float*)d_in[5];
  p.kv_norm_w = (const float*)d_in[6]; p.w_kv_up = (const float*)d_in[7]; p.conv_w = (const float*)d_in[8];
  p.a_log = (const float*)d_in[9]; p.dt_bias = (const float*)d_in[10]; p.delta_norm_w = (const float*)d_in[11];
  p.w_out = (const float*)d_in[12]; p.norm_ffn_w = (const float*)d_in[13]; p.w_router = (const float*)d_in[14];
  p.b_router = (const float*)d_in[15]; p.w_gate_up = (const float*)d_in[16]; p.b_gate_up = (const float*)d_in[17];
  p.w_down = (const float*)d_in[18]; p.b_down = (const float*)d_in[19];
  p.out = (float*)d_out;
  p.ws = (char*)d_ws;
  (void)hipMemsetAsync((char*)d_ws + OFF_CNT, 0, 4096, stream);
  (void)hipMemsetAsync((char*)d_ws + OFF_BAR, 0, 16384, stream);
  static int grid_blocks = 0;
  if (!grid_blocks) {
    int dev = 0, cus = 0, per_cu = 0;
    (void)hipGetDevice(&dev);
    (void)hipDeviceGetAttribute(&cus, hipDeviceAttributeMultiprocessorCount, dev);
    (void)hipOccupancyMaxActiveBlocksPerMultiprocessor(&per_cu, mk, NTHREADS, 0);
    if (per_cu > 1) per_cu = 1;
    grid_blocks = cus * per_cu;
  }
  void* args[] = {&p};
  hipError_t e = hipLaunchCooperativeKernel((void*)mk, dim3(grid_blocks), dim3(NTHREADS), args, 0, stream);
  if (e != hipSuccess) fprintf(stderr, "cooperative launch failed: %s (grid %d)\n", hipGetErrorString(e), grid_blocks);
}
```

```cpp
#include <hip/hip_runtime.h>
#include <stdint.h>
#include <stdio.h>


typedef __attribute__((ext_vector_type(8))) short bf16x8;
typedef __attribute__((ext_vector_type(4))) short s16x4;
typedef __attribute__((ext_vector_type(16))) float f32x16;
typedef __attribute__((ext_vector_type(4))) float f32x4;
typedef __bf16 bf2_t __attribute__((ext_vector_type(2)));
#define DI __device__ __forceinline__
#define MFMA32(a, b, c) __builtin_amdgcn_mfma_f32_32x32x16_bf16((a), (b), (c), 0, 0, 0)
#define MFMA16(a, b, c) __builtin_amdgcn_mfma_f32_16x16x32_bf16((a), (b), (c), 0, 0, 0)

constexpr int NB = 4, SEQ = 4096, NM = 16, T = 4112, NT = NB * T, NR = NB * SEQ, D = 1024, INC = 3408;
constexpr int C_AQ = 0, C_CKV = 512, C_IQ = 768, C_IK = 1280, C_IW = 1344, C_BQKV = 1352, C_BZ = 2888, C_BBETA = 3400, C_BA = 3404;
constexpr int NCH = 65, NCHT = NB * 4 * NCH;
constexpr int NEXP = 32, NASG = NR * 4;
constexpr int CNTS = 32;
constexpr int NTHREADS = 512, NWAVES = 8;

constexpr size_t al256(size_t x) { return (x + 255) & ~(size_t)255; }
constexpr size_t OFF_U = 0;
constexpr int NTP = 16640;
constexpr size_t OFF_P = OFF_U + al256((size_t)NTP * 1024 * 2);
constexpr size_t OFF_ROPE = OFF_P + al256((size_t)NT * INC * 4);
constexpr size_t OFF_QB = OFF_ROPE + al256((size_t)T * 64 * 4);
constexpr size_t OFF_KB = OFF_QB + al256((size_t)NT * 512 * 2);
constexpr size_t OFF_VT = OFF_KB + al256((size_t)NT * 512 * 2);
constexpr size_t OFF_QI = OFF_VT + al256((size_t)NT * 512 * 2);
constexpr size_t OFF_KI = OFF_QI + al256((size_t)NT * 512 * 2);
constexpr size_t OFF_WI = OFF_KI + al256((size_t)NT * 64 * 2);
constexpr size_t OFF_CKV = OFF_WI + al256((size_t)NT * 8 * 4);
constexpr size_t OFF_KV = OFF_CKV + al256((size_t)NTP * 256 * 2);
constexpr size_t OFF_MASK = OFF_KV + al256((size_t)NT * 1024 * 4);
constexpr size_t OFF_MIX = OFF_MASK + al256((size_t)NB * SEQ * 128 * 4);
constexpr size_t OFF_QD = OFF_MIX + al256((size_t)NT * 1024 * 2);
constexpr size_t OFF_KD = OFF_QD + al256((size_t)NT * 512 * 4);
constexpr size_t OFF_VD = OFF_KD + al256((size_t)NT * 512 * 4);
constexpr size_t OFF_BETA = OFF_VD + al256((size_t)NT * 512 * 4);
constexpr size_t OFF_G = OFF_BETA + al256((size_t)NT * 4 * 4);
constexpr int CHB_ELEMS = 30720, CH_QG = 8448, CH_KDT = 16896, CH_IN = 25600;
constexpr size_t OFF_WN = OFF_G + al256((size_t)NT * 4 * 4);
constexpr size_t OFF_UU = OFF_WN + al256((size_t)NCHT * CHB_ELEMS * 2);
constexpr size_t OFF_DL = OFF_UU + al256((size_t)NCHT * 64 * 128 * 4);
constexpr size_t OFF_OD = OFF_DL + al256((size_t)NCHT * 4);
constexpr size_t OFF_U2 = OFF_OD + al256((size_t)NT * 512 * 4);
constexpr size_t OFF_TOPE = OFF_U2 + al256((size_t)NR * 1024 * 2);
constexpr size_t OFF_GATEV = OFF_TOPE + al256((size_t)NR * 4 * 4);
constexpr size_t OFF_POS = OFF_GATEV + al256((size_t)NR * 4 * 4);
constexpr size_t OFF_SLOT = OFF_POS + al256((size_t)NR * 4 * 4);
constexpr size_t OFF_LTOK = OFF_SLOT + al256((size_t)NR * 4 * 4);
constexpr size_t OFF_LGATE = OFF_LTOK + al256((size_t)NASG * 4);
constexpr size_t OFF_WTIN = OFF_LGATE + al256((size_t)NASG * 4);
constexpr size_t OFF_WTKV = OFF_WTIN + al256((size_t)3584 * 1024 * 2);
constexpr size_t OFF_WTOUT = OFF_WTKV + al256((size_t)1024 * 256 * 2);
constexpr size_t OFF_WTGU = OFF_WTOUT + al256((size_t)1024 * 1024 * 2);
constexpr size_t OFF_WTDN = OFF_WTGU + al256((size_t)32 * 2048 * 1024 * 2);
constexpr size_t OFF_CNT = OFF_WTDN + al256((size_t)32 * 1024 * 1024 * 2);
constexpr size_t OFF_Y = OFF_QD;
static_assert(OFF_U2 - OFF_QD >= (size_t)NASG * 1024 * 2, "Y alias does not fit");
static_assert((size_t)(NASG + 256) * 1024 * 2 <= (size_t)NT * INC * 4, "HD alias does not fit");
constexpr size_t OFF_WRS = OFF_CNT + 4096;
constexpr size_t OFF_SST = OFF_WRS + 131072;
constexpr size_t OFF_BAR = OFF_SST + (size_t)16 * 4 * 64 * 64 * 4;
constexpr size_t WS_NEED = OFF_BAR + 16384;
constexpr size_t OFF_H1 = OFF_KV;
constexpr size_t OFF_HD = OFF_P;

struct Params {
  const float *x, *meta, *norm_mix_w, *w_in, *q_norm_w, *k_norm_w, *kv_norm_w, *w_kv_up, *conv_w, *a_log, *dt_bias,
      *delta_norm_w, *w_out, *norm_ffn_w, *w_router, *b_router, *w_gate_up, *b_gate_up, *w_down, *b_down;
  float* out;
  char* ws;
  int wv;
  int pad0;
};

#define LAS __attribute__((address_space(3)))
constexpr int STAGE_LDS_BYTES = 131072;
DI unsigned pk2(float a, float b) { bf2_t v; v[0] = (__bf16)a; v[1] = (__bf16)b; return __builtin_bit_cast(unsigned, v); }
DI unsigned short f2bf(float a) { return (unsigned short)(pk2(a, 0.f) & 0xffffu); }
DI float bf2f(unsigned short u) { return __uint_as_float(((unsigned)u) << 16); }
template <int CTRL> DI float dppf(float v) { return __builtin_bit_cast(float, __builtin_amdgcn_update_dpp(0, __builtin_bit_cast(int, v), CTRL, 0xf, 0xf, false)); }
template <int CTRL> DI int dppi(int v) { return __builtin_amdgcn_update_dpp(0, v, CTRL, 0xf, 0xf, false); }
DI float rlf(float v, int l) { return __builtin_bit_cast(float, __builtin_amdgcn_readlane(__builtin_bit_cast(int, v), l)); }
DI float wave_sum(float v) {
  v += dppf<0xB1>(v); v += dppf<0x4E>(v); v += dppf<0x141>(v); v += dppf<0x140>(v);
  return (rlf(v, 0) + rlf(v, 16)) + (rlf(v, 32) + rlf(v, 48));
}
DI float xor32f(float v, int lane) {
  auto r = __builtin_amdgcn_permlane32_swap(__builtin_bit_cast(unsigned, v), __builtin_bit_cast(unsigned, v), false, false);
  return __builtin_bit_cast(float, (lane < 32) ? r[1] : r[0]);
}
DI float xor16f(float v, int lane) {
  auto r = __builtin_amdgcn_permlane16_swap(__builtin_bit_cast(unsigned, v), __builtin_bit_cast(unsigned, v), false, false);
  return __builtin_bit_cast(float, (lane & 16) ? r[0] : r[1]);
}
DI int otid(const Params& p) {
  int l;
  asm volatile("v_mbcnt_lo_u32_b32 %0, -1, 0\n\tv_mbcnt_hi_u32_b32 %0, -1, %0" : "=v"(l));
  return (p.wv << 6) | l;
}
DI int swzA(int row, int col) { return row * 132 + col; }
DI int swzB(int row, int col) { return row * 68 + col; }
DI int crow(int reg, int h) { return (reg & 3) + 8 * (reg >> 2) + 4 * h; }
DI bf16x8 pack8(const f32x16& x, int s) {
  uint4 p;
  p.x = pk2(x[8 * s + 0], x[8 * s + 1]); p.y = pk2(x[8 * s + 2], x[8 * s + 3]);
  p.z = pk2(x[8 * s + 4], x[8 * s + 5]); p.w = pk2(x[8 * s + 6], x[8 * s + 7]);
  return __builtin_bit_cast(bf16x8, p);
}
DI bf16x8 ld8x2(const unsigned short* p0, const unsigned short* p1) {
  uint2 a = *(const uint2*)p0, b = *(const uint2*)p1;
  uint4 r = make_uint4(a.x, a.y, b.x, b.y);
  return __builtin_bit_cast(bf16x8, r);
}
DI bf16x8 ld16(const unsigned short* p) { uint4 r = *(const uint4*)p; return __builtin_bit_cast(bf16x8, r); }
DI const float* hrow(const Params& p, int tok) {
  int b = tok / T, t = tok - b * T;
  return (t < NM) ? (p.meta + (size_t)t * D) : (p.x + ((size_t)b * SEQ + (t - NM)) * D);
}

DI void phase_prep(const Params& p) {
  const int tid = otid(p), lane = tid & 63, wave = tid >> 6;
  float* rope = (float*)(p.ws + OFF_ROPE);
  for (int idx = blockIdx.x * NTHREADS + tid; idx < T * 32; idx += gridDim.x * NTHREADS) {
    int t = idx >> 5, i = idx & 31;
    float inv = (float)pow(10000.0, -(double)i / 32.0);
    float ang = (float)t * inv;
    double ad = (double)ang;
    double n = rint(ad * 0.15915494309189535);
    float r = (float)(ad - n * 6.283185307179586);
    float sn, cs;
    sincosf(r, &sn, &cs);
    rope[t * 64 + i] = cs;
    rope[t * 64 + 32 + i] = sn;
  }
  float* wrs = (float*)(p.ws + OFF_WRS);
  for (int idx = blockIdx.x * NTHREADS + tid; idx < 1024 * 32; idx += gridDim.x * NTHREADS) wrs[idx] = p.norm_ffn_w[idx >> 5] * p.w_router[idx];
  unsigned short* U = (unsigned short*)(p.ws + OFF_U);
  for (int tok = blockIdx.x * NWAVES + wave; tok < NT; tok += gridDim.x * NWAVES) {
    const float* src = hrow(p, tok);
    float4 v[4];
    float ss = 0.f;
#pragma unroll
    for (int i = 0; i < 4; ++i) {
      v[i] = *(const float4*)(src + lane * 4 + 256 * i);
      ss += v[i].x * v[i].x + v[i].y * v[i].y + v[i].z * v[i].z + v[i].w * v[i].w;
    }
    ss = wave_sum(ss);
    float rstd = rsqrtf(ss * (1.f / 1024.f) + 1e-6f);
#pragma unroll
    for (int i = 0; i < 4; ++i) {
      float4 w = *(const float4*)(p.norm_mix_w + lane * 4 + 256 * i);
      uint2 o;
      o.x = pk2(v[i].x * rstd * w.x, v[i].y * rstd * w.y);
      o.y = pk2(v[i].z * rstd * w.z, v[i].w * rstd * w.w);
      *(uint2*)(U + (size_t)tok * 1024 + lane * 4 + 256 * i) = o;
    }
  }
}

DI void wconv_task2(const float* src, unsigned short* dst, int K, int N, int k0, int n0, int tid) {
  const int kg = tid >> 6, n = n0 + (tid & 63) * 4, k = k0 + kg * 8;
  float4 v[8];
#pragma unroll
  for (int i = 0; i < 8; ++i) {
    v[i] = make_float4(0.f, 0.f, 0.f, 0.f);
    if (n < N) v[i] = *(const float4*)(src + (size_t)(k + i) * N + n);
  }
  uint4 o;
  o.x = pk2(v[0].x, v[1].x); o.y = pk2(v[2].x, v[3].x); o.z = pk2(v[4].x, v[5].x); o.w = pk2(v[6].x, v[7].x);
  *(uint4*)(dst + (size_t)(n + 0) * K + k) = o;
  o.x = pk2(v[0].y, v[1].y); o.y = pk2(v[2].y, v[3].y); o.z = pk2(v[4].y, v[5].y); o.w = pk2(v[6].y, v[7].y);
  *(uint4*)(dst + (size_t)(n + 1) * K + k) = o;
  o.x = pk2(v[0].z, v[1].z); o.y = pk2(v[2].z, v[3].z); o.z = pk2(v[4].z, v[5].z); o.w = pk2(v[6].z, v[7].z);
  *(uint4*)(dst + (size_t)(n + 2) * K + k) = o;
  o.x = pk2(v[0].w, v[1].w); o.y = pk2(v[2].w, v[3].w); o.z = pk2(v[4].w, v[5].w); o.w = pk2(v[6].w, v[7].w);
  *(uint4*)(dst + (size_t)(n + 3) * K + k) = o;
}
constexpr int WC_IN = 16 * 14, WC_KV = 4 * 4, WC_OUT = 16 * 4, WC_GU = 32 * 128, WC_DN = 32 * 64;
constexpr int WC_SMALL = WC_IN + WC_KV + WC_OUT, WC_ALL = WC_SMALL + WC_GU + WC_DN;
DI void wconv_task(const Params& p, int t, int tid) {
  if (t < WC_IN) {
    wconv_task2(p.w_in, (unsigned short*)(p.ws + OFF_WTIN), 1024, INC, (t / 14) * 64, (t % 14) * 256, tid);
  } else if (t < WC_IN + WC_KV) {
    t -= WC_IN;
    wconv_task2(p.w_kv_up, (unsigned short*)(p.ws + OFF_WTKV), 256, 1024, (t >> 2) * 64, (t & 3) * 256, tid);
  } else if (t < WC_SMALL) {
    t -= WC_IN + WC_KV;
    wconv_task2(p.w_out, (unsigned short*)(p.ws + OFF_WTOUT), 1024, 1024, (t >> 2) * 64, (t & 3) * 256, tid);
  } else if (t < WC_SMALL + WC_GU) {
    t -= WC_SMALL;
    const int e = t >> 7, r = t & 127;
    wconv_task2(p.w_gate_up + (size_t)e * 1024 * 2048, (unsigned short*)(p.ws + OFF_WTGU) + (size_t)e * 2048 * 1024, 1024, 2048,
                (r >> 3) * 64, (r & 7) * 256, tid);
  } else {
    t -= WC_SMALL + WC_GU;
    const int e = t >> 6, r = t & 63;
    wconv_task2(p.w_down + (size_t)e * 1024 * 1024, (unsigned short*)(p.ws + OFF_WTDN) + (size_t)e * 1024 * 1024, 1024, 1024,
                (r >> 2) * 64, (r & 3) * 256, tid);
  }
}
DI void wconv_fill(const Params& p, char* smem, int site, bool drain) {
  unsigned* q = (unsigned*)(p.ws + OFF_BAR + 15872 + 128);
  volatile LAS int* slot = (volatile LAS int*)((LAS unsigned char*)smem + STAGE_LDS_BYTES + 832);
  const int tid = otid(p);
  __syncthreads();
  if (tid == 0 && !drain) (void)__hip_atomic_fetch_add(&q[16 + site], 1u, __ATOMIC_RELAXED, __HIP_MEMORY_SCOPE_AGENT);
  for (;;) {
    __syncthreads();
    if (tid == 0) {
      int t = -1;
      const bool all_done = !drain && __hip_atomic_load(&q[16 + site], __ATOMIC_RELAXED, __HIP_MEMORY_SCOPE_AGENT) >= gridDim.x;
      if (!all_done) t = WC_SMALL + (int)__hip_atomic_fetch_add(&q[0], 1u, __ATOMIC_RELAXED, __HIP_MEMORY_SCOPE_AGENT);
      *slot = t;
    }
    __syncthreads();
    const int t = __builtin_amdgcn_readfirstlane(*slot);
    if (t < 0 || t >= WC_ALL) break;
    wconv_task(p, t, tid);
  }
}
DI void phase_wconv(const Params& p, int t0, int t1) {
  const int tid = otid(p);
  for (int t = t0 + blockIdx.x; t < t1; t += gridDim.x) wconv_task(p, t, tid);
}

namespace g8 {
constexpr int BM = 256, BK = 64, HALF = 128, HTB = HALF * BK * 2, STAGE_BYTES = 8 * HTB, NXCD = 8, WGM = 8;
constexpr int TAB_OFF = STAGE_BYTES;
constexpr int MAXU = 24;
DI int lds_byte(int r, int c) { const int st = (r >> 4) * 2 + (c >> 5), rr = r & 15, cc = c & 31, ob = rr * 64 + cc * 2; return st * 1024 + (ob ^ (((ob >> 9) & 1) << 5)); }
DI void stage_rc(int b, int& R, int& C) { const int st = b / 1024, sb = b % 1024, swz = sb ^ (((sb >> 9) & 1) << 5); R = (st >> 1) * 16 + swz / 64; C = (st & 1) * 32 + (swz % 64) / 2; }
DI int perm32(int rho) { const int n = rho >> 4, i = rho & 15; return 8 * (i >> 2) + 4 * n + (i & 3); }
DI int xcd_remap(int L, int nwg) { const int q = nwg / NXCD, r = nwg % NXCD, xcd = L % NXCD, off = L / NXCD; return (xcd < r ? xcd * (q + 1) : r * (q + 1) + (xcd - r) * q) + off; }
struct UnitT { int valid, arow, mend, pn, e, orow; };

template <int MODE> DI int n_units(const Params& p) {
  if (MODE == 0) return 65 * 14;
  if (MODE == 1) return 65 * 4;
  if (MODE == 2) return 64 * 4;
  const int* cnt = (const int*)(p.ws + OFF_CNT);
  int n = 0;
  for (int e = 0; e < NEXP; ++e) n += ((cnt[e * CNTS] + 255) >> 8) * (MODE == 3 ? 8 : 4);
  return n;
}
template <int MODE> DI void unit_of(const Params& p, int L, int nwg, UnitT& u) {
  u.valid = 0; u.arow = 0; u.mend = 0; u.pn = 0; u.e = 0; u.orow = 0;
  if (L >= nwg) return;
  const int wgid = xcd_remap(L, nwg);
  u.valid = 1;
  if (MODE <= 2) {
    const int nM = (MODE == 2) ? 64 : 65, nN = (MODE == 0) ? 14 : 4;
    const int nig = WGM * nN, gid = wgid / nig, fm = gid * WGM, gsz = (nM - fm) < WGM ? (nM - fm) : WGM;
    const int pm = fm + ((wgid % nig) % gsz);
    u.pn = (wgid % nig) / gsz;
    u.orow = pm * 256;
    u.arow = (MODE == 2) ? (pm * 256 + 16 * (pm / 16 + 1)) : pm * 256;
    u.mend = (MODE == 2) ? NR : NT;
  } else {
    const int* cnt = (const int*)(p.ws + OFF_CNT);
    constexpr int NTN = (MODE == 3) ? 8 : 4;
    int id = wgid, sbase = 0;
    for (int e = 0; e < NEXP; ++e) {
      const int c = cnt[e * CNTS], mts = (c + 255) >> 8, ne = mts * NTN;
      if (id < ne) {
        const int tn = id / mts, tm = id - tn * mts;
        u.e = e; u.pn = tn; u.arow = sbase + tm * 256; u.orow = u.arow; u.mend = sbase + c;
        return;
      }
      id -= ne;
      sbase += c;
    }
    u.valid = 0;
  }
}
DI float swiglu(float g, float u) {
  g = fminf(g, 7.0f);
  u = fminf(fmaxf(u, -7.0f), 7.0f);
  return g / (1.f + __expf(-1.702f * g)) * (u + 1.f);
}
template <int MODE>
DI void epilogue(const Params& p, const f32x4 (&acc)[2][2][4][2], const UnitT& u, int wr, int wc, int fr, int fq) {
  constexpr bool PERM = (MODE >= 3);
  const int row0 = u.orow + wr * 64 + fr;
  const int col0 = u.pn * 256 + wc * 32 + (PERM ? 8 * fq : 4 * fq);
  if (MODE == 0 || MODE == 1 || MODE == 2) {
    float* C = (float*)(p.ws + (MODE == 0 ? OFF_P : MODE == 1 ? OFF_KV : OFF_H1));
    const int ldc = (MODE == 0) ? INC : 1024;
#pragma unroll
    for (int ai = 0; ai < 2; ++ai)
#pragma unroll
      for (int m = 0; m < 4; ++m) {
        const int row = row0 + ai * 128 + m * 16;
        if (row < u.mend) {
#pragma unroll
          for (int bj = 0; bj < 2; ++bj)
#pragma unroll
            for (int n = 0; n < 2; ++n) {
              const int col = col0 + bj * 128 + n * 16;
              if (MODE != 0 || col < INC) {
                f32x4 v = acc[ai][bj][m][n];
                if (MODE == 2) v += *(const f32x4*)(p.x + (size_t)row * D + col);
                *(f32x4*)(C + (size_t)row * ldc + col) = v;
              }
            }
        }
      }
  } else if (MODE == 3) {
    unsigned short* HD = (unsigned short*)(p.ws + OFF_HD);
    f32x4 bv[2][2];
#pragma unroll
    for (int bj = 0; bj < 2; ++bj)
#pragma unroll
      for (int n = 0; n < 2; ++n) bv[bj][n] = *(const f32x4*)(p.b_gate_up + (size_t)u.e * 2048 + col0 + bj * 128 + 4 * n);
#pragma unroll
    for (int ai = 0; ai < 2; ++ai)
#pragma unroll
      for (int m = 0; m < 4; ++m) {
        const int row = row0 + ai * 128 + m * 16;
        if (row < u.mend) {
#pragma unroll
          for (int bj = 0; bj < 2; ++bj) {
            const f32x4 v0 = acc[ai][bj][m][0] + bv[bj][0], v1 = acc[ai][bj][m][1] + bv[bj][1];
            uint2 o;
            o.x = pk2(swiglu(v0[0], v0[1]), swiglu(v0[2], v0[3]));
            o.y = pk2(swiglu(v1[0], v1[1]), swiglu(v1[2], v1[3]));
            *(uint2*)(HD + (size_t)row * 1024 + (col0 + bj * 128) / 2) = o;
          }
        }
      }
  } else {
    unsigned short* Y = (unsigned short*)(p.ws + OFF_Y);
    const float* lgate = (const float*)(p.ws + OFF_LGATE);
    f32x4 bv[2][2];
#pragma unroll
    for (int bj = 0; bj < 2; ++bj)
#pragma unroll
      for (int n = 0; n < 2; ++n) bv[bj][n] = *(const f32x4*)(p.b_down + (size_t)u.e * 1024 + col0 + bj * 128 + 4 * n);
#pragma unroll
    for (int ai = 0; ai < 2; ++ai)
#pragma unroll
      for (int m = 0; m < 4; ++m) {
        const int row = row0 + ai * 128 + m * 16;
        if (row < u.mend) {
          const float gt = lgate[row];
#pragma unroll
          for (int bj = 0; bj < 2; ++bj) {
            const f32x4 v0 = (acc[ai][bj][m][0] + bv[bj][0]) * gt, v1 = (acc[ai][bj][m][1] + bv[bj][1]) * gt;
            uint4 o;
            o.x = pk2(v0[0], v0[1]); o.y = pk2(v0[2], v0[3]); o.z = pk2(v1[0], v1[1]); o.w = pk2(v1[2], v1[3]);
            *(uint4*)(Y + (size_t)row * 1024 + col0 + bj * 128) = o;
          }
        }
      }
  }
}

template <int MODE>
DI void gemm_phase(const Params& p, char* smem) {
  constexpr bool PERM = (MODE >= 3);
  constexpr int K = (MODE == 1) ? 256 : 1024, nt = K / BK;
  LAS unsigned char* lds = (LAS unsigned char*)smem;
  LAS int* tab = (LAS int*)(lds + TAB_OFF);
  const int tid = otid(p), wid = __builtin_amdgcn_readfirstlane(tid >> 6), lane = tid & 63, wr = wid >> 2, wc = wid & 3, fr = lane & 15, fq = lane >> 4;
  __syncthreads();
  {
    const int nwg = n_units<MODE>(p);
    for (int ti = 0; ti < MAXU; ++ti) {
      UnitT u;
      unit_of<MODE>(p, ti * (int)gridDim.x + (int)blockIdx.x, nwg, u);
      if (tid == 0) { tab[ti * 8 + 0] = u.valid; tab[ti * 8 + 1] = u.arow; tab[ti * 8 + 2] = u.mend; tab[ti * 8 + 3] = u.pn; tab[ti * 8 + 4] = u.e; tab[ti * 8 + 5] = u.orow; }
    }
  }
  __syncthreads();
#define G8_GETU(i, u) do { const int _i = (i); (u).valid = (_i < MAXU) ? __builtin_amdgcn_readfirstlane(tab[_i * 8 + 0]) : 0; (u).arow = __builtin_amdgcn_readfirstlane(tab[(_i < MAXU ? _i : 0) * 8 + 1]); \
    (u).mend = __builtin_amdgcn_readfirstlane(tab[(_i < MAXU ? _i : 0) * 8 + 2]); (u).pn = __builtin_amdgcn_readfirstlane(tab[(_i < MAXU ? _i : 0) * 8 + 3]); \
    (u).e = __builtin_amdgcn_readfirstlane(tab[(_i < MAXU ? _i : 0) * 8 + 4]); (u).orow = __builtin_amdgcn_readfirstlane(tab[(_i < MAXU ? _i : 0) * 8 + 5]); } while (0)
  UnitT cur, nxt;
  G8_GETU(0, cur);
  if (!cur.valid) return;
  const char* Abase = (const char*)(p.ws + (MODE == 0 ? OFF_U : MODE == 1 ? OFF_CKV : MODE == 2 ? OFF_MIX : MODE == 3 ? OFF_U2 : OFF_HD));
  const char* Bbase = (const char*)(p.ws + (MODE == 0 ? OFF_WTIN : MODE == 1 ? OFF_WTKV : MODE == 2 ? OFF_WTOUT : MODE == 3 ? OFF_WTGU : OFF_WTDN));
  constexpr size_t BEXP = (MODE == 3) ? (size_t)2048 * 1024 * 2 : (MODE == 4) ? (size_t)1024 * 1024 * 2 : 0;
  int Rr[2], Cc[2];
  unsigned voffB[2];
#pragma unroll
  for (int i = 0; i < 2; ++i) {
    stage_rc(tid * 16 + i * 8192, Rr[i], Cc[i]);
    const int Rb = PERM ? ((Rr[i] & ~31) + perm32(Rr[i] & 31)) : Rr[i];
    voffB[i] = (unsigned)(Rb * K + Cc[i]) * 2u;
  }
  unsigned voffA[2][2];
  const int* ltok = (const int*)(p.ws + OFF_LTOK);
#define G8_VOFFA(dst, un) do { _Pragma("unroll") for (int _h = 0; _h < 2; ++_h) _Pragma("unroll") for (int _i = 0; _i < 2; ++_i) { \
      if (MODE == 3) { int _s = (un).arow + _h * 128 + Rr[_i]; _s = _s < NASG ? _s : NASG - 1; dst[_h][_i] = (unsigned)(ltok[_s] * K + Cc[_i]) * 2u; } \
      else dst[_h][_i] = (unsigned)((_h * 128 + Rr[_i]) * K + Cc[_i]) * 2u; } } while (0)
  const size_t kstep = (size_t)(BK * 2);
  const size_t hstep = (size_t)HALF * K * 2;
  const size_t tstep = 2 * hstep;
  const unsigned ldsw = (unsigned)wid * 1024u;
  const int aoff = lds_byte(wr * 64 + fr, fq * 8), boff = lds_byte(wc * 32 + fr, fq * 8);
#define G8_SA(b, h) (((b) * 2 + (h)) * HTB)
#define G8_SB(b, h) ((4 + (b) * 2 + (h)) * HTB)
#define G8_STAGE(bufoff, gbase, voff) do { _Pragma("unroll") for (int _i = 0; _i < 2; ++_i) \
    __builtin_amdgcn_global_load_lds((const unsigned*)((const char*)(gbase) + (voff)[_i]), (LAS unsigned*)(lds + (bufoff) + ldsw + _i * 8192), 16, 0, 0); } while (0)
#define G8_LDA(dst, b, h) do { _Pragma("unroll") for (int m = 0; m < 4; ++m) _Pragma("unroll") for (int k = 0; k < 2; ++k) dst[m][k] = *(const LAS bf16x8*)(lds + G8_SA(b, h) + aoff + m * 2048 + k * 1024); } while (0)
#define G8_LDB(dst, b, h) do { _Pragma("unroll") for (int n = 0; n < 2; ++n) _Pragma("unroll") for (int k = 0; k < 2; ++k) dst[n][k] = *(const LAS bf16x8*)(lds + G8_SB(b, h) + boff + n * 2048 + k * 1024); } while (0)
#define G8_MMA(ai, bj, At, Bt) do { __builtin_amdgcn_s_setprio(1); _Pragma("unroll") for (int m = 0; m < 4; ++m) _Pragma("unroll") for (int n = 0; n < 2; ++n) _Pragma("unroll") for (int k = 0; k < 2; ++k) \
    acc[ai][bj][m][n] = __builtin_amdgcn_mfma_f32_16x16x32_bf16(Bt[n][k], At[m][k], acc[ai][bj][m][n], 0, 0, 0); __builtin_amdgcn_s_setprio(0); } while (0)
#define G8_WAIT_V(n) asm volatile("s_waitcnt vmcnt(" #n ")" ::: "memory")
#define G8_WAIT_L(n) asm volatile("s_waitcnt lgkmcnt(" #n ")" ::: "memory")
#define G8_BAR __builtin_amdgcn_s_barrier()
#define G8_SCHED __builtin_amdgcn_sched_barrier(0)
  int ui = 0;
  f32x4 acc[2][2][4][2];
#pragma unroll
  for (int a = 0; a < 2; ++a)
#pragma unroll
    for (int b = 0; b < 2; ++b)
#pragma unroll
      for (int m = 0; m < 4; ++m)
#pragma unroll
        for (int n = 0; n < 2; ++n) acc[a][b][m][n] = (f32x4){0.f, 0.f, 0.f, 0.f};
  bf16x8 At[4][2], B0[2][2], B1[2][2];
  G8_VOFFA(voffA, cur);
  if (MODE == 3) asm volatile("s_waitcnt vmcnt(0)" ::: "memory");
  const char* cA = (MODE == 3) ? Abase : Abase + (size_t)cur.arow * K * 2;
  const char* cB = Bbase + (size_t)cur.e * BEXP + (size_t)cur.pn * tstep;
  G8_STAGE(G8_SB(0, 0), cB, voffB); G8_STAGE(G8_SA(0, 0), cA, voffA[0]); G8_STAGE(G8_SB(0, 1), cB + hstep, voffB); G8_STAGE(G8_SA(0, 1), cA, voffA[1]);
  if (wr == 1) G8_BAR;
  G8_WAIT_V(4); G8_BAR;
  G8_STAGE(G8_SB(1, 0), cB + kstep, voffB); G8_STAGE(G8_SA(1, 0), cA + kstep, voffA[0]); G8_STAGE(G8_SB(1, 1), cB + hstep + kstep, voffB);
  G8_WAIT_V(6); G8_BAR;
  for (;;) {
    G8_GETU(ui + 1, nxt);
    const bool has_next = nxt.valid != 0;
    const char* nA = has_next ? ((MODE == 3) ? Abase : Abase + (size_t)nxt.arow * K * 2) : cA;
    const char* nB = has_next ? Bbase + (size_t)nxt.e * BEXP + (size_t)nxt.pn * tstep : cB;
#pragma unroll 1
    for (int t = 0; t < nt; t += 2) {
      const bool last = (t == nt - 2);
      const char* a1 = cA + (size_t)(t + 1) * kstep;
      const char* a2 = last ? nA : cA + (size_t)(t + 2) * kstep;
      const char* b2 = last ? nB : cB + (size_t)(t + 2) * kstep;
      const char* a3 = a2 + kstep;
      const char* b3 = b2 + kstep;
      G8_LDB(B0, 0, 0); G8_SCHED; G8_LDA(At, 0, 0); G8_STAGE(G8_SA(1, 1), a1, voffA[1]);
      if (MODE == 3) {
        if (last && has_next) {
          G8_VOFFA(voffA, nxt);
          asm volatile("s_waitcnt vmcnt(0)" ::: "memory");
        }
      }
      G8_WAIT_L(8); G8_BAR; G8_WAIT_L(0); G8_MMA(0, 0, At, B0); G8_BAR; G8_SCHED;
      G8_LDB(B1, 0, 1); G8_STAGE(G8_SB(0, 0), b2, voffB);
      G8_BAR; G8_WAIT_L(0); G8_MMA(0, 1, At, B1); G8_BAR;
      G8_LDA(At, 0, 1); G8_STAGE(G8_SA(0, 0), a2, voffA[0]);
      G8_BAR; G8_WAIT_L(0); G8_MMA(1, 0, At, B0); G8_BAR; G8_SCHED;
      G8_STAGE(G8_SB(0, 1), b2 + hstep, voffB);
      G8_WAIT_V(6); G8_BAR; G8_MMA(1, 1, At, B1); G8_BAR;
      G8_LDB(B0, 1, 0); G8_SCHED; G8_LDA(At, 1, 0); G8_STAGE(G8_SA(0, 1), a2, voffA[1]);
      G8_WAIT_L(8); G8_BAR; G8_WAIT_L(0); G8_MMA(0, 0, At, B0); G8_BAR; G8_SCHED;
      G8_LDB(B1, 1, 1); G8_STAGE(G8_SB(1, 0), b3, voffB);
      G8_BAR; G8_WAIT_L(0); G8_MMA(0, 1, At, B1); G8_BAR;
      G8_LDA(At, 1, 1); G8_STAGE(G8_SA(1, 0), a3, voffA[0]);
      G8_BAR; G8_WAIT_L(0); G8_MMA(1, 0, At, B0); G8_BAR; G8_SCHED;
      G8_STAGE(G8_SB(1, 1), b3 + hstep, voffB);
      G8_WAIT_V(6); G8_BAR; G8_MMA(1, 1, At, B1); G8_BAR;
    }
    epilogue<MODE>(p, acc, cur, wr, wc, fr, fq);
    if (!has_next) break;
#pragma unroll
    for (int a = 0; a < 2; ++a)
#pragma unroll
      for (int b = 0; b < 2; ++b)
#pragma unroll
        for (int m = 0; m < 4; ++m)
#pragma unroll
          for (int n = 0; n < 2; ++n) acc[a][b][m][n] = (f32x4){0.f, 0.f, 0.f, 0.f};
    cur = nxt; cA = nA; cB = nB; ++ui;
  }
  G8_WAIT_V(0);
  if (wr == 0) G8_BAR;
  G8_BAR;
#undef G8_GETU
#undef G8_VOFFA
#undef G8_SA
#undef G8_SB
#undef G8_STAGE
#undef G8_LDA
#undef G8_LDB
#undef G8_MMA
#undef G8_WAIT_V
#undef G8_WAIT_L
#undef G8_BAR
#undef G8_SCHED
}
}

DI float rope_apply(float v, float c, float s, int lane) {
  float o = xor32f(v, lane);
  return (lane < 32) ? (v * c - o * s) : (v * c + o * s);
}
DI void phase_post1(const Params& p, char* smem) {
  const int tid = otid(p), lane = tid & 63, wave = tid >> 6;
  const float* P = (const float*)(p.ws + OFF_P);
  const float* rope = (const float*)(p.ws + OFF_ROPE);
  unsigned short* Qb = (unsigned short*)(p.ws + OFF_QB);
  unsigned short* QI = (unsigned short*)(p.ws + OFF_QI);
  unsigned short* KI = (unsigned short*)(p.ws + OFF_KI);
  unsigned short* CKV = (unsigned short*)(p.ws + OFF_CKV);
  float* WI = (float*)(p.ws + OFF_WI);
  float* Qd = (float*)(p.ws + OFF_QD);
  float* Kd = (float*)(p.ws + OFF_KD);
  float* Vd = (float*)(p.ws + OFF_VD);
  float* BETA = (float*)(p.ws + OFF_BETA);
  float* G = (float*)(p.ws + OFF_G);
  float* cw = (float*)smem;
  __syncthreads();
  for (int idx = tid; idx < 4 * 1536; idx += NTHREADS) cw[idx] = p.conv_w[idx];
  __syncthreads();
  const float qw = p.q_norm_w[lane];
  const float4 kvw = *(const float4*)(p.kv_norm_w + lane * 4);
  constexpr int PG = 4;
  for (int g = blockIdx.x * NWAVES + wave; g < NT / PG; g += gridDim.x * NWAVES) {
    const int tok0 = g * PG, b = tok0 / T, t0 = tok0 - b * T;
    const int tailc = (lane < 8) ? (C_IW + lane) : (C_BBETA + ((lane - 8) & 7));
    float nqv[8], niv[8];
    float4 nckv;
    float nikv, ntail;
    {
      const float* row = P + (size_t)tok0 * INC;
#pragma unroll
      for (int hh = 0; hh < 8; ++hh) { nqv[hh] = row[C_AQ + hh * 64 + lane]; niv[hh] = row[C_IQ + hh * 64 + lane]; }
      nckv = *(const float4*)(row + C_CKV + lane * 4);
      nikv = row[C_IK + lane];
      ntail = row[tailc];
    }
#pragma unroll 1
    for (int tt = 0; tt < PG; ++tt) {
      const int tok = tok0 + tt, t = t0 + tt;
      float qv[8], iv[8];
#pragma unroll
      for (int hh = 0; hh < 8; ++hh) { qv[hh] = nqv[hh]; iv[hh] = niv[hh]; }
      const float4 ckv = nckv;
      const float ikv = nikv, tailv = ntail;
      if (tt + 1 < PG) {
        const float* row = P + (size_t)(tok + 1) * INC;
#pragma unroll
        for (int hh = 0; hh < 8; ++hh) { nqv[hh] = row[C_AQ + hh * 64 + lane]; niv[hh] = row[C_IQ + hh * 64 + lane]; }
        nckv = *(const float4*)(row + C_CKV + lane * 4);
        nikv = row[C_IK + lane];
        ntail = row[tailc];
      }
      const float cs = rope[t * 64 + (lane & 31)], sn = rope[t * 64 + 32 + (lane & 31)];
      unsigned short* qb = Qb + (size_t)tok * 512 + lane;
      unsigned short* qi = QI + (size_t)tok * 512 + lane;
#pragma unroll
      for (int hh = 0; hh < 8; ++hh) {
        float v = qv[hh];
        const float ss = wave_sum(v * v);
        v = v * rsqrtf(ss * (1.f / 64.f) + 1e-6f) * qw;
        qb[hh * 64] = f2bf(rope_apply(v, cs, sn, lane));
        qi[hh * 64] = f2bf(rope_apply(iv[hh], cs, sn, lane));
      }
      {
        const float ss = wave_sum(ckv.x * ckv.x + ckv.y * ckv.y + ckv.z * ckv.z + ckv.w * ckv.w);
        const float rstd = rsqrtf(ss * (1.f / 256.f) + 1e-6f);
        uint2 o;
        o.x = pk2(ckv.x * rstd * kvw.x, ckv.y * rstd * kvw.y);
        o.y = pk2(ckv.z * rstd * kvw.z, ckv.w * rstd * kvw.w);
        *(uint2*)(CKV + (size_t)tok * 256 + lane * 4) = o;
      }
      KI[(size_t)tok * 64 + lane] = f2bf(rope_apply(ikv, cs, sn, lane));
      if (lane < 8) WI[(size_t)tok * 8 + lane] = tailv * 0.04419417382415922f;
      if (lane >= 8 && lane < 12) BETA[(size_t)tok * 4 + (lane - 8)] = 1.f / (1.f + expf(-tailv));
      if (lane >= 12 && lane < 16) {
        const float xx = tailv + p.dt_bias[lane - 12];
        const float sp = fmaxf(xx, 0.f) + log1pf(expf(-fabsf(xx)));
        G[(size_t)tok * 4 + (lane - 12)] = -expf(p.a_log[lane - 12]) * sp;
      }
    }
    float x0[24], x1[24], x2[24];
    {
      const float* base = P + (size_t)tok0 * INC + C_BQKV + lane;
#pragma unroll
      for (int i = 0; i < 24; ++i) {
        x0[i] = (t0 >= 3) ? base[64 * i - 3 * (ptrdiff_t)INC] : 0.f;
        x1[i] = (t0 >= 2) ? base[64 * i - 2 * (ptrdiff_t)INC] : 0.f;
        x2[i] = (t0 >= 1) ? base[64 * i - 1 * (ptrdiff_t)INC] : 0.f;
      }
    }
    float xn[24];
    {
      const float* xr = P + (size_t)tok0 * INC + C_BQKV + lane;
#pragma unroll
      for (int i = 0; i < 24; ++i) xn[i] = xr[64 * i];
    }
#pragma unroll 1
    for (int tt = 0; tt < PG; ++tt) {
      const int tok = tok0 + tt;
      float x3[24];
#pragma unroll
      for (int i = 0; i < 24; ++i) x3[i] = xn[i];
      if (tt + 1 < PG) {
        const float* xr = P + (size_t)(tok + 1) * INC + C_BQKV + lane;
#pragma unroll
        for (int i = 0; i < 24; ++i) xn[i] = xr[64 * i];
      }
      int cl = lane;
      asm volatile("" : "+v"(cl));
      float* qd = Qd + (size_t)tok * 512 + lane;
      float* kd = Kd + (size_t)tok * 512 + lane;
      float* vd = Vd + (size_t)tok * 512 + lane;
#pragma unroll
      for (int hd = 0; hd < 4; ++hd) {
        float cv[6];
#pragma unroll
        for (int q = 0; q < 6; ++q) {
          const int i = (q >> 1) * 8 + 2 * hd + (q & 1);
          const int c = cl + 64 * i;
          const float a = cw[c] * x0[i] + cw[1536 + c] * x1[i] + cw[2 * 1536 + c] * x2[i] + cw[3 * 1536 + c] * x3[i];
          cv[q] = a / (1.f + __expf(-a));
          x0[i] = x1[i]; x1[i] = x2[i]; x2[i] = x3[i];
        }
        float ss = wave_sum(cv[0] * cv[0] + cv[1] * cv[1]);
        float r = rsqrtf(ss + 1e-6f);
        qd[hd * 128] = cv[0] * r;
        qd[hd * 128 + 64] = cv[1] * r;
        ss = wave_sum(cv[2] * cv[2] + cv[3] * cv[3]);
        r = rsqrtf(ss + 1e-6f);
        kd[hd * 128] = cv[2] * r;
        kd[hd * 128 + 64] = cv[3] * r;
        vd[hd * 128] = cv[4];
        vd[hd * 128 + 64] = cv[5];
      }
    }
  }
}

DI void phase_post2(const Params& p, char* smem) {
  (void)smem;
  const int tid = otid(p), lane = tid & 63, wave = tid >> 6;
  const float* KV = (const float*)(p.ws + OFF_KV);
  const float* rope = (const float*)(p.ws + OFF_ROPE);
  unsigned short* Kb = (unsigned short*)(p.ws + OFF_KB);
  unsigned short* Vb = (unsigned short*)(p.ws + OFF_VT);
  const float kw = p.k_norm_w[lane];
  for (int tok = blockIdx.x * NWAVES + wave; tok < NT; tok += gridDim.x * NWAVES) {
    const int b = tok / T, t = tok - b * T;
    const float* row = KV + (size_t)tok * 1024;
    float kv[8], vv[8];
#pragma unroll
    for (int hh = 0; hh < 8; ++hh) { kv[hh] = row[hh * 64 + lane]; vv[hh] = row[512 + hh * 64 + lane]; }
    const float cs = rope[t * 64 + (lane & 31)], sn = rope[t * 64 + 32 + (lane & 31)];
    unsigned short* kb = Kb + (size_t)tok * 512 + lane;
    unsigned short* vb = Vb + (size_t)tok * 512 + lane;
#pragma unroll
    for (int hh = 0; hh < 8; ++hh) {
      float v = kv[hh];
      const float ss = wave_sum(v * v);
      v = v * rsqrtf(ss * (1.f / 64.f) + 1e-6f) * kw;
      kb[hh * 64] = f2bf(rope_apply(v, cs, sn, lane));
      vb[hh * 64] = f2bf(vv[hh]);
    }
  }
}

constexpr int KS_STRIDE = 129, AM_STRIDE = 65;
DI void phase_chunkprep(const Params& p, char* smem) {
  float* Ks = (float*)smem;
  float* Qs = Ks + 64 * KS_STRIDE;
  float* Am = Qs + 64 * KS_STRIDE;
  float* Tm = Am + 64 * AM_STRIDE;
  float* gc = Tm + 64 * AM_STRIDE;
  float* bet = gc + 64;
  float* gl = bet + 64;
  unsigned short* T16 = (unsigned short*)(gl + 64);
  float* Mt = (float*)T16;
  unsigned short* VbT = T16 + 64 * 72;
  unsigned short* KbT = (unsigned short*)Qs;
  static_assert((64 * KS_STRIDE * 2 + 64 * AM_STRIDE * 2 + 192) * 4 + (64 * 72 + 128 * 72) * 2 <= 131072, "chunk prep LDS");
  const int tid = otid(p), lane = tid & 63, wave = tid >> 6;
  const float* Qd = (const float*)(p.ws + OFF_QD);
  const float* Kd = (const float*)(p.ws + OFF_KD);
  const float* Vd = (const float*)(p.ws + OFF_VD);
  const float* BETA = (const float*)(p.ws + OFF_BETA);
  const float* G = (const float*)(p.ws + OFF_G);
  unsigned short* CHB = (unsigned short*)(p.ws + OFF_WN);
  float* UU = (float*)(p.ws + OFF_UU);
  float* DL = (float*)(p.ws + OFF_DL);
  for (int ci = blockIdx.x; ci < NCHT; ci += gridDim.x) {
    unsigned short* chb = CHB + (size_t)ci * CHB_ELEMS;
    const int bh = ci / NCH, c = ci - bh * NCH, b = bh >> 2, h = bh & 3;
    __syncthreads();
    if (tid < 64) {
      int t = c * 64 + tid - 48;
      float g = 0.f, be = 0.f;
      if (t >= 0) { g = G[(size_t)(b * T + t) * 4 + h]; be = BETA[(size_t)(b * T + t) * 4 + h]; }
      gl[tid] = g;
      bet[tid] = be;
    }
    float vreg[16];
#pragma unroll
    for (int it = 0; it < 16; ++it) {
      const int idx = tid + it * NTHREADS, i = idx >> 7, d = idx & 127;
      const int t = c * 64 + i - 48;
      float kv = 0.f, qv = 0.f, vv = 0.f;
      if (t >= 0) {
        const size_t o = ((size_t)(b * T + t)) * 512 + h * 128 + d;
        kv = Kd[o];
        qv = Qd[o] * 0.08838834764831845f;
        vv = Vd[o];
      }
      Ks[i * KS_STRIDE + d] = kv;
      Qs[i * KS_STRIDE + d] = qv;
      vreg[it] = vv;
    }
    __syncthreads();
    if (tid < 64) {
      float s2 = 0.f;
      for (int j = 0; j <= tid; ++j) s2 += gl[j];
      gc[tid] = s2;
    }
    __syncthreads();
    {
      const int i = tid >> 3, jb = tid & 7;
      float akk[8], aqk[8];
#pragma unroll
      for (int jj = 0; jj < 8; ++jj) { akk[jj] = 0.f; aqk[jj] = 0.f; }
      for (int d = 0; d < 128; ++d) {
        float ki = Ks[i * KS_STRIDE + d], qi = Qs[i * KS_STRIDE + d];
#pragma unroll
        for (int jj = 0; jj < 8; ++jj) {
          float kj = Ks[(jb + 8 * jj) * KS_STRIDE + d];
          akk[jj] += ki * kj;
          aqk[jj] += qi * kj;
        }
      }
      const float gi = gc[i], bi = bet[i];
#pragma unroll
      for (int jj = 0; jj < 8; ++jj) {
        int j = jb + 8 * jj;
        float dec = (j <= i) ? __expf(gi - gc[j]) : 0.f;
        Am[i * AM_STRIDE + j] = (j < i) ? bi * akk[jj] * dec : 0.f;
        chb[CH_IN + swzB(i, j)] = f2bf((j <= i) ? aqk[jj] * dec : 0.f);
      }
    }
    for (int idx = tid; idx < 64 * 128; idx += NTHREADS) {
      int i = idx >> 7, d = idx & 127;
      chb[CH_QG + swzA(i, d)] = f2bf(Qs[i * KS_STRIDE + d] * __expf(gc[i]));
    }
    __syncthreads();
#pragma unroll
    for (int it = 0; it < 16; ++it) {
      const int idx = tid + it * NTHREADS, i = idx >> 7, d = idx & 127;
      const float bi = bet[i];
      VbT[d * 72 + i] = f2bf(bi * vreg[it]);
      KbT[d * 72 + i] = f2bf(bi * __expf(gc[i]) * Ks[i * KS_STRIDE + d]);
    }
    {
      for (int idx = tid; idx < 64 * 64; idx += NTHREADS) Tm[(idx >> 6) * AM_STRIDE + (idx & 63)] = 0.f;
      __syncthreads();
      if (tid < 64) {
        const int bb = tid >> 4, cc = tid & 15, o = 16 * bb;
        float x[16];
#pragma unroll
        for (int i = 0; i < 16; ++i) {
          float a = (i == cc) ? 1.f : 0.f;
#pragma unroll
          for (int j = 0; j < 16; ++j)
            if (j < i) a -= Am[(o + i) * AM_STRIDE + o + j] * x[j];
          x[i] = a;
          Tm[(o + i) * AM_STRIDE + o + cc] = a;
        }
      }
      __syncthreads();
      {
        const int B = tid >> 8, i = (tid >> 4) & 15, j = tid & 15, o = 32 * B;
        float m = 0.f;
#pragma unroll
        for (int k = 0; k < 16; ++k) m += Am[(o + 16 + i) * AM_STRIDE + o + k] * Tm[(o + k) * AM_STRIDE + o + j];
        Mt[(B * 16 + i) * 33 + j] = m;
        __syncthreads();
        float t = 0.f;
#pragma unroll
        for (int k = 0; k < 16; ++k) t += Tm[(o + 16 + i) * AM_STRIDE + o + 16 + k] * Mt[(B * 16 + k) * 33 + j];
        __syncthreads();
        Tm[(o + 16 + i) * AM_STRIDE + o + j] = -t;
      }
      __syncthreads();
      {
        const int i = tid >> 4, j0 = (tid & 15) * 2;
        float m0 = 0.f, m1 = 0.f;
        for (int k = 0; k < 32; ++k) {
          const float a = Am[(32 + i) * AM_STRIDE + k];
          m0 += a * Tm[k * AM_STRIDE + j0];
          m1 += a * Tm[k * AM_STRIDE + j0 + 1];
        }
        Mt[i * 33 + j0] = m0;
        Mt[i * 33 + j0 + 1] = m1;
        __syncthreads();
        float t0 = 0.f, t1 = 0.f;
        for (int k = 0; k < 32; ++k) {
          const float a = Tm[(32 + i) * AM_STRIDE + 32 + k];
          t0 += a * Mt[k * 33 + j0];
          t1 += a * Mt[k * 33 + j0 + 1];
        }
        __syncthreads();
        Tm[(32 + i) * AM_STRIDE + j0] = -t0;
        Tm[(32 + i) * AM_STRIDE + j0 + 1] = -t1;
      }
    }
    __syncthreads();
    for (int idx = tid; idx < 64 * 64; idx += NTHREADS) T16[(idx >> 6) * 72 + (idx & 63)] = f2bf(Tm[(idx >> 6) * AM_STRIDE + (idx & 63)]);
    __syncthreads();
    {
      const int mat = wave >> 2, nt = wave & 3, lr = lane & 31, lh = lane >> 5;
      const unsigned short* Bt = mat ? KbT : VbT;
#pragma unroll
      for (int mt = 0; mt < 2; ++mt) {
        f32x16 acc;
#pragma unroll
        for (int r = 0; r < 16; ++r) acc[r] = 0.f;
#pragma unroll
        for (int ks = 0; ks < 4; ++ks) {
          const bf16x8 af = ld16(T16 + (mt * 32 + lr) * 72 + ks * 16 + 8 * lh);
          const bf16x8 bfr = ld16(Bt + (nt * 32 + lr) * 72 + ks * 16 + 8 * lh);
          acc = MFMA32(af, bfr, acc);
        }
        if (mat == 0) {
          float* up = UU + (size_t)ci * 8192 + (((nt * 2 + mt) * 2 + lh) * 32 + lr) * 16;
#pragma unroll
          for (int q = 0; q < 4; ++q) *(float4*)(up + 4 * q) = make_float4(acc[4 * q], acc[4 * q + 1], acc[4 * q + 2], acc[4 * q + 3]);
        } else {
#pragma unroll
          for (int r = 0; r < 16; ++r) chb[swzA(mt * 32 + crow(r, lh), nt * 32 + lr)] = f2bf(-acc[r]);
        }
      }
    }
    const float glast = gc[63];
    for (int idx = tid; idx < 64 * 128; idx += NTHREADS) {
      int i = idx & 63, d = idx >> 6;
      chb[CH_KDT + swzB(d, i)] = f2bf(Ks[i * KS_STRIDE + d] * __expf(glast - gc[i]));
    }
    if (tid == 0) DL[ci] = __expf(glast);
  }
}

DI float relu_fma(float w, float x, float acc) {
  const int xi = __builtin_bit_cast(int, x);
  const float m = __builtin_bit_cast(float, xi > 0 ? xi : 0);
  return __builtin_fmaf(w, m, acc);
}
DI unsigned ordkey(float f) {
  unsigned u = __float_as_uint(f);
  return (u & 0x80000000u) ? ~u : (u | 0x80000000u);
}
DI int half_sum(int v) {
  v += dppi<0xB1>(v); v += dppi<0x4E>(v); v += dppi<0x141>(v); v += dppi<0x140>(v);
  const int lo = __builtin_amdgcn_readlane(v, 0) + __builtin_amdgcn_readlane(v, 16);
  const int hi = __builtin_amdgcn_readlane(v, 32) + __builtin_amdgcn_readlane(v, 48);
  return (__builtin_amdgcn_mbcnt_hi(~0u, __builtin_amdgcn_mbcnt_lo(~0u, 0u)) < 32u) ? lo : hi;
}
DI int cnt4_ge(int cnt, unsigned a, unsigned b, unsigned c, unsigned d, unsigned cand) {
  unsigned long long m0, m1, m2, m3;
  asm("v_cmp_ge_u32_e64 %1, %5, %9\n\tv_cmp_ge_u32_e64 %2, %6, %9\n\tv_cmp_ge_u32_e64 %3, %7, %9\n\tv_cmp_ge_u32_e64 %4, %8, %9\n\t"
      "v_addc_co_u32_e64 %0, %1, %0, 0, %1\n\tv_addc_co_u32_e64 %0, %2, %0, 0, %2\n\tv_addc_co_u32_e64 %0, %3, %0, 0, %3\n\tv_addc_co_u32_e64 %0, %4, %0, 0, %4"
      : "+v"(cnt), "=&s"(m0), "=&s"(m1), "=&s"(m2), "=&s"(m3)
      : "v"(a), "v"(b), "v"(c), "v"(d), "v"(cand));
  return cnt;
}
DI int cnt4_gt(int cnt, unsigned a, unsigned b, unsigned c, unsigned d, unsigned cand) {
  unsigned long long m0, m1, m2, m3;
  asm("v_cmp_gt_u32_e64 %1, %5, %9\n\tv_cmp_gt_u32_e64 %2, %6, %9\n\tv_cmp_gt_u32_e64 %3, %7, %9\n\tv_cmp_gt_u32_e64 %4, %8, %9\n\t"
      "v_addc_co_u32_e64 %0, %1, %0, 0, %1\n\tv_addc_co_u32_e64 %0, %2, %0, 0, %2\n\tv_addc_co_u32_e64 %0, %3, %0, 0, %3\n\tv_addc_co_u32_e64 %0, %4, %0, 0, %4"
      : "+v"(cnt), "=&s"(m0), "=&s"(m1), "=&s"(m2), "=&s"(m3)
      : "v"(a), "v"(b), "v"(c), "v"(d), "v"(cand));
  return cnt;
}
DI void indexer_task(const Params& p, char* smem, int b, int q8, int wave, int lane) {
  const int q0 = (q8 * 8 + wave) * 2;
  unsigned* MASK = (unsigned*)(p.ws + OFF_MASK);
  const int qsel = lane >> 5;
  const int tq = q0 + qsel;
  unsigned* mrow = MASK + ((size_t)b * SEQ + tq) * 128;
  if (q8 < 16) {
    for (int i = (lane & 31); i < 128; i += 32) {
      int rem = tq + 1 - 32 * i;
      unsigned w = (rem >= 32) ? 0xffffffffu : (rem > 0 ? ((1u << rem) - 1u) : 0u);
      mrow[i] = w;
    }
    return;
  }
  const unsigned short* QI = (const unsigned short*)(p.ws + OFF_QI);
  const unsigned short* KI = (const unsigned short*)(p.ws + OFF_KI);
  const float* WI = (const float*)(p.ws + OFF_WI);
  const int l15 = lane & 15, lg = lane >> 4;
  const size_t qtok = (size_t)b * T + NM + q0 + (l15 >> 3);
  const bf16x8 a0 = ld16(QI + qtok * 512 + (l15 & 7) * 64 + 8 * lg);
  const bf16x8 a1 = ld16(QI + qtok * 512 + (l15 & 7) * 64 + 32 + 8 * lg);
  float w[4];
  {
    const size_t wtok = (size_t)b * T + NM + q0 + (lg >> 1);
#pragma unroll
    for (int r = 0; r < 4; ++r) w[r] = WI[wtok * 8 + 4 * (lg & 1) + r];
  }
  const int npairs = (q0 + 2 + 31) >> 5;
  const int npmax = (16 * q8 + 16 + 31) >> 5;
  LAS unsigned char* lds = (LAS unsigned char*)smem;
  const bool loader = wave < 4;
  const unsigned short* ksrc = KI + ((size_t)b * T + NM + 8 * wave + (lane >> 3)) * 64 + (((lane & 7) ^ (lane >> 3)) << 3);
  const unsigned frag0 = (unsigned)(l15 * 128 + ((lg ^ (l15 & 7)) << 4));
  const unsigned frag1 = (unsigned)(l15 * 128 + (((4 + lg) ^ (l15 & 7)) << 4));
  asm volatile("s_waitcnt vmcnt(0)" ::: "memory");
  __syncthreads();
#define IX_DMA(stage) __builtin_amdgcn_global_load_lds((const unsigned*)(ksrc + (size_t)(stage) * 2048), (LAS unsigned*)(lds + ((stage) & 3) * 4096 + wave * 1024), 16, 0, 0)
  if (loader) {
    IX_DMA(0);
    if (1 < npmax) IX_DMA(1);
    if (2 < npmax) IX_DMA(2);
  }
  unsigned u[128];
  int rem = tq - (lane & 31);
#pragma unroll
  for (int i = 0; i < 128; ++i) {
    unsigned uv = 0u;
    if (i < npmax) {
      if (loader) {
        if (i + 2 < npmax) asm volatile("s_waitcnt vmcnt(2)" ::: "memory");
        else if (i + 1 < npmax) asm volatile("s_waitcnt vmcnt(1)" ::: "memory");
        else asm volatile("s_waitcnt vmcnt(0)" ::: "memory");
      }
      __builtin_amdgcn_s_barrier();
      if (loader && i + 3 < npmax) IX_DMA(i + 3);
      if (i < npairs) {
        const LAS unsigned char* sb = lds + (i & 3) * 4096;
        float tot[2];
#pragma unroll
        for (int par = 0; par < 2; ++par) {
          const bf16x8 b0 = *(const LAS bf16x8*)(sb + par * 2048 + frag0);
          const bf16x8 b1 = *(const LAS bf16x8*)(sb + par * 2048 + frag1);
          f32x4 acc = {0.f, 0.f, 0.f, 0.f};
          acc = MFMA16(a0, b0, acc);
          acc = MFMA16(a1, b1, acc);
          float part = 0.f;
#pragma unroll
          for (int r = 0; r < 4; ++r) part = relu_fma(w[r], acc[r], part);
          tot[par] = part + xor16f(part, lane);
        }
        const float sc = (lg & 1) ? tot[1] : tot[0];
        uv = (rem >= 0) ? ordkey(sc) : 0u;
      }
    }
    u[i] = uv;
    rem -= 32;
    asm volatile("" : "+v"(rem));
  }
#undef IX_DMA
  __builtin_amdgcn_s_barrier();
  const int nblk = (npairs + 15) >> 4;
  unsigned thr = 0u;
  bool done = false;
  for (int bit = 31; bit >= 0; --bit) {
    const unsigned cand = thr | (1u << bit);
    int cnt = 0;
#pragma unroll
    for (int blk = 0; blk < 8; ++blk) {
      if (blk < nblk) {
#pragma unroll
        for (int j = 0; j < 16; j += 4) cnt = cnt4_ge(cnt, u[blk * 16 + j], u[blk * 16 + j + 1], u[blk * 16 + j + 2], u[blk * 16 + j + 3], cand);
      }
    }
    cnt = half_sum(cnt);
    if (!done && cnt >= 256) thr = cand;
    done = done || (cnt == 256);
    if (__all(done)) break;
  }
  int cgt = 0;
#pragma unroll
  for (int blk = 0; blk < 8; ++blk) {
    if (blk < nblk) {
#pragma unroll
      for (int j = 0; j < 16; j += 4) cgt = cnt4_gt(cgt, u[blk * 16 + j], u[blk * 16 + j + 1], u[blk * 16 + j + 2], u[blk * 16 + j + 3], thr);
    }
  }
  cgt = half_sum(cgt);
  const int need = 256 - cgt;
  int base = 0;
  const unsigned lt_mask = (1u << (lane & 31)) - 1u;
#pragma unroll
  for (int blk = 0; blk < 8; ++blk) {
    if (blk < nblk) {
#pragma unroll
      for (int j = 0; j < 16; ++j) {
        const int i = blk * 16 + j;
        const bool eq = (u[i] == thr);
        const unsigned long long eb = __ballot(eq);
        const unsigned ehalf = qsel ? (unsigned)(eb >> 32) : (unsigned)eb;
        const int below = __popc(ehalf & lt_mask);
        const bool sel = (u[i] > thr) || (eq && (base + below < need));
        base += __popc(ehalf);
        const unsigned long long sb = __ballot(sel);
        const unsigned shalf = qsel ? (unsigned)(sb >> 32) : (unsigned)sb;
        if ((lane & 31) == 0) mrow[i] = shalf;
      }
    }
  }
}
DI void phase_indexer(const Params& p, char* smem) {
  const int tid = otid(p), lane = tid & 63, wave = __builtin_amdgcn_readfirstlane(tid >> 6);
  unsigned* ctr = (unsigned*)(p.ws + OFF_BAR + 15872 + 64);
  volatile LAS int* slot = (volatile LAS int*)((LAS unsigned char*)smem + g8::STAGE_BYTES + 800);
  const int ngroup = NB * (SEQ / 16);
  for (;;) {
    __syncthreads();
    if (tid == 0) *slot = (int)__hip_atomic_fetch_add(ctr, 1u, __ATOMIC_RELAXED, __HIP_MEMORY_SCOPE_AGENT);
    __syncthreads();
    const int g = __builtin_amdgcn_readfirstlane(*slot);
    if (g >= ngroup) break;
    const int b = g & 3, q8 = (SEQ / 16 - 1) - (g >> 2);
    indexer_task(p, smem, b, q8, wave, lane);
  }
}

constexpr int AT_KROW = 72, AT_VROW = 96;
constexpr int AT_KBYTES = 32 * AT_KROW * 2, AT_STAGE = AT_KBYTES + 32 * AT_VROW * 2;
typedef short s16x4v __attribute__((ext_vector_type(4)));
typedef unsigned u32x4v __attribute__((ext_vector_type(4)));
DI void attn_block(const Params& p, char* smem, int b, int hh, int G) {
  const unsigned short* Qb = (const unsigned short*)(p.ws + OFF_QB);
  const unsigned short* Kb = (const unsigned short*)(p.ws + OFF_KB);
  const unsigned short* Vb = (const unsigned short*)(p.ws + OFF_VT);
  const unsigned* MASK = (const unsigned*)(p.ws + OFF_MASK);
  unsigned short* MIX = (unsigned short*)(p.ws + OFF_MIX);
  LAS unsigned char* lds = (LAS unsigned char*)smem;
  const int tid = otid(p), lane = tid & 63, wave = __builtin_amdgcn_readfirstlane(tid >> 6);
  const int lr = lane & 31, lh = lane >> 5;
  const int qt = 8 * G + wave;
  const int tq = qt * 32 + lr;
  const size_t qtok = (size_t)b * T + NM + tq;
  bf16x8 qf[4];
#pragma unroll
  for (int ks = 0; ks < 4; ++ks) qf[ks] = ld16(Qb + qtok * 512 + hh * 64 + ks * 16 + 8 * lh);
  const unsigned* mrow = MASK + ((size_t)b * SEQ + tq) * 128;
  const int which = tid >> 8, srow = (tid >> 3) & 31, sch = tid & 7;
  const unsigned short* gsrc = (which ? Vb : Kb) + ((size_t)b * T + srow) * 512 + hh * 64 + sch * 8;
  const unsigned sdst = which ? (unsigned)(AT_KBYTES + srow * (AT_VROW * 2) + sch * 16) : (unsigned)(srow * (AT_KROW * 2) + sch * 16);
  const int ntile = 8 * G + 9;
  const unsigned koff = (unsigned)(lr * (AT_KROW * 2) + 16 * lh);
  const unsigned voff = (unsigned)(AT_KBYTES + (4 * lh + ((lane & 15) >> 2)) * (AT_VROW * 2) + (16 * ((lane >> 4) & 1) + 4 * (lane & 3)) * 2);
  __syncthreads();
  {
    const u32x4v st0 = *(const u32x4v*)gsrc;
    *(LAS u32x4v*)(lds + sdst) = st0;
  }
  u32x4v stg = {0u, 0u, 0u, 0u};
  if (ntile > 1) stg = *(const u32x4v*)(gsrc + (size_t)NM * 512);
  f32x16 o[2];
#pragma unroll
  for (int i = 0; i < 2; ++i)
#pragma unroll
    for (int r = 0; r < 16; ++r) o[i][r] = 0.f;
  float m = -1e30f, lsum = 0.f;
  const float sl2 = 0.125f * 1.4426950408889634f;
  unsigned wnext = mrow[0];
  __syncthreads();
  for (int it = 0; it < ntile; ++it) {
    const int kt = it - 1;
    const bool has_next = it + 1 < ntile;
    u32x4v stg2 = {0u, 0u, 0u, 0u};
    if (it + 2 < ntile) stg2 = *(const u32x4v*)(gsrc + (size_t)(NM + 32 * (kt + 2)) * 512);
    if (kt <= qt) {
      const unsigned word = (kt < 0) ? 0x0000ffffu : wnext;
      if (kt >= 0 && kt < qt) wnext = mrow[kt + 1];
      const LAS unsigned char* sb = lds + (it & 1) * AT_STAGE;
      f32x16 s;
#pragma unroll
      for (int r = 0; r < 16; ++r) s[r] = 0.f;
#pragma unroll
      for (int ks = 0; ks < 4; ++ks) {
        const bf16x8 kf = *(const LAS bf16x8*)(sb + koff + ks * 32);
        s = MFMA32(kf, qf[ks], s);
      }
      const unsigned wsh = word >> (4 * lh);
      float tmax = -1e30f;
#pragma unroll
      for (int r = 0; r < 16; ++r) {
        const bool valid = (wsh >> ((r & 3) + 8 * (r >> 2))) & 1u;
        s[r] = valid ? s[r] * sl2 : -1e30f;
        tmax = fmaxf(tmax, s[r]);
      }
      tmax = fmaxf(tmax, xor32f(tmax, lane));
      if (!__all(tmax <= m)) {
        const float mnew = fmaxf(m, tmax);
        const float alpha = __builtin_amdgcn_exp2f(m - mnew);
        lsum *= alpha;
        m = mnew;
#pragma unroll
        for (int i = 0; i < 2; ++i)
#pragma unroll
          for (int r = 0; r < 16; ++r) o[i][r] *= alpha;
      }
      float psum = 0.f;
#pragma unroll
      for (int r = 0; r < 16; ++r) {
        const float pv = __builtin_amdgcn_exp2f(s[r] - m);
        s[r] = pv;
        psum += pv;
      }
      psum += xor32f(psum, lane);
      lsum += psum;
#pragma unroll
      for (int ss = 0; ss < 2; ++ss) {
        const bf16x8 pf = pack8(s, ss);
#pragma unroll
        for (int dt = 0; dt < 2; ++dt) {
          const LAS unsigned char* vp = sb + voff + (16 * ss) * (AT_VROW * 2) + dt * 64;
          const s16x4v lo = __builtin_amdgcn_ds_read_tr16_b64_v4i16((LAS s16x4v*)vp);
          const s16x4v hi = __builtin_amdgcn_ds_read_tr16_b64_v4i16((LAS s16x4v*)(vp + 8 * (AT_VROW * 2)));
          const bf16x8 vf = __builtin_shufflevector(lo, hi, 0, 1, 2, 3, 4, 5, 6, 7);
          o[dt] = MFMA32(vf, pf, o[dt]);
        }
      }
    }
    if (has_next) *(LAS u32x4v*)(lds + ((it + 1) & 1) * AT_STAGE + sdst) = stg;
    stg = stg2;
    __syncthreads();
  }
  const float inv = 1.f / lsum;
#pragma unroll
  for (int dt = 0; dt < 2; ++dt)
#pragma unroll
    for (int r = 0; r < 16; ++r) MIX[qtok * 1024 + hh * 64 + dt * 32 + crow(r, lh)] = f2bf(o[dt][r] * inv);
}
DI void attn_worker(const Params& p, char* smem) {
  unsigned* ctr = (unsigned*)(p.ws + OFF_BAR + 15872);
  volatile LAS int* slot = (volatile LAS int*)((LAS unsigned char*)smem + g8::STAGE_BYTES + 800);
  const int tid = otid(p);
  for (;;) {
    __syncthreads();
    if (tid == 0) *slot = (int)__hip_atomic_fetch_add(ctr, 1u, __ATOMIC_RELAXED, __HIP_MEMORY_SCOPE_AGENT);
    __syncthreads();
    const int k = __builtin_amdgcn_readfirstlane(*slot);
    if (k >= NB * 8 * 16) break;
    const int bh = k & 31, G = 15 - (k >> 5);
    attn_block(p, smem, bh >> 3, bh & 7, G);
  }
}

DI bf16x8 lds8x2(const LAS unsigned short* p0, const LAS unsigned short* p1) {
  typedef unsigned u32x2_t __attribute__((ext_vector_type(2)));
  typedef unsigned u32x4_t __attribute__((ext_vector_type(4)));
  const u32x2_t a = *(const LAS u32x2_t*)p0, b = *(const LAS u32x2_t*)p1;
  const u32x4_t r = {a[0], a[1], b[0], b[1]};
  return __builtin_bit_cast(bf16x8, r);
}
DI void scan_block(const Params& p, char* smem, int bh, const int c0, const int c1) {
  const int tid = otid(p), lane = tid & 63, wave = __builtin_amdgcn_readfirstlane(tid >> 6);
  const int b = bh >> 2, h = bh & 3;
  LAS unsigned char* lds = (LAS unsigned char*)smem;
  const unsigned short* CHB = (const unsigned short*)(p.ws + OFF_WN) + (size_t)bh * NCH * CHB_ELEMS;
  const float* UU = (const float*)(p.ws + OFF_UU) + (size_t)bh * NCH * 8192;
  const float* DL = (const float*)(p.ws + OFF_DL) + (size_t)bh * NCH;
  float* OD = (float*)(p.ws + OFF_OD);
  constexpr int CHB_BYTES = CHB_ELEMS * 2;
  __syncthreads();
  if (wave >= 4) {
    const int w4 = wave - 4;
    for (int c = c0; c <= c1; ++c) {
      if (c < c1) {
        const char* src = (const char*)(CHB + (size_t)c * CHB_ELEMS) + (size_t)(w4 * 15) * 1024 + lane * 16;
        const unsigned dst = (unsigned)((c & 1) * CHB_BYTES + (w4 * 15) * 1024);
#pragma unroll
        for (int j = 0; j < 15; ++j)
          __builtin_amdgcn_global_load_lds((const unsigned*)(src + j * 1024), (LAS unsigned*)(lds + dst + j * 1024), 16, 0, 0);
      }
      asm volatile("s_waitcnt vmcnt(0)" ::: "memory");
      __builtin_amdgcn_s_barrier();
    }
  } else {
    const int sl = wave, lr = lane & 31, lh = lane >> 5, e0 = sl * 32;
    f32x16 S[4];
    float* sst = (float*)(p.ws + OFF_SST) + ((size_t)(bh * 4 + sl) * 64 + lane) * 64;
#pragma unroll
    for (int i = 0; i < 4; ++i)
#pragma unroll
      for (int q = 0; q < 4; ++q) {
        float4 v = make_float4(0.f, 0.f, 0.f, 0.f);
        if (c0 > 0) v = *(const float4*)(sst + i * 16 + q * 4);
        S[i][4 * q] = v.x; S[i][4 * q + 1] = v.y; S[i][4 * q + 2] = v.z; S[i][4 * q + 3] = v.w;
      }
    f32x16 un[2];
    const float* up0 = UU + (size_t)c0 * 8192 + ((size_t)(sl * 2) * 2 + lh) * 512 + lr * 16;
#pragma unroll
    for (int pt = 0; pt < 2; ++pt)
#pragma unroll
      for (int q = 0; q < 4; ++q) {
        const float4 v = *(const float4*)(up0 + pt * 1024 + q * 4);
        un[pt][4 * q] = v.x; un[pt][4 * q + 1] = v.y; un[pt][4 * q + 2] = v.z; un[pt][4 * q + 3] = v.w;
      }
    const int oA = lr * 132 + 4 * lh;
    const int oB = lr * 68 + 4 * lh;
    __builtin_amdgcn_s_barrier();
    for (int c = c0; c < c1; ++c) {
      const LAS unsigned short* cb = (const LAS unsigned short*)(lds + (c & 1) * CHB_BYTES);
      f32x16 vn[2];
      vn[0] = un[0];
      vn[1] = un[1];
#pragma unroll
      for (int pt = 0; pt < 2; ++pt) {
#pragma unroll
        for (int mt = 0; mt < 4; ++mt)
#pragma unroll
          for (int s2 = 0; s2 < 2; ++s2) {
            const LAS unsigned short* ap = cb + oA + pt * 32 * 132 + mt * 32 + 16 * s2;
            vn[pt] = MFMA32(lds8x2(ap, ap + 8), pack8(S[mt], s2), vn[pt]);
          }
      }
      bf16x8 vb[2][2];
#pragma unroll
      for (int pt = 0; pt < 2; ++pt)
#pragma unroll
        for (int s2 = 0; s2 < 2; ++s2) vb[pt][s2] = pack8(vn[pt], s2);
#pragma unroll
      for (int pt = 0; pt < 2; ++pt) {
        f32x16 o;
#pragma unroll
        for (int r = 0; r < 16; ++r) o[r] = 0.f;
#pragma unroll
        for (int mt = 0; mt < 4; ++mt)
#pragma unroll
          for (int s2 = 0; s2 < 2; ++s2) {
            const LAS unsigned short* ap = cb + CH_QG + oA + pt * 32 * 132 + mt * 32 + 16 * s2;
            o = MFMA32(lds8x2(ap, ap + 8), pack8(S[mt], s2), o);
          }
#pragma unroll
        for (int pt2 = 0; pt2 <= pt; ++pt2)
#pragma unroll
          for (int s2 = 0; s2 < 2; ++s2) {
            const LAS unsigned short* ap = cb + CH_IN + oB + pt * 32 * 68 + pt2 * 32 + 16 * s2;
            o = MFMA32(lds8x2(ap, ap + 8), vb[pt2][s2], o);
          }
#pragma unroll
        for (int r = 0; r < 16; ++r) {
          const int t = c * 64 + pt * 32 + crow(r, lh) - 48;
          if (t >= 0) OD[((size_t)(b * T + t)) * 512 + h * 128 + e0 + lr] = o[r];
        }
      }
      if (c + 1 < c1) {
        const float* up = up0 + (size_t)(c + 1 - c0) * 8192;
#pragma unroll
        for (int pt = 0; pt < 2; ++pt)
#pragma unroll
          for (int q = 0; q < 4; ++q) {
            const float4 v = *(const float4*)(up + pt * 1024 + q * 4);
            un[pt][4 * q] = v.x; un[pt][4 * q + 1] = v.y; un[pt][4 * q + 2] = v.z; un[pt][4 * q + 3] = v.w;
          }
      }
      const float dl = DL[c];
#pragma unroll
      for (int mt = 0; mt < 4; ++mt) {
#pragma unroll
        for (int r = 0; r < 16; ++r) S[mt][r] *= dl;
#pragma unroll
        for (int pt2 = 0; pt2 < 2; ++pt2)
#pragma unroll
          for (int s2 = 0; s2 < 2; ++s2) {
            const LAS unsigned short* ap = cb + CH_KDT + oB + mt * 32 * 68 + pt2 * 32 + 16 * s2;
            S[mt] = MFMA32(lds8x2(ap, ap + 8), vb[pt2][s2], S[mt]);
          }
      }
      asm volatile("s_waitcnt lgkmcnt(0)" ::: "memory");
      __builtin_amdgcn_s_barrier();
    }
    if (c1 < NCH) {
#pragma unroll
      for (int i = 0; i < 4; ++i)
#pragma unroll
        for (int q = 0; q < 4; ++q) *(float4*)(sst + i * 16 + q * 4) = make_float4(S[i][4 * q], S[i][4 * q + 1], S[i][4 * q + 2], S[i][4 * q + 3]);
    }
  }
  __syncthreads();
}
DI void phase_scan_attn(const Params& p, char* smem) {
  attn_worker(p, smem);
}

DI void phase_gnorm(const Params& p) {
  const int tid = otid(p), lane = tid & 63, wave = tid >> 6;
  const float* OD = (const float*)(p.ws + OFF_OD);
  const float* P = (const float*)(p.ws + OFF_P);
  unsigned short* MIX = (unsigned short*)(p.ws + OFF_MIX);
  for (int r = blockIdx.x * NWAVES + wave; r < NR; r += gridDim.x * NWAVES) {
    const int tok = r + 16 * (r / SEQ + 1);
#pragma unroll
    for (int hd = 0; hd < 4; ++hd) {
      float o0 = OD[(size_t)tok * 512 + hd * 128 + lane], o1 = OD[(size_t)tok * 512 + hd * 128 + 64 + lane];
      float ss = wave_sum(o0 * o0 + o1 * o1);
      float rstd = rsqrtf(ss * (1.f / 128.f) + 1e-6f);
      float z0 = P[(size_t)tok * INC + C_BZ + hd * 128 + lane], z1 = P[(size_t)tok * INC + C_BZ + hd * 128 + 64 + lane];
      float y0 = o0 * rstd * p.delta_norm_w[lane] * (z0 / (1.f + __expf(-z0)));
      float y1 = o1 * rstd * p.delta_norm_w[64 + lane] * (z1 / (1.f + __expf(-z1)));
      MIX[(size_t)tok * 1024 + 512 + hd * 128 + lane] = f2bf(y0);
      MIX[(size_t)tok * 1024 + 512 + hd * 128 + 64 + lane] = f2bf(y1);
    }
  }
}

DI void phase_router(const Params& p, char* smem) {
  const int tid = otid(p), lane = tid & 63, wave = tid >> 6;
  float* part = (float*)smem;
  float* rstds = part + 8 * 32 * 33;
  int* lhist = (int*)(rstds + 32);
  int* lbase = lhist + 32;
  const float* H1 = (const float*)(p.ws + OFF_H1);
  const float* wrs = (const float*)(p.ws + OFF_WRS);
  unsigned short* U2 = (unsigned short*)(p.ws + OFF_U2);
  int* TOPE = (int*)(p.ws + OFF_TOPE);
  float* GATEV = (float*)(p.ws + OFF_GATEV);
  int* POS = (int*)(p.ws + OFF_POS);
  int* CNT = (int*)(p.ws + OFF_CNT);
  const int lr = lane & 31, lh = lane >> 5;
  float4 nw[4];
#pragma unroll
  for (int i = 0; i < 4; ++i) nw[i] = *(const float4*)(p.norm_ffn_w + lane * 4 + 256 * i);
  for (int task = blockIdx.x; task < NR / 32; task += gridDim.x) {
    const int r0 = task * 32;
    __syncthreads();
    if (tid < 32) lhist[tid] = 0;
    int lp0 = 0, lp1 = 0, lp2 = 0, lp3 = 0, xe0 = 0, xe1 = 0, xe2 = 0, xe3 = 0;
#pragma unroll
    for (int tt = 0; tt < 4; ++tt) {
      const int r = r0 + wave * 4 + tt;
      const float* src = H1 + (size_t)r * 1024;
      float4 v[4];
      float ss = 0.f;
#pragma unroll
      for (int i = 0; i < 4; ++i) {
        v[i] = *(const float4*)(src + lane * 4 + 256 * i);
        ss += v[i].x * v[i].x + v[i].y * v[i].y + v[i].z * v[i].z + v[i].w * v[i].w;
      }
      ss = wave_sum(ss);
      const float rstd = rsqrtf(ss * (1.f / 1024.f) + 1e-6f);
      if (lane == 0) rstds[wave * 4 + tt] = rstd;
#pragma unroll
      for (int i = 0; i < 4; ++i) {
        uint2 o;
        o.x = pk2(v[i].x * rstd * nw[i].x, v[i].y * rstd * nw[i].y);
        o.y = pk2(v[i].z * rstd * nw[i].z, v[i].w * rstd * nw[i].w);
        *(uint2*)(U2 + (size_t)r * 1024 + lane * 4 + 256 * i) = o;
      }
    }
    f32x16 acc;
#pragma unroll
    for (int i = 0; i < 16; ++i) acc[i] = 0.f;
    const float* arow = H1 + (size_t)(r0 + lr) * 1024 + wave * 128;
    const float* bcol = wrs + (size_t)(wave * 128 + lh) * 32 + lr;
#pragma unroll 8
    for (int k0 = 0; k0 < 128; k0 += 4) {
      const float4 a4 = *(const float4*)(arow + k0);
      const float b0 = bcol[(size_t)k0 * 32], b1 = bcol[(size_t)(k0 + 2) * 32];
      acc = __builtin_amdgcn_mfma_f32_32x32x2f32(lh ? a4.y : a4.x, b0, acc, 0, 0, 0);
      acc = __builtin_amdgcn_mfma_f32_32x32x2f32(lh ? a4.w : a4.z, b1, acc, 0, 0, 0);
    }
#pragma unroll
    for (int r = 0; r < 16; ++r) part[(wave * 32 + crow(r, lh)) * 33 + lr] = acc[r];
    __syncthreads();
    if (tid < 32) {
      const float myrstd = rstds[tid];
      float lv[32];
#pragma unroll
      for (int e = 0; e < 32; ++e) {
        float a = 0.f;
#pragma unroll
        for (int w = 0; w < 8; ++w) a += part[(w * 32 + tid) * 33 + e];
        lv[e] = a * myrstd + p.b_router[e];
      }
      float tv[4];
      int te[4];
#pragma unroll
      for (int k = 0; k < 4; ++k) {
        float bv = lv[0];
        int bi = 0;
#pragma unroll
        for (int e = 1; e < 32; ++e)
          if (lv[e] > bv) { bv = lv[e]; bi = e; }
        tv[k] = bv;
        te[k] = bi;
#pragma unroll
        for (int e = 0; e < 32; ++e)
          if (e == bi) lv[e] = -3.0e38f;
      }
      const float e1 = __expf(tv[1] - tv[0]), e2 = __expf(tv[2] - tv[0]), e3 = __expf(tv[3] - tv[0]);
      const float inv = 1.f / (1.f + e1 + e2 + e3);
      const size_t rr = (size_t)(r0 + tid) * 4;
      TOPE[rr + 0] = te[0]; TOPE[rr + 1] = te[1]; TOPE[rr + 2] = te[2]; TOPE[rr + 3] = te[3];
      GATEV[rr + 0] = inv; GATEV[rr + 1] = e1 * inv; GATEV[rr + 2] = e2 * inv; GATEV[rr + 3] = e3 * inv;
      lp0 = atomicAdd(&lhist[te[0]], 1); lp1 = atomicAdd(&lhist[te[1]], 1); lp2 = atomicAdd(&lhist[te[2]], 1); lp3 = atomicAdd(&lhist[te[3]], 1);
      xe0 = te[0]; xe1 = te[1]; xe2 = te[2]; xe3 = te[3];
    }
    __syncthreads();
    if (tid < 32) {
      const int c = lhist[tid];
      lbase[tid] = (c > 0) ? atomicAdd(&CNT[tid * CNTS], c) : 0;
    }
    __syncthreads();
    if (tid < 32) {
      const size_t rr = (size_t)(r0 + tid) * 4;
      POS[rr + 0] = lbase[xe0] + lp0; POS[rr + 1] = lbase[xe1] + lp1; POS[rr + 2] = lbase[xe2] + lp2; POS[rr + 3] = lbase[xe3] + lp3;
    }
  }
}
DI void phase_lists(const Params& p) {
  const int* CNT = (const int*)(p.ws + OFF_CNT);
  const int* TOPE = (const int*)(p.ws + OFF_TOPE);
  const float* GATEV = (const float*)(p.ws + OFF_GATEV);
  const int* POS = (const int*)(p.ws + OFF_POS);
  int* SLOT = (int*)(p.ws + OFF_SLOT);
  int* LTOK = (int*)(p.ws + OFF_LTOK);
  float* LGATE = (float*)(p.ws + OFF_LGATE);
  for (int a = blockIdx.x * NTHREADS + otid(p); a < NASG; a += gridDim.x * NTHREADS) {
    const int e = TOPE[a];
    int off = 0;
    for (int j = 0; j < e; ++j) off += CNT[j * CNTS];
    const int slot = off + POS[a];
    SLOT[a] = slot;
    LTOK[slot] = a >> 2;
    LGATE[slot] = GATEV[a];
  }
}
DI void phase_combine(const Params& p) {
  const float* H1 = (const float*)(p.ws + OFF_H1);
  const unsigned short* Y = (const unsigned short*)(p.ws + OFF_Y);
  const int* SLOT = (const int*)(p.ws + OFF_SLOT);
  for (int idx = blockIdx.x * NTHREADS + otid(p); idx < NR * 256; idx += gridDim.x * NTHREADS) {
    const int r = idx >> 8, c4 = (idx & 255) * 4;
    float4 a = *(const float4*)(H1 + (size_t)r * 1024 + c4);
#pragma unroll
    for (int k = 0; k < 4; ++k) {
      const int slot = SLOT[r * 4 + k];
      uint2 y = *(const uint2*)(Y + (size_t)slot * 1024 + c4);
      a.x += bf2f((unsigned short)(y.x & 0xffffu));
      a.y += bf2f((unsigned short)(y.x >> 16));
      a.z += bf2f((unsigned short)(y.y & 0xffffu));
      a.w += bf2f((unsigned short)(y.y >> 16));
    }
    *(float4*)(p.out + (size_t)r * 1024 + c4) = a;
  }
}


#define XB_TMO      128
#define XB_XCNT(j)  (256  + 64 * (j))
#define XB_XSUB(j)  (1280 + 64 * (j))
#define XB_XGEN(j)  (2304 + 64 * (j))
#define XB_TOP      3328
#define XB_TOPGEN   3392
#define XB_SPIN_CAP (1u << 22)
DI unsigned xb_ld(unsigned* p) { return __hip_atomic_load(p, __ATOMIC_RELAXED, __HIP_MEMORY_SCOPE_AGENT); }
DI unsigned xb_add(unsigned* p, unsigned v) { return __hip_atomic_fetch_add(p, v, __ATOMIC_RELAXED, __HIP_MEMORY_SCOPE_AGENT); }
DI unsigned xb_xcc_id() { return (unsigned)__builtin_amdgcn_s_getreg((3 << 11) | 20) & 0xFu; }
#define XB_SPIN(cond, bar) do { unsigned _sp = 0; while (cond) { __builtin_amdgcn_s_sleep(1); \
    if ((++_sp & 255u) == 0u) { if (xb_ld(&(bar)[XB_TMO])) break; if (_sp > XB_SPIN_CAP) { atomicAdd(&(bar)[XB_TMO], 1u); break; } } } } while (0)
struct XcdBarrier { unsigned* bar; unsigned x; volatile LAS unsigned* st; bool leader; };
DI void xcd_barrier_complete(unsigned* bar, unsigned x, unsigned& nloc, unsigned& nx) {
  const unsigned G = gridDim.x * gridDim.y * gridDim.z;
  unsigned sum, cnt, mine, sp = 0u;
  for (;;) {
    sum = 0u; cnt = 0u; mine = 0u;
#pragma unroll
    for (unsigned j = 0; j < 16; ++j) { const unsigned c = xb_ld(&bar[XB_XCNT(j)]); sum += c; cnt += (c > 0u) ? 1u : 0u; mine = (j == x) ? c : mine; }
    if (sum == G) break;
    __builtin_amdgcn_s_sleep(1);
    if ((++sp & 255u) == 0u) { if (xb_ld(&bar[XB_TMO])) break; if (sp > XB_SPIN_CAP) { atomicAdd(&bar[XB_TMO], 1u); break; } }
  }
  nloc = mine > 0u ? mine : 1u; nx = cnt > 0u ? cnt : 1u;
}
DI void xcd_barrier(const XcdBarrier& b) {
  asm volatile("s_waitcnt vmcnt(0)" ::: "memory");
  __syncthreads();
  if (b.leader) {
    unsigned* bar = b.bar;
    __builtin_amdgcn_s_waitcnt(0);
    unsigned nloc = b.st[0], nx = b.st[1];
    if (nloc == 0u) { xcd_barrier_complete(bar, b.x, nloc, nx); b.st[0] = nloc; b.st[1] = nx; }
    const unsigned old = xb_add(&bar[XB_XSUB(b.x)], 1u);
    const unsigned gen = old / nloc;
    if (old + 1u == (gen + 1u) * nloc) {
      __builtin_amdgcn_fence(__ATOMIC_RELEASE, "agent");
      asm volatile("s_waitcnt vmcnt(0)" ::: "memory");
      const unsigned og = xb_add(&bar[XB_TOP], 1u);
      const unsigned tg = og / nx;
      if (og + 1u == (tg + 1u) * nx) xb_add(&bar[XB_TOPGEN], 1u);
      else XB_SPIN(xb_ld(&bar[XB_TOPGEN]) == tg, bar);
      __builtin_amdgcn_fence(__ATOMIC_ACQUIRE, "agent");
      xb_add(&bar[XB_XGEN(b.x)], 1u);
      asm volatile("s_waitcnt vmcnt(0)" ::: "memory");
    } else {
      XB_SPIN(xb_ld(&bar[XB_XGEN(b.x)]) == gen, bar);
      __builtin_amdgcn_fence(__ATOMIC_ACQUIRE, "agent");
      asm volatile("s_waitcnt vmcnt(0)" ::: "memory");
    }
  }
  __syncthreads();
}

constexpr int SMEM_BYTES = g8::STAGE_BYTES + 1024;

__global__ void __launch_bounds__(NTHREADS) mk(Params p0) {
  __shared__ __attribute__((aligned(16))) char smem[SMEM_BYTES];
  Params p = p0;
  p.wv = __builtin_amdgcn_readfirstlane((int)(threadIdx.x >> 6));
  XcdBarrier xb;
  {
    volatile LAS unsigned* st = (volatile LAS unsigned*)((LAS unsigned char*)smem + g8::STAGE_BYTES + 768);
    if (threadIdx.x == 0) { st[0] = 0u; st[1] = 0u; }
    __syncthreads();
    xb.bar = (unsigned*)(p.ws + OFF_BAR); xb.x = xb_xcc_id(); xb.st = st; xb.leader = (threadIdx.x == 0);
    if (xb.leader) (void)xb_add(&xb.bar[XB_XCNT(xb.x)], 1u);
  }
  phase_prep(p);
  phase_wconv(p, 0, WC_SMALL);
  xcd_barrier(xb);
  g8::gemm_phase<0>(p, smem);
  wconv_fill(p, smem, 0, false);
  xcd_barrier(xb);
  phase_post1(p, smem);
  xcd_barrier(xb);
  g8::gemm_phase<1>(p, smem);
  phase_chunkprep(p, smem);
  wconv_fill(p, smem, 1, false);
  xcd_barrier(xb);
  if (blockIdx.x < 16) scan_block(p, smem, blockIdx.x, 0, NCH);
  phase_post2(p, smem);
  phase_indexer(p, smem);
  wconv_fill(p, smem, 2, false);
  xcd_barrier(xb);
  phase_scan_attn(p, smem);
  wconv_fill(p, smem, 3, false);
  xcd_barrier(xb);
  phase_gnorm(p);
  xcd_barrier(xb);
  g8::gemm_phase<2>(p, smem);
  xcd_barrier(xb);
  phase_router(p, smem);
  xcd_barrier(xb);
  phase_lists(p);
  wconv_fill(p, smem, 4, true);
  xcd_barrier(xb);
  g8::gemm_phase<3>(p, smem);
  xcd_barrier(xb);
  g8::gemm_phase<4>(p, smem);
  xcd_barrier(xb);
  phase_combine(p);
}

extern "C" void kernel_launch(void* const* d_in, const int* in_sizes, int n_in, void* d_out, int out_size, void* d_ws,
                              size_t ws_size, hipStream_t stream) {
  (void)in_sizes; (void)n_in; (void)out_size;
  if (ws_size < WS_NEED) return;
  Params p{};
  p.x = (const float*)d_in[0]; p.meta = (const float*)d_in[1]; p.norm_mix_w = (const float*)d_in[2];
  p.w_in = (const float*)d_in[3]; p.q_norm_w = (const float*)d_in[4]; p.k_norm_w = (const float*)d_in[5];
  p.kv_norm_w = (const float*)d_in[6]; p.w_kv_up = (const float*)d_in[7]; p.conv_w = (const float*)d_in[8];
  p.a_log = (const float*)d_in[9]; p.dt_bias = (const float*)d_in[10]; p.delta_norm_w = (const float*)d_in[11];
  p.w_out = (const float*)d_in[12]; p.norm_ffn_w = (const float*)d_in[13]; p.w_router = (const float*)d_in[14];
  p.b_router = (const float*)d_in[15]; p.w_gate_up = (const float*)d_in[16]; p.b_gate_up = (const float*)d_in[17];
  p.w_down = (const float*)d_in[18]; p.b_down = (const float*)d_in[19];
  p.out = (float*)d_out;
  p.ws = (char*)d_ws;
  (void)hipMemsetAsync((char*)d_ws + OFF_CNT, 0, 4096, stream);
  (void)hipMemsetAsync((char*)d_ws + OFF_BAR, 0, 16384, stream);
  static int grid_blocks = 0;
  if (!grid_blocks) {
    int dev = 0, cus = 0, per_cu = 0;
    (void)hipGetDevice(&dev);
    (void)hipDeviceGetAttribute(&cus, hipDeviceAttributeMultiprocessorCount, dev);
    (void)hipOccupancyMaxActiveBlocksPerMultiprocessor(&per_cu, mk, NTHREADS, 0);
    if (per_cu > 1) per_cu = 1;
    grid_blocks = cus * per_cu;
  }
  void* args[] = {&p};
  hipError_t e = hipLaunchCooperativeKernel((void*)mk, dim3(grid_blocks), dim3(NTHREADS), args, 0, stream);
  if (e != hipSuccess) fprintf(stderr, "cooperative launch failed: %s (grid %d)\n", hipGetErrorString(e), grid_blocks);
}
```

```cpp
#include <hip/hip_runtime.h>
#include <stdint.h>
#include <stdio.h>


typedef __attribute__((ext_vector_type(8))) short bf16x8;
typedef __attribute__((ext_vector_type(4))) short s16x4;
typedef __attribute__((ext_vector_type(16))) float f32x16;
typedef __attribute__((ext_vector_type(4))) float f32x4;
typedef __bf16 bf2_t __attribute__((ext_vector_type(2)));
#define DI __device__ __forceinline__
#define MFMA32(a, b, c) __builtin_amdgcn_mfma_f32_32x32x16_bf16((a), (b), (c), 0, 0, 0)
#define MFMA16(a, b, c) __builtin_amdgcn_mfma_f32_16x16x32_bf16((a), (b), (c), 0, 0, 0)

constexpr int NB = 4, SEQ = 4096, NM = 16, T = 4112, NT = NB * T, NR = NB * SEQ, D = 1024, INC = 3408;
constexpr int C_AQ = 0, C_CKV = 512, C_IQ = 768, C_IK = 1280, C_IW = 1344, C_BQKV = 1352, C_BZ = 2888, C_BBETA = 3400, C_BA = 3404;
constexpr int NCH = 65, NCHT = NB * 4 * NCH;
constexpr int NEXP = 32, NASG = NR * 4;
constexpr int CNTS = 32;
constexpr int NTHREADS = 512, NWAVES = 8;

constexpr size_t al256(size_t x) { return (x + 255) & ~(size_t)255; }
constexpr size_t OFF_U = 0;
constexpr int NTP = 16640;
constexpr size_t OFF_P = OFF_U + al256((size_t)NTP * 1024 * 2);
constexpr size_t OFF_ROPE = OFF_P + al256((size_t)NT * INC * 4);
constexpr size_t OFF_QB = OFF_ROPE + al256((size_t)T * 64 * 4);
constexpr size_t OFF_KB = OFF_QB + al256((size_t)NT * 512 * 2);
constexpr size_t OFF_VT = OFF_KB + al256((size_t)NT * 512 * 2);
constexpr size_t OFF_QI = OFF_VT + al256((size_t)NT * 512 * 2);
constexpr size_t OFF_KI = OFF_QI + al256((size_t)NT * 512 * 2);
constexpr size_t OFF_WI = OFF_KI + al256((size_t)NT * 64 * 2);
constexpr size_t OFF_CKV = OFF_WI + al256((size_t)NT * 8 * 4);
constexpr size_t OFF_KV = OFF_CKV + al256((size_t)NTP * 256 * 2);
constexpr size_t OFF_MASK = OFF_KV + al256((size_t)NT * 1024 * 4);
constexpr size_t OFF_MIX = OFF_MASK + al256((size_t)NB * SEQ * 128 * 4);
constexpr size_t OFF_QD = OFF_MIX + al256((size_t)NT * 1024 * 2);
constexpr size_t OFF_KD = OFF_QD + al256((size_t)NT * 512 * 4);
constexpr size_t OFF_VD = OFF_KD + al256((size_t)NT * 512 * 4);
constexpr size_t OFF_BETA = OFF_VD + al256((size_t)NT * 512 * 4);
constexpr size_t OFF_G = OFF_BETA + al256((size_t)NT * 4 * 4);
constexpr int CHB_ELEMS = 30720, CH_QG = 8448, CH_KDT = 16896, CH_IN = 25600;
constexpr size_t OFF_WN = OFF_G + al256((size_t)NT * 4 * 4);
constexpr size_t OFF_UU = OFF_WN + al256((size_t)NCHT * CHB_ELEMS * 2);
constexpr size_t OFF_DL = OFF_UU + al256((size_t)NCHT * 64 * 128 * 4);
constexpr size_t OFF_OD = OFF_DL + al256((size_t)NCHT * 4);
constexpr size_t OFF_U2 = OFF_OD + al256((size_t)NT * 512 * 4);
constexpr size_t OFF_TOPE = OFF_U2 + al256((size_t)NR * 1024 * 2);
constexpr size_t OFF_GATEV = OFF_TOPE + al256((size_t)NR * 4 * 4);
constexpr size_t OFF_POS = OFF_GATEV + al256((size_t)NR * 4 * 4);
constexpr size_t OFF_SLOT = OFF_POS + al256((size_t)NR * 4 * 4);
constexpr size_t OFF_LTOK = OFF_SLOT + al256((size_t)NR * 4 * 4);
constexpr size_t OFF_LGATE = OFF_LTOK + al256((size_t)NASG * 4);
constexpr size_t OFF_WTIN = OFF_LGATE + al256((size_t)NASG * 4);
constexpr size_t OFF_WTKV = OFF_WTIN + al256((size_t)3584 * 1024 * 2);
constexpr size_t OFF_WTOUT = OFF_WTKV + al256((size_t)1024 * 256 * 2);
constexpr size_t OFF_WTGU = OFF_WTOUT + al256((size_t)1024 * 1024 * 2);
constexpr size_t OFF_WTDN = OFF_WTGU + al256((size_t)32 * 2048 * 1024 * 2);
constexpr size_t OFF_CNT = OFF_WTDN + al256((size_t)32 * 1024 * 1024 * 2);
constexpr size_t OFF_Y = OFF_QD;
static_assert(OFF_U2 - OFF_QD >= (size_t)NASG * 1024 * 2, "Y alias does not fit");
static_assert((size_t)(NASG + 256) * 1024 * 2 <= (size_t)NT * INC * 4, "HD alias does not fit");
constexpr size_t OFF_WRS = OFF_CNT + 4096;
constexpr size_t OFF_SST = OFF_WRS + 131072;
constexpr size_t OFF_BAR = OFF_SST + (size_t)16 * 4 * 64 * 64 * 4;
constexpr size_t WS_NEED = OFF_BAR + 16384;
constexpr size_t OFF_H1 = OFF_KV;
constexpr size_t OFF_HD = OFF_P;

struct Params {
  const float *x, *meta, *norm_mix_w, *w_in, *q_norm_w, *k_norm_w, *kv_norm_w, *w_kv_up, *conv_w, *a_log, *dt_bias,
      *delta_norm_w, *w_out, *norm_ffn_w, *w_router, *b_router, *w_gate_up, *b_gate_up, *w_down, *b_down;
  float* out;
  char* ws;
  int wv;
  int pad0;
};

#define LAS __attribute__((address_space(3)))
constexpr int STAGE_LDS_BYTES = 131072;
DI unsigned pk2(float a, float b) { bf2_t v; v[0] = (__bf16)a; v[1] = (__bf16)b; return __builtin_bit_cast(unsigned, v); }
DI unsigned short f2bf(float a) { return (unsigned short)(pk2(a, 0.f) & 0xffffu); }
DI float bf2f(unsigned short u) { return __uint_as_float(((unsigned)u) << 16); }
template <int CTRL> DI float dppf(float v) { return __builtin_bit_cast(float, __builtin_amdgcn_update_dpp(0, __builtin_bit_cast(int, v), CTRL, 0xf, 0xf, false)); }
template <int CTRL> DI int dppi(int v) { return __builtin_amdgcn_update_dpp(0, v, CTRL, 0xf, 0xf, false); }
DI float rlf(float v, int l) { return __builtin_bit_cast(float, __builtin_amdgcn_readlane(__builtin_bit_cast(int, v), l)); }
DI float wave_sum(float v) {
  v += dppf<0xB1>(v); v += dppf<0x4E>(v); v += dppf<0x141>(v); v += dppf<0x140>(v);
  return (rlf(v, 0) + rlf(v, 16)) + (rlf(v, 32) + rlf(v, 48));
}
DI float xor32f(float v, int lane) {
  auto r = __builtin_amdgcn_permlane32_swap(__builtin_bit_cast(unsigned, v), __builtin_bit_cast(unsigned, v), false, false);
  return __builtin_bit_cast(float, (lane < 32) ? r[1] : r[0]);
}
DI float xor16f(float v, int lane) {
  auto r = __builtin_amdgcn_permlane16_swap(__builtin_bit_cast(unsigned, v), __builtin_bit_cast(unsigned, v), false, false);
  return __builtin_bit_cast(float, (lane & 16) ? r[0] : r[1]);
}
DI int otid(const Params& p) {
  int l;
  asm volatile("v_mbcnt_lo_u32_b32 %0, -1, 0\n\tv_mbcnt_hi_u32_b32 %0, -1, %0" : "=v"(l));
  return (p.wv << 6) | l;
}
DI int swzA(int row, int col) { return row * 132 + col; }
DI int swzB(int row, int col) { return row * 68 + col; }
DI int crow(int reg, int h) { return (reg & 3) + 8 * (reg >> 2) + 4 * h; }
DI bf16x8 pack8(const f32x16& x, int s) {
  uint4 p;
  p.x = pk2(x[8 * s + 0], x[8 * s + 1]); p.y = pk2(x[8 * s + 2], x[8 * s + 3]);
  p.z = pk2(x[8 * s + 4], x[8 * s + 5]); p.w = pk2(x[8 * s + 6], x[8 * s + 7]);
  return __builtin_bit_cast(bf16x8, p);
}
DI bf16x8 ld8x2(const unsigned short* p0, const unsigned short* p1) {
  uint2 a = *(const uint2*)p0, b = *(const uint2*)p1;
  uint4 r = make_uint4(a.x, a.y, b.x, b.y);
  return __builtin_bit_cast(bf16x8, r);
}
DI bf16x8 ld16(const unsigned short* p) { uint4 r = *(const uint4*)p; return __builtin_bit_cast(bf16x8, r); }
DI const float* hrow(const Params& p, int tok) {
  int b = tok / T, t = tok - b * T;
  return (t < NM) ? (p.meta + (size_t)t * D) : (p.x + ((size_t)b * SEQ + (t - NM)) * D);
}

DI void phase_prep(const Params& p) {
  const int tid = otid(p), lane = tid & 63, wave = tid >> 6;
  float* rope = (float*)(p.ws + OFF_ROPE);
  for (int idx = blockIdx.x * NTHREADS + tid; idx < T * 32; idx += gridDim.x * NTHREADS) {
    int t = idx >> 5, i = idx & 31;
    float inv = (float)pow(10000.0, -(double)i / 32.0);
    float ang = (float)t * inv;
    double ad = (double)ang;
    double n = rint(ad * 0.15915494309189535);
    float r = (float)(ad - n * 6.283185307179586);
    float sn, cs;
    sincosf(r, &sn, &cs);
    rope[t * 64 + i] = cs;
    rope[t * 64 + 32 + i] = sn;
  }
  float* wrs = (float*)(p.ws + OFF_WRS);
  for (int idx = blockIdx.x * NTHREADS + tid; idx < 1024 * 32; idx += gridDim.x * NTHREADS) wrs[idx] = p.norm_ffn_w[idx >> 5] * p.w_router[idx];
  unsigned short* U = (unsigned short*)(p.ws + OFF_U);
  for (int tok = blockIdx.x * NWAVES + wave; tok < NT; tok += gridDim.x * NWAVES) {
    const float* src = hrow(p, tok);
    float4 v[4];
    float ss = 0.f;
#pragma unroll
    for (int i = 0; i < 4; ++i) {
      v[i] = *(const float4*)(src + lane * 4 + 256 * i);
      ss += v[i].x * v[i].x + v[i].y * v[i].y + v[i].z * v[i].z + v[i].w * v[i].w;
    }
    ss = wave_sum(ss);
    float rstd = rsqrtf(ss * (1.f / 1024.f) + 1e-6f);
#pragma unroll
    for (int i = 0; i < 4; ++i) {
      float4 w = *(const float4*)(p.norm_mix_w + lane * 4 + 256 * i);
      uint2 o;
      o.x = pk2(v[i].x * rstd * w.x, v[i].y * rstd * w.y);
      o.y = pk2(v[i].z * rstd * w.z, v[i].w * rstd * w.w);
      *(uint2*)(U + (size_t)tok * 1024 + lane * 4 + 256 * i) = o;
    }
  }
}

DI void wconv_task2(const float* src, unsigned short* dst, int K, int N, int k0, int n0, int tid) {
  const int kg = tid >> 6, n = n0 + (tid & 63) * 4, k = k0 + kg * 8;
  float4 v[8];
#pragma unroll
  for (int i = 0; i < 8; ++i) {
    v[i] = make_float4(0.f, 0.f, 0.f, 0.f);
    if (n < N) v[i] = *(const float4*)(src + (size_t)(k + i) * N + n);
  }
  uint4 o;
  o.x = pk2(v[0].x, v[1].x); o.y = pk2(v[2].x, v[3].x); o.z = pk2(v[4].x, v[5].x); o.w = pk2(v[6].x, v[7].x);
  *(uint4*)(dst + (size_t)(n + 0) * K + k) = o;
  o.x = pk2(v[0].y, v[1].y); o.y = pk2(v[2].y, v[3].y); o.z = pk2(v[4].y, v[5].y); o.w = pk2(v[6].y, v[7].y);
  *(uint4*)(dst + (size_t)(n + 1) * K + k) = o;
  o.x = pk2(v[0].z, v[1].z); o.y = pk2(v[2].z, v[3].z); o.z = pk2(v[4].z, v[5].z); o.w = pk2(v[6].z, v[7].z);
  *(uint4*)(dst + (size_t)(n + 2) * K + k) = o;
  o.x = pk2(v[0].w, v[1].w); o.y = pk2(v[2].w, v[3].w); o.z = pk2(v[4].w, v[5].w); o.w = pk2(v[6].w, v[7].w);
  *(uint4*)(dst + (size_t)(n + 3) * K + k) = o;
}
constexpr int WC_IN = 16 * 14, WC_KV = 4 * 4, WC_OUT = 16 * 4, WC_GU = 32 * 128, WC_DN = 32 * 64;
constexpr int WC_SMALL = WC_IN + WC_KV + WC_OUT, WC_ALL = WC_SMALL + WC_GU + WC_DN;
DI void wconv_task(const Params& p, int t, int tid) {
  if (t < WC_IN) {
    wconv_task2(p.w_in, (unsigned short*)(p.ws + OFF_WTIN), 1024, INC, (t / 14) * 64, (t % 14) * 256, tid);
  } else if (t < WC_IN + WC_KV) {
    t -= WC_IN;
    wconv_task2(p.w_kv_up, (unsigned short*)(p.ws + OFF_WTKV), 256, 1024, (t >> 2) * 64, (t & 3) * 256, tid);
  } else if (t < WC_SMALL) {
    t -= WC_IN + WC_KV;
    wconv_task2(p.w_out, (unsigned short*)(p.ws + OFF_WTOUT), 1024, 1024, (t >> 2) * 64, (t & 3) * 256, tid);
  } else if (t < WC_SMALL + WC_GU) {
    t -= WC_SMALL;
    const int e = t >> 7, r = t & 127;
    wconv_task2(p.w_gate_up + (size_t)e * 1024 * 2048, (unsigned short*)(p.ws + OFF_WTGU) + (size_t)e * 2048 * 1024, 1024, 2048,
                (r >> 3) * 64, (r & 7) * 256, tid);
  } else {
    t -= WC_SMALL + WC_GU;
    const int e = t >> 6, r = t & 63;
    wconv_task2(p.w_down + (size_t)e * 1024 * 1024, (unsigned short*)(p.ws + OFF_WTDN) + (size_t)e * 1024 * 1024, 1024, 1024,
                (r >> 2) * 64, (r & 3) * 256, tid);
  }
}
DI void wconv_fill(const Params& p, char* smem, int site, bool drain) {
  unsigned* q = (unsigned*)(p.ws + OFF_BAR + 15872 + 128);
  volatile LAS int* slot = (volatile LAS int*)((LAS unsigned char*)smem + STAGE_LDS_BYTES + 832);
  const int tid = otid(p);
  __syncthreads();
  if (tid == 0 && !drain) (void)__hip_atomic_fetch_add(&q[16 + site], 1u, __ATOMIC_RELAXED, __HIP_MEMORY_SCOPE_AGENT);
  for (;;) {
    __syncthreads();
    if (tid == 0) {
      int t = -1;
      const bool all_done = !drain && __hip_atomic_load(&q[16 + site], __ATOMIC_RELAXED, __HIP_MEMORY_SCOPE_AGENT) >= gridDim.x;
      if (!all_done) t = WC_SMALL + (int)__hip_atomic_fetch_add(&q[0], 1u, __ATOMIC_RELAXED, __HIP_MEMORY_SCOPE_AGENT);
      *slot = t;
    }
    __syncthreads();
    const int t = __builtin_amdgcn_readfirstlane(*slot);
    if (t < 0 || t >= WC_ALL) break;
    wconv_task(p, t, tid);
  }
}
DI void phase_wconv(const Params& p, int t0, int t1) {
  const int tid = otid(p);
  for (int t = t0 + blockIdx.x; t < t1; t += gridDim.x) wconv_task(p, t, tid);
}

namespace g8 {
constexpr int BM = 256, BK = 64, HALF = 128, HTB = HALF * BK * 2, STAGE_BYTES = 8 * HTB, NXCD = 8, WGM = 8;
constexpr int TAB_OFF = STAGE_BYTES;
constexpr int MAXU = 24;
DI int lds_byte(int r, int c) { const int st = (r >> 4) * 2 + (c >> 5), rr = r & 15, cc = c & 31, ob = rr * 64 + cc * 2; return st * 1024 + (ob ^ (((ob >> 9) & 1) << 5)); }
DI void stage_rc(int b, int& R, int& C) { const int st = b / 1024, sb = b % 1024, swz = sb ^ (((sb >> 9) & 1) << 5); R = (st >> 1) * 16 + swz / 64; C = (st & 1) * 32 + (swz % 64) / 2; }
DI int perm32(int rho) { const int n = rho >> 4, i = rho & 15; return 8 * (i >> 2) + 4 * n + (i & 3); }
DI int xcd_remap(int L, int nwg) { const int q = nwg / NXCD, r = nwg % NXCD, xcd = L % NXCD, off = L / NXCD; return (xcd < r ? xcd * (q + 1) : r * (q + 1) + (xcd - r) * q) + off; }
struct UnitT { int valid, arow, mend, pn, e, orow; };

template <int MODE> DI int n_units(const Params& p) {
  if (MODE == 0) return 65 * 14;
  if (MODE == 1) return 65 * 4;
  if (MODE == 2) return 64 * 4;
  const int* cnt = (const int*)(p.ws + OFF_CNT);
  int n = 0;
  for (int e = 0; e < NEXP; ++e) n += ((cnt[e * CNTS] + 255) >> 8) * (MODE == 3 ? 8 : 4);
  return n;
}
template <int MODE> DI void unit_of(const Params& p, int L, int nwg, UnitT& u) {
  u.valid = 0; u.arow = 0; u.mend = 0; u.pn = 0; u.e = 0; u.orow = 0;
  if (L >= nwg) return;
  const int wgid = xcd_remap(L, nwg);
  u.valid = 1;
  if (MODE <= 2) {
    const int nM = (MODE == 2) ? 64 : 65, nN = (MODE == 0) ? 14 : 4;
    const int nig = WGM * nN, gid = wgid / nig, fm = gid * WGM, gsz = (nM - fm) < WGM ? (nM - fm) : WGM;
    const int pm = fm + ((wgid % nig) % gsz);
    u.pn = (wgid % nig) / gsz;
    u.orow = pm * 256;
    u.arow = (MODE == 2) ? (pm * 256 + 16 * (pm / 16 + 1)) : pm * 256;
    u.mend = (MODE == 2) ? NR : NT;
  } else {
    const int* cnt = (const int*)(p.ws + OFF_CNT);
    constexpr int NTN = (MODE == 3) ? 8 : 4;
    int id = wgid, sbase = 0;
    for (int e = 0; e < NEXP; ++e) {
      const int c = cnt[e * CNTS], mts = (c + 255) >> 8, ne = mts * NTN;
      if (id < ne) {
        const int tn = id / mts, tm = id - tn * mts;
        u.e = e; u.pn = tn; u.arow = sbase + tm * 256; u.orow = u.arow; u.mend = sbase + c;
        return;
      }
      id -= ne;
      sbase += c;
    }
    u.valid = 0;
  }
}
DI float swiglu(float g, float u) {
  g = fminf(g, 7.0f);
  u = fminf(fmaxf(u, -7.0f), 7.0f);
  return g / (1.f + __expf(-1.702f * g)) * (u + 1.f);
}
template <int MODE>
DI void epilogue(const Params& p, const f32x4 (&acc)[2][2][4][2], const UnitT& u, int wr, int wc, int fr, int fq) {
  constexpr bool PERM = (MODE >= 3);
  const int row0 = u.orow + wr * 64 + fr;
  const int col0 = u.pn * 256 + wc * 32 + (PERM ? 8 * fq : 4 * fq);
  if (MODE == 0 || MODE == 1 || MODE == 2) {
    float* C = (float*)(p.ws + (MODE == 0 ? OFF_P : MODE == 1 ? OFF_KV : OFF_H1));
    const int ldc = (MODE == 0) ? INC : 1024;
#pragma unroll
    for (int ai = 0; ai < 2; ++ai)
#pragma unroll
      for (int m = 0; m < 4; ++m) {
        const int row = row0 + ai * 128 + m * 16;
        if (row < u.mend) {
#pragma unroll
          for (int bj = 0; bj < 2; ++bj)
#pragma unroll
            for (int n = 0; n < 2; ++n) {
              const int col = col0 + bj * 128 + n * 16;
              if (MODE != 0 || col < INC) {
                f32x4 v = acc[ai][bj][m][n];
                if (MODE == 2) v += *(const f32x4*)(p.x + (size_t)row * D + col);
                *(f32x4*)(C + (size_t)row * ldc + col) = v;
              }
            }
        }
      }
  } else if (MODE == 3) {
    unsigned short* HD = (unsigned short*)(p.ws + OFF_HD);
    f32x4 bv[2][2];
#pragma unroll
    for (int bj = 0; bj < 2; ++bj)
#pragma unroll
      for (int n = 0; n < 2; ++n) bv[bj][n] = *(const f32x4*)(p.b_gate_up + (size_t)u.e * 2048 + col0 + bj * 128 + 4 * n);
#pragma unroll
    for (int ai = 0; ai < 2; ++ai)
#pragma unroll
      for (int m = 0; m < 4; ++m) {
        const int row = row0 + ai * 128 + m * 16;
        if (row < u.mend) {
#pragma unroll
          for (int bj = 0; bj < 2; ++bj) {
            const f32x4 v0 = acc[ai][bj][m][0] + bv[bj][0], v1 = acc[ai][bj][m][1] + bv[bj][1];
            uint2 o;
            o.x = pk2(swiglu(v0[0], v0[1]), swiglu(v0[2], v0[3]));
            o.y = pk2(swiglu(v1[0], v1[1]), swiglu(v1[2], v1[3]));
            *(uint2*)(HD + (size_t)row * 1024 + (col0 + bj * 128) / 2) = o;
          }
        }
      }
  } else {
    unsigned short* Y = (unsigned short*)(p.ws + OFF_Y);
    const float* lgate = (const float*)(p.ws + OFF_LGATE);
    f32x4 bv[2][2];
#pragma unroll
    for (int bj = 0; bj < 2; ++bj)
#pragma unroll
      for (int n = 0; n < 2; ++n) bv[bj][n] = *(const f32x4*)(p.b_down + (size_t)u.e * 1024 + col0 + bj * 128 + 4 * n);
#pragma unroll
    for (int ai = 0; ai < 2; ++ai)
#pragma unroll
      for (int m = 0; m < 4; ++m) {
        const int row = row0 + ai * 128 + m * 16;
        if (row < u.mend) {
          const float gt = lgate[row];
#pragma unroll
          for (int bj = 0; bj < 2; ++bj) {
            const f32x4 v0 = (acc[ai][bj][m][0] + bv[bj][0]) * gt, v1 = (acc[ai][bj][m][1] + bv[bj][1]) * gt;
            uint4 o;
            o.x = pk2(v0[0], v0[1]); o.y = pk2(v0[2], v0[3]); o.z = pk2(v1[0], v1[1]); o.w = pk2(v1[2], v1[3]);
            *(uint4*)(Y + (size_t)row * 1024 + col0 + bj * 128) = o;
          }
        }
      }
  }
}

template <int MODE>
DI void gemm_phase(const Params& p, char* smem) {
  constexpr bool PERM = (MODE >= 3);
  constexpr int K = (MODE == 1) ? 256 : 1024, nt = K / BK;
  LAS unsigned char* lds = (LAS unsigned char*)smem;
  LAS int* tab = (LAS int*)(lds + TAB_OFF);
  const int tid = otid(p), wid = __builtin_amdgcn_readfirstlane(tid >> 6), lane = tid & 63, wr = wid >> 2, wc = wid & 3, fr = lane & 15, fq = lane >> 4;
  __syncthreads();
  {
    const int nwg = n_units<MODE>(p);
    for (int ti = 0; ti < MAXU; ++ti) {
      UnitT u;
      unit_of<MODE>(p, ti * (int)gridDim.x + (int)blockIdx.x, nwg, u);
      if (tid == 0) { tab[ti * 8 + 0] = u.valid; tab[ti * 8 + 1] = u.arow; tab[ti * 8 + 2] = u.mend; tab[ti * 8 + 3] = u.pn; tab[ti * 8 + 4] = u.e; tab[ti * 8 + 5] = u.orow; }
    }
  }
  __syncthreads();
#define G8_GETU(i, u) do { const int _i = (i); (u).valid = (_i < MAXU) ? __builtin_amdgcn_readfirstlane(tab[_i * 8 + 0]) : 0; (u).arow = __builtin_amdgcn_readfirstlane(tab[(_i < MAXU ? _i : 0) * 8 + 1]); \
    (u).mend = __builtin_amdgcn_readfirstlane(tab[(_i < MAXU ? _i : 0) * 8 + 2]); (u).pn = __builtin_amdgcn_readfirstlane(tab[(_i < MAXU ? _i : 0) * 8 + 3]); \
    (u).e = __builtin_amdgcn_readfirstlane(tab[(_i < MAXU ? _i : 0) * 8 + 4]); (u).orow = __builtin_amdgcn_readfirstlane(tab[(_i < MAXU ? _i : 0) * 8 + 5]); } while (0)
  UnitT cur, nxt;
  G8_GETU(0, cur);
  if (!cur.valid) return;
  const char* Abase = (const char*)(p.ws + (MODE == 0 ? OFF_U : MODE == 1 ? OFF_CKV : MODE == 2 ? OFF_MIX : MODE == 3 ? OFF_U2 : OFF_HD));
  const char* Bbase = (const char*)(p.ws + (MODE == 0 ? OFF_WTIN : MODE == 1 ? OFF_WTKV : MODE == 2 ? OFF_WTOUT : MODE == 3 ? OFF_WTGU : OFF_WTDN));
  constexpr size_t BEXP = (MODE == 3) ? (size_t)2048 * 1024 * 2 : (MODE == 4) ? (size_t)1024 * 1024 * 2 : 0;
  int Rr[2], Cc[2];
  unsigned voffB[2];
#pragma unroll
  for (int i = 0; i < 2; ++i) {
    stage_rc(tid * 16 + i * 8192, Rr[i], Cc[i]);
    const int Rb = PERM ? ((Rr[i] & ~31) + perm32(Rr[i] & 31)) : Rr[i];
    voffB[i] = (unsigned)(Rb * K + Cc[i]) * 2u;
  }
  unsigned voffA[2][2];
  const int* ltok = (const int*)(p.ws + OFF_LTOK);
#define G8_VOFFA(dst, un) do { _Pragma("unroll") for (int _h = 0; _h < 2; ++_h) _Pragma("unroll") for (int _i = 0; _i < 2; ++_i) { \
      if (MODE == 3) { int _s = (un).arow + _h * 128 + Rr[_i]; _s = _s < NASG ? _s : NASG - 1; dst[_h][_i] = (unsigned)(ltok[_s] * K + Cc[_i]) * 2u; } \
      else dst[_h][_i] = (unsigned)((_h * 128 + Rr[_i]) * K + Cc[_i]) * 2u; } } while (0)
  const size_t kstep = (size_t)(BK * 2);
  const size_t hstep = (size_t)HALF * K * 2;
  const size_t tstep = 2 * hstep;
  const unsigned ldsw = (unsigned)wid * 1024u;
  const int aoff = lds_byte(wr * 64 + fr, fq * 8), boff = lds_byte(wc * 32 + fr, fq * 8);
#define G8_SA(b, h) (((b) * 2 + (h)) * HTB)
#define G8_SB(b, h) ((4 + (b) * 2 + (h)) * HTB)
#define G8_STAGE(bufoff, gbase, voff) do { _Pragma("unroll") for (int _i = 0; _i < 2; ++_i) \
    __builtin_amdgcn_global_load_lds((const unsigned*)((const char*)(gbase) + (voff)[_i]), (LAS unsigned*)(lds + (bufoff) + ldsw + _i * 8192), 16, 0, 0); } while (0)
#define G8_LDA(dst, b, h) do { _Pragma("unroll") for (int m = 0; m < 4; ++m) _Pragma("unroll") for (int k = 0; k < 2; ++k) dst[m][k] = *(const LAS bf16x8*)(lds + G8_SA(b, h) + aoff + m * 2048 + k * 1024); } while (0)
#define G8_LDB(dst, b, h) do { _Pragma("unroll") for (int n = 0; n < 2; ++n) _Pragma("unroll") for (int k = 0; k < 2; ++k) dst[n][k] = *(const LAS bf16x8*)(lds + G8_SB(b, h) + boff + n * 2048 + k * 1024); } while (0)
#define G8_MMA(ai, bj, At, Bt) do { __builtin_amdgcn_s_setprio(1); _Pragma("unroll") for (int m = 0; m < 4; ++m) _Pragma("unroll") for (int n = 0; n < 2; ++n) _Pragma("unroll") for (int k = 0; k < 2; ++k) \
    acc[ai][bj][m][n] = __builtin_amdgcn_mfma_f32_16x16x32_bf16(Bt[n][k], At[m][k], acc[ai][bj][m][n], 0, 0, 0); __builtin_amdgcn_s_setprio(0); } while (0)
#define G8_WAIT_V(n) asm volatile("s_waitcnt vmcnt(" #n ")" ::: "memory")
#define G8_WAIT_L(n) asm volatile("s_waitcnt lgkmcnt(" #n ")" ::: "memory")
#define G8_BAR __builtin_amdgcn_s_barrier()
#define G8_SCHED __builtin_amdgcn_sched_barrier(0)
  int ui = 0;
  f32x4 acc[2][2][4][2];
#pragma unroll
  for (int a = 0; a < 2; ++a)
#pragma unroll
    for (int b = 0; b < 2; ++b)
#pragma unroll
      for (int m = 0; m < 4; ++m)
#pragma unroll
        for (int n = 0; n < 2; ++n) acc[a][b][m][n] = (f32x4){0.f, 0.f, 0.f, 0.f};
  bf16x8 At[4][2], B0[2][2], B1[2][2];
  G8_VOFFA(voffA, cur);
  if (MODE == 3) asm volatile("s_waitcnt vmcnt(0)" ::: "memory");
  const char* cA = (MODE == 3) ? Abase : Abase + (size_t)cur.arow * K * 2;
  const char* cB = Bbase + (size_t)cur.e * BEXP + (size_t)cur.pn * tstep;
  G8_STAGE(G8_SB(0, 0), cB, voffB); G8_STAGE(G8_SA(0, 0), cA, voffA[0]); G8_STAGE(G8_SB(0, 1), cB + hstep, voffB); G8_STAGE(G8_SA(0, 1), cA, voffA[1]);
  if (wr == 1) G8_BAR;
  G8_WAIT_V(4); G8_BAR;
  G8_STAGE(G8_SB(1, 0), cB + kstep, voffB); G8_STAGE(G8_SA(1, 0), cA + kstep, voffA[0]); G8_STAGE(G8_SB(1, 1), cB + hstep + kstep, voffB);
  G8_WAIT_V(6); G8_BAR;
  for (;;) {
    G8_GETU(ui + 1, nxt);
    const bool has_next = nxt.valid != 0;
    const char* nA = has_next ? ((MODE == 3) ? Abase : Abase + (size_t)nxt.arow * K * 2) : cA;
    const char* nB = has_next ? Bbase + (size_t)nxt.e * BEXP + (size_t)nxt.pn * tstep : cB;
#pragma unroll 1
    for (int t = 0; t < nt; t += 2) {
      const bool last = (t == nt - 2);
      const char* a1 = cA + (size_t)(t + 1) * kstep;
      const char* a2 = last ? nA : cA + (size_t)(t + 2) * kstep;
      const char* b2 = last ? nB : cB + (size_t)(t + 2) * kstep;
      const char* a3 = a2 + kstep;
      const char* b3 = b2 + kstep;
      G8_LDB(B0, 0, 0); G8_SCHED; G8_LDA(At, 0, 0); G8_STAGE(G8_SA(1, 1), a1, voffA[1]);
      if (MODE == 3) {
        if (last && has_next) {
          G8_VOFFA(voffA, nxt);
          asm volatile("s_waitcnt vmcnt(0)" ::: "memory");
        }
      }
      G8_WAIT_L(8); G8_BAR; G8_WAIT_L(0); G8_MMA(0, 0, At, B0); G8_BAR; G8_SCHED;
      G8_LDB(B1, 0, 1); G8_STAGE(G8_SB(0, 0), b2, voffB);
      G8_BAR; G8_WAIT_L(0); G8_MMA(0, 1, At, B1); G8_BAR;
      G8_LDA(At, 0, 1); G8_STAGE(G8_SA(0, 0), a2, voffA[0]);
      G8_BAR; G8_WAIT_L(0); G8_MMA(1, 0, At, B0); G8_BAR; G8_SCHED;
      G8_STAGE(G8_SB(0, 1), b2 + hstep, voffB);
      G8_WAIT_V(6); G8_BAR; G8_MMA(1, 1, At, B1); G8_BAR;
      G8_LDB(B0, 1, 0); G8_SCHED; G8_LDA(At, 1, 0); G8_STAGE(G8_SA(0, 1), a2, voffA[1]);
      G8_WAIT_L(8); G8_BAR; G8_WAIT_L(0); G8_MMA(0, 0, At, B0); G8_BAR; G8_SCHED;
      G8_LDB(B1, 1, 1); G8_STAGE(G8_SB(1, 0), b3, voffB);
      G8_BAR; G8_WAIT_L(0); G8_MMA(0, 1, At, B1); G8_BAR;
      G8_LDA(At, 1, 1); G8_STAGE(G8_SA(1, 0), a3, voffA[0]);
      G8_BAR; G8_WAIT_L(0); G8_MMA(1, 0, At, B0); G8_BAR; G8_SCHED;
      G8_STAGE(G8_SB(1, 1), b3 + hstep, voffB);
      G8_WAIT_V(6); G8_BAR; G8_MMA(1, 1, At, B1); G8_BAR;
    }
    epilogue<MODE>(p, acc, cur, wr, wc, fr, fq);
    if (!has_next) break;
#pragma unroll
    for (int a = 0; a < 2; ++a)
#pragma unroll
      for (int b = 0; b < 2; ++b)
#pragma unroll
        for (int m = 0; m < 4; ++m)
#pragma unroll
          for (int n = 0; n < 2; ++n) acc[a][b][m][n] = (f32x4){0.f, 0.f, 0.f, 0.f};
    cur = nxt; cA = nA; cB = nB; ++ui;
  }
  G8_WAIT_V(0);
  if (wr == 0) G8_BAR;
  G8_BAR;
#undef G8_GETU
#undef G8_VOFFA
#undef G8_SA
#undef G8_SB
#undef G8_STAGE
#undef G8_LDA
#undef G8_LDB
#undef G8_MMA
#undef G8_WAIT_V
#undef G8_WAIT_L
#undef G8_BAR
#undef G8_SCHED
}
}

DI float rope_apply(float v, float c, float s, int lane) {
  float o = xor32f(v, lane);
  return (lane < 32) ? (v * c - o * s) : (v * c + o * s);
}
DI void phase_post1(const Params& p, char* smem) {
  const int tid = otid(p), lane = tid & 63, wave = tid >> 6;
  const float* P = (const float*)(p.ws + OFF_P);
  const float* rope = (const float*)(p.ws + OFF_ROPE);
  unsigned short* Qb = (unsigned short*)(p.ws + OFF_QB);
  unsigned short* QI = (unsigned short*)(p.ws + OFF_QI);
  unsigned short* KI = (unsigned short*)(p.ws + OFF_KI);
  unsigned short* CKV = (unsigned short*)(p.ws + OFF_CKV);
  float* WI = (float*)(p.ws + OFF_WI);
  float* Qd = (float*)(p.ws + OFF_QD);
  float* Kd = (float*)(p.ws + OFF_KD);
  float* Vd = (float*)(p.ws + OFF_VD);
  float* BETA = (float*)(p.ws + OFF_BETA);
  float* G = (float*)(p.ws + OFF_G);
  float* cw = (float*)smem;
  __syncthreads();
  for (int idx = tid; idx < 4 * 1536; idx += NTHREADS) cw[idx] = p.conv_w[idx];
  __syncthreads();
  const float qw = p.q_norm_w[lane];
  const float4 kvw = *(const float4*)(p.kv_norm_w + lane * 4);
  constexpr int PG = 4;
  for (int g = blockIdx.x * NWAVES + wave; g < NT / PG; g += gridDim.x * NWAVES) {
    const int tok0 = g * PG, b = tok0 / T, t0 = tok0 - b * T;
    const int tailc = (lane < 8) ? (C_IW + lane) : (C_BBETA + ((lane - 8) & 7));
    float nqv[8], niv[8];
    float4 nckv;
    float nikv, ntail;
    {
      const float* row = P + (size_t)tok0 * INC;
#pragma unroll
      for (int hh = 0; hh < 8; ++hh) { nqv[hh] = row[C_AQ + hh * 64 + lane]; niv[hh] = row[C_IQ + hh * 64 + lane]; }
      nckv = *(const float4*)(row + C_CKV + lane * 4);
      nikv = row[C_IK + lane];
      ntail = row[tailc];
    }
#pragma unroll 1
    for (int tt = 0; tt < PG; ++tt) {
      const int tok = tok0 + tt, t = t0 + tt;
      float qv[8], iv[8];
#pragma unroll
      for (int hh = 0; hh < 8; ++hh) { qv[hh] = nqv[hh]; iv[hh] = niv[hh]; }
      const float4 ckv = nckv;
      const float ikv = nikv, tailv = ntail;
      if (tt + 1 < PG) {
        const float* row = P + (size_t)(tok + 1) * INC;
#pragma unroll
        for (int hh = 0; hh < 8; ++hh) { nqv[hh] = row[C_AQ + hh * 64 + lane]; niv[hh] = row[C_IQ + hh * 64 + lane]; }
        nckv = *(const float4*)(row + C_CKV + lane * 4);
        nikv = row[C_IK + lane];
        ntail = row[tailc];
      }
      const float cs = rope[t * 64 + (lane & 31)], sn = rope[t * 64 + 32 + (lane & 31)];
      unsigned short* qb = Qb + (size_t)tok * 512 + lane;
      unsigned short* qi = QI + (size_t)tok * 512 + lane;
#pragma unroll
      for (int hh = 0; hh < 8; ++hh) {
        float v = qv[hh];
        const float ss = wave_sum(v * v);
        v = v * rsqrtf(ss * (1.f / 64.f) + 1e-6f) * qw;
        qb[hh * 64] = f2bf(rope_apply(v, cs, sn, lane));
        qi[hh * 64] = f2bf(rope_apply(iv[hh], cs, sn, lane));
      }
      {
        const float ss = wave_sum(ckv.x * ckv.x + ckv.y * ckv.y + ckv.z * ckv.z + ckv.w * ckv.w);
        const float rstd = rsqrtf(ss * (1.f / 256.f) + 1e-6f);
        uint2 o;
        o.x = pk2(ckv.x * rstd * kvw.x, ckv.y * rstd * kvw.y);
        o.y = pk2(ckv.z * rstd * kvw.z, ckv.w * rstd * kvw.w);
        *(uint2*)(CKV + (size_t)tok * 256 + lane * 4) = o;
      }
      KI[(size_t)tok * 64 + lane] = f2bf(rope_apply(ikv, cs, sn, lane));
      if (lane < 8) WI[(size_t)tok * 8 + lane] = tailv * 0.04419417382415922f;
      if (lane >= 8 && lane < 12) BETA[(size_t)tok * 4 + (lane - 8)] = 1.f / (1.f + expf(-tailv));
      if (lane >= 12 && lane < 16) {
        const float xx = tailv + p.dt_bias[lane - 12];
        const float sp = fmaxf(xx, 0.f) + log1pf(expf(-fabsf(xx)));
        G[(size_t)tok * 4 + (lane - 12)] = -expf(p.a_log[lane - 12]) * sp;
      }
    }
    float x0[24], x1[24], x2[24];
    {
      const float* base = P + (size_t)tok0 * INC + C_BQKV + lane;
#pragma unroll
      for (int i = 0; i < 24; ++i) {
        x0[i] = (t0 >= 3) ? base[64 * i - 3 * (ptrdiff_t)INC] : 0.f;
        x1[i] = (t0 >= 2) ? base[64 * i - 2 * (ptrdiff_t)INC] : 0.f;
        x2[i] = (t0 >= 1) ? base[64 * i - 1 * (ptrdiff_t)INC] : 0.f;
      }
    }
    float xn[24];
    {
      const float* xr = P + (size_t)tok0 * INC + C_BQKV + lane;
#pragma unroll
      for (int i = 0; i < 24; ++i) xn[i] = xr[64 * i];
    }
#pragma unroll 1
    for (int tt = 0; tt < PG; ++tt) {
      const int tok = tok0 + tt;
      float x3[24];
#pragma unroll
      for (int i = 0; i < 24; ++i) x3[i] = xn[i];
      if (tt + 1 < PG) {
        const float* xr = P + (size_t)(tok + 1) * INC + C_BQKV + lane;
#pragma unroll
        for (int i = 0; i < 24; ++i) xn[i] = xr[64 * i];
      }
      int cl = lane;
      asm volatile("" : "+v"(cl));
      float* qd = Qd + (size_t)tok * 512 + lane;
      float* kd = Kd + (size_t)tok * 512 + lane;
      float* vd = Vd + (size_t)tok * 512 + lane;
#pragma unroll
      for (int hd = 0; hd < 4; ++hd) {
        float cv[6];
#pragma unroll
        for (int q = 0; q < 6; ++q) {
          const int i = (q >> 1) * 8 + 2 * hd + (q & 1);
          const int c = cl + 64 * i;
          const float a = cw[c] * x0[i] + cw[1536 + c] * x1[i] + cw[2 * 1536 + c] * x2[i] + cw[3 * 1536 + c] * x3[i];
          cv[q] = a / (1.f + __expf(-a));
          x0[i] = x1[i]; x1[i] = x2[i]; x2[i] = x3[i];
        }
        float ss = wave_sum(cv[0] * cv[0] + cv[1] * cv[1]);
        float r = rsqrtf(ss + 1e-6f);
        qd[hd * 128] = cv[0] * r;
        qd[hd * 128 + 64] = cv[1] * r;
        ss = wave_sum(cv[2] * cv[2] + cv[3] * cv[3]);
        r = rsqrtf(ss + 1e-6f);
        kd[hd * 128] = cv[2] * r;
        kd[hd * 128 + 64] = cv[3] * r;
        vd[hd * 128] = cv[4];
        vd[hd * 128 + 64] = cv[5];
      }
    }
  }
}

DI void phase_post2(const Params& p, char* smem) {
  (void)smem;
  const int tid = otid(p), lane = tid & 63, wave = tid >> 6;
  const float* KV = (const float*)(p.ws + OFF_KV);
  const float* rope = (const float*)(p.ws + OFF_ROPE);
  unsigned short* Kb = (unsigned short*)(p.ws + OFF_KB);
  unsigned short* Vb = (unsigned short*)(p.ws + OFF_VT);
  const float kw = p.k_norm_w[lane];
  for (int tok = blockIdx.x * NWAVES + wave; tok < NT; tok += gridDim.x * NWAVES) {
    const int b = tok / T, t = tok - b * T;
    const float* row = KV + (size_t)tok * 1024;
    float kv[8], vv[8];
#pragma unroll
    for (int hh = 0; hh < 8; ++hh) { kv[hh] = row[hh * 64 + lane]; vv[hh] = row[512 + hh * 64 + lane]; }
    const float cs = rope[t * 64 + (lane & 31)], sn = rope[t * 64 + 32 + (lane & 31)];
    unsigned short* kb = Kb + (size_t)tok * 512 + lane;
    unsigned short* vb = Vb + (size_t)tok * 512 + lane;
#pragma unroll
    for (int hh = 0; hh < 8; ++hh) {
      float v = kv[hh];
      const float ss = wave_sum(v * v);
      v = v * rsqrtf(ss * (1.f / 64.f) + 1e-6f) * kw;
      kb[hh * 64] = f2bf(rope_apply(v, cs, sn, lane));
      vb[hh * 64] = f2bf(vv[hh]);
    }
  }
}

constexpr int KS_STRIDE = 129, AM_STRIDE = 65;
DI void phase_chunkprep(const Params& p, char* smem) {
  constexpr int KQ = 136;
  unsigned short* K16 = (unsigned short*)smem;
  unsigned short* Q16 = K16 + 64 * KQ;
  float* Am = (float*)(Q16 + 64 * KQ);
  float* Tm = Am + 64 * AM_STRIDE;
  float* gc = Tm + 64 * AM_STRIDE;
  float* bet = gc + 64;
  float* gl = bet + 64;
  unsigned short* T16 = (unsigned short*)(gl + 64);
  float* Mt = (float*)T16;
  unsigned short* VbT = T16 + 64 * 72;
  unsigned short* KbT = VbT + 128 * 72;
  static_assert(2 * 64 * KQ * 2 + (64 * AM_STRIDE * 2 + 192) * 4 + (64 * 72 + 2 * 128 * 72) * 2 <= 131072, "chunk prep LDS");
  const int tid = otid(p), lane = tid & 63, wave = tid >> 6;
  const float* Qd = (const float*)(p.ws + OFF_QD);
  const float* Kd = (const float*)(p.ws + OFF_KD);
  const float* Vd = (const float*)(p.ws + OFF_VD);
  const float* BETA = (const float*)(p.ws + OFF_BETA);
  const float* G = (const float*)(p.ws + OFF_G);
  unsigned short* CHB = (unsigned short*)(p.ws + OFF_WN);
  float* UU = (float*)(p.ws + OFF_UU);
  float* DL = (float*)(p.ws + OFF_DL);
  for (int ci = blockIdx.x; ci < NCHT; ci += gridDim.x) {
    unsigned short* chb = CHB + (size_t)ci * CHB_ELEMS;
    const int bh = ci / NCH, c = ci - bh * NCH, b = bh >> 2, h = bh & 3;
    __syncthreads();
    if (tid < 64) {
      int t = c * 64 + tid - 48;
      float g = 0.f, be = 0.f;
      if (t >= 0) { g = G[(size_t)(b * T + t) * 4 + h]; be = BETA[(size_t)(b * T + t) * 4 + h]; }
      gl[tid] = g;
      bet[tid] = be;
    }
    __syncthreads();
    if (tid < 64) {
      float s2 = 0.f;
      for (int j = 0; j <= tid; ++j) s2 += gl[j];
      gc[tid] = s2;
    }
    __syncthreads();
#pragma unroll 1
    for (int hb = 0; hb < 2; ++hb) {
      float kr[8], qr[8], vr[8];
#pragma unroll
      for (int it = 0; it < 8; ++it) {
        const int idx = tid + (hb * 8 + it) * NTHREADS, i = idx >> 7, d = idx & 127;
        const int t = c * 64 + i - 48;
        kr[it] = 0.f; qr[it] = 0.f; vr[it] = 0.f;
        if (t >= 0) {
          const size_t o = ((size_t)(b * T + t)) * 512 + h * 128 + d;
          kr[it] = Kd[o];
          qr[it] = Qd[o] * 0.08838834764831845f;
          vr[it] = Vd[o];
        }
      }
#pragma unroll
      for (int it = 0; it < 8; ++it) {
        const int idx = tid + (hb * 8 + it) * NTHREADS, i = idx >> 7, d = idx & 127;
        const float bi = bet[i], eg = __expf(gc[i]);
        K16[i * KQ + d] = f2bf(kr[it]);
        Q16[i * KQ + d] = f2bf(qr[it]);
        VbT[d * 72 + i] = f2bf(bi * vr[it]);
        KbT[d * 72 + i] = f2bf(bi * eg * kr[it]);
        chb[CH_QG + swzA(i, d)] = f2bf(qr[it] * eg);
      }
    }
    __syncthreads();
    {
      const int mat = wave >> 2, tl = wave & 3, lr = lane & 31, lh = lane >> 5;
      if (tl < 3) {
        const int mt = (tl + 1) >> 1, nt = tl >> 1;
        const unsigned short* At = mat ? Q16 : K16;
        f32x16 acc;
#pragma unroll
        for (int r = 0; r < 16; ++r) acc[r] = 0.f;
#pragma unroll
        for (int ks = 0; ks < 8; ++ks) {
          const bf16x8 af = ld16(At + (mt * 32 + lr) * KQ + ks * 16 + 8 * lh);
          const bf16x8 bfr = ld16(K16 + (nt * 32 + lr) * KQ + ks * 16 + 8 * lh);
          acc = MFMA32(af, bfr, acc);
        }
        const int j = nt * 32 + lr;
        const float gj = gc[j];
#pragma unroll
        for (int r = 0; r < 16; ++r) {
          const int i = mt * 32 + crow(r, lh);
          const float dec = (j <= i) ? __expf(gc[i] - gj) : 0.f;
          if (mat == 0) Am[i * AM_STRIDE + j] = (j < i) ? bet[i] * acc[r] * dec : 0.f;
          else chb[CH_IN + swzB(i, j)] = f2bf(acc[r] * dec);
        }
      } else {
        const int lr = lane & 31, lh = lane >> 5;
#pragma unroll
        for (int r = 0; r < 16; ++r) {
          const int i = crow(r, lh), j = 32 + lr;
          if (mat == 0) Am[i * AM_STRIDE + j] = 0.f;
          else chb[CH_IN + swzB(i, j)] = 0;
        }
      }
    }
    __syncthreads();
    {
      for (int idx = tid; idx < 64 * 64; idx += NTHREADS) Tm[(idx >> 6) * AM_STRIDE + (idx & 63)] = 0.f;
      __syncthreads();
      if (tid < 64) {
        const int bb = tid >> 4, cc = tid & 15, o = 16 * bb;
        float x[16];
#pragma unroll
        for (int i = 0; i < 16; ++i) {
          float a = (i == cc) ? 1.f : 0.f;
#pragma unroll
          for (int j = 0; j < 16; ++j)
            if (j < i) a -= Am[(o + i) * AM_STRIDE + o + j] * x[j];
          x[i] = a;
          Tm[(o + i) * AM_STRIDE + o + cc] = a;
        }
      }
      __syncthreads();
      {
        const int B = tid >> 8, i = (tid >> 4) & 15, j = tid & 15, o = 32 * B;
        float m = 0.f;
#pragma unroll
        for (int k = 0; k < 16; ++k) m += Am[(o + 16 + i) * AM_STRIDE + o + k] * Tm[(o + k) * AM_STRIDE + o + j];
        Mt[(B * 16 + i) * 33 + j] = m;
        __syncthreads();
        float t = 0.f;
#pragma unroll
        for (int k = 0; k < 16; ++k) t += Tm[(o + 16 + i) * AM_STRIDE + o + 16 + k] * Mt[(B * 16 + k) * 33 + j];
        __syncthreads();
        Tm[(o + 16 + i) * AM_STRIDE + o + j] = -t;
      }
      __syncthreads();
      {
        const int i = tid >> 4, j0 = (tid & 15) * 2;
        float m0 = 0.f, m1 = 0.f;
        for (int k = 0; k < 32; ++k) {
          const float a = Am[(32 + i) * AM_STRIDE + k];
          m0 += a * Tm[k * AM_STRIDE + j0];
          m1 += a * Tm[k * AM_STRIDE + j0 + 1];
        }
        Mt[i * 33 + j0] = m0;
        Mt[i * 33 + j0 + 1] = m1;
        __syncthreads();
        float t0 = 0.f, t1 = 0.f;
        for (int k = 0; k < 32; ++k) {
          const float a = Tm[(32 + i) * AM_STRIDE + 32 + k];
          t0 += a * Mt[k * 33 + j0];
          t1 += a * Mt[k * 33 + j0 + 1];
        }
        __syncthreads();
        Tm[(32 + i) * AM_STRIDE + j0] = -t0;
        Tm[(32 + i) * AM_STRIDE + j0 + 1] = -t1;
      }
    }
    __syncthreads();
    for (int idx = tid; idx < 64 * 64; idx += NTHREADS) T16[(idx >> 6) * 72 + (idx & 63)] = f2bf(Tm[(idx >> 6) * AM_STRIDE + (idx & 63)]);
    __syncthreads();
    {
      const int mat = wave >> 2, nt = wave & 3, lr = lane & 31, lh = lane >> 5;
      const unsigned short* Bt = mat ? KbT : VbT;
#pragma unroll
      for (int mt = 0; mt < 2; ++mt) {
        f32x16 acc;
#pragma unroll
        for (int r = 0; r < 16; ++r) acc[r] = 0.f;
#pragma unroll
        for (int ks = 0; ks < 4; ++ks) {
          const bf16x8 af = ld16(T16 + (mt * 32 + lr) * 72 + ks * 16 + 8 * lh);
          const bf16x8 bfr = ld16(Bt + (nt * 32 + lr) * 72 + ks * 16 + 8 * lh);
          acc = MFMA32(af, bfr, acc);
        }
        if (mat == 0) {
          float* up = UU + (size_t)ci * 8192 + (((nt * 2 + mt) * 2 + lh) * 32 + lr) * 16;
#pragma unroll
          for (int q = 0; q < 4; ++q) *(float4*)(up + 4 * q) = make_float4(acc[4 * q], acc[4 * q + 1], acc[4 * q + 2], acc[4 * q + 3]);
        } else {
#pragma unroll
          for (int r = 0; r < 16; ++r) chb[swzA(mt * 32 + crow(r, lh), nt * 32 + lr)] = f2bf(-acc[r]);
        }
      }
    }
    const float glast = gc[63];
    for (int idx = tid; idx < 64 * 128; idx += NTHREADS) {
      int i = idx & 63, d = idx >> 6;
      chb[CH_KDT + swzB(d, i)] = f2bf(bf2f(K16[i * KQ + d]) * __expf(glast - gc[i]));
    }
    if (tid == 0) DL[ci] = __expf(glast);
  }
}

DI float relu_fma(float w, float x, float acc) {
  const int xi = __builtin_bit_cast(int, x);
  const float m = __builtin_bit_cast(float, xi > 0 ? xi : 0);
  return __builtin_fmaf(w, m, acc);
}
DI unsigned ordkey(float f) {
  unsigned u = __float_as_uint(f);
  return (u & 0x80000000u) ? ~u : (u | 0x80000000u);
}
DI int half_sum(int v) {
  v += dppi<0xB1>(v); v += dppi<0x4E>(v); v += dppi<0x141>(v); v += dppi<0x140>(v);
  const int lo = __builtin_amdgcn_readlane(v, 0) + __builtin_amdgcn_readlane(v, 16);
  const int hi = __builtin_amdgcn_readlane(v, 32) + __builtin_amdgcn_readlane(v, 48);
  return (__builtin_amdgcn_mbcnt_hi(~0u, __builtin_amdgcn_mbcnt_lo(~0u, 0u)) < 32u) ? lo : hi;
}
DI int cnt4_ge(int cnt, unsigned a, unsigned b, unsigned c, unsigned d, unsigned cand) {
  unsigned long long m0, m1, m2, m3;
  asm("v_cmp_ge_u32_e64 %1, %5, %9\n\tv_cmp_ge_u32_e64 %2, %6, %9\n\tv_cmp_ge_u32_e64 %3, %7, %9\n\tv_cmp_ge_u32_e64 %4, %8, %9\n\t"
      "v_addc_co_u32_e64 %0, %1, %0, 0, %1\n\tv_addc_co_u32_e64 %0, %2, %0, 0, %2\n\tv_addc_co_u32_e64 %0, %3, %0, 0, %3\n\tv_addc_co_u32_e64 %0, %4, %0, 0, %4"
      : "+v"(cnt), "=&s"(m0), "=&s"(m1), "=&s"(m2), "=&s"(m3)
      : "v"(a), "v"(b), "v"(c), "v"(d), "v"(cand));
  return cnt;
}
DI int cnt4_gt(int cnt, unsigned a, unsigned b, unsigned c, unsigned d, unsigned cand) {
  unsigned long long m0, m1, m2, m3;
  asm("v_cmp_gt_u32_e64 %1, %5, %9\n\tv_cmp_gt_u32_e64 %2, %6, %9\n\tv_cmp_gt_u32_e64 %3, %7, %9\n\tv_cmp_gt_u32_e64 %4, %8, %9\n\t"
      "v_addc_co_u32_e64 %0, %1, %0, 0, %1\n\tv_addc_co_u32_e64 %0, %2, %0, 0, %2\n\tv_addc_co_u32_e64 %0, %3, %0, 0, %3\n\tv_addc_co_u32_e64 %0, %4, %0, 0, %4"
      : "+v"(cnt), "=&s"(m0), "=&s"(m1), "=&s"(m2), "=&s"(m3)
      : "v"(a), "v"(b), "v"(c), "v"(d), "v"(cand));
  return cnt;
}
DI void indexer_task(const Params& p, char* smem, int b, int q8, int wave, int lane) {
  const int q0 = (q8 * 8 + wave) * 2;
  unsigned* MASK = (unsigned*)(p.ws + OFF_MASK);
  const int qsel = lane >> 5;
  const int tq = q0 + qsel;
  unsigned* mrow = MASK + ((size_t)b * SEQ + tq) * 128;
  if (q8 < 16) {
    for (int i = (lane & 31); i < 128; i += 32) {
      int rem = tq + 1 - 32 * i;
      unsigned w = (rem >= 32) ? 0xffffffffu : (rem > 0 ? ((1u << rem) - 1u) : 0u);
      mrow[i] = w;
    }
    return;
  }
  const unsigned short* QI = (const unsigned short*)(p.ws + OFF_QI);
  const unsigned short* KI = (const unsigned short*)(p.ws + OFF_KI);
  const float* WI = (const float*)(p.ws + OFF_WI);
  const int l15 = lane & 15, lg = lane >> 4;
  const size_t qtok = (size_t)b * T + NM + q0 + (l15 >> 3);
  const bf16x8 a0 = ld16(QI + qtok * 512 + (l15 & 7) * 64 + 8 * lg);
  const bf16x8 a1 = ld16(QI + qtok * 512 + (l15 & 7) * 64 + 32 + 8 * lg);
  float w[4];
  {
    const size_t wtok = (size_t)b * T + NM + q0 + (lg >> 1);
#pragma unroll
    for (int r = 0; r < 4; ++r) w[r] = WI[wtok * 8 + 4 * (lg & 1) + r];
  }
  const int npairs = (q0 + 2 + 31) >> 5;
  const int npmax = (16 * q8 + 16 + 31) >> 5;
  LAS unsigned char* lds = (LAS unsigned char*)smem;
  const bool loader = wave < 4;
  const unsigned short* ksrc = KI + ((size_t)b * T + NM + 8 * wave + (lane >> 3)) * 64 + (((lane & 7) ^ (lane >> 3)) << 3);
  const unsigned frag0 = (unsigned)(l15 * 128 + ((lg ^ (l15 & 7)) << 4));
  const unsigned frag1 = (unsigned)(l15 * 128 + (((4 + lg) ^ (l15 & 7)) << 4));
  asm volatile("s_waitcnt vmcnt(0)" ::: "memory");
  __syncthreads();
#define IX_DMA(stage) __builtin_amdgcn_global_load_lds((const unsigned*)(ksrc + (size_t)(stage) * 2048), (LAS unsigned*)(lds + ((stage) & 3) * 4096 + wave * 1024), 16, 0, 0)
  if (loader) {
    IX_DMA(0);
    if (1 < npmax) IX_DMA(1);
    if (2 < npmax) IX_DMA(2);
  }
  unsigned u[128];
  int rem = tq - (lane & 31);
#pragma unroll
  for (int i = 0; i < 128; ++i) {
    unsigned uv = 0u;
    if (i < npmax) {
      if (loader) {
        if (i + 2 < npmax) asm volatile("s_waitcnt vmcnt(2)" ::: "memory");
        else if (i + 1 < npmax) asm volatile("s_waitcnt vmcnt(1)" ::: "memory");
        else asm volatile("s_waitcnt vmcnt(0)" ::: "memory");
      }
      __builtin_amdgcn_s_barrier();
      if (loader && i + 3 < npmax) IX_DMA(i + 3);
      if (i < npairs) {
        const LAS unsigned char* sb = lds + (i & 3) * 4096;
        float tot[2];
#pragma unroll
        for (int par = 0; par < 2; ++par) {
          const bf16x8 b0 = *(const LAS bf16x8*)(sb + par * 2048 + frag0);
          const bf16x8 b1 = *(const LAS bf16x8*)(sb + par * 2048 + frag1);
          f32x4 acc = {0.f, 0.f, 0.f, 0.f};
          acc = MFMA16(a0, b0, acc);
          acc = MFMA16(a1, b1, acc);
          float part = 0.f;
#pragma unroll
          for (int r = 0; r < 4; ++r) part = relu_fma(w[r], acc[r], part);
          tot[par] = part + xor16f(part, lane);
        }
        const float sc = (lg & 1) ? tot[1] : tot[0];
        uv = (rem >= 0) ? ordkey(sc) : 0u;
      }
    }
    u[i] = uv;
    rem -= 32;
    asm volatile("" : "+v"(rem));
  }
#undef IX_DMA
  __builtin_amdgcn_s_barrier();
  const int nblk = (npairs + 15) >> 4;
  unsigned thr = 0u;
  bool done = false;
  for (int bit = 31; bit >= 0; --bit) {
    const unsigned cand = thr | (1u << bit);
    int cnt = 0;
#pragma unroll
    for (int blk = 0; blk < 8; ++blk) {
      if (blk < nblk) {
#pragma unroll
        for (int j = 0; j < 16; j += 4) cnt = cnt4_ge(cnt, u[blk * 16 + j], u[blk * 16 + j + 1], u[blk * 16 + j + 2], u[blk * 16 + j + 3], cand);
      }
    }
    cnt = half_sum(cnt);
    if (!done && cnt >= 256) thr = cand;
    done = done || (cnt == 256);
    if (__all(done)) break;
  }
  int cgt = 0;
#pragma unroll
  for (int blk = 0; blk < 8; ++blk) {
    if (blk < nblk) {
#pragma unroll
      for (int j = 0; j < 16; j += 4) cgt = cnt4_gt(cgt, u[blk * 16 + j], u[blk * 16 + j + 1], u[blk * 16 + j + 2], u[blk * 16 + j + 3], thr);
    }
  }
  cgt = half_sum(cgt);
  const int need = 256 - cgt;
  int base = 0;
  const unsigned lt_mask = (1u << (lane & 31)) - 1u;
#pragma unroll
  for (int blk = 0; blk < 8; ++blk) {
    if (blk < nblk) {
#pragma unroll
      for (int j = 0; j < 16; ++j) {
        const int i = blk * 16 + j;
        const bool eq = (u[i] == thr);
        const unsigned long long eb = __ballot(eq);
        const unsigned ehalf = qsel ? (unsigned)(eb >> 32) : (unsigned)eb;
        const int below = __popc(ehalf & lt_mask);
        const bool sel = (u[i] > thr) || (eq && (base + below < need));
        base += __popc(ehalf);
        const unsigned long long sb = __ballot(sel);
        const unsigned shalf = qsel ? (unsigned)(sb >> 32) : (unsigned)sb;
        if ((lane & 31) == 0) mrow[i] = shalf;
      }
    }
  }
}
DI void phase_indexer(const Params& p, char* smem) {
  const int tid = otid(p), lane = tid & 63, wave = __builtin_amdgcn_readfirstlane(tid >> 6);
  unsigned* ctr = (unsigned*)(p.ws + OFF_BAR + 15872 + 64);
  volatile LAS int* slot = (volatile LAS int*)((LAS unsigned char*)smem + g8::STAGE_BYTES + 800);
  const int ngroup = NB * (SEQ / 16);
  for (;;) {
    __syncthreads();
    if (tid == 0) *slot = (int)__hip_atomic_fetch_add(ctr, 1u, __ATOMIC_RELAXED, __HIP_MEMORY_SCOPE_AGENT);
    __syncthreads();
    const int g = __builtin_amdgcn_readfirstlane(*slot);
    if (g >= ngroup) break;
    const int b = g & 3, q8 = (SEQ / 16 - 1) - (g >> 2);
    indexer_task(p, smem, b, q8, wave, lane);
  }
}

constexpr int AT_KROW = 72, AT_VROW = 96;
constexpr int AT_KBYTES = 32 * AT_KROW * 2, AT_STAGE = AT_KBYTES + 32 * AT_VROW * 2;
typedef short s16x4v __attribute__((ext_vector_type(4)));
typedef unsigned u32x4v __attribute__((ext_vector_type(4)));
DI void attn_block(const Params& p, char* smem, int b, int hh, int G) {
  const unsigned short* Qb = (const unsigned short*)(p.ws + OFF_QB);
  const unsigned short* Kb = (const unsigned short*)(p.ws + OFF_KB);
  const unsigned short* Vb = (const unsigned short*)(p.ws + OFF_VT);
  const unsigned* MASK = (const unsigned*)(p.ws + OFF_MASK);
  unsigned short* MIX = (unsigned short*)(p.ws + OFF_MIX);
  LAS unsigned char* lds = (LAS unsigned char*)smem;
  const int tid = otid(p), lane = tid & 63, wave = __builtin_amdgcn_readfirstlane(tid >> 6);
  const int lr = lane & 31, lh = lane >> 5;
  const int qt = 8 * G + wave;
  const int tq = qt * 32 + lr;
  const size_t qtok = (size_t)b * T + NM + tq;
  bf16x8 qf[4];
#pragma unroll
  for (int ks = 0; ks < 4; ++ks) qf[ks] = ld16(Qb + qtok * 512 + hh * 64 + ks * 16 + 8 * lh);
  const unsigned* mrow = MASK + ((size_t)b * SEQ + tq) * 128;
  const int which = tid >> 8, srow = (tid >> 3) & 31, sch = tid & 7;
  const unsigned short* gsrc = (which ? Vb : Kb) + ((size_t)b * T + srow) * 512 + hh * 64 + sch * 8;
  const unsigned sdst = which ? (unsigned)(AT_KBYTES + srow * (AT_VROW * 2) + sch * 16) : (unsigned)(srow * (AT_KROW * 2) + sch * 16);
  const int ntile = 8 * G + 9;
  const unsigned koff = (unsigned)(lr * (AT_KROW * 2) + 16 * lh);
  const unsigned voff = (unsigned)(AT_KBYTES + (4 * lh + ((lane & 15) >> 2)) * (AT_VROW * 2) + (16 * ((lane >> 4) & 1) + 4 * (lane & 3)) * 2);
  __syncthreads();
  {
    const u32x4v st0 = *(const u32x4v*)gsrc;
    *(LAS u32x4v*)(lds + sdst) = st0;
  }
  u32x4v stg = {0u, 0u, 0u, 0u};
  if (ntile > 1) stg = *(const u32x4v*)(gsrc + (size_t)NM * 512);
  f32x16 o[2];
#pragma unroll
  for (int i = 0; i < 2; ++i)
#pragma unroll
    for (int r = 0; r < 16; ++r) o[i][r] = 0.f;
  float m = -1e30f, lsum = 0.f;
  const float sl2 = 0.125f * 1.4426950408889634f;
  unsigned wnext = mrow[0];
  __syncthreads();
  for (int it = 0; it < ntile; ++it) {
    const int kt = it - 1;
    const bool has_next = it + 1 < ntile;
    u32x4v stg2 = {0u, 0u, 0u, 0u};
    if (it + 2 < ntile) stg2 = *(const u32x4v*)(gsrc + (size_t)(NM + 32 * (kt + 2)) * 512);
    if (kt <= qt) {
      const unsigned word = (kt < 0) ? 0x0000ffffu : wnext;
      if (kt >= 0 && kt < qt) wnext = mrow[kt + 1];
      const LAS unsigned char* sb = lds + (it & 1) * AT_STAGE;
      f32x16 s;
#pragma unroll
      for (int r = 0; r < 16; ++r) s[r] = 0.f;
#pragma unroll
      for (int ks = 0; ks < 4; ++ks) {
        const bf16x8 kf = *(const LAS bf16x8*)(sb + koff + ks * 32);
        s = MFMA32(kf, qf[ks], s);
      }
      const unsigned wsh = word >> (4 * lh);
      float tmax = -1e30f;
#pragma unroll
      for (int r = 0; r < 16; ++r) {
        const bool valid = (wsh >> ((r & 3) + 8 * (r >> 2))) & 1u;
        s[r] = valid ? s[r] * sl2 : -1e30f;
        tmax = fmaxf(tmax, s[r]);
      }
      tmax = fmaxf(tmax, xor32f(tmax, lane));
      if (!__all(tmax <= m)) {
        const float mnew = fmaxf(m, tmax);
        const float alpha = __builtin_amdgcn_exp2f(m - mnew);
        lsum *= alpha;
        m = mnew;
#pragma unroll
        for (int i = 0; i < 2; ++i)
#pragma unroll
          for (int r = 0; r < 16; ++r) o[i][r] *= alpha;
      }
      float psum = 0.f;
#pragma unroll
      for (int r = 0; r < 16; ++r) {
        const float pv = __builtin_amdgcn_exp2f(s[r] - m);
        s[r] = pv;
        psum += pv;
      }
      psum += xor32f(psum, lane);
      lsum += psum;
#pragma unroll
      for (int ss = 0; ss < 2; ++ss) {
        const bf16x8 pf = pack8(s, ss);
#pragma unroll
        for (int dt = 0; dt < 2; ++dt) {
          const LAS unsigned char* vp = sb + voff + (16 * ss) * (AT_VROW * 2) + dt * 64;
          const s16x4v lo = __builtin_amdgcn_ds_read_tr16_b64_v4i16((LAS s16x4v*)vp);
          const s16x4v hi = __builtin_amdgcn_ds_read_tr16_b64_v4i16((LAS s16x4v*)(vp + 8 * (AT_VROW * 2)));
          const bf16x8 vf = __builtin_shufflevector(lo, hi, 0, 1, 2, 3, 4, 5, 6, 7);
          o[dt] = MFMA32(vf, pf, o[dt]);
        }
      }
    }
    if (has_next) *(LAS u32x4v*)(lds + ((it + 1) & 1) * AT_STAGE + sdst) = stg;
    stg = stg2;
    __syncthreads();
  }
  const float inv = 1.f / lsum;
#pragma unroll
  for (int dt = 0; dt < 2; ++dt)
#pragma unroll
    for (int r = 0; r < 16; ++r) MIX[qtok * 1024 + hh * 64 + dt * 32 + crow(r, lh)] = f2bf(o[dt][r] * inv);
}
DI void attn_worker(const Params& p, char* smem) {
  unsigned* ctr = (unsigned*)(p.ws + OFF_BAR + 15872);
  volatile LAS int* slot = (volatile LAS int*)((LAS unsigned char*)smem + g8::STAGE_BYTES + 800);
  const int tid = otid(p);
  for (;;) {
    __syncthreads();
    if (tid == 0) *slot = (int)__hip_atomic_fetch_add(ctr, 1u, __ATOMIC_RELAXED, __HIP_MEMORY_SCOPE_AGENT);
    __syncthreads();
    const int k = __builtin_amdgcn_readfirstlane(*slot);
    if (k >= NB * 8 * 16) break;
    const int bh = k & 31, G = 15 - (k >> 5);
    attn_block(p, smem, bh >> 3, bh & 7, G);
  }
}

DI bf16x8 lds8x2(const LAS unsigned short* p0, const LAS unsigned short* p1) {
  typedef unsigned u32x2_t __attribute__((ext_vector_type(2)));
  typedef unsigned u32x4_t __attribute__((ext_vector_type(4)));
  const u32x2_t a = *(const LAS u32x2_t*)p0, b = *(const LAS u32x2_t*)p1;
  const u32x4_t r = {a[0], a[1], b[0], b[1]};
  return __builtin_bit_cast(bf16x8, r);
}
DI void scan_block(const Params& p, char* smem, int bh, const int c0, const int c1) {
  const int tid = otid(p), lane = tid & 63, wave = __builtin_amdgcn_readfirstlane(tid >> 6);
  const int b = bh >> 2, h = bh & 3;
  LAS unsigned char* lds = (LAS unsigned char*)smem;
  const unsigned short* CHB = (const unsigned short*)(p.ws + OFF_WN) + (size_t)bh * NCH * CHB_ELEMS;
  const float* UU = (const float*)(p.ws + OFF_UU) + (size_t)bh * NCH * 8192;
  const float* DL = (const float*)(p.ws + OFF_DL) + (size_t)bh * NCH;
  float* OD = (float*)(p.ws + OFF_OD);
  constexpr int CHB_BYTES = CHB_ELEMS * 2;
  __syncthreads();
  if (wave >= 4) {
    const int w4 = wave - 4;
    for (int c = c0; c <= c1; ++c) {
      if (c < c1) {
        const char* src = (const char*)(CHB + (size_t)c * CHB_ELEMS) + (size_t)(w4 * 15) * 1024 + lane * 16;
        const unsigned dst = (unsigned)((c & 1) * CHB_BYTES + (w4 * 15) * 1024);
#pragma unroll
        for (int j = 0; j < 15; ++j)
          __builtin_amdgcn_global_load_lds((const unsigned*)(src + j * 1024), (LAS unsigned*)(lds + dst + j * 1024), 16, 0, 0);
      }
      asm volatile("s_waitcnt vmcnt(0)" ::: "memory");
      __builtin_amdgcn_s_barrier();
    }
  } else {
    const int sl = wave, lr = lane & 31, lh = lane >> 5, e0 = sl * 32;
    f32x16 S[4];
    float* sst = (float*)(p.ws + OFF_SST) + ((size_t)(bh * 4 + sl) * 64 + lane) * 64;
#pragma unroll
    for (int i = 0; i < 4; ++i)
#pragma unroll
      for (int q = 0; q < 4; ++q) {
        float4 v = make_float4(0.f, 0.f, 0.f, 0.f);
        if (c0 > 0) v = *(const float4*)(sst + i * 16 + q * 4);
        S[i][4 * q] = v.x; S[i][4 * q + 1] = v.y; S[i][4 * q + 2] = v.z; S[i][4 * q + 3] = v.w;
      }
    f32x16 un[2];
    const float* up0 = UU + (size_t)c0 * 8192 + ((size_t)(sl * 2) * 2 + lh) * 512 + lr * 16;
#pragma unroll
    for (int pt = 0; pt < 2; ++pt)
#pragma unroll
      for (int q = 0; q < 4; ++q) {
        const float4 v = *(const float4*)(up0 + pt * 1024 + q * 4);
        un[pt][4 * q] = v.x; un[pt][4 * q + 1] = v.y; un[pt][4 * q + 2] = v.z; un[pt][4 * q + 3] = v.w;
      }
    const int oA = lr * 132 + 4 * lh;
    const int oB = lr * 68 + 4 * lh;
    __builtin_amdgcn_s_barrier();
    for (int c = c0; c < c1; ++c) {
      const LAS unsigned short* cb = (const LAS unsigned short*)(lds + (c & 1) * CHB_BYTES);
      f32x16 vn[2];
      vn[0] = un[0];
      vn[1] = un[1];
#pragma unroll
      for (int pt = 0; pt < 2; ++pt) {
#pragma unroll
        for (int mt = 0; mt < 4; ++mt)
#pragma unroll
          for (int s2 = 0; s2 < 2; ++s2) {
            const LAS unsigned short* ap = cb + oA + pt * 32 * 132 + mt * 32 + 16 * s2;
            vn[pt] = MFMA32(lds8x2(ap, ap + 8), pack8(S[mt], s2), vn[pt]);
          }
      }
      bf16x8 vb[2][2];
#pragma unroll
      for (int pt = 0; pt < 2; ++pt)
#pragma unroll
        for (int s2 = 0; s2 < 2; ++s2) vb[pt][s2] = pack8(vn[pt], s2);
#pragma unroll
      for (int pt = 0; pt < 2; ++pt) {
        f32x16 o;
#pragma unroll
        for (int r = 0; r < 16; ++r) o[r] = 0.f;
#pragma unroll
        for (int mt = 0; mt < 4; ++mt)
#pragma unroll
          for (int s2 = 0; s2 < 2; ++s2) {
            const LAS unsigned short* ap = cb + CH_QG + oA + pt * 32 * 132 + mt * 32 + 16 * s2;
            o = MFMA32(lds8x2(ap, ap + 8), pack8(S[mt], s2), o);
          }
#pragma unroll
        for (int pt2 = 0; pt2 <= pt; ++pt2)
#pragma unroll
          for (int s2 = 0; s2 < 2; ++s2) {
            const LAS unsigned short* ap = cb + CH_IN + oB + pt * 32 * 68 + pt2 * 32 + 16 * s2;
            o = MFMA32(lds8x2(ap, ap + 8), vb[pt2][s2], o);
          }
#pragma unroll
        for (int r = 0; r < 16; ++r) {
          const int t = c * 64 + pt * 32 + crow(r, lh) - 48;
          if (t >= 0) OD[((size_t)(b * T + t)) * 512 + h * 128 + e0 + lr] = o[r];
        }
      }
      if (c + 1 < c1) {
        const float* up = up0 + (size_t)(c + 1 - c0) * 8192;
#pragma unroll
        for (int pt = 0; pt < 2; ++pt)
#pragma unroll
          for (int q = 0; q < 4; ++q) {
            const float4 v = *(const float4*)(up + pt * 1024 + q * 4);
            un[pt][4 * q] = v.x; un[pt][4 * q + 1] = v.y; un[pt][4 * q + 2] = v.z; un[pt][4 * q + 3] = v.w;
          }
      }
      const float dl = DL[c];
#pragma unroll
      for (int mt = 0; mt < 4; ++mt) {
#pragma unroll
        for (int r = 0; r < 16; ++r) S[mt][r] *= dl;
#pragma unroll
        for (int pt2 = 0; pt2 < 2; ++pt2)
#pragma unroll
          for (int s2 = 0; s2 < 2; ++s2) {
            const LAS unsigned short* ap = cb + CH_KDT + oB + mt * 32 * 68 + pt2 * 32 + 16 * s2;
            S[mt] = MFMA32(lds8x2(ap, ap + 8), vb[pt2][s2], S[mt]);
          }
      }
      asm volatile("s_waitcnt lgkmcnt(0)" ::: "memory");
      __builtin_amdgcn_s_barrier();
    }
    if (c1 < NCH) {
#pragma unroll
      for (int i = 0; i < 4; ++i)
#pragma unroll
        for (int q = 0; q < 4; ++q) *(float4*)(sst + i * 16 + q * 4) = make_float4(S[i][4 * q], S[i][4 * q + 1], S[i][4 * q + 2], S[i][4 * q + 3]);
    }
  }
  __syncthreads();
}
DI void phase_scan_attn(const Params& p, char* smem) {
  attn_worker(p, smem);
}

DI void phase_gnorm(const Params& p) {
  const int tid = otid(p), lane = tid & 63, wave = tid >> 6;
  const float* OD = (const float*)(p.ws + OFF_OD);
  const float* P = (const float*)(p.ws + OFF_P);
  unsigned short* MIX = (unsigned short*)(p.ws + OFF_MIX);
  for (int r = blockIdx.x * NWAVES + wave; r < NR; r += gridDim.x * NWAVES) {
    const int tok = r + 16 * (r / SEQ + 1);
#pragma unroll
    for (int hd = 0; hd < 4; ++hd) {
      float o0 = OD[(size_t)tok * 512 + hd * 128 + lane], o1 = OD[(size_t)tok * 512 + hd * 128 + 64 + lane];
      float ss = wave_sum(o0 * o0 + o1 * o1);
      float rstd = rsqrtf(ss * (1.f / 128.f) + 1e-6f);
      float z0 = P[(size_t)tok * INC + C_BZ + hd * 128 + lane], z1 = P[(size_t)tok * INC + C_BZ + hd * 128 + 64 + lane];
      float y0 = o0 * rstd * p.delta_norm_w[lane] * (z0 / (1.f + __expf(-z0)));
      float y1 = o1 * rstd * p.delta_norm_w[64 + lane] * (z1 / (1.f + __expf(-z1)));
      MIX[(size_t)tok * 1024 + 512 + hd * 128 + lane] = f2bf(y0);
      MIX[(size_t)tok * 1024 + 512 + hd * 128 + 64 + lane] = f2bf(y1);
    }
  }
}

DI void phase_router(const Params& p, char* smem) {
  const int tid = otid(p), lane = tid & 63, wave = tid >> 6;
  float* part = (float*)smem;
  float* rstds = part + 8 * 32 * 33;
  int* lhist = (int*)(rstds + 32);
  int* lbase = lhist + 32;
  const float* H1 = (const float*)(p.ws + OFF_H1);
  const float* wrs = (const float*)(p.ws + OFF_WRS);
  unsigned short* U2 = (unsigned short*)(p.ws + OFF_U2);
  int* TOPE = (int*)(p.ws + OFF_TOPE);
  float* GATEV = (float*)(p.ws + OFF_GATEV);
  int* POS = (int*)(p.ws + OFF_POS);
  int* CNT = (int*)(p.ws + OFF_CNT);
  const int lr = lane & 31, lh = lane >> 5;
  float4 nw[4];
#pragma unroll
  for (int i = 0; i < 4; ++i) nw[i] = *(const float4*)(p.norm_ffn_w + lane * 4 + 256 * i);
  for (int task = blockIdx.x; task < NR / 32; task += gridDim.x) {
    const int r0 = task * 32;
    __syncthreads();
    if (tid < 32) lhist[tid] = 0;
    int lp0 = 0, lp1 = 0, lp2 = 0, lp3 = 0, xe0 = 0, xe1 = 0, xe2 = 0, xe3 = 0;
#pragma unroll
    for (int tt = 0; tt < 4; ++tt) {
      const int r = r0 + wave * 4 + tt;
      const float* src = H1 + (size_t)r * 1024;
      float4 v[4];
      float ss = 0.f;
#pragma unroll
      for (int i = 0; i < 4; ++i) {
        v[i] = *(const float4*)(src + lane * 4 + 256 * i);
        ss += v[i].x * v[i].x + v[i].y * v[i].y + v[i].z * v[i].z + v[i].w * v[i].w;
      }
      ss = wave_sum(ss);
      const float rstd = rsqrtf(ss * (1.f / 1024.f) + 1e-6f);
      if (lane == 0) rstds[wave * 4 + tt] = rstd;
#pragma unroll
      for (int i = 0; i < 4; ++i) {
        uint2 o;
        o.x = pk2(v[i].x * rstd * nw[i].x, v[i].y * rstd * nw[i].y);
        o.y = pk2(v[i].z * rstd * nw[i].z, v[i].w * rstd * nw[i].w);
        *(uint2*)(U2 + (size_t)r * 1024 + lane * 4 + 256 * i) = o;
      }
    }
    f32x16 acc;
#pragma unroll
    for (int i = 0; i < 16; ++i) acc[i] = 0.f;
    const float* arow = H1 + (size_t)(r0 + lr) * 1024 + wave * 128;
    const float* bcol = wrs + (size_t)(wave * 128 + lh) * 32 + lr;
#pragma unroll 8
    for (int k0 = 0; k0 < 128; k0 += 4) {
      const float4 a4 = *(const float4*)(arow + k0);
      const float b0 = bcol[(size_t)k0 * 32], b1 = bcol[(size_t)(k0 + 2) * 32];
      acc = __builtin_amdgcn_mfma_f32_32x32x2f32(lh ? a4.y : a4.x, b0, acc, 0, 0, 0);
      acc = __builtin_amdgcn_mfma_f32_32x32x2f32(lh ? a4.w : a4.z, b1, acc, 0, 0, 0);
    }
#pragma unroll
    for (int r = 0; r < 16; ++r) part[(wave * 32 + crow(r, lh)) * 33 + lr] = acc[r];
    __syncthreads();
    if (tid < 32) {
      const float myrstd = rstds[tid];
      float lv[32];
#pragma unroll
      for (int e = 0; e < 32; ++e) {
        float a = 0.f;
#pragma unroll
        for (int w = 0; w < 8; ++w) a += part[(w * 32 + tid) * 33 + e];
        lv[e] = a * myrstd + p.b_router[e];
      }
      float tv[4];
      int te[4];
#pragma unroll
      for (int k = 0; k < 4; ++k) {
        float bv = lv[0];
        int bi = 0;
#pragma unroll
        for (int e = 1; e < 32; ++e)
          if (lv[e] > bv) { bv = lv[e]; bi = e; }
        tv[k] = bv;
        te[k] = bi;
#pragma unroll
        for (int e = 0; e < 32; ++e)
          if (e == bi) lv[e] = -3.0e38f;
      }
      const float e1 = __expf(tv[1] - tv[0]), e2 = __expf(tv[2] - tv[0]), e3 = __expf(tv[3] - tv[0]);
      const float inv = 1.f / (1.f + e1 + e2 + e3);
      const size_t rr = (size_t)(r0 + tid) * 4;
      TOPE[rr + 0] = te[0]; TOPE[rr + 1] = te[1]; TOPE[rr + 2] = te[2]; TOPE[rr + 3] = te[3];
      GATEV[rr + 0] = inv; GATEV[rr + 1] = e1 * inv; GATEV[rr + 2] = e2 * inv; GATEV[rr + 3] = e3 * inv;
      lp0 = atomicAdd(&lhist[te[0]], 1); lp1 = atomicAdd(&lhist[te[1]], 1); lp2 = atomicAdd(&lhist[te[2]], 1); lp3 = atomicAdd(&lhist[te[3]], 1);
      xe0 = te[0]; xe1 = te[1]; xe2 = te[2]; xe3 = te[3];
    }
    __syncthreads();
    if (tid < 32) {
      const int c = lhist[tid];
      lbase[tid] = (c > 0) ? atomicAdd(&CNT[tid * CNTS], c) : 0;
    }
    __syncthreads();
    if (tid < 32) {
      const size_t rr = (size_t)(r0 + tid) * 4;
      POS[rr + 0] = lbase[xe0] + lp0; POS[rr + 1] = lbase[xe1] + lp1; POS[rr + 2] = lbase[xe2] + lp2; POS[rr + 3] = lbase[xe3] + lp3;
    }
  }
}
DI void phase_lists(const Params& p) {
  const int* CNT = (const int*)(p.ws + OFF_CNT);
  const int* TOPE = (const int*)(p.ws + OFF_TOPE);
  const float* GATEV = (const float*)(p.ws + OFF_GATEV);
  const int* POS = (const int*)(p.ws + OFF_POS);
  int* SLOT = (int*)(p.ws + OFF_SLOT);
  int* LTOK = (int*)(p.ws + OFF_LTOK);
  float* LGATE = (float*)(p.ws + OFF_LGATE);
  for (int a = blockIdx.x * NTHREADS + otid(p); a < NASG; a += gridDim.x * NTHREADS) {
    const int e = TOPE[a];
    int off = 0;
    for (int j = 0; j < e; ++j) off += CNT[j * CNTS];
    const int slot = off + POS[a];
    SLOT[a] = slot;
    LTOK[slot] = a >> 2;
    LGATE[slot] = GATEV[a];
  }
}
DI void phase_combine(const Params& p) {
  const float* H1 = (const float*)(p.ws + OFF_H1);
  const unsigned short* Y = (const unsigned short*)(p.ws + OFF_Y);
  const int* SLOT = (const int*)(p.ws + OFF_SLOT);
  for (int idx = blockIdx.x * NTHREADS + otid(p); idx < NR * 256; idx += gridDim.x * NTHREADS) {
    const int r = idx >> 8, c4 = (idx & 255) * 4;
    float4 a = *(const float4*)(H1 + (size_t)r * 1024 + c4);
#pragma unroll
    for (int k = 0; k < 4; ++k) {
      const int slot = SLOT[r * 4 + k];
      uint2 y = *(const uint2*)(Y + (size_t)slot * 1024 + c4);
      a.x += bf2f((unsigned short)(y.x & 0xffffu));
      a.y += bf2f((unsigned short)(y.x >> 16));
      a.z += bf2f((unsigned short)(y.y & 0xffffu));
      a.w += bf2f((unsigned short)(y.y >> 16));
    }
    *(float4*)(p.out + (size_t)r * 1024 + c4) = a;
  }
}


#define XB_TMO      128
#define XB_XCNT(j)  (256  + 64 * (j))
#define XB_XSUB(j)  (1280 + 64 * (j))
#define XB_XGEN(j)  (2304 + 64 * (j))
#define XB_TOP      3328
#define XB_TOPGEN   3392
#define XB_SPIN_CAP (1u << 22)
DI unsigned xb_ld(unsigned* p) { return __hip_atomic_load(p, __ATOMIC_RELAXED, __HIP_MEMORY_SCOPE_AGENT); }
DI unsigned xb_add(unsigned* p, unsigned v) { return __hip_atomic_fetch_add(p, v, __ATOMIC_RELAXED, __HIP_MEMORY_SCOPE_AGENT); }
DI unsigned xb_xcc_id() { return (unsigned)__builtin_amdgcn_s_getreg((3 << 11) | 20) & 0xFu; }
#define XB_SPIN(cond, bar) do { unsigned _sp = 0; while (cond) { __builtin_amdgcn_s_sleep(1); \
    if ((++_sp & 255u) == 0u) { if (xb_ld(&(bar)[XB_TMO])) break; if (_sp > XB_SPIN_CAP) { atomicAdd(&(bar)[XB_TMO], 1u); break; } } } } while (0)
struct XcdBarrier { unsigned* bar; unsigned x; volatile LAS unsigned* st; bool leader; };
DI void xcd_barrier_complete(unsigned* bar, unsigned x, unsigned& nloc, unsigned& nx) {
  const unsigned G = gridDim.x * gridDim.y * gridDim.z;
  unsigned sum, cnt, mine, sp = 0u;
  for (;;) {
    sum = 0u; cnt = 0u; mine = 0u;
#pragma unroll
    for (unsigned j = 0; j < 16; ++j) { const unsigned c = xb_ld(&bar[XB_XCNT(j)]); sum += c; cnt += (c > 0u) ? 1u : 0u; mine = (j == x) ? c : mine; }
    if (sum == G) break;
    __builtin_amdgcn_s_sleep(1);
    if ((++sp & 255u) == 0u) { if (xb_ld(&bar[XB_TMO])) break; if (sp > XB_SPIN_CAP) { atomicAdd(&bar[XB_TMO], 1u); break; } }
  }
  nloc = mine > 0u ? mine : 1u; nx = cnt > 0u ? cnt : 1u;
}
DI void xcd_barrier(const XcdBarrier& b) {
  asm volatile("s_waitcnt vmcnt(0)" ::: "memory");
  __syncthreads();
  if (b.leader) {
    unsigned* bar = b.bar;
    __builtin_amdgcn_s_waitcnt(0);
    unsigned nloc = b.st[0], nx = b.st[1];
    if (nloc == 0u) { xcd_barrier_complete(bar, b.x, nloc, nx); b.st[0] = nloc; b.st[1] = nx; }
    const unsigned old = xb_add(&bar[XB_XSUB(b.x)], 1u);
    const unsigned gen = old / nloc;
    if (old + 1u == (gen + 1u) * nloc) {
      __builtin_amdgcn_fence(__ATOMIC_RELEASE, "agent");
      asm volatile("s_waitcnt vmcnt(0)" ::: "memory");
      const unsigned og = xb_add(&bar[XB_TOP], 1u);
      const unsigned tg = og / nx;
      if (og + 1u == (tg + 1u) * nx) xb_add(&bar[XB_TOPGEN], 1u);
      else XB_SPIN(xb_ld(&bar[XB_TOPGEN]) == tg, bar);
      __builtin_amdgcn_fence(__ATOMIC_ACQUIRE, "agent");
      xb_add(&bar[XB_XGEN(b.x)], 1u);
      asm volatile("s_waitcnt vmcnt(0)" ::: "memory");
    } else {
      XB_SPIN(xb_ld(&bar[XB_XGEN(b.x)]) == gen, bar);
      __builtin_amdgcn_fence(__ATOMIC_ACQUIRE, "agent");
      asm volatile("s_waitcnt vmcnt(0)" ::: "memory");
    }
  }
  __syncthreads();
}

constexpr int SMEM_BYTES = g8::STAGE_BYTES + 1024;

__global__ void __launch_bounds__(NTHREADS) mk(Params p0) {
  __shared__ __attribute__((aligned(16))) char smem[SMEM_BYTES];
  Params p = p0;
  p.wv = __builtin_amdgcn_readfirstlane((int)(threadIdx.x >> 6));
  XcdBarrier xb;
  {
    volatile LAS unsigned* st = (volatile LAS unsigned*)((LAS unsigned char*)smem + g8::STAGE_BYTES + 768);
    if (threadIdx.x == 0) { st[0] = 0u; st[1] = 0u; }
    __syncthreads();
    xb.bar = (unsigned*)(p.ws + OFF_BAR); xb.x = xb_xcc_id(); xb.st = st; xb.leader = (threadIdx.x == 0);
    if (xb.leader) (void)xb_add(&xb.bar[XB_XCNT(xb.x)], 1u);
  }
  phase_prep(p);
  phase_wconv(p, 0, WC_SMALL);
  xcd_barrier(xb);
  g8::gemm_phase<0>(p, smem);
  wconv_fill(p, smem, 0, false);
  xcd_barrier(xb);
  phase_post1(p, smem);
  xcd_barrier(xb);
  g8::gemm_phase<1>(p, smem);
  phase_chunkprep(p, smem);
  wconv_fill(p, smem, 1, false);
  xcd_barrier(xb);
  if (blockIdx.x < 16) scan_block(p, smem, blockIdx.x, 0, NCH);
  phase_post2(p, smem);
  phase_indexer(p, smem);
  wconv_fill(p, smem, 2, false);
  xcd_barrier(xb);
  phase_gnorm(p);
  phase_scan_attn(p, smem);
  wconv_fill(p, smem, 3, false);
  xcd_barrier(xb);
  g8::gemm_phase<2>(p, smem);
  xcd_barrier(xb);
  phase_router(p, smem);
  xcd_barrier(xb);
  phase_lists(p);
  wconv_fill(p, smem, 4, true);
  xcd_barrier(xb);
  g8::gemm_phase<3>(p, smem);
  xcd_barrier(xb);
  g8::gemm_phase<4>(p, smem);
  xcd_barrier(xb);
  phase_combine(p);
}

extern "C" void kernel_launch(void* const* d_in, const int* in_sizes, int n_in, void* d_out, int out_size, void* d_ws,
                              size_t ws_size, hipStream_t stream) {
  (void)in_sizes; (void)n_in; (void)out_size;
  if (ws_size < WS_NEED) return;
  Params p{};
  p.x = (const float*)d_in[0]; p.meta = (const float*)d_in[1]; p.norm_mix_w = (const float*)d_in[2];
  p.w_in = (const float*)d_in[3]; p.q_norm_w = (const float*)d_in[4]; p.k_norm_w = (const float*)d_in[5];
  p.kv_norm_w = (const float*)d_in[6]; p.w_kv_up = (const float*)d_in[7]; p.conv_w = (const float*)d_in[8];
  p.a_log = (const float*)d_in[9]; p.dt_bias = (const float*)d_in[10]; p.delta_norm_w = (const float*)d_in[11];
  p.w_out = (const float*)d_in[12]; p.norm_ffn_w = (const float*)d_in[13]; p.w_router = (const float*)d_in[14];
  p.b_router = (const float*)d_in[15]; p.w_gate_up = (const float*)d_in[16]; p.b_gate_up = (const float*)d_in[17];
  p.w_down = (const float*)d_in[18]; p.b_down = (const float*)d_in[19];
  p.out = (float*)d_out;
  p.ws = (char*)d_ws;
  (void)hipMemsetAsync((char*)d_ws + OFF_CNT, 0, 4096, stream);
  (void)hipMemsetAsync((char*)d_ws + OFF_BAR, 0, 16384, stream);
  static int grid_blocks = 0;
  if (!grid_blocks) {
    int dev = 0, cus = 0, per_cu = 0;
    (void)hipGetDevice(&dev);
    (void)hipDeviceGetAttribute(&cus, hipDeviceAttributeMultiprocessorCount, dev);
    (void)hipOccupancyMaxActiveBlocksPerMultiprocessor(&per_cu, mk, NTHREADS, 0);
    if (per_cu > 1) per_cu = 1;
    grid_blocks = cus * per_cu;
  }
  void* args[] = {&p};
  hipError_t e = hipLaunchCooperativeKernel((void*)mk, dim3(grid_blocks), dim3(NTHREADS), args, 0, stream);
  if (e != hipSuccess) fprintf(stderr, "cooperative launch failed: %s (grid %d)\n", hipGetErrorString(e), grid_blocks);
}
```

```cpp
#include <hip/hip_runtime.h>
#include <stdint.h>
#include <stdio.h>


typedef __attribute__((ext_vector_type(8))) short bf16x8;
typedef __attribute__((ext_vector_type(4))) short s16x4;
typedef __attribute__((ext_vector_type(16))) float f32x16;
typedef __attribute__((ext_vector_type(4))) float f32x4;
typedef __bf16 bf2_t __attribute__((ext_vector_type(2)));
#define DI __device__ __forceinline__
#define MFMA32(a, b, c) __builtin_amdgcn_mfma_f32_32x32x16_bf16((a), (b), (c), 0, 0, 0)
#define MFMA16(a, b, c) __builtin_amdgcn_mfma_f32_16x16x32_bf16((a), (b), (c), 0, 0, 0)

constexpr int NB = 4, SEQ = 4096, NM = 16, T = 4112, NT = NB * T, NR = NB * SEQ, D = 1024, INC = 3408;
constexpr int C_AQ = 0, C_CKV = 512, C_IQ = 768, C_IK = 1280, C_IW = 1344, C_BQKV = 1352, C_BZ = 2888, C_BBETA = 3400, C_BA = 3404;
constexpr int NCH = 65, NCHT = NB * 4 * NCH;
constexpr int NEXP = 32, NASG = NR * 4;
constexpr int CNTS = 32;
constexpr int NTHREADS = 512, NWAVES = 8;

constexpr size_t al256(size_t x) { return (x + 255) & ~(size_t)255; }
constexpr size_t OFF_U = 0;
constexpr int NTP = 16640;
constexpr size_t OFF_P = OFF_U + al256((size_t)NTP * 1024 * 2);
constexpr size_t OFF_ROPE = OFF_P + al256((size_t)NT * INC * 4);
constexpr size_t OFF_QB = OFF_ROPE + al256((size_t)T * 64 * 4);
constexpr size_t OFF_KB = OFF_QB + al256((size_t)NT * 512 * 2);
constexpr size_t OFF_VT = OFF_KB + al256((size_t)NT * 512 * 2);
constexpr size_t OFF_QI = OFF_VT + al256((size_t)NT * 512 * 2);
constexpr size_t OFF_KI = OFF_QI + al256((size_t)NT * 512 * 2);
constexpr size_t OFF_WI = OFF_KI + al256((size_t)NT * 64 * 2);
constexpr size_t OFF_CKV = OFF_WI + al256((size_t)NT * 8 * 4);
constexpr size_t OFF_KV = OFF_CKV + al256((size_t)NTP * 256 * 2);
constexpr size_t OFF_MASK = OFF_KV + al256((size_t)NT * 1024 * 4);
constexpr size_t OFF_MIX = OFF_MASK + al256((size_t)NB * SEQ * 128 * 4);
constexpr size_t OFF_QD = OFF_MIX + al256((size_t)NT * 1024 * 2);
constexpr size_t OFF_KD = OFF_QD + al256((size_t)NT * 512 * 4);
constexpr size_t OFF_VD = OFF_KD + al256((size_t)NT * 512 * 4);
constexpr size_t OFF_BETA = OFF_VD + al256((size_t)NT * 512 * 4);
constexpr size_t OFF_G = OFF_BETA + al256((size_t)NT * 4 * 4);
constexpr int CHB_ELEMS = 30720, CH_QG = 8448, CH_KDT = 16896, CH_IN = 25600;
constexpr size_t OFF_WN = OFF_G + al256((size_t)NT * 4 * 4);
constexpr size_t OFF_UU = OFF_WN + al256((size_t)NCHT * CHB_ELEMS * 2);
constexpr size_t OFF_DL = OFF_UU + al256((size_t)NCHT * 64 * 128 * 4);
constexpr size_t OFF_OD = OFF_DL + al256((size_t)NCHT * 4);
constexpr size_t OFF_U2 = OFF_OD + al256((size_t)NT * 512 * 4);
constexpr size_t OFF_TOPE = OFF_U2 + al256((size_t)NR * 1024 * 2);
constexpr size_t OFF_GATEV = OFF_TOPE + al256((size_t)NR * 4 * 4);
constexpr size_t OFF_POS = OFF_GATEV + al256((size_t)NR * 4 * 4);
constexpr size_t OFF_SLOT = OFF_POS + al256((size_t)NR * 4 * 4);
constexpr size_t OFF_LTOK = OFF_SLOT + al256((size_t)NR * 4 * 4);
constexpr size_t OFF_LGATE = OFF_LTOK + al256((size_t)NASG * 4);
constexpr size_t OFF_WTIN = OFF_LGATE + al256((size_t)NASG * 4);
constexpr size_t OFF_WTKV = OFF_WTIN + al256((size_t)3584 * 1024 * 2);
constexpr size_t OFF_WTOUT = OFF_WTKV + al256((size_t)1024 * 256 * 2);
constexpr size_t OFF_WTGU = OFF_WTOUT + al256((size_t)1024 * 1024 * 2);
constexpr size_t OFF_WTDN = OFF_WTGU + al256((size_t)32 * 2048 * 1024 * 2);
constexpr size_t OFF_CNT = OFF_WTDN + al256((size_t)32 * 1024 * 1024 * 2);
constexpr size_t OFF_Y = OFF_QD;
static_assert(OFF_U2 - OFF_QD >= (size_t)NASG * 1024 * 2, "Y alias does not fit");
static_assert((size_t)(NASG + 256) * 1024 * 2 <= (size_t)NT * INC * 4, "HD alias does not fit");
constexpr size_t OFF_WRS = OFF_CNT + 4096;
constexpr size_t OFF_SST = OFF_WRS + 131072;
constexpr size_t OFF_BAR = OFF_SST + (size_t)16 * 4 * 64 * 64 * 4;
constexpr size_t WS_NEED = OFF_BAR + 16384;
constexpr size_t OFF_H1 = OFF_KV;
constexpr size_t OFF_HD = OFF_P;

struct Params {
  const float *x, *meta, *norm_mix_w, *w_in, *q_norm_w, *k_norm_w, *kv_norm_w, *w_kv_up, *conv_w, *a_log, *dt_bias,
      *delta_norm_w, *w_out, *norm_ffn_w, *w_router, *b_router, *w_gate_up, *b_gate_up, *w_down, *b_down;
  float* out;
  char* ws;
  int wv;
  int pad0;
};

#define LAS __attribute__((address_space(3)))
constexpr int STAGE_LDS_BYTES = 131072;
DI unsigned pk2(float a, float b) { bf2_t v; v[0] = (__bf16)a; v[1] = (__bf16)b; return __builtin_bit_cast(unsigned, v); }
DI unsigned short f2bf(float a) { return (unsigned short)(pk2(a, 0.f) & 0xffffu); }
DI float bf2f(unsigned short u) { return __uint_as_float(((unsigned)u) << 16); }
template <int CTRL> DI float dppf(float v) { return __builtin_bit_cast(float, __builtin_amdgcn_update_dpp(0, __builtin_bit_cast(int, v), CTRL, 0xf, 0xf, false)); }
template <int CTRL> DI int dppi(int v) { return __builtin_amdgcn_update_dpp(0, v, CTRL, 0xf, 0xf, false); }
DI float rlf(float v, int l) { return __builtin_bit_cast(float, __builtin_amdgcn_readlane(__builtin_bit_cast(int, v), l)); }
DI float wave_sum(float v) {
  v += dppf<0xB1>(v); v += dppf<0x4E>(v); v += dppf<0x141>(v); v += dppf<0x140>(v);
  return (rlf(v, 0) + rlf(v, 16)) + (rlf(v, 32) + rlf(v, 48));
}
DI float xor32f(float v, int lane) {
  auto r = __builtin_amdgcn_permlane32_swap(__builtin_bit_cast(unsigned, v), __builtin_bit_cast(unsigned, v), false, false);
  return __builtin_bit_cast(float, (lane < 32) ? r[1] : r[0]);
}
DI float xor16f(float v, int lane) {
  auto r = __builtin_amdgcn_permlane16_swap(__builtin_bit_cast(unsigned, v), __builtin_bit_cast(unsigned, v), false, false);
  return __builtin_bit_cast(float, (lane & 16) ? r[0] : r[1]);
}
DI int otid(const Params& p) {
  int l;
  asm volatile("v_mbcnt_lo_u32_b32 %0, -1, 0\n\tv_mbcnt_hi_u32_b32 %0, -1, %0" : "=v"(l));
  return (p.wv << 6) | l;
}
DI int swzA(int row, int col) { return row * 132 + col; }
DI int swzB(int row, int col) { return row * 68 + col; }
DI int crow(int reg, int h) { return (reg & 3) + 8 * (reg >> 2) + 4 * h; }
DI bf16x8 pack8(const f32x16& x, int s) {
  uint4 p;
  p.x = pk2(x[8 * s + 0], x[8 * s + 1]); p.y = pk2(x[8 * s + 2], x[8 * s + 3]);
  p.z = pk2(x[8 * s + 4], x[8 * s + 5]); p.w = pk2(x[8 * s + 6], x[8 * s + 7]);
  return __builtin_bit_cast(bf16x8, p);
}
DI bf16x8 ld8x2(const unsigned short* p0, const unsigned short* p1) {
  uint2 a = *(const uint2*)p0, b = *(const uint2*)p1;
  uint4 r = make_uint4(a.x, a.y, b.x, b.y);
  return __builtin_bit_cast(bf16x8, r);
}
DI bf16x8 ld16(const unsigned short* p) { uint4 r = *(const uint4*)p; return __builtin_bit_cast(bf16x8, r); }
DI const float* hrow(const Params& p, int tok) {
  int b = tok / T, t = tok - b * T;
  return (t < NM) ? (p.meta + (size_t)t * D) : (p.x + ((size_t)b * SEQ + (t - NM)) * D);
}

DI void phase_prep(const Params& p) {
  const int tid = otid(p), lane = tid & 63, wave = tid >> 6;
  float* rope = (float*)(p.ws + OFF_ROPE);
  for (int idx = blockIdx.x * NTHREADS + tid; idx < T * 32; idx += gridDim.x * NTHREADS) {
    int t = idx >> 5, i = idx & 31;
    float inv = (float)pow(10000.0, -(double)i / 32.0);
    float ang = (float)t * inv;
    double ad = (double)ang;
    double n = rint(ad * 0.15915494309189535);
    float r = (float)(ad - n * 6.283185307179586);
    float sn, cs;
    sincosf(r, &sn, &cs);
    rope[t * 64 + i] = cs;
    rope[t * 64 + 32 + i] = sn;
  }
  float* wrs = (float*)(p.ws + OFF_WRS);
  for (int idx = blockIdx.x * NTHREADS + tid; idx < 1024 * 32; idx += gridDim.x * NTHREADS) wrs[idx] = p.norm_ffn_w[idx >> 5] * p.w_router[idx];
  unsigned short* U = (unsigned short*)(p.ws + OFF_U);
  for (int tok = blockIdx.x * NWAVES + wave; tok < NT; tok += gridDim.x * NWAVES) {
    const float* src = hrow(p, tok);
    float4 v[4];
    float ss = 0.f;
#pragma unroll
    for (int i = 0; i < 4; ++i) {
      v[i] = *(const float4*)(src + lane * 4 + 256 * i);
      ss += v[i].x * v[i].x + v[i].y * v[i].y + v[i].z * v[i].z + v[i].w * v[i].w;
    }
    ss = wave_sum(ss);
    float rstd = rsqrtf(ss * (1.f / 1024.f) + 1e-6f);
#pragma unroll
    for (int i = 0; i < 4; ++i) {
      float4 w = *(const float4*)(p.norm_mix_w + lane * 4 + 256 * i);
      uint2 o;
      o.x = pk2(v[i].x * rstd * w.x, v[i].y * rstd * w.y);
      o.y = pk2(v[i].z * rstd * w.z, v[i].w * rstd * w.w);
      *(uint2*)(U + (size_t)tok * 1024 + lane * 4 + 256 * i) = o;
    }
  }
}

DI void wconv_task2(const float* src, unsigned short* dst, int K, int N, int k0, int n0, int tid) {
  const int kg = tid >> 6, n = n0 + (tid & 63) * 4, k = k0 + kg * 8;
  float4 v[8];
#pragma unroll
  for (int i = 0; i < 8; ++i) {
    v[i] = make_float4(0.f, 0.f, 0.f, 0.f);
    if (n < N) v[i] = *(const float4*)(src + (size_t)(k + i) * N + n);
  }
  uint4 o;
  o.x = pk2(v[0].x, v[1].x); o.y = pk2(v[2].x, v[3].x); o.z = pk2(v[4].x, v[5].x); o.w = pk2(v[6].x, v[7].x);
  *(uint4*)(dst + (size_t)(n + 0) * K + k) = o;
  o.x = pk2(v[0].y, v[1].y); o.y = pk2(v[2].y, v[3].y); o.z = pk2(v[4].y, v[5].y); o.w = pk2(v[6].y, v[7].y);
  *(uint4*)(dst + (size_t)(n + 1) * K + k) = o;
  o.x = pk2(v[0].z, v[1].z); o.y = pk2(v[2].z, v[3].z); o.z = pk2(v[4].z, v[5].z); o.w = pk2(v[6].z, v[7].z);
  *(uint4*)(dst + (size_t)(n + 2) * K + k) = o;
  o.x = pk2(v[0].w, v[1].w); o.y = pk2(v[2].w, v[3].w); o.z = pk2(v[4].w, v[5].w); o.w = pk2(v[6].w, v[7].w);
  *(uint4*)(dst + (size_t)(n + 3) * K + k) = o;
}
constexpr int WC_IN = 16 * 14, WC_KV = 4 * 4, WC_OUT = 16 * 4, WC_GU = 32 * 128, WC_DN = 32 * 64;
constexpr int WC_SMALL = WC_IN + WC_KV + WC_OUT, WC_ALL = WC_SMALL + WC_GU + WC_DN;
DI void wconv_task(const Params& p, int t, int tid) {
  if (t < WC_IN) {
    wconv_task2(p.w_in, (unsigned short*)(p.ws + OFF_WTIN), 1024, INC, (t / 14) * 64, (t % 14) * 256, tid);
  } else if (t < WC_IN + WC_KV) {
    t -= WC_IN;
    wconv_task2(p.w_kv_up, (unsigned short*)(p.ws + OFF_WTKV), 256, 1024, (t >> 2) * 64, (t & 3) * 256, tid);
  } else if (t < WC_SMALL) {
    t -= WC_IN + WC_KV;
    wconv_task2(p.w_out, (unsigned short*)(p.ws + OFF_WTOUT), 1024, 1024, (t >> 2) * 64, (t & 3) * 256, tid);
  } else if (t < WC_SMALL + WC_GU) {
    t -= WC_SMALL;
    const int e = t >> 7, r = t & 127;
    wconv_task2(p.w_gate_up + (size_t)e * 1024 * 2048, (unsigned short*)(p.ws + OFF_WTGU) + (size_t)e * 2048 * 1024, 1024, 2048,
                (r >> 3) * 64, (r & 7) * 256, tid);
  } else {
    t -= WC_SMALL + WC_GU;
    const int e = t >> 6, r = t & 63;
    wconv_task2(p.w_down + (size_t)e * 1024 * 1024, (unsigned short*)(p.ws + OFF_WTDN) + (size_t)e * 1024 * 1024, 1024, 1024,
                (r >> 2) * 64, (r & 3) * 256, tid);
  }
}
DI void wconv_fill(const Params& p, char* smem, int site, bool drain) {
  unsigned* q = (unsigned*)(p.ws + OFF_BAR + 15872 + 128);
  volatile LAS int* slot = (volatile LAS int*)((LAS unsigned char*)smem + STAGE_LDS_BYTES + 832);
  const int tid = otid(p);
  __syncthreads();
  if (tid == 0 && !drain) (void)__hip_atomic_fetch_add(&q[16 + site], 1u, __ATOMIC_RELAXED, __HIP_MEMORY_SCOPE_AGENT);
  for (;;) {
    __syncthreads();
    if (tid == 0) {
      int t = -1;
      const bool all_done = !drain && __hip_atomic_load(&q[16 + site], __ATOMIC_RELAXED, __HIP_MEMORY_SCOPE_AGENT) >= gridDim.x;
      if (!all_done) t = WC_SMALL + (int)__hip_atomic_fetch_add(&q[0], 1u, __ATOMIC_RELAXED, __HIP_MEMORY_SCOPE_AGENT);
      *slot = t;
    }
    __syncthreads();
    const int t = __builtin_amdgcn_readfirstlane(*slot);
    if (t < 0 || t >= WC_ALL) break;
    wconv_task(p, t, tid);
  }
}
DI void phase_wconv(const Params& p, int t0, int t1) {
  const int tid = otid(p);
  for (int t = t0 + blockIdx.x; t < t1; t += gridDim.x) wconv_task(p, t, tid);
}

namespace g8 {
constexpr int BM = 256, BK = 64, HALF = 128, HTB = HALF * BK * 2, STAGE_BYTES = 8 * HTB, NXCD = 8, WGM = 8;
constexpr int TAB_OFF = STAGE_BYTES;
constexpr int MAXU = 24;
DI int lds_byte(int r, int c) { const int st = (r >> 4) * 2 + (c >> 5), rr = r & 15, cc = c & 31, ob = rr * 64 + cc * 2; return st * 1024 + (ob ^ (((ob >> 9) & 1) << 5)); }
DI void stage_rc(int b, int& R, int& C) { const int st = b / 1024, sb = b % 1024, swz = sb ^ (((sb >> 9) & 1) << 5); R = (st >> 1) * 16 + swz / 64; C = (st & 1) * 32 + (swz % 64) / 2; }
DI int perm32(int rho) { const int n = rho >> 4, i = rho & 15; return 8 * (i >> 2) + 4 * n + (i & 3); }
DI int xcd_remap(int L, int nwg) { const int q = nwg / NXCD, r = nwg % NXCD, xcd = L % NXCD, off = L / NXCD; return (xcd < r ? xcd * (q + 1) : r * (q + 1) + (xcd - r) * q) + off; }
struct UnitT { int valid, arow, mend, pn, e, orow; };

template <int MODE> DI int n_units(const Params& p) {
  if (MODE == 0) return 65 * 14;
  if (MODE == 1) return 65 * 4;
  if (MODE == 2) return 64 * 4;
  const int* cnt = (const int*)(p.ws + OFF_CNT);
  int n = 0;
  for (int e = 0; e < NEXP; ++e) n += ((cnt[e * CNTS] + 255) >> 8) * (MODE == 3 ? 8 : 4);
  return n;
}
template <int MODE> DI void unit_of(const Params& p, int L, int nwg, UnitT& u) {
  u.valid = 0; u.arow = 0; u.mend = 0; u.pn = 0; u.e = 0; u.orow = 0;
  if (L >= nwg) return;
  const int wgid = xcd_remap(L, nwg);
  u.valid = 1;
  if (MODE <= 2) {
    const int nM = (MODE == 2) ? 64 : 65, nN = (MODE == 0) ? 14 : 4;
    const int nig = WGM * nN, gid = wgid / nig, fm = gid * WGM, gsz = (nM - fm) < WGM ? (nM - fm) : WGM;
    const int pm = fm + ((wgid % nig) % gsz);
    u.pn = (wgid % nig) / gsz;
    u.orow = pm * 256;
    u.arow = (MODE == 2) ? (pm * 256 + 16 * (pm / 16 + 1)) : pm * 256;
    u.mend = (MODE == 2) ? NR : NT;
  } else {
    const int* cnt = (const int*)(p.ws + OFF_CNT);
    constexpr int NTN = (MODE == 3) ? 8 : 4;
    int id = wgid, sbase = 0;
    for (int e = 0; e < NEXP; ++e) {
      const int c = cnt[e * CNTS], mts = (c + 255) >> 8, ne = mts * NTN;
      if (id < ne) {
        const int tn = id / mts, tm = id - tn * mts;
        u.e = e; u.pn = tn; u.arow = sbase + tm * 256; u.orow = u.arow; u.mend = sbase + c;
        return;
      }
      id -= ne;
      sbase += c;
    }
    u.valid = 0;
  }
}
DI float swiglu(float g, float u) {
  g = fminf(g, 7.0f);
  u = fminf(fmaxf(u, -7.0f), 7.0f);
  return g / (1.f + __expf(-1.702f * g)) * (u + 1.f);
}
template <int MODE>
DI void epilogue(const Params& p, const f32x4 (&acc)[2][2][4][2], const UnitT& u, int wr, int wc, int fr, int fq) {
  constexpr bool PERM = (MODE >= 3);
  const int row0 = u.orow + wr * 64 + fr;
  const int col0 = u.pn * 256 + wc * 32 + (PERM ? 8 * fq : 4 * fq);
  if (MODE == 0 || MODE == 1 || MODE == 2) {
    float* C = (float*)(p.ws + (MODE == 0 ? OFF_P : MODE == 1 ? OFF_KV : OFF_H1));
    const int ldc = (MODE == 0) ? INC : 1024;
#pragma unroll
    for (int ai = 0; ai < 2; ++ai)
#pragma unroll
      for (int m = 0; m < 4; ++m) {
        const int row = row0 + ai * 128 + m * 16;
        if (row < u.mend) {
#pragma unroll
          for (int bj = 0; bj < 2; ++bj)
#pragma unroll
            for (int n = 0; n < 2; ++n) {
              const int col = col0 + bj * 128 + n * 16;
              if (MODE != 0 || col < INC) {
                f32x4 v = acc[ai][bj][m][n];
                if (MODE == 2) v += *(const f32x4*)(p.x + (size_t)row * D + col);
                *(f32x4*)(C + (size_t)row * ldc + col) = v;
              }
            }
        }
      }
  } else if (MODE == 3) {
    unsigned short* HD = (unsigned short*)(p.ws + OFF_HD);
    f32x4 bv[2][2];
#pragma unroll
    for (int bj = 0; bj < 2; ++bj)
#pragma unroll
      for (int n = 0; n < 2; ++n) bv[bj][n] = *(const f32x4*)(p.b_gate_up + (size_t)u.e * 2048 + col0 + bj * 128 + 4 * n);
#pragma unroll
    for (int ai = 0; ai < 2; ++ai)
#pragma unroll
      for (int m = 0; m < 4; ++m) {
        const int row = row0 + ai * 128 + m * 16;
        if (row < u.mend) {
#pragma unroll
          for (int bj = 0; bj < 2; ++bj) {
            const f32x4 v0 = acc[ai][bj][m][0] + bv[bj][0], v1 = acc[ai][bj][m][1] + bv[bj][1];
            uint2 o;
            o.x = pk2(swiglu(v0[0], v0[1]), swiglu(v0[2], v0[3]));
            o.y = pk2(swiglu(v1[0], v1[1]), swiglu(v1[2], v1[3]));
            *(uint2*)(HD + (size_t)row * 1024 + (col0 + bj * 128) / 2) = o;
          }
        }
      }
  } else {
    unsigned short* Y = (unsigned short*)(p.ws + OFF_Y);
    const float* lgate = (const float*)(p.ws + OFF_LGATE);
    f32x4 bv[2][2];
#pragma unroll
    for (int bj = 0; bj < 2; ++bj)
#pragma unroll
      for (int n = 0; n < 2; ++n) bv[bj][n] = *(const f32x4*)(p.b_down + (size_t)u.e * 1024 + col0 + bj * 128 + 4 * n);
#pragma unroll
    for (int ai = 0; ai < 2; ++ai)
#pragma unroll
      for (int m = 0; m < 4; ++m) {
        const int row = row0 + ai * 128 + m * 16;
        if (row < u.mend) {
          const float gt = lgate[row];
#pragma unroll
          for (int bj = 0; bj < 2; ++bj) {
            const f32x4 v0 = (acc[ai][bj][m][0] + bv[bj][0]) * gt, v1 = (acc[ai][bj][m][1] + bv[bj][1]) * gt;
            uint4 o;
            o.x = pk2(v0[0], v0[1]); o.y = pk2(v0[2], v0[3]); o.z = pk2(v1[0], v1[1]); o.w = pk2(v1[2], v1[3]);
            *(uint4*)(Y + (size_t)row * 1024 + col0 + bj * 128) = o;
          }
        }
      }
  }
}

template <int MODE>
DI void gemm_phase(const Params& p, char* smem) {
  constexpr bool PERM = (MODE >= 3);
  constexpr int K = (MODE == 1) ? 256 : 1024, nt = K / BK;
  LAS unsigned char* lds = (LAS unsigned char*)smem;
  LAS int* tab = (LAS int*)(lds + TAB_OFF);
  const int tid = otid(p), wid = __builtin_amdgcn_readfirstlane(tid >> 6), lane = tid & 63, wr = wid >> 2, wc = wid & 3, fr = lane & 15, fq = lane >> 4;
  __syncthreads();
  {
    const int nwg = n_units<MODE>(p);
    for (int ti = 0; ti < MAXU; ++ti) {
      UnitT u;
      unit_of<MODE>(p, ti * (int)gridDim.x + (int)blockIdx.x, nwg, u);
      if (tid == 0) { tab[ti * 8 + 0] = u.valid; tab[ti * 8 + 1] = u.arow; tab[ti * 8 + 2] = u.mend; tab[ti * 8 + 3] = u.pn; tab[ti * 8 + 4] = u.e; tab[ti * 8 + 5] = u.orow; }
    }
  }
  __syncthreads();
#define G8_GETU(i, u) do { const int _i = (i); (u).valid = (_i < MAXU) ? __builtin_amdgcn_readfirstlane(tab[_i * 8 + 0]) : 0; (u).arow = __builtin_amdgcn_readfirstlane(tab[(_i < MAXU ? _i : 0) * 8 + 1]); \
    (u).mend = __builtin_amdgcn_readfirstlane(tab[(_i < MAXU ? _i : 0) * 8 + 2]); (u).pn = __builtin_amdgcn_readfirstlane(tab[(_i < MAXU ? _i : 0) * 8 + 3]); \
    (u).e = __builtin_amdgcn_readfirstlane(tab[(_i < MAXU ? _i : 0) * 8 + 4]); (u).orow = __builtin_amdgcn_readfirstlane(tab[(_i < MAXU ? _i : 0) * 8 + 5]); } while (0)
  UnitT cur, nxt;
  G8_GETU(0, cur);
  if (!cur.valid) return;
  const char* Abase = (const char*)(p.ws + (MODE == 0 ? OFF_U : MODE == 1 ? OFF_CKV : MODE == 2 ? OFF_MIX : MODE == 3 ? OFF_U2 : OFF_HD));
  const char* Bbase = (const char*)(p.ws + (MODE == 0 ? OFF_WTIN : MODE == 1 ? OFF_WTKV : MODE == 2 ? OFF_WTOUT : MODE == 3 ? OFF_WTGU : OFF_WTDN));
  constexpr size_t BEXP = (MODE == 3) ? (size_t)2048 * 1024 * 2 : (MODE == 4) ? (size_t)1024 * 1024 * 2 : 0;
  int Rr[2], Cc[2];
  unsigned voffB[2];
#pragma unroll
  for (int i = 0; i < 2; ++i) {
    stage_rc(tid * 16 + i * 8192, Rr[i], Cc[i]);
    const int Rb = PERM ? ((Rr[i] & ~31) + perm32(Rr[i] & 31)) : Rr[i];
    voffB[i] = (unsigned)(Rb * K + Cc[i]) * 2u;
  }
  unsigned voffA[2][2];
  const int* ltok = (const int*)(p.ws + OFF_LTOK);
#define G8_VOFFA(dst, un) do { _Pragma("unroll") for (int _h = 0; _h < 2; ++_h) _Pragma("unroll") for (int _i = 0; _i < 2; ++_i) { \
      if (MODE == 3) { int _s = (un).arow + _h * 128 + Rr[_i]; _s = _s < NASG ? _s : NASG - 1; dst[_h][_i] = (unsigned)(ltok[_s] * K + Cc[_i]) * 2u; } \
      else dst[_h][_i] = (unsigned)((_h * 128 + Rr[_i]) * K + Cc[_i]) * 2u; } } while (0)
  const size_t kstep = (size_t)(BK * 2);
  const size_t hstep = (size_t)HALF * K * 2;
  const size_t tstep = 2 * hstep;
  const unsigned ldsw = (unsigned)wid * 1024u;
  const int aoff = lds_byte(wr * 64 + fr, fq * 8), boff = lds_byte(wc * 32 + fr, fq * 8);
#define G8_SA(b, h) (((b) * 2 + (h)) * HTB)
#define G8_SB(b, h) ((4 + (b) * 2 + (h)) * HTB)
#define G8_STAGE(bufoff, gbase, voff) do { _Pragma("unroll") for (int _i = 0; _i < 2; ++_i) \
    __builtin_amdgcn_global_load_lds((const unsigned*)((const char*)(gbase) + (voff)[_i]), (LAS unsigned*)(lds + (bufoff) + ldsw + _i * 8192), 16, 0, 0); } while (0)
#define G8_LDA(dst, b, h) do { _Pragma("unroll") for (int m = 0; m < 4; ++m) _Pragma("unroll") for (int k = 0; k < 2; ++k) dst[m][k] = *(const LAS bf16x8*)(lds + G8_SA(b, h) + aoff + m * 2048 + k * 1024); } while (0)
#define G8_LDB(dst, b, h) do { _Pragma("unroll") for (int n = 0; n < 2; ++n) _Pragma("unroll") for (int k = 0; k < 2; ++k) dst[n][k] = *(const LAS bf16x8*)(lds + G8_SB(b, h) + boff + n * 2048 + k * 1024); } while (0)
#define G8_MMA(ai, bj, At, Bt) do { __builtin_amdgcn_s_setprio(1); _Pragma("unroll") for (int m = 0; m < 4; ++m) _Pragma("unroll") for (int n = 0; n < 2; ++n) _Pragma("unroll") for (int k = 0; k < 2; ++k) \
    acc[ai][bj][m][n] = __builtin_amdgcn_mfma_f32_16x16x32_bf16(Bt[n][k], At[m][k], acc[ai][bj][m][n], 0, 0, 0); __builtin_amdgcn_s_setprio(0); } while (0)
#define G8_WAIT_V(n) asm volatile("s_waitcnt vmcnt(" #n ")" ::: "memory")
#define G8_WAIT_L(n) asm volatile("s_waitcnt lgkmcnt(" #n ")" ::: "memory")
#define G8_BAR __builtin_amdgcn_s_barrier()
#define G8_SCHED __builtin_amdgcn_sched_barrier(0)
  int ui = 0;
  f32x4 acc[2][2][4][2];
#pragma unroll
  for (int a = 0; a < 2; ++a)
#pragma unroll
    for (int b = 0; b < 2; ++b)
#pragma unroll
      for (int m = 0; m < 4; ++m)
#pragma unroll
        for (int n = 0; n < 2; ++n) acc[a][b][m][n] = (f32x4){0.f, 0.f, 0.f, 0.f};
  bf16x8 At[4][2], B0[2][2], B1[2][2];
  G8_VOFFA(voffA, cur);
  if (MODE == 3) asm volatile("s_waitcnt vmcnt(0)" ::: "memory");
  const char* cA = (MODE == 3) ? Abase : Abase + (size_t)cur.arow * K * 2;
  const char* cB = Bbase + (size_t)cur.e * BEXP + (size_t)cur.pn * tstep;
  G8_STAGE(G8_SB(0, 0), cB, voffB); G8_STAGE(G8_SA(0, 0), cA, voffA[0]); G8_STAGE(G8_SB(0, 1), cB + hstep, voffB); G8_STAGE(G8_SA(0, 1), cA, voffA[1]);
  if (wr == 1) G8_BAR;
  G8_WAIT_V(4); G8_BAR;
  G8_STAGE(G8_SB(1, 0), cB + kstep, voffB); G8_STAGE(G8_SA(1, 0), cA + kstep, voffA[0]); G8_STAGE(G8_SB(1, 1), cB + hstep + kstep, voffB);
  G8_WAIT_V(6); G8_BAR;
  for (;;) {
    G8_GETU(ui + 1, nxt);
    const bool has_next = nxt.valid != 0;
    const char* nA = has_next ? ((MODE == 3) ? Abase : Abase + (size_t)nxt.arow * K * 2) : cA;
    const char* nB = has_next ? Bbase + (size_t)nxt.e * BEXP + (size_t)nxt.pn * tstep : cB;
#pragma unroll 1
    for (int t = 0; t < nt; t += 2) {
      const bool last = (t == nt - 2);
      const char* a1 = cA + (size_t)(t + 1) * kstep;
      const char* a2 = last ? nA : cA + (size_t)(t + 2) * kstep;
      const char* b2 = last ? nB : cB + (size_t)(t + 2) * kstep;
      const char* a3 = a2 + kstep;
      const char* b3 = b2 + kstep;
      G8_LDB(B0, 0, 0); G8_SCHED; G8_LDA(At, 0, 0); G8_STAGE(G8_SA(1, 1), a1, voffA[1]);
      if (MODE == 3) {
        if (last && has_next) {
          G8_VOFFA(voffA, nxt);
          asm volatile("s_waitcnt vmcnt(0)" ::: "memory");
        }
      }
      G8_WAIT_L(8); G8_BAR; G8_WAIT_L(0); G8_MMA(0, 0, At, B0); G8_BAR; G8_SCHED;
      G8_LDB(B1, 0, 1); G8_STAGE(G8_SB(0, 0), b2, voffB);
      G8_BAR; G8_WAIT_L(0); G8_MMA(0, 1, At, B1); G8_BAR;
      G8_LDA(At, 0, 1); G8_STAGE(G8_SA(0, 0), a2, voffA[0]);
      G8_BAR; G8_WAIT_L(0); G8_MMA(1, 0, At, B0); G8_BAR; G8_SCHED;
      G8_STAGE(G8_SB(0, 1), b2 + hstep, voffB);
      G8_WAIT_V(6); G8_BAR; G8_MMA(1, 1, At, B1); G8_BAR;
      G8_LDB(B0, 1, 0); G8_SCHED; G8_LDA(At, 1, 0); G8_STAGE(G8_SA(0, 1), a2, voffA[1]);
      G8_WAIT_L(8); G8_BAR; G8_WAIT_L(0); G8_MMA(0, 0, At, B0); G8_BAR; G8_SCHED;
      G8_LDB(B1, 1, 1); G8_STAGE(G8_SB(1, 0), b3, voffB);
      G8_BAR; G8_WAIT_L(0); G8_MMA(0, 1, At, B1); G8_BAR;
      G8_LDA(At, 1, 1); G8_STAGE(G8_SA(1, 0), a3, voffA[0]);
      G8_BAR; G8_WAIT_L(0); G8_MMA(1, 0, At, B0); G8_BAR; G8_SCHED;
      G8_STAGE(G8_SB(1, 1), b3 + hstep, voffB);
      G8_WAIT_V(6); G8_BAR; G8_MMA(1, 1, At, B1); G8_BAR;
    }
    epilogue<MODE>(p, acc, cur, wr, wc, fr, fq);
    if (!has_next) break;
#pragma unroll
    for (int a = 0; a < 2; ++a)
#pragma unroll
      for (int b = 0; b < 2; ++b)
#pragma unroll
        for (int m = 0; m < 4; ++m)
#pragma unroll
          for (int n = 0; n < 2; ++n) acc[a][b][m][n] = (f32x4){0.f, 0.f, 0.f, 0.f};
    cur = nxt; cA = nA; cB = nB; ++ui;
  }
  G8_WAIT_V(0);
  if (wr == 0) G8_BAR;
  G8_BAR;
#undef G8_GETU
#undef G8_VOFFA
#undef G8_SA
#undef G8_SB
#undef G8_STAGE
#undef G8_LDA
#undef G8_LDB
#undef G8_MMA
#undef G8_WAIT_V
#undef G8_WAIT_L
#undef G8_BAR
#undef G8_SCHED
}
}

DI float rope_apply(float v, float c, float s, int lane) {
  float o = xor32f(v, lane);
  return (lane < 32) ? (v * c - o * s) : (v * c + o * s);
}
DI void phase_post1(const Params& p, char* smem) {
  const int tid = otid(p), lane = tid & 63, wave = tid >> 6;
  const float* P = (const float*)(p.ws + OFF_P);
  const float* rope = (const float*)(p.ws + OFF_ROPE);
  unsigned short* Qb = (unsigned short*)(p.ws + OFF_QB);
  unsigned short* QI = (unsigned short*)(p.ws + OFF_QI);
  unsigned short* KI = (unsigned short*)(p.ws + OFF_KI);
  unsigned short* CKV = (unsigned short*)(p.ws + OFF_CKV);
  float* WI = (float*)(p.ws + OFF_WI);
  float* Qd = (float*)(p.ws + OFF_QD);
  float* Kd = (float*)(p.ws + OFF_KD);
  float* Vd = (float*)(p.ws + OFF_VD);
  float* BETA = (float*)(p.ws + OFF_BETA);
  float* G = (float*)(p.ws + OFF_G);
  float* cw = (float*)smem;
  __syncthreads();
  for (int idx = tid; idx < 4 * 1536; idx += NTHREADS) cw[idx] = p.conv_w[idx];
  __syncthreads();
  const float qw = p.q_norm_w[lane];
  const float4 kvw = *(const float4*)(p.kv_norm_w + lane * 4);
  constexpr int PG = 4;
  for (int g = blockIdx.x * NWAVES + wave; g < NT / PG; g += gridDim.x * NWAVES) {
    const int tok0 = g * PG, b = tok0 / T, t0 = tok0 - b * T;
    const int tailc = (lane < 8) ? (C_IW + lane) : (C_BBETA + ((lane - 8) & 7));
    float nqv[8], niv[8];
    float4 nckv;
    float nikv, ntail;
    {
      const float* row = P + (size_t)tok0 * INC;
#pragma unroll
      for (int hh = 0; hh < 8; ++hh) { nqv[hh] = row[C_AQ + hh * 64 + lane]; niv[hh] = row[C_IQ + hh * 64 + lane]; }
      nckv = *(const float4*)(row + C_CKV + lane * 4);
      nikv = row[C_IK + lane];
      ntail = row[tailc];
    }
#pragma unroll 1
    for (int tt = 0; tt < PG; ++tt) {
      const int tok = tok0 + tt, t = t0 + tt;
      float qv[8], iv[8];
#pragma unroll
      for (int hh = 0; hh < 8; ++hh) { qv[hh] = nqv[hh]; iv[hh] = niv[hh]; }
      const float4 ckv = nckv;
      const float ikv = nikv, tailv = ntail;
      if (tt + 1 < PG) {
        const float* row = P + (size_t)(tok + 1) * INC;
#pragma unroll
        for (int hh = 0; hh < 8; ++hh) { nqv[hh] = row[C_AQ + hh * 64 + lane]; niv[hh] = row[C_IQ + hh * 64 + lane]; }
        nckv = *(const float4*)(row + C_CKV + lane * 4);
        nikv = row[C_IK + lane];
        ntail = row[tailc];
      }
      const float cs = rope[t * 64 + (lane & 31)], sn = rope[t * 64 + 32 + (lane & 31)];
      unsigned short* qb = Qb + (size_t)tok * 512 + lane;
      unsigned short* qi = QI + (size_t)tok * 512 + lane;
#pragma unroll
      for (int hh = 0; hh < 8; ++hh) {
        float v = qv[hh];
        const float ss = wave_sum(v * v);
        v = v * rsqrtf(ss * (1.f / 64.f) + 1e-6f) * qw;
        qb[hh * 64] = f2bf(rope_apply(v, cs, sn, lane));
        qi[hh * 64] = f2bf(rope_apply(iv[hh], cs, sn, lane));
      }
      {
        const float ss = wave_sum(ckv.x * ckv.x + ckv.y * ckv.y + ckv.z * ckv.z + ckv.w * ckv.w);
        const float rstd = rsqrtf(ss * (1.f / 256.f) + 1e-6f);
        uint2 o;
        o.x = pk2(ckv.x * rstd * kvw.x, ckv.y * rstd * kvw.y);
        o.y = pk2(ckv.z * rstd * kvw.z, ckv.w * rstd * kvw.w);
        *(uint2*)(CKV + (size_t)tok * 256 + lane * 4) = o;
      }
      KI[(size_t)tok * 64 + lane] = f2bf(rope_apply(ikv, cs, sn, lane));
      if (lane < 8) WI[(size_t)tok * 8 + lane] = tailv * 0.04419417382415922f;
      if (lane >= 8 && lane < 12) BETA[(size_t)tok * 4 + (lane - 8)] = 1.f / (1.f + expf(-tailv));
      if (lane >= 12 && lane < 16) {
        const float xx = tailv + p.dt_bias[lane - 12];
        const float sp = fmaxf(xx, 0.f) + log1pf(expf(-fabsf(xx)));
        G[(size_t)tok * 4 + (lane - 12)] = -expf(p.a_log[lane - 12]) * sp;
      }
    }
    float x0[24], x1[24], x2[24];
    {
      const float* base = P + (size_t)tok0 * INC + C_BQKV + lane;
#pragma unroll
      for (int i = 0; i < 24; ++i) {
        x0[i] = (t0 >= 3) ? base[64 * i - 3 * (ptrdiff_t)INC] : 0.f;
        x1[i] = (t0 >= 2) ? base[64 * i - 2 * (ptrdiff_t)INC] : 0.f;
        x2[i] = (t0 >= 1) ? base[64 * i - 1 * (ptrdiff_t)INC] : 0.f;
      }
    }
    float xn[24];
    {
      const float* xr = P + (size_t)tok0 * INC + C_BQKV + lane;
#pragma unroll
      for (int i = 0; i < 24; ++i) xn[i] = xr[64 * i];
    }
#pragma unroll 1
    for (int tt = 0; tt < PG; ++tt) {
      const int tok = tok0 + tt;
      float x3[24];
#pragma unroll
      for (int i = 0; i < 24; ++i) x3[i] = xn[i];
      if (tt + 1 < PG) {
        const float* xr = P + (size_t)(tok + 1) * INC + C_BQKV + lane;
#pragma unroll
        for (int i = 0; i < 24; ++i) xn[i] = xr[64 * i];
      }
      int cl = lane;
      asm volatile("" : "+v"(cl));
      float* qd = Qd + (size_t)tok * 512 + lane;
      float* kd = Kd + (size_t)tok * 512 + lane;
      float* vd = Vd + (size_t)tok * 512 + lane;
#pragma unroll
      for (int hd = 0; hd < 4; ++hd) {
        float cv[6];
#pragma unroll
        for (int q = 0; q < 6; ++q) {
          const int i = (q >> 1) * 8 + 2 * hd + (q & 1);
          const int c = cl + 64 * i;
          const float a = cw[c] * x0[i] + cw[1536 + c] * x1[i] + cw[2 * 1536 + c] * x2[i] + cw[3 * 1536 + c] * x3[i];
          cv[q] = a / (1.f + __expf(-a));
          x0[i] = x1[i]; x1[i] = x2[i]; x2[i] = x3[i];
        }
        float ss = wave_sum(cv[0] * cv[0] + cv[1] * cv[1]);
        float r = rsqrtf(ss + 1e-6f);
        qd[hd * 128] = cv[0] * r;
        qd[hd * 128 + 64] = cv[1] * r;
        ss = wave_sum(cv[2] * cv[2] + cv[3] * cv[3]);
        r = rsqrtf(ss + 1e-6f);
        kd[hd * 128] = cv[2] * r;
        kd[hd * 128 + 64] = cv[3] * r;
        vd[hd * 128] = cv[4];
        vd[hd * 128 + 64] = cv[5];
      }
    }
  }
}

DI void phase_post2(const Params& p, char* smem) {
  (void)smem;
  const int tid = otid(p), lane = tid & 63, wave = tid >> 6;
  const float* KV = (const float*)(p.ws + OFF_KV);
  const float* rope = (const float*)(p.ws + OFF_ROPE);
  unsigned short* Kb = (unsigned short*)(p.ws + OFF_KB);
  unsigned short* Vb = (unsigned short*)(p.ws + OFF_VT);
  const float kw = p.k_norm_w[lane];
  for (int tok = blockIdx.x * NWAVES + wave; tok < NT; tok += gridDim.x * NWAVES) {
    const int b = tok / T, t = tok - b * T;
    const float* row = KV + (size_t)tok * 1024;
    float kv[8], vv[8];
#pragma unroll
    for (int hh = 0; hh < 8; ++hh) { kv[hh] = row[hh * 64 + lane]; vv[hh] = row[512 + hh * 64 + lane]; }
    const float cs = rope[t * 64 + (lane & 31)], sn = rope[t * 64 + 32 + (lane & 31)];
    unsigned short* kb = Kb + (size_t)tok * 512 + lane;
    unsigned short* vb = Vb + (size_t)tok * 512 + lane;
#pragma unroll
    for (int hh = 0; hh < 8; ++hh) {
      float v = kv[hh];
      const float ss = wave_sum(v * v);
      v = v * rsqrtf(ss * (1.f / 64.f) + 1e-6f) * kw;
      kb[hh * 64] = f2bf(rope_apply(v, cs, sn, lane));
      vb[hh * 64] = f2bf(vv[hh]);
    }
  }
}

constexpr int KS_STRIDE = 129, AM_STRIDE = 65;
DI void phase_chunkprep(const Params& p, char* smem) {
  constexpr int KQ = 136;
  unsigned short* K16 = (unsigned short*)smem;
  unsigned short* Q16 = K16 + 64 * KQ;
  float* Am = (float*)(Q16 + 64 * KQ);
  float* Tm = Am + 64 * AM_STRIDE;
  float* gc = Tm + 64 * AM_STRIDE;
  float* bet = gc + 64;
  float* gl = bet + 64;
  unsigned short* T16 = (unsigned short*)(gl + 64);
  float* Mt = (float*)T16;
  unsigned short* VbT = T16 + 64 * 72;
  unsigned short* KbT = VbT + 128 * 72;
  static_assert(2 * 64 * KQ * 2 + (64 * AM_STRIDE * 2 + 192) * 4 + (64 * 72 + 2 * 128 * 72) * 2 <= 131072, "chunk prep LDS");
  const int tid = otid(p), lane = tid & 63, wave = tid >> 6;
  const float* Qd = (const float*)(p.ws + OFF_QD);
  const float* Kd = (const float*)(p.ws + OFF_KD);
  const float* Vd = (const float*)(p.ws + OFF_VD);
  const float* BETA = (const float*)(p.ws + OFF_BETA);
  const float* G = (const float*)(p.ws + OFF_G);
  unsigned short* CHB = (unsigned short*)(p.ws + OFF_WN);
  float* UU = (float*)(p.ws + OFF_UU);
  float* DL = (float*)(p.ws + OFF_DL);
  for (int ci = blockIdx.x; ci < NCHT; ci += gridDim.x) {
    unsigned short* chb = CHB + (size_t)ci * CHB_ELEMS;
    const int bh = ci / NCH, c = ci - bh * NCH, b = bh >> 2, h = bh & 3;
    __syncthreads();
    if (tid < 64) {
      int t = c * 64 + tid - 48;
      float g = 0.f, be = 0.f;
      if (t >= 0) { g = G[(size_t)(b * T + t) * 4 + h]; be = BETA[(size_t)(b * T + t) * 4 + h]; }
      gl[tid] = g;
      bet[tid] = be;
    }
    __syncthreads();
    if (tid < 64) {
      float s2 = 0.f;
      for (int j = 0; j <= tid; ++j) s2 += gl[j];
      gc[tid] = s2;
    }
    __syncthreads();
#pragma unroll 1
    for (int hb = 0; hb < 2; ++hb) {
      float kr[8], qr[8], vr[8];
#pragma unroll
      for (int it = 0; it < 8; ++it) {
        const int idx = tid + (hb * 8 + it) * NTHREADS, i = idx >> 7, d = idx & 127;
        const int t = c * 64 + i - 48;
        kr[it] = 0.f; qr[it] = 0.f; vr[it] = 0.f;
        if (t >= 0) {
          const size_t o = ((size_t)(b * T + t)) * 512 + h * 128 + d;
          kr[it] = Kd[o];
          qr[it] = Qd[o] * 0.08838834764831845f;
          vr[it] = Vd[o];
        }
      }
#pragma unroll
      for (int it = 0; it < 8; ++it) {
        const int idx = tid + (hb * 8 + it) * NTHREADS, i = idx >> 7, d = idx & 127;
        const float bi = bet[i], eg = __expf(gc[i]);
        K16[i * KQ + d] = f2bf(kr[it]);
        Q16[i * KQ + d] = f2bf(qr[it]);
        VbT[d * 72 + i] = f2bf(bi * vr[it]);
        KbT[d * 72 + i] = f2bf(bi * eg * kr[it]);
        chb[CH_QG + swzA(i, d)] = f2bf(qr[it] * eg);
      }
    }
    __syncthreads();
    {
      const int mat = wave >> 2, tl = wave & 3, lr = lane & 31, lh = lane >> 5;
      if (tl < 3) {
        const int mt = (tl + 1) >> 1, nt = tl >> 1;
        const unsigned short* At = mat ? Q16 : K16;
        f32x16 acc;
#pragma unroll
        for (int r = 0; r < 16; ++r) acc[r] = 0.f;
#pragma unroll
        for (int ks = 0; ks < 8; ++ks) {
          const bf16x8 af = ld16(At + (mt * 32 + lr) * KQ + ks * 16 + 8 * lh);
          const bf16x8 bfr = ld16(K16 + (nt * 32 + lr) * KQ + ks * 16 + 8 * lh);
          acc = MFMA32(af, bfr, acc);
        }
        const int j = nt * 32 + lr;
        const float gj = gc[j];
#pragma unroll
        for (int r = 0; r < 16; ++r) {
          const int i = mt * 32 + crow(r, lh);
          const float dec = (j <= i) ? __expf(gc[i] - gj) : 0.f;
          if (mat == 0) Am[i * AM_STRIDE + j] = (j < i) ? bet[i] * acc[r] * dec : 0.f;
          else chb[CH_IN + swzB(i, j)] = f2bf(acc[r] * dec);
        }
      } else {
        const int lr = lane & 31, lh = lane >> 5;
#pragma unroll
        for (int r = 0; r < 16; ++r) {
          const int i = crow(r, lh), j = 32 + lr;
          if (mat == 0) Am[i * AM_STRIDE + j] = 0.f;
          else chb[CH_IN + swzB(i, j)] = 0;
        }
      }
    }
    __syncthreads();
    {
      for (int idx = tid; idx < 64 * 64; idx += NTHREADS) Tm[(idx >> 6) * AM_STRIDE + (idx & 63)] = 0.f;
      __syncthreads();
      if (tid < 64) {
        const int bb = tid >> 4, cc = tid & 15, o = 16 * bb;
        float x[16];
#pragma unroll
        for (int i = 0; i < 16; ++i) {
          float a = (i == cc) ? 1.f : 0.f;
#pragma unroll
          for (int j = 0; j < 16; ++j)
            if (j < i) a -= Am[(o + i) * AM_STRIDE + o + j] * x[j];
          x[i] = a;
          Tm[(o + i) * AM_STRIDE + o + cc] = a;
        }
      }
      __syncthreads();
      {
        const int B = tid >> 8, i = (tid >> 4) & 15, j = tid & 15, o = 32 * B;
        float m = 0.f;
#pragma unroll
        for (int k = 0; k < 16; ++k) m += Am[(o + 16 + i) * AM_STRIDE + o + k] * Tm[(o + k) * AM_STRIDE + o + j];
        Mt[(B * 16 + i) * 33 + j] = m;
        __syncthreads();
        float t = 0.f;
#pragma unroll
        for (int k = 0; k < 16; ++k) t += Tm[(o + 16 + i) * AM_STRIDE + o + 16 + k] * Mt[(B * 16 + k) * 33 + j];
        __syncthreads();
        Tm[(o + 16 + i) * AM_STRIDE + o + j] = -t;
      }
      __syncthreads();
      {
        const int i = tid >> 4, j0 = (tid & 15) * 2;
        float m0 = 0.f, m1 = 0.f;
        for (int k = 0; k < 32; ++k) {
          const float a = Am[(32 + i) * AM_STRIDE + k];
          m0 += a * Tm[k * AM_STRIDE + j0];
          m1 += a * Tm[k * AM_STRIDE + j0 + 1];
        }
        Mt[i * 33 + j0] = m0;
        Mt[i * 33 + j0 + 1] = m1;
        __syncthreads();
        float t0 = 0.f, t1 = 0.f;
        for (int k = 0; k < 32; ++k) {
          const float a = Tm[(32 + i) * AM_STRIDE + 32 + k];
          t0 += a * Mt[k * 33 + j0];
          t1 += a * Mt[k * 33 + j0 + 1];
        }
        __syncthreads();
        Tm[(32 + i) * AM_STRIDE + j0] = -t0;
        Tm[(32 + i) * AM_STRIDE + j0 + 1] = -t1;
      }
    }
    __syncthreads();
    for (int idx = tid; idx < 64 * 64; idx += NTHREADS) T16[(idx >> 6) * 72 + (idx & 63)] = f2bf(Tm[(idx >> 6) * AM_STRIDE + (idx & 63)]);
    __syncthreads();
    {
      const int mat = wave >> 2, nt = wave & 3, lr = lane & 31, lh = lane >> 5;
      const unsigned short* Bt = mat ? KbT : VbT;
#pragma unroll
      for (int mt = 0; mt < 2; ++mt) {
        f32x16 acc;
#pragma unroll
        for (int r = 0; r < 16; ++r) acc[r] = 0.f;
#pragma unroll
        for (int ks = 0; ks < 4; ++ks) {
          const bf16x8 af = ld16(T16 + (mt * 32 + lr) * 72 + ks * 16 + 8 * lh);
          const bf16x8 bfr = ld16(Bt + (nt * 32 + lr) * 72 + ks * 16 + 8 * lh);
          acc = MFMA32(af, bfr, acc);
        }
        if (mat == 0) {
          float* up = UU + (size_t)ci * 8192 + (((nt * 2 + mt) * 2 + lh) * 32 + lr) * 16;
#pragma unroll
          for (int q = 0; q < 4; ++q) *(float4*)(up + 4 * q) = make_float4(acc[4 * q], acc[4 * q + 1], acc[4 * q + 2], acc[4 * q + 3]);
        } else {
#pragma unroll
          for (int r = 0; r < 16; ++r) chb[swzA(mt * 32 + crow(r, lh), nt * 32 + lr)] = f2bf(-acc[r]);
        }
      }
    }
    const float glast = gc[63];
    for (int idx = tid; idx < 64 * 128; idx += NTHREADS) {
      int i = idx & 63, d = idx >> 6;
      chb[CH_KDT + swzB(d, i)] = f2bf(bf2f(K16[i * KQ + d]) * __expf(glast - gc[i]));
    }
    if (tid == 0) DL[ci] = __expf(glast);
  }
}

DI float relu_fma(float w, float x, float acc) {
  const int xi = __builtin_bit_cast(int, x);
  const float m = __builtin_bit_cast(float, xi > 0 ? xi : 0);
  return __builtin_fmaf(w, m, acc);
}
DI unsigned ordkey(float f) {
  unsigned u = __float_as_uint(f);
  return (u & 0x80000000u) ? ~u : (u | 0x80000000u);
}
DI int half_sum(int v) {
  v += dppi<0xB1>(v); v += dppi<0x4E>(v); v += dppi<0x141>(v); v += dppi<0x140>(v);
  const int lo = __builtin_amdgcn_readlane(v, 0) + __builtin_amdgcn_readlane(v, 16);
  const int hi = __builtin_amdgcn_readlane(v, 32) + __builtin_amdgcn_readlane(v, 48);
  return (__builtin_amdgcn_mbcnt_hi(~0u, __builtin_amdgcn_mbcnt_lo(~0u, 0u)) < 32u) ? lo : hi;
}
DI int cnt4_ge(int cnt, unsigned a, unsigned b, unsigned c, unsigned d, unsigned cand) {
  unsigned long long m0, m1, m2, m3;
  asm("v_cmp_ge_u32_e64 %1, %5, %9\n\tv_cmp_ge_u32_e64 %2, %6, %9\n\tv_cmp_ge_u32_e64 %3, %7, %9\n\tv_cmp_ge_u32_e64 %4, %8, %9\n\t"
      "v_addc_co_u32_e64 %0, %1, %0, 0, %1\n\tv_addc_co_u32_e64 %0, %2, %0, 0, %2\n\tv_addc_co_u32_e64 %0, %3, %0, 0, %3\n\tv_addc_co_u32_e64 %0, %4, %0, 0, %4"
      : "+v"(cnt), "=&s"(m0), "=&s"(m1), "=&s"(m2), "=&s"(m3)
      : "v"(a), "v"(b), "v"(c), "v"(d), "v"(cand));
  return cnt;
}
DI int cnt4_gt(int cnt, unsigned a, unsigned b, unsigned c, unsigned d, unsigned cand) {
  unsigned long long m0, m1, m2, m3;
  asm("v_cmp_gt_u32_e64 %1, %5, %9\n\tv_cmp_gt_u32_e64 %2, %6, %9\n\tv_cmp_gt_u32_e64 %3, %7, %9\n\tv_cmp_gt_u32_e64 %4, %8, %9\n\t"
      "v_addc_co_u32_e64 %0, %1, %0, 0, %1\n\tv_addc_co_u32_e64 %0, %2, %0, 0, %2\n\tv_addc_co_u32_e64 %0, %3, %0, 0, %3\n\tv_addc_co_u32_e64 %0, %4, %0, 0, %4"
      : "+v"(cnt), "=&s"(m0), "=&s"(m1), "=&s"(m2), "=&s"(m3)
      : "v"(a), "v"(b), "v"(c), "v"(d), "v"(cand));
  return cnt;
}
DI void indexer_task(const Params& p, char* smem, int b, int q8, int wave, int lane) {
  const int q0 = (q8 * 8 + wave) * 2;
  unsigned* MASK = (unsigned*)(p.ws + OFF_MASK);
  const int qsel = lane >> 5;
  const int tq = q0 + qsel;
  unsigned* mrow = MASK + ((size_t)b * SEQ + tq) * 128;
  if (q8 < 16) {
    for (int i = (lane & 31); i < 128; i += 32) {
      int rem = tq + 1 - 32 * i;
      unsigned w = (rem >= 32) ? 0xffffffffu : (rem > 0 ? ((1u << rem) - 1u) : 0u);
      mrow[i] = w;
    }
    return;
  }
  const unsigned short* QI = (const unsigned short*)(p.ws + OFF_QI);
  const unsigned short* KI = (const unsigned short*)(p.ws + OFF_KI);
  const float* WI = (const float*)(p.ws + OFF_WI);
  const int l15 = lane & 15, lg = lane >> 4;
  const size_t qtok = (size_t)b * T + NM + q0 + (l15 >> 3);
  const bf16x8 a0 = ld16(QI + qtok * 512 + (l15 & 7) * 64 + 8 * lg);
  const bf16x8 a1 = ld16(QI + qtok * 512 + (l15 & 7) * 64 + 32 + 8 * lg);
  float w[4];
  {
    const size_t wtok = (size_t)b * T + NM + q0 + (lg >> 1);
#pragma unroll
    for (int r = 0; r < 4; ++r) w[r] = WI[wtok * 8 + 4 * (lg & 1) + r];
  }
  const int npairs = (q0 + 2 + 31) >> 5;
  const int npmax = (16 * q8 + 16 + 31) >> 5;
  LAS unsigned char* lds = (LAS unsigned char*)smem;
  const bool loader = wave < 4;
  const unsigned short* ksrc = KI + ((size_t)b * T + NM + 8 * wave + (lane >> 3)) * 64 + (((lane & 7) ^ (lane >> 3)) << 3);
  const unsigned frag0 = (unsigned)(l15 * 128 + ((lg ^ (l15 & 7)) << 4));
  const unsigned frag1 = (unsigned)(l15 * 128 + (((4 + lg) ^ (l15 & 7)) << 4));
  asm volatile("s_waitcnt vmcnt(0)" ::: "memory");
  __syncthreads();
#define IX_DMA(stage) __builtin_amdgcn_global_load_lds((const unsigned*)(ksrc + (size_t)(stage) * 2048), (LAS unsigned*)(lds + ((stage) & 3) * 4096 + wave * 1024), 16, 0, 0)
  if (loader) {
    IX_DMA(0);
    if (1 < npmax) IX_DMA(1);
    if (2 < npmax) IX_DMA(2);
  }
  unsigned u[128];
  int rem = tq - (lane & 31);
#pragma unroll
  for (int i = 0; i < 128; ++i) {
    unsigned uv = 0u;
    if (i < npmax) {
      if (loader) {
        if (i + 2 < npmax) asm volatile("s_waitcnt vmcnt(2)" ::: "memory");
        else if (i + 1 < npmax) asm volatile("s_waitcnt vmcnt(1)" ::: "memory");
        else asm volatile("s_waitcnt vmcnt(0)" ::: "memory");
      }
      __builtin_amdgcn_s_barrier();
      if (loader && i + 3 < npmax) IX_DMA(i + 3);
      if (i < npairs) {
        const LAS unsigned char* sb = lds + (i & 3) * 4096;
        float tot[2];
#pragma unroll
        for (int par = 0; par < 2; ++par) {
          const bf16x8 b0 = *(const LAS bf16x8*)(sb + par * 2048 + frag0);
          const bf16x8 b1 = *(const LAS bf16x8*)(sb + par * 2048 + frag1);
          f32x4 acc = {0.f, 0.f, 0.f, 0.f};
          acc = MFMA16(a0, b0, acc);
          acc = MFMA16(a1, b1, acc);
          float part = 0.f;
#pragma unroll
          for (int r = 0; r < 4; ++r) part = relu_fma(w[r], acc[r], part);
          tot[par] = part + xor16f(part, lane);
        }
        const float sc = (lg & 1) ? tot[1] : tot[0];
        uv = (rem >= 0) ? ordkey(sc) : 0u;
      }
    }
    u[i] = uv;
    rem -= 32;
    asm volatile("" : "+v"(rem));
  }
#undef IX_DMA
  __builtin_amdgcn_s_barrier();
  const int nblk = (npairs + 15) >> 4;
  unsigned thr = 0u;
  bool done = false;
  for (int bit = 31; bit >= 0; --bit) {
    const unsigned cand = thr | (1u << bit);
    int cnt = 0;
#pragma unroll
    for (int blk = 0; blk < 8; ++blk) {
      if (blk < nblk) {
#pragma unroll
        for (int j = 0; j < 16; j += 4) cnt = cnt4_ge(cnt, u[blk * 16 + j], u[blk * 16 + j + 1], u[blk * 16 + j + 2], u[blk * 16 + j + 3], cand);
      }
    }
    cnt = half_sum(cnt);
    if (!done && cnt >= 256) thr = cand;
    done = done || (cnt == 256);
    if (__all(done)) break;
  }
  int cgt = 0;
#pragma unroll
  for (int blk = 0; blk < 8; ++blk) {
    if (blk < nblk) {
#pragma unroll
      for (int j = 0; j < 16; j += 4) cgt = cnt4_gt(cgt, u[blk * 16 + j], u[blk * 16 + j + 1], u[blk * 16 + j + 2], u[blk * 16 + j + 3], thr);
    }
  }
  cgt = half_sum(cgt);
  const int need = 256 - cgt;
  int base = 0;
  const unsigned lt_mask = (1u << (lane & 31)) - 1u;
#pragma unroll
  for (int blk = 0; blk < 8; ++blk) {
    if (blk < nblk) {
#pragma unroll
      for (int j = 0; j < 16; ++j) {
        const int i = blk * 16 + j;
        const bool eq = (u[i] == thr);
        const unsigned long long eb = __ballot(eq);
        const unsigned ehalf = qsel ? (unsigned)(eb >> 32) : (unsigned)eb;
        const int below = __popc(ehalf & lt_mask);
        const bool sel = (u[i] > thr) || (eq && (base + below < need));
        base += __popc(ehalf);
        const unsigned long long sb = __ballot(sel);
        const unsigned shalf = qsel ? (unsigned)(sb >> 32) : (unsigned)sb;
        if ((lane & 31) == 0) mrow[i] = shalf;
      }
    }
  }
}
DI void phase_indexer(const Params& p, char* smem) {
  const int tid = otid(p), lane = tid & 63, wave = __builtin_amdgcn_readfirstlane(tid >> 6);
  unsigned* ctr = (unsigned*)(p.ws + OFF_BAR + 15872 + 64);
  volatile LAS int* slot = (volatile LAS int*)((LAS unsigned char*)smem + g8::STAGE_BYTES + 800);
  const int ngroup = NB * (SEQ / 16);
  for (;;) {
    __syncthreads();
    if (tid == 0) *slot = (int)__hip_atomic_fetch_add(ctr, 1u, __ATOMIC_RELAXED, __HIP_MEMORY_SCOPE_AGENT);
    __syncthreads();
    const int g = __builtin_amdgcn_readfirstlane(*slot);
    if (g >= ngroup) break;
    const int b = g & 3, q8 = (SEQ / 16 - 1) - (g >> 2);
    indexer_task(p, smem, b, q8, wave, lane);
  }
}

constexpr int AT_KROW = 72, AT_VROW = 96;
constexpr int AT_KBYTES = 32 * AT_KROW * 2, AT_STAGE = AT_KBYTES + 32 * AT_VROW * 2;
typedef short s16x4v __attribute__((ext_vector_type(4)));
typedef unsigned u32x4v __attribute__((ext_vector_type(4)));
DI void attn_block(const Params& p, char* smem, int b, int hh, int G) {
  const unsigned short* Qb = (const unsigned short*)(p.ws + OFF_QB);
  const unsigned short* Kb = (const unsigned short*)(p.ws + OFF_KB);
  const unsigned short* Vb = (const unsigned short*)(p.ws + OFF_VT);
  const unsigned* MASK = (const unsigned*)(p.ws + OFF_MASK);
  unsigned short* MIX = (unsigned short*)(p.ws + OFF_MIX);
  LAS unsigned char* lds = (LAS unsigned char*)smem;
  const int tid = otid(p), lane = tid & 63, wave = __builtin_amdgcn_readfirstlane(tid >> 6);
  const int lr = lane & 31, lh = lane >> 5;
  const int qt = 8 * G + wave;
  const int tq = qt * 32 + lr;
  const size_t qtok = (size_t)b * T + NM + tq;
  bf16x8 qf[4];
#pragma unroll
  for (int ks = 0; ks < 4; ++ks) qf[ks] = ld16(Qb + qtok * 512 + hh * 64 + ks * 16 + 8 * lh);
  const unsigned* mrow = MASK + ((size_t)b * SEQ + tq) * 128;
  const int which = tid >> 8, srow = (tid >> 3) & 31, sch = tid & 7;
  const unsigned short* gsrc = (which ? Vb : Kb) + ((size_t)b * T + srow) * 512 + hh * 64 + sch * 8;
  const unsigned sdst = which ? (unsigned)(AT_KBYTES + srow * (AT_VROW * 2) + sch * 16) : (unsigned)(srow * (AT_KROW * 2) + sch * 16);
  const int ntile = 8 * G + 9;
  const unsigned koff = (unsigned)(lr * (AT_KROW * 2) + 16 * lh);
  const unsigned voff = (unsigned)(AT_KBYTES + (4 * lh + ((lane & 15) >> 2)) * (AT_VROW * 2) + (16 * ((lane >> 4) & 1) + 4 * (lane & 3)) * 2);
  __syncthreads();
  {
    const u32x4v st0 = *(const u32x4v*)gsrc;
    *(LAS u32x4v*)(lds + sdst) = st0;
  }
  u32x4v rg0 = {0u, 0u, 0u, 0u}, rg1 = {0u, 0u, 0u, 0u};
  if (ntile > 1) rg1 = *(const u32x4v*)(gsrc + (size_t)NM * 512);
  if (ntile > 2) rg0 = *(const u32x4v*)(gsrc + (size_t)(NM + 32) * 512);
  f32x16 o[2];
#pragma unroll
  for (int i = 0; i < 2; ++i)
#pragma unroll
    for (int r = 0; r < 16; ++r) o[i][r] = 0.f;
  float m = -1e30f, lsum = 0.f;
  const float sl2 = 0.125f * 1.4426950408889634f;
  unsigned wm0 = 0x0000ffffu, wm1 = mrow[0];
  asm volatile("" : "+v"(rg0), "+v"(rg1), "+v"(wm1));
  __syncthreads();
  auto step = [&](const int it, const int PAR, u32x4v& rnext, unsigned& wm) __attribute__((always_inline)) {
    const int kt = it - 1;
    *(LAS u32x4v*)(lds + (PAR ^ 1) * AT_STAGE + sdst) = rnext;
    rnext = *(const u32x4v*)(gsrc + (size_t)(NM + 32 * min(kt + 3, 127)) * 512);
    if (kt <= qt) {
      const unsigned word = wm;
      const LAS unsigned char* sb = lds + PAR * AT_STAGE;
      f32x16 s;
#pragma unroll
      for (int r = 0; r < 16; ++r) s[r] = 0.f;
#pragma unroll
      for (int ks = 0; ks < 4; ++ks) {
        const bf16x8 kf = *(const LAS bf16x8*)(sb + koff + ks * 32);
        s = MFMA32(kf, qf[ks], s);
      }
      const unsigned wsh = word >> (4 * lh);
      float tmax = -1e30f;
#pragma unroll
      for (int r = 0; r < 16; ++r) {
        const bool valid = (wsh >> ((r & 3) + 8 * (r >> 2))) & 1u;
        s[r] = valid ? s[r] * sl2 : -1e30f;
        tmax = fmaxf(tmax, s[r]);
      }
      tmax = fmaxf(tmax, xor32f(tmax, lane));
      if (!__all(tmax <= m)) {
        const float mnew = fmaxf(m, tmax);
        const float alpha = __builtin_amdgcn_exp2f(m - mnew);
        lsum *= alpha;
        m = mnew;
#pragma unroll
        for (int i = 0; i < 2; ++i)
#pragma unroll
          for (int r = 0; r < 16; ++r) o[i][r] *= alpha;
      }
      float psum = 0.f;
#pragma unroll
      for (int r = 0; r < 16; ++r) {
        const float pv = __builtin_amdgcn_exp2f(s[r] - m);
        s[r] = pv;
        psum += pv;
      }
      psum += xor32f(psum, lane);
      lsum += psum;
#pragma unroll
      for (int ss = 0; ss < 2; ++ss) {
        const bf16x8 pf = pack8(s, ss);
#pragma unroll
        for (int dt = 0; dt < 2; ++dt) {
          const LAS unsigned char* vp = sb + voff + (16 * ss) * (AT_VROW * 2) + dt * 64;
          const s16x4v lo = __builtin_amdgcn_ds_read_tr16_b64_v4i16((LAS s16x4v*)vp);
          const s16x4v hi = __builtin_amdgcn_ds_read_tr16_b64_v4i16((LAS s16x4v*)(vp + 8 * (AT_VROW * 2)));
          const bf16x8 vf = __builtin_shufflevector(lo, hi, 0, 1, 2, 3, 4, 5, 6, 7);
          o[dt] = MFMA32(vf, pf, o[dt]);
        }
      }
    }
    wm = mrow[min(kt + 2, 127)];
    __syncthreads();
  };
  step(0, 0, rg1, wm0);
  for (int it = 1; it < ntile; it += 2) {
    step(it, 1, rg0, wm1);
    step(it + 1, 0, rg1, wm0);
  }
  const float inv = 1.f / lsum;
#pragma unroll
  for (int dt = 0; dt < 2; ++dt)
#pragma unroll
    for (int r = 0; r < 16; ++r) MIX[qtok * 1024 + hh * 64 + dt * 32 + crow(r, lh)] = f2bf(o[dt][r] * inv);
}
DI void attn_worker(const Params& p, char* smem) {
  unsigned* ctr = (unsigned*)(p.ws + OFF_BAR + 15872);
  volatile LAS int* slot = (volatile LAS int*)((LAS unsigned char*)smem + g8::STAGE_BYTES + 800);
  const int tid = otid(p);
  for (;;) {
    __syncthreads();
    if (tid == 0) *slot = (int)__hip_atomic_fetch_add(ctr, 1u, __ATOMIC_RELAXED, __HIP_MEMORY_SCOPE_AGENT);
    __syncthreads();
    const int k = __builtin_amdgcn_readfirstlane(*slot);
    if (k >= NB * 8 * 16) break;
    const int bh = k & 31, G = 15 - (k >> 5);
    attn_block(p, smem, bh >> 3, bh & 7, G);
  }
}

DI bf16x8 lds8x2(const LAS unsigned short* p0, const LAS unsigned short* p1) {
  typedef unsigned u32x2_t __attribute__((ext_vector_type(2)));
  typedef unsigned u32x4_t __attribute__((ext_vector_type(4)));
  const u32x2_t a = *(const LAS u32x2_t*)p0, b = *(const LAS u32x2_t*)p1;
  const u32x4_t r = {a[0], a[1], b[0], b[1]};
  return __builtin_bit_cast(bf16x8, r);
}
DI void scan_block(const Params& p, char* smem, int bh, const int c0, const int c1) {
  const int tid = otid(p), lane = tid & 63, wave = __builtin_amdgcn_readfirstlane(tid >> 6);
  const int b = bh >> 2, h = bh & 3;
  LAS unsigned char* lds = (LAS unsigned char*)smem;
  const unsigned short* CHB = (const unsigned short*)(p.ws + OFF_WN) + (size_t)bh * NCH * CHB_ELEMS;
  const float* UU = (const float*)(p.ws + OFF_UU) + (size_t)bh * NCH * 8192;
  const float* DL = (const float*)(p.ws + OFF_DL) + (size_t)bh * NCH;
  float* OD = (float*)(p.ws + OFF_OD);
  constexpr int CHB_BYTES = CHB_ELEMS * 2;
  __syncthreads();
  if (wave >= 4) {
    const int w4 = wave - 4;
    for (int c = c0; c <= c1; ++c) {
      if (c < c1) {
        const char* src = (const char*)(CHB + (size_t)c * CHB_ELEMS) + (size_t)(w4 * 15) * 1024 + lane * 16;
        const unsigned dst = (unsigned)((c & 1) * CHB_BYTES + (w4 * 15) * 1024);
#pragma unroll
        for (int j = 0; j < 15; ++j)
          __builtin_amdgcn_global_load_lds((const unsigned*)(src + j * 1024), (LAS unsigned*)(lds + dst + j * 1024), 16, 0, 0);
      }
      asm volatile("s_waitcnt vmcnt(0)" ::: "memory");
      __builtin_amdgcn_s_barrier();
    }
  } else {
    const int sl = wave, lr = lane & 31, lh = lane >> 5, e0 = sl * 32;
    f32x16 S[4];
    float* sst = (float*)(p.ws + OFF_SST) + ((size_t)(bh * 4 + sl) * 64 + lane) * 64;
#pragma unroll
    for (int i = 0; i < 4; ++i)
#pragma unroll
      for (int q = 0; q < 4; ++q) {
        float4 v = make_float4(0.f, 0.f, 0.f, 0.f);
        if (c0 > 0) v = *(const float4*)(sst + i * 16 + q * 4);
        S[i][4 * q] = v.x; S[i][4 * q + 1] = v.y; S[i][4 * q + 2] = v.z; S[i][4 * q + 3] = v.w;
      }
    f32x16 un[2];
    const float* up0 = UU + (size_t)c0 * 8192 + ((size_t)(sl * 2) * 2 + lh) * 512 + lr * 16;
#pragma unroll
    for (int pt = 0; pt < 2; ++pt)
#pragma unroll
      for (int q = 0; q < 4; ++q) {
        const float4 v = *(const float4*)(up0 + pt * 1024 + q * 4);
        un[pt][4 * q] = v.x; un[pt][4 * q + 1] = v.y; un[pt][4 * q + 2] = v.z; un[pt][4 * q + 3] = v.w;
      }
    const int oA = lr * 132 + 4 * lh;
    const int oB = lr * 68 + 4 * lh;
    __builtin_amdgcn_s_barrier();
    for (int c = c0; c < c1; ++c) {
      const LAS unsigned short* cb = (const LAS unsigned short*)(lds + (c & 1) * CHB_BYTES);
      f32x16 vn[2];
      vn[0] = un[0];
      vn[1] = un[1];
#pragma unroll
      for (int pt = 0; pt < 2; ++pt) {
#pragma unroll
        for (int mt = 0; mt < 4; ++mt)
#pragma unroll
          for (int s2 = 0; s2 < 2; ++s2) {
            const LAS unsigned short* ap = cb + oA + pt * 32 * 132 + mt * 32 + 16 * s2;
            vn[pt] = MFMA32(lds8x2(ap, ap + 8), pack8(S[mt], s2), vn[pt]);
          }
      }
      bf16x8 vb[2][2];
#pragma unroll
      for (int pt = 0; pt < 2; ++pt)
#pragma unroll
        for (int s2 = 0; s2 < 2; ++s2) vb[pt][s2] = pack8(vn[pt], s2);
#pragma unroll
      for (int pt = 0; pt < 2; ++pt) {
        f32x16 o;
#pragma unroll
        for (int r = 0; r < 16; ++r) o[r] = 0.f;
#pragma unroll
        for (int mt = 0; mt < 4; ++mt)
#pragma unroll
          for (int s2 = 0; s2 < 2; ++s2) {
            const LAS unsigned short* ap = cb + CH_QG + oA + pt * 32 * 132 + mt * 32 + 16 * s2;
            o = MFMA32(lds8x2(ap, ap + 8), pack8(S[mt], s2), o);
          }
#pragma unroll
        for (int pt2 = 0; pt2 <= pt; ++pt2)
#pragma unroll
          for (int s2 = 0; s2 < 2; ++s2) {
            const LAS unsigned short* ap = cb + CH_IN + oB + pt * 32 * 68 + pt2 * 32 + 16 * s2;
            o = MFMA32(lds8x2(ap, ap + 8), vb[pt2][s2], o);
          }
#pragma unroll
        for (int r = 0; r < 16; ++r) {
          const int t = c * 64 + pt * 32 + crow(r, lh) - 48;
          if (t >= 0) OD[((size_t)(b * T + t)) * 512 + h * 128 + e0 + lr] = o[r];
        }
      }
      if (c + 1 < c1) {
        const float* up = up0 + (size_t)(c + 1 - c0) * 8192;
#pragma unroll
        for (int pt = 0; pt < 2; ++pt)
#pragma unroll
          for (int q = 0; q < 4; ++q) {
            const float4 v = *(const float4*)(up + pt * 1024 + q * 4);
            un[pt][4 * q] = v.x; un[pt][4 * q + 1] = v.y; un[pt][4 * q + 2] = v.z; un[pt][4 * q + 3] = v.w;
          }
      }
      const float dl = DL[c];
#pragma unroll
      for (int mt = 0; mt < 4; ++mt) {
#pragma unroll
        for (int r = 0; r < 16; ++r) S[mt][r] *= dl;
#pragma unroll
        for (int pt2 = 0; pt2 < 2; ++pt2)
#pragma unroll
          for (int s2 = 0; s2 < 2; ++s2) {
            const LAS unsigned short* ap = cb + CH_KDT + oB + mt * 32 * 68 + pt2 * 32 + 16 * s2;
            S[mt] = MFMA32(lds8x2(ap, ap + 8), vb[pt2][s2], S[mt]);
          }
      }
      asm volatile("s_waitcnt lgkmcnt(0)" ::: "memory");
      __builtin_amdgcn_s_barrier();
    }
    if (c1 < NCH) {
#pragma unroll
      for (int i = 0; i < 4; ++i)
#pragma unroll
        for (int q = 0; q < 4; ++q) *(float4*)(sst + i * 16 + q * 4) = make_float4(S[i][4 * q], S[i][4 * q + 1], S[i][4 * q + 2], S[i][4 * q + 3]);
    }
  }
  __syncthreads();
}
DI void phase_scan_attn(const Params& p, char* smem) {
  attn_worker(p, smem);
}

DI void phase_gnorm(const Params& p) {
  const int tid = otid(p), lane = tid & 63, wave = tid >> 6;
  const float* OD = (const float*)(p.ws + OFF_OD);
  const float* P = (const float*)(p.ws + OFF_P);
  unsigned short* MIX = (unsigned short*)(p.ws + OFF_MIX);
  for (int r = blockIdx.x * NWAVES + wave; r < NR; r += gridDim.x * NWAVES) {
    const int tok = r + 16 * (r / SEQ + 1);
#pragma unroll
    for (int hd = 0; hd < 4; ++hd) {
      float o0 = OD[(size_t)tok * 512 + hd * 128 + lane], o1 = OD[(size_t)tok * 512 + hd * 128 + 64 + lane];
      float ss = wave_sum(o0 * o0 + o1 * o1);
      float rstd = rsqrtf(ss * (1.f / 128.f) + 1e-6f);
      float z0 = P[(size_t)tok * INC + C_BZ + hd * 128 + lane], z1 = P[(size_t)tok * INC + C_BZ + hd * 128 + 64 + lane];
      float y0 = o0 * rstd * p.delta_norm_w[lane] * (z0 / (1.f + __expf(-z0)));
      float y1 = o1 * rstd * p.delta_norm_w[64 + lane] * (z1 / (1.f + __expf(-z1)));
      MIX[(size_t)tok * 1024 + 512 + hd * 128 + lane] = f2bf(y0);
      MIX[(size_t)tok * 1024 + 512 + hd * 128 + 64 + lane] = f2bf(y1);
    }
  }
}

DI void phase_router(const Params& p, char* smem) {
  const int tid = otid(p), lane = tid & 63, wave = tid >> 6;
  float* part = (float*)smem;
  float* rstds = part + 8 * 32 * 33;
  int* lhist = (int*)(rstds + 32);
  int* lbase = lhist + 32;
  const float* H1 = (const float*)(p.ws + OFF_H1);
  const float* wrs = (const float*)(p.ws + OFF_WRS);
  unsigned short* U2 = (unsigned short*)(p.ws + OFF_U2);
  int* TOPE = (int*)(p.ws + OFF_TOPE);
  float* GATEV = (float*)(p.ws + OFF_GATEV);
  int* POS = (int*)(p.ws + OFF_POS);
  int* CNT = (int*)(p.ws + OFF_CNT);
  const int lr = lane & 31, lh = lane >> 5;
  float4 nw[4];
#pragma unroll
  for (int i = 0; i < 4; ++i) nw[i] = *(const float4*)(p.norm_ffn_w + lane * 4 + 256 * i);
  for (int task = blockIdx.x; task < NR / 32; task += gridDim.x) {
    const int r0 = task * 32;
    __syncthreads();
    if (tid < 32) lhist[tid] = 0;
    int lp0 = 0, lp1 = 0, lp2 = 0, lp3 = 0, xe0 = 0, xe1 = 0, xe2 = 0, xe3 = 0;
#pragma unroll
    for (int tt = 0; tt < 4; ++tt) {
      const int r = r0 + wave * 4 + tt;
      const float* src = H1 + (size_t)r * 1024;
      float4 v[4];
      float ss = 0.f;
#pragma unroll
      for (int i = 0; i < 4; ++i) {
        v[i] = *(const float4*)(src + lane * 4 + 256 * i);
        ss += v[i].x * v[i].x + v[i].y * v[i].y + v[i].z * v[i].z + v[i].w * v[i].w;
      }
      ss = wave_sum(ss);
      const float rstd = rsqrtf(ss * (1.f / 1024.f) + 1e-6f);
      if (lane == 0) rstds[wave * 4 + tt] = rstd;
#pragma unroll
      for (int i = 0; i < 4; ++i) {
        uint2 o;
        o.x = pk2(v[i].x * rstd * nw[i].x, v[i].y * rstd * nw[i].y);
        o.y = pk2(v[i].z * rstd * nw[i].z, v[i].w * rstd * nw[i].w);
        *(uint2*)(U2 + (size_t)r * 1024 + lane * 4 + 256 * i) = o;
      }
    }
    f32x16 acc;
#pragma unroll
    for (int i = 0; i < 16; ++i) acc[i] = 0.f;
    const float* arow = H1 + (size_t)(r0 + lr) * 1024 + wave * 128;
    const float* bcol = wrs + (size_t)(wave * 128 + lh) * 32 + lr;
#pragma unroll 8
    for (int k0 = 0; k0 < 128; k0 += 4) {
      const float4 a4 = *(const float4*)(arow + k0);
      const float b0 = bcol[(size_t)k0 * 32], b1 = bcol[(size_t)(k0 + 2) * 32];
      acc = __builtin_amdgcn_mfma_f32_32x32x2f32(lh ? a4.y : a4.x, b0, acc, 0, 0, 0);
      acc = __builtin_amdgcn_mfma_f32_32x32x2f32(lh ? a4.w : a4.z, b1, acc, 0, 0, 0);
    }
#pragma unroll
    for (int r = 0; r < 16; ++r) part[(wave * 32 + crow(r, lh)) * 33 + lr] = acc[r];
    __syncthreads();
    if (tid < 32) {
      const float myrstd = rstds[tid];
      float lv[32];
#pragma unroll
      for (int e = 0; e < 32; ++e) {
        float a = 0.f;
#pragma unroll
        for (int w = 0; w < 8; ++w) a += part[(w * 32 + tid) * 33 + e];
        lv[e] = a * myrstd + p.b_router[e];
      }
      float tv[4];
      int te[4];
#pragma unroll
      for (int k = 0; k < 4; ++k) {
        float bv = lv[0];
        int bi = 0;
#pragma unroll
        for (int e = 1; e < 32; ++e)
          if (lv[e] > bv) { bv = lv[e]; bi = e; }
        tv[k] = bv;
        te[k] = bi;
#pragma unroll
        for (int e = 0; e < 32; ++e)
          if (e == bi) lv[e] = -3.0e38f;
      }
      const float e1 = __expf(tv[1] - tv[0]), e2 = __expf(tv[2] - tv[0]), e3 = __expf(tv[3] - tv[0]);
      const float inv = 1.f / (1.f + e1 + e2 + e3);
      const size_t rr = (size_t)(r0 + tid) * 4;
      TOPE[rr + 0] = te[0]; TOPE[rr + 1] = te[1]; TOPE[rr + 2] = te[2]; TOPE[rr + 3] = te[3];
      GATEV[rr + 0] = inv; GATEV[rr + 1] = e1 * inv; GATEV[rr + 2] = e2 * inv; GATEV[rr + 3] = e3 * inv;
      lp0 = atomicAdd(&lhist[te[0]], 1); lp1 = atomicAdd(&lhist[te[1]], 1); lp2 = atomicAdd(&lhist[te[2]], 1); lp3 = atomicAdd(&lhist[te[3]], 1);
      xe0 = te[0]; xe1 = te[1]; xe2 = te[2]; xe3 = te[3];
    }
    __syncthreads();
    if (tid < 32) {
      const int c = lhist[tid];
      lbase[tid] = (c > 0) ? atomicAdd(&CNT[tid * CNTS], c) : 0;
    }
    __syncthreads();
    if (tid < 32) {
      const size_t rr = (size_t)(r0 + tid) * 4;
      POS[rr + 0] = lbase[xe0] + lp0; POS[rr + 1] = lbase[xe1] + lp1; POS[rr + 2] = lbase[xe2] + lp2; POS[rr + 3] = lbase[xe3] + lp3;
    }
  }
}
DI void phase_lists(const Params& p) {
  const int* CNT = (const int*)(p.ws + OFF_CNT);
  const int* TOPE = (const int*)(p.ws + OFF_TOPE);
  const float* GATEV = (const float*)(p.ws + OFF_GATEV);
  const int* POS = (const int*)(p.ws + OFF_POS);
  int* SLOT = (int*)(p.ws + OFF_SLOT);
  int* LTOK = (int*)(p.ws + OFF_LTOK);
  float* LGATE = (float*)(p.ws + OFF_LGATE);
  for (int a = blockIdx.x * NTHREADS + otid(p); a < NASG; a += gridDim.x * NTHREADS) {
    const int e = TOPE[a];
    int off = 0;
    for (int j = 0; j < e; ++j) off += CNT[j * CNTS];
    const int slot = off + POS[a];
    SLOT[a] = slot;
    LTOK[slot] = a >> 2;
    LGATE[slot] = GATEV[a];
  }
}
DI void phase_combine(const Params& p) {
  const float* H1 = (const float*)(p.ws + OFF_H1);
  const unsigned short* Y = (const unsigned short*)(p.ws + OFF_Y);
  const int* SLOT = (const int*)(p.ws + OFF_SLOT);
  for (int idx = blockIdx.x * NTHREADS + otid(p); idx < NR * 256; idx += gridDim.x * NTHREADS) {
    const int r = idx >> 8, c4 = (idx & 255) * 4;
    float4 a = *(const float4*)(H1 + (size_t)r * 1024 + c4);
#pragma unroll
    for (int k = 0; k < 4; ++k) {
      const int slot = SLOT[r * 4 + k];
      uint2 y = *(const uint2*)(Y + (size_t)slot * 1024 + c4);
      a.x += bf2f((unsigned short)(y.x & 0xffffu));
      a.y += bf2f((unsigned short)(y.x >> 16));
      a.z += bf2f((unsigned short)(y.y & 0xffffu));
      a.w += bf2f((unsigned short)(y.y >> 16));
    }
    *(float4*)(p.out + (size_t)r * 1024 + c4) = a;
  }
}


#define XB_TMO      128
#define XB_XCNT(j)  (256  + 64 * (j))
#define XB_XSUB(j)  (1280 + 64 * (j))
#define XB_XGEN(j)  (2304 + 64 * (j))
#define XB_TOP      3328
#define XB_TOPGEN   3392
#define XB_SPIN_CAP (1u << 22)
DI unsigned xb_ld(unsigned* p) { return __hip_atomic_load(p, __ATOMIC_RELAXED, __HIP_MEMORY_SCOPE_AGENT); }
DI unsigned xb_add(unsigned* p, unsigned v) { return __hip_atomic_fetch_add(p, v, __ATOMIC_RELAXED, __HIP_MEMORY_SCOPE_AGENT); }
DI unsigned xb_xcc_id() { return (unsigned)__builtin_amdgcn_s_getreg((3 << 11) | 20) & 0xFu; }
#define XB_SPIN(cond, bar) do { unsigned _sp = 0; while (cond) { __builtin_amdgcn_s_sleep(1); \
    if ((++_sp & 255u) == 0u) { if (xb_ld(&(bar)[XB_TMO])) break; if (_sp > XB_SPIN_CAP) { atomicAdd(&(bar)[XB_TMO], 1u); break; } } } } while (0)
struct XcdBarrier { unsigned* bar; unsigned x; volatile LAS unsigned* st; bool leader; };
DI void xcd_barrier_complete(unsigned* bar, unsigned x, unsigned& nloc, unsigned& nx) {
  const unsigned G = gridDim.x * gridDim.y * gridDim.z;
  unsigned sum, cnt, mine, sp = 0u;
  for (;;) {
    sum = 0u; cnt = 0u; mine = 0u;
#pragma unroll
    for (unsigned j = 0; j < 16; ++j) { const unsigned c = xb_ld(&bar[XB_XCNT(j)]); sum += c; cnt += (c > 0u) ? 1u : 0u; mine = (j == x) ? c : mine; }
    if (sum == G) break;
    __builtin_amdgcn_s_sleep(1);
    if ((++sp & 255u) == 0u) { if (xb_ld(&bar[XB_TMO])) break; if (sp > XB_SPIN_CAP) { atomicAdd(&bar[XB_TMO], 1u); break; } }
  }
  nloc = mine > 0u ? mine : 1u; nx = cnt > 0u ? cnt : 1u;
}
DI void xcd_barrier(const XcdBarrier& b) {
  asm volatile("s_waitcnt vmcnt(0)" ::: "memory");
  __syncthreads();
  if (b.leader) {
    unsigned* bar = b.bar;
    __builtin_amdgcn_s_waitcnt(0);
    unsigned nloc = b.st[0], nx = b.st[1];
    if (nloc == 0u) { xcd_barrier_complete(bar, b.x, nloc, nx); b.st[0] = nloc; b.st[1] = nx; }
    const unsigned old = xb_add(&bar[XB_XSUB(b.x)], 1u);
    const unsigned gen = old / nloc;
    if (old + 1u == (gen + 1u) * nloc) {
      __builtin_amdgcn_fence(__ATOMIC_RELEASE, "agent");
      asm volatile("s_waitcnt vmcnt(0)" ::: "memory");
      const unsigned og = xb_add(&bar[XB_TOP], 1u);
      const unsigned tg = og / nx;
      if (og + 1u == (tg + 1u) * nx) xb_add(&bar[XB_TOPGEN], 1u);
      else XB_SPIN(xb_ld(&bar[XB_TOPGEN]) == tg, bar);
      __builtin_amdgcn_fence(__ATOMIC_ACQUIRE, "agent");
      xb_add(&bar[XB_XGEN(b.x)], 1u);
      asm volatile("s_waitcnt vmcnt(0)" ::: "memory");
    } else {
      XB_SPIN(xb_ld(&bar[XB_XGEN(b.x)]) == gen, bar);
      __builtin_amdgcn_fence(__ATOMIC_ACQUIRE, "agent");
      asm volatile("s_waitcnt vmcnt(0)" ::: "memory");
    }
  }
  __syncthreads();
}

constexpr int SMEM_BYTES = g8::STAGE_BYTES + 1024;

__global__ void __launch_bounds__(NTHREADS) mk(Params p0) {
  __shared__ __attribute__((aligned(16))) char smem[SMEM_BYTES];
  Params p = p0;
  p.wv = __builtin_amdgcn_readfirstlane((int)(threadIdx.x >> 6));
  XcdBarrier xb;
  {
    volatile LAS unsigned* st = (volatile LAS unsigned*)((LAS unsigned char*)smem + g8::STAGE_BYTES + 768);
    if (threadIdx.x == 0) { st[0] = 0u; st[1] = 0u; }
    __syncthreads();
    xb.bar = (unsigned*)(p.ws + OFF_BAR); xb.x = xb_xcc_id(); xb.st = st; xb.leader = (threadIdx.x == 0);
    if (xb.leader) (void)xb_add(&xb.bar[XB_XCNT(xb.x)], 1u);
  }
  phase_prep(p);
  phase_wconv(p, 0, WC_SMALL);
  xcd_barrier(xb);
  g8::gemm_phase<0>(p, smem);
  wconv_fill(p, smem, 0, false);
  xcd_barrier(xb);
  phase_post1(p, smem);
  xcd_barrier(xb);
  g8::gemm_phase<1>(p, smem);
  phase_chunkprep(p, smem);
  wconv_fill(p, smem, 1, false);
  xcd_barrier(xb);
  if (blockIdx.x < 16) scan_block(p, smem, blockIdx.x, 0, NCH);
  phase_post2(p, smem);
  phase_indexer(p, smem);
  wconv_fill(p, smem, 2, false);
  xcd_barrier(xb);
  phase_gnorm(p);
  phase_scan_attn(p, smem);
  wconv_fill(p, smem, 3, false);
  xcd_barrier(xb);
  g8::gemm_phase<2>(p, smem);
  xcd_barrier(xb);
  phase_router(p, smem);
  xcd_barrier(xb);
  phase_lists(p);
  wconv_fill(p, smem, 4, true);
  xcd_barrier(xb);
  g8::gemm_phase<3>(p, smem);
  xcd_barrier(xb);
  g8::gemm_phase<4>(p, smem);
  xcd_barrier(xb);
  phase_combine(p);
}

extern "C" void kernel_launch(void* const* d_in, const int* in_sizes, int n_in, void* d_out, int out_size, void* d_ws,
                              size_t ws_size, hipStream_t stream) {
  (void)in_sizes; (void)n_in; (void)out_size;
  if (ws_size < WS_NEED) return;
  Params p{};
  p.x = (const float*)d_in[0]; p.meta = (const float*)d_in[1]; p.norm_mix_w = (const float*)d_in[2];
  p.w_in = (const float*)d_in[3]; p.q_norm_w = (const float*)d_in[4]; p.k_norm_w = (const float*)d_in[5];
  p.kv_norm_w = (const float*)d_in[6]; p.w_kv_up = (const float*)d_in[7]; p.conv_w = (const float*)d_in[8];
  p.a_log = (const float*)d_in[9]; p.dt_bias = (const float*)d_in[10]; p.delta_norm_w = (const float*)d_in[11];
  p.w_out = (const float*)d_in[12]; p.norm_ffn_w = (const float*)d_in[13]; p.w_router = (const float*)d_in[14];
  p.b_router = (const float*)d_in[15]; p.w_gate_up = (const float*)d_in[16]; p.b_gate_up = (const float*)d_in[17];
  p.w_down = (const float*)d_in[18]; p.b_down = (const float*)d_in[19];
  p.out = (float*)d_out;
  p.ws = (char*)d_ws;
  (void)hipMemsetAsync((char*)d_ws + OFF_CNT, 0, 4096, stream);
  (void)hipMemsetAsync((char*)d_ws + OFF_BAR, 0, 16384, stream);
  static int grid_blocks = 0;
  if (!grid_blocks) {
    int dev = 0, cus = 0, per_cu = 0;
    (void)hipGetDevice(&dev);
    (void)hipDeviceGetAttribute(&cus, hipDeviceAttributeMultiprocessorCount, dev);
    (void)hipOccupancyMaxActiveBlocksPerMultiprocessor(&per_cu, mk, NTHREADS, 0);
    if (per_cu > 1) per_cu = 1;
    grid_blocks = cus * per_cu;
  }
  void* args[] = {&p};
  hipError_t e = hipLaunchCooperativeKernel((void*)mk, dim3(grid_blocks), dim3(NTHREADS), args, 0, stream);
  if (e != hipSuccess) fprintf(stderr, "cooperative launch failed: %s (grid %d)\n", hipGetErrorString(e), grid_blocks);
}
```

```cpp
#include <hip/hip_runtime.h>
#include <stdint.h>
#include <stdio.h>


typedef __attribute__((ext_vector_type(8))) short bf16x8;
typedef __attribute__((ext_vector_type(4))) short s16x4;
typedef __attribute__((ext_vector_type(16))) float f32x16;
typedef __attribute__((ext_vector_type(4))) float f32x4;
typedef __bf16 bf2_t __attribute__((ext_vector_type(2)));
#define DI __device__ __forceinline__
#define MFMA32(a, b, c) __builtin_amdgcn_mfma_f32_32x32x16_bf16((a), (b), (c), 0, 0, 0)
#define MFMA16(a, b, c) __builtin_amdgcn_mfma_f32_16x16x32_bf16((a), (b), (c), 0, 0, 0)

constexpr int NB = 4, SEQ = 4096, NM = 16, T = 4112, NT = NB * T, NR = NB * SEQ, D = 1024, INC = 3408;
constexpr int C_AQ = 0, C_CKV = 512, C_IQ = 768, C_IK = 1280, C_IW = 1344, C_BQKV = 1352, C_BZ = 2888, C_BBETA = 3400, C_BA = 3404;
constexpr int NCH = 65, NCHT = NB * 4 * NCH;
constexpr int NEXP = 32, NASG = NR * 4;
constexpr int CNTS = 32;
constexpr int NTHREADS = 512, NWAVES = 8;

constexpr size_t al256(size_t x) { return (x + 255) & ~(size_t)255; }
constexpr size_t OFF_U = 0;
constexpr int NTP = 16640;
constexpr size_t OFF_P = OFF_U + al256((size_t)NTP * 1024 * 2);
constexpr size_t OFF_ROPE = OFF_P + al256((size_t)NT * INC * 4);
constexpr size_t OFF_QB = OFF_ROPE + al256((size_t)T * 64 * 4);
constexpr size_t OFF_KB = OFF_QB + al256((size_t)NT * 512 * 2);
constexpr size_t OFF_VT = OFF_KB + al256((size_t)NT * 512 * 2);
constexpr size_t OFF_QI = OFF_VT + al256((size_t)NT * 512 * 2);
constexpr size_t OFF_KI = OFF_QI + al256((size_t)NT * 512 * 2);
constexpr size_t OFF_WI = OFF_KI + al256((size_t)NT * 64 * 2);
constexpr size_t OFF_CKV = OFF_WI + al256((size_t)NT * 8 * 4);
constexpr size_t OFF_KV = OFF_CKV + al256((size_t)NTP * 256 * 2);
constexpr size_t OFF_MASK = OFF_KV + al256((size_t)NT * 1024 * 4);
constexpr size_t OFF_MIX = OFF_MASK + al256((size_t)NB * SEQ * 128 * 4);
constexpr size_t OFF_QD = OFF_MIX + al256((size_t)NT * 1024 * 2);
constexpr size_t OFF_KD = OFF_QD + al256((size_t)NT * 512 * 4);
constexpr size_t OFF_VD = OFF_KD + al256((size_t)NT * 512 * 4);
constexpr size_t OFF_BETA = OFF_VD + al256((size_t)NT * 512 * 4);
constexpr size_t OFF_G = OFF_BETA + al256((size_t)NT * 4 * 4);
constexpr int CHB_ELEMS = 30720, CH_QG = 8448, CH_KDT = 16896, CH_IN = 25600;
constexpr size_t OFF_WN = OFF_G + al256((size_t)NT * 4 * 4);
constexpr size_t OFF_UU = OFF_WN + al256((size_t)NCHT * CHB_ELEMS * 2);
constexpr size_t OFF_DL = OFF_UU + al256((size_t)NCHT * 64 * 128 * 4);
constexpr size_t OFF_OD = OFF_DL + al256((size_t)NCHT * 4);
constexpr size_t OFF_U2 = OFF_OD + al256((size_t)NT * 512 * 4);
constexpr size_t OFF_TOPE = OFF_U2 + al256((size_t)NR * 1024 * 2);
constexpr size_t OFF_GATEV = OFF_TOPE + al256((size_t)NR * 4 * 4);
constexpr size_t OFF_POS = OFF_GATEV + al256((size_t)NR * 4 * 4);
constexpr size_t OFF_SLOT = OFF_POS + al256((size_t)NR * 4 * 4);
constexpr size_t OFF_LTOK = OFF_SLOT + al256((size_t)NR * 4 * 4);
constexpr size_t OFF_LGATE = OFF_LTOK + al256((size_t)NASG * 4);
constexpr size_t OFF_WTIN = OFF_LGATE + al256((size_t)NASG * 4);
constexpr size_t OFF_WTKV = OFF_WTIN + al256((size_t)3584 * 1024 * 2);
constexpr size_t OFF_WTOUT = OFF_WTKV + al256((size_t)1024 * 256 * 2);
constexpr size_t OFF_WTGU = OFF_WTOUT + al256((size_t)1024 * 1024 * 2);
constexpr size_t OFF_WTDN = OFF_WTGU + al256((size_t)32 * 2048 * 1024 * 2);
constexpr size_t OFF_CNT = OFF_WTDN + al256((size_t)32 * 1024 * 1024 * 2);
constexpr size_t OFF_Y = OFF_QD;
static_assert(OFF_U2 - OFF_QD >= (size_t)NASG * 1024 * 2, "Y alias does not fit");
static_assert((size_t)(NASG + 256) * 1024 * 2 <= (size_t)NT * INC * 4, "HD alias does not fit");
constexpr size_t OFF_WRS = OFF_CNT + 4096;
constexpr size_t OFF_SST = OFF_WRS + 131072;
constexpr size_t OFF_BAR = OFF_SST + (size_t)16 * 4 * 64 * 64 * 4;
constexpr size_t WS_NEED = OFF_BAR + 16384;
constexpr size_t OFF_H1 = OFF_KV;
constexpr size_t OFF_HD = OFF_P;

struct Params {
  const float *x, *meta, *norm_mix_w, *w_in, *q_norm_w, *k_norm_w, *kv_norm_w, *w_kv_up, *conv_w, *a_log, *dt_bias,
      *delta_norm_w, *w_out, *norm_ffn_w, *w_router, *b_router, *w_gate_up, *b_gate_up, *w_down, *b_down;
  float* out;
  char* ws;
  int wv;
  int pad0;
};

#define LAS __attribute__((address_space(3)))
constexpr int STAGE_LDS_BYTES = 131072;
DI unsigned pk2(float a, float b) { bf2_t v; v[0] = (__bf16)a; v[1] = (__bf16)b; return __builtin_bit_cast(unsigned, v); }
DI unsigned short f2bf(float a) { return (unsigned short)(pk2(a, 0.f) & 0xffffu); }
DI float bf2f(unsigned short u) { return __uint_as_float(((unsigned)u) << 16); }
template <int CTRL> DI float dppf(float v) { return __builtin_bit_cast(float, __builtin_amdgcn_update_dpp(0, __builtin_bit_cast(int, v), CTRL, 0xf, 0xf, false)); }
template <int CTRL> DI int dppi(int v) { return __builtin_amdgcn_update_dpp(0, v, CTRL, 0xf, 0xf, false); }
DI float rlf(float v, int l) { return __builtin_bit_cast(float, __builtin_amdgcn_readlane(__builtin_bit_cast(int, v), l)); }
DI float wave_sum(float v) {
  v += dppf<0xB1>(v); v += dppf<0x4E>(v); v += dppf<0x141>(v); v += dppf<0x140>(v);
  return (rlf(v, 0) + rlf(v, 16)) + (rlf(v, 32) + rlf(v, 48));
}
DI float xor32f(float v, int lane) {
  auto r = __builtin_amdgcn_permlane32_swap(__builtin_bit_cast(unsigned, v), __builtin_bit_cast(unsigned, v), false, false);
  return __builtin_bit_cast(float, (lane < 32) ? r[1] : r[0]);
}
DI float xor16f(float v, int lane) {
  auto r = __builtin_amdgcn_permlane16_swap(__builtin_bit_cast(unsigned, v), __builtin_bit_cast(unsigned, v), false, false);
  return __builtin_bit_cast(float, (lane & 16) ? r[0] : r[1]);
}
DI int otid(const Params& p) {
  int l;
  asm volatile("v_mbcnt_lo_u32_b32 %0, -1, 0\n\tv_mbcnt_hi_u32_b32 %0, -1, %0" : "=v"(l));
  return (p.wv << 6) | l;
}
DI int swzA(int row, int col) { return row * 132 + col; }
DI int swzB(int row, int col) { return row * 68 + col; }
DI int crow(int reg, int h) { return (reg & 3) + 8 * (reg >> 2) + 4 * h; }
DI bf16x8 pack8(const f32x16& x, int s) {
  uint4 p;
  p.x = pk2(x[8 * s + 0], x[8 * s + 1]); p.y = pk2(x[8 * s + 2], x[8 * s + 3]);
  p.z = pk2(x[8 * s + 4], x[8 * s + 5]); p.w = pk2(x[8 * s + 6], x[8 * s + 7]);
  return __builtin_bit_cast(bf16x8, p);
}
DI bf16x8 ld8x2(const unsigned short* p0, const unsigned short* p1) {
  uint2 a = *(const uint2*)p0, b = *(const uint2*)p1;
  uint4 r = make_uint4(a.x, a.y, b.x, b.y);
  return __builtin_bit_cast(bf16x8, r);
}
DI bf16x8 ld16(const unsigned short* p) { uint4 r = *(const uint4*)p; return __builtin_bit_cast(bf16x8, r); }
DI const float* hrow(const Params& p, int tok) {
  int b = tok / T, t = tok - b * T;
  return (t < NM) ? (p.meta + (size_t)t * D) : (p.x + ((size_t)b * SEQ + (t - NM)) * D);
}

DI void phase_prep(const Params& p) {
  const int tid = otid(p), lane = tid & 63, wave = tid >> 6;
  float* rope = (float*)(p.ws + OFF_ROPE);
  for (int idx = blockIdx.x * NTHREADS + tid; idx < T * 32; idx += gridDim.x * NTHREADS) {
    int t = idx >> 5, i = idx & 31;
    float inv = (float)pow(10000.0, -(double)i / 32.0);
    float ang = (float)t * inv;
    double ad = (double)ang;
    double n = rint(ad * 0.15915494309189535);
    float r = (float)(ad - n * 6.283185307179586);
    float sn, cs;
    sincosf(r, &sn, &cs);
    rope[t * 64 + i] = cs;
    rope[t * 64 + 32 + i] = sn;
  }
  float* wrs = (float*)(p.ws + OFF_WRS);
  for (int idx = blockIdx.x * NTHREADS + tid; idx < 1024 * 32; idx += gridDim.x * NTHREADS) wrs[idx] = p.norm_ffn_w[idx >> 5] * p.w_router[idx];
  unsigned short* U = (unsigned short*)(p.ws + OFF_U);
  for (int tok = blockIdx.x * NWAVES + wave; tok < NT; tok += gridDim.x * NWAVES) {
    const float* src = hrow(p, tok);
    float4 v[4];
    float ss = 0.f;
#pragma unroll
    for (int i = 0; i < 4; ++i) {
      v[i] = *(const float4*)(src + lane * 4 + 256 * i);
      ss += v[i].x * v[i].x + v[i].y * v[i].y + v[i].z * v[i].z + v[i].w * v[i].w;
    }
    ss = wave_sum(ss);
    float rstd = rsqrtf(ss * (1.f / 1024.f) + 1e-6f);
#pragma unroll
    for (int i = 0; i < 4; ++i) {
      float4 w = *(const float4*)(p.norm_mix_w + lane * 4 + 256 * i);
      uint2 o;
      o.x = pk2(v[i].x * rstd * w.x, v[i].y * rstd * w.y);
      o.y = pk2(v[i].z * rstd * w.z, v[i].w * rstd * w.w);
      *(uint2*)(U + (size_t)tok * 1024 + lane * 4 + 256 * i) = o;
    }
  }
}

DI void wconv_task2(const float* src, unsigned short* dst, int K, int N, int k0, int n0, int tid) {
  const int kg = tid >> 6, n = n0 + (tid & 63) * 4, k = k0 + kg * 8;
  float4 v[8];
#pragma unroll
  for (int i = 0; i < 8; ++i) {
    v[i] = make_float4(0.f, 0.f, 0.f, 0.f);
    if (n < N) v[i] = *(const float4*)(src + (size_t)(k + i) * N + n);
  }
  uint4 o;
  o.x = pk2(v[0].x, v[1].x); o.y = pk2(v[2].x, v[3].x); o.z = pk2(v[4].x, v[5].x); o.w = pk2(v[6].x, v[7].x);
  *(uint4*)(dst + (size_t)(n + 0) * K + k) = o;
  o.x = pk2(v[0].y, v[1].y); o.y = pk2(v[2].y, v[3].y); o.z = pk2(v[4].y, v[5].y); o.w = pk2(v[6].y, v[7].y);
  *(uint4*)(dst + (size_t)(n + 1) * K + k) = o;
  o.x = pk2(v[0].z, v[1].z); o.y = pk2(v[2].z, v[3].z); o.z = pk2(v[4].z, v[5].z); o.w = pk2(v[6].z, v[7].z);
  *(uint4*)(dst + (size_t)(n + 2) * K + k) = o;
  o.x = pk2(v[0].w, v[1].w); o.y = pk2(v[2].w, v[3].w); o.z = pk2(v[4].w, v[5].w); o.w = pk2(v[6].w, v[7].w);
  *(uint4*)(dst + (size_t)(n + 3) * K + k) = o;
}
constexpr int WC_IN = 16 * 14, WC_KV = 4 * 4, WC_OUT = 16 * 4, WC_GU = 32 * 128, WC_DN = 32 * 64;
constexpr int WC_SMALL = WC_IN + WC_KV + WC_OUT, WC_ALL = WC_SMALL + WC_GU + WC_DN;
DI void wconv_task(const Params& p, int t, int tid) {
  if (t < WC_IN) {
    wconv_task2(p.w_in, (unsigned short*)(p.ws + OFF_WTIN), 1024, INC, (t / 14) * 64, (t % 14) * 256, tid);
  } else if (t < WC_IN + WC_KV) {
    t -= WC_IN;
    wconv_task2(p.w_kv_up, (unsigned short*)(p.ws + OFF_WTKV), 256, 1024, (t >> 2) * 64, (t & 3) * 256, tid);
  } else if (t < WC_SMALL) {
    t -= WC_IN + WC_KV;
    wconv_task2(p.w_out, (unsigned short*)(p.ws + OFF_WTOUT), 1024, 1024, (t >> 2) * 64, (t & 3) * 256, tid);
  } else if (t < WC_SMALL + WC_GU) {
    t -= WC_SMALL;
    const int e = t >> 7, r = t & 127;
    wconv_task2(p.w_gate_up + (size_t)e * 1024 * 2048, (unsigned short*)(p.ws + OFF_WTGU) + (size_t)e * 2048 * 1024, 1024, 2048,
                (r >> 3) * 64, (r & 7) * 256, tid);
  } else {
    t -= WC_SMALL + WC_GU;
    const int e = t >> 6, r = t & 63;
    wconv_task2(p.w_down + (size_t)e * 1024 * 1024, (unsigned short*)(p.ws + OFF_WTDN) + (size_t)e * 1024 * 1024, 1024, 1024,
                (r >> 2) * 64, (r & 3) * 256, tid);
  }
}
DI void wconv_fill(const Params& p, char* smem, int site, bool drain) {
  unsigned* q = (unsigned*)(p.ws + OFF_BAR + 15872 + 128);
  volatile LAS int* slot = (volatile LAS int*)((LAS unsigned char*)smem + STAGE_LDS_BYTES + 832);
  const int tid = otid(p);
  __syncthreads();
  if (tid == 0 && !drain) (void)__hip_atomic_fetch_add(&q[16 + site], 1u, __ATOMIC_RELAXED, __HIP_MEMORY_SCOPE_AGENT);
  for (;;) {
    __syncthreads();
    if (tid == 0) {
      int t = -1;
      const bool all_done = !drain && __hip_atomic_load(&q[16 + site], __ATOMIC_RELAXED, __HIP_MEMORY_SCOPE_AGENT) >= gridDim.x;
      if (!all_done) t = WC_SMALL + (int)__hip_atomic_fetch_add(&q[0], 1u, __ATOMIC_RELAXED, __HIP_MEMORY_SCOPE_AGENT);
      *slot = t;
    }
    __syncthreads();
    const int t = __builtin_amdgcn_readfirstlane(*slot);
    if (t < 0 || t >= WC_ALL) break;
    wconv_task(p, t, tid);
  }
}
DI void phase_wconv(const Params& p, int t0, int t1) {
  const int tid = otid(p);
  for (int t = t0 + blockIdx.x; t < t1; t += gridDim.x) wconv_task(p, t, tid);
}

namespace g8 {
constexpr int BM = 256, BK = 64, HALF = 128, HTB = HALF * BK * 2, STAGE_BYTES = 8 * HTB, NXCD = 8, WGM = 8;
constexpr int TAB_OFF = STAGE_BYTES;
constexpr int MAXU = 24;
DI int lds_byte(int r, int c) { const int st = (r >> 4) * 2 + (c >> 5), rr = r & 15, cc = c & 31, ob = rr * 64 + cc * 2; return st * 1024 + (ob ^ (((ob >> 9) & 1) << 5)); }
DI void stage_rc(int b, int& R, int& C) { const int st = b / 1024, sb = b % 1024, swz = sb ^ (((sb >> 9) & 1) << 5); R = (st >> 1) * 16 + swz / 64; C = (st & 1) * 32 + (swz % 64) / 2; }
DI int perm32(int rho) { const int n = rho >> 4, i = rho & 15; return 8 * (i >> 2) + 4 * n + (i & 3); }
DI int xcd_remap(int L, int nwg) { const int q = nwg / NXCD, r = nwg % NXCD, xcd = L % NXCD, off = L / NXCD; return (xcd < r ? xcd * (q + 1) : r * (q + 1) + (xcd - r) * q) + off; }
struct UnitT { int valid, arow, mend, pn, e, orow; };

template <int MODE> DI int n_units(const Params& p) {
  if (MODE == 0) return 65 * 14;
  if (MODE == 1) return 65 * 4;
  if (MODE == 2) return 64 * 4;
  const int* cnt = (const int*)(p.ws + OFF_CNT);
  int n = 0;
  for (int e = 0; e < NEXP; ++e) n += ((cnt[e * CNTS] + 255) >> 8) * (MODE == 3 ? 8 : 4);
  return n;
}
template <int MODE> DI void unit_of(const Params& p, int L, int nwg, UnitT& u) {
  u.valid = 0; u.arow = 0; u.mend = 0; u.pn = 0; u.e = 0; u.orow = 0;
  if (L >= nwg) return;
  const int wgid = xcd_remap(L, nwg);
  u.valid = 1;
  if (MODE <= 2) {
    const int nM = (MODE == 2) ? 64 : 65, nN = (MODE == 0) ? 14 : 4;
    const int nig = WGM * nN, gid = wgid / nig, fm = gid * WGM, gsz = (nM - fm) < WGM ? (nM - fm) : WGM;
    const int pm = fm + ((wgid % nig) % gsz);
    u.pn = (wgid % nig) / gsz;
    u.orow = pm * 256;
    u.arow = (MODE == 2) ? (pm * 256 + 16 * (pm / 16 + 1)) : pm * 256;
    u.mend = (MODE == 2) ? NR : NT;
  } else {
    const int* cnt = (const int*)(p.ws + OFF_CNT);
    constexpr int NTN = (MODE == 3) ? 8 : 4;
    int id = wgid, sbase = 0;
    for (int e = 0; e < NEXP; ++e) {
      const int c = cnt[e * CNTS], mts = (c + 255) >> 8, ne = mts * NTN;
      if (id < ne) {
        const int tn = id / mts, tm = id - tn * mts;
        u.e = e; u.pn = tn; u.arow = sbase + tm * 256; u.orow = u.arow; u.mend = sbase + c;
        return;
      }
      id -= ne;
      sbase += c;
    }
    u.valid = 0;
  }
}
DI float swiglu(float g, float u) {
  g = fminf(g, 7.0f);
  u = fminf(fmaxf(u, -7.0f), 7.0f);
  return g / (1.f + __expf(-1.702f * g)) * (u + 1.f);
}
template <int MODE>
DI void epilogue(const Params& p, const f32x4 (&acc)[2][2][4][2], const UnitT& u, int wr, int wc, int fr, int fq) {
  constexpr bool PERM = (MODE >= 3);
  const int row0 = u.orow + wr * 64 + fr;
  const int col0 = u.pn * 256 + wc * 32 + (PERM ? 8 * fq : 4 * fq);
  if (MODE == 0 || MODE == 1 || MODE == 2) {
    float* C = (float*)(p.ws + (MODE == 0 ? OFF_P : MODE == 1 ? OFF_KV : OFF_H1));
    const int ldc = (MODE == 0) ? INC : 1024;
#pragma unroll
    for (int ai = 0; ai < 2; ++ai)
#pragma unroll
      for (int m = 0; m < 4; ++m) {
        const int row = row0 + ai * 128 + m * 16;
        if (row < u.mend) {
#pragma unroll
          for (int bj = 0; bj < 2; ++bj)
#pragma unroll
            for (int n = 0; n < 2; ++n) {
              const int col = col0 + bj * 128 + n * 16;
              if (MODE != 0 || col < INC) {
                f32x4 v = acc[ai][bj][m][n];
                if (MODE == 2) v += *(const f32x4*)(p.x + (size_t)row * D + col);
                *(f32x4*)(C + (size_t)row * ldc + col) = v;
              }
            }
        }
      }
  } else if (MODE == 3) {
    unsigned short* HD = (unsigned short*)(p.ws + OFF_HD);
    f32x4 bv[2][2];
#pragma unroll
    for (int bj = 0; bj < 2; ++bj)
#pragma unroll
      for (int n = 0; n < 2; ++n) bv[bj][n] = *(const f32x4*)(p.b_gate_up + (size_t)u.e * 2048 + col0 + bj * 128 + 4 * n);
#pragma unroll
    for (int ai = 0; ai < 2; ++ai)
#pragma unroll
      for (int m = 0; m < 4; ++m) {
        const int row = row0 + ai * 128 + m * 16;
        if (row < u.mend) {
#pragma unroll
          for (int bj = 0; bj < 2; ++bj) {
            const f32x4 v0 = acc[ai][bj][m][0] + bv[bj][0], v1 = acc[ai][bj][m][1] + bv[bj][1];
            uint2 o;
            o.x = pk2(swiglu(v0[0], v0[1]), swiglu(v0[2], v0[3]));
            o.y = pk2(swiglu(v1[0], v1[1]), swiglu(v1[2], v1[3]));
            *(uint2*)(HD + (size_t)row * 1024 + (col0 + bj * 128) / 2) = o;
          }
        }
      }
  } else {
    unsigned short* Y = (unsigned short*)(p.ws + OFF_Y);
    const float* lgate = (const float*)(p.ws + OFF_LGATE);
    f32x4 bv[2][2];
#pragma unroll
    for (int bj = 0; bj < 2; ++bj)
#pragma unroll
      for (int n = 0; n < 2; ++n) bv[bj][n] = *(const f32x4*)(p.b_down + (size_t)u.e * 1024 + col0 + bj * 128 + 4 * n);
#pragma unroll
    for (int ai = 0; ai < 2; ++ai)
#pragma unroll
      for (int m = 0; m < 4; ++m) {
        const int row = row0 + ai * 128 + m * 16;
        if (row < u.mend) {
          const float gt = lgate[row];
#pragma unroll
          for (int bj = 0; bj < 2; ++bj) {
            const f32x4 v0 = (acc[ai][bj][m][0] + bv[bj][0]) * gt, v1 = (acc[ai][bj][m][1] + bv[bj][1]) * gt;
            uint4 o;
            o.x = pk2(v0[0], v0[1]); o.y = pk2(v0[2], v0[3]); o.z = pk2(v1[0], v1[1]); o.w = pk2(v1[2], v1[3]);
            *(uint4*)(Y + (size_t)row * 1024 + col0 + bj * 128) = o;
          }
        }
      }
  }
}

template <int MODE>
DI void gemm_phase(const Params& p, char* smem) {
  constexpr bool PERM = (MODE >= 3);
  constexpr int K = (MODE == 1) ? 256 : 1024, nt = K / BK;
  LAS unsigned char* lds = (LAS unsigned char*)smem;
  LAS int* tab = (LAS int*)(lds + TAB_OFF);
  const int tid = otid(p), wid = __builtin_amdgcn_readfirstlane(tid >> 6), lane = tid & 63, wr = wid >> 2, wc = wid & 3, fr = lane & 15, fq = lane >> 4;
  __syncthreads();
  {
    const int nwg = n_units<MODE>(p);
    for (int ti = 0; ti < MAXU; ++ti) {
      UnitT u;
      unit_of<MODE>(p, ti * (int)gridDim.x + (int)blockIdx.x, nwg, u);
      if (tid == 0) { tab[ti * 8 + 0] = u.valid; tab[ti * 8 + 1] = u.arow; tab[ti * 8 + 2] = u.mend; tab[ti * 8 + 3] = u.pn; tab[ti * 8 + 4] = u.e; tab[ti * 8 + 5] = u.orow; }
    }
  }
  __syncthreads();
#define G8_GETU(i, u) do { const int _i = (i); (u).valid = (_i < MAXU) ? __builtin_amdgcn_readfirstlane(tab[_i * 8 + 0]) : 0; (u).arow = __builtin_amdgcn_readfirstlane(tab[(_i < MAXU ? _i : 0) * 8 + 1]); \
    (u).mend = __builtin_amdgcn_readfirstlane(tab[(_i < MAXU ? _i : 0) * 8 + 2]); (u).pn = __builtin_amdgcn_readfirstlane(tab[(_i < MAXU ? _i : 0) * 8 + 3]); \
    (u).e = __builtin_amdgcn_readfirstlane(tab[(_i < MAXU ? _i : 0) * 8 + 4]); (u).orow = __builtin_amdgcn_readfirstlane(tab[(_i < MAXU ? _i : 0) * 8 + 5]); } while (0)
  UnitT cur, nxt;
  G8_GETU(0, cur);
  if (!cur.valid) return;
  const char* Abase = (const char*)(p.ws + (MODE == 0 ? OFF_U : MODE == 1 ? OFF_CKV : MODE == 2 ? OFF_MIX : MODE == 3 ? OFF_U2 : OFF_HD));
  const char* Bbase = (const char*)(p.ws + (MODE == 0 ? OFF_WTIN : MODE == 1 ? OFF_WTKV : MODE == 2 ? OFF_WTOUT : MODE == 3 ? OFF_WTGU : OFF_WTDN));
  constexpr size_t BEXP = (MODE == 3) ? (size_t)2048 * 1024 * 2 : (MODE == 4) ? (size_t)1024 * 1024 * 2 : 0;
  int Rr[2], Cc[2];
  unsigned voffB[2];
#pragma unroll
  for (int i = 0; i < 2; ++i) {
    stage_rc(tid * 16 + i * 8192, Rr[i], Cc[i]);
    const int Rb = PERM ? ((Rr[i] & ~31) + perm32(Rr[i] & 31)) : Rr[i];
    voffB[i] = (unsigned)(Rb * K + Cc[i]) * 2u;
  }
  unsigned voffA[2][2];
  const int* ltok = (const int*)(p.ws + OFF_LTOK);
#define G8_VOFFA(dst, un) do { _Pragma("unroll") for (int _h = 0; _h < 2; ++_h) _Pragma("unroll") for (int _i = 0; _i < 2; ++_i) { \
      if (MODE == 3) { int _s = (un).arow + _h * 128 + Rr[_i]; _s = _s < NASG ? _s : NASG - 1; dst[_h][_i] = (unsigned)(ltok[_s] * K + Cc[_i]) * 2u; } \
      else dst[_h][_i] = (unsigned)((_h * 128 + Rr[_i]) * K + Cc[_i]) * 2u; } } while (0)
  const size_t kstep = (size_t)(BK * 2);
  const size_t hstep = (size_t)HALF * K * 2;
  const size_t tstep = 2 * hstep;
  const unsigned ldsw = (unsigned)wid * 1024u;
  const int aoff = lds_byte(wr * 64 + fr, fq * 8), boff = lds_byte(wc * 32 + fr, fq * 8);
#define G8_SA(b, h) (((b) * 2 + (h)) * HTB)
#define G8_SB(b, h) ((4 + (b) * 2 + (h)) * HTB)
#define G8_STAGE(bufoff, gbase, voff) do { _Pragma("unroll") for (int _i = 0; _i < 2; ++_i) \
    __builtin_amdgcn_global_load_lds((const unsigned*)((const char*)(gbase) + (voff)[_i]), (LAS unsigned*)(lds + (bufoff) + ldsw + _i * 8192), 16, 0, 0); } while (0)
#define G8_LDA(dst, b, h) do { _Pragma("unroll") for (int m = 0; m < 4; ++m) _Pragma("unroll") for (int k = 0; k < 2; ++k) dst[m][k] = *(const LAS bf16x8*)(lds + G8_SA(b, h) + aoff + m * 2048 + k * 1024); } while (0)
#define G8_LDB(dst, b, h) do { _Pragma("unroll") for (int n = 0; n < 2; ++n) _Pragma("unroll") for (int k = 0; k < 2; ++k) dst[n][k] = *(const LAS bf16x8*)(lds + G8_SB(b, h) + boff + n * 2048 + k * 1024); } while (0)
#define G8_MMA(ai, bj, At, Bt) do { __builtin_amdgcn_s_setprio(1); _Pragma("unroll") for (int m = 0; m < 4; ++m) _Pragma("unroll") for (int n = 0; n < 2; ++n) _Pragma("unroll") for (int k = 0; k < 2; ++k) \
    acc[ai][bj][m][n] = __builtin_amdgcn_mfma_f32_16x16x32_bf16(Bt[n][k], At[m][k], acc[ai][bj][m][n], 0, 0, 0); __builtin_amdgcn_s_setprio(0); } while (0)
#define G8_WAIT_V(n) asm volatile("s_waitcnt vmcnt(" #n ")" ::: "memory")
#define G8_WAIT_L(n) asm volatile("s_waitcnt lgkmcnt(" #n ")" ::: "memory")
#define G8_BAR __builtin_amdgcn_s_barrier()
#define G8_SCHED __builtin_amdgcn_sched_barrier(0)
  int ui = 0;
  f32x4 acc[2][2][4][2];
#pragma unroll
  for (int a = 0; a < 2; ++a)
#pragma unroll
    for (int b = 0; b < 2; ++b)
#pragma unroll
      for (int m = 0; m < 4; ++m)
#pragma unroll
        for (int n = 0; n < 2; ++n) acc[a][b][m][n] = (f32x4){0.f, 0.f, 0.f, 0.f};
  bf16x8 At[4][2], B0[2][2], B1[2][2];
  G8_VOFFA(voffA, cur);
  if (MODE == 3) asm volatile("s_waitcnt vmcnt(0)" ::: "memory");
  const char* cA = (MODE == 3) ? Abase : Abase + (size_t)cur.arow * K * 2;
  const char* cB = Bbase + (size_t)cur.e * BEXP + (size_t)cur.pn * tstep;
  G8_STAGE(G8_SB(0, 0), cB, voffB); G8_STAGE(G8_SA(0, 0), cA, voffA[0]); G8_STAGE(G8_SB(0, 1), cB + hstep, voffB); G8_STAGE(G8_SA(0, 1), cA, voffA[1]);
  if (wr == 1) G8_BAR;
  G8_WAIT_V(4); G8_BAR;
  G8_STAGE(G8_SB(1, 0), cB + kstep, voffB); G8_STAGE(G8_SA(1, 0), cA + kstep, voffA[0]); G8_STAGE(G8_SB(1, 1), cB + hstep + kstep, voffB);
  G8_WAIT_V(6); G8_BAR;
  for (;;) {
    G8_GETU(ui + 1, nxt);
    const bool has_next = nxt.valid != 0;
    const char* nA = has_next ? ((MODE == 3) ? Abase : Abase + (size_t)nxt.arow * K * 2) : cA;
    const char* nB = has_next ? Bbase + (size_t)nxt.e * BEXP + (size_t)nxt.pn * tstep : cB;
#pragma unroll 1
    for (int t = 0; t < nt; t += 2) {
      const bool last = (t == nt - 2);
      const char* a1 = cA + (size_t)(t + 1) * kstep;
      const char* a2 = last ? nA : cA + (size_t)(t + 2) * kstep;
      const char* b2 = last ? nB : cB + (size_t)(t + 2) * kstep;
      const char* a3 = a2 + kstep;
      const char* b3 = b2 + kstep;
      G8_LDB(B0, 0, 0); G8_SCHED; G8_LDA(At, 0, 0); G8_STAGE(G8_SA(1, 1), a1, voffA[1]);
      if (MODE == 3) {
        if (last && has_next) {
          G8_VOFFA(voffA, nxt);
          asm volatile("s_waitcnt vmcnt(0)" ::: "memory");
        }
      }
      G8_WAIT_L(8); G8_BAR; G8_WAIT_L(0); G8_MMA(0, 0, At, B0); G8_BAR; G8_SCHED;
      G8_LDB(B1, 0, 1); G8_STAGE(G8_SB(0, 0), b2, voffB);
      G8_BAR; G8_WAIT_L(0); G8_MMA(0, 1, At, B1); G8_BAR;
      G8_LDA(At, 0, 1); G8_STAGE(G8_SA(0, 0), a2, voffA[0]);
      G8_BAR; G8_WAIT_L(0); G8_MMA(1, 0, At, B0); G8_BAR; G8_SCHED;
      G8_STAGE(G8_SB(0, 1), b2 + hstep, voffB);
      G8_WAIT_V(6); G8_BAR; G8_MMA(1, 1, At, B1); G8_BAR;
      G8_LDB(B0, 1, 0); G8_SCHED; G8_LDA(At, 1, 0); G8_STAGE(G8_SA(0, 1), a2, voffA[1]);
      G8_WAIT_L(8); G8_BAR; G8_WAIT_L(0); G8_MMA(0, 0, At, B0); G8_BAR; G8_SCHED;
      G8_LDB(B1, 1, 1); G8_STAGE(G8_SB(1, 0), b3, voffB);
      G8_BAR; G8_WAIT_L(0); G8_MMA(0, 1, At, B1); G8_BAR;
      G8_LDA(At, 1, 1); G8_STAGE(G8_SA(1, 0), a3, voffA[0]);
      G8_BAR; G8_WAIT_L(0); G8_MMA(1, 0, At, B0); G8_BAR; G8_SCHED;
      G8_STAGE(G8_SB(1, 1), b3 + hstep, voffB);
      G8_WAIT_V(6); G8_BAR; G8_MMA(1, 1, At, B1); G8_BAR;
    }
    epilogue<MODE>(p, acc, cur, wr, wc, fr, fq);
    if (!has_next) break;
#pragma unroll
    for (int a = 0; a < 2; ++a)
#pragma unroll
      for (int b = 0; b < 2; ++b)
#pragma unroll
        for (int m = 0; m < 4; ++m)
#pragma unroll
          for (int n = 0; n < 2; ++n) acc[a][b][m][n] = (f32x4){0.f, 0.f, 0.f, 0.f};
    cur = nxt; cA = nA; cB = nB; ++ui;
  }
  G8_WAIT_V(0);
  if (wr == 0) G8_BAR;
  G8_BAR;
#undef G8_GETU
#undef G8_VOFFA
#undef G8_SA
#undef G8_SB
#undef G8_STAGE
#undef G8_LDA
#undef G8_LDB
#undef G8_MMA
#undef G8_WAIT_V
#undef G8_WAIT_L
#undef G8_BAR
#undef G8_SCHED
}
}

DI float rope_apply(float v, float c, float s, int lane) {
  float o = xor32f(v, lane);
  return (lane < 32) ? (v * c - o * s) : (v * c + o * s);
}
DI void phase_post1(const Params& p, char* smem) {
  const int tid = otid(p), lane = tid & 63, wave = tid >> 6;
  const float* P = (const float*)(p.ws + OFF_P);
  const float* rope = (const float*)(p.ws + OFF_ROPE);
  unsigned short* Qb = (unsigned short*)(p.ws + OFF_QB);
  unsigned short* QI = (unsigned short*)(p.ws + OFF_QI);
  unsigned short* KI = (unsigned short*)(p.ws + OFF_KI);
  unsigned short* CKV = (unsigned short*)(p.ws + OFF_CKV);
  float* WI = (float*)(p.ws + OFF_WI);
  float* Qd = (float*)(p.ws + OFF_QD);
  float* Kd = (float*)(p.ws + OFF_KD);
  float* Vd = (float*)(p.ws + OFF_VD);
  float* BETA = (float*)(p.ws + OFF_BETA);
  float* G = (float*)(p.ws + OFF_G);
  float* cw = (float*)smem;
  __syncthreads();
  for (int idx = tid; idx < 4 * 1536; idx += NTHREADS) cw[idx] = p.conv_w[idx];
  __syncthreads();
  const float qw = p.q_norm_w[lane] * (0.125f * 1.4426950408889634f);
  const float4 kvw = *(const float4*)(p.kv_norm_w + lane * 4);
  constexpr int PG = 4;
  for (int g = blockIdx.x * NWAVES + wave; g < NT / PG; g += gridDim.x * NWAVES) {
    const int tok0 = g * PG, b = tok0 / T, t0 = tok0 - b * T;
    const int tailc = (lane < 8) ? (C_IW + lane) : (C_BBETA + ((lane - 8) & 7));
    float nqv[8], niv[8];
    float4 nckv;
    float nikv, ntail;
    {
      const float* row = P + (size_t)tok0 * INC;
#pragma unroll
      for (int hh = 0; hh < 8; ++hh) { nqv[hh] = row[C_AQ + hh * 64 + lane]; niv[hh] = row[C_IQ + hh * 64 + lane]; }
      nckv = *(const float4*)(row + C_CKV + lane * 4);
      nikv = row[C_IK + lane];
      ntail = row[tailc];
    }
#pragma unroll 1
    for (int tt = 0; tt < PG; ++tt) {
      const int tok = tok0 + tt, t = t0 + tt;
      float qv[8], iv[8];
#pragma unroll
      for (int hh = 0; hh < 8; ++hh) { qv[hh] = nqv[hh]; iv[hh] = niv[hh]; }
      const float4 ckv = nckv;
      const float ikv = nikv, tailv = ntail;
      if (tt + 1 < PG) {
        const float* row = P + (size_t)(tok + 1) * INC;
#pragma unroll
        for (int hh = 0; hh < 8; ++hh) { nqv[hh] = row[C_AQ + hh * 64 + lane]; niv[hh] = row[C_IQ + hh * 64 + lane]; }
        nckv = *(const float4*)(row + C_CKV + lane * 4);
        nikv = row[C_IK + lane];
        ntail = row[tailc];
      }
      const float cs = rope[t * 64 + (lane & 31)], sn = rope[t * 64 + 32 + (lane & 31)];
      unsigned short* qb = Qb + (size_t)tok * 512 + lane;
      unsigned short* qi = QI + (size_t)tok * 512 + lane;
#pragma unroll
      for (int hh = 0; hh < 8; ++hh) {
        float v = qv[hh];
        const float ss = wave_sum(v * v);
        v = v * rsqrtf(ss * (1.f / 64.f) + 1e-6f) * qw;
        qb[hh * 64] = f2bf(rope_apply(v, cs, sn, lane));
        qi[hh * 64] = f2bf(rope_apply(iv[hh], cs, sn, lane));
      }
      {
        const float ss = wave_sum(ckv.x * ckv.x + ckv.y * ckv.y + ckv.z * ckv.z + ckv.w * ckv.w);
        const float rstd = rsqrtf(ss * (1.f / 256.f) + 1e-6f);
        uint2 o;
        o.x = pk2(ckv.x * rstd * kvw.x, ckv.y * rstd * kvw.y);
        o.y = pk2(ckv.z * rstd * kvw.z, ckv.w * rstd * kvw.w);
        *(uint2*)(CKV + (size_t)tok * 256 + lane * 4) = o;
      }
      KI[(size_t)tok * 64 + lane] = f2bf(rope_apply(ikv, cs, sn, lane));
      if (lane < 8) WI[(size_t)tok * 8 + lane] = tailv * 0.04419417382415922f;
      if (lane >= 8 && lane < 12) BETA[(size_t)tok * 4 + (lane - 8)] = 1.f / (1.f + expf(-tailv));
      if (lane >= 12 && lane < 16) {
        const float xx = tailv + p.dt_bias[lane - 12];
        const float sp = fmaxf(xx, 0.f) + log1pf(expf(-fabsf(xx)));
        G[(size_t)tok * 4 + (lane - 12)] = -expf(p.a_log[lane - 12]) * sp;
      }
    }
    float x0[24], x1[24], x2[24];
    {
      const float* base = P + (size_t)tok0 * INC + C_BQKV + lane;
#pragma unroll
      for (int i = 0; i < 24; ++i) {
        x0[i] = (t0 >= 3) ? base[64 * i - 3 * (ptrdiff_t)INC] : 0.f;
        x1[i] = (t0 >= 2) ? base[64 * i - 2 * (ptrdiff_t)INC] : 0.f;
        x2[i] = (t0 >= 1) ? base[64 * i - 1 * (ptrdiff_t)INC] : 0.f;
      }
    }
    float xn[24];
    {
      const float* xr = P + (size_t)tok0 * INC + C_BQKV + lane;
#pragma unroll
      for (int i = 0; i < 24; ++i) xn[i] = xr[64 * i];
    }
#pragma unroll 1
    for (int tt = 0; tt < PG; ++tt) {
      const int tok = tok0 + tt;
      float x3[24];
#pragma unroll
      for (int i = 0; i < 24; ++i) x3[i] = xn[i];
      if (tt + 1 < PG) {
        const float* xr = P + (size_t)(tok + 1) * INC + C_BQKV + lane;
#pragma unroll
        for (int i = 0; i < 24; ++i) xn[i] = xr[64 * i];
      }
      int cl = lane;
      asm volatile("" : "+v"(cl));
      float* qd = Qd + (size_t)tok * 512 + lane;
      float* kd = Kd + (size_t)tok * 512 + lane;
      float* vd = Vd + (size_t)tok * 512 + lane;
#pragma unroll
      for (int hd = 0; hd < 4; ++hd) {
        float cv[6];
#pragma unroll
        for (int q = 0; q < 6; ++q) {
          const int i = (q >> 1) * 8 + 2 * hd + (q & 1);
          const int c = cl + 64 * i;
          const float a = cw[c] * x0[i] + cw[1536 + c] * x1[i] + cw[2 * 1536 + c] * x2[i] + cw[3 * 1536 + c] * x3[i];
          cv[q] = a / (1.f + __expf(-a));
          x0[i] = x1[i]; x1[i] = x2[i]; x2[i] = x3[i];
        }
        float ss = wave_sum(cv[0] * cv[0] + cv[1] * cv[1]);
        float r = rsqrtf(ss + 1e-6f);
        qd[hd * 128] = cv[0] * r;
        qd[hd * 128 + 64] = cv[1] * r;
        ss = wave_sum(cv[2] * cv[2] + cv[3] * cv[3]);
        r = rsqrtf(ss + 1e-6f);
        kd[hd * 128] = cv[2] * r;
        kd[hd * 128 + 64] = cv[3] * r;
        vd[hd * 128] = cv[4];
        vd[hd * 128 + 64] = cv[5];
      }
    }
  }
}

DI void phase_post2(const Params& p, char* smem) {
  (void)smem;
  const int tid = otid(p), lane = tid & 63, wave = tid >> 6;
  const float* KV = (const float*)(p.ws + OFF_KV);
  const float* rope = (const float*)(p.ws + OFF_ROPE);
  unsigned short* Kb = (unsigned short*)(p.ws + OFF_KB);
  unsigned short* Vb = (unsigned short*)(p.ws + OFF_VT);
  const float kw = p.k_norm_w[lane];
  for (int tok = blockIdx.x * NWAVES + wave; tok < NT; tok += gridDim.x * NWAVES) {
    const int b = tok / T, t = tok - b * T;
    const float* row = KV + (size_t)tok * 1024;
    float kv[8], vv[8];
#pragma unroll
    for (int hh = 0; hh < 8; ++hh) { kv[hh] = row[hh * 64 + lane]; vv[hh] = row[512 + hh * 64 + lane]; }
    const float cs = rope[t * 64 + (lane & 31)], sn = rope[t * 64 + 32 + (lane & 31)];
    unsigned short* kb = Kb + (size_t)tok * 512 + lane;
    unsigned short* vb = Vb + (size_t)tok * 512 + lane;
#pragma unroll
    for (int hh = 0; hh < 8; ++hh) {
      float v = kv[hh];
      const float ss = wave_sum(v * v);
      v = v * rsqrtf(ss * (1.f / 64.f) + 1e-6f) * kw;
      kb[hh * 64] = f2bf(rope_apply(v, cs, sn, lane));
      vb[hh * 64] = f2bf(vv[hh]);
    }
  }
}

constexpr int KS_STRIDE = 129, AM_STRIDE = 65;
DI void phase_chunkprep(const Params& p, char* smem) {
  constexpr int KQ = 136;
  unsigned short* K16 = (unsigned short*)smem;
  unsigned short* Q16 = K16 + 64 * KQ;
  float* Am = (float*)(Q16 + 64 * KQ);
  float* Tm = Am + 64 * AM_STRIDE;
  float* gc = Tm + 64 * AM_STRIDE;
  float* bet = gc + 64;
  float* gl = bet + 64;
  unsigned short* T16 = (unsigned short*)(gl + 64);
  float* Mt = (float*)T16;
  unsigned short* VbT = T16 + 64 * 72;
  unsigned short* KbT = VbT + 128 * 72;
  static_assert(2 * 64 * KQ * 2 + (64 * AM_STRIDE * 2 + 192) * 4 + (64 * 72 + 2 * 128 * 72) * 2 <= 131072, "chunk prep LDS");
  const int tid = otid(p), lane = tid & 63, wave = tid >> 6;
  const float* Qd = (const float*)(p.ws + OFF_QD);
  const float* Kd = (const float*)(p.ws + OFF_KD);
  const float* Vd = (const float*)(p.ws + OFF_VD);
  const float* BETA = (const float*)(p.ws + OFF_BETA);
  const float* G = (const float*)(p.ws + OFF_G);
  unsigned short* CHB = (unsigned short*)(p.ws + OFF_WN);
  float* UU = (float*)(p.ws + OFF_UU);
  float* DL = (float*)(p.ws + OFF_DL);
  for (int ci = blockIdx.x; ci < NCHT; ci += gridDim.x) {
    unsigned short* chb = CHB + (size_t)ci * CHB_ELEMS;
    const int bh = ci / NCH, c = ci - bh * NCH, b = bh >> 2, h = bh & 3;
    __syncthreads();
    if (tid < 64) {
      int t = c * 64 + tid - 48;
      float g = 0.f, be = 0.f;
      if (t >= 0) { g = G[(size_t)(b * T + t) * 4 + h]; be = BETA[(size_t)(b * T + t) * 4 + h]; }
      gl[tid] = g;
      bet[tid] = be;
    }
    __syncthreads();
    if (tid < 64) {
      float s2 = 0.f;
      for (int j = 0; j <= tid; ++j) s2 += gl[j];
      gc[tid] = s2;
    }
    __syncthreads();
#pragma unroll 1
    for (int hb = 0; hb < 2; ++hb) {
      float kr[8], qr[8], vr[8];
#pragma unroll
      for (int it = 0; it < 8; ++it) {
        const int idx = tid + (hb * 8 + it) * NTHREADS, i = idx >> 7, d = idx & 127;
        const int t = c * 64 + i - 48;
        kr[it] = 0.f; qr[it] = 0.f; vr[it] = 0.f;
        if (t >= 0) {
          const size_t o = ((size_t)(b * T + t)) * 512 + h * 128 + d;
          kr[it] = Kd[o];
          qr[it] = Qd[o] * 0.08838834764831845f;
          vr[it] = Vd[o];
        }
      }
#pragma unroll
      for (int it = 0; it < 8; ++it) {
        const int idx = tid + (hb * 8 + it) * NTHREADS, i = idx >> 7, d = idx & 127;
        const float bi = bet[i], eg = __expf(gc[i]);
        K16[i * KQ + d] = f2bf(kr[it]);
        Q16[i * KQ + d] = f2bf(qr[it]);
        VbT[d * 72 + i] = f2bf(bi * vr[it]);
        KbT[d * 72 + i] = f2bf(bi * eg * kr[it]);
        chb[CH_QG + swzA(i, d)] = f2bf(qr[it] * eg);
      }
    }
    __syncthreads();
    {
      const int mat = wave >> 2, tl = wave & 3, lr = lane & 31, lh = lane >> 5;
      if (tl < 3) {
        const int mt = (tl + 1) >> 1, nt = tl >> 1;
        const unsigned short* At = mat ? Q16 : K16;
        f32x16 acc;
#pragma unroll
        for (int r = 0; r < 16; ++r) acc[r] = 0.f;
#pragma unroll
        for (int ks = 0; ks < 8; ++ks) {
          const bf16x8 af = ld16(At + (mt * 32 + lr) * KQ + ks * 16 + 8 * lh);
          const bf16x8 bfr = ld16(K16 + (nt * 32 + lr) * KQ + ks * 16 + 8 * lh);
          acc = MFMA32(af, bfr, acc);
        }
        const int j = nt * 32 + lr;
        const float gj = gc[j];
#pragma unroll
        for (int r = 0; r < 16; ++r) {
          const int i = mt * 32 + crow(r, lh);
          const float dec = (j <= i) ? __expf(gc[i] - gj) : 0.f;
          if (mat == 0) Am[i * AM_STRIDE + j] = (j < i) ? bet[i] * acc[r] * dec : 0.f;
          else chb[CH_IN + swzB(i, j)] = f2bf(acc[r] * dec);
        }
      } else {
        const int lr = lane & 31, lh = lane >> 5;
#pragma unroll
        for (int r = 0; r < 16; ++r) {
          const int i = crow(r, lh), j = 32 + lr;
          if (mat == 0) Am[i * AM_STRIDE + j] = 0.f;
          else chb[CH_IN + swzB(i, j)] = 0;
        }
      }
    }
    __syncthreads();
    {
      for (int idx = tid; idx < 64 * 64; idx += NTHREADS) Tm[(idx >> 6) * AM_STRIDE + (idx & 63)] = 0.f;
      __syncthreads();
      if (tid < 64) {
        const int bb = tid >> 4, cc = tid & 15, o = 16 * bb;
        float x[16];
#pragma unroll
        for (int i = 0; i < 16; ++i) {
          float a = (i == cc) ? 1.f : 0.f;
#pragma unroll
          for (int j = 0; j < 16; ++j)
            if (j < i) a -= Am[(o + i) * AM_STRIDE + o + j] * x[j];
          x[i] = a;
          Tm[(o + i) * AM_STRIDE + o + cc] = a;
        }
      }
      __syncthreads();
      {
        const int B = tid >> 8, i = (tid >> 4) & 15, j = tid & 15, o = 32 * B;
        float m = 0.f;
#pragma unroll
        for (int k = 0; k < 16; ++k) m += Am[(o + 16 + i) * AM_STRIDE + o + k] * Tm[(o + k) * AM_STRIDE + o + j];
        Mt[(B * 16 + i) * 33 + j] = m;
        __syncthreads();
        float t = 0.f;
#pragma unroll
        for (int k = 0; k < 16; ++k) t += Tm[(o + 16 + i) * AM_STRIDE + o + 16 + k] * Mt[(B * 16 + k) * 33 + j];
        __syncthreads();
        Tm[(o + 16 + i) * AM_STRIDE + o + j] = -t;
      }
      __syncthreads();
      {
        const int i = tid >> 4, j0 = (tid & 15) * 2;
        float m0 = 0.f, m1 = 0.f;
        for (int k = 0; k < 32; ++k) {
          const float a = Am[(32 + i) * AM_STRIDE + k];
          m0 += a * Tm[k * AM_STRIDE + j0];
          m1 += a * Tm[k * AM_STRIDE + j0 + 1];
        }
        Mt[i * 33 + j0] = m0;
        Mt[i * 33 + j0 + 1] = m1;
        __syncthreads();
        float t0 = 0.f, t1 = 0.f;
        for (int k = 0; k < 32; ++k) {
          const float a = Tm[(32 + i) * AM_STRIDE + 32 + k];
          t0 += a * Mt[k * 33 + j0];
          t1 += a * Mt[k * 33 + j0 + 1];
        }
        __syncthreads();
        Tm[(32 + i) * AM_STRIDE + j0] = -t0;
        Tm[(32 + i) * AM_STRIDE + j0 + 1] = -t1;
      }
    }
    __syncthreads();
    for (int idx = tid; idx < 64 * 64; idx += NTHREADS) T16[(idx >> 6) * 72 + (idx & 63)] = f2bf(Tm[(idx >> 6) * AM_STRIDE + (idx & 63)]);
    __syncthreads();
    {
      const int mat = wave >> 2, nt = wave & 3, lr = lane & 31, lh = lane >> 5;
      const unsigned short* Bt = mat ? KbT : VbT;
#pragma unroll
      for (int mt = 0; mt < 2; ++mt) {
        f32x16 acc;
#pragma unroll
        for (int r = 0; r < 16; ++r) acc[r] = 0.f;
#pragma unroll
        for (int ks = 0; ks < 4; ++ks) {
          const bf16x8 af = ld16(T16 + (mt * 32 + lr) * 72 + ks * 16 + 8 * lh);
          const bf16x8 bfr = ld16(Bt + (nt * 32 + lr) * 72 + ks * 16 + 8 * lh);
          acc = MFMA32(af, bfr, acc);
        }
        if (mat == 0) {
          float* up = UU + (size_t)ci * 8192 + (((nt * 2 + mt) * 2 + lh) * 32 + lr) * 16;
#pragma unroll
          for (int q = 0; q < 4; ++q) *(float4*)(up + 4 * q) = make_float4(acc[4 * q], acc[4 * q + 1], acc[4 * q + 2], acc[4 * q + 3]);
        } else {
#pragma unroll
          for (int r = 0; r < 16; ++r) chb[swzA(mt * 32 + crow(r, lh), nt * 32 + lr)] = f2bf(-acc[r]);
        }
      }
    }
    const float glast = gc[63];
    for (int idx = tid; idx < 64 * 128; idx += NTHREADS) {
      int i = idx & 63, d = idx >> 6;
      chb[CH_KDT + swzB(d, i)] = f2bf(bf2f(K16[i * KQ + d]) * __expf(glast - gc[i]));
    }
    if (tid == 0) DL[ci] = __expf(glast);
  }
}

DI float relu_fma(float w, float x, float acc) {
  const int xi = __builtin_bit_cast(int, x);
  const float m = __builtin_bit_cast(float, xi > 0 ? xi : 0);
  return __builtin_fmaf(w, m, acc);
}
DI unsigned ordkey(float f) {
  unsigned u = __float_as_uint(f);
  return (u & 0x80000000u) ? ~u : (u | 0x80000000u);
}
DI int half_sum(int v) {
  v += dppi<0xB1>(v); v += dppi<0x4E>(v); v += dppi<0x141>(v); v += dppi<0x140>(v);
  const int lo = __builtin_amdgcn_readlane(v, 0) + __builtin_amdgcn_readlane(v, 16);
  const int hi = __builtin_amdgcn_readlane(v, 32) + __builtin_amdgcn_readlane(v, 48);
  return (__builtin_amdgcn_mbcnt_hi(~0u, __builtin_amdgcn_mbcnt_lo(~0u, 0u)) < 32u) ? lo : hi;
}
DI int cnt4_ge(int cnt, unsigned a, unsigned b, unsigned c, unsigned d, unsigned cand) {
  unsigned long long m0, m1, m2, m3;
  asm("v_cmp_ge_u32_e64 %1, %5, %9\n\tv_cmp_ge_u32_e64 %2, %6, %9\n\tv_cmp_ge_u32_e64 %3, %7, %9\n\tv_cmp_ge_u32_e64 %4, %8, %9\n\t"
      "v_addc_co_u32_e64 %0, %1, %0, 0, %1\n\tv_addc_co_u32_e64 %0, %2, %0, 0, %2\n\tv_addc_co_u32_e64 %0, %3, %0, 0, %3\n\tv_addc_co_u32_e64 %0, %4, %0, 0, %4"
      : "+v"(cnt), "=&s"(m0), "=&s"(m1), "=&s"(m2), "=&s"(m3)
      : "v"(a), "v"(b), "v"(c), "v"(d), "v"(cand));
  return cnt;
}
DI int cnt4_gt(int cnt, unsigned a, unsigned b, unsigned c, unsigned d, unsigned cand) {
  unsigned long long m0, m1, m2, m3;
  asm("v_cmp_gt_u32_e64 %1, %5, %9\n\tv_cmp_gt_u32_e64 %2, %6, %9\n\tv_cmp_gt_u32_e64 %3, %7, %9\n\tv_cmp_gt_u32_e64 %4, %8, %9\n\t"
      "v_addc_co_u32_e64 %0, %1, %0, 0, %1\n\tv_addc_co_u32_e64 %0, %2, %0, 0, %2\n\tv_addc_co_u32_e64 %0, %3, %0, 0, %3\n\tv_addc_co_u32_e64 %0, %4, %0, 0, %4"
      : "+v"(cnt), "=&s"(m0), "=&s"(m1), "=&s"(m2), "=&s"(m3)
      : "v"(a), "v"(b), "v"(c), "v"(d), "v"(cand));
  return cnt;
}
DI void indexer_task(const Params& p, char* smem, int b, int q8, int wave, int lane) {
  const int q0 = (q8 * 8 + wave) * 2;
  unsigned* MASK = (unsigned*)(p.ws + OFF_MASK);
  const int qsel = lane >> 5;
  const int tq = q0 + qsel;
  unsigned* mrow = MASK + (size_t)b * 128 * SEQ + tq;
  if (q8 < 16) {
    for (int i = (lane & 31); i < 128; i += 32) {
      int rem = tq + 1 - 32 * i;
      unsigned w = (rem >= 32) ? 0xffffffffu : (rem > 0 ? ((1u << rem) - 1u) : 0u);
      mrow[(size_t)i * SEQ] = w;
    }
    return;
  }
  const unsigned short* QI = (const unsigned short*)(p.ws + OFF_QI);
  const unsigned short* KI = (const unsigned short*)(p.ws + OFF_KI);
  const float* WI = (const float*)(p.ws + OFF_WI);
  const int l15 = lane & 15, lg = lane >> 4;
  const size_t qtok = (size_t)b * T + NM + q0 + (l15 >> 3);
  const bf16x8 a0 = ld16(QI + qtok * 512 + (l15 & 7) * 64 + 8 * lg);
  const bf16x8 a1 = ld16(QI + qtok * 512 + (l15 & 7) * 64 + 32 + 8 * lg);
  float w[4];
  {
    const size_t wtok = (size_t)b * T + NM + q0 + (lg >> 1);
#pragma unroll
    for (int r = 0; r < 4; ++r) w[r] = WI[wtok * 8 + 4 * (lg & 1) + r];
  }
  const int npairs = (q0 + 2 + 31) >> 5;
  const int npmax = (16 * q8 + 16 + 31) >> 5;
  LAS unsigned char* lds = (LAS unsigned char*)smem;
  const bool loader = wave < 4;
  const unsigned short* ksrc = KI + ((size_t)b * T + NM + 8 * wave + (lane >> 3)) * 64 + (((lane & 7) ^ (lane >> 3)) << 3);
  const unsigned frag0 = (unsigned)(l15 * 128 + ((lg ^ (l15 & 7)) << 4));
  const unsigned frag1 = (unsigned)(l15 * 128 + (((4 + lg) ^ (l15 & 7)) << 4));
  asm volatile("s_waitcnt vmcnt(0)" ::: "memory");
  __syncthreads();
#define IX_DMA(stage) __builtin_amdgcn_global_load_lds((const unsigned*)(ksrc + (size_t)(stage) * 2048), (LAS unsigned*)(lds + ((stage) & 3) * 4096 + wave * 1024), 16, 0, 0)
  if (loader) {
    IX_DMA(0);
    if (1 < npmax) IX_DMA(1);
    if (2 < npmax) IX_DMA(2);
  }
  unsigned u[128];
  int rem = tq - (lane & 31);
#pragma unroll
  for (int i = 0; i < 128; ++i) {
    unsigned uv = 0u;
    if (i < npmax) {
      if (loader) {
        if (i + 2 < npmax) asm volatile("s_waitcnt vmcnt(2)" ::: "memory");
        else if (i + 1 < npmax) asm volatile("s_waitcnt vmcnt(1)" ::: "memory");
        else asm volatile("s_waitcnt vmcnt(0)" ::: "memory");
      }
      __builtin_amdgcn_s_barrier();
      if (loader && i + 3 < npmax) IX_DMA(i + 3);
      if (i < npairs) {
        const LAS unsigned char* sb = lds + (i & 3) * 4096;
        float tot[2];
#pragma unroll
        for (int par = 0; par < 2; ++par) {
          const bf16x8 b0 = *(const LAS bf16x8*)(sb + par * 2048 + frag0);
          const bf16x8 b1 = *(const LAS bf16x8*)(sb + par * 2048 + frag1);
          f32x4 acc = {0.f, 0.f, 0.f, 0.f};
          acc = MFMA16(a0, b0, acc);
          acc = MFMA16(a1, b1, acc);
          float part = 0.f;
#pragma unroll
          for (int r = 0; r < 4; ++r) part = relu_fma(w[r], acc[r], part);
          tot[par] = part + xor16f(part, lane);
        }
        const float sc = (lg & 1) ? tot[1] : tot[0];
        uv = (rem >= 0) ? ordkey(sc) : 0u;
      }
    }
    u[i] = uv;
    rem -= 32;
    asm volatile("" : "+v"(rem));
  }
#undef IX_DMA
  __builtin_amdgcn_s_barrier();
  const int nblk = (npairs + 15) >> 4;
  unsigned thr = 0u;
  bool done = false;
  for (int bit = 31; bit >= 0; --bit) {
    const unsigned cand = thr | (1u << bit);
    int cnt = 0;
#pragma unroll
    for (int blk = 0; blk < 8; ++blk) {
      if (blk < nblk) {
#pragma unroll
        for (int j = 0; j < 16; j += 4) cnt = cnt4_ge(cnt, u[blk * 16 + j], u[blk * 16 + j + 1], u[blk * 16 + j + 2], u[blk * 16 + j + 3], cand);
      }
    }
    cnt = half_sum(cnt);
    if (!done && cnt >= 256) thr = cand;
    done = done || (cnt == 256);
    if (__all(done)) break;
  }
  int cgt = 0;
#pragma unroll
  for (int blk = 0; blk < 8; ++blk) {
    if (blk < nblk) {
#pragma unroll
      for (int j = 0; j < 16; j += 4) cgt = cnt4_gt(cgt, u[blk * 16 + j], u[blk * 16 + j + 1], u[blk * 16 + j + 2], u[blk * 16 + j + 3], thr);
    }
  }
  cgt = half_sum(cgt);
  const int need = 256 - cgt;
  int base = 0;
  const unsigned lt_mask = (1u << (lane & 31)) - 1u;
#pragma unroll
  for (int blk = 0; blk < 8; ++blk) {
    if (blk < nblk) {
#pragma unroll
      for (int j = 0; j < 16; ++j) {
        const int i = blk * 16 + j;
        const bool eq = (u[i] == thr);
        const unsigned long long eb = __ballot(eq);
        const unsigned ehalf = qsel ? (unsigned)(eb >> 32) : (unsigned)eb;
        const int below = __popc(ehalf & lt_mask);
        const bool sel = (u[i] > thr) || (eq && (base + below < need));
        base += __popc(ehalf);
        const unsigned long long sb = __ballot(sel);
        const unsigned shalf = qsel ? (unsigned)(sb >> 32) : (unsigned)sb;
        if ((lane & 31) == 0) mrow[(size_t)i * SEQ] = shalf;
      }
    }
  }
}
DI void phase_indexer(const Params& p, char* smem) {
  const int tid = otid(p), lane = tid & 63, wave = __builtin_amdgcn_readfirstlane(tid >> 6);
  unsigned* ctr = (unsigned*)(p.ws + OFF_BAR + 15872 + 64);
  volatile LAS int* slot = (volatile LAS int*)((LAS unsigned char*)smem + g8::STAGE_BYTES + 800);
  const int ngroup = NB * (SEQ / 16);
  for (;;) {
    __syncthreads();
    if (tid == 0) *slot = (int)__hip_atomic_fetch_add(ctr, 1u, __ATOMIC_RELAXED, __HIP_MEMORY_SCOPE_AGENT);
    __syncthreads();
    const int g = __builtin_amdgcn_readfirstlane(*slot);
    if (g >= ngroup) break;
    const int b = g & 3, q8 = (SEQ / 16 - 1) - (g >> 2);
    indexer_task(p, smem, b, q8, wave, lane);
  }
}

constexpr int AT_KROW = 72, AT_VROW = 96;
constexpr int AT_KBYTES = 64 * AT_KROW * 2, AT_STAGE = AT_KBYTES + 64 * AT_VROW * 2;
typedef short s16x4v __attribute__((ext_vector_type(4)));
typedef unsigned u32x4v __attribute__((ext_vector_type(4)));
DI void attn_block(const Params& p, char* smem, int b, int hh, int G) {
  const unsigned short* Qb = (const unsigned short*)(p.ws + OFF_QB);
  const unsigned short* Kb = (const unsigned short*)(p.ws + OFF_KB);
  const unsigned short* Vb = (const unsigned short*)(p.ws + OFF_VT);
  const unsigned* MASK = (const unsigned*)(p.ws + OFF_MASK);
  unsigned short* MIX = (unsigned short*)(p.ws + OFF_MIX);
  LAS unsigned char* lds = (LAS unsigned char*)smem;
  const int tid = otid(p), lane = tid & 63, wave = __builtin_amdgcn_readfirstlane(tid >> 6);
  const int lr = lane & 31, lh = lane >> 5;
  const int qt = 8 * G + wave;
  const int jl = (qt + 1) >> 1;
  const int tq = qt * 32 + lr;
  const size_t qtok = (size_t)b * T + NM + tq;
  bf16x8 qf[4];
#pragma unroll
  for (int ks = 0; ks < 4; ++ks) qf[ks] = ld16(Qb + qtok * 512 + hh * 64 + ks * 16 + 8 * lh);
  const unsigned* mrow = MASK + (size_t)b * 128 * SEQ + tq;
  const int srow = tid >> 3, sch = tid & 7;
  const size_t gcol = (size_t)hh * 64 + sch * 8;
  const unsigned short* kbase = Kb + (size_t)b * T * 512 + gcol;
  const unsigned short* vbase = Vb + (size_t)b * T * 512 + gcol;
  const unsigned sdk = (unsigned)(srow * (AT_KROW * 2) + sch * 16);
  const unsigned sdv = (unsigned)(AT_KBYTES + srow * (AT_VROW * 2) + sch * 16);
  const int nst = 4 * G + 5;
  const unsigned koff = (unsigned)(lr * (AT_KROW * 2) + 16 * lh);
  const unsigned voff = (unsigned)(AT_KBYTES + (4 * lh + ((lane & 15) >> 2)) * (AT_VROW * 2) + (16 * ((lane >> 4) & 1) + 4 * (lane & 3)) * 2);
  __syncthreads();
  {
    const size_t t0 = (size_t)(srow < 32 ? srow : srow - 16) * 512;
    const u32x4v k0 = *(const u32x4v*)(kbase + t0);
    const u32x4v v0 = *(const u32x4v*)(vbase + t0);
    *(LAS u32x4v*)(lds + sdk) = k0;
    *(LAS u32x4v*)(lds + sdv) = v0;
  }
  u32x4v rk1 = *(const u32x4v*)(kbase + (size_t)(48 + srow) * 512), rv1 = *(const u32x4v*)(vbase + (size_t)(48 + srow) * 512);
  u32x4v rk0 = *(const u32x4v*)(kbase + (size_t)(112 + srow) * 512), rv0 = *(const u32x4v*)(vbase + (size_t)(112 + srow) * 512);
  f32x16 o[2], negm, lacc;
#pragma unroll
  for (int r = 0; r < 16; ++r) { o[0][r] = 0.f; o[1][r] = 0.f; negm[r] = 0.f; lacc[r] = 0.f; }
  const bf16x8 ones = {0x3F80, 0x3F80, 0x3F80, 0x3F80, 0x3F80, 0x3F80, 0x3F80, 0x3F80};
  unsigned wa0 = 0x0000ffffu, wb0 = mrow[0], wa1 = mrow[SEQ], wb1 = mrow[2 * SEQ];
  asm volatile("" : "+v"(rk0), "+v"(rv0), "+v"(rk1), "+v"(rv1), "+v"(wb0), "+v"(wa1), "+v"(wb1));
  __syncthreads();
#define AT_STEP(jj, PAR, FIRST, rkn, rvn, wa, wb) do { \
    const int j_ = (jj); \
      \
      \
    *(LAS u32x4v*)(lds + (PAR ^ 1) * AT_STAGE + sdk) = rkn; \
    *(LAS u32x4v*)(lds + (PAR ^ 1) * AT_STAGE + sdv) = rvn; \
    { \
      const size_t go = (size_t)min(64 * (j_ + 3) - 16 + srow, T - 1) * 512; \
      rkn = *(const u32x4v*)(kbase + go); \
      rvn = *(const u32x4v*)(vbase + go); \
    } \
    if (j_ <= jl) { \
      const LAS unsigned char* sb = lds + PAR * AT_STAGE; \
        \
        \
      bf16x8 kf0[4], kf1[4], vf[4][2]; \
_Pragma("unroll") \
      for (int ks = 0; ks < 4; ++ks) { \
        kf0[ks] = *(const LAS bf16x8*)(sb + koff + ks * 32); \
        kf1[ks] = *(const LAS bf16x8*)(sb + koff + 32 * (AT_KROW * 2) + ks * 32); \
      } \
_Pragma("unroll") \
      for (int ss = 0; ss < 4; ++ss) \
_Pragma("unroll") \
        for (int dt = 0; dt < 2; ++dt) { \
            \
          const LAS unsigned char* vp = sb + voff + (16 * ss) * (AT_VROW * 2) + dt * 64; \
          const s16x4v lo = __builtin_amdgcn_ds_read_tr16_b64_v4i16((LAS s16x4v*)vp); \
          const s16x4v hi = __builtin_amdgcn_ds_read_tr16_b64_v4i16((LAS s16x4v*)(vp + 8 * (AT_VROW * 2))); \
          vf[ss][dt] = __builtin_shufflevector(lo, hi, 0, 1, 2, 3, 4, 5, 6, 7); \
        } \
      __builtin_amdgcn_sched_barrier(0); \
      f32x16 s0 = negm, s1 = negm; \
_Pragma("unroll") \
      for (int ks = 0; ks < 4; ++ks) { \
        s0 = MFMA32(kf0[ks], qf[ks], s0); \
        s1 = MFMA32(kf1[ks], qf[ks], s1); \
      } \
        \
        \
        \
      int tmi = max(__float_as_int(s0[0]), __float_as_int(s1[0])); \
_Pragma("unroll") \
      for (int r = 1; r < 16; ++r) tmi = max(tmi, max(__float_as_int(s0[r]), __float_as_int(s1[r]))); \
      tmi = max(tmi, __float_as_int(xor32f(__int_as_float(tmi), lane))); \
      if (FIRST) {     \
        float tmax = fmaxf(s0[0], s1[0]); \
_Pragma("unroll") \
        for (int r = 1; r < 16; ++r) tmax = fmaxf(tmax, fmaxf(s0[r], s1[r])); \
        tmax = fmaxf(tmax, xor32f(tmax, lane)); \
_Pragma("unroll") \
        for (int r = 0; r < 16; ++r) { negm[r] = -tmax; s0[r] -= tmax; s1[r] -= tmax; } \
      } else if (!__all(tmi <= 0)) { \
        const float d = __int_as_float(max(tmi, 0)); \
        const float alpha = __builtin_amdgcn_exp2f(-d); \
_Pragma("unroll") \
        for (int r = 0; r < 16; ++r) { \
          negm[r] -= d; s0[r] -= d; s1[r] -= d; \
          o[0][r] *= alpha; o[1][r] *= alpha; lacc[r] *= alpha; \
        } \
      } \
        \
      const unsigned wsa = wa >> (4 * lh); \
      const unsigned wsb = (2 * j_ <= qt ? wb : 0u) >> (4 * lh); \
_Pragma("unroll") \
      for (int r = 0; r < 16; ++r) { \
        unsigned va, vb; \
        asm("v_bfe_i32 %0, %1, %2, 1" : "=v"(va) : "v"(wsa), "n"((r & 3) + 8 * (r >> 2))); \
        asm("v_bfe_i32 %0, %1, %2, 1" : "=v"(vb) : "v"(wsb), "n"((r & 3) + 8 * (r >> 2))); \
        s0[r] = __uint_as_float(__float_as_uint(__builtin_amdgcn_exp2f(s0[r])) & va); \
        s1[r] = __uint_as_float(__float_as_uint(__builtin_amdgcn_exp2f(s1[r])) & vb); \
      } \
_Pragma("unroll") \
      for (int ss = 0; ss < 4; ++ss) { \
        const bf16x8 pf = (ss < 2) ? pack8(s0, ss & 1) : pack8(s1, ss & 1); \
        lacc = MFMA32(ones, pf, lacc); \
_Pragma("unroll") \
        for (int dt = 0; dt < 2; ++dt) o[dt] = MFMA32(vf[ss][dt], pf, o[dt]); \
      } \
    } \
    wa = mrow[(size_t)min(2 * j_ + 3, 127) * SEQ];     \
    wb = mrow[(size_t)min(2 * j_ + 4, 127) * SEQ];     \
    __syncthreads(); \
  } while (0)
  AT_STEP(0, 0, true, rk1, rv1, wa0, wb0);
  for (int j = 1; j < nst; j += 2) {
    AT_STEP(j, 1, false, rk0, rv0, wa1, wb1);
    AT_STEP(j + 1, 0, false, rk1, rv1, wa0, wb0);
  }
#undef AT_STEP
  const float inv = 1.f / lacc[0];
#pragma unroll
  for (int dt = 0; dt < 2; ++dt)
#pragma unroll
    for (int r = 0; r < 16; ++r) MIX[qtok * 1024 + hh * 64 + dt * 32 + crow(r, lh)] = f2bf(o[dt][r] * inv);
}
DI void attn_worker(const Params& p, char* smem) {
  unsigned* ctr = (unsigned*)(p.ws + OFF_BAR + 15872);
  volatile LAS int* slot = (volatile LAS int*)((LAS unsigned char*)smem + g8::STAGE_BYTES + 800);
  const int tid = otid(p);
  for (;;) {
    __syncthreads();
    if (tid == 0) *slot = (int)__hip_atomic_fetch_add(ctr, 1u, __ATOMIC_RELAXED, __HIP_MEMORY_SCOPE_AGENT);
    __syncthreads();
    const int k = __builtin_amdgcn_readfirstlane(*slot);
    if (k >= NB * 8 * 16) break;
    const int bh = k & 31, G = 15 - (k >> 5);
    attn_block(p, smem, bh >> 3, bh & 7, G);
  }
}

DI bf16x8 lds8x2(const LAS unsigned short* p0, const LAS unsigned short* p1) {
  typedef unsigned u32x2_t __attribute__((ext_vector_type(2)));
  typedef unsigned u32x4_t __attribute__((ext_vector_type(4)));
  const u32x2_t a = *(const LAS u32x2_t*)p0, b = *(const LAS u32x2_t*)p1;
  const u32x4_t r = {a[0], a[1], b[0], b[1]};
  return __builtin_bit_cast(bf16x8, r);
}
DI void scan_block(const Params& p, char* smem, int bh, const int c0, const int c1) {
  const int tid = otid(p), lane = tid & 63, wave = __builtin_amdgcn_readfirstlane(tid >> 6);
  const int b = bh >> 2, h = bh & 3;
  LAS unsigned char* lds = (LAS unsigned char*)smem;
  const unsigned short* CHB = (const unsigned short*)(p.ws + OFF_WN) + (size_t)bh * NCH * CHB_ELEMS;
  const float* UU = (const float*)(p.ws + OFF_UU) + (size_t)bh * NCH * 8192;
  const float* DL = (const float*)(p.ws + OFF_DL) + (size_t)bh * NCH;
  float* OD = (float*)(p.ws + OFF_OD);
  constexpr int CHB_BYTES = CHB_ELEMS * 2;
  __syncthreads();
  if (wave >= 4) {
    const int w4 = wave - 4;
    for (int c = c0; c <= c1; ++c) {
      if (c < c1) {
        const char* src = (const char*)(CHB + (size_t)c * CHB_ELEMS) + (size_t)(w4 * 15) * 1024 + lane * 16;
        const unsigned dst = (unsigned)((c & 1) * CHB_BYTES + (w4 * 15) * 1024);
#pragma unroll
        for (int j = 0; j < 15; ++j)
          __builtin_amdgcn_global_load_lds((const unsigned*)(src + j * 1024), (LAS unsigned*)(lds + dst + j * 1024), 16, 0, 0);
      }
      asm volatile("s_waitcnt vmcnt(0)" ::: "memory");
      __builtin_amdgcn_s_barrier();
    }
  } else {
    const int sl = wave, lr = lane & 31, lh = lane >> 5, e0 = sl * 32;
    f32x16 S[4];
    float* sst = (float*)(p.ws + OFF_SST) + ((size_t)(bh * 4 + sl) * 64 + lane) * 64;
#pragma unroll
    for (int i = 0; i < 4; ++i)
#pragma unroll
      for (int q = 0; q < 4; ++q) {
        float4 v = make_float4(0.f, 0.f, 0.f, 0.f);
        if (c0 > 0) v = *(const float4*)(sst + i * 16 + q * 4);
        S[i][4 * q] = v.x; S[i][4 * q + 1] = v.y; S[i][4 * q + 2] = v.z; S[i][4 * q + 3] = v.w;
      }
    f32x16 un[2];
    const float* up0 = UU + (size_t)c0 * 8192 + ((size_t)(sl * 2) * 2 + lh) * 512 + lr * 16;
#pragma unroll
    for (int pt = 0; pt < 2; ++pt)
#pragma unroll
      for (int q = 0; q < 4; ++q) {
        const float4 v = *(const float4*)(up0 + pt * 1024 + q * 4);
        un[pt][4 * q] = v.x; un[pt][4 * q + 1] = v.y; un[pt][4 * q + 2] = v.z; un[pt][4 * q + 3] = v.w;
      }
    const int oA = lr * 132 + 4 * lh;
    const int oB = lr * 68 + 4 * lh;
    __builtin_amdgcn_s_barrier();
    for (int c = c0; c < c1; ++c) {
      const LAS unsigned short* cb = (const LAS unsigned short*)(lds + (c & 1) * CHB_BYTES);
      f32x16 vn[2];
      vn[0] = un[0];
      vn[1] = un[1];
#pragma unroll
      for (int pt = 0; pt < 2; ++pt) {
#pragma unroll
        for (int mt = 0; mt < 4; ++mt)
#pragma unroll
          for (int s2 = 0; s2 < 2; ++s2) {
            const LAS unsigned short* ap = cb + oA + pt * 32 * 132 + mt * 32 + 16 * s2;
            vn[pt] = MFMA32(lds8x2(ap, ap + 8), pack8(S[mt], s2), vn[pt]);
          }
      }
      bf16x8 vb[2][2];
#pragma unroll
      for (int pt = 0; pt < 2; ++pt)
#pragma unroll
        for (int s2 = 0; s2 < 2; ++s2) vb[pt][s2] = pack8(vn[pt], s2);
#pragma unroll
      for (int pt = 0; pt < 2; ++pt) {
        f32x16 o;
#pragma unroll
        for (int r = 0; r < 16; ++r) o[r] = 0.f;
#pragma unroll
        for (int mt = 0; mt < 4; ++mt)
#pragma unroll
          for (int s2 = 0; s2 < 2; ++s2) {
            const LAS unsigned short* ap = cb + CH_QG + oA + pt * 32 * 132 + mt * 32 + 16 * s2;
            o = MFMA32(lds8x2(ap, ap + 8), pack8(S[mt], s2), o);
          }
#pragma unroll
        for (int pt2 = 0; pt2 <= pt; ++pt2)
#pragma unroll
          for (int s2 = 0; s2 < 2; ++s2) {
            const LAS unsigned short* ap = cb + CH_IN + oB + pt * 32 * 68 + pt2 * 32 + 16 * s2;
            o = MFMA32(lds8x2(ap, ap + 8), vb[pt2][s2], o);
          }
#pragma unroll
        for (int r = 0; r < 16; ++r) {
          const int t = c * 64 + pt * 32 + crow(r, lh) - 48;
          if (t >= 0) OD[((size_t)(b * T + t)) * 512 + h * 128 + e0 + lr] = o[r];
        }
      }
      if (c + 1 < c1) {
        const float* up = up0 + (size_t)(c + 1 - c0) * 8192;
#pragma unroll
        for (int pt = 0; pt < 2; ++pt)
#pragma unroll
          for (int q = 0; q < 4; ++q) {
            const float4 v = *(const float4*)(up + pt * 1024 + q * 4);
            un[pt][4 * q] = v.x; un[pt][4 * q + 1] = v.y; un[pt][4 * q + 2] = v.z; un[pt][4 * q + 3] = v.w;
          }
      }
      const float dl = DL[c];
#pragma unroll
      for (int mt = 0; mt < 4; ++mt) {
#pragma unroll
        for (int r = 0; r < 16; ++r) S[mt][r] *= dl;
#pragma unroll
        for (int pt2 = 0; pt2 < 2; ++pt2)
#pragma unroll
          for (int s2 = 0; s2 < 2; ++s2) {
            const LAS unsigned short* ap = cb + CH_KDT + oB + mt * 32 * 68 + pt2 * 32 + 16 * s2;
            S[mt] = MFMA32(lds8x2(ap, ap + 8), vb[pt2][s2], S[mt]);
          }
      }
      asm volatile("s_waitcnt lgkmcnt(0)" ::: "memory");
      __builtin_amdgcn_s_barrier();
    }
    if (c1 < NCH) {
#pragma unroll
      for (int i = 0; i < 4; ++i)
#pragma unroll
        for (int q = 0; q < 4; ++q) *(float4*)(sst + i * 16 + q * 4) = make_float4(S[i][4 * q], S[i][4 * q + 1], S[i][4 * q + 2], S[i][4 * q + 3]);
    }
  }
  __syncthreads();
}
DI void phase_scan_attn(const Params& p, char* smem) {
  attn_worker(p, smem);
}

DI void phase_gnorm(const Params& p) {
  const int tid = otid(p), lane = tid & 63, wave = tid >> 6;
  const float* OD = (const float*)(p.ws + OFF_OD);
  const float* P = (const float*)(p.ws + OFF_P);
  unsigned short* MIX = (unsigned short*)(p.ws + OFF_MIX);
  for (int r = blockIdx.x * NWAVES + wave; r < NR; r += gridDim.x * NWAVES) {
    const int tok = r + 16 * (r / SEQ + 1);
#pragma unroll
    for (int hd = 0; hd < 4; ++hd) {
      float o0 = OD[(size_t)tok * 512 + hd * 128 + lane], o1 = OD[(size_t)tok * 512 + hd * 128 + 64 + lane];
      float ss = wave_sum(o0 * o0 + o1 * o1);
      float rstd = rsqrtf(ss * (1.f / 128.f) + 1e-6f);
      float z0 = P[(size_t)tok * INC + C_BZ + hd * 128 + lane], z1 = P[(size_t)tok * INC + C_BZ + hd * 128 + 64 + lane];
      float y0 = o0 * rstd * p.delta_norm_w[lane] * (z0 / (1.f + __expf(-z0)));
      float y1 = o1 * rstd * p.delta_norm_w[64 + lane] * (z1 / (1.f + __expf(-z1)));
      MIX[(size_t)tok * 1024 + 512 + hd * 128 + lane] = f2bf(y0);
      MIX[(size_t)tok * 1024 + 512 + hd * 128 + 64 + lane] = f2bf(y1);
    }
  }
}

DI void phase_router(const Params& p, char* smem) {
  const int tid = otid(p), lane = tid & 63, wave = tid >> 6;
  float* part = (float*)smem;
  float* rstds = part + 8 * 32 * 33;
  int* lhist = (int*)(rstds + 32);
  int* lbase = lhist + 32;
  const float* H1 = (const float*)(p.ws + OFF_H1);
  const float* wrs = (const float*)(p.ws + OFF_WRS);
  unsigned short* U2 = (unsigned short*)(p.ws + OFF_U2);
  int* TOPE = (int*)(p.ws + OFF_TOPE);
  float* GATEV = (float*)(p.ws + OFF_GATEV);
  int* POS = (int*)(p.ws + OFF_POS);
  int* CNT = (int*)(p.ws + OFF_CNT);
  const int lr = lane & 31, lh = lane >> 5;
  float4 nw[4];
#pragma unroll
  for (int i = 0; i < 4; ++i) nw[i] = *(const float4*)(p.norm_ffn_w + lane * 4 + 256 * i);
  for (int task = blockIdx.x; task < NR / 32; task += gridDim.x) {
    const int r0 = task * 32;
    __syncthreads();
    if (tid < 32) lhist[tid] = 0;
    int lp0 = 0, lp1 = 0, lp2 = 0, lp3 = 0, xe0 = 0, xe1 = 0, xe2 = 0, xe3 = 0;
#pragma unroll
    for (int tt = 0; tt < 4; ++tt) {
      const int r = r0 + wave * 4 + tt;
      const float* src = H1 + (size_t)r * 1024;
      float4 v[4];
      float ss = 0.f;
#pragma unroll
      for (int i = 0; i < 4; ++i) {
        v[i] = *(const float4*)(src + lane * 4 + 256 * i);
        ss += v[i].x * v[i].x + v[i].y * v[i].y + v[i].z * v[i].z + v[i].w * v[i].w;
      }
      ss = wave_sum(ss);
      const float rstd = rsqrtf(ss * (1.f / 1024.f) + 1e-6f);
      if (lane == 0) rstds[wave * 4 + tt] = rstd;
#pragma unroll
      for (int i = 0; i < 4; ++i) {
        uint2 o;
        o.x = pk2(v[i].x * rstd * nw[i].x, v[i].y * rstd * nw[i].y);
        o.y = pk2(v[i].z * rstd * nw[i].z, v[i].w * rstd * nw[i].w);
        *(uint2*)(U2 + (size_t)r * 1024 + lane * 4 + 256 * i) = o;
      }
    }
    f32x16 acc;
#pragma unroll
    for (int i = 0; i < 16; ++i) acc[i] = 0.f;
    const float* arow = H1 + (size_t)(r0 + lr) * 1024 + wave * 128;
    const float* bcol = wrs + (size_t)(wave * 128 + lh) * 32 + lr;
#pragma unroll 8
    for (int k0 = 0; k0 < 128; k0 += 4) {
      const float4 a4 = *(const float4*)(arow + k0);
      const float b0 = bcol[(size_t)k0 * 32], b1 = bcol[(size_t)(k0 + 2) * 32];
      acc = __builtin_amdgcn_mfma_f32_32x32x2f32(lh ? a4.y : a4.x, b0, acc, 0, 0, 0);
      acc = __builtin_amdgcn_mfma_f32_32x32x2f32(lh ? a4.w : a4.z, b1, acc, 0, 0, 0);
    }
#pragma unroll
    for (int r = 0; r < 16; ++r) part[(wave * 32 + crow(r, lh)) * 33 + lr] = acc[r];
    __syncthreads();
    if (tid < 32) {
      const float myrstd = rstds[tid];
      float lv[32];
#pragma unroll
      for (int e = 0; e < 32; ++e) {
        float a = 0.f;
#pragma unroll
        for (int w = 0; w < 8; ++w) a += part[(w * 32 + tid) * 33 + e];
        lv[e] = a * myrstd + p.b_router[e];
      }
      float tv[4];
      int te[4];
#pragma unroll
      for (int k = 0; k < 4; ++k) {
        float bv = lv[0];
        int bi = 0;
#pragma unroll
        for (int e = 1; e < 32; ++e)
          if (lv[e] > bv) { bv = lv[e]; bi = e; }
        tv[k] = bv;
        te[k] = bi;
#pragma unroll
        for (int e = 0; e < 32; ++e)
          if (e == bi) lv[e] = -3.0e38f;
      }
      const float e1 = __expf(tv[1] - tv[0]), e2 = __expf(tv[2] - tv[0]), e3 = __expf(tv[3] - tv[0]);
      const float inv = 1.f / (1.f + e1 + e2 + e3);
      const size_t rr = (size_t)(r0 + tid) * 4;
      TOPE[rr + 0] = te[0]; TOPE[rr + 1] = te[1]; TOPE[rr + 2] = te[2]; TOPE[rr + 3] = te[3];
      GATEV[rr + 0] = inv; GATEV[rr + 1] = e1 * inv; GATEV[rr + 2] = e2 * inv; GATEV[rr + 3] = e3 * inv;
      lp0 = atomicAdd(&lhist[te[0]], 1); lp1 = atomicAdd(&lhist[te[1]], 1); lp2 = atomicAdd(&lhist[te[2]], 1); lp3 = atomicAdd(&lhist[te[3]], 1);
      xe0 = te[0]; xe1 = te[1]; xe2 = te[2]; xe3 = te[3];
    }
    __syncthreads();
    if (tid < 32) {
      const int c = lhist[tid];
      lbase[tid] = (c > 0) ? atomicAdd(&CNT[tid * CNTS], c) : 0;
    }
    __syncthreads();
    if (tid < 32) {
      const size_t rr = (size_t)(r0 + tid) * 4;
      POS[rr + 0] = lbase[xe0] + lp0; POS[rr + 1] = lbase[xe1] + lp1; POS[rr + 2] = lbase[xe2] + lp2; POS[rr + 3] = lbase[xe3] + lp3;
    }
  }
}
DI void phase_lists(const Params& p) {
  const int* CNT = (const int*)(p.ws + OFF_CNT);
  const int* TOPE = (const int*)(p.ws + OFF_TOPE);
  const float* GATEV = (const float*)(p.ws + OFF_GATEV);
  const int* POS = (const int*)(p.ws + OFF_POS);
  int* SLOT = (int*)(p.ws + OFF_SLOT);
  int* LTOK = (int*)(p.ws + OFF_LTOK);
  float* LGATE = (float*)(p.ws + OFF_LGATE);
  for (int a = blockIdx.x * NTHREADS + otid(p); a < NASG; a += gridDim.x * NTHREADS) {
    const int e = TOPE[a];
    int off = 0;
    for (int j = 0; j < e; ++j) off += CNT[j * CNTS];
    const int slot = off + POS[a];
    SLOT[a] = slot;
    LTOK[slot] = a >> 2;
    LGATE[slot] = GATEV[a];
  }
}
DI void phase_combine(const Params& p) {
  const float* H1 = (const float*)(p.ws + OFF_H1);
  const unsigned short* Y = (const unsigned short*)(p.ws + OFF_Y);
  const int* SLOT = (const int*)(p.ws + OFF_SLOT);
  for (int idx = blockIdx.x * NTHREADS + otid(p); idx < NR * 256; idx += gridDim.x * NTHREADS) {
    const int r = idx >> 8, c4 = (idx & 255) * 4;
    float4 a = *(const float4*)(H1 + (size_t)r * 1024 + c4);
#pragma unroll
    for (int k = 0; k < 4; ++k) {
      const int slot = SLOT[r * 4 + k];
      uint2 y = *(const uint2*)(Y + (size_t)slot * 1024 + c4);
      a.x += bf2f((unsigned short)(y.x & 0xffffu));
      a.y += bf2f((unsigned short)(y.x >> 16));
      a.z += bf2f((unsigned short)(y.y & 0xffffu));
      a.w += bf2f((unsigned short)(y.y >> 16));
    }
    *(float4*)(p.out + (size_t)r * 1024 + c4) = a;
  }
}


#define XB_TMO      128
#define XB_XCNT(j)  (256  + 64 * (j))
#define XB_XSUB(j)  (1280 + 64 * (j))
#define XB_XGEN(j)  (2304 + 64 * (j))
#define XB_TOP      3328
#define XB_TOPGEN   3392
#define XB_SPIN_CAP (1u << 22)
DI unsigned xb_ld(unsigned* p) { return __hip_atomic_load(p, __ATOMIC_RELAXED, __HIP_MEMORY_SCOPE_AGENT); }
DI unsigned xb_add(unsigned* p, unsigned v) { return __hip_atomic_fetch_add(p, v, __ATOMIC_RELAXED, __HIP_MEMORY_SCOPE_AGENT); }
DI unsigned xb_xcc_id() { return (unsigned)__builtin_amdgcn_s_getreg((3 << 11) | 20) & 0xFu; }
#define XB_SPIN(cond, bar) do { unsigned _sp = 0; while (cond) { __builtin_amdgcn_s_sleep(1); \
    if ((++_sp & 255u) == 0u) { if (xb_ld(&(bar)[XB_TMO])) break; if (_sp > XB_SPIN_CAP) { atomicAdd(&(bar)[XB_TMO], 1u); break; } } } } while (0)
struct XcdBarrier { unsigned* bar; unsigned x; volatile LAS unsigned* st; bool leader; };
DI void xcd_barrier_complete(unsigned* bar, unsigned x, unsigned& nloc, unsigned& nx) {
  const unsigned G = gridDim.x * gridDim.y * gridDim.z;
  unsigned sum, cnt, mine, sp = 0u;
  for (;;) {
    sum = 0u; cnt = 0u; mine = 0u;
#pragma unroll
    for (unsigned j = 0; j < 16; ++j) { const unsigned c = xb_ld(&bar[XB_XCNT(j)]); sum += c; cnt += (c > 0u) ? 1u : 0u; mine = (j == x) ? c : mine; }
    if (sum == G) break;
    __builtin_amdgcn_s_sleep(1);
    if ((++sp & 255u) == 0u) { if (xb_ld(&bar[XB_TMO])) break; if (sp > XB_SPIN_CAP) { atomicAdd(&bar[XB_TMO], 1u); break; } }
  }
  nloc = mine > 0u ? mine : 1u; nx = cnt > 0u ? cnt : 1u;
}
DI void xcd_barrier(const XcdBarrier& b) {
  asm volatile("s_waitcnt vmcnt(0)" ::: "memory");
  __syncthreads();
  if (b.leader) {
    unsigned* bar = b.bar;
    __builtin_amdgcn_s_waitcnt(0);
    unsigned nloc = b.st[0], nx = b.st[1];
    if (nloc == 0u) { xcd_barrier_complete(bar, b.x, nloc, nx); b.st[0] = nloc; b.st[1] = nx; }
    const unsigned old = xb_add(&bar[XB_XSUB(b.x)], 1u);
    const unsigned gen = old / nloc;
    if (old + 1u == (gen + 1u) * nloc) {
      __builtin_amdgcn_fence(__ATOMIC_RELEASE, "agent");
      asm volatile("s_waitcnt vmcnt(0)" ::: "memory");
      const unsigned og = xb_add(&bar[XB_TOP], 1u);
      const unsigned tg = og / nx;
      if (og + 1u == (tg + 1u) * nx) xb_add(&bar[XB_TOPGEN], 1u);
      else XB_SPIN(xb_ld(&bar[XB_TOPGEN]) == tg, bar);
      __builtin_amdgcn_fence(__ATOMIC_ACQUIRE, "agent");
      xb_add(&bar[XB_XGEN(b.x)], 1u);
      asm volatile("s_waitcnt vmcnt(0)" ::: "memory");
    } else {
      XB_SPIN(xb_ld(&bar[XB_XGEN(b.x)]) == gen, bar);
      __builtin_amdgcn_fence(__ATOMIC_ACQUIRE, "agent");
      asm volatile("s_waitcnt vmcnt(0)" ::: "memory");
    }
  }
  __syncthreads();
}

constexpr int SMEM_BYTES = g8::STAGE_BYTES + 1024;

__global__ void __launch_bounds__(NTHREADS) mk(Params p0) {
  __shared__ __attribute__((aligned(16))) char smem[SMEM_BYTES];
  Params p = p0;
  p.wv = __builtin_amdgcn_readfirstlane((int)(threadIdx.x >> 6));
  XcdBarrier xb;
  {
    volatile LAS unsigned* st = (volatile LAS unsigned*)((LAS unsigned char*)smem + g8::STAGE_BYTES + 768);
    if (threadIdx.x == 0) { st[0] = 0u; st[1] = 0u; }
    __syncthreads();
    xb.bar = (unsigned*)(p.ws + OFF_BAR); xb.x = xb_xcc_id(); xb.st = st; xb.leader = (threadIdx.x == 0);
    if (xb.leader) (void)xb_add(&xb.bar[XB_XCNT(xb.x)], 1u);
  }
  phase_prep(p);
  phase_wconv(p, 0, WC_SMALL);
  xcd_barrier(xb);
  g8::gemm_phase<0>(p, smem);
  wconv_fill(p, smem, 0, false);
  xcd_barrier(xb);
  phase_post1(p, smem);
  xcd_barrier(xb);
  g8::gemm_phase<1>(p, smem);
  phase_chunkprep(p, smem);
  wconv_fill(p, smem, 1, false);
  xcd_barrier(xb);
  if (blockIdx.x < 16) scan_block(p, smem, blockIdx.x, 0, NCH);
  phase_post2(p, smem);
  phase_indexer(p, smem);
  wconv_fill(p, smem, 2, false);
  xcd_barrier(xb);
  phase_gnorm(p);
  phase_scan_attn(p, smem);
  wconv_fill(p, smem, 3, false);
  xcd_barrier(xb);
  g8::gemm_phase<2>(p, smem);
  xcd_barrier(xb);
  phase_router(p, smem);
  xcd_barrier(xb);
  phase_lists(p);
  wconv_fill(p, smem, 4, true);
  xcd_barrier(xb);
  g8::gemm_phase<3>(p, smem);
  xcd_barrier(xb);
  g8::gemm_phase<4>(p, smem);
  xcd_barrier(xb);
  phase_combine(p);
}

extern "C" void kernel_launch(void* const* d_in, const int* in_sizes, int n_in, void* d_out, int out_size, void* d_ws,
                              size_t ws_size, hipStream_t stream) {
  (void)in_sizes; (void)n_in; (void)out_size;
  if (ws_size < WS_NEED) return;
  Params p{};
  p.x = (const float*)d_in[0]; p.meta = (const float*)d_in[1]; p.norm_mix_w = (const float*)d_in[2];
  p.w_in = (const float*)d_in[3]; p.q_norm_w = (const float*)d_in[4]; p.k_norm_w = (const float*)d_in[5];
  p.kv_norm_w = (const float*)d_in[6]; p.w_kv_up = (const float*)d_in[7]; p.conv_w = (const float*)d_in[8];
  p.a_log = (const float*)d_in[9]; p.dt_bias = (const float*)d_in[10]; p.delta_norm_w = (const float*)d_in[11];
  p.w_out = (const float*)d_in[12]; p.norm_ffn_w = (const float*)d_in[13]; p.w_router = (const float*)d_in[14];
  p.b_router = (const float*)d_in[15]; p.w_gate_up = (const float*)d_in[16]; p.b_gate_up = (const float*)d_in[17];
  p.w_down = (const float*)d_in[18]; p.b_down = (const float*)d_in[19];
  p.out = (float*)d_out;
  p.ws = (char*)d_ws;
  (void)hipMemsetAsync((char*)d_ws + OFF_CNT, 0, 4096, stream);
  (void)hipMemsetAsync((char*)d_ws + OFF_BAR, 0, 16384, stream);
  static int grid_blocks = 0;
  if (!grid_blocks) {
    int dev = 0, cus = 0, per_cu = 0;
    (void)hipGetDevice(&dev);
    (void)hipDeviceGetAttribute(&cus, hipDeviceAttributeMultiprocessorCount, dev);
    (void)hipOccupancyMaxActiveBlocksPerMultiprocessor(&per_cu, mk, NTHREADS, 0);
    if (per_cu > 1) per_cu = 1;
    grid_blocks = cus * per_cu;
  }
  void* args[] = {&p};
  hipError_t e = hipLaunchCooperativeKernel((void*)mk, dim3(grid_blocks), dim3(NTHREADS), args, 0, stream);
  if (e != hipSuccess) fprintf(stderr, "cooperative launch failed: %s (grid %d)\n", hipGetErrorString(e), grid_blocks);
}
```

```cpp
#include <hip/hip_runtime.h>
#include <stdint.h>
#include <stdio.h>


typedef __attribute__((ext_vector_type(8))) short bf16x8;
typedef __attribute__((ext_vector_type(4))) short s16x4;
typedef __attribute__((ext_vector_type(16))) float f32x16;
typedef __attribute__((ext_vector_type(4))) float f32x4;
typedef __bf16 bf2_t __attribute__((ext_vector_type(2)));
#define DI __device__ __forceinline__
#define MFMA32(a, b, c) __builtin_amdgcn_mfma_f32_32x32x16_bf16((a), (b), (c), 0, 0, 0)
#define MFMA16(a, b, c) __builtin_amdgcn_mfma_f32_16x16x32_bf16((a), (b), (c), 0, 0, 0)

constexpr int NB = 4, SEQ = 4096, NM = 16, T = 4112, NT = NB * T, NR = NB * SEQ, D = 1024, INC = 3408;
constexpr int C_AQ = 0, C_CKV = 512, C_IQ = 768, C_IK = 1280, C_IW = 1344, C_BQKV = 1352, C_BZ = 2888, C_BBETA = 3400, C_BA = 3404;
constexpr int NCH = 65, NCHT = NB * 4 * NCH;
constexpr int NEXP = 32, NASG = NR * 4;
constexpr int CNTS = 32;
constexpr int NTHREADS = 512, NWAVES = 8;

constexpr size_t al256(size_t x) { return (x + 255) & ~(size_t)255; }
constexpr size_t OFF_U = 0;
constexpr int NTP = 16640;
constexpr size_t OFF_P = OFF_U + al256((size_t)NTP * 1024 * 2);
constexpr size_t OFF_ROPE = OFF_P + al256((size_t)NT * INC * 4);
constexpr size_t OFF_QB = OFF_ROPE + al256((size_t)T * 64 * 4);
constexpr size_t OFF_KB = OFF_QB + al256((size_t)NT * 512 * 2);
constexpr size_t OFF_VT = OFF_KB + al256((size_t)NT * 512 * 2);
constexpr size_t OFF_QI = OFF_VT + al256((size_t)NT * 512 * 2);
constexpr size_t OFF_KI = OFF_QI + al256((size_t)NT * 512 * 2);
constexpr size_t OFF_WI = OFF_KI + al256((size_t)NT * 64 * 2);
constexpr size_t OFF_CKV = OFF_WI + al256((size_t)NT * 8 * 4);
constexpr size_t OFF_KV = OFF_CKV + al256((size_t)NTP * 256 * 2);
constexpr size_t OFF_MASK = OFF_KV + al256((size_t)NT * 1024 * 4);
constexpr size_t OFF_MIX = OFF_MASK + al256((size_t)NB * SEQ * 128 * 4);
constexpr size_t OFF_QD = OFF_MIX + al256((size_t)NT * 1024 * 2);
constexpr size_t OFF_KD = OFF_QD + al256((size_t)NT * 512 * 4);
constexpr size_t OFF_VD = OFF_KD + al256((size_t)NT * 512 * 4);
constexpr size_t OFF_BETA = OFF_VD + al256((size_t)NT * 512 * 4);
constexpr size_t OFF_G = OFF_BETA + al256((size_t)NT * 4 * 4);
constexpr int CHB_ELEMS = 30720, CH_QG = 8448, CH_KDT = 16896, CH_IN = 25600;
constexpr size_t OFF_WN = OFF_G + al256((size_t)NT * 4 * 4);
constexpr size_t OFF_UU = OFF_WN + al256((size_t)NCHT * CHB_ELEMS * 2);
constexpr size_t OFF_DL = OFF_UU + al256((size_t)NCHT * 64 * 128 * 4);
constexpr size_t OFF_OD = OFF_DL + al256((size_t)NCHT * 4);
constexpr size_t OFF_U2 = OFF_OD + al256((size_t)NT * 512 * 4);
constexpr size_t OFF_TOPE = OFF_U2 + al256((size_t)NR * 1024 * 2);
constexpr size_t OFF_GATEV = OFF_TOPE + al256((size_t)NR * 4 * 4);
constexpr size_t OFF_POS = OFF_GATEV + al256((size_t)NR * 4 * 4);
constexpr size_t OFF_SLOT = OFF_POS + al256((size_t)NR * 4 * 4);
constexpr size_t OFF_LTOK = OFF_SLOT + al256((size_t)NR * 4 * 4);
constexpr size_t OFF_LGATE = OFF_LTOK + al256((size_t)NASG * 4);
constexpr size_t OFF_WTIN = OFF_LGATE + al256((size_t)NASG * 4);
constexpr size_t OFF_WTKV = OFF_WTIN + al256((size_t)3584 * 1024 * 2);
constexpr size_t OFF_WTOUT = OFF_WTKV + al256((size_t)1024 * 256 * 2);
constexpr size_t OFF_WTGU = OFF_WTOUT + al256((size_t)1024 * 1024 * 2);
constexpr size_t OFF_WTDN = OFF_WTGU + al256((size_t)32 * 2048 * 1024 * 2);
constexpr size_t OFF_CNT = OFF_WTDN + al256((size_t)32 * 1024 * 1024 * 2);
constexpr size_t OFF_Y = OFF_QD;
static_assert(OFF_U2 - OFF_QD >= (size_t)NASG * 1024 * 2, "Y alias does not fit");
static_assert((size_t)(NASG + 256) * 1024 * 2 <= (size_t)NT * INC * 4, "HD alias does not fit");
constexpr size_t OFF_WRS = OFF_CNT + 4096;
constexpr size_t OFF_SST = OFF_WRS + 131072;
constexpr size_t OFF_BAR = OFF_SST + (size_t)16 * 4 * 64 * 64 * 4;
constexpr size_t WS_NEED = OFF_BAR + 16384;
constexpr size_t OFF_H1 = OFF_KV;
constexpr size_t OFF_HD = OFF_P;

struct Params {
  const float *x, *meta, *norm_mix_w, *w_in, *q_norm_w, *k_norm_w, *kv_norm_w, *w_kv_up, *conv_w, *a_log, *dt_bias,
      *delta_norm_w, *w_out, *norm_ffn_w, *w_router, *b_router, *w_gate_up, *b_gate_up, *w_down, *b_down;
  float* out;
  char* ws;
  int wv;
  int pad0;
};

#define LAS __attribute__((address_space(3)))
constexpr int STAGE_LDS_BYTES = 131072;
DI unsigned pk2(float a, float b) { bf2_t v; v[0] = (__bf16)a; v[1] = (__bf16)b; return __builtin_bit_cast(unsigned, v); }
DI unsigned short f2bf(float a) { return (unsigned short)(pk2(a, 0.f) & 0xffffu); }
DI float bf2f(unsigned short u) { return __uint_as_float(((unsigned)u) << 16); }
template <int CTRL> DI float dppf(float v) { return __builtin_bit_cast(float, __builtin_amdgcn_update_dpp(0, __builtin_bit_cast(int, v), CTRL, 0xf, 0xf, false)); }
template <int CTRL> DI int dppi(int v) { return __builtin_amdgcn_update_dpp(0, v, CTRL, 0xf, 0xf, false); }
DI float rlf(float v, int l) { return __builtin_bit_cast(float, __builtin_amdgcn_readlane(__builtin_bit_cast(int, v), l)); }
DI float wave_sum(float v) {
  v += dppf<0xB1>(v); v += dppf<0x4E>(v); v += dppf<0x141>(v); v += dppf<0x140>(v);
  return (rlf(v, 0) + rlf(v, 16)) + (rlf(v, 32) + rlf(v, 48));
}
DI float xor32f(float v, int lane) {
  auto r = __builtin_amdgcn_permlane32_swap(__builtin_bit_cast(unsigned, v), __builtin_bit_cast(unsigned, v), false, false);
  return __builtin_bit_cast(float, (lane < 32) ? r[1] : r[0]);
}
DI float xor16f(float v, int lane) {
  auto r = __builtin_amdgcn_permlane16_swap(__builtin_bit_cast(unsigned, v), __builtin_bit_cast(unsigned, v), false, false);
  return __builtin_bit_cast(float, (lane & 16) ? r[0] : r[1]);
}
DI int otid(const Params& p) {
  int l;
  asm volatile("v_mbcnt_lo_u32_b32 %0, -1, 0\n\tv_mbcnt_hi_u32_b32 %0, -1, %0" : "=v"(l));
  return (p.wv << 6) | l;
}
DI int swzA(int row, int col) { return row * 132 + col; }
DI int swzB(int row, int col) { return row * 68 + col; }
DI int crow(int reg, int h) { return (reg & 3) + 8 * (reg >> 2) + 4 * h; }
DI bf16x8 pack8(const f32x16& x, int s) {
  uint4 p;
  p.x = pk2(x[8 * s + 0], x[8 * s + 1]); p.y = pk2(x[8 * s + 2], x[8 * s + 3]);
  p.z = pk2(x[8 * s + 4], x[8 * s + 5]); p.w = pk2(x[8 * s + 6], x[8 * s + 7]);
  return __builtin_bit_cast(bf16x8, p);
}
DI bf16x8 ld8x2(const unsigned short* p0, const unsigned short* p1) {
  uint2 a = *(const uint2*)p0, b = *(const uint2*)p1;
  uint4 r = make_uint4(a.x, a.y, b.x, b.y);
  return __builtin_bit_cast(bf16x8, r);
}
DI bf16x8 ld16(const unsigned short* p) { uint4 r = *(const uint4*)p; return __builtin_bit_cast(bf16x8, r); }
DI const float* hrow(const Params& p, int tok) {
  int b = tok / T, t = tok - b * T;
  return (t < NM) ? (p.meta + (size_t)t * D) : (p.x + ((size_t)b * SEQ + (t - NM)) * D);
}

DI void phase_prep(const Params& p) {
  const int tid = otid(p), lane = tid & 63, wave = tid >> 6;
  float* rope = (float*)(p.ws + OFF_ROPE);
  for (int idx = blockIdx.x * NTHREADS + tid; idx < T * 32; idx += gridDim.x * NTHREADS) {
    int t = idx >> 5, i = idx & 31;
    float inv = (float)pow(10000.0, -(double)i / 32.0);
    float ang = (float)t * inv;
    double ad = (double)ang;
    double n = rint(ad * 0.15915494309189535);
    float r = (float)(ad - n * 6.283185307179586);
    float sn, cs;
    sincosf(r, &sn, &cs);
    rope[t * 64 + i] = cs;
    rope[t * 64 + 32 + i] = sn;
  }
  float* wrs = (float*)(p.ws + OFF_WRS);
  for (int idx = blockIdx.x * NTHREADS + tid; idx < 1024 * 32; idx += gridDim.x * NTHREADS) wrs[idx] = p.norm_ffn_w[idx >> 5] * p.w_router[idx];
  unsigned short* U = (unsigned short*)(p.ws + OFF_U);
  for (int tok = blockIdx.x * NWAVES + wave; tok < NT; tok += gridDim.x * NWAVES) {
    const float* src = hrow(p, tok);
    float4 v[4];
    float ss = 0.f;
#pragma unroll
    for (int i = 0; i < 4; ++i) {
      v[i] = *(const float4*)(src + lane * 4 + 256 * i);
      ss += v[i].x * v[i].x + v[i].y * v[i].y + v[i].z * v[i].z + v[i].w * v[i].w;
    }
    ss = wave_sum(ss);
    float rstd = rsqrtf(ss * (1.f / 1024.f) + 1e-6f);
#pragma unroll
    for (int i = 0; i < 4; ++i) {
      float4 w = *(const float4*)(p.norm_mix_w + lane * 4 + 256 * i);
      uint2 o;
      o.x = pk2(v[i].x * rstd * w.x, v[i].y * rstd * w.y);
      o.y = pk2(v[i].z * rstd * w.z, v[i].w * rstd * w.w);
      *(uint2*)(U + (size_t)tok * 1024 + lane * 4 + 256 * i) = o;
    }
  }
}

DI void wconv_task2(const float* src, unsigned short* dst, int K, int N, int k0, int n0, int tid) {
  const int kg = tid >> 6, n = n0 + (tid & 63) * 4, k = k0 + kg * 8;
  float4 v[8];
#pragma unroll
  for (int i = 0; i < 8; ++i) {
    v[i] = make_float4(0.f, 0.f, 0.f, 0.f);
    if (n < N) v[i] = *(const float4*)(src + (size_t)(k + i) * N + n);
  }
  uint4 o;
  o.x = pk2(v[0].x, v[1].x); o.y = pk2(v[2].x, v[3].x); o.z = pk2(v[4].x, v[5].x); o.w = pk2(v[6].x, v[7].x);
  *(uint4*)(dst + (size_t)(n + 0) * K + k) = o;
  o.x = pk2(v[0].y, v[1].y); o.y = pk2(v[2].y, v[3].y); o.z = pk2(v[4].y, v[5].y); o.w = pk2(v[6].y, v[7].y);
  *(uint4*)(dst + (size_t)(n + 1) * K + k) = o;
  o.x = pk2(v[0].z, v[1].z); o.y = pk2(v[2].z, v[3].z); o.z = pk2(v[4].z, v[5].z); o.w = pk2(v[6].z, v[7].z);
  *(uint4*)(dst + (size_t)(n + 2) * K + k) = o;
  o.x = pk2(v[0].w, v[1].w); o.y = pk2(v[2].w, v[3].w); o.z = pk2(v[4].w, v[5].w); o.w = pk2(v[6].w, v[7].w);
  *(uint4*)(dst + (size_t)(n + 3) * K + k) = o;
}
constexpr int WC_IN = 16 * 14, WC_KV = 4 * 4, WC_OUT = 16 * 4, WC_GU = 32 * 128, WC_DN = 32 * 64;
constexpr int WC_SMALL = WC_IN + WC_KV + WC_OUT, WC_ALL = WC_SMALL + WC_GU + WC_DN;
DI void wconv_task(const Params& p, int t, int tid) {
  if (t < WC_IN) {
    wconv_task2(p.w_in, (unsigned short*)(p.ws + OFF_WTIN), 1024, INC, (t / 14) * 64, (t % 14) * 256, tid);
  } else if (t < WC_IN + WC_KV) {
    t -= WC_IN;
    wconv_task2(p.w_kv_up, (unsigned short*)(p.ws + OFF_WTKV), 256, 1024, (t >> 2) * 64, (t & 3) * 256, tid);
  } else if (t < WC_SMALL) {
    t -= WC_IN + WC_KV;
    wconv_task2(p.w_out, (unsigned short*)(p.ws + OFF_WTOUT), 1024, 1024, (t >> 2) * 64, (t & 3) * 256, tid);
  } else if (t < WC_SMALL + WC_GU) {
    t -= WC_SMALL;
    const int e = t >> 7, r = t & 127;
    wconv_task2(p.w_gate_up + (size_t)e * 1024 * 2048, (unsigned short*)(p.ws + OFF_WTGU) + (size_t)e * 2048 * 1024, 1024, 2048,
                (r >> 3) * 64, (r & 7) * 256, tid);
  } else {
    t -= WC_SMALL + WC_GU;
    const int e = t >> 6, r = t & 63;
    wconv_task2(p.w_down + (size_t)e * 1024 * 1024, (unsigned short*)(p.ws + OFF_WTDN) + (size_t)e * 1024 * 1024, 1024, 1024,
                (r >> 2) * 64, (r & 3) * 256, tid);
  }
}
DI void wconv_fill(const Params& p, char* smem, int site, bool drain) {
  unsigned* q = (unsigned*)(p.ws + OFF_BAR + 15872 + 128);
  volatile LAS int* slot = (volatile LAS int*)((LAS unsigned char*)smem + STAGE_LDS_BYTES + 832);
  const int tid = otid(p);
  __syncthreads();
  if (tid == 0 && !drain) (void)__hip_atomic_fetch_add(&q[16 + site], 1u, __ATOMIC_RELAXED, __HIP_MEMORY_SCOPE_AGENT);
  for (;;) {
    __syncthreads();
    if (tid == 0) {
      int t = -1;
      const bool all_done = !drain && __hip_atomic_load(&q[16 + site], __ATOMIC_RELAXED, __HIP_MEMORY_SCOPE_AGENT) >= gridDim.x;
      if (!all_done) t = WC_SMALL + (int)__hip_atomic_fetch_add(&q[0], 1u, __ATOMIC_RELAXED, __HIP_MEMORY_SCOPE_AGENT);
      *slot = t;
    }
    __syncthreads();
    const int t = __builtin_amdgcn_readfirstlane(*slot);
    if (t < 0 || t >= WC_ALL) break;
    wconv_task(p, t, tid);
  }
}
DI void phase_wconv(const Params& p, int t0, int t1) {
  const int tid = otid(p);
  for (int t = t0 + blockIdx.x; t < t1; t += gridDim.x) wconv_task(p, t, tid);
}

namespace g8 {
constexpr int BM = 256, BK = 64, HALF = 128, HTB = HALF * BK * 2, STAGE_BYTES = 8 * HTB, NXCD = 8, WGM = 8;
constexpr int TAB_OFF = STAGE_BYTES;
constexpr int MAXU = 24;
DI int lds_byte(int r, int c) { const int st = (r >> 4) * 2 + (c >> 5), rr = r & 15, cc = c & 31, ob = rr * 64 + cc * 2; return st * 1024 + (ob ^ (((ob >> 9) & 1) << 5)); }
DI void stage_rc(int b, int& R, int& C) { const int st = b / 1024, sb = b % 1024, swz = sb ^ (((sb >> 9) & 1) << 5); R = (st >> 1) * 16 + swz / 64; C = (st & 1) * 32 + (swz % 64) / 2; }
DI int perm32(int rho) { const int n = rho >> 4, i = rho & 15; return 8 * (i >> 2) + 4 * n + (i & 3); }
DI int xcd_remap(int L, int nwg) { const int q = nwg / NXCD, r = nwg % NXCD, xcd = L % NXCD, off = L / NXCD; return (xcd < r ? xcd * (q + 1) : r * (q + 1) + (xcd - r) * q) + off; }
struct UnitT { int valid, arow, mend, pn, e, orow; };

template <int MODE> DI int n_units(const Params& p) {
  if (MODE == 0) return 65 * 14;
  if (MODE == 1) return 65 * 4;
  if (MODE == 2) return 64 * 4;
  const int* cnt = (const int*)(p.ws + OFF_CNT);
  int n = 0;
  for (int e = 0; e < NEXP; ++e) n += ((cnt[e * CNTS] + 255) >> 8) * (MODE == 3 ? 8 : 4);
  return n;
}
template <int MODE> DI void unit_of(const Params& p, int L, int nwg, UnitT& u) {
  u.valid = 0; u.arow = 0; u.mend = 0; u.pn = 0; u.e = 0; u.orow = 0;
  if (L >= nwg) return;
  const int wgid = xcd_remap(L, nwg);
  u.valid = 1;
  if (MODE <= 2) {
    const int nM = (MODE == 2) ? 64 : 65, nN = (MODE == 0) ? 14 : 4;
    const int nig = WGM * nN, gid = wgid / nig, fm = gid * WGM, gsz = (nM - fm) < WGM ? (nM - fm) : WGM;
    const int pm = fm + ((wgid % nig) % gsz);
    u.pn = (wgid % nig) / gsz;
    u.orow = pm * 256;
    u.arow = (MODE == 2) ? (pm * 256 + 16 * (pm / 16 + 1)) : pm * 256;
    u.mend = (MODE == 2) ? NR : NT;
  } else {
    const int* cnt = (const int*)(p.ws + OFF_CNT);
    constexpr int NTN = (MODE == 3) ? 8 : 4;
    int id = wgid, sbase = 0;
    for (int e = 0; e < NEXP; ++e) {
      const int c = cnt[e * CNTS], mts = (c + 255) >> 8, ne = mts * NTN;
      if (id < ne) {
        const int tn = id / mts, tm = id - tn * mts;
        u.e = e; u.pn = tn; u.arow = sbase + tm * 256; u.orow = u.arow; u.mend = sbase + c;
        return;
      }
      id -= ne;
      sbase += c;
    }
    u.valid = 0;
  }
}
DI float swiglu(float g, float u) {
  g = fminf(g, 7.0f);
  u = fminf(fmaxf(u, -7.0f), 7.0f);
  return g / (1.f + __expf(-1.702f * g)) * (u + 1.f);
}
template <int MODE>
DI void epilogue(const Params& p, const f32x4 (&acc)[2][2][4][2], const UnitT& u, int wr, int wc, int fr, int fq) {
  constexpr bool PERM = (MODE >= 3);
  const int row0 = u.orow + wr * 64 + fr;
  const int col0 = u.pn * 256 + wc * 32 + (PERM ? 8 * fq : 4 * fq);
  if (MODE == 0 || MODE == 1 || MODE == 2) {
    float* C = (float*)(p.ws + (MODE == 0 ? OFF_P : MODE == 1 ? OFF_KV : OFF_H1));
    const int ldc = (MODE == 0) ? INC : 1024;
#pragma unroll
    for (int ai = 0; ai < 2; ++ai)
#pragma unroll
      for (int m = 0; m < 4; ++m) {
        const int row = row0 + ai * 128 + m * 16;
        if (row < u.mend) {
#pragma unroll
          for (int bj = 0; bj < 2; ++bj)
#pragma unroll
            for (int n = 0; n < 2; ++n) {
              const int col = col0 + bj * 128 + n * 16;
              if (MODE != 0 || col < INC) {
                f32x4 v = acc[ai][bj][m][n];
                if (MODE == 2) v += *(const f32x4*)(p.x + (size_t)row * D + col);
                *(f32x4*)(C + (size_t)row * ldc + col) = v;
              }
            }
        }
      }
  } else if (MODE == 3) {
    unsigned short* HD = (unsigned short*)(p.ws + OFF_HD);
    f32x4 bv[2][2];
#pragma unroll
    for (int bj = 0; bj < 2; ++bj)
#pragma unroll
      for (int n = 0; n < 2; ++n) bv[bj][n] = *(const f32x4*)(p.b_gate_up + (size_t)u.e * 2048 + col0 + bj * 128 + 4 * n);
#pragma unroll
    for (int ai = 0; ai < 2; ++ai)
#pragma unroll
      for (int m = 0; m < 4; ++m) {
        const int row = row0 + ai * 128 + m * 16;
        if (row < u.mend) {
#pragma unroll
          for (int bj = 0; bj < 2; ++bj) {
            const f32x4 v0 = acc[ai][bj][m][0] + bv[bj][0], v1 = acc[ai][bj][m][1] + bv[bj][1];
            uint2 o;
            o.x = pk2(swiglu(v0[0], v0[1]), swiglu(v0[2], v0[3]));
            o.y = pk2(swiglu(v1[0], v1[1]), swiglu(v1[2], v1[3]));
            *(uint2*)(HD + (size_t)row * 1024 + (col0 + bj * 128) / 2) = o;
          }
        }
      }
  } else {
    unsigned short* Y = (unsigned short*)(p.ws + OFF_Y);
    const float* lgate = (const float*)(p.ws + OFF_LGATE);
    f32x4 bv[2][2];
#pragma unroll
    for (int bj = 0; bj < 2; ++bj)
#pragma unroll
      for (int n = 0; n < 2; ++n) bv[bj][n] = *(const f32x4*)(p.b_down + (size_t)u.e * 1024 + col0 + bj * 128 + 4 * n);
#pragma unroll
    for (int ai = 0; ai < 2; ++ai)
#pragma unroll
      for (int m = 0; m < 4; ++m) {
        const int row = row0 + ai * 128 + m * 16;
        if (row < u.mend) {
          const float gt = lgate[row];
#pragma unroll
          for (int bj = 0; bj < 2; ++bj) {
            const f32x4 v0 = (acc[ai][bj][m][0] + bv[bj][0]) * gt, v1 = (acc[ai][bj][m][1] + bv[bj][1]) * gt;
            uint4 o;
            o.x = pk2(v0[0], v0[1]); o.y = pk2(v0[2], v0[3]); o.z = pk2(v1[0], v1[1]); o.w = pk2(v1[2], v1[3]);
            *(uint4*)(Y + (size_t)row * 1024 + col0 + bj * 128) = o;
          }
        }
      }
  }
}

template <int MODE>
DI void gemm_phase(const Params& p, char* smem) {
  constexpr bool PERM = (MODE >= 3);
  constexpr int K = (MODE == 1) ? 256 : 1024, nt = K / BK;
  LAS unsigned char* lds = (LAS unsigned char*)smem;
  LAS int* tab = (LAS int*)(lds + TAB_OFF);
  const int tid = otid(p), wid = __builtin_amdgcn_readfirstlane(tid >> 6), lane = tid & 63, wr = wid >> 2, wc = wid & 3, fr = lane & 15, fq = lane >> 4;
  __syncthreads();
  {
    const int nwg = n_units<MODE>(p);
    for (int ti = 0; ti < MAXU; ++ti) {
      UnitT u;
      unit_of<MODE>(p, ti * (int)gridDim.x + (int)blockIdx.x, nwg, u);
      if (tid == 0) { tab[ti * 8 + 0] = u.valid; tab[ti * 8 + 1] = u.arow; tab[ti * 8 + 2] = u.mend; tab[ti * 8 + 3] = u.pn; tab[ti * 8 + 4] = u.e; tab[ti * 8 + 5] = u.orow; }
    }
  }
  __syncthreads();
#define G8_GETU(i, u) do { const int _i = (i); (u).valid = (_i < MAXU) ? __builtin_amdgcn_readfirstlane(tab[_i * 8 + 0]) : 0; (u).arow = __builtin_amdgcn_readfirstlane(tab[(_i < MAXU ? _i : 0) * 8 + 1]); \
    (u).mend = __builtin_amdgcn_readfirstlane(tab[(_i < MAXU ? _i : 0) * 8 + 2]); (u).pn = __builtin_amdgcn_readfirstlane(tab[(_i < MAXU ? _i : 0) * 8 + 3]); \
    (u).e = __builtin_amdgcn_readfirstlane(tab[(_i < MAXU ? _i : 0) * 8 + 4]); (u).orow = __builtin_amdgcn_readfirstlane(tab[(_i < MAXU ? _i : 0) * 8 + 5]); } while (0)
  UnitT cur, nxt;
  G8_GETU(0, cur);
  if (!cur.valid) return;
  const char* Abase = (const char*)(p.ws + (MODE == 0 ? OFF_U : MODE == 1 ? OFF_CKV : MODE == 2 ? OFF_MIX : MODE == 3 ? OFF_U2 : OFF_HD));
  const char* Bbase = (const char*)(p.ws + (MODE == 0 ? OFF_WTIN : MODE == 1 ? OFF_WTKV : MODE == 2 ? OFF_WTOUT : MODE == 3 ? OFF_WTGU : OFF_WTDN));
  constexpr size_t BEXP = (MODE == 3) ? (size_t)2048 * 1024 * 2 : (MODE == 4) ? (size_t)1024 * 1024 * 2 : 0;
  int Rr[2], Cc[2];
  unsigned voffB[2];
#pragma unroll
  for (int i = 0; i < 2; ++i) {
    stage_rc(tid * 16 + i * 8192, Rr[i], Cc[i]);
    const int Rb = PERM ? ((Rr[i] & ~31) + perm32(Rr[i] & 31)) : Rr[i];
    voffB[i] = (unsigned)(Rb * K + Cc[i]) * 2u;
  }
  unsigned voffA[2][2];
  const int* ltok = (const int*)(p.ws + OFF_LTOK);
#define G8_VOFFA(dst, un) do { _Pragma("unroll") for (int _h = 0; _h < 2; ++_h) _Pragma("unroll") for (int _i = 0; _i < 2; ++_i) { \
      if (MODE == 3) { int _s = (un).arow + _h * 128 + Rr[_i]; _s = _s < NASG ? _s : NASG - 1; dst[_h][_i] = (unsigned)(ltok[_s] * K + Cc[_i]) * 2u; } \
      else dst[_h][_i] = (unsigned)((_h * 128 + Rr[_i]) * K + Cc[_i]) * 2u; } } while (0)
  const size_t kstep = (size_t)(BK * 2);
  const size_t hstep = (size_t)HALF * K * 2;
  const size_t tstep = 2 * hstep;
  const unsigned ldsw = (unsigned)wid * 1024u;
  const int aoff = lds_byte(wr * 64 + fr, fq * 8), boff = lds_byte(wc * 32 + fr, fq * 8);
#define G8_SA(b, h) (((b) * 2 + (h)) * HTB)
#define G8_SB(b, h) ((4 + (b) * 2 + (h)) * HTB)
#define G8_STAGE(bufoff, gbase, voff) do { _Pragma("unroll") for (int _i = 0; _i < 2; ++_i) \
    __builtin_amdgcn_global_load_lds((const unsigned*)((const char*)(gbase) + (voff)[_i]), (LAS unsigned*)(lds + (bufoff) + ldsw + _i * 8192), 16, 0, 0); } while (0)
#define G8_LDA(dst, b, h) do { _Pragma("unroll") for (int m = 0; m < 4; ++m) _Pragma("unroll") for (int k = 0; k < 2; ++k) dst[m][k] = *(const LAS bf16x8*)(lds + G8_SA(b, h) + aoff + m * 2048 + k * 1024); } while (0)
#define G8_LDB(dst, b, h) do { _Pragma("unroll") for (int n = 0; n < 2; ++n) _Pragma("unroll") for (int k = 0; k < 2; ++k) dst[n][k] = *(const LAS bf16x8*)(lds + G8_SB(b, h) + boff + n * 2048 + k * 1024); } while (0)
#define G8_MMA(ai, bj, At, Bt) do { __builtin_amdgcn_s_setprio(1); _Pragma("unroll") for (int m = 0; m < 4; ++m) _Pragma("unroll") for (int n = 0; n < 2; ++n) _Pragma("unroll") for (int k = 0; k < 2; ++k) \
    acc[ai][bj][m][n] = __builtin_amdgcn_mfma_f32_16x16x32_bf16(Bt[n][k], At[m][k], acc[ai][bj][m][n], 0, 0, 0); __builtin_amdgcn_s_setprio(0); } while (0)
#define G8_WAIT_V(n) asm volatile("s_waitcnt vmcnt(" #n ")" ::: "memory")
#define G8_WAIT_L(n) asm volatile("s_waitcnt lgkmcnt(" #n ")" ::: "memory")
#define G8_BAR __builtin_amdgcn_s_barrier()
#define G8_SCHED __builtin_amdgcn_sched_barrier(0)
  int ui = 0;
  f32x4 acc[2][2][4][2];
#pragma unroll
  for (int a = 0; a < 2; ++a)
#pragma unroll
    for (int b = 0; b < 2; ++b)
#pragma unroll
      for (int m = 0; m < 4; ++m)
#pragma unroll
        for (int n = 0; n < 2; ++n) acc[a][b][m][n] = (f32x4){0.f, 0.f, 0.f, 0.f};
  bf16x8 At[4][2], B0[2][2], B1[2][2];
  G8_VOFFA(voffA, cur);
  if (MODE == 3) asm volatile("s_waitcnt vmcnt(0)" ::: "memory");
  const char* cA = (MODE == 3) ? Abase : Abase + (size_t)cur.arow * K * 2;
  const char* cB = Bbase + (size_t)cur.e * BEXP + (size_t)cur.pn * tstep;
  G8_STAGE(G8_SB(0, 0), cB, voffB); G8_STAGE(G8_SA(0, 0), cA, voffA[0]); G8_STAGE(G8_SB(0, 1), cB + hstep, voffB); G8_STAGE(G8_SA(0, 1), cA, voffA[1]);
  if (wr == 1) G8_BAR;
  G8_WAIT_V(4); G8_BAR;
  G8_STAGE(G8_SB(1, 0), cB + kstep, voffB); G8_STAGE(G8_SA(1, 0), cA + kstep, voffA[0]); G8_STAGE(G8_SB(1, 1), cB + hstep + kstep, voffB);
  G8_WAIT_V(6); G8_BAR;
  for (;;) {
    G8_GETU(ui + 1, nxt);
    const bool has_next = nxt.valid != 0;
    const char* nA = has_next ? ((MODE == 3) ? Abase : Abase + (size_t)nxt.arow * K * 2) : cA;
    const char* nB = has_next ? Bbase + (size_t)nxt.e * BEXP + (size_t)nxt.pn * tstep : cB;
#pragma unroll 1
    for (int t = 0; t < nt; t += 2) {
      const bool last = (t == nt - 2);
      const char* a1 = cA + (size_t)(t + 1) * kstep;
      const char* a2 = last ? nA : cA + (size_t)(t + 2) * kstep;
      const char* b2 = last ? nB : cB + (size_t)(t + 2) * kstep;
      const char* a3 = a2 + kstep;
      const char* b3 = b2 + kstep;
      G8_LDB(B0, 0, 0); G8_SCHED; G8_LDA(At, 0, 0); G8_STAGE(G8_SA(1, 1), a1, voffA[1]);
      if (MODE == 3) {
        if (last && has_next) {
          G8_VOFFA(voffA, nxt);
          asm volatile("s_waitcnt vmcnt(0)" ::: "memory");
        }
      }
      G8_WAIT_L(8); G8_BAR; G8_WAIT_L(0); G8_MMA(0, 0, At, B0); G8_BAR; G8_SCHED;
      G8_LDB(B1, 0, 1); G8_STAGE(G8_SB(0, 0), b2, voffB);
      G8_BAR; G8_WAIT_L(0); G8_MMA(0, 1, At, B1); G8_BAR;
      G8_LDA(At, 0, 1); G8_STAGE(G8_SA(0, 0), a2, voffA[0]);
      G8_BAR; G8_WAIT_L(0); G8_MMA(1, 0, At, B0); G8_BAR; G8_SCHED;
      G8_STAGE(G8_SB(0, 1), b2 + hstep, voffB);
      G8_WAIT_V(6); G8_BAR; G8_MMA(1, 1, At, B1); G8_BAR;
      G8_LDB(B0, 1, 0); G8_SCHED; G8_LDA(At, 1, 0); G8_STAGE(G8_SA(0, 1), a2, voffA[1]);
      G8_WAIT_L(8); G8_BAR; G8_WAIT_L(0); G8_MMA(0, 0, At, B0); G8_BAR; G8_SCHED;
      G8_LDB(B1, 1, 1); G8_STAGE(G8_SB(1, 0), b3, voffB);
      G8_BAR; G8_WAIT_L(0); G8_MMA(0, 1, At, B1); G8_BAR;
      G8_LDA(At, 1, 1); G8_STAGE(G8_SA(1, 0), a3, voffA[0]);
      G8_BAR; G8_WAIT_L(0); G8_MMA(1, 0, At, B0); G8_BAR; G8_SCHED;
      G8_STAGE(G8_SB(1, 1), b3 + hstep, voffB);
      G8_WAIT_V(6); G8_BAR; G8_MMA(1, 1, At, B1); G8_BAR;
    }
    epilogue<MODE>(p, acc, cur, wr, wc, fr, fq);
    if (!has_next) break;
#pragma unroll
    for (int a = 0; a < 2; ++a)
#pragma unroll
      for (int b = 0; b < 2; ++b)
#pragma unroll
        for (int m = 0; m < 4; ++m)
#pragma unroll
          for (int n = 0; n < 2; ++n) acc[a][b][m][n] = (f32x4){0.f, 0.f, 0.f, 0.f};
    cur = nxt; cA = nA; cB = nB; ++ui;
  }
  G8_WAIT_V(0);
  if (wr == 0) G8_BAR;
  G8_BAR;
#undef G8_GETU
#undef G8_VOFFA
#undef G8_SA
#undef G8_SB
#undef G8_STAGE
#undef G8_LDA
#undef G8_LDB
#undef G8_MMA
#undef G8_WAIT_V
#undef G8_WAIT_L
#undef G8_BAR
#undef G8_SCHED
}
}

DI float rope_apply(float v, float c, float s, int lane) {
  float o = xor32f(v, lane);
  return (lane < 32) ? (v * c - o * s) : (v * c + o * s);
}
DI void phase_post1(const Params& p, char* smem) {
  const int tid = otid(p), lane = tid & 63, wave = tid >> 6;
  const float* P = (const float*)(p.ws + OFF_P);
  const float* rope = (const float*)(p.ws + OFF_ROPE);
  unsigned short* Qb = (unsigned short*)(p.ws + OFF_QB);
  unsigned short* QI = (unsigned short*)(p.ws + OFF_QI);
  unsigned short* KI = (unsigned short*)(p.ws + OFF_KI);
  unsigned short* CKV = (unsigned short*)(p.ws + OFF_CKV);
  float* WI = (float*)(p.ws + OFF_WI);
  float* Qd = (float*)(p.ws + OFF_QD);
  float* Kd = (float*)(p.ws + OFF_KD);
  float* Vd = (float*)(p.ws + OFF_VD);
  float* BETA = (float*)(p.ws + OFF_BETA);
  float* G = (float*)(p.ws + OFF_G);
  float* cw = (float*)smem;
  __syncthreads();
  for (int idx = tid; idx < 4 * 1536; idx += NTHREADS) cw[idx] = p.conv_w[idx];
  __syncthreads();
  const float qw = p.q_norm_w[lane] * (0.125f * 1.4426950408889634f);
  const float4 kvw = *(const float4*)(p.kv_norm_w + lane * 4);
  constexpr int PG = 4;
  for (int g = blockIdx.x * NWAVES + wave; g < NT / PG; g += gridDim.x * NWAVES) {
    const int tok0 = g * PG, b = tok0 / T, t0 = tok0 - b * T;
    const int tailc = (lane < 8) ? (C_IW + lane) : (C_BBETA + ((lane - 8) & 7));
    float nqv[8], niv[8];
    float4 nckv;
    float nikv, ntail;
    {
      const float* row = P + (size_t)tok0 * INC;
#pragma unroll
      for (int hh = 0; hh < 8; ++hh) { nqv[hh] = row[C_AQ + hh * 64 + lane]; niv[hh] = row[C_IQ + hh * 64 + lane]; }
      nckv = *(const float4*)(row + C_CKV + lane * 4);
      nikv = row[C_IK + lane];
      ntail = row[tailc];
    }
#pragma unroll 1
    for (int tt = 0; tt < PG; ++tt) {
      const int tok = tok0 + tt, t = t0 + tt;
      float qv[8], iv[8];
#pragma unroll
      for (int hh = 0; hh < 8; ++hh) { qv[hh] = nqv[hh]; iv[hh] = niv[hh]; }
      const float4 ckv = nckv;
      const float ikv = nikv, tailv = ntail;
      if (tt + 1 < PG) {
        const float* row = P + (size_t)(tok + 1) * INC;
#pragma unroll
        for (int hh = 0; hh < 8; ++hh) { nqv[hh] = row[C_AQ + hh * 64 + lane]; niv[hh] = row[C_IQ + hh * 64 + lane]; }
        nckv = *(const float4*)(row + C_CKV + lane * 4);
        nikv = row[C_IK + lane];
        ntail = row[tailc];
      }
      const float cs = rope[t * 64 + (lane & 31)], sn = rope[t * 64 + 32 + (lane & 31)];
      unsigned short* qb = Qb + (size_t)tok * 512 + lane;
      unsigned short* qi = QI + (size_t)tok * 512 + lane;
#pragma unroll
      for (int hh = 0; hh < 8; ++hh) {
        float v = qv[hh];
        const float ss = wave_sum(v * v);
        v = v * rsqrtf(ss * (1.f / 64.f) + 1e-6f) * qw;
        qb[hh * 64] = f2bf(rope_apply(v, cs, sn, lane));
        qi[hh * 64] = f2bf(rope_apply(iv[hh], cs, sn, lane));
      }
      {
        const float ss = wave_sum(ckv.x * ckv.x + ckv.y * ckv.y + ckv.z * ckv.z + ckv.w * ckv.w);
        const float rstd = rsqrtf(ss * (1.f / 256.f) + 1e-6f);
        uint2 o;
        o.x = pk2(ckv.x * rstd * kvw.x, ckv.y * rstd * kvw.y);
        o.y = pk2(ckv.z * rstd * kvw.z, ckv.w * rstd * kvw.w);
        *(uint2*)(CKV + (size_t)tok * 256 + lane * 4) = o;
      }
      KI[(size_t)tok * 64 + lane] = f2bf(rope_apply(ikv, cs, sn, lane));
      if (lane < 8) WI[(size_t)tok * 8 + lane] = tailv * 0.04419417382415922f;
      if (lane >= 8 && lane < 12) BETA[(size_t)tok * 4 + (lane - 8)] = 1.f / (1.f + expf(-tailv));
      if (lane >= 12 && lane < 16) {
        const float xx = tailv + p.dt_bias[lane - 12];
        const float sp = fmaxf(xx, 0.f) + log1pf(expf(-fabsf(xx)));
        G[(size_t)tok * 4 + (lane - 12)] = -expf(p.a_log[lane - 12]) * sp;
      }
    }
    float x0[24], x1[24], x2[24];
    {
      const float* base = P + (size_t)tok0 * INC + C_BQKV + lane;
#pragma unroll
      for (int i = 0; i < 24; ++i) {
        x0[i] = (t0 >= 3) ? base[64 * i - 3 * (ptrdiff_t)INC] : 0.f;
        x1[i] = (t0 >= 2) ? base[64 * i - 2 * (ptrdiff_t)INC] : 0.f;
        x2[i] = (t0 >= 1) ? base[64 * i - 1 * (ptrdiff_t)INC] : 0.f;
      }
    }
    float xn[24];
    {
      const float* xr = P + (size_t)tok0 * INC + C_BQKV + lane;
#pragma unroll
      for (int i = 0; i < 24; ++i) xn[i] = xr[64 * i];
    }
#pragma unroll 1
    for (int tt = 0; tt < PG; ++tt) {
      const int tok = tok0 + tt;
      float x3[24];
#pragma unroll
      for (int i = 0; i < 24; ++i) x3[i] = xn[i];
      if (tt + 1 < PG) {
        const float* xr = P + (size_t)(tok + 1) * INC + C_BQKV + lane;
#pragma unroll
        for (int i = 0; i < 24; ++i) xn[i] = xr[64 * i];
      }
      int cl = lane;
      asm volatile("" : "+v"(cl));
      float* qd = Qd + (size_t)tok * 512 + lane;
      float* kd = Kd + (size_t)tok * 512 + lane;
      float* vd = Vd + (size_t)tok * 512 + lane;
#pragma unroll
      for (int hd = 0; hd < 4; ++hd) {
        float cv[6];
#pragma unroll
        for (int q = 0; q < 6; ++q) {
          const int i = (q >> 1) * 8 + 2 * hd + (q & 1);
          const int c = cl + 64 * i;
          const float a = cw[c] * x0[i] + cw[1536 + c] * x1[i] + cw[2 * 1536 + c] * x2[i] + cw[3 * 1536 + c] * x3[i];
          cv[q] = a / (1.f + __expf(-a));
          x0[i] = x1[i]; x1[i] = x2[i]; x2[i] = x3[i];
        }
        float ss = wave_sum(cv[0] * cv[0] + cv[1] * cv[1]);
        float r = rsqrtf(ss + 1e-6f);
        qd[hd * 128] = cv[0] * r;
        qd[hd * 128 + 64] = cv[1] * r;
        ss = wave_sum(cv[2] * cv[2] + cv[3] * cv[3]);
        r = rsqrtf(ss + 1e-6f);
        kd[hd * 128] = cv[2] * r;
        kd[hd * 128 + 64] = cv[3] * r;
        vd[hd * 128] = cv[4];
        vd[hd * 128 + 64] = cv[5];
      }
    }
  }
}

DI void phase_post2(const Params& p, char* smem) {
  (void)smem;
  const int tid = otid(p), lane = tid & 63, wave = tid >> 6;
  const float* KV = (const float*)(p.ws + OFF_KV);
  const float* rope = (const float*)(p.ws + OFF_ROPE);
  unsigned short* Kb = (unsigned short*)(p.ws + OFF_KB);
  unsigned short* Vb = (unsigned short*)(p.ws + OFF_VT);
  const float kw = p.k_norm_w[lane];
  for (int tok = blockIdx.x * NWAVES + wave; tok < NT; tok += gridDim.x * NWAVES) {
    const int b = tok / T, t = tok - b * T;
    const float* row = KV + (size_t)tok * 1024;
    float kv[8], vv[8];
#pragma unroll
    for (int hh = 0; hh < 8; ++hh) { kv[hh] = row[hh * 64 + lane]; vv[hh] = row[512 + hh * 64 + lane]; }
    const float cs = rope[t * 64 + (lane & 31)], sn = rope[t * 64 + 32 + (lane & 31)];
    unsigned short* kb = Kb + (size_t)tok * 512 + lane;
    unsigned short* vb = Vb + (size_t)tok * 512 + lane;
#pragma unroll
    for (int hh = 0; hh < 8; ++hh) {
      float v = kv[hh];
      const float ss = wave_sum(v * v);
      v = v * rsqrtf(ss * (1.f / 64.f) + 1e-6f) * kw;
      kb[hh * 64] = f2bf(rope_apply(v, cs, sn, lane));
      vb[hh * 64] = f2bf(vv[hh]);
    }
  }
}

constexpr int KS_STRIDE = 129, AM_STRIDE = 65;
DI void phase_chunkprep(const Params& p, char* smem) {
  constexpr int KQ = 136;
  unsigned short* K16 = (unsigned short*)smem;
  unsigned short* Q16 = K16 + 64 * KQ;
  float* Am = (float*)(Q16 + 64 * KQ);
  float* Tm = Am + 64 * AM_STRIDE;
  float* gc = Tm + 64 * AM_STRIDE;
  float* bet = gc + 64;
  float* gl = bet + 64;
  unsigned short* T16 = (unsigned short*)(gl + 64);
  float* Mt = (float*)T16;
  unsigned short* VbT = T16 + 64 * 72;
  unsigned short* KbT = VbT + 128 * 72;
  static_assert(2 * 64 * KQ * 2 + (64 * AM_STRIDE * 2 + 192) * 4 + (64 * 72 + 2 * 128 * 72) * 2 <= 131072, "chunk prep LDS");
  const int tid = otid(p), lane = tid & 63, wave = tid >> 6;
  const float* Qd = (const float*)(p.ws + OFF_QD);
  const float* Kd = (const float*)(p.ws + OFF_KD);
  const float* Vd = (const float*)(p.ws + OFF_VD);
  const float* BETA = (const float*)(p.ws + OFF_BETA);
  const float* G = (const float*)(p.ws + OFF_G);
  unsigned short* CHB = (unsigned short*)(p.ws + OFF_WN);
  float* UU = (float*)(p.ws + OFF_UU);
  float* DL = (float*)(p.ws + OFF_DL);
  for (int ci = blockIdx.x; ci < NCHT; ci += gridDim.x) {
    unsigned short* chb = CHB + (size_t)ci * CHB_ELEMS;
    const int bh = ci / NCH, c = ci - bh * NCH, b = bh >> 2, h = bh & 3;
    __syncthreads();
    if (tid < 64) {
      int t = c * 64 + tid - 48;
      float g = 0.f, be = 0.f;
      if (t >= 0) { g = G[(size_t)(b * T + t) * 4 + h]; be = BETA[(size_t)(b * T + t) * 4 + h]; }
      gl[tid] = g;
      bet[tid] = be;
    }
    __syncthreads();
    if (tid < 64) {
      float s2 = 0.f;
      for (int j = 0; j <= tid; ++j) s2 += gl[j];
      gc[tid] = s2;
    }
    __syncthreads();
#pragma unroll 1
    for (int hb = 0; hb < 2; ++hb) {
      float kr[8], qr[8], vr[8];
#pragma unroll
      for (int it = 0; it < 8; ++it) {
        const int idx = tid + (hb * 8 + it) * NTHREADS, i = idx >> 7, d = idx & 127;
        const int t = c * 64 + i - 48;
        kr[it] = 0.f; qr[it] = 0.f; vr[it] = 0.f;
        if (t >= 0) {
          const size_t o = ((size_t)(b * T + t)) * 512 + h * 128 + d;
          kr[it] = Kd[o];
          qr[it] = Qd[o] * 0.08838834764831845f;
          vr[it] = Vd[o];
        }
      }
#pragma unroll
      for (int it = 0; it < 8; ++it) {
        const int idx = tid + (hb * 8 + it) * NTHREADS, i = idx >> 7, d = idx & 127;
        const float bi = bet[i], eg = __expf(gc[i]);
        K16[i * KQ + d] = f2bf(kr[it]);
        Q16[i * KQ + d] = f2bf(qr[it]);
        VbT[d * 72 + i] = f2bf(bi * vr[it]);
        KbT[d * 72 + i] = f2bf(bi * eg * kr[it]);
        chb[CH_QG + swzA(i, d)] = f2bf(qr[it] * eg);
      }
    }
    __syncthreads();
    {
      const int mat = wave >> 2, tl = wave & 3, lr = lane & 31, lh = lane >> 5;
      if (tl < 3) {
        const int mt = (tl + 1) >> 1, nt = tl >> 1;
        const unsigned short* At = mat ? Q16 : K16;
        f32x16 acc;
#pragma unroll
        for (int r = 0; r < 16; ++r) acc[r] = 0.f;
#pragma unroll
        for (int ks = 0; ks < 8; ++ks) {
          const bf16x8 af = ld16(At + (mt * 32 + lr) * KQ + ks * 16 + 8 * lh);
          const bf16x8 bfr = ld16(K16 + (nt * 32 + lr) * KQ + ks * 16 + 8 * lh);
          acc = MFMA32(af, bfr, acc);
        }
        const int j = nt * 32 + lr;
        const float gj = gc[j];
#pragma unroll
        for (int r = 0; r < 16; ++r) {
          const int i = mt * 32 + crow(r, lh);
          const float dec = (j <= i) ? __expf(gc[i] - gj) : 0.f;
          if (mat == 0) Am[i * AM_STRIDE + j] = (j < i) ? bet[i] * acc[r] * dec : 0.f;
          else chb[CH_IN + swzB(i, j)] = f2bf(acc[r] * dec);
        }
      } else {
        const int lr = lane & 31, lh = lane >> 5;
#pragma unroll
        for (int r = 0; r < 16; ++r) {
          const int i = crow(r, lh), j = 32 + lr;
          if (mat == 0) Am[i * AM_STRIDE + j] = 0.f;
          else chb[CH_IN + swzB(i, j)] = 0;
        }
      }
    }
    __syncthreads();
    {
      for (int idx = tid; idx < 64 * 64; idx += NTHREADS) Tm[(idx >> 6) * AM_STRIDE + (idx & 63)] = 0.f;
      __syncthreads();
      if (tid < 64) {
        const int bb = tid >> 4, cc = tid & 15, o = 16 * bb;
        float x[16];
#pragma unroll
        for (int i = 0; i < 16; ++i) {
          float a = (i == cc) ? 1.f : 0.f;
#pragma unroll
          for (int j = 0; j < 16; ++j)
            if (j < i) a -= Am[(o + i) * AM_STRIDE + o + j] * x[j];
          x[i] = a;
          Tm[(o + i) * AM_STRIDE + o + cc] = a;
        }
      }
      __syncthreads();
      {
        const int B = tid >> 8, i = (tid >> 4) & 15, j = tid & 15, o = 32 * B;
        float m = 0.f;
#pragma unroll
        for (int k = 0; k < 16; ++k) m += Am[(o + 16 + i) * AM_STRIDE + o + k] * Tm[(o + k) * AM_STRIDE + o + j];
        Mt[(B * 16 + i) * 33 + j] = m;
        __syncthreads();
        float t = 0.f;
#pragma unroll
        for (int k = 0; k < 16; ++k) t += Tm[(o + 16 + i) * AM_STRIDE + o + 16 + k] * Mt[(B * 16 + k) * 33 + j];
        __syncthreads();
        Tm[(o + 16 + i) * AM_STRIDE + o + j] = -t;
      }
      __syncthreads();
      {
        const int i = tid >> 4, j0 = (tid & 15) * 2;
        float m0 = 0.f, m1 = 0.f;
        for (int k = 0; k < 32; ++k) {
          const float a = Am[(32 + i) * AM_STRIDE + k];
          m0 += a * Tm[k * AM_STRIDE + j0];
          m1 += a * Tm[k * AM_STRIDE + j0 + 1];
        }
        Mt[i * 33 + j0] = m0;
        Mt[i * 33 + j0 + 1] = m1;
        __syncthreads();
        float t0 = 0.f, t1 = 0.f;
        for (int k = 0; k < 32; ++k) {
          const float a = Tm[(32 + i) * AM_STRIDE + 32 + k];
          t0 += a * Mt[k * 33 + j0];
          t1 += a * Mt[k * 33 + j0 + 1];
        }
        __syncthreads();
        Tm[(32 + i) * AM_STRIDE + j0] = -t0;
        Tm[(32 + i) * AM_STRIDE + j0 + 1] = -t1;
      }
    }
    __syncthreads();
    for (int idx = tid; idx < 64 * 64; idx += NTHREADS) T16[(idx >> 6) * 72 + (idx & 63)] = f2bf(Tm[(idx >> 6) * AM_STRIDE + (idx & 63)]);
    __syncthreads();
    {
      const int mat = wave >> 2, nt = wave & 3, lr = lane & 31, lh = lane >> 5;
      const unsigned short* Bt = mat ? KbT : VbT;
#pragma unroll
      for (int mt = 0; mt < 2; ++mt) {
        f32x16 acc;
#pragma unroll
        for (int r = 0; r < 16; ++r) acc[r] = 0.f;
#pragma unroll
        for (int ks = 0; ks < 4; ++ks) {
          const bf16x8 af = ld16(T16 + (mt * 32 + lr) * 72 + ks * 16 + 8 * lh);
          const bf16x8 bfr = ld16(Bt + (nt * 32 + lr) * 72 + ks * 16 + 8 * lh);
          acc = MFMA32(af, bfr, acc);
        }
        if (mat == 0) {
          float* up = UU + (size_t)ci * 8192 + (((nt * 2 + mt) * 2 + lh) * 32 + lr) * 16;
#pragma unroll
          for (int q = 0; q < 4; ++q) *(float4*)(up + 4 * q) = make_float4(acc[4 * q], acc[4 * q + 1], acc[4 * q + 2], acc[4 * q + 3]);
        } else {
#pragma unroll
          for (int r = 0; r < 16; ++r) chb[swzA(mt * 32 + crow(r, lh), nt * 32 + lr)] = f2bf(-acc[r]);
        }
      }
    }
    const float glast = gc[63];
    for (int idx = tid; idx < 64 * 128; idx += NTHREADS) {
      int i = idx & 63, d = idx >> 6;
      chb[CH_KDT + swzB(d, i)] = f2bf(bf2f(K16[i * KQ + d]) * __expf(glast - gc[i]));
    }
    if (tid == 0) DL[ci] = __expf(glast);
  }
}

DI float relu_fma(float w, float x, float acc) {
  const int xi = __builtin_bit_cast(int, x);
  const float m = __builtin_bit_cast(float, xi > 0 ? xi : 0);
  return __builtin_fmaf(w, m, acc);
}
DI unsigned ordkey(float f) {
  unsigned u = __float_as_uint(f);
  return (u & 0x80000000u) ? ~u : (u | 0x80000000u);
}
DI int half_sum(int v) {
  v += dppi<0xB1>(v); v += dppi<0x4E>(v); v += dppi<0x141>(v); v += dppi<0x140>(v);
  const int lo = __builtin_amdgcn_readlane(v, 0) + __builtin_amdgcn_readlane(v, 16);
  const int hi = __builtin_amdgcn_readlane(v, 32) + __builtin_amdgcn_readlane(v, 48);
  return (__builtin_amdgcn_mbcnt_hi(~0u, __builtin_amdgcn_mbcnt_lo(~0u, 0u)) < 32u) ? lo : hi;
}
DI int cnt4_ge(int cnt, unsigned a, unsigned b, unsigned c, unsigned d, unsigned cand) {
  unsigned long long m0, m1, m2, m3;
  asm("v_cmp_ge_u32_e64 %1, %5, %9\n\tv_cmp_ge_u32_e64 %2, %6, %9\n\tv_cmp_ge_u32_e64 %3, %7, %9\n\tv_cmp_ge_u32_e64 %4, %8, %9\n\t"
      "v_addc_co_u32_e64 %0, %1, %0, 0, %1\n\tv_addc_co_u32_e64 %0, %2, %0, 0, %2\n\tv_addc_co_u32_e64 %0, %3, %0, 0, %3\n\tv_addc_co_u32_e64 %0, %4, %0, 0, %4"
      : "+v"(cnt), "=&s"(m0), "=&s"(m1), "=&s"(m2), "=&s"(m3)
      : "v"(a), "v"(b), "v"(c), "v"(d), "v"(cand));
  return cnt;
}
DI int cnt4_gt(int cnt, unsigned a, unsigned b, unsigned c, unsigned d, unsigned cand) {
  unsigned long long m0, m1, m2, m3;
  asm("v_cmp_gt_u32_e64 %1, %5, %9\n\tv_cmp_gt_u32_e64 %2, %6, %9\n\tv_cmp_gt_u32_e64 %3, %7, %9\n\tv_cmp_gt_u32_e64 %4, %8, %9\n\t"
      "v_addc_co_u32_e64 %0, %1, %0, 0, %1\n\tv_addc_co_u32_e64 %0, %2, %0, 0, %2\n\tv_addc_co_u32_e64 %0, %3, %0, 0, %3\n\tv_addc_co_u32_e64 %0, %4, %0, 0, %4"
      : "+v"(cnt), "=&s"(m0), "=&s"(m1), "=&s"(m2), "=&s"(m3)
      : "v"(a), "v"(b), "v"(c), "v"(d), "v"(cand));
  return cnt;
}
DI void indexer_task(const Params& p, char* smem, int b, int q8, int wave, int lane) {
  const int q0 = (q8 * 8 + wave) * 2;
  unsigned* MASK = (unsigned*)(p.ws + OFF_MASK);
  const int qsel = lane >> 5;
  const int tq = q0 + qsel;
  unsigned* mrow = MASK + (size_t)b * 128 * SEQ + tq;
  if (q8 < 16) {
    for (int i = (lane & 31); i < 128; i += 32) {
      int rem = tq + 1 - 32 * i;
      unsigned w = (rem >= 32) ? 0xffffffffu : (rem > 0 ? ((1u << rem) - 1u) : 0u);
      mrow[(size_t)i * SEQ] = w;
    }
    return;
  }
  const unsigned short* QI = (const unsigned short*)(p.ws + OFF_QI);
  const unsigned short* KI = (const unsigned short*)(p.ws + OFF_KI);
  const float* WI = (const float*)(p.ws + OFF_WI);
  const int l15 = lane & 15, lg = lane >> 4;
  const size_t qtok = (size_t)b * T + NM + q0 + (l15 >> 3);
  const bf16x8 a0 = ld16(QI + qtok * 512 + (l15 & 7) * 64 + 8 * lg);
  const bf16x8 a1 = ld16(QI + qtok * 512 + (l15 & 7) * 64 + 32 + 8 * lg);
  float w[4];
  {
    const size_t wtok = (size_t)b * T + NM + q0 + (lg >> 1);
#pragma unroll
    for (int r = 0; r < 4; ++r) w[r] = WI[wtok * 8 + 4 * (lg & 1) + r];
  }
  const int npairs = (q0 + 2 + 31) >> 5;
  const int npmax = (16 * q8 + 16 + 31) >> 5;
  LAS unsigned char* lds = (LAS unsigned char*)smem;
  const bool loader = wave < 4;
  const unsigned short* ksrc = KI + ((size_t)b * T + NM + 8 * wave + (lane >> 3)) * 64 + (((lane & 7) ^ (lane >> 3)) << 3);
  const unsigned frag0 = (unsigned)(l15 * 128 + ((lg ^ (l15 & 7)) << 4));
  const unsigned frag1 = (unsigned)(l15 * 128 + (((4 + lg) ^ (l15 & 7)) << 4));
  asm volatile("s_waitcnt vmcnt(0)" ::: "memory");
  __syncthreads();
#define IX_DMA(stage) __builtin_amdgcn_global_load_lds((const unsigned*)(ksrc + (size_t)(stage) * 2048), (LAS unsigned*)(lds + ((stage) & 3) * 4096 + wave * 1024), 16, 0, 0)
  if (loader) {
    IX_DMA(0);
    if (1 < npmax) IX_DMA(1);
    if (2 < npmax) IX_DMA(2);
  }
  unsigned u[128];
  int rem = tq - (lane & 31);
#pragma unroll
  for (int i = 0; i < 128; ++i) {
    unsigned uv = 0u;
    if (i < npmax) {
      if (loader) {
        if (i + 2 < npmax) asm volatile("s_waitcnt vmcnt(2)" ::: "memory");
        else if (i + 1 < npmax) asm volatile("s_waitcnt vmcnt(1)" ::: "memory");
        else asm volatile("s_waitcnt vmcnt(0)" ::: "memory");
      }
      __builtin_amdgcn_s_barrier();
      if (loader && i + 3 < npmax) IX_DMA(i + 3);
      if (i < npairs) {
        const LAS unsigned char* sb = lds + (i & 3) * 4096;
        float tot[2];
#pragma unroll
        for (int par = 0; par < 2; ++par) {
          const bf16x8 b0 = *(const LAS bf16x8*)(sb + par * 2048 + frag0);
          const bf16x8 b1 = *(const LAS bf16x8*)(sb + par * 2048 + frag1);
          f32x4 acc = {0.f, 0.f, 0.f, 0.f};
          acc = MFMA16(a0, b0, acc);
          acc = MFMA16(a1, b1, acc);
          float part = 0.f;
#pragma unroll
          for (int r = 0; r < 4; ++r) part = relu_fma(w[r], acc[r], part);
          tot[par] = part + xor16f(part, lane);
        }
        const float sc = (lg & 1) ? tot[1] : tot[0];
        uv = (rem >= 0) ? ordkey(sc) : 0u;
      }
    }
    u[i] = uv;
    rem -= 32;
    asm volatile("" : "+v"(rem));
  }
#undef IX_DMA
  __builtin_amdgcn_s_barrier();
  const int nblk = (npairs + 15) >> 4;
  unsigned thr = 0u;
  bool done = false;
  for (int bit = 31; bit >= 0; --bit) {
    const unsigned cand = thr | (1u << bit);
    int cnt = 0;
#pragma unroll
    for (int blk = 0; blk < 8; ++blk) {
      if (blk < nblk) {
#pragma unroll
        for (int j = 0; j < 16; j += 4) cnt = cnt4_ge(cnt, u[blk * 16 + j], u[blk * 16 + j + 1], u[blk * 16 + j + 2], u[blk * 16 + j + 3], cand);
      }
    }
    cnt = half_sum(cnt);
    if (!done && cnt >= 256) thr = cand;
    done = done || (cnt == 256);
    if (__all(done)) break;
  }
  int cgt = 0;
#pragma unroll
  for (int blk = 0; blk < 8; ++blk) {
    if (blk < nblk) {
#pragma unroll
      for (int j = 0; j < 16; j += 4) cgt = cnt4_gt(cgt, u[blk * 16 + j], u[blk * 16 + j + 1], u[blk * 16 + j + 2], u[blk * 16 + j + 3], thr);
    }
  }
  cgt = half_sum(cgt);
  const int need = 256 - cgt;
  int base = 0;
  const unsigned lt_mask = (1u << (lane & 31)) - 1u;
#pragma unroll
  for (int blk = 0; blk < 8; ++blk) {
    if (blk < nblk) {
#pragma unroll
      for (int j = 0; j < 16; ++j) {
        const int i = blk * 16 + j;
        const bool eq = (u[i] == thr);
        const unsigned long long eb = __ballot(eq);
        const unsigned ehalf = qsel ? (unsigned)(eb >> 32) : (unsigned)eb;
        const int below = __popc(ehalf & lt_mask);
        const bool sel = (u[i] > thr) || (eq && (base + below < need));
        base += __popc(ehalf);
        const unsigned long long sb = __ballot(sel);
        const unsigned shalf = qsel ? (unsigned)(sb >> 32) : (unsigned)sb;
        if ((lane & 31) == 0) mrow[(size_t)i * SEQ] = shalf;
      }
    }
  }
}
DI void phase_indexer(const Params& p, char* smem) {
  const int tid = otid(p), lane = tid & 63, wave = __builtin_amdgcn_readfirstlane(tid >> 6);
  unsigned* ctr = (unsigned*)(p.ws + OFF_BAR + 15872 + 64);
  volatile LAS int* slot = (volatile LAS int*)((LAS unsigned char*)smem + g8::STAGE_BYTES + 800);
  const int ngroup = NB * (SEQ / 16);
  for (;;) {
    __syncthreads();
    if (tid == 0) *slot = (int)__hip_atomic_fetch_add(ctr, 1u, __ATOMIC_RELAXED, __HIP_MEMORY_SCOPE_AGENT);
    __syncthreads();
    const int g = __builtin_amdgcn_readfirstlane(*slot);
    if (g >= ngroup) break;
    const int b = g & 3, q8 = (SEQ / 16 - 1) - (g >> 2);
    indexer_task(p, smem, b, q8, wave, lane);
  }
}

constexpr int AT_KROW = 72, AT_VROW = 96;
constexpr int AT_KBYTES = 64 * AT_KROW * 2, AT_STAGE = AT_KBYTES + 64 * AT_VROW * 2;
typedef short s16x4v __attribute__((ext_vector_type(4)));
typedef unsigned u32x4v __attribute__((ext_vector_type(4)));
DI void attn_block(const Params& p, char* smem, int b, int hh, int G) {
  const unsigned short* Qb = (const unsigned short*)(p.ws + OFF_QB);
  const unsigned short* Kb = (const unsigned short*)(p.ws + OFF_KB);
  const unsigned short* Vb = (const unsigned short*)(p.ws + OFF_VT);
  const unsigned* MASK = (const unsigned*)(p.ws + OFF_MASK);
  unsigned short* MIX = (unsigned short*)(p.ws + OFF_MIX);
  LAS unsigned char* lds = (LAS unsigned char*)smem;
  const int tid = otid(p), lane = tid & 63, wave = __builtin_amdgcn_readfirstlane(tid >> 6);
  const int lr = lane & 31, lh = lane >> 5;
  const int qt = 8 * G + wave;
  const int jl = (qt + 1) >> 1;
  const int tq = qt * 32 + lr;
  const size_t qtok = (size_t)b * T + NM + tq;
  bf16x8 qf[4];
#pragma unroll
  for (int ks = 0; ks < 4; ++ks) qf[ks] = ld16(Qb + qtok * 512 + hh * 64 + ks * 16 + 8 * lh);
  const unsigned* mrow = MASK + (size_t)b * 128 * SEQ + tq;
  const int srow = tid >> 3, sch = tid & 7;
  const size_t gcol = (size_t)hh * 64 + sch * 8;
  const unsigned short* kbase = Kb + (size_t)b * T * 512 + gcol;
  const unsigned short* vbase = Vb + (size_t)b * T * 512 + gcol;
  const unsigned sdk = (unsigned)(srow * (AT_KROW * 2) + sch * 16);
  const unsigned sdv = (unsigned)(AT_KBYTES + srow * (AT_VROW * 2) + sch * 16);
  const int nst = 4 * G + 5;
  const unsigned koff = (unsigned)(lr * (AT_KROW * 2) + 16 * lh);
  const unsigned voff = (unsigned)(AT_KBYTES + (4 * lh + ((lane & 15) >> 2)) * (AT_VROW * 2) + (16 * ((lane >> 4) & 1) + 4 * (lane & 3)) * 2);
  __syncthreads();
  {
    const size_t t0 = (size_t)(srow < 32 ? srow : srow - 16) * 512;
    const u32x4v k0 = *(const u32x4v*)(kbase + t0);
    const u32x4v v0 = *(const u32x4v*)(vbase + t0);
    *(LAS u32x4v*)(lds + sdk) = k0;
    *(LAS u32x4v*)(lds + sdv) = v0;
  }
  u32x4v rk1 = *(const u32x4v*)(kbase + (size_t)(48 + srow) * 512), rv1 = *(const u32x4v*)(vbase + (size_t)(48 + srow) * 512);
  u32x4v rk0 = *(const u32x4v*)(kbase + (size_t)(112 + srow) * 512), rv0 = *(const u32x4v*)(vbase + (size_t)(112 + srow) * 512);
  f32x16 o[2], negm, lacc;
#pragma unroll
  for (int r = 0; r < 16; ++r) { o[0][r] = 0.f; o[1][r] = 0.f; negm[r] = 0.f; lacc[r] = 0.f; }
  const bf16x8 ones = {0x3F80, 0x3F80, 0x3F80, 0x3F80, 0x3F80, 0x3F80, 0x3F80, 0x3F80};
  unsigned wa0 = 0x0000ffffu, wb0 = mrow[0], wa1 = mrow[SEQ], wb1 = mrow[2 * SEQ];
  asm volatile("" : "+v"(rk0), "+v"(rv0), "+v"(rk1), "+v"(rv1), "+v"(wb0), "+v"(wa1), "+v"(wb1));
  __syncthreads();
#define AT_STEP(jj, PAR, FIRST, rkn, rvn, wa, wb) do { \
    const int j_ = (jj); \
      \
      \
    *(LAS u32x4v*)(lds + (PAR ^ 1) * AT_STAGE + sdk) = rkn; \
    *(LAS u32x4v*)(lds + (PAR ^ 1) * AT_STAGE + sdv) = rvn; \
    { \
      const size_t go = (size_t)min(64 * (j_ + 3) - 16 + srow, T - 1) * 512; \
      rkn = *(const u32x4v*)(kbase + go); \
      rvn = *(const u32x4v*)(vbase + go); \
    } \
    if (j_ <= jl) { \
      const LAS unsigned char* sb = lds + PAR * AT_STAGE; \
        \
        \
      bf16x8 kf0[4], kf1[4], vf[4][2]; \
_Pragma("unroll") \
      for (int ks = 0; ks < 4; ++ks) { \
        kf0[ks] = *(const LAS bf16x8*)(sb + koff + ks * 32); \
        kf1[ks] = *(const LAS bf16x8*)(sb + koff + 32 * (AT_KROW * 2) + ks * 32); \
      } \
_Pragma("unroll") \
      for (int ss = 0; ss < 4; ++ss) \
_Pragma("unroll") \
        for (int dt = 0; dt < 2; ++dt) { \
            \
          const LAS unsigned char* vp = sb + voff + (16 * ss) * (AT_VROW * 2) + dt * 64; \
          const s16x4v lo = __builtin_amdgcn_ds_read_tr16_b64_v4i16((LAS s16x4v*)vp); \
          const s16x4v hi = __builtin_amdgcn_ds_read_tr16_b64_v4i16((LAS s16x4v*)(vp + 8 * (AT_VROW * 2))); \
          vf[ss][dt] = __builtin_shufflevector(lo, hi, 0, 1, 2, 3, 4, 5, 6, 7); \
        } \
      __builtin_amdgcn_sched_barrier(0); \
      f32x16 s0 = negm, s1 = negm; \
_Pragma("unroll") \
      for (int ks = 0; ks < 4; ++ks) { \
        s0 = MFMA32(kf0[ks], qf[ks], s0); \
        s1 = MFMA32(kf1[ks], qf[ks], s1); \
      } \
        \
        \
        \
      int tmi = max(__float_as_int(s0[0]), __float_as_int(s1[0])); \
_Pragma("unroll") \
      for (int r = 1; r < 16; ++r) tmi = max(tmi, max(__float_as_int(s0[r]), __float_as_int(s1[r]))); \
      tmi = max(tmi, __float_as_int(xor32f(__int_as_float(tmi), lane))); \
      if (FIRST) {     \
        float tmax = fmaxf(s0[0], s1[0]); \
_Pragma("unroll") \
        for (int r = 1; r < 16; ++r) tmax = fmaxf(tmax, fmaxf(s0[r], s1[r])); \
        tmax = fmaxf(tmax, xor32f(tmax, lane)); \
_Pragma("unroll") \
        for (int r = 0; r < 16; ++r) { negm[r] = -tmax; s0[r] -= tmax; s1[r] -= tmax; } \
      } else if (!__all(tmi <= 0)) { \
        const float d = __int_as_float(max(tmi, 0)); \
        const float alpha = __builtin_amdgcn_exp2f(-d); \
_Pragma("unroll") \
        for (int r = 0; r < 16; ++r) { \
          negm[r] -= d; s0[r] -= d; s1[r] -= d; \
          o[0][r] *= alpha; o[1][r] *= alpha; lacc[r] *= alpha; \
        } \
      } \
        \
      const unsigned wsa = wa >> (4 * lh); \
      const unsigned wsb = (2 * j_ <= qt ? wb : 0u) >> (4 * lh); \
_Pragma("unroll") \
      for (int r = 0; r < 16; ++r) { \
        unsigned va, vb; \
        asm("v_bfe_i32 %0, %1, %2, 1" : "=v"(va) : "v"(wsa), "n"((r & 3) + 8 * (r >> 2))); \
        asm("v_bfe_i32 %0, %1, %2, 1" : "=v"(vb) : "v"(wsb), "n"((r & 3) + 8 * (r >> 2))); \
        s0[r] = __uint_as_float(__float_as_uint(__builtin_amdgcn_exp2f(s0[r])) & va); \
        s1[r] = __uint_as_float(__float_as_uint(__builtin_amdgcn_exp2f(s1[r])) & vb); \
      } \
_Pragma("unroll") \
      for (int ss = 0; ss < 4; ++ss) { \
        const bf16x8 pf = (ss < 2) ? pack8(s0, ss & 1) : pack8(s1, ss & 1); \
        lacc = MFMA32(ones, pf, lacc); \
_Pragma("unroll") \
        for (int dt = 0; dt < 2; ++dt) o[dt] = MFMA32(vf[ss][dt], pf, o[dt]); \
      } \
    } \
    wa = mrow[(size_t)min(2 * j_ + 3, 127) * SEQ];     \
    wb = mrow[(size_t)min(2 * j_ + 4, 127) * SEQ];     \
    __syncthreads(); \
  } while (0)
  AT_STEP(0, 0, true, rk1, rv1, wa0, wb0);
  for (int j = 1; j < nst; j += 2) {
    AT_STEP(j, 1, false, rk0, rv0, wa1, wb1);
    AT_STEP(j + 1, 0, false, rk1, rv1, wa0, wb0);
  }
#undef AT_STEP
  const float inv = 1.f / lacc[0];
#pragma unroll
  for (int dt = 0; dt < 2; ++dt)
#pragma unroll
    for (int r = 0; r < 16; ++r) MIX[qtok * 1024 + hh * 64 + dt * 32 + crow(r, lh)] = f2bf(o[dt][r] * inv);
}
DI void attn_worker(const Params& p, char* smem) {
  unsigned* ctr = (unsigned*)(p.ws + OFF_BAR + 15872);
  volatile LAS int* slot = (volatile LAS int*)((LAS unsigned char*)smem + g8::STAGE_BYTES + 800);
  const int tid = otid(p);
  for (;;) {
    __syncthreads();
    if (tid == 0) *slot = (int)__hip_atomic_fetch_add(ctr, 1u, __ATOMIC_RELAXED, __HIP_MEMORY_SCOPE_AGENT);
    __syncthreads();
    const int k = __builtin_amdgcn_readfirstlane(*slot);
    if (k >= NB * 8 * 16) break;
    const int bh = k & 31, G = 15 - (k >> 5);
    attn_block(p, smem, bh >> 3, bh & 7, G);
  }
}

DI bf16x8 lds8x2(const LAS unsigned short* p0, const LAS unsigned short* p1) {
  typedef unsigned u32x2_t __attribute__((ext_vector_type(2)));
  typedef unsigned u32x4_t __attribute__((ext_vector_type(4)));
  const u32x2_t a = *(const LAS u32x2_t*)p0, b = *(const LAS u32x2_t*)p1;
  const u32x4_t r = {a[0], a[1], b[0], b[1]};
  return __builtin_bit_cast(bf16x8, r);
}
DI void scan_block(const Params& p, char* smem, int bh, const int c0, const int c1) {
  const int tid = otid(p), lane = tid & 63, wave = __builtin_amdgcn_readfirstlane(tid >> 6);
  const int b = bh >> 2, h = bh & 3;
  LAS unsigned char* lds = (LAS unsigned char*)smem;
  const unsigned short* CHB = (const unsigned short*)(p.ws + OFF_WN) + (size_t)bh * NCH * CHB_ELEMS;
  const float* UU = (const float*)(p.ws + OFF_UU) + (size_t)bh * NCH * 8192;
  const float* DL = (const float*)(p.ws + OFF_DL) + (size_t)bh * NCH;
  float* OD = (float*)(p.ws + OFF_OD);
  constexpr int CHB_BYTES = CHB_ELEMS * 2;
  __syncthreads();
  if (wave >= 4) {
    const int w4 = wave - 4;
    for (int c = c0; c <= c1; ++c) {
      if (c < c1) {
        const char* src = (const char*)(CHB + (size_t)c * CHB_ELEMS) + (size_t)(w4 * 15) * 1024 + lane * 16;
        const unsigned dst = (unsigned)((c & 1) * CHB_BYTES + (w4 * 15) * 1024);
#pragma unroll
        for (int j = 0; j < 15; ++j)
          __builtin_amdgcn_global_load_lds((const unsigned*)(src + j * 1024), (LAS unsigned*)(lds + dst + j * 1024), 16, 0, 0);
      }
      asm volatile("s_waitcnt vmcnt(0)" ::: "memory");
      __builtin_amdgcn_s_barrier();
    }
  } else {
    const int sl = wave, lr = lane & 31, lh = lane >> 5, e0 = sl * 32;
    f32x16 S[4];
    float* sst = (float*)(p.ws + OFF_SST) + ((size_t)(bh * 4 + sl) * 64 + lane) * 64;
#pragma unroll
    for (int i = 0; i < 4; ++i)
#pragma unroll
      for (int q = 0; q < 4; ++q) {
        float4 v = make_float4(0.f, 0.f, 0.f, 0.f);
        if (c0 > 0) v = *(const float4*)(sst + i * 16 + q * 4);
        S[i][4 * q] = v.x; S[i][4 * q + 1] = v.y; S[i][4 * q + 2] = v.z; S[i][4 * q + 3] = v.w;
      }
    f32x16 un[2];
    const float* up0 = UU + (size_t)c0 * 8192 + ((size_t)(sl * 2) * 2 + lh) * 512 + lr * 16;
#pragma unroll
    for (int pt = 0; pt < 2; ++pt)
#pragma unroll
      for (int q = 0; q < 4; ++q) {
        const float4 v = *(const float4*)(up0 + pt * 1024 + q * 4);
        un[pt][4 * q] = v.x; un[pt][4 * q + 1] = v.y; un[pt][4 * q + 2] = v.z; un[pt][4 * q + 3] = v.w;
      }
    const int oA = lr * 132 + 4 * lh;
    const int oB = lr * 68 + 4 * lh;
    __builtin_amdgcn_s_barrier();
    for (int c = c0; c < c1; ++c) {
      const LAS unsigned short* cb = (const LAS unsigned short*)(lds + (c & 1) * CHB_BYTES);
      f32x16 vn[2];
      vn[0] = un[0];
      vn[1] = un[1];
#pragma unroll
      for (int pt = 0; pt < 2; ++pt) {
#pragma unroll
        for (int mt = 0; mt < 4; ++mt)
#pragma unroll
          for (int s2 = 0; s2 < 2; ++s2) {
            const LAS unsigned short* ap = cb + oA + pt * 32 * 132 + mt * 32 + 16 * s2;
            vn[pt] = MFMA32(lds8x2(ap, ap + 8), pack8(S[mt], s2), vn[pt]);
          }
      }
      bf16x8 vb[2][2];
#pragma unroll
      for (int pt = 0; pt < 2; ++pt)
#pragma unroll
        for (int s2 = 0; s2 < 2; ++s2) vb[pt][s2] = pack8(vn[pt], s2);
#pragma unroll
      for (int pt = 0; pt < 2; ++pt) {
        f32x16 o;
#pragma unroll
        for (int r = 0; r < 16; ++r) o[r] = 0.f;
#pragma unroll
        for (int mt = 0; mt < 4; ++mt)
#pragma unroll
          for (int s2 = 0; s2 < 2; ++s2) {
            const LAS unsigned short* ap = cb + CH_QG + oA + pt * 32 * 132 + mt * 32 + 16 * s2;
            o = MFMA32(lds8x2(ap, ap + 8), pack8(S[mt], s2), o);
          }
#pragma unroll
        for (int pt2 = 0; pt2 <= pt; ++pt2)
#pragma unroll
          for (int s2 = 0; s2 < 2; ++s2) {
            const LAS unsigned short* ap = cb + CH_IN + oB + pt * 32 * 68 + pt2 * 32 + 16 * s2;
            o = MFMA32(lds8x2(ap, ap + 8), vb[pt2][s2], o);
          }
#pragma unroll
        for (int r = 0; r < 16; ++r) {
          const int t = c * 64 + pt * 32 + crow(r, lh) - 48;
          if (t >= 0) OD[((size_t)(b * T + t)) * 512 + h * 128 + e0 + lr] = o[r];
        }
      }
      if (c + 1 < c1) {
        const float* up = up0 + (size_t)(c + 1 - c0) * 8192;
#pragma unroll
        for (int pt = 0; pt < 2; ++pt)
#pragma unroll
          for (int q = 0; q < 4; ++q) {
            const float4 v = *(const float4*)(up + pt * 1024 + q * 4);
            un[pt][4 * q] = v.x; un[pt][4 * q + 1] = v.y; un[pt][4 * q + 2] = v.z; un[pt][4 * q + 3] = v.w;
          }
      }
      const float dl = DL[c];
#pragma unroll
      for (int mt = 0; mt < 4; ++mt) {
#pragma unroll
        for (int r = 0; r < 16; ++r) S[mt][r] *= dl;
#pragma unroll
        for (int pt2 = 0; pt2 < 2; ++pt2)
#pragma unroll
          for (int s2 = 0; s2 < 2; ++s2) {
            const LAS unsigned short* ap = cb + CH_KDT + oB + mt * 32 * 68 + pt2 * 32 + 16 * s2;
            S[mt] = MFMA32(lds8x2(ap, ap + 8), vb[pt2][s2], S[mt]);
          }
      }
      asm volatile("s_waitcnt lgkmcnt(0)" ::: "memory");
      __builtin_amdgcn_s_barrier();
    }
    if (c1 < NCH) {
#pragma unroll
      for (int i = 0; i < 4; ++i)
#pragma unroll
        for (int q = 0; q < 4; ++q) *(float4*)(sst + i * 16 + q * 4) = make_float4(S[i][4 * q], S[i][4 * q + 1], S[i][4 * q + 2], S[i][4 * q + 3]);
    }
  }
  __syncthreads();
}
DI void phase_scan_attn(const Params& p, char* smem) {
  attn_worker(p, smem);
}

DI void phase_gnorm(const Params& p) {
  const int tid = otid(p), lane = tid & 63, wave = tid >> 6;
  const float* OD = (const float*)(p.ws + OFF_OD);
  const float* P = (const float*)(p.ws + OFF_P);
  unsigned short* MIX = (unsigned short*)(p.ws + OFF_MIX);
  const float4 w4 = *(const float4*)(p.delta_norm_w + 4 * (lane & 31));
  const int nw = gridDim.x * NWAVES;
  for (int r = (blockIdx.x * NWAVES + wave) * 2; r < NR; r += nw * 2) {
    float4 ov[2][2], zv[2][2];
#pragma unroll
    for (int t = 0; t < 2; ++t) {
      const int rr = r + t, tok = rr + 16 * (rr / SEQ + 1);
#pragma unroll
      for (int c = 0; c < 2; ++c) {
        ov[t][c] = *(const float4*)(OD + (size_t)tok * 512 + c * 256 + 4 * lane);
        zv[t][c] = *(const float4*)(P + (size_t)tok * INC + C_BZ + c * 256 + 4 * lane);
      }
    }
#pragma unroll
    for (int t = 0; t < 2; ++t) {
      const int rr = r + t, tok = rr + 16 * (rr / SEQ + 1);
#pragma unroll
      for (int c = 0; c < 2; ++c) {
        const float4 o4 = ov[t][c], z4 = zv[t][c];
        float v = o4.x * o4.x + o4.y * o4.y + o4.z * o4.z + o4.w * o4.w;
        v += dppf<0xB1>(v); v += dppf<0x4E>(v); v += dppf<0x141>(v); v += dppf<0x140>(v);
        const float slo = rlf(v, 0) + rlf(v, 16), shi = rlf(v, 32) + rlf(v, 48);
        const float rstd = rsqrtf((lane < 32 ? slo : shi) * (1.f / 128.f) + 1e-6f);
        uint2 y;
        y.x = pk2(o4.x * rstd * w4.x * (z4.x / (1.f + __expf(-z4.x))), o4.y * rstd * w4.y * (z4.y / (1.f + __expf(-z4.y))));
        y.y = pk2(o4.z * rstd * w4.z * (z4.z / (1.f + __expf(-z4.z))), o4.w * rstd * w4.w * (z4.w / (1.f + __expf(-z4.w))));
        *(uint2*)(MIX + (size_t)tok * 1024 + 512 + c * 256 + 4 * lane) = y;
      }
    }
  }
}

DI void phase_router(const Params& p, char* smem) {
  const int tid = otid(p), lane = tid & 63, wave = tid >> 6;
  float* part = (float*)smem;
  float* rstds = part + 8 * 32 * 33;
  int* lhist = (int*)(rstds + 32);
  int* lbase = lhist + 32;
  const float* H1 = (const float*)(p.ws + OFF_H1);
  const float* wrs = (const float*)(p.ws + OFF_WRS);
  unsigned short* U2 = (unsigned short*)(p.ws + OFF_U2);
  int* TOPE = (int*)(p.ws + OFF_TOPE);
  float* GATEV = (float*)(p.ws + OFF_GATEV);
  int* POS = (int*)(p.ws + OFF_POS);
  int* CNT = (int*)(p.ws + OFF_CNT);
  const int lr = lane & 31, lh = lane >> 5;
  float4 nw[4];
#pragma unroll
  for (int i = 0; i < 4; ++i) nw[i] = *(const float4*)(p.norm_ffn_w + lane * 4 + 256 * i);
  for (int task = blockIdx.x; task < NR / 32; task += gridDim.x) {
    const int r0 = task * 32;
    __syncthreads();
    if (tid < 32) lhist[tid] = 0;
    int lp0 = 0, lp1 = 0, lp2 = 0, lp3 = 0, xe0 = 0, xe1 = 0, xe2 = 0, xe3 = 0;
#pragma unroll
    for (int tt = 0; tt < 4; ++tt) {
      const int r = r0 + wave * 4 + tt;
      const float* src = H1 + (size_t)r * 1024;
      float4 v[4];
      float ss = 0.f;
#pragma unroll
      for (int i = 0; i < 4; ++i) {
        v[i] = *(const float4*)(src + lane * 4 + 256 * i);
        ss += v[i].x * v[i].x + v[i].y * v[i].y + v[i].z * v[i].z + v[i].w * v[i].w;
      }
      ss = wave_sum(ss);
      const float rstd = rsqrtf(ss * (1.f / 1024.f) + 1e-6f);
      if (lane == 0) rstds[wave * 4 + tt] = rstd;
#pragma unroll
      for (int i = 0; i < 4; ++i) {
        uint2 o;
        o.x = pk2(v[i].x * rstd * nw[i].x, v[i].y * rstd * nw[i].y);
        o.y = pk2(v[i].z * rstd * nw[i].z, v[i].w * rstd * nw[i].w);
        *(uint2*)(U2 + (size_t)r * 1024 + lane * 4 + 256 * i) = o;
      }
    }
    f32x16 acc;
#pragma unroll
    for (int i = 0; i < 16; ++i) acc[i] = 0.f;
    const float* arow = H1 + (size_t)(r0 + lr) * 1024 + wave * 128;
    const float* bcol = wrs + (size_t)(wave * 128 + lh) * 32 + lr;
#pragma unroll 8
    for (int k0 = 0; k0 < 128; k0 += 4) {
      const float4 a4 = *(const float4*)(arow + k0);
      const float b0 = bcol[(size_t)k0 * 32], b1 = bcol[(size_t)(k0 + 2) * 32];
      acc = __builtin_amdgcn_mfma_f32_32x32x2f32(lh ? a4.y : a4.x, b0, acc, 0, 0, 0);
      acc = __builtin_amdgcn_mfma_f32_32x32x2f32(lh ? a4.w : a4.z, b1, acc, 0, 0, 0);
    }
#pragma unroll
    for (int r = 0; r < 16; ++r) part[(wave * 32 + crow(r, lh)) * 33 + lr] = acc[r];
    __syncthreads();
    if (tid < 32) {
      const float myrstd = rstds[tid];
      float lv[32];
#pragma unroll
      for (int e = 0; e < 32; ++e) {
        float a = 0.f;
#pragma unroll
        for (int w = 0; w < 8; ++w) a += part[(w * 32 + tid) * 33 + e];
        lv[e] = a * myrstd + p.b_router[e];
      }
      float tv[4];
      int te[4];
#pragma unroll
      for (int k = 0; k < 4; ++k) {
        float bv = lv[0];
        int bi = 0;
#pragma unroll
        for (int e = 1; e < 32; ++e)
          if (lv[e] > bv) { bv = lv[e]; bi = e; }
        tv[k] = bv;
        te[k] = bi;
#pragma unroll
        for (int e = 0; e < 32; ++e)
          if (e == bi) lv[e] = -3.0e38f;
      }
      const float e1 = __expf(tv[1] - tv[0]), e2 = __expf(tv[2] - tv[0]), e3 = __expf(tv[3] - tv[0]);
      const float inv = 1.f / (1.f + e1 + e2 + e3);
      const size_t rr = (size_t)(r0 + tid) * 4;
      TOPE[rr + 0] = te[0]; TOPE[rr + 1] = te[1]; TOPE[rr + 2] = te[2]; TOPE[rr + 3] = te[3];
      GATEV[rr + 0] = inv; GATEV[rr + 1] = e1 * inv; GATEV[rr + 2] = e2 * inv; GATEV[rr + 3] = e3 * inv;
      lp0 = atomicAdd(&lhist[te[0]], 1); lp1 = atomicAdd(&lhist[te[1]], 1); lp2 = atomicAdd(&lhist[te[2]], 1); lp3 = atomicAdd(&lhist[te[3]], 1);
      xe0 = te[0]; xe1 = te[1]; xe2 = te[2]; xe3 = te[3];
    }
    __syncthreads();
    if (tid < 32) {
      const int c = lhist[tid];
      lbase[tid] = (c > 0) ? atomicAdd(&CNT[tid * CNTS], c) : 0;
    }
    __syncthreads();
    if (tid < 32) {
      const size_t rr = (size_t)(r0 + tid) * 4;
      POS[rr + 0] = lbase[xe0] + lp0; POS[rr + 1] = lbase[xe1] + lp1; POS[rr + 2] = lbase[xe2] + lp2; POS[rr + 3] = lbase[xe3] + lp3;
    }
  }
}
DI void phase_lists(const Params& p) {
  const int* CNT = (const int*)(p.ws + OFF_CNT);
  const int* TOPE = (const int*)(p.ws + OFF_TOPE);
  const float* GATEV = (const float*)(p.ws + OFF_GATEV);
  const int* POS = (const int*)(p.ws + OFF_POS);
  int* SLOT = (int*)(p.ws + OFF_SLOT);
  int* LTOK = (int*)(p.ws + OFF_LTOK);
  float* LGATE = (float*)(p.ws + OFF_LGATE);
  for (int a = blockIdx.x * NTHREADS + otid(p); a < NASG; a += gridDim.x * NTHREADS) {
    const int e = TOPE[a];
    int off = 0;
    for (int j = 0; j < e; ++j) off += CNT[j * CNTS];
    const int slot = off + POS[a];
    SLOT[a] = slot;
    LTOK[slot] = a >> 2;
    LGATE[slot] = GATEV[a];
  }
}
DI void phase_combine(const Params& p) {
  const float* H1 = (const float*)(p.ws + OFF_H1);
  const unsigned short* Y = (const unsigned short*)(p.ws + OFF_Y);
  const int* SLOT = (const int*)(p.ws + OFF_SLOT);
  for (int idx = blockIdx.x * NTHREADS + otid(p); idx < NR * 256; idx += gridDim.x * NTHREADS) {
    const int r = idx >> 8, c4 = (idx & 255) * 4;
    float4 a = *(const float4*)(H1 + (size_t)r * 1024 + c4);
#pragma unroll
    for (int k = 0; k < 4; ++k) {
      const int slot = SLOT[r * 4 + k];
      uint2 y = *(const uint2*)(Y + (size_t)slot * 1024 + c4);
      a.x += bf2f((unsigned short)(y.x & 0xffffu));
      a.y += bf2f((unsigned short)(y.x >> 16));
      a.z += bf2f((unsigned short)(y.y & 0xffffu));
      a.w += bf2f((unsigned short)(y.y >> 16));
    }
    *(float4*)(p.out + (size_t)r * 1024 + c4) = a;
  }
}


#define XB_TMO      128
#define XB_XCNT(j)  (256  + 64 * (j))
#define XB_XSUB(j)  (1280 + 64 * (j))
#define XB_XGEN(j)  (2304 + 64 * (j))
#define XB_TOP      3328
#define XB_TOPGEN   3392
#define XB_SPIN_CAP (1u << 22)
DI unsigned xb_ld(unsigned* p) { return __hip_atomic_load(p, __ATOMIC_RELAXED, __HIP_MEMORY_SCOPE_AGENT); }
DI unsigned xb_add(unsigned* p, unsigned v) { return __hip_atomic_fetch_add(p, v, __ATOMIC_RELAXED, __HIP_MEMORY_SCOPE_AGENT); }
DI unsigned xb_xcc_id() { return (unsigned)__builtin_amdgcn_s_getreg((3 << 11) | 20) & 0xFu; }
#define XB_SPIN(cond, bar) do { unsigned _sp = 0; while (cond) { __builtin_amdgcn_s_sleep(1); \
    if ((++_sp & 255u) == 0u) { if (xb_ld(&(bar)[XB_TMO])) break; if (_sp > XB_SPIN_CAP) { atomicAdd(&(bar)[XB_TMO], 1u); break; } } } } while (0)
struct XcdBarrier { unsigned* bar; unsigned x; volatile LAS unsigned* st; bool leader; };
DI void xcd_barrier_complete(unsigned* bar, unsigned x, unsigned& nloc, unsigned& nx) {
  const unsigned G = gridDim.x * gridDim.y * gridDim.z;
  unsigned sum, cnt, mine, sp = 0u;
  for (;;) {
    sum = 0u; cnt = 0u; mine = 0u;
#pragma unroll
    for (unsigned j = 0; j < 16; ++j) { const unsigned c = xb_ld(&bar[XB_XCNT(j)]); sum += c; cnt += (c > 0u) ? 1u : 0u; mine = (j == x) ? c : mine; }
    if (sum == G) break;
    __builtin_amdgcn_s_sleep(1);
    if ((++sp & 255u) == 0u) { if (xb_ld(&bar[XB_TMO])) break; if (sp > XB_SPIN_CAP) { atomicAdd(&bar[XB_TMO], 1u); break; } }
  }
  nloc = mine > 0u ? mine : 1u; nx = cnt > 0u ? cnt : 1u;
}
DI void xcd_barrier(const XcdBarrier& b) {
  asm volatile("s_waitcnt vmcnt(0)" ::: "memory");
  __syncthreads();
  if (b.leader) {
    unsigned* bar = b.bar;
    __builtin_amdgcn_s_waitcnt(0);
    unsigned nloc = b.st[0], nx = b.st[1];
    if (nloc == 0u) { xcd_barrier_complete(bar, b.x, nloc, nx); b.st[0] = nloc; b.st[1] = nx; }
    const unsigned old = xb_add(&bar[XB_XSUB(b.x)], 1u);
    const unsigned gen = old / nloc;
    if (old + 1u == (gen + 1u) * nloc) {
      __builtin_amdgcn_fence(__ATOMIC_RELEASE, "agent");
      asm volatile("s_waitcnt vmcnt(0)" ::: "memory");
      const unsigned og = xb_add(&bar[XB_TOP], 1u);
      const unsigned tg = og / nx;
      if (og + 1u == (tg + 1u) * nx) xb_add(&bar[XB_TOPGEN], 1u);
      else XB_SPIN(xb_ld(&bar[XB_TOPGEN]) == tg, bar);
      __builtin_amdgcn_fence(__ATOMIC_ACQUIRE, "agent");
      xb_add(&bar[XB_XGEN(b.x)], 1u);
      asm volatile("s_waitcnt vmcnt(0)" ::: "memory");
    } else {
      XB_SPIN(xb_ld(&bar[XB_XGEN(b.x)]) == gen, bar);
      __builtin_amdgcn_fence(__ATOMIC_ACQUIRE, "agent");
      asm volatile("s_waitcnt vmcnt(0)" ::: "memory");
    }
  }
  __syncthreads();
}

constexpr int SMEM_BYTES = g8::STAGE_BYTES + 1024;

__global__ void __launch_bounds__(NTHREADS) mk(Params p0) {
  __shared__ __attribute__((aligned(16))) char smem[SMEM_BYTES];
  Params p = p0;
  p.wv = __builtin_amdgcn_readfirstlane((int)(threadIdx.x >> 6));
  XcdBarrier xb;
  {
    volatile LAS unsigned* st = (volatile LAS unsigned*)((LAS unsigned char*)smem + g8::STAGE_BYTES + 768);
    if (threadIdx.x == 0) { st[0] = 0u; st[1] = 0u; }
    __syncthreads();
    xb.bar = (unsigned*)(p.ws + OFF_BAR); xb.x = xb_xcc_id(); xb.st = st; xb.leader = (threadIdx.x == 0);
    if (xb.leader) (void)xb_add(&xb.bar[XB_XCNT(xb.x)], 1u);
  }
  phase_prep(p);
  phase_wconv(p, 0, WC_SMALL);
  xcd_barrier(xb);
  g8::gemm_phase<0>(p, smem);
  wconv_fill(p, smem, 0, false);
  xcd_barrier(xb);
  phase_post1(p, smem);
  xcd_barrier(xb);
  g8::gemm_phase<1>(p, smem);
  phase_chunkprep(p, smem);
  wconv_fill(p, smem, 1, false);
  xcd_barrier(xb);
  if (blockIdx.x < 16) scan_block(p, smem, blockIdx.x, 0, NCH);
  phase_post2(p, smem);
  phase_indexer(p, smem);
  wconv_fill(p, smem, 2, false);
  xcd_barrier(xb);
  phase_gnorm(p);
  phase_scan_attn(p, smem);
  wconv_fill(p, smem, 3, false);
  xcd_barrier(xb);
  g8::gemm_phase<2>(p, smem);
  xcd_barrier(xb);
  phase_router(p, smem);
  xcd_barrier(xb);
  phase_lists(p);
  wconv_fill(p, smem, 4, true);
  xcd_barrier(xb);
  g8::gemm_phase<3>(p, smem);
  xcd_barrier(xb);
  g8::gemm_phase<4>(p, smem);
  xcd_barrier(xb);
  phase_combine(p);
}

extern "C" void kernel_launch(void* const* d_in, const int* in_sizes, int n_in, void* d_out, int out_size, void* d_ws,
                              size_t ws_size, hipStream_t stream) {
  (void)in_sizes; (void)n_in; (void)out_size;
  if (ws_size < WS_NEED) return;
  Params p{};
  p.x = (const float*)d_in[0]; p.meta = (const float*)d_in[1]; p.norm_mix_w = (const float*)d_in[2];
  p.w_in = (const float*)d_in[3]; p.q_norm_w = (const float*)d_in[4]; p.k_norm_w = (const float*)d_in[5];
  p.kv_norm_w = (const float*)d_in[6]; p.w_kv_up = (const float*)d_in[7]; p.conv_w = (const float*)d_in[8];
  p.a_log = (const float*)d_in[9]; p.dt_bias = (const float*)d_in[10]; p.delta_norm_w = (const float*)d_in[11];
  p.w_out = (const float*)d_in[12]; p.norm_ffn_w = (const float*)d_in[13]; p.w_router = (const float*)d_in[14];
  p.b_router = (const float*)d_in[15]; p.w_gate_up = (const float*)d_in[16]; p.b_gate_up = (const float*)d_in[17];
  p.w_down = (const float*)d_in[18]; p.b_down = (const float*)d_in[19];
  p.out = (float*)d_out;
  p.ws = (char*)d_ws;
  (void)hipMemsetAsync((char*)d_ws + OFF_CNT, 0, 4096, stream);
  (void)hipMemsetAsync((char*)d_ws + OFF_BAR, 0, 16384, stream);
  static int grid_blocks = 0;
  if (!grid_blocks) {
    int dev = 0, cus = 0, per_cu = 0;
    (void)hipGetDevice(&dev);
    (void)hipDeviceGetAttribute(&cus, hipDeviceAttributeMultiprocessorCount, dev);
    (void)hipOccupancyMaxActiveBlocksPerMultiprocessor(&per_cu, mk, NTHREADS, 0);
    if (per_cu > 1) per_cu = 1;
    grid_blocks = cus * per_cu;
  }
  void* args[] = {&p};
  hipError_t e = hipLaunchCooperativeKernel((void*)mk, dim3(grid_blocks), dim3(NTHREADS), args, 0, stream);
  if (e != hipSuccess) fprintf(stderr, "cooperative launch failed: %s (grid %d)\n", hipGetErrorString(e), grid_blocks);
}
```

```cpp
#include <hip/hip_runtime.h>
#include <stdint.h>
#include <stdio.h>


typedef __attribute__((ext_vector_type(8))) short bf16x8;
typedef __attribute__((ext_vector_type(4))) short s16x4;
typedef __attribute__((ext_vector_type(16))) float f32x16;
typedef __attribute__((ext_vector_type(4))) float f32x4;
typedef __bf16 bf2_t __attribute__((ext_vector_type(2)));
#define DI __device__ __forceinline__
#define MFMA32(a, b, c) __builtin_amdgcn_mfma_f32_32x32x16_bf16((a), (b), (c), 0, 0, 0)
#define MFMA16(a, b, c) __builtin_amdgcn_mfma_f32_16x16x32_bf16((a), (b), (c), 0, 0, 0)

constexpr int NB = 4, SEQ = 4096, NM = 16, T = 4112, NT = NB * T, NR = NB * SEQ, D = 1024, INC = 3408;
constexpr int C_AQ = 0, C_CKV = 512, C_IQ = 768, C_IK = 1280, C_IW = 1344, C_BQKV = 1352, C_BZ = 2888, C_BBETA = 3400, C_BA = 3404;
constexpr int NCH = 65, NCHT = NB * 4 * NCH;
constexpr int NEXP = 32, NASG = NR * 4;
constexpr int CNTS = 32;
constexpr int NTHREADS = 512, NWAVES = 8;

constexpr size_t al256(size_t x) { return (x + 255) & ~(size_t)255; }
constexpr size_t OFF_U = 0;
constexpr int NTP = 16640;
constexpr size_t OFF_P = OFF_U + al256((size_t)NTP * 1024 * 2);
constexpr size_t OFF_ROPE = OFF_P + al256((size_t)NT * INC * 4);
constexpr size_t OFF_QB = OFF_ROPE + al256((size_t)T * 64 * 4);
constexpr size_t OFF_KB = OFF_QB + al256((size_t)NT * 512 * 2);
constexpr size_t OFF_VT = OFF_KB + al256((size_t)NT * 512 * 2);
constexpr size_t OFF_QI = OFF_VT + al256((size_t)NT * 512 * 2);
constexpr size_t OFF_KI = OFF_QI + al256((size_t)NT * 512 * 2);
constexpr size_t OFF_WI = OFF_KI + al256((size_t)NT * 64 * 2);
constexpr size_t OFF_CKV = OFF_WI + al256((size_t)NT * 8 * 4);
constexpr size_t OFF_KV = OFF_CKV + al256((size_t)NTP * 256 * 2);
constexpr size_t OFF_MASK = OFF_KV + al256((size_t)NT * 1024 * 4);
constexpr size_t OFF_MIX = OFF_MASK + al256((size_t)NB * SEQ * 128 * 4);
constexpr size_t OFF_QD = OFF_MIX + al256((size_t)NT * 1024 * 2);
constexpr size_t OFF_KD = OFF_QD + al256((size_t)NT * 512 * 4);
constexpr size_t OFF_VD = OFF_KD + al256((size_t)NT * 512 * 4);
constexpr size_t OFF_BETA = OFF_VD + al256((size_t)NT * 512 * 4);
constexpr size_t OFF_G = OFF_BETA + al256((size_t)NT * 4 * 4);
constexpr int CHB_ELEMS = 30720, CH_QG = 8704, CH_KDT = 17408, CH_IN = 26112;
constexpr size_t OFF_WN = OFF_G + al256((size_t)NT * 4 * 4);
constexpr size_t OFF_UU = OFF_WN + al256((size_t)NCHT * CHB_ELEMS * 2);
constexpr size_t OFF_DL = OFF_UU + al256((size_t)NCHT * 64 * 128 * 4);
constexpr size_t OFF_OD = OFF_DL + al256((size_t)NCHT * 4);
constexpr size_t OFF_U2 = OFF_OD + al256((size_t)NT * 512 * 4);
constexpr size_t OFF_TOPE = OFF_U2 + al256((size_t)NR * 1024 * 2);
constexpr size_t OFF_GATEV = OFF_TOPE + al256((size_t)NR * 4 * 4);
constexpr size_t OFF_POS = OFF_GATEV + al256((size_t)NR * 4 * 4);
constexpr size_t OFF_SLOT = OFF_POS + al256((size_t)NR * 4 * 4);
constexpr size_t OFF_LTOK = OFF_SLOT + al256((size_t)NR * 4 * 4);
constexpr size_t OFF_LGATE = OFF_LTOK + al256((size_t)NASG * 4);
constexpr size_t OFF_WTIN = OFF_LGATE + al256((size_t)NASG * 4);
constexpr size_t OFF_WTKV = OFF_WTIN + al256((size_t)3584 * 1024 * 2);
constexpr size_t OFF_WTOUT = OFF_WTKV + al256((size_t)1024 * 256 * 2);
constexpr size_t OFF_WTGU = OFF_WTOUT + al256((size_t)1024 * 1024 * 2);
constexpr size_t OFF_WTDN = OFF_WTGU + al256((size_t)32 * 2048 * 1024 * 2);
constexpr size_t OFF_CNT = OFF_WTDN + al256((size_t)32 * 1024 * 1024 * 2);
constexpr size_t OFF_Y = OFF_QD;
static_assert(OFF_U2 - OFF_QD >= (size_t)NASG * 1024 * 2, "Y alias does not fit");
static_assert((size_t)(NASG + 256) * 1024 * 2 <= (size_t)NT * INC * 4, "HD alias does not fit");
constexpr size_t OFF_WRS = OFF_CNT + 4096;
constexpr size_t OFF_SST = OFF_WRS + 131072;
constexpr size_t OFF_BAR = OFF_SST + (size_t)16 * 4 * 64 * 64 * 4;
constexpr size_t WS_NEED = OFF_BAR + 16384;
constexpr size_t OFF_H1 = OFF_KV;
constexpr size_t OFF_HD = OFF_P;

struct Params {
  const float *x, *meta, *norm_mix_w, *w_in, *q_norm_w, *k_norm_w, *kv_norm_w, *w_kv_up, *conv_w, *a_log, *dt_bias,
      *delta_norm_w, *w_out, *norm_ffn_w, *w_router, *b_router, *w_gate_up, *b_gate_up, *w_down, *b_down;
  float* out;
  char* ws;
  int wv;
  int pad0;
};

#define LAS __attribute__((address_space(3)))
constexpr int STAGE_LDS_BYTES = 131072;
DI unsigned pk2(float a, float b) { bf2_t v; v[0] = (__bf16)a; v[1] = (__bf16)b; return __builtin_bit_cast(unsigned, v); }
DI unsigned short f2bf(float a) { return (unsigned short)(pk2(a, 0.f) & 0xffffu); }
DI float bf2f(unsigned short u) { return __uint_as_float(((unsigned)u) << 16); }
template <int CTRL> DI float dppf(float v) { return __builtin_bit_cast(float, __builtin_amdgcn_update_dpp(0, __builtin_bit_cast(int, v), CTRL, 0xf, 0xf, false)); }
template <int CTRL> DI int dppi(int v) { return __builtin_amdgcn_update_dpp(0, v, CTRL, 0xf, 0xf, false); }
DI float rlf(float v, int l) { return __builtin_bit_cast(float, __builtin_amdgcn_readlane(__builtin_bit_cast(int, v), l)); }
DI float wave_sum(float v) {
  v += dppf<0xB1>(v); v += dppf<0x4E>(v); v += dppf<0x141>(v); v += dppf<0x140>(v);
  return (rlf(v, 0) + rlf(v, 16)) + (rlf(v, 32) + rlf(v, 48));
}
DI float xor32f(float v, int lane) {
  auto r = __builtin_amdgcn_permlane32_swap(__builtin_bit_cast(unsigned, v), __builtin_bit_cast(unsigned, v), false, false);
  return __builtin_bit_cast(float, (lane < 32) ? r[1] : r[0]);
}
DI float xor16f(float v, int lane) {
  auto r = __builtin_amdgcn_permlane16_swap(__builtin_bit_cast(unsigned, v), __builtin_bit_cast(unsigned, v), false, false);
  return __builtin_bit_cast(float, (lane & 16) ? r[0] : r[1]);
}
DI int otid(const Params& p) {
  int l;
  asm volatile("v_mbcnt_lo_u32_b32 %0, -1, 0\n\tv_mbcnt_hi_u32_b32 %0, -1, %0" : "=v"(l));
  return (p.wv << 6) | l;
}
DI int swzA(int row, int col) { return row * 132 + col; }
DI int swzB(int row, int col) { return row * 68 + col; }
DI int crow(int reg, int h) { return (reg & 3) + 8 * (reg >> 2) + 4 * h; }
DI bf16x8 pack8(const f32x16& x, int s) {
  uint4 p;
  p.x = pk2(x[8 * s + 0], x[8 * s + 1]); p.y = pk2(x[8 * s + 2], x[8 * s + 3]);
  p.z = pk2(x[8 * s + 4], x[8 * s + 5]); p.w = pk2(x[8 * s + 6], x[8 * s + 7]);
  return __builtin_bit_cast(bf16x8, p);
}
DI bf16x8 ld8x2(const unsigned short* p0, const unsigned short* p1) {
  uint2 a = *(const uint2*)p0, b = *(const uint2*)p1;
  uint4 r = make_uint4(a.x, a.y, b.x, b.y);
  return __builtin_bit_cast(bf16x8, r);
}
DI bf16x8 ld16(const unsigned short* p) { uint4 r = *(const uint4*)p; return __builtin_bit_cast(bf16x8, r); }
DI const float* hrow(const Params& p, int tok) {
  int b = tok / T, t = tok - b * T;
  return (t < NM) ? (p.meta + (size_t)t * D) : (p.x + ((size_t)b * SEQ + (t - NM)) * D);
}

DI void phase_prep(const Params& p) {
  const int tid = otid(p), lane = tid & 63, wave = tid >> 6;
  float* rope = (float*)(p.ws + OFF_ROPE);
  for (int idx = blockIdx.x * NTHREADS + tid; idx < T * 32; idx += gridDim.x * NTHREADS) {
    int t = idx >> 5, i = idx & 31;
    float inv = (float)pow(10000.0, -(double)i / 32.0);
    float ang = (float)t * inv;
    double ad = (double)ang;
    double n = rint(ad * 0.15915494309189535);
    float r = (float)(ad - n * 6.283185307179586);
    float sn, cs;
    sincosf(r, &sn, &cs);
    rope[t * 64 + i] = cs;
    rope[t * 64 + 32 + i] = sn;
  }
  float* wrs = (float*)(p.ws + OFF_WRS);
  for (int idx = blockIdx.x * NTHREADS + tid; idx < 1024 * 32; idx += gridDim.x * NTHREADS) wrs[idx] = p.norm_ffn_w[idx >> 5] * p.w_router[idx];
  unsigned short* U = (unsigned short*)(p.ws + OFF_U);
  for (int tok = blockIdx.x * NWAVES + wave; tok < NT; tok += gridDim.x * NWAVES) {
    const float* src = hrow(p, tok);
    float4 v[4];
    float ss = 0.f;
#pragma unroll
    for (int i = 0; i < 4; ++i) {
      v[i] = *(const float4*)(src + lane * 4 + 256 * i);
      ss += v[i].x * v[i].x + v[i].y * v[i].y + v[i].z * v[i].z + v[i].w * v[i].w;
    }
    ss = wave_sum(ss);
    float rstd = rsqrtf(ss * (1.f / 1024.f) + 1e-6f);
#pragma unroll
    for (int i = 0; i < 4; ++i) {
      float4 w = *(const float4*)(p.norm_mix_w + lane * 4 + 256 * i);
      uint2 o;
      o.x = pk2(v[i].x * rstd * w.x, v[i].y * rstd * w.y);
      o.y = pk2(v[i].z * rstd * w.z, v[i].w * rstd * w.w);
      *(uint2*)(U + (size_t)tok * 1024 + lane * 4 + 256 * i) = o;
    }
  }
}

DI void wconv_task2(const float* src, unsigned short* dst, int K, int N, int k0, int n0, int tid) {
  const int kg = tid >> 6, n = n0 + (tid & 63) * 4, k = k0 + kg * 8;
  float4 v[8];
#pragma unroll
  for (int i = 0; i < 8; ++i) {
    v[i] = make_float4(0.f, 0.f, 0.f, 0.f);
    if (n < N) v[i] = *(const float4*)(src + (size_t)(k + i) * N + n);
  }
  uint4 o;
  o.x = pk2(v[0].x, v[1].x); o.y = pk2(v[2].x, v[3].x); o.z = pk2(v[4].x, v[5].x); o.w = pk2(v[6].x, v[7].x);
  *(uint4*)(dst + (size_t)(n + 0) * K + k) = o;
  o.x = pk2(v[0].y, v[1].y); o.y = pk2(v[2].y, v[3].y); o.z = pk2(v[4].y, v[5].y); o.w = pk2(v[6].y, v[7].y);
  *(uint4*)(dst + (size_t)(n + 1) * K + k) = o;
  o.x = pk2(v[0].z, v[1].z); o.y = pk2(v[2].z, v[3].z); o.z = pk2(v[4].z, v[5].z); o.w = pk2(v[6].z, v[7].z);
  *(uint4*)(dst + (size_t)(n + 2) * K + k) = o;
  o.x = pk2(v[0].w, v[1].w); o.y = pk2(v[2].w, v[3].w); o.z = pk2(v[4].w, v[5].w); o.w = pk2(v[6].w, v[7].w);
  *(uint4*)(dst + (size_t)(n + 3) * K + k) = o;
}
constexpr int WC_IN = 16 * 14, WC_KV = 4 * 4, WC_OUT = 16 * 4, WC_GU = 32 * 128, WC_DN = 32 * 64;
constexpr int WC_SMALL = WC_IN + WC_KV + WC_OUT, WC_ALL = WC_SMALL + WC_GU + WC_DN;
DI void wconv_task(const Params& p, int t, int tid) {
  if (t < WC_IN) {
    wconv_task2(p.w_in, (unsigned short*)(p.ws + OFF_WTIN), 1024, INC, (t / 14) * 64, (t % 14) * 256, tid);
  } else if (t < WC_IN + WC_KV) {
    t -= WC_IN;
    wconv_task2(p.w_kv_up, (unsigned short*)(p.ws + OFF_WTKV), 256, 1024, (t >> 2) * 64, (t & 3) * 256, tid);
  } else if (t < WC_SMALL) {
    t -= WC_IN + WC_KV;
    wconv_task2(p.w_out, (unsigned short*)(p.ws + OFF_WTOUT), 1024, 1024, (t >> 2) * 64, (t & 3) * 256, tid);
  } else if (t < WC_SMALL + WC_GU) {
    t -= WC_SMALL;
    const int e = t >> 7, r = t & 127;
    wconv_task2(p.w_gate_up + (size_t)e * 1024 * 2048, (unsigned short*)(p.ws + OFF_WTGU) + (size_t)e * 2048 * 1024, 1024, 2048,
                (r >> 3) * 64, (r & 7) * 256, tid);
  } else {
    t -= WC_SMALL + WC_GU;
    const int e = t >> 6, r = t & 63;
    wconv_task2(p.w_down + (size_t)e * 1024 * 1024, (unsigned short*)(p.ws + OFF_WTDN) + (size_t)e * 1024 * 1024, 1024, 1024,
                (r >> 2) * 64, (r & 3) * 256, tid);
  }
}
DI void wconv_fill(const Params& p, char* smem, int site, bool drain) {
  unsigned* q = (unsigned*)(p.ws + OFF_BAR + 15872 + 128);
  volatile LAS int* slot = (volatile LAS int*)((LAS unsigned char*)smem + STAGE_LDS_BYTES + 832);
  const int tid = otid(p);
  __syncthreads();
  if (tid == 0 && !drain) (void)__hip_atomic_fetch_add(&q[16 + site], 1u, __ATOMIC_RELAXED, __HIP_MEMORY_SCOPE_AGENT);
  for (;;) {
    __syncthreads();
    if (tid == 0) {
      int t = -1;
      const bool all_done = !drain && __hip_atomic_load(&q[16 + site], __ATOMIC_RELAXED, __HIP_MEMORY_SCOPE_AGENT) >= gridDim.x;
      if (!all_done) t = WC_SMALL + (int)__hip_atomic_fetch_add(&q[0], 1u, __ATOMIC_RELAXED, __HIP_MEMORY_SCOPE_AGENT);
      *slot = t;
    }
    __syncthreads();
    const int t = __builtin_amdgcn_readfirstlane(*slot);
    if (t < 0 || t >= WC_ALL) break;
    wconv_task(p, t, tid);
  }
}
DI void phase_wconv(const Params& p, int t0, int t1) {
  const int tid = otid(p);
  for (int t = t0 + blockIdx.x; t < t1; t += gridDim.x) wconv_task(p, t, tid);
}

namespace g8 {
constexpr int BM = 256, BK = 64, HALF = 128, HTB = HALF * BK * 2, STAGE_BYTES = 8 * HTB, NXCD = 8, WGM = 8;
constexpr int TAB_OFF = STAGE_BYTES;
constexpr int MAXU = 24;
DI int lds_byte(int r, int c) { const int st = (r >> 4) * 2 + (c >> 5), rr = r & 15, cc = c & 31, ob = rr * 64 + cc * 2; return st * 1024 + (ob ^ (((ob >> 9) & 1) << 5)); }
DI void stage_rc(int b, int& R, int& C) { const int st = b / 1024, sb = b % 1024, swz = sb ^ (((sb >> 9) & 1) << 5); R = (st >> 1) * 16 + swz / 64; C = (st & 1) * 32 + (swz % 64) / 2; }
DI int perm32(int rho) { const int n = rho >> 4, i = rho & 15; return 8 * (i >> 2) + 4 * n + (i & 3); }
DI int xcd_remap(int L, int nwg) { const int q = nwg / NXCD, r = nwg % NXCD, xcd = L % NXCD, off = L / NXCD; return (xcd < r ? xcd * (q + 1) : r * (q + 1) + (xcd - r) * q) + off; }
struct UnitT { int valid, arow, mend, pn, e, orow; };

template <int MODE> DI int n_units(const Params& p) {
  if (MODE == 0) return 65 * 14;
  if (MODE == 1) return 65 * 4;
  if (MODE == 2) return 64 * 4;
  const int* cnt = (const int*)(p.ws + OFF_CNT);
  int n = 0;
  for (int e = 0; e < NEXP; ++e) n += ((cnt[e * CNTS] + 255) >> 8) * (MODE == 3 ? 8 : 4);
  return n;
}
template <int MODE> DI void unit_of(const Params& p, int L, int nwg, UnitT& u) {
  u.valid = 0; u.arow = 0; u.mend = 0; u.pn = 0; u.e = 0; u.orow = 0;
  if (L >= nwg) return;
  const int wgid = xcd_remap(L, nwg);
  u.valid = 1;
  if (MODE <= 2) {
    const int nM = (MODE == 2) ? 64 : 65, nN = (MODE == 0) ? 14 : 4;
    const int nig = WGM * nN, gid = wgid / nig, fm = gid * WGM, gsz = (nM - fm) < WGM ? (nM - fm) : WGM;
    const int pm = fm + ((wgid % nig) % gsz);
    u.pn = (wgid % nig) / gsz;
    u.orow = pm * 256;
    u.arow = (MODE == 2) ? (pm * 256 + 16 * (pm / 16 + 1)) : pm * 256;
    u.mend = (MODE == 2) ? NR : NT;
  } else {
    const int* cnt = (const int*)(p.ws + OFF_CNT);
    constexpr int NTN = (MODE == 3) ? 8 : 4;
    int id = wgid, sbase = 0;
    for (int e = 0; e < NEXP; ++e) {
      const int c = cnt[e * CNTS], mts = (c + 255) >> 8, ne = mts * NTN;
      if (id < ne) {
        const int tn = id / mts, tm = id - tn * mts;
        u.e = e; u.pn = tn; u.arow = sbase + tm * 256; u.orow = u.arow; u.mend = sbase + c;
        return;
      }
      id -= ne;
      sbase += c;
    }
    u.valid = 0;
  }
}
DI float swiglu(float g, float u) {
  g = fminf(g, 7.0f);
  u = fminf(fmaxf(u, -7.0f), 7.0f);
  return g / (1.f + __expf(-1.702f * g)) * (u + 1.f);
}
template <int MODE>
DI void epilogue(const Params& p, const f32x4 (&acc)[2][2][4][2], const UnitT& u, int wr, int wc, int fr, int fq) {
  constexpr bool PERM = (MODE >= 3);
  const int row0 = u.orow + wr * 64 + fr;
  const int col0 = u.pn * 256 + wc * 32 + (PERM ? 8 * fq : 4 * fq);
  if (MODE == 0 || MODE == 1 || MODE == 2) {
    float* C = (float*)(p.ws + (MODE == 0 ? OFF_P : MODE == 1 ? OFF_KV : OFF_H1));
    const int ldc = (MODE == 0) ? INC : 1024;
#pragma unroll
    for (int ai = 0; ai < 2; ++ai)
#pragma unroll
      for (int m = 0; m < 4; ++m) {
        const int row = row0 + ai * 128 + m * 16;
        if (row < u.mend) {
#pragma unroll
          for (int bj = 0; bj < 2; ++bj)
#pragma unroll
            for (int n = 0; n < 2; ++n) {
              const int col = col0 + bj * 128 + n * 16;
              if (MODE != 0 || col < INC) {
                f32x4 v = acc[ai][bj][m][n];
                if (MODE == 2) v += *(const f32x4*)(p.x + (size_t)row * D + col);
                *(f32x4*)(C + (size_t)row * ldc + col) = v;
              }
            }
        }
      }
  } else if (MODE == 3) {
    unsigned short* HD = (unsigned short*)(p.ws + OFF_HD);
    f32x4 bv[2][2];
#pragma unroll
    for (int bj = 0; bj < 2; ++bj)
#pragma unroll
      for (int n = 0; n < 2; ++n) bv[bj][n] = *(const f32x4*)(p.b_gate_up + (size_t)u.e * 2048 + col0 + bj * 128 + 4 * n);
#pragma unroll
    for (int ai = 0; ai < 2; ++ai)
#pragma unroll
      for (int m = 0; m < 4; ++m) {
        const int row = row0 + ai * 128 + m * 16;
        if (row < u.mend) {
#pragma unroll
          for (int bj = 0; bj < 2; ++bj) {
            const f32x4 v0 = acc[ai][bj][m][0] + bv[bj][0], v1 = acc[ai][bj][m][1] + bv[bj][1];
            uint2 o;
            o.x = pk2(swiglu(v0[0], v0[1]), swiglu(v0[2], v0[3]));
            o.y = pk2(swiglu(v1[0], v1[1]), swiglu(v1[2], v1[3]));
            *(uint2*)(HD + (size_t)row * 1024 + (col0 + bj * 128) / 2) = o;
          }
        }
      }
  } else {
    unsigned short* Y = (unsigned short*)(p.ws + OFF_Y);
    const float* lgate = (const float*)(p.ws + OFF_LGATE);
    f32x4 bv[2][2];
#pragma unroll
    for (int bj = 0; bj < 2; ++bj)
#pragma unroll
      for (int n = 0; n < 2; ++n) bv[bj][n] = *(const f32x4*)(p.b_down + (size_t)u.e * 1024 + col0 + bj * 128 + 4 * n);
#pragma unroll
    for (int ai = 0; ai < 2; ++ai)
#pragma unroll
      for (int m = 0; m < 4; ++m) {
        const int row = row0 + ai * 128 + m * 16;
        if (row < u.mend) {
          const float gt = lgate[row];
#pragma unroll
          for (int bj = 0; bj < 2; ++bj) {
            const f32x4 v0 = (acc[ai][bj][m][0] + bv[bj][0]) * gt, v1 = (acc[ai][bj][m][1] + bv[bj][1]) * gt;
            uint4 o;
            o.x = pk2(v0[0], v0[1]); o.y = pk2(v0[2], v0[3]); o.z = pk2(v1[0], v1[1]); o.w = pk2(v1[2], v1[3]);
            *(uint4*)(Y + (size_t)row * 1024 + col0 + bj * 128) = o;
          }
        }
      }
  }
}

template <int MODE>
DI void gemm_phase(const Params& p, char* smem) {
  constexpr bool PERM = (MODE >= 3);
  constexpr int K = (MODE == 1) ? 256 : 1024, nt = K / BK;
  LAS unsigned char* lds = (LAS unsigned char*)smem;
  LAS int* tab = (LAS int*)(lds + TAB_OFF);
  const int tid = otid(p), wid = __builtin_amdgcn_readfirstlane(tid >> 6), lane = tid & 63, wr = wid >> 2, wc = wid & 3, fr = lane & 15, fq = lane >> 4;
  __syncthreads();
  {
    const int nwg = n_units<MODE>(p);
    for (int ti = 0; ti < MAXU; ++ti) {
      UnitT u;
      unit_of<MODE>(p, ti * (int)gridDim.x + (int)blockIdx.x, nwg, u);
      if (tid == 0) { tab[ti * 8 + 0] = u.valid; tab[ti * 8 + 1] = u.arow; tab[ti * 8 + 2] = u.mend; tab[ti * 8 + 3] = u.pn; tab[ti * 8 + 4] = u.e; tab[ti * 8 + 5] = u.orow; }
    }
  }
  __syncthreads();
#define G8_GETU(i, u) do { const int _i = (i); (u).valid = (_i < MAXU) ? __builtin_amdgcn_readfirstlane(tab[_i * 8 + 0]) : 0; (u).arow = __builtin_amdgcn_readfirstlane(tab[(_i < MAXU ? _i : 0) * 8 + 1]); \
    (u).mend = __builtin_amdgcn_readfirstlane(tab[(_i < MAXU ? _i : 0) * 8 + 2]); (u).pn = __builtin_amdgcn_readfirstlane(tab[(_i < MAXU ? _i : 0) * 8 + 3]); \
    (u).e = __builtin_amdgcn_readfirstlane(tab[(_i < MAXU ? _i : 0) * 8 + 4]); (u).orow = __builtin_amdgcn_readfirstlane(tab[(_i < MAXU ? _i : 0) * 8 + 5]); } while (0)
  UnitT cur, nxt;
  G8_GETU(0, cur);
  if (!cur.valid) return;
  const char* Abase = (const char*)(p.ws + (MODE == 0 ? OFF_U : MODE == 1 ? OFF_CKV : MODE == 2 ? OFF_MIX : MODE == 3 ? OFF_U2 : OFF_HD));
  const char* Bbase = (const char*)(p.ws + (MODE == 0 ? OFF_WTIN : MODE == 1 ? OFF_WTKV : MODE == 2 ? OFF_WTOUT : MODE == 3 ? OFF_WTGU : OFF_WTDN));
  constexpr size_t BEXP = (MODE == 3) ? (size_t)2048 * 1024 * 2 : (MODE == 4) ? (size_t)1024 * 1024 * 2 : 0;
  int Rr[2], Cc[2];
  unsigned voffB[2];
#pragma unroll
  for (int i = 0; i < 2; ++i) {
    stage_rc(tid * 16 + i * 8192, Rr[i], Cc[i]);
    const int Rb = PERM ? ((Rr[i] & ~31) + perm32(Rr[i] & 31)) : Rr[i];
    voffB[i] = (unsigned)(Rb * K + Cc[i]) * 2u;
  }
  unsigned voffA[2][2];
  const int* ltok = (const int*)(p.ws + OFF_LTOK);
#define G8_VOFFA(dst, un) do { _Pragma("unroll") for (int _h = 0; _h < 2; ++_h) _Pragma("unroll") for (int _i = 0; _i < 2; ++_i) { \
      if (MODE == 3) { int _s = (un).arow + _h * 128 + Rr[_i]; _s = _s < NASG ? _s : NASG - 1; dst[_h][_i] = (unsigned)(ltok[_s] * K + Cc[_i]) * 2u; } \
      else dst[_h][_i] = (unsigned)((_h * 128 + Rr[_i]) * K + Cc[_i]) * 2u; } } while (0)
  const size_t kstep = (size_t)(BK * 2);
  const size_t hstep = (size_t)HALF * K * 2;
  const size_t tstep = 2 * hstep;
  const unsigned ldsw = (unsigned)wid * 1024u;
  const int aoff = lds_byte(wr * 64 + fr, fq * 8), boff = lds_byte(wc * 32 + fr, fq * 8);
#define G8_SA(b, h) (((b) * 2 + (h)) * HTB)
#define G8_SB(b, h) ((4 + (b) * 2 + (h)) * HTB)
#define G8_STAGE(bufoff, gbase, voff) do { _Pragma("unroll") for (int _i = 0; _i < 2; ++_i) \
    __builtin_amdgcn_global_load_lds((const unsigned*)((const char*)(gbase) + (voff)[_i]), (LAS unsigned*)(lds + (bufoff) + ldsw + _i * 8192), 16, 0, 0); } while (0)
#define G8_LDA(dst, b, h) do { _Pragma("unroll") for (int m = 0; m < 4; ++m) _Pragma("unroll") for (int k = 0; k < 2; ++k) dst[m][k] = *(const LAS bf16x8*)(lds + G8_SA(b, h) + aoff + m * 2048 + k * 1024); } while (0)
#define G8_LDB(dst, b, h) do { _Pragma("unroll") for (int n = 0; n < 2; ++n) _Pragma("unroll") for (int k = 0; k < 2; ++k) dst[n][k] = *(const LAS bf16x8*)(lds + G8_SB(b, h) + boff + n * 2048 + k * 1024); } while (0)
#define G8_MMA(ai, bj, At, Bt) do { __builtin_amdgcn_s_setprio(1); _Pragma("unroll") for (int m = 0; m < 4; ++m) _Pragma("unroll") for (int n = 0; n < 2; ++n) _Pragma("unroll") for (int k = 0; k < 2; ++k) \
    acc[ai][bj][m][n] = __builtin_amdgcn_mfma_f32_16x16x32_bf16(Bt[n][k], At[m][k], acc[ai][bj][m][n], 0, 0, 0); __builtin_amdgcn_s_setprio(0); } while (0)
#define G8_WAIT_V(n) asm volatile("s_waitcnt vmcnt(" #n ")" ::: "memory")
#define G8_WAIT_L(n) asm volatile("s_waitcnt lgkmcnt(" #n ")" ::: "memory")
#define G8_BAR __builtin_amdgcn_s_barrier()
#define G8_SCHED __builtin_amdgcn_sched_barrier(0)
  int ui = 0;
  f32x4 acc[2][2][4][2];
#pragma unroll
  for (int a = 0; a < 2; ++a)
#pragma unroll
    for (int b = 0; b < 2; ++b)
#pragma unroll
      for (int m = 0; m < 4; ++m)
#pragma unroll
        for (int n = 0; n < 2; ++n) acc[a][b][m][n] = (f32x4){0.f, 0.f, 0.f, 0.f};
  bf16x8 At[4][2], B0[2][2], B1[2][2];
  G8_VOFFA(voffA, cur);
  if (MODE == 3) asm volatile("s_waitcnt vmcnt(0)" ::: "memory");
  const char* cA = (MODE == 3) ? Abase : Abase + (size_t)cur.arow * K * 2;
  const char* cB = Bbase + (size_t)cur.e * BEXP + (size_t)cur.pn * tstep;
  G8_STAGE(G8_SB(0, 0), cB, voffB); G8_STAGE(G8_SA(0, 0), cA, voffA[0]); G8_STAGE(G8_SB(0, 1), cB + hstep, voffB); G8_STAGE(G8_SA(0, 1), cA, voffA[1]);
  if (wr == 1) G8_BAR;
  G8_WAIT_V(4); G8_BAR;
  G8_STAGE(G8_SB(1, 0), cB + kstep, voffB); G8_STAGE(G8_SA(1, 0), cA + kstep, voffA[0]); G8_STAGE(G8_SB(1, 1), cB + hstep + kstep, voffB);
  G8_WAIT_V(6); G8_BAR;
  for (;;) {
    G8_GETU(ui + 1, nxt);
    const bool has_next = nxt.valid != 0;
    const char* nA = has_next ? ((MODE == 3) ? Abase : Abase + (size_t)nxt.arow * K * 2) : cA;
    const char* nB = has_next ? Bbase + (size_t)nxt.e * BEXP + (size_t)nxt.pn * tstep : cB;
#pragma unroll 1
    for (int t = 0; t < nt; t += 2) {
      const bool last = (t == nt - 2);
      const char* a1 = cA + (size_t)(t + 1) * kstep;
      const char* a2 = last ? nA : cA + (size_t)(t + 2) * kstep;
      const char* b2 = last ? nB : cB + (size_t)(t + 2) * kstep;
      const char* a3 = a2 + kstep;
      const char* b3 = b2 + kstep;
      G8_LDB(B0, 0, 0); G8_SCHED; G8_LDA(At, 0, 0); G8_STAGE(G8_SA(1, 1), a1, voffA[1]);
      if (MODE == 3) {
        if (last && has_next) {
          G8_VOFFA(voffA, nxt);
          asm volatile("s_waitcnt vmcnt(0)" ::: "memory");
        }
      }
      G8_WAIT_L(8); G8_BAR; G8_WAIT_L(0); G8_MMA(0, 0, At, B0); G8_BAR; G8_SCHED;
      G8_LDB(B1, 0, 1); G8_STAGE(G8_SB(0, 0), b2, voffB);
      G8_BAR; G8_WAIT_L(0); G8_MMA(0, 1, At, B1); G8_BAR;
      G8_LDA(At, 0, 1); G8_STAGE(G8_SA(0, 0), a2, voffA[0]);
      G8_BAR; G8_WAIT_L(0); G8_MMA(1, 0, At, B0); G8_BAR; G8_SCHED;
      G8_STAGE(G8_SB(0, 1), b2 + hstep, voffB);
      G8_WAIT_V(6); G8_BAR; G8_MMA(1, 1, At, B1); G8_BAR;
      G8_LDB(B0, 1, 0); G8_SCHED; G8_LDA(At, 1, 0); G8_STAGE(G8_SA(0, 1), a2, voffA[1]);
      G8_WAIT_L(8); G8_BAR; G8_WAIT_L(0); G8_MMA(0, 0, At, B0); G8_BAR; G8_SCHED;
      G8_LDB(B1, 1, 1); G8_STAGE(G8_SB(1, 0), b3, voffB);
      G8_BAR; G8_WAIT_L(0); G8_MMA(0, 1, At, B1); G8_BAR;
      G8_LDA(At, 1, 1); G8_STAGE(G8_SA(1, 0), a3, voffA[0]);
      G8_BAR; G8_WAIT_L(0); G8_MMA(1, 0, At, B0); G8_BAR; G8_SCHED;
      G8_STAGE(G8_SB(1, 1), b3 + hstep, voffB);
      G8_WAIT_V(6); G8_BAR; G8_MMA(1, 1, At, B1); G8_BAR;
    }
    epilogue<MODE>(p, acc, cur, wr, wc, fr, fq);
    if (!has_next) break;
#pragma unroll
    for (int a = 0; a < 2; ++a)
#pragma unroll
      for (int b = 0; b < 2; ++b)
#pragma unroll
        for (int m = 0; m < 4; ++m)
#pragma unroll
          for (int n = 0; n < 2; ++n) acc[a][b][m][n] = (f32x4){0.f, 0.f, 0.f, 0.f};
    cur = nxt; cA = nA; cB = nB; ++ui;
  }
  G8_WAIT_V(0);
  if (wr == 0) G8_BAR;
  G8_BAR;
#undef G8_GETU
#undef G8_VOFFA
#undef G8_SA
#undef G8_SB
#undef G8_STAGE
#undef G8_LDA
#undef G8_LDB
#undef G8_MMA
#undef G8_WAIT_V
#undef G8_WAIT_L
#undef G8_BAR
#undef G8_SCHED
}
}

DI float rope_apply(float v, float c, float s, int lane) {
  float o = xor32f(v, lane);
  return (lane < 32) ? (v * c - o * s) : (v * c + o * s);
}
DI void phase_post1(const Params& p, char* smem) {
  const int tid = otid(p), lane = tid & 63, wave = tid >> 6;
  const float* P = (const float*)(p.ws + OFF_P);
  const float* rope = (const float*)(p.ws + OFF_ROPE);
  unsigned short* Qb = (unsigned short*)(p.ws + OFF_QB);
  unsigned short* QI = (unsigned short*)(p.ws + OFF_QI);
  unsigned short* KI = (unsigned short*)(p.ws + OFF_KI);
  unsigned short* CKV = (unsigned short*)(p.ws + OFF_CKV);
  float* WI = (float*)(p.ws + OFF_WI);
  float* Qd = (float*)(p.ws + OFF_QD);
  float* Kd = (float*)(p.ws + OFF_KD);
  float* Vd = (float*)(p.ws + OFF_VD);
  float* BETA = (float*)(p.ws + OFF_BETA);
  float* G = (float*)(p.ws + OFF_G);
  float* cw = (float*)smem;
  __syncthreads();
  for (int idx = tid; idx < 4 * 1536; idx += NTHREADS) cw[idx] = p.conv_w[idx];
  __syncthreads();
  const float qw = p.q_norm_w[lane] * (0.125f * 1.4426950408889634f);
  const float4 kvw = *(const float4*)(p.kv_norm_w + lane * 4);
  constexpr int PG = 4;
  for (int g = blockIdx.x * NWAVES + wave; g < NT / PG; g += gridDim.x * NWAVES) {
    const int tok0 = g * PG, b = tok0 / T, t0 = tok0 - b * T;
    const int tailc = (lane < 8) ? (C_IW + lane) : (C_BBETA + ((lane - 8) & 7));
    float nqv[8], niv[8];
    float4 nckv;
    float nikv, ntail;
    {
      const float* row = P + (size_t)tok0 * INC;
#pragma unroll
      for (int hh = 0; hh < 8; ++hh) { nqv[hh] = row[C_AQ + hh * 64 + lane]; niv[hh] = row[C_IQ + hh * 64 + lane]; }
      nckv = *(const float4*)(row + C_CKV + lane * 4);
      nikv = row[C_IK + lane];
      ntail = row[tailc];
    }
#pragma unroll 1
    for (int tt = 0; tt < PG; ++tt) {
      const int tok = tok0 + tt, t = t0 + tt;
      float qv[8], iv[8];
#pragma unroll
      for (int hh = 0; hh < 8; ++hh) { qv[hh] = nqv[hh]; iv[hh] = niv[hh]; }
      const float4 ckv = nckv;
      const float ikv = nikv, tailv = ntail;
      if (tt + 1 < PG) {
        const float* row = P + (size_t)(tok + 1) * INC;
#pragma unroll
        for (int hh = 0; hh < 8; ++hh) { nqv[hh] = row[C_AQ + hh * 64 + lane]; niv[hh] = row[C_IQ + hh * 64 + lane]; }
        nckv = *(const float4*)(row + C_CKV + lane * 4);
        nikv = row[C_IK + lane];
        ntail = row[tailc];
      }
      const float cs = rope[t * 64 + (lane & 31)], sn = rope[t * 64 + 32 + (lane & 31)];
      unsigned short* qb = Qb + (size_t)tok * 512 + lane;
      unsigned short* qi = QI + (size_t)tok * 512 + lane;
#pragma unroll
      for (int hh = 0; hh < 8; ++hh) {
        float v = qv[hh];
        const float ss = wave_sum(v * v);
        v = v * rsqrtf(ss * (1.f / 64.f) + 1e-6f) * qw;
        qb[hh * 64] = f2bf(rope_apply(v, cs, sn, lane));
        qi[hh * 64] = f2bf(rope_apply(iv[hh], cs, sn, lane));
      }
      {
        const float ss = wave_sum(ckv.x * ckv.x + ckv.y * ckv.y + ckv.z * ckv.z + ckv.w * ckv.w);
        const float rstd = rsqrtf(ss * (1.f / 256.f) + 1e-6f);
        uint2 o;
        o.x = pk2(ckv.x * rstd * kvw.x, ckv.y * rstd * kvw.y);
        o.y = pk2(ckv.z * rstd * kvw.z, ckv.w * rstd * kvw.w);
        *(uint2*)(CKV + (size_t)tok * 256 + lane * 4) = o;
      }
      KI[(size_t)tok * 64 + lane] = f2bf(rope_apply(ikv, cs, sn, lane));
      if (lane < 8) WI[(size_t)tok * 8 + lane] = tailv * 0.04419417382415922f;
      if (lane >= 8 && lane < 12) BETA[(size_t)tok * 4 + (lane - 8)] = 1.f / (1.f + expf(-tailv));
      if (lane >= 12 && lane < 16) {
        const float xx = tailv + p.dt_bias[lane - 12];
        const float sp = fmaxf(xx, 0.f) + log1pf(expf(-fabsf(xx)));
        G[(size_t)tok * 4 + (lane - 12)] = -expf(p.a_log[lane - 12]) * sp;
      }
    }
    float x0[24], x1[24], x2[24];
    {
      const float* base = P + (size_t)tok0 * INC + C_BQKV + lane;
#pragma unroll
      for (int i = 0; i < 24; ++i) {
        x0[i] = (t0 >= 3) ? base[64 * i - 3 * (ptrdiff_t)INC] : 0.f;
        x1[i] = (t0 >= 2) ? base[64 * i - 2 * (ptrdiff_t)INC] : 0.f;
        x2[i] = (t0 >= 1) ? base[64 * i - 1 * (ptrdiff_t)INC] : 0.f;
      }
    }
    float xn[24];
    {
      const float* xr = P + (size_t)tok0 * INC + C_BQKV + lane;
#pragma unroll
      for (int i = 0; i < 24; ++i) xn[i] = xr[64 * i];
    }
#pragma unroll 1
    for (int tt = 0; tt < PG; ++tt) {
      const int tok = tok0 + tt;
      float x3[24];
#pragma unroll
      for (int i = 0; i < 24; ++i) x3[i] = xn[i];
      if (tt + 1 < PG) {
        const float* xr = P + (size_t)(tok + 1) * INC + C_BQKV + lane;
#pragma unroll
        for (int i = 0; i < 24; ++i) xn[i] = xr[64 * i];
      }
      int cl = lane;
      asm volatile("" : "+v"(cl));
      float* qd = Qd + (size_t)tok * 512 + lane;
      float* kd = Kd + (size_t)tok * 512 + lane;
      float* vd = Vd + (size_t)tok * 512 + lane;
#pragma unroll
      for (int hd = 0; hd < 4; ++hd) {
        float cv[6];
#pragma unroll
        for (int q = 0; q < 6; ++q) {
          const int i = (q >> 1) * 8 + 2 * hd + (q & 1);
          const int c = cl + 64 * i;
          const float a = cw[c] * x0[i] + cw[1536 + c] * x1[i] + cw[2 * 1536 + c] * x2[i] + cw[3 * 1536 + c] * x3[i];
          cv[q] = a / (1.f + __expf(-a));
          x0[i] = x1[i]; x1[i] = x2[i]; x2[i] = x3[i];
        }
        float ss = wave_sum(cv[0] * cv[0] + cv[1] * cv[1]);
        float r = rsqrtf(ss + 1e-6f);
        qd[hd * 128] = cv[0] * r;
        qd[hd * 128 + 64] = cv[1] * r;
        ss = wave_sum(cv[2] * cv[2] + cv[3] * cv[3]);
        r = rsqrtf(ss + 1e-6f);
        kd[hd * 128] = cv[2] * r;
        kd[hd * 128 + 64] = cv[3] * r;
        vd[hd * 128] = cv[4];
        vd[hd * 128 + 64] = cv[5];
      }
    }
  }
}

DI void phase_post2(const Params& p, char* smem) {
  (void)smem;
  const int tid = otid(p), lane = tid & 63, wave = tid >> 6;
  const float* KV = (const float*)(p.ws + OFF_KV);
  const float* rope = (const float*)(p.ws + OFF_ROPE);
  unsigned short* Kb = (unsigned short*)(p.ws + OFF_KB);
  unsigned short* Vb = (unsigned short*)(p.ws + OFF_VT);
  const float kw = p.k_norm_w[lane];
  if (blockIdx.x < 16) return;
  for (int tok = (blockIdx.x - 16) * NWAVES + wave; tok < NT; tok += (gridDim.x - 16) * NWAVES) {
    const int b = tok / T, t = tok - b * T;
    const float* row = KV + (size_t)tok * 1024;
    float kv[8], vv[8];
#pragma unroll
    for (int hh = 0; hh < 8; ++hh) { kv[hh] = row[hh * 64 + lane]; vv[hh] = row[512 + hh * 64 + lane]; }
    const float cs = rope[t * 64 + (lane & 31)], sn = rope[t * 64 + 32 + (lane & 31)];
    unsigned short* kb = Kb + (size_t)tok * 512 + lane;
    unsigned short* vb = Vb + (size_t)tok * 512 + lane;
#pragma unroll
    for (int hh = 0; hh < 8; ++hh) {
      float v = kv[hh];
      const float ss = wave_sum(v * v);
      v = v * rsqrtf(ss * (1.f / 64.f) + 1e-6f) * kw;
      kb[hh * 64] = f2bf(rope_apply(v, cs, sn, lane));
      vb[hh * 64] = f2bf(vv[hh]);
    }
  }
}

constexpr int KS_STRIDE = 129, AM_STRIDE = 65;
DI void phase_chunkprep(const Params& p, char* smem) {
  constexpr int KQ = 136;
  unsigned short* K16 = (unsigned short*)smem;
  unsigned short* Q16 = K16 + 64 * KQ;
  float* Am = (float*)(Q16 + 64 * KQ);
  float* Tm = Am + 64 * AM_STRIDE;
  float* gc = Tm + 64 * AM_STRIDE;
  float* bet = gc + 64;
  float* gl = bet + 64;
  unsigned short* T16 = (unsigned short*)(gl + 64);
  float* Mt = (float*)T16;
  unsigned short* VbT = T16 + 64 * 72;
  unsigned short* KbT = VbT + 128 * 72;
  static_assert(2 * 64 * KQ * 2 + (64 * AM_STRIDE * 2 + 192) * 4 + (64 * 72 + 2 * 128 * 72) * 2 <= 131072, "chunk prep LDS");
  const int tid = otid(p), lane = tid & 63, wave = tid >> 6;
  const float* Qd = (const float*)(p.ws + OFF_QD);
  const float* Kd = (const float*)(p.ws + OFF_KD);
  const float* Vd = (const float*)(p.ws + OFF_VD);
  const float* BETA = (const float*)(p.ws + OFF_BETA);
  const float* G = (const float*)(p.ws + OFF_G);
  unsigned short* CHB = (unsigned short*)(p.ws + OFF_WN);
  float* UU = (float*)(p.ws + OFF_UU);
  float* DL = (float*)(p.ws + OFF_DL);
  for (int ci = blockIdx.x; ci < NCHT; ci += gridDim.x) {
    unsigned short* chb = CHB + (size_t)ci * CHB_ELEMS;
    const int bh = ci / NCH, c = ci - bh * NCH, b = bh >> 2, h = bh & 3;
    __syncthreads();
    if (tid < 64) {
      int t = c * 64 + tid - 48;
      float g = 0.f, be = 0.f;
      if (t >= 0) { g = G[(size_t)(b * T + t) * 4 + h]; be = BETA[(size_t)(b * T + t) * 4 + h]; }
      gl[tid] = g;
      bet[tid] = be;
    }
    __syncthreads();
    if (tid < 64) {
      float s2 = 0.f;
      for (int j = 0; j <= tid; ++j) s2 += gl[j];
      gc[tid] = s2;
    }
    __syncthreads();
#pragma unroll 1
    for (int hb = 0; hb < 2; ++hb) {
      float kr[8], qr[8], vr[8];
#pragma unroll
      for (int it = 0; it < 8; ++it) {
        const int idx = tid + (hb * 8 + it) * NTHREADS, i = idx >> 7, d = idx & 127;
        const int t = c * 64 + i - 48;
        kr[it] = 0.f; qr[it] = 0.f; vr[it] = 0.f;
        if (t >= 0) {
          const size_t o = ((size_t)(b * T + t)) * 512 + h * 128 + d;
          kr[it] = Kd[o];
          qr[it] = Qd[o] * 0.08838834764831845f;
          vr[it] = Vd[o];
        }
      }
#pragma unroll
      for (int it = 0; it < 8; ++it) {
        const int idx = tid + (hb * 8 + it) * NTHREADS, i = idx >> 7, d = idx & 127;
        const float bi = bet[i], eg = __expf(gc[i]);
        K16[i * KQ + d] = f2bf(kr[it]);
        Q16[i * KQ + d] = f2bf(qr[it]);
        VbT[d * 72 + i] = f2bf(bi * vr[it]);
        KbT[d * 72 + i] = f2bf(bi * eg * kr[it]);
        chb[CH_QG + swzA(i, d)] = f2bf(qr[it] * eg);
      }
    }
    __syncthreads();
    {
      const int mat = wave >> 2, tl = wave & 3, lr = lane & 31, lh = lane >> 5;
      if (tl < 3) {
        const int mt = (tl + 1) >> 1, nt = tl >> 1;
        const unsigned short* At = mat ? Q16 : K16;
        f32x16 acc;
#pragma unroll
        for (int r = 0; r < 16; ++r) acc[r] = 0.f;
#pragma unroll
        for (int ks = 0; ks < 8; ++ks) {
          const bf16x8 af = ld16(At + (mt * 32 + lr) * KQ + ks * 16 + 8 * lh);
          const bf16x8 bfr = ld16(K16 + (nt * 32 + lr) * KQ + ks * 16 + 8 * lh);
          acc = MFMA32(af, bfr, acc);
        }
        const int j = nt * 32 + lr;
        const float gj = gc[j];
#pragma unroll
        for (int r = 0; r < 16; ++r) {
          const int i = mt * 32 + crow(r, lh);
          const float dec = (j <= i) ? __expf(gc[i] - gj) : 0.f;
          if (mat == 0) Am[i * AM_STRIDE + j] = (j < i) ? bet[i] * acc[r] * dec : 0.f;
          else chb[CH_IN + swzB(i, j)] = f2bf(acc[r] * dec);
        }
      } else {
        const int lr = lane & 31, lh = lane >> 5;
#pragma unroll
        for (int r = 0; r < 16; ++r) {
          const int i = crow(r, lh), j = 32 + lr;
          if (mat == 0) Am[i * AM_STRIDE + j] = 0.f;
          else chb[CH_IN + swzB(i, j)] = 0;
        }
      }
    }
    __syncthreads();
    {
      for (int idx = tid; idx < 64 * 64; idx += NTHREADS) Tm[(idx >> 6) * AM_STRIDE + (idx & 63)] = 0.f;
      __syncthreads();
      if (tid < 64) {
        const int bb = tid >> 4, cc = tid & 15, o = 16 * bb;
        float x[16];
#pragma unroll
        for (int i = 0; i < 16; ++i) {
          float a = (i == cc) ? 1.f : 0.f;
#pragma unroll
          for (int j = 0; j < 16; ++j)
            if (j < i) a -= Am[(o + i) * AM_STRIDE + o + j] * x[j];
          x[i] = a;
          Tm[(o + i) * AM_STRIDE + o + cc] = a;
        }
      }
      __syncthreads();
      {
        const int B = tid >> 8, i = (tid >> 4) & 15, j = tid & 15, o = 32 * B;
        float m = 0.f;
#pragma unroll
        for (int k = 0; k < 16; ++k) m += Am[(o + 16 + i) * AM_STRIDE + o + k] * Tm[(o + k) * AM_STRIDE + o + j];
        Mt[(B * 16 + i) * 33 + j] = m;
        __syncthreads();
        float t = 0.f;
#pragma unroll
        for (int k = 0; k < 16; ++k) t += Tm[(o + 16 + i) * AM_STRIDE + o + 16 + k] * Mt[(B * 16 + k) * 33 + j];
        __syncthreads();
        Tm[(o + 16 + i) * AM_STRIDE + o + j] = -t;
      }
      __syncthreads();
      {
        const int i = tid >> 4, j0 = (tid & 15) * 2;
        float m0 = 0.f, m1 = 0.f;
        for (int k = 0; k < 32; ++k) {
          const float a = Am[(32 + i) * AM_STRIDE + k];
          m0 += a * Tm[k * AM_STRIDE + j0];
          m1 += a * Tm[k * AM_STRIDE + j0 + 1];
        }
        Mt[i * 33 + j0] = m0;
        Mt[i * 33 + j0 + 1] = m1;
        __syncthreads();
        float t0 = 0.f, t1 = 0.f;
        for (int k = 0; k < 32; ++k) {
          const float a = Tm[(32 + i) * AM_STRIDE + 32 + k];
          t0 += a * Mt[k * 33 + j0];
          t1 += a * Mt[k * 33 + j0 + 1];
        }
        __syncthreads();
        Tm[(32 + i) * AM_STRIDE + j0] = -t0;
        Tm[(32 + i) * AM_STRIDE + j0 + 1] = -t1;
      }
    }
    __syncthreads();
    for (int idx = tid; idx < 64 * 64; idx += NTHREADS) T16[(idx >> 6) * 72 + (idx & 63)] = f2bf(Tm[(idx >> 6) * AM_STRIDE + (idx & 63)]);
    __syncthreads();
    {
      const int mat = wave >> 2, nt = wave & 3, lr = lane & 31, lh = lane >> 5;
      const unsigned short* Bt = mat ? KbT : VbT;
#pragma unroll
      for (int mt = 0; mt < 2; ++mt) {
        f32x16 acc;
#pragma unroll
        for (int r = 0; r < 16; ++r) acc[r] = 0.f;
#pragma unroll
        for (int ks = 0; ks < 4; ++ks) {
          const bf16x8 af = ld16(T16 + (mt * 32 + lr) * 72 + ks * 16 + 8 * lh);
          const bf16x8 bfr = ld16(Bt + (nt * 32 + lr) * 72 + ks * 16 + 8 * lh);
          acc = MFMA32(af, bfr, acc);
        }
        if (mat == 0) {
          float* up = UU + (size_t)ci * 8192 + (((nt * 2 + mt) * 2 + lh) * 32 + lr) * 16;
#pragma unroll
          for (int q = 0; q < 4; ++q) *(float4*)(up + 4 * q) = make_float4(acc[4 * q], acc[4 * q + 1], acc[4 * q + 2], acc[4 * q + 3]);
        } else {
#pragma unroll
          for (int r = 0; r < 16; ++r) chb[swzA(mt * 32 + crow(r, lh), nt * 32 + lr)] = f2bf(-acc[r]);
        }
      }
    }
    const float glast = gc[63];
    for (int idx = tid; idx < 64 * 128; idx += NTHREADS) {
      int i = idx & 63, d = idx >> 6;
      chb[CH_KDT + swzB(d, i)] = f2bf(bf2f(K16[i * KQ + d]) * __expf(glast - gc[i]));
    }
    if (tid == 0) DL[ci] = __expf(glast);
  }
}

DI float relu_fma(float w, float x, float acc) {
  const int xi = __builtin_bit_cast(int, x);
  const float m = __builtin_bit_cast(float, xi > 0 ? xi : 0);
  return __builtin_fmaf(w, m, acc);
}
DI unsigned ordkey(float f) {
  unsigned u = __float_as_uint(f);
  return (u & 0x80000000u) ? ~u : (u | 0x80000000u);
}
DI int half_sum(int v) {
  v += dppi<0xB1>(v); v += dppi<0x4E>(v); v += dppi<0x141>(v); v += dppi<0x140>(v);
  const int lo = __builtin_amdgcn_readlane(v, 0) + __builtin_amdgcn_readlane(v, 16);
  const int hi = __builtin_amdgcn_readlane(v, 32) + __builtin_amdgcn_readlane(v, 48);
  return (__builtin_amdgcn_mbcnt_hi(~0u, __builtin_amdgcn_mbcnt_lo(~0u, 0u)) < 32u) ? lo : hi;
}
DI int cnt4_ge(int cnt, unsigned a, unsigned b, unsigned c, unsigned d, unsigned cand) {
  unsigned long long m0, m1, m2, m3;
  asm("v_cmp_ge_u32_e64 %1, %5, %9\n\tv_cmp_ge_u32_e64 %2, %6, %9\n\tv_cmp_ge_u32_e64 %3, %7, %9\n\tv_cmp_ge_u32_e64 %4, %8, %9\n\t"
      "v_addc_co_u32_e64 %0, %1, %0, 0, %1\n\tv_addc_co_u32_e64 %0, %2, %0, 0, %2\n\tv_addc_co_u32_e64 %0, %3, %0, 0, %3\n\tv_addc_co_u32_e64 %0, %4, %0, 0, %4"
      : "+v"(cnt), "=&s"(m0), "=&s"(m1), "=&s"(m2), "=&s"(m3)
      : "v"(a), "v"(b), "v"(c), "v"(d), "v"(cand));
  return cnt;
}
DI int cnt4_gt(int cnt, unsigned a, unsigned b, unsigned c, unsigned d, unsigned cand) {
  unsigned long long m0, m1, m2, m3;
  asm("v_cmp_gt_u32_e64 %1, %5, %9\n\tv_cmp_gt_u32_e64 %2, %6, %9\n\tv_cmp_gt_u32_e64 %3, %7, %9\n\tv_cmp_gt_u32_e64 %4, %8, %9\n\t"
      "v_addc_co_u32_e64 %0, %1, %0, 0, %1\n\tv_addc_co_u32_e64 %0, %2, %0, 0, %2\n\tv_addc_co_u32_e64 %0, %3, %0, 0, %3\n\tv_addc_co_u32_e64 %0, %4, %0, 0, %4"
      : "+v"(cnt), "=&s"(m0), "=&s"(m1), "=&s"(m2), "=&s"(m3)
      : "v"(a), "v"(b), "v"(c), "v"(d), "v"(cand));
  return cnt;
}
typedef unsigned u32x4v __attribute__((ext_vector_type(4)));
DI void indexer_task(const Params& p, char* smem, int b, int q8, int wave, int lane) {
  const int q0 = (q8 * 8 + wave) * 2;
  unsigned* MASK = (unsigned*)(p.ws + OFF_MASK);
  const int qsel = lane >> 5;
  const int tq = q0 + qsel;
  unsigned* mrow = MASK + (size_t)b * 128 * SEQ + tq;
  if (q8 < 16) {
    for (int i = (lane & 31); i < 128; i += 32) {
      int rem = tq + 1 - 32 * i;
      unsigned w = (rem >= 32) ? 0xffffffffu : (rem > 0 ? ((1u << rem) - 1u) : 0u);
      mrow[(size_t)i * SEQ] = w;
    }
    return;
  }
  const unsigned short* QI = (const unsigned short*)(p.ws + OFF_QI);
  const unsigned short* KI = (const unsigned short*)(p.ws + OFF_KI);
  const float* WI = (const float*)(p.ws + OFF_WI);
  const int l15 = lane & 15, lg = lane >> 4;
  const size_t qtok = (size_t)b * T + NM + q0 + (l15 >> 3);
  bf16x8 a0 = ld16(QI + qtok * 512 + (l15 & 7) * 64 + 8 * lg);
  bf16x8 a1 = ld16(QI + qtok * 512 + (l15 & 7) * 64 + 32 + 8 * lg);
  float w[4];
  {
    const size_t wtok = (size_t)b * T + NM + q0 + (lg >> 1);
#pragma unroll
    for (int r = 0; r < 4; ++r) w[r] = WI[wtok * 8 + 4 * (lg & 1) + r];
  }
  const int npairs = (q0 + 2 + 31) >> 5;
  const int npmax = (16 * q8 + 16 + 31) >> 5;
  LAS unsigned char* lds = (LAS unsigned char*)smem;
  const bool loader = wave < 4;
  const unsigned short* ksrc = KI + ((size_t)b * T + NM + 8 * wave + (lane >> 3)) * 64 + (((lane & 7) ^ (lane >> 3)) << 3);
  const unsigned frag0 = (unsigned)(l15 * 128 + ((lg ^ (l15 & 7)) << 4));
  const unsigned frag1 = (unsigned)(l15 * 128 + (((4 + lg) ^ (l15 & 7)) << 4));
  asm volatile("s_waitcnt vmcnt(0)" ::: "memory");
  {
    u32x4v t0 = __builtin_bit_cast(u32x4v, a0), t1 = __builtin_bit_cast(u32x4v, a1);
    asm volatile("" : "+v"(t0), "+v"(t1), "+v"(w[0]), "+v"(w[1]), "+v"(w[2]), "+v"(w[3]));
    a0 = __builtin_bit_cast(bf16x8, t0); a1 = __builtin_bit_cast(bf16x8, t1);
  }
  __syncthreads();
  const unsigned ldsbase = (unsigned)(size_t)lds + (unsigned)wave * 1024u;
#define IX_DMA(stage) asm volatile("s_mov_b32 m0, %1\n\ts_nop 0\n\tglobal_load_lds_dwordx4 %0, off" :: "v"(ksrc + (size_t)(stage) * 2048), "s"(ldsbase + (unsigned)(((stage) & 7) * 4096)) : "memory", "m0")
  if (loader) {
#pragma unroll
    for (int s = 0; s < 6; ++s)
      if (s < npmax) IX_DMA(s);
  }
  unsigned u[128];
  int rem = tq - (lane & 31);
#pragma unroll
  for (int ii = 0; ii < 64; ++ii) {
    unsigned uv0 = 0u, uv1 = 0u;
    if (2 * ii < npmax) {
      if (loader) {
        const int ahead = min(npmax, 2 * ii + 6) - (2 * ii + 2);
        if (ahead >= 4) asm volatile("s_waitcnt vmcnt(4)" ::: "memory");
        else if (ahead == 3) asm volatile("s_waitcnt vmcnt(3)" ::: "memory");
        else if (ahead == 2) asm volatile("s_waitcnt vmcnt(2)" ::: "memory");
        else if (ahead == 1) asm volatile("s_waitcnt vmcnt(1)" ::: "memory");
        else asm volatile("s_waitcnt vmcnt(0)" ::: "memory");
      }
      __builtin_amdgcn_s_barrier();
      if (loader) {
        if (2 * ii + 6 < npmax) IX_DMA(2 * ii + 6);
        if (2 * ii + 7 < npmax) IX_DMA(2 * ii + 7);
      }
#pragma unroll
      for (int h = 0; h < 2; ++h) {
        const int i = 2 * ii + h;
        unsigned uv = 0u;
        if (i < npairs) {
          const LAS unsigned char* sb = lds + (i & 7) * 4096;
          float tot[2];
#pragma unroll
          for (int par = 0; par < 2; ++par) {
            const bf16x8 b0 = *(const LAS bf16x8*)(sb + par * 2048 + frag0);
            const bf16x8 b1 = *(const LAS bf16x8*)(sb + par * 2048 + frag1);
            f32x4 acc = {0.f, 0.f, 0.f, 0.f};
            acc = MFMA16(a0, b0, acc);
            acc = MFMA16(a1, b1, acc);
            float part = 0.f;
#pragma unroll
            for (int r = 0; r < 4; ++r) part = relu_fma(w[r], acc[r], part);
            tot[par] = part + xor16f(part, lane);
          }
          const float sc = (lg & 1) ? tot[1] : tot[0];
          uv = (rem - 32 * h >= 0) ? ordkey(sc) : 0u;
        }
        if (h == 0) uv0 = uv; else uv1 = uv;
      }
    }
    u[2 * ii] = uv0;
    u[2 * ii + 1] = uv1;
    rem -= 64;
    asm volatile("" : "+v"(rem));
  }
#undef IX_DMA
  __builtin_amdgcn_s_barrier();
  const int nblk = (npairs + 15) >> 4;
  unsigned thr = 0u;
  bool done = false;
  for (int bit = 31; bit >= 0; --bit) {
    const unsigned cand = thr | (1u << bit);
    int cnt = 0;
#pragma unroll
    for (int blk = 0; blk < 8; ++blk) {
      if (blk < nblk) {
#pragma unroll
        for (int j = 0; j < 16; j += 4) cnt = cnt4_ge(cnt, u[blk * 16 + j], u[blk * 16 + j + 1], u[blk * 16 + j + 2], u[blk * 16 + j + 3], cand);
      }
    }
    cnt = half_sum(cnt);
    if (!done && cnt >= 256) thr = cand;
    done = done || (cnt == 256);
    if (__all(done)) break;
  }
  int cgt = 0;
#pragma unroll
  for (int blk = 0; blk < 8; ++blk) {
    if (blk < nblk) {
#pragma unroll
      for (int j = 0; j < 16; j += 4) cgt = cnt4_gt(cgt, u[blk * 16 + j], u[blk * 16 + j + 1], u[blk * 16 + j + 2], u[blk * 16 + j + 3], thr);
    }
  }
  cgt = half_sum(cgt);
  const int need = 256 - cgt;
  int base = 0;
  const unsigned lt_mask = (1u << (lane & 31)) - 1u;
#pragma unroll
  for (int blk = 0; blk < 8; ++blk) {
    if (blk < nblk) {
#pragma unroll
      for (int j = 0; j < 16; ++j) {
        const int i = blk * 16 + j;
        const bool eq = (u[i] == thr);
        const unsigned long long eb = __ballot(eq);
        const unsigned ehalf = qsel ? (unsigned)(eb >> 32) : (unsigned)eb;
        const int below = __popc(ehalf & lt_mask);
        const bool sel = (u[i] > thr) || (eq && (base + below < need));
        base += __popc(ehalf);
        const unsigned long long sb = __ballot(sel);
        const unsigned shalf = qsel ? (unsigned)(sb >> 32) : (unsigned)sb;
        if ((lane & 31) == 0) mrow[(size_t)i * SEQ] = shalf;
      }
    }
  }
}
DI void phase_indexer(const Params& p, char* smem) {
  const int tid = otid(p), lane = tid & 63, wave = __builtin_amdgcn_readfirstlane(tid >> 6);
  unsigned* ctr = (unsigned*)(p.ws + OFF_BAR + 15872 + 64);
  volatile LAS int* slot = (volatile LAS int*)((LAS unsigned char*)smem + g8::STAGE_BYTES + 800);
  const int ngroup = NB * (SEQ / 16);
  for (;;) {
    __syncthreads();
    if (tid == 0) *slot = (int)__hip_atomic_fetch_add(ctr, 1u, __ATOMIC_RELAXED, __HIP_MEMORY_SCOPE_AGENT);
    __syncthreads();
    const int g = __builtin_amdgcn_readfirstlane(*slot);
    if (g >= ngroup) break;
    const int b = g & 3, q8 = (SEQ / 16 - 1) - (g >> 2);
    indexer_task(p, smem, b, q8, wave, lane);
  }
}

constexpr int AT_KROW = 72, AT_VROW = 96;
constexpr int AT_KBYTES = 64 * AT_KROW * 2, AT_STAGE = AT_KBYTES + 64 * AT_VROW * 2;
typedef short s16x4v __attribute__((ext_vector_type(4)));
DI void attn_block(const Params& p, char* smem, int b, int hh, int G) {
  const unsigned short* Qb = (const unsigned short*)(p.ws + OFF_QB);
  const unsigned short* Kb = (const unsigned short*)(p.ws + OFF_KB);
  const unsigned short* Vb = (const unsigned short*)(p.ws + OFF_VT);
  const unsigned* MASK = (const unsigned*)(p.ws + OFF_MASK);
  unsigned short* MIX = (unsigned short*)(p.ws + OFF_MIX);
  LAS unsigned char* lds = (LAS unsigned char*)smem;
  const int tid = otid(p), lane = tid & 63, wave = __builtin_amdgcn_readfirstlane(tid >> 6);
  const int lr = lane & 31, lh = lane >> 5;
  const int qt = 8 * G + wave;
  const int jl = (qt + 1) >> 1;
  const int tq = qt * 32 + lr;
  const size_t qtok = (size_t)b * T + NM + tq;
  bf16x8 qf[4];
#pragma unroll
  for (int ks = 0; ks < 4; ++ks) qf[ks] = ld16(Qb + qtok * 512 + hh * 64 + ks * 16 + 8 * lh);
  const unsigned* mrow = MASK + (size_t)b * 128 * SEQ + tq;
  const int srow = tid >> 3, sch = tid & 7;
  const size_t gcol = (size_t)hh * 64 + sch * 8;
  const unsigned short* kbase = Kb + (size_t)b * T * 512 + gcol;
  const unsigned short* vbase = Vb + (size_t)b * T * 512 + gcol;
  const unsigned sdk = (unsigned)(srow * (AT_KROW * 2) + sch * 16);
  const unsigned sdv = (unsigned)(AT_KBYTES + srow * (AT_VROW * 2) + sch * 16);
  const int nst = 4 * G + 5;
  const unsigned koff = (unsigned)(lr * (AT_KROW * 2) + 16 * lh);
  const unsigned voff = (unsigned)(AT_KBYTES + (4 * lh + ((lane & 15) >> 2)) * (AT_VROW * 2) + (16 * ((lane >> 4) & 1) + 4 * (lane & 3)) * 2);
  __syncthreads();
  {
    const size_t t0 = (size_t)(srow < 32 ? srow : srow - 16) * 512;
    const u32x4v k0 = *(const u32x4v*)(kbase + t0);
    const u32x4v v0 = *(const u32x4v*)(vbase + t0);
    *(LAS u32x4v*)(lds + sdk) = k0;
    *(LAS u32x4v*)(lds + sdv) = v0;
  }
  u32x4v rk1 = *(const u32x4v*)(kbase + (size_t)(48 + srow) * 512), rv1 = *(const u32x4v*)(vbase + (size_t)(48 + srow) * 512);
  u32x4v rk0 = *(const u32x4v*)(kbase + (size_t)(112 + srow) * 512), rv0 = *(const u32x4v*)(vbase + (size_t)(112 + srow) * 512);
  f32x16 o[2], negm, lacc;
#pragma unroll
  for (int r = 0; r < 16; ++r) { o[0][r] = 0.f; o[1][r] = 0.f; negm[r] = 0.f; lacc[r] = 0.f; }
  const bf16x8 ones = {0x3F80, 0x3F80, 0x3F80, 0x3F80, 0x3F80, 0x3F80, 0x3F80, 0x3F80};
  unsigned wa0 = 0x0000ffffu, wb0 = mrow[0], wa1 = mrow[SEQ], wb1 = mrow[2 * SEQ];
  asm volatile("" : "+v"(rk0), "+v"(rv0), "+v"(rk1), "+v"(rv1), "+v"(wb0), "+v"(wa1), "+v"(wb1));
  __syncthreads();
#define AT_STEP(jj, PAR, FIRST, rkn, rvn, wa, wb) do { \
    const int j_ = (jj); \
      \
      \
    *(LAS u32x4v*)(lds + (PAR ^ 1) * AT_STAGE + sdk) = rkn; \
    *(LAS u32x4v*)(lds + (PAR ^ 1) * AT_STAGE + sdv) = rvn; \
    { \
      const size_t go = (size_t)min(64 * (j_ + 3) - 16 + srow, T - 1) * 512; \
      rkn = *(const u32x4v*)(kbase + go); \
      rvn = *(const u32x4v*)(vbase + go); \
    } \
    if (j_ <= jl) { \
      const LAS unsigned char* sb = lds + PAR * AT_STAGE; \
        \
        \
      bf16x8 kf0[4], kf1[4], vf[4][2]; \
_Pragma("unroll") \
      for (int ks = 0; ks < 4; ++ks) { \
        kf0[ks] = *(const LAS bf16x8*)(sb + koff + ks * 32); \
        kf1[ks] = *(const LAS bf16x8*)(sb + koff + 32 * (AT_KROW * 2) + ks * 32); \
      } \
_Pragma("unroll") \
      for (int ss = 0; ss < 4; ++ss) \
_Pragma("unroll") \
        for (int dt = 0; dt < 2; ++dt) { \
            \
          const LAS unsigned char* vp = sb + voff + (16 * ss) * (AT_VROW * 2) + dt * 64; \
          const s16x4v lo = __builtin_amdgcn_ds_read_tr16_b64_v4i16((LAS s16x4v*)vp); \
          const s16x4v hi = __builtin_amdgcn_ds_read_tr16_b64_v4i16((LAS s16x4v*)(vp + 8 * (AT_VROW * 2))); \
          vf[ss][dt] = __builtin_shufflevector(lo, hi, 0, 1, 2, 3, 4, 5, 6, 7); \
        } \
      __builtin_amdgcn_sched_barrier(0); \
      f32x16 s0 = negm, s1 = negm; \
_Pragma("unroll") \
      for (int ks = 0; ks < 4; ++ks) { \
        s0 = MFMA32(kf0[ks], qf[ks], s0); \
        s1 = MFMA32(kf1[ks], qf[ks], s1); \
      } \
        \
        \
        \
      int tmi = max(__float_as_int(s0[0]), __float_as_int(s1[0])); \
_Pragma("unroll") \
      for (int r = 1; r < 16; ++r) tmi = max(tmi, max(__float_as_int(s0[r]), __float_as_int(s1[r]))); \
      tmi = max(tmi, __float_as_int(xor32f(__int_as_float(tmi), lane))); \
      if (FIRST) {     \
        float tmax = fmaxf(s0[0], s1[0]); \
_Pragma("unroll") \
        for (int r = 1; r < 16; ++r) tmax = fmaxf(tmax, fmaxf(s0[r], s1[r])); \
        tmax = fmaxf(tmax, xor32f(tmax, lane)); \
_Pragma("unroll") \
        for (int r = 0; r < 16; ++r) { negm[r] = -tmax; s0[r] -= tmax; s1[r] -= tmax; } \
      } else if (!__all(tmi <= 0)) { \
        const float d = __int_as_float(max(tmi, 0)); \
        const float alpha = __builtin_amdgcn_exp2f(-d); \
_Pragma("unroll") \
        for (int r = 0; r < 16; ++r) { \
          negm[r] -= d; s0[r] -= d; s1[r] -= d; \
          o[0][r] *= alpha; o[1][r] *= alpha; lacc[r] *= alpha; \
        } \
      } \
        \
      const unsigned wsa = wa >> (4 * lh); \
      const unsigned wsb = (2 * j_ <= qt ? wb : 0u) >> (4 * lh); \
_Pragma("unroll") \
      for (int r = 0; r < 16; ++r) { \
        unsigned va, vb; \
        asm("v_bfe_i32 %0, %1, %2, 1" : "=v"(va) : "v"(wsa), "n"((r & 3) + 8 * (r >> 2))); \
        asm("v_bfe_i32 %0, %1, %2, 1" : "=v"(vb) : "v"(wsb), "n"((r & 3) + 8 * (r >> 2))); \
        s0[r] = __uint_as_float(__float_as_uint(__builtin_amdgcn_exp2f(s0[r])) & va); \
        s1[r] = __uint_as_float(__float_as_uint(__builtin_amdgcn_exp2f(s1[r])) & vb); \
      } \
_Pragma("unroll") \
      for (int ss = 0; ss < 4; ++ss) { \
        const bf16x8 pf = (ss < 2) ? pack8(s0, ss & 1) : pack8(s1, ss & 1); \
        lacc = MFMA32(ones, pf, lacc); \
_Pragma("unroll") \
        for (int dt = 0; dt < 2; ++dt) o[dt] = MFMA32(vf[ss][dt], pf, o[dt]); \
      } \
    } \
    wa = mrow[(size_t)min(2 * j_ + 3, 127) * SEQ];     \
    wb = mrow[(size_t)min(2 * j_ + 4, 127) * SEQ];     \
    __syncthreads(); \
  } while (0)
  AT_STEP(0, 0, true, rk1, rv1, wa0, wb0);
  for (int j = 1; j < nst; j += 2) {
    AT_STEP(j, 1, false, rk0, rv0, wa1, wb1);
    AT_STEP(j + 1, 0, false, rk1, rv1, wa0, wb0);
  }
#undef AT_STEP
  const float inv = 1.f / lacc[0];
#pragma unroll
  for (int dt = 0; dt < 2; ++dt)
#pragma unroll
    for (int r = 0; r < 16; ++r) MIX[qtok * 1024 + hh * 64 + dt * 32 + crow(r, lh)] = f2bf(o[dt][r] * inv);
}
DI void attn_worker(const Params& p, char* smem) {
  unsigned* ctr = (unsigned*)(p.ws + OFF_BAR + 15872);
  volatile LAS int* slot = (volatile LAS int*)((LAS unsigned char*)smem + g8::STAGE_BYTES + 800);
  const int tid = otid(p);
  for (;;) {
    __syncthreads();
    if (tid == 0) *slot = (int)__hip_atomic_fetch_add(ctr, 1u, __ATOMIC_RELAXED, __HIP_MEMORY_SCOPE_AGENT);
    __syncthreads();
    const int k = __builtin_amdgcn_readfirstlane(*slot);
    if (k >= NB * 8 * 16) break;
    const int bh = k & 31, G = 15 - (k >> 5);
    attn_block(p, smem, bh >> 3, bh & 7, G);
  }
}

DI bf16x8 lds8x2(const LAS unsigned short* p0, const LAS unsigned short* p1) {
  typedef unsigned u32x2_t __attribute__((ext_vector_type(2)));
  typedef unsigned u32x4_t __attribute__((ext_vector_type(4)));
  const u32x2_t a = *(const LAS u32x2_t*)p0, b = *(const LAS u32x2_t*)p1;
  const u32x4_t r = {a[0], a[1], b[0], b[1]};
  return __builtin_bit_cast(bf16x8, r);
}
DI void scan_block(const Params& p, char* smem, int bh, const int c0, const int c1) {
  const int tid = otid(p), lane = tid & 63, wave = __builtin_amdgcn_readfirstlane(tid >> 6);
  const int b = bh >> 2, h = bh & 3;
  LAS unsigned char* lds = (LAS unsigned char*)smem;
  const unsigned short* CHB = (const unsigned short*)(p.ws + OFF_WN) + (size_t)bh * NCH * CHB_ELEMS;
  const float* UU = (const float*)(p.ws + OFF_UU) + (size_t)bh * NCH * 8192;
  const float* DL = (const float*)(p.ws + OFF_DL) + (size_t)bh * NCH;
  float* OD = (float*)(p.ws + OFF_OD);
  constexpr int CHB_BYTES = CHB_ELEMS * 2;
  __syncthreads();
  if (wave >= 4) {
    const int w4 = wave - 4;
#define SC_P17(c, OFFB) do { \
      const char* s_ = (const char*)(CHB + (size_t)(c) * CHB_ELEMS) + (OFFB); \
      const unsigned d_ = (unsigned)(((c) & 1) * CHB_BYTES + (OFFB)); \
      _Pragma("unroll") for (int j = 0; j < 4; ++j) \
        __builtin_amdgcn_global_load_lds((const unsigned*)(s_ + (w4 * 4 + j) * 1024 + lane * 16), (LAS unsigned*)(lds + d_ + (w4 * 4 + j) * 1024), 16, 0, 0); \
      __builtin_amdgcn_global_load_lds((const unsigned*)(s_ + 16384 + w4 * 256 + lane * 4), (LAS unsigned*)(lds + d_ + 16384 + w4 * 256), 4, 0, 0); } while (0)
#define SC_P9(c, OFFB) do { \
      const char* s_ = (const char*)(CHB + (size_t)(c) * CHB_ELEMS) + (OFFB); \
      const unsigned d_ = (unsigned)(((c) & 1) * CHB_BYTES + (OFFB)); \
      _Pragma("unroll") for (int j = 0; j < 2; ++j) \
        __builtin_amdgcn_global_load_lds((const unsigned*)(s_ + (w4 * 2 + j) * 1024 + lane * 16), (LAS unsigned*)(lds + d_ + (w4 * 2 + j) * 1024), 16, 0, 0); \
      __builtin_amdgcn_global_load_lds((const unsigned*)(s_ + 8192 + w4 * 256 + lane * 4), (LAS unsigned*)(lds + d_ + 8192 + w4 * 256), 4, 0, 0); } while (0)
#define SC_WN(c) SC_P17(c, 0)
#define SC_QGIN(c) do { SC_P17(c, CH_QG * 2); SC_P9(c, CH_IN * 2); } while (0)
#define SC_KDT(c) SC_P17(c, CH_KDT * 2)
    SC_WN(c0); SC_QGIN(c0); SC_KDT(c0);
    if (c0 + 1 < c1) { SC_WN(c0 + 1); SC_QGIN(c0 + 1); SC_KDT(c0 + 1); asm volatile("s_waitcnt vmcnt(31)" ::: "memory"); }
    else asm volatile("s_waitcnt vmcnt(13)" ::: "memory");
    __builtin_amdgcn_s_barrier();
    for (int c = c0; c < c1; ++c) {
      if (c + 1 < c1) asm volatile("s_waitcnt vmcnt(23)" ::: "memory"); else asm volatile("s_waitcnt vmcnt(0)" ::: "memory");
      __builtin_amdgcn_s_barrier();
      if (c + 2 < c1) SC_WN(c + 2);
      if (c + 2 < c1) asm volatile("s_waitcnt vmcnt(23)" ::: "memory");
      else if (c + 1 < c1) asm volatile("s_waitcnt vmcnt(18)" ::: "memory");
      else asm volatile("s_waitcnt vmcnt(0)" ::: "memory");
      __builtin_amdgcn_s_barrier();
      if (c + 2 < c1) SC_QGIN(c + 2);
      if (c + 2 < c1) asm volatile("s_waitcnt vmcnt(26)" ::: "memory");
      else if (c + 1 < c1) asm volatile("s_waitcnt vmcnt(13)" ::: "memory");
      else asm volatile("s_waitcnt vmcnt(0)" ::: "memory");
      __builtin_amdgcn_s_barrier();
      if (c + 2 < c1) SC_KDT(c + 2);
    }
#undef SC_P17
#undef SC_P9
#undef SC_WN
#undef SC_QGIN
#undef SC_KDT
  } else {
    const int sl = wave, lr = lane & 31, lh = lane >> 5, e0 = sl * 32;
    f32x16 S[4];
    float* sst = (float*)(p.ws + OFF_SST) + ((size_t)(bh * 4 + sl) * 64 + lane) * 64;
#pragma unroll
    for (int i = 0; i < 4; ++i)
#pragma unroll
      for (int q = 0; q < 4; ++q) {
        float4 v = make_float4(0.f, 0.f, 0.f, 0.f);
        if (c0 > 0) v = *(const float4*)(sst + i * 16 + q * 4);
        S[i][4 * q] = v.x; S[i][4 * q + 1] = v.y; S[i][4 * q + 2] = v.z; S[i][4 * q + 3] = v.w;
      }
    f32x16 un[2];
    const float* up0 = UU + (size_t)c0 * 8192 + ((size_t)(sl * 2) * 2 + lh) * 512 + lr * 16;
#pragma unroll
    for (int pt = 0; pt < 2; ++pt)
#pragma unroll
      for (int q = 0; q < 4; ++q) {
        const float4 v = *(const float4*)(up0 + pt * 1024 + q * 4);
        un[pt][4 * q] = v.x; un[pt][4 * q + 1] = v.y; un[pt][4 * q + 2] = v.z; un[pt][4 * q + 3] = v.w;
      }
    const int oA = lr * 132 + 4 * lh;
    const int oB = lr * 68 + 4 * lh;
    float dl_next = DL[c0];
    __builtin_amdgcn_s_barrier();
    for (int c = c0; c < c1; ++c) {
      const LAS unsigned short* cb = (const LAS unsigned short*)(lds + (c & 1) * CHB_BYTES);
      f32x16 vn[2];
      vn[0] = un[0];
      vn[1] = un[1];
      const float dl = dl_next;
      dl_next = DL[min(c + 1, c1 - 1)];
#pragma unroll
      for (int pt = 0; pt < 2; ++pt) {
#pragma unroll
        for (int mt = 0; mt < 4; ++mt)
#pragma unroll
          for (int s2 = 0; s2 < 2; ++s2) {
            const LAS unsigned short* ap = cb + oA + pt * 32 * 132 + mt * 32 + 16 * s2;
            vn[pt] = MFMA32(lds8x2(ap, ap + 8), pack8(S[mt], s2), vn[pt]);
          }
      }
      asm volatile("s_waitcnt lgkmcnt(0)" ::: "memory");
      __builtin_amdgcn_s_barrier();
      bf16x8 vb[2][2];
#pragma unroll
      for (int pt = 0; pt < 2; ++pt)
#pragma unroll
        for (int s2 = 0; s2 < 2; ++s2) vb[pt][s2] = pack8(vn[pt], s2);
      {
        const float* up = up0 + (size_t)(min(c + 1, c1 - 1) - c0) * 8192;
#pragma unroll
        for (int pt = 0; pt < 2; ++pt)
#pragma unroll
          for (int q = 0; q < 4; ++q) {
            const float4 v = *(const float4*)(up + pt * 1024 + q * 4);
            un[pt][4 * q] = v.x; un[pt][4 * q + 1] = v.y; un[pt][4 * q + 2] = v.z; un[pt][4 * q + 3] = v.w;
          }
      }
#pragma unroll
      for (int pt = 0; pt < 2; ++pt) {
        f32x16 o;
#pragma unroll
        for (int r = 0; r < 16; ++r) o[r] = 0.f;
#pragma unroll
        for (int mt = 0; mt < 4; ++mt)
#pragma unroll
          for (int s2 = 0; s2 < 2; ++s2) {
            const LAS unsigned short* ap = cb + CH_QG + oA + pt * 32 * 132 + mt * 32 + 16 * s2;
            o = MFMA32(lds8x2(ap, ap + 8), pack8(S[mt], s2), o);
          }
#pragma unroll
        for (int pt2 = 0; pt2 <= pt; ++pt2)
#pragma unroll
          for (int s2 = 0; s2 < 2; ++s2) {
            const LAS unsigned short* ap = cb + CH_IN + oB + pt * 32 * 68 + pt2 * 32 + 16 * s2;
            o = MFMA32(lds8x2(ap, ap + 8), vb[pt2][s2], o);
          }
#pragma unroll
        for (int r = 0; r < 16; ++r) {
          const int t = c * 64 + pt * 32 + crow(r, lh) - 48;
          if (t >= 0) OD[((size_t)(b * T + t)) * 512 + h * 128 + e0 + lr] = o[r];
        }
      }
      asm volatile("s_waitcnt lgkmcnt(0)" ::: "memory");
      __builtin_amdgcn_s_barrier();
#pragma unroll
      for (int mt = 0; mt < 4; ++mt) {
#pragma unroll
        for (int r = 0; r < 16; ++r) S[mt][r] *= dl;
#pragma unroll
        for (int pt2 = 0; pt2 < 2; ++pt2)
#pragma unroll
          for (int s2 = 0; s2 < 2; ++s2) {
            const LAS unsigned short* ap = cb + CH_KDT + oB + mt * 32 * 68 + pt2 * 32 + 16 * s2;
            S[mt] = MFMA32(lds8x2(ap, ap + 8), vb[pt2][s2], S[mt]);
          }
      }
      asm volatile("s_waitcnt lgkmcnt(0)" ::: "memory");
      __builtin_amdgcn_s_barrier();
    }
    if (c1 < NCH) {
#pragma unroll
      for (int i = 0; i < 4; ++i)
#pragma unroll
        for (int q = 0; q < 4; ++q) *(float4*)(sst + i * 16 + q * 4) = make_float4(S[i][4 * q], S[i][4 * q + 1], S[i][4 * q + 2], S[i][4 * q + 3]);
    }
  }
  __syncthreads();
}
DI void phase_scan_attn(const Params& p, char* smem) {
  attn_worker(p, smem);
}

DI void phase_gnorm(const Params& p) {
  const int tid = otid(p), lane = tid & 63, wave = tid >> 6;
  const float* OD = (const float*)(p.ws + OFF_OD);
  const float* P = (const float*)(p.ws + OFF_P);
  unsigned short* MIX = (unsigned short*)(p.ws + OFF_MIX);
  const float4 w4 = *(const float4*)(p.delta_norm_w + 4 * (lane & 31));
  const int nw = gridDim.x * NWAVES;
  for (int r = (blockIdx.x * NWAVES + wave) * 2; r < NR; r += nw * 2) {
    float4 ov[2][2], zv[2][2];
#pragma unroll
    for (int t = 0; t < 2; ++t) {
      const int rr = r + t, tok = rr + 16 * (rr / SEQ + 1);
#pragma unroll
      for (int c = 0; c < 2; ++c) {
        ov[t][c] = *(const float4*)(OD + (size_t)tok * 512 + c * 256 + 4 * lane);
        zv[t][c] = *(const float4*)(P + (size_t)tok * INC + C_BZ + c * 256 + 4 * lane);
      }
    }
#pragma unroll
    for (int t = 0; t < 2; ++t) {
      const int rr = r + t, tok = rr + 16 * (rr / SEQ + 1);
#pragma unroll
      for (int c = 0; c < 2; ++c) {
        const float4 o4 = ov[t][c], z4 = zv[t][c];
        float v = o4.x * o4.x + o4.y * o4.y + o4.z * o4.z + o4.w * o4.w;
        v += dppf<0xB1>(v); v += dppf<0x4E>(v); v += dppf<0x141>(v); v += dppf<0x140>(v);
        const float slo = rlf(v, 0) + rlf(v, 16), shi = rlf(v, 32) + rlf(v, 48);
        const float rstd = rsqrtf((lane < 32 ? slo : shi) * (1.f / 128.f) + 1e-6f);
        uint2 y;
        y.x = pk2(o4.x * rstd * w4.x * (z4.x / (1.f + __expf(-z4.x))), o4.y * rstd * w4.y * (z4.y / (1.f + __expf(-z4.y))));
        y.y = pk2(o4.z * rstd * w4.z * (z4.z / (1.f + __expf(-z4.z))), o4.w * rstd * w4.w * (z4.w / (1.f + __expf(-z4.w))));
        *(uint2*)(MIX + (size_t)tok * 1024 + 512 + c * 256 + 4 * lane) = y;
      }
    }
  }
}

DI void phase_router(const Params& p, char* smem) {
  const int tid = otid(p), lane = tid & 63, wave = tid >> 6;
  float* part = (float*)smem;
  float* rstds = part + 8 * 32 * 33;
  int* lhist = (int*)(rstds + 32);
  int* lbase = lhist + 32;
  const float* H1 = (const float*)(p.ws + OFF_H1);
  const float* wrs = (const float*)(p.ws + OFF_WRS);
  unsigned short* U2 = (unsigned short*)(p.ws + OFF_U2);
  int* TOPE = (int*)(p.ws + OFF_TOPE);
  float* GATEV = (float*)(p.ws + OFF_GATEV);
  int* POS = (int*)(p.ws + OFF_POS);
  int* CNT = (int*)(p.ws + OFF_CNT);
  const int lr = lane & 31, lh = lane >> 5;
  float4 nw[4];
#pragma unroll
  for (int i = 0; i < 4; ++i) nw[i] = *(const float4*)(p.norm_ffn_w + lane * 4 + 256 * i);
  for (int task = blockIdx.x; task < NR / 32; task += gridDim.x) {
    const int r0 = task * 32;
    __syncthreads();
    if (tid < 32) lhist[tid] = 0;
    int lp0 = 0, lp1 = 0, lp2 = 0, lp3 = 0, xe0 = 0, xe1 = 0, xe2 = 0, xe3 = 0;
#pragma unroll
    for (int tt = 0; tt < 4; ++tt) {
      const int r = r0 + wave * 4 + tt;
      const float* src = H1 + (size_t)r * 1024;
      float4 v[4];
      float ss = 0.f;
#pragma unroll
      for (int i = 0; i < 4; ++i) {
        v[i] = *(const float4*)(src + lane * 4 + 256 * i);
        ss += v[i].x * v[i].x + v[i].y * v[i].y + v[i].z * v[i].z + v[i].w * v[i].w;
      }
      ss = wave_sum(ss);
      const float rstd = rsqrtf(ss * (1.f / 1024.f) + 1e-6f);
      if (lane == 0) rstds[wave * 4 + tt] = rstd;
#pragma unroll
      for (int i = 0; i < 4; ++i) {
        uint2 o;
        o.x = pk2(v[i].x * rstd * nw[i].x, v[i].y * rstd * nw[i].y);
        o.y = pk2(v[i].z * rstd * nw[i].z, v[i].w * rstd * nw[i].w);
        *(uint2*)(U2 + (size_t)r * 1024 + lane * 4 + 256 * i) = o;
      }
    }
    f32x16 acc;
#pragma unroll
    for (int i = 0; i < 16; ++i) acc[i] = 0.f;
    const float* arow = H1 + (size_t)(r0 + lr) * 1024 + wave * 128;
    const float* bcol = wrs + (size_t)(wave * 128 + lh) * 32 + lr;
#pragma unroll 8
    for (int k0 = 0; k0 < 128; k0 += 4) {
      const float4 a4 = *(const float4*)(arow + k0);
      const float b0 = bcol[(size_t)k0 * 32], b1 = bcol[(size_t)(k0 + 2) * 32];
      acc = __builtin_amdgcn_mfma_f32_32x32x2f32(lh ? a4.y : a4.x, b0, acc, 0, 0, 0);
      acc = __builtin_amdgcn_mfma_f32_32x32x2f32(lh ? a4.w : a4.z, b1, acc, 0, 0, 0);
    }
#pragma unroll
    for (int r = 0; r < 16; ++r) part[(wave * 32 + crow(r, lh)) * 33 + lr] = acc[r];
    __syncthreads();
    if (tid < 32) {
      const float myrstd = rstds[tid];
      float lv[32];
#pragma unroll
      for (int e = 0; e < 32; ++e) {
        float a = 0.f;
#pragma unroll
        for (int w = 0; w < 8; ++w) a += part[(w * 32 + tid) * 33 + e];
        lv[e] = a * myrstd + p.b_router[e];
      }
      float tv[4];
      int te[4];
#pragma unroll
      for (int k = 0; k < 4; ++k) {
        float bv = lv[0];
        int bi = 0;
#pragma unroll
        for (int e = 1; e < 32; ++e)
          if (lv[e] > bv) { bv = lv[e]; bi = e; }
        tv[k] = bv;
        te[k] = bi;
#pragma unroll
        for (int e = 0; e < 32; ++e)
          if (e == bi) lv[e] = -3.0e38f;
      }
      const float e1 = __expf(tv[1] - tv[0]), e2 = __expf(tv[2] - tv[0]), e3 = __expf(tv[3] - tv[0]);
      const float inv = 1.f / (1.f + e1 + e2 + e3);
      const size_t rr = (size_t)(r0 + tid) * 4;
      TOPE[rr + 0] = te[0]; TOPE[rr + 1] = te[1]; TOPE[rr + 2] = te[2]; TOPE[rr + 3] = te[3];
      GATEV[rr + 0] = inv; GATEV[rr + 1] = e1 * inv; GATEV[rr + 2] = e2 * inv; GATEV[rr + 3] = e3 * inv;
      lp0 = atomicAdd(&lhist[te[0]], 1); lp1 = atomicAdd(&lhist[te[1]], 1); lp2 = atomicAdd(&lhist[te[2]], 1); lp3 = atomicAdd(&lhist[te[3]], 1);
      xe0 = te[0]; xe1 = te[1]; xe2 = te[2]; xe3 = te[3];
    }
    __syncthreads();
    if (tid < 32) {
      const int c = lhist[tid];
      lbase[tid] = (c > 0) ? atomicAdd(&CNT[tid * CNTS], c) : 0;
    }
    __syncthreads();
    if (tid < 32) {
      const size_t rr = (size_t)(r0 + tid) * 4;
      POS[rr + 0] = lbase[xe0] + lp0; POS[rr + 1] = lbase[xe1] + lp1; POS[rr + 2] = lbase[xe2] + lp2; POS[rr + 3] = lbase[xe3] + lp3;
    }
  }
}
DI void phase_lists(const Params& p) {
  const int* CNT = (const int*)(p.ws + OFF_CNT);
  const int* TOPE = (const int*)(p.ws + OFF_TOPE);
  const float* GATEV = (const float*)(p.ws + OFF_GATEV);
  const int* POS = (const int*)(p.ws + OFF_POS);
  int* SLOT = (int*)(p.ws + OFF_SLOT);
  int* LTOK = (int*)(p.ws + OFF_LTOK);
  float* LGATE = (float*)(p.ws + OFF_LGATE);
  for (int a = blockIdx.x * NTHREADS + otid(p); a < NASG; a += gridDim.x * NTHREADS) {
    const int e = TOPE[a];
    int off = 0;
    for (int j = 0; j < e; ++j) off += CNT[j * CNTS];
    const int slot = off + POS[a];
    SLOT[a] = slot;
    LTOK[slot] = a >> 2;
    LGATE[slot] = GATEV[a];
  }
}
DI void phase_combine(const Params& p) {
  const float* H1 = (const float*)(p.ws + OFF_H1);
  const unsigned short* Y = (const unsigned short*)(p.ws + OFF_Y);
  const int* SLOT = (const int*)(p.ws + OFF_SLOT);
  for (int idx = blockIdx.x * NTHREADS + otid(p); idx < NR * 256; idx += gridDim.x * NTHREADS) {
    const int r = idx >> 8, c4 = (idx & 255) * 4;
    float4 a = *(const float4*)(H1 + (size_t)r * 1024 + c4);
#pragma unroll
    for (int k = 0; k < 4; ++k) {
      const int slot = SLOT[r * 4 + k];
      uint2 y = *(const uint2*)(Y + (size_t)slot * 1024 + c4);
      a.x += bf2f((unsigned short)(y.x & 0xffffu));
      a.y += bf2f((unsigned short)(y.x >> 16));
      a.z += bf2f((unsigned short)(y.y & 0xffffu));
      a.w += bf2f((unsigned short)(y.y >> 16));
    }
    *(float4*)(p.out + (size_t)r * 1024 + c4) = a;
  }
}


#define XB_TMO      128
#define XB_XCNT(j)  (256  + 64 * (j))
#define XB_XSUB(j)  (1280 + 64 * (j))
#define XB_XGEN(j)  (2304 + 64 * (j))
#define XB_TOP      3328
#define XB_TOPGEN   3392
#define XB_SPIN_CAP (1u << 22)
DI unsigned xb_ld(unsigned* p) { return __hip_atomic_load(p, __ATOMIC_RELAXED, __HIP_MEMORY_SCOPE_AGENT); }
DI unsigned xb_add(unsigned* p, unsigned v) { return __hip_atomic_fetch_add(p, v, __ATOMIC_RELAXED, __HIP_MEMORY_SCOPE_AGENT); }
DI unsigned xb_xcc_id() { return (unsigned)__builtin_amdgcn_s_getreg((3 << 11) | 20) & 0xFu; }
#define XB_SPIN(cond, bar) do { unsigned _sp = 0; while (cond) { __builtin_amdgcn_s_sleep(1); \
    if ((++_sp & 255u) == 0u) { if (xb_ld(&(bar)[XB_TMO])) break; if (_sp > XB_SPIN_CAP) { atomicAdd(&(bar)[XB_TMO], 1u); break; } } } } while (0)
struct XcdBarrier { unsigned* bar; unsigned x; volatile LAS unsigned* st; bool leader; };
DI void xcd_barrier_complete(unsigned* bar, unsigned x, unsigned& nloc, unsigned& nx) {
  const unsigned G = gridDim.x * gridDim.y * gridDim.z;
  unsigned sum, cnt, mine, sp = 0u;
  for (;;) {
    sum = 0u; cnt = 0u; mine = 0u;
#pragma unroll
    for (unsigned j = 0; j < 16; ++j) { const unsigned c = xb_ld(&bar[XB_XCNT(j)]); sum += c; cnt += (c > 0u) ? 1u : 0u; mine = (j == x) ? c : mine; }
    if (sum == G) break;
    __builtin_amdgcn_s_sleep(1);
    if ((++sp & 255u) == 0u) { if (xb_ld(&bar[XB_TMO])) break; if (sp > XB_SPIN_CAP) { atomicAdd(&bar[XB_TMO], 1u); break; } }
  }
  nloc = mine > 0u ? mine : 1u; nx = cnt > 0u ? cnt : 1u;
}
DI void xcd_barrier(const XcdBarrier& b) {
  asm volatile("s_waitcnt vmcnt(0)" ::: "memory");
  __syncthreads();
  if (b.leader) {
    unsigned* bar = b.bar;
    __builtin_amdgcn_s_waitcnt(0);
    unsigned nloc = b.st[0], nx = b.st[1];
    if (nloc == 0u) { xcd_barrier_complete(bar, b.x, nloc, nx); b.st[0] = nloc; b.st[1] = nx; }
    const unsigned old = xb_add(&bar[XB_XSUB(b.x)], 1u);
    const unsigned gen = old / nloc;
    if (old + 1u == (gen + 1u) * nloc) {
      __builtin_amdgcn_fence(__ATOMIC_RELEASE, "agent");
      asm volatile("s_waitcnt vmcnt(0)" ::: "memory");
      const unsigned og = xb_add(&bar[XB_TOP], 1u);
      const unsigned tg = og / nx;
      if (og + 1u == (tg + 1u) * nx) xb_add(&bar[XB_TOPGEN], 1u);
      else XB_SPIN(xb_ld(&bar[XB_TOPGEN]) == tg, bar);
      __builtin_amdgcn_fence(__ATOMIC_ACQUIRE, "agent");
      xb_add(&bar[XB_XGEN(b.x)], 1u);
      asm volatile("s_waitcnt vmcnt(0)" ::: "memory");
    } else {
      XB_SPIN(xb_ld(&bar[XB_XGEN(b.x)]) == gen, bar);
      __builtin_amdgcn_fence(__ATOMIC_ACQUIRE, "agent");
      asm volatile("s_waitcnt vmcnt(0)" ::: "memory");
    }
  }
  __syncthreads();
}

constexpr int SMEM_BYTES = g8::STAGE_BYTES + 1024;

__global__ void __launch_bounds__(NTHREADS) mk(Params p0) {
  __shared__ __attribute__((aligned(16))) char smem[SMEM_BYTES];
  Params p = p0;
  p.wv = __builtin_amdgcn_readfirstlane((int)(threadIdx.x >> 6));
  XcdBarrier xb;
  {
    volatile LAS unsigned* st = (volatile LAS unsigned*)((LAS unsigned char*)smem + g8::STAGE_BYTES + 768);
    if (threadIdx.x == 0) { st[0] = 0u; st[1] = 0u; }
    __syncthreads();
    xb.bar = (unsigned*)(p.ws + OFF_BAR); xb.x = xb_xcc_id(); xb.st = st; xb.leader = (threadIdx.x == 0);
    if (xb.leader) (void)xb_add(&xb.bar[XB_XCNT(xb.x)], 1u);
  }
  phase_prep(p);
  phase_wconv(p, 0, WC_SMALL);
  xcd_barrier(xb);
  g8::gemm_phase<0>(p, smem);
  wconv_fill(p, smem, 0, false);
  xcd_barrier(xb);
  phase_post1(p, smem);
  xcd_barrier(xb);
  g8::gemm_phase<1>(p, smem);
  phase_chunkprep(p, smem);
  wconv_fill(p, smem, 1, false);
  xcd_barrier(xb);
  if (blockIdx.x < 16) scan_block(p, smem, blockIdx.x, 0, NCH);
  phase_post2(p, smem);
  phase_indexer(p, smem);
  wconv_fill(p, smem, 2, false);
  xcd_barrier(xb);
  phase_gnorm(p);
  phase_scan_attn(p, smem);
  wconv_fill(p, smem, 3, false);
  xcd_barrier(xb);
  g8::gemm_phase<2>(p, smem);
  xcd_barrier(xb);
  phase_router(p, smem);
  xcd_barrier(xb);
  phase_lists(p);
  wconv_fill(p, smem, 4, true);
  xcd_barrier(xb);
  g8::gemm_phase<3>(p, smem);
  xcd_barrier(xb);
  g8::gemm_phase<4>(p, smem);
  xcd_barrier(xb);
  phase_combine(p);
}

extern "C" void kernel_launch(void* const* d_in, const int* in_sizes, int n_in, void* d_out, int out_size, void* d_ws,
                              size_t ws_size, hipStream_t stream) {
  (void)in_sizes; (void)n_in; (void)out_size;
  if (ws_size < WS_NEED) return;
  Params p{};
  p.x = (const float*)d_in[0]; p.meta = (const float*)d_in[1]; p.norm_mix_w = (const float*)d_in[2];
  p.w_in = (const float*)d_in[3]; p.q_norm_w = (const float*)d_in[4]; p.k_norm_w = (const float*)d_in[5];
  p.kv_norm_w = (const float*)d_in[6]; p.w_kv_up = (const float*)d_in[7]; p.conv_w = (const float*)d_in[8];
  p.a_log = (const float*)d_in[9]; p.dt_bias = (const float*)d_in[10]; p.delta_norm_w = (const float*)d_in[11];
  p.w_out = (const float*)d_in[12]; p.norm_ffn_w = (const float*)d_in[13]; p.w_router = (const float*)d_in[14];
  p.b_router = (const float*)d_in[15]; p.w_gate_up = (const float*)d_in[16]; p.b_gate_up = (const float*)d_in[17];
  p.w_down = (const float*)d_in[18]; p.b_down = (const float*)d_in[19];
  p.out = (float*)d_out;
  p.ws = (char*)d_ws;
  (void)hipMemsetAsync((char*)d_ws + OFF_CNT, 0, 4096, stream);
  (void)hipMemsetAsync((char*)d_ws + OFF_BAR, 0, 16384, stream);
  static int grid_blocks = 0;
  if (!grid_blocks) {
    int dev = 0, cus = 0, per_cu = 0;
    (void)hipGetDevice(&dev);
    (void)hipDeviceGetAttribute(&cus, hipDeviceAttributeMultiprocessorCount, dev);
    (void)hipOccupancyMaxActiveBlocksPerMultiprocessor(&per_cu, mk, NTHREADS, 0);
    if (per_cu > 1) per_cu = 1;
    grid_blocks = cus * per_cu;
  }
  void* args[] = {&p};
  hipError_t e = hipLaunchCooperativeKernel((void*)mk, dim3(grid_blocks), dim3(NTHREADS), args, 0, stream);
  if (e != hipSuccess) fprintf(stderr, "cooperative launch failed: %s (grid %d)\n", hipGetErrorString(e), grid_blocks);
}
```
